# Optimizing an MI355X kernel written in HIP

```python
import math
import jax
import jax.numpy as jnp
from jax import lax
import numpy as np

D_MODEL = 1024
BATCH = 8
SEQ = 4096
DEPTH = 2
DEC_BATCH = 4
DEC_SEQ = 4096
PAST_LEN = 128

N_META = 16
NORM_EPS = 1e-6
N_BRANCH = 4
BRANCH_WIDTH = D_MODEL // 2
D_FF = 4 * D_MODEL

HG_WIDTH = BRANCH_WIDTH
HG_HEAD_DIM = 128
HG_HEADS = HG_WIDTH // HG_HEAD_DIM
HG_CHUNK = 64
LB_FLOOR = 1e-20

SC_WIDTH = BRANCH_WIDTH
SC_KSIZE = 3

DA_HEADS = 4
DA_QK_DIM = 64
DA_V_DIM = 2 * DA_QK_DIM
DA_QK_WIDTH = DA_HEADS * 2 * DA_QK_DIM
DA_WIDTH = DA_HEADS * DA_V_DIM
ROPE_THETA = 500000.0
ROPE_DIM = DA_QK_DIM // 4
Q_BLOCK = 128
SUBLN_EPS = 1e-5

RW_WIDTH = BRANCH_WIDTH
RW_HEAD_DIM = 64
RW_HEADS = RW_WIDTH // RW_HEAD_DIM
RW_DECAY_RANK = 64
RW_ICLR_RANK = 64
RW_GATE_RANK = 128
RW_LNX_EPS = 64e-5
RW_SIZES = (RW_WIDTH, RW_WIDTH, RW_WIDTH, RW_DECAY_RANK, RW_DECAY_RANK, RW_ICLR_RANK, RW_ICLR_RANK, RW_GATE_RANK)
RW_COLS = sum(RW_SIZES)
IN_SIZES = (HG_WIDTH,) * 5 + (SC_WIDTH,) * 3 + (DA_QK_WIDTH, DA_QK_WIDTH, DA_WIDTH, RW_COLS)
N_IN = sum(IN_SIZES)

kernel_name = 'hybrid_bidir_encoder_two_groups'


def _split(z, sizes):
    return jnp.split(z, [int(c) for c in np.cumsum(sizes)[:-1]], axis=-1)


def rms_norm(x, g, eps=NORM_EPS):
    xf = x.astype(jnp.float32)
    y = xf * lax.rsqrt(jnp.mean(xf * xf, axis=-1, keepdims=True) + eps)
    return (y * g.astype(jnp.float32)).astype(x.dtype)


def rope_partial(x, pos):
    half = ROPE_DIM // 2
    inv = ROPE_THETA ** (-jnp.arange(half, dtype=jnp.float32) / half)
    ang = pos[:, None] * inv[None, :]
    cos, sin = jnp.cos(ang), jnp.sin(ang)
    x1 = x[..., :half].astype(jnp.float32)
    x2 = x[..., half:ROPE_DIM].astype(jnp.float32)
    rot = jnp.concatenate([x1 * cos - x2 * sin, x2 * cos + x1 * sin], axis=-1).astype(x.dtype)
    return jnp.concatenate([rot, x[..., ROPE_DIM:]], axis=-1)


def centred_shift(u):
    up = jnp.pad(u, ((0, 0), (1, 1), (0, 0)))
    return 0.5 * (up[:, :-2] + up[:, 2:])


def gla_chunk_scan(q, k, logf, v):
    B, H, T, DK = q.shape
    DV = v.shape[-1]
    n = T // HG_CHUNK

    def to_chunks(a):
        return jnp.moveaxis(a.reshape(B, H, n, HG_CHUNK, a.shape[-1]), 2, 0)

    causal = jnp.tril(jnp.ones((HG_CHUNK, HG_CHUNK), dtype=bool))[:, :, None]

    def step(S, inp):
        qi, ki, gi, vi = inp
        b = jnp.cumsum(gi, axis=2)
        diff = b[:, :, :, None, :] - b[:, :, None, :, :]
        decay = jnp.where(causal, jnp.exp(jnp.where(causal, diff, 0.0)), 0.0)
        attn = jnp.einsum('bhtk,bhtsk,bhsk->bhts', qi, decay, ki)
        o = (jnp.einsum('bhts,bhsv->bhtv', attn, vi)
             + jnp.einsum('bhtk,bhkv->bhtv', qi * jnp.exp(b), S))
        b_last = b[:, :, -1:, :]
        S = (jnp.exp(b_last[:, :, 0, :, None]) * S
             + jnp.einsum('bhsk,bhsv->bhkv', ki * jnp.exp(b_last - b), vi))
        return S, o

    S0 = jnp.zeros((B, H, DK, DV), jnp.float32)
    _, o = lax.scan(step, S0, (to_chunks(q), to_chunks(k), to_chunks(logf), to_chunks(v)))
    return jnp.moveaxis(o, 0, 2).reshape(B, H, T, DV)


def hgrn2_mixer(q, f_fwd, f_bwd, i, g, lb, onorm_g):
    dt = q.dtype
    B, L, _ = q.shape
    pad = (-N_META) % HG_CHUNK

    def heads(t):
        t = jnp.pad(t.astype(jnp.float32), ((0, 0), (pad, 0), (0, 0)))
        return t.reshape(B, L + pad, HG_HEADS, HG_HEAD_DIM).transpose(0, 2, 1, 3)

    qh, vh = heads(q), heads(i)
    outs = []
    for d, f_raw in enumerate((f_fwd, f_bwd)):
        lb_d = lb[d].astype(jnp.float32)
        logf = jnp.logaddexp(jnp.log(jnp.maximum(lb_d, LB_FLOOR)),
                             jnp.log1p(-lb_d) + jax.nn.log_sigmoid(f_raw.astype(jnp.float32)))
        seqs = (qh, heads(-jnp.expm1(logf)), heads(logf), vh)
        if d == 1:
            seqs = tuple(jnp.flip(t, axis=2) for t in seqs)
        o = gla_chunk_scan(*seqs)
        if d == 1:
            o = jnp.flip(o, axis=2)
        outs.append(o)
    o = (outs[0] + outs[1]).transpose(0, 2, 1, 3)[:, pad:]
    o = rms_norm(o, onorm_g.reshape(HG_HEADS, HG_HEAD_DIM)).reshape(B, L, HG_WIDTH)
    return (o * jax.nn.silu(g.astype(jnp.float32))).astype(dt)


def shortconv_mixer(b, c, h, conv_w):
    L = h.shape[1]
    half = SC_KSIZE // 2
    u = jnp.pad(c * h, ((0, 0), (half, half), (0, 0)))
    y = u[:, 0:L] * conv_w[0]
    for j in range(1, SC_KSIZE):
        y = y + u[:, j:j + L] * conv_w[j]
    return (b * y).astype(h.dtype)


def diff_attention_mixer(q, k, v, qn_g, kn_g, lam_p, subln_g, lam_init, pos):
    dt = v.dtype
    B, L, _ = q.shape
    q = q.reshape(B, L, DA_HEADS, 2, DA_QK_DIM).transpose(0, 2, 3, 1, 4)
    k = k.reshape(B, L, DA_HEADS, 2, DA_QK_DIM).transpose(0, 2, 3, 1, 4)
    v = v.reshape(B, L, DA_HEADS, DA_V_DIM).transpose(0, 2, 1, 3)
    q = rope_partial(rms_norm(q, qn_g), pos) * (DA_QK_DIM ** -0.5)
    k = rope_partial(rms_norm(k, kn_g), pos)
    lam_p = lam_p.astype(jnp.float32)
    lam = jnp.exp(jnp.sum(lam_p[0] * lam_p[1])) - jnp.exp(jnp.sum(lam_p[2] * lam_p[3])) + lam_init
    n_blk = -(-L // Q_BLOCK)
    qp = jnp.pad(q, ((0, 0), (0, 0), (0, 0), (0, n_blk * Q_BLOCK - L), (0, 0)))
    qb = jnp.moveaxis(qp.reshape(B, DA_HEADS, 2, n_blk, Q_BLOCK, DA_QK_DIM), 3, 0)

    def block(qi):
        s = jnp.einsum('bhmqd,bhmkd->bhmqk', qi, k).astype(jnp.float32)
        p = jax.nn.softmax(s, axis=-1)
        w = p[:, :, 0] - lam * p[:, :, 1]
        return jnp.einsum('bhqk,bhkv->bhqv', w.astype(dt), v)

    o = lax.map(block, qb)
    o = jnp.moveaxis(o, 0, 2).reshape(B, DA_HEADS, n_blk * Q_BLOCK, DA_V_DIM)[:, :, :L]
    o = rms_norm(o, subln_g, SUBLN_EPS) * (1.0 - lam_init)
    return o.transpose(0, 2, 1, 3).reshape(B, L, DA_WIDTH).astype(dt)


def rwkv7_scan(r, w, k, v, kk, a):
    B, L, H, N = r.shape

    def step(S, inp):
        rt, wt, kt, vt, kkt, at = inp
        sa = jnp.einsum('bhvk,bhk->bhv', S, -kkt)
        S = (S * wt[:, :, None, :] + sa[..., None] * (kkt * at)[:, :, None, :]
             + vt[..., None] * kt[:, :, None, :])
        return S, jnp.einsum('bhvk,bhk->bhv', S, rt)

    xs = tuple(jnp.moveaxis(t, 1, 0) for t in (r, w, k, v, kk, a))
    _, o = lax.scan(step, jnp.zeros((B, H, N, N), jnp.float32), xs)
    return jnp.moveaxis(o, 0, 1)


def rwkv7_mixer(cols, mu, w0, w2, a0, a2, g2, k_k, k_a, r_k, lnx_g, lnx_b):
    dt = cols.dtype
    B, L, _ = cols.shape
    u = cols.astype(jnp.float32)
    xm = u + mu * (centred_shift(u) - u)
    r, k, v, wl_f, wl_b, al_f, al_b, gl = _split(xm, RW_SIZES)

    def heads(t):
        return t.reshape(B, L, RW_HEADS, RW_HEAD_DIM)

    kk = heads(k * k_k)
    kk = kk / jnp.maximum(jnp.sqrt(jnp.sum(kk * kk, axis=-1, keepdims=True)), 1e-12)
    rh, vh = heads(r), heads(v)
    outs, keys = [], []
    for d, (wl, al) in enumerate(((wl_f, al_f), (wl_b, al_b))):
        wlog = -jax.nn.softplus(-(w0[d] + jnp.tanh(wl) @ w2[d])) - 0.5
        decay = heads(jnp.exp(-jnp.exp(wlog)))
        a = jax.nn.sigmoid(a0[d] + al @ a2[d])
        kd = heads(k * (1.0 + (a - 1.0) * k_a))
        seqs = (rh, decay, kd, vh, kk, heads(a))
        if d == 1:
            seqs = tuple(jnp.flip(t, axis=1) for t in seqs)
        o = rwkv7_scan(*seqs)
        if d == 1:
            o = jnp.flip(o, axis=1)
        outs.append(o)
        keys.append(kd)
    o = outs[0] + outs[1]
    mean = jnp.mean(o, axis=-1, keepdims=True)
    var = jnp.mean(jnp.square(o - mean), axis=-1, keepdims=True)
    o = ((o - mean) * lax.rsqrt(var + RW_LNX_EPS)).reshape(B, L, RW_WIDTH) * lnx_g + lnx_b
    bonus = jnp.sum(rh * (keys[0] + keys[1]) * r_k, axis=-1, keepdims=True) * vh
    y = (o + bonus.reshape(B, L, RW_WIDTH)) * (jax.nn.sigmoid(gl) @ g2)
    return y.astype(dt)


def encoder_layer(x, l, p, lb, pos):
    B, L, _ = x.shape
    h = rms_norm(x, p['norm_mix_g'][l])
    z = h @ p['w_in'][l]
    hq, hf_f, hf_b, hi, hg, sb, sc, sh, dq, dk, dv, rw = _split(z, IN_SIZES)
    y_hg = hgrn2_mixer(hq, hf_f, hf_b, hi, hg, lb, p['hgrn_onorm_g'][l])
    y_sc = shortconv_mixer(sb, sc, sh, p['conv_w'][l])
    y_da = diff_attention_mixer(dq, dk, dv, p['diff_qnorm_g'][l], p['diff_knorm_g'][l],
                                p['diff_lambda'][l], p['diff_subln_g'][l],
                                0.8 - 0.6 * math.exp(-0.3 * l), pos)
    y_rw = rwkv7_mixer(rw, p['rwkv_mu'][l], p['rwkv_w0'][l], p['rwkv_w2'][l], p['rwkv_a0'][l],
                       p['rwkv_a2'][l], p['rwkv_g2'][l], p['rwkv_k_k'][l], p['rwkv_k_a'][l],
                       p['rwkv_r_k'][l], p['rwkv_lnx_g'][l], p['rwkv_lnx_b'][l])
    gates = jax.nn.sigmoid(h @ p['w_gate'][l]).reshape(B, L, N_BRANCH, D_MODEL)
    merged = gates[:, :, 0] * (y_hg @ p['branch_proj'][l, 0])
    for n, y_n in enumerate((y_sc, y_da, y_rw), start=1):
        merged = merged + gates[:, :, n] * (y_n @ p['branch_proj'][l, n])
    x = x + merged @ p['w_out'][l]
    h2 = rms_norm(x, p['norm_mlp_g'][l])
    x = x + jnp.square(jax.nn.relu(h2 @ p['mlp_w1'][l])) @ p['mlp_w2'][l]
    return x


def trunk(x, p):
    B, S, _ = x.shape
    meta = jnp.broadcast_to(p['meta_tokens'].astype(x.dtype)[None], (B, N_META, D_MODEL))
    h = jnp.concatenate([meta, x], axis=1)
    pos = jnp.arange(N_META + S, dtype=jnp.float32)
    sm = jax.nn.softmax(p['hgrn_lb_logits'].astype(jnp.float32), axis=1)
    lb = jnp.cumsum(sm, axis=1) - sm[:, :1]
    for l in range(DEPTH):
        h = encoder_layer(h, l, p, lb[:, l], pos)
    return h[:, N_META:]


def setup_inputs(seed: int = 0) -> dict:
    key = jax.random.key(seed)
    keys = jax.random.split(key, 40)
    ks = (keys[i] for i in range(40))

    def nrm(shape, scale):
        return scale * jax.random.normal(next(ks), shape, jnp.float32)

    def gain(shape):
        return 1.0 + 0.02 * jax.random.normal(next(ks), shape, jnp.float32)

    def unif(shape, lo, hi):
        return jax.random.uniform(next(ks), shape, jnp.float32, lo, hi)

    return {
        'x_prompt': nrm((BATCH, SEQ, D_MODEL), 1.0),
        'x_sample': nrm((DEC_BATCH, DEC_SEQ, D_MODEL), 1.0),
        'meta_tokens': nrm((N_META, D_MODEL), 1.0),
        'norm_mix_g': gain((DEPTH, D_MODEL)),
        'w_in': nrm((DEPTH, D_MODEL, N_IN), D_MODEL ** -0.5),
        'hgrn_lb_logits': nrm((2, DEPTH, HG_WIDTH), 0.5),
        'hgrn_onorm_g': gain((DEPTH, HG_WIDTH)),
        'conv_w': nrm((DEPTH, SC_KSIZE, SC_WIDTH), SC_KSIZE ** -0.5),
        'diff_qnorm_g': gain((DEPTH, DA_QK_DIM)),
        'diff_knorm_g': gain((DEPTH, DA_QK_DIM)),
        'diff_lambda': nrm((DEPTH, 4, DA_QK_DIM), 0.1),
        'diff_subln_g': gain((DEPTH, DA_V_DIM)),
        'rwkv_mu': unif((DEPTH, RW_COLS), 0.0, 1.0),
        'rwkv_w0': unif((DEPTH, 2, RW_WIDTH), -6.5, -1.5),
        'rwkv_w2': nrm((DEPTH, 2, RW_DECAY_RANK, RW_WIDTH), 0.1 * RW_DECAY_RANK ** -0.5),
        'rwkv_a0': nrm((DEPTH, 2, RW_WIDTH), 0.1),
        'rwkv_a2': nrm((DEPTH, 2, RW_ICLR_RANK, RW_WIDTH), RW_ICLR_RANK ** -0.5),
        'rwkv_g2': nrm((DEPTH, RW_GATE_RANK, RW_WIDTH), RW_GATE_RANK ** -0.5),
        'rwkv_k_k': 0.85 + nrm((DEPTH, RW_WIDTH), 0.02),
        'rwkv_k_a': gain((DEPTH, RW_WIDTH)),
        'rwkv_r_k': nrm((DEPTH, RW_HEADS, RW_HEAD_DIM), 0.1),
        'rwkv_lnx_g': gain((DEPTH, RW_WIDTH)),
        'rwkv_lnx_b': nrm((DEPTH, RW_WIDTH), 0.02),
        'w_gate': nrm((DEPTH, D_MODEL, N_BRANCH * D_MODEL), D_MODEL ** -0.5),
        'branch_proj': nrm((DEPTH, N_BRANCH, BRANCH_WIDTH, D_MODEL), BRANCH_WIDTH ** -0.5),
        'w_out': nrm((DEPTH, D_MODEL, D_MODEL), D_MODEL ** -0.5),
        'norm_mlp_g': gain((DEPTH, D_MODEL)),
        'mlp_w1': nrm((DEPTH, D_MODEL, D_FF), D_MODEL ** -0.5),
        'mlp_w2': nrm((DEPTH, D_FF, D_MODEL), D_FF ** -0.5),
    }


def reference(x_prompt, x_sample, meta_tokens, norm_mix_g, w_in, hgrn_lb_logits, hgrn_onorm_g,
              conv_w, diff_qnorm_g, diff_knorm_g, diff_lambda, diff_subln_g, rwkv_mu, rwkv_w0,
              rwkv_w2, rwkv_a0, rwkv_a2, rwkv_g2, rwkv_k_k, rwkv_k_a, rwkv_r_k, rwkv_lnx_g,
              rwkv_lnx_b, w_gate, branch_proj, w_out, norm_mlp_g, mlp_w1, mlp_w2):
    p = {
        'meta_tokens': meta_tokens, 'norm_mix_g': norm_mix_g, 'w_in': w_in,
        'hgrn_lb_logits': hgrn_lb_logits, 'hgrn_onorm_g': hgrn_onorm_g, 'conv_w': conv_w,
        'diff_qnorm_g': diff_qnorm_g, 'diff_knorm_g': diff_knorm_g, 'diff_lambda': diff_lambda,
        'diff_subln_g': diff_subln_g, 'rwkv_mu': rwkv_mu, 'rwkv_w0': rwkv_w0, 'rwkv_w2': rwkv_w2,
        'rwkv_a0': rwkv_a0, 'rwkv_a2': rwkv_a2, 'rwkv_g2': rwkv_g2, 'rwkv_k_k': rwkv_k_k,
        'rwkv_k_a': rwkv_k_a, 'rwkv_r_k': rwkv_r_k, 'rwkv_lnx_g': rwkv_lnx_g,
        'rwkv_lnx_b': rwkv_lnx_b, 'w_gate': w_gate, 'branch_proj': branch_proj, 'w_out': w_out,
        'norm_mlp_g': norm_mlp_g, 'mlp_w1': mlp_w1, 'mlp_w2': mlp_w2,
    }
    y_prompt = trunk(x_prompt, p)
    y_sample = trunk(x_sample, p)
    return (y_prompt, y_sample)
```

```cpp
#include <hip/hip_runtime.h>
#include <hip/hip_cooperative_groups.h>
#include <cstdio>
#include <cstdint>
namespace cg = cooperative_groups;
#define PROBE 0
#define DEV __device__ __forceinline__
__device__ __forceinline__ int lsd(int x) { asm volatile("" : "+s"(x)); return x; }
__device__ __forceinline__ int launder_tid(int wv) { int l; asm volatile("v_mbcnt_lo_u32_b32 %0, -1, 0\n\tv_mbcnt_hi_u32_b32 %0, -1, %0" : "=v"(l)); return wv * 64 + l; }
namespace pg8 {
#define PG8_LAS __attribute__((address_space(3)))
typedef unsigned short bf16_t;
typedef short bf16x8 __attribute__((ext_vector_type(8)));
typedef float f32x4 __attribute__((ext_vector_type(4)));
typedef unsigned u32x4 __attribute__((ext_vector_type(4)));
constexpr int BM = 256, BK = 64, HALF = 128, HTB = HALF * BK * 2  , STAGE_BYTES = 8 * HTB, NXCD = 8, WGM = 8;

__host__ __device__ __forceinline__ int lds_byte(int r, int c) { const int st = (r >> 4) * 2 + (c >> 5), rr = r & 15, cc = c & 31, ob = rr * 64 + cc * 2; return st * 1024 + (ob ^ (((ob >> 9) & 1) << 5)); }
__host__ __device__ __forceinline__ void stage_rc(int b, int& R, int& C) { const int st = b / 1024, sb = b % 1024, swz = sb ^ (((sb >> 9) & 1) << 5); R = (st >> 1) * 16 + swz / 64; C = (st & 1) * 32 + (swz % 64) / 2; }
__host__ __device__ __forceinline__ int perm32(int rho) { const int n = rho >> 4, i = rho & 15; return 8 * (i >> 2) + 4 * n + (i & 3); }

struct Unit { int pm, pn; };
struct Gemm { const bf16_t* A; const bf16_t* Bt; int M, N, K; int pn_per_ab; size_t ab_stride; };

struct StaticOrder {
    int nM, nN, nwg, G, c;
    __host__ __device__ void init(int M, int N, int G_, int c_) { nM = M / BM; nN = N / BM; nwg = nM * nN; G = G_; c = c_; }
    __host__ __device__ bool next(int i, Unit& u) const {
        const long L = (long)i * G + c; if (L >= nwg) return false;
        int wgid = (int)L; { const int q = nwg / NXCD, r = nwg % NXCD, xcd = wgid % NXCD, off = wgid / NXCD; wgid = (xcd < r ? xcd * (q + 1) : r * (q + 1) + (xcd - r) * q) + off; }
        const int nig = WGM * nN, gid = wgid / nig, fm = gid * WGM, gsz = (nM - fm) < WGM ? (nM - fm) : WGM;
        u.pm = fm + ((wgid % nig) % gsz); u.pn = (wgid % nig) / gsz; return true;
    }
    __device__ __forceinline__ void a_ready(const Unit&) const {}
    __device__ __forceinline__ void done(const Unit&) const {}
};

__device__ __forceinline__ unsigned cvt_pk_bf16(float lo, float hi) { unsigned r; asm volatile("v_cvt_pk_bf16_f32 %0, %1, %2" : "=v"(r) : "v"(lo), "v"(hi)); return r; }
typedef float f32x2 __attribute__((ext_vector_type(2)));
__device__ __forceinline__ float sigm(float x) { return __builtin_amdgcn_rcpf(1.0f + __expf(-x)); }
template <int ACT  > struct EpiBf {
    static constexpr bool PERM = true, AFTER_DRAIN = false;
    bf16_t* O; int ldc; size_t gstride;
    __device__ __forceinline__ void operator()(const f32x4 (&acc)[2][2][4][2], const Unit& u, int wr, int wc, int fr, int fq) const {
        const int row0 = u.pm * BM + wr * 64 + fr; int colt = u.pn * BM; bf16_t* base = O; int ld = ldc;
        if (gstride) { const int t = colt >> 9; colt &= 511; base += (size_t)t * gstride; ld = 512; }
        const int col0 = colt + wc * 32 + 8 * fq;
#pragma unroll
        for (int ai = 0; ai < 2; ++ai)
#pragma unroll
            for (int m = 0; m < 4; ++m) { bf16_t* rowp = base + (size_t)(row0 + ai * HALF + m * 16) * ld + col0;
#pragma unroll
                for (int bj = 0; bj < 2; ++bj) { f32x4 v0 = acc[ai][bj][m][0], v1 = acc[ai][bj][m][1];
                    if (ACT == 1) {
#pragma unroll
                        for (int i = 0; i < 4; ++i) { float a = fmaxf(v0[i], 0.f), b = fmaxf(v1[i], 0.f); v0[i] = a * a; v1[i] = b * b; } }
                    u32x4 w; w.x = cvt_pk_bf16(v0[0], v0[1]); w.y = cvt_pk_bf16(v0[2], v0[3]); w.z = cvt_pk_bf16(v1[0], v1[1]); w.w = cvt_pk_bf16(v1[2], v1[3]);
                    *(u32x4*)(rowp + bj * HALF) = w; } }
    }
};
struct EpiLR {
    static constexpr bool PERM = true, AFTER_DRAIN = false;
    bf16_t *s0, *s1, *s2, *s3, *s4; const float* w0; const float* a0;
    __device__ __forceinline__ void operator()(const f32x4 (&acc)[2][2][4][2], const Unit& u, int wr, int wc, int fr, int fq) const {
        const int row0 = u.pm * BM + wr * 64 + fr; const int colg = u.pn * BM; const int seg = colg >> 9; const int cb = colg & 511;
        bf16_t* base = seg == 0 ? s0 : seg == 1 ? s1 : seg == 2 ? s2 : seg == 3 ? s3 : s4;
        const int col0 = cb + wc * 32 + 8 * fq;
        const float* bsrc = seg < 2 ? w0 + seg * 512 : a0 + (seg & 1) * 512;
        const float sc = seg < 2 ? 0.6065306597f : 1.0f; const float bm = seg < 4 ? 1.f : 0.f; const bool act = seg < 4;
#pragma unroll
        for (int bj = 0; bj < 2; ++bj) {
            const f32x4 b0 = *(const f32x4*)(bsrc + col0 + bj * HALF) * bm, b1 = *(const f32x4*)(bsrc + col0 + bj * HALF + 4) * bm;
#pragma unroll
            for (int ai = 0; ai < 2; ++ai)
#pragma unroll
                for (int m = 0; m < 4; ++m) { bf16_t* rowp = base + (size_t)(row0 + ai * HALF + m * 16) * 512 + col0;
                    f32x4 v0 = acc[ai][bj][m][0] + b0, v1 = acc[ai][bj][m][1] + b1;
#pragma unroll
                    for (int i = 0; i < 4; ++i) { const float g0 = sc * sigm(v0[i]), g1 = sc * sigm(v1[i]); v0[i] = act ? g0 : v0[i]; v1[i] = act ? g1 : v1[i]; }
                    u32x4 w; w.x = cvt_pk_bf16(v0[0], v0[1]); w.y = cvt_pk_bf16(v0[2], v0[3]); w.z = cvt_pk_bf16(v1[0], v1[1]); w.w = cvt_pk_bf16(v1[2], v1[3]);
                    *(u32x4*)(rowp + bj * HALF) = w; __builtin_amdgcn_sched_barrier(0); }
        }
    }
};
struct EpiGate {
    static constexpr bool PERM = true, AFTER_DRAIN = false;
    const bf16_t* Pm; bf16_t* Mg;
    __device__ __forceinline__ void operator()(const f32x4 (&acc)[2][2][4][2], const Unit& u, int wr, int wc, int fr, int fq) const {
        const int row0 = u.pm * BM + wr * 64 + fr; const int ocol = u.pn * 64 + wc * 16 + fq * 4;
#pragma unroll
        for (int ai = 0; ai < 2; ++ai)
#pragma unroll
            for (int m = 0; m < 4; ++m) { const size_t row = (size_t)(row0 + ai * HALF + m * 16);
                float s0 = 0.f, s1 = 0.f, s2 = 0.f, s3 = 0.f;
#pragma unroll
                for (int bj = 0; bj < 2; ++bj)
#pragma unroll
                    for (int n = 0; n < 2; ++n) { const int br = bj * 2 + n;
                        const uint2 pw = *(const uint2*)(Pm + row * 4096 + br * 1024 + ocol);
                        const f32x4 a = acc[ai][bj][m][n];
                        s0 += sigm(a[0]) * __uint_as_float(pw.x << 16); s1 += sigm(a[1]) * __uint_as_float(pw.x & 0xffff0000u);
                        s2 += sigm(a[2]) * __uint_as_float(pw.y << 16); s3 += sigm(a[3]) * __uint_as_float(pw.y & 0xffff0000u); }
                uint2 o; o.x = cvt_pk_bf16(s0, s1); o.y = cvt_pk_bf16(s2, s3);
                *(uint2*)(Mg + row * 1024 + ocol) = o; }
    }
};
struct EpiResid {
    static constexpr bool PERM = true, AFTER_DRAIN = false;
    const float* om; const float* mt; float* nm; float* xmb; int g; int rlim;
    __device__ __forceinline__ void operator()(const f32x4 (&acc)[2][2][4][2], const Unit& u, int wr, int wc, int fr, int fq) const {
        const int row0 = u.pm * BM + wr * 64 + fr; const int col0 = u.pn * BM + wc * 32 + 8 * fq;
#pragma unroll
        for (int ai = 0; ai < 2; ++ai)
#pragma unroll
            for (int m = 0; m < 4; ++m) { const int r = row0 + ai * HALF + m * 16;
                if (r < rlim) {
                    const int mi = r - 16384;
                    float* dmeta = xmb + (size_t)(mi < 64 ? g * 64 + mi : ((mi >> 6) - 1) * 64 + (mi & 63)) * 1024;
                    const float* src = r < 16384 ? om + (size_t)r * 1024 : (mt ? mt + (size_t)(mi & 15) * 1024 : (const float*)dmeta);
                    float* dst = r < 16384 ? nm + (size_t)r * 1024 : dmeta;
#pragma unroll
                    for (int bj = 0; bj < 2; ++bj)
#pragma unroll
                        for (int n = 0; n < 2; ++n) { const int c = col0 + bj * HALF + 4 * n;
                            const f32x4 xo = *(const f32x4*)(src + c); *(f32x4*)(dst + c) = xo + acc[ai][bj][m][n]; } } }
    }
};
template <class Epi, class Sched, bool ALIGN_EPI = false, bool SP2 = false>
__device__ __forceinline__ void gemm_phase(PG8_LAS unsigned char* lds, const Gemm g, const Sched& S, const Epi& E, int wv) {
    const int tid = launder_tid(wv), wid = __builtin_amdgcn_readfirstlane(tid >> 6), lane = tid & 63, wr = wid >> 2, wc = wid & 3, fr = lane & 15, fq = lane >> 4;
    const int K = g.K, nt = K / BK;
    unsigned voffA[2], voffB[2];
#pragma unroll
    for (int i = 0; i < 2; ++i) { int R, C; stage_rc(tid * 16 + i * 8192, R, C); const int Rb = Epi::PERM ? ((R & ~31) + perm32(R & 31)) : R;
        voffA[i] = (unsigned)(R * K + C) * 2u; voffB[i] = (unsigned)(Rb * K + C) * 2u; }
    const size_t kstep = (size_t)(BK * 2);
    const size_t hstep = (size_t)HALF * K * 2;
    const size_t tstep = 2 * hstep;
    const unsigned ldsw = (unsigned)wid * 1024u;
    const int aoff = lds_byte(wr * 64 + fr, fq * 8), boff = lds_byte(wc * 32 + fr, fq * 8);
#define PG8_SA(b, h) (((b) * 2 + (h)) * HTB)
#define PG8_SB(b, h) ((4 + (b) * 2 + (h)) * HTB)
#define PG8_STAGE(bufoff, gbase, voff) do { _Pragma("unroll") for (int _i = 0; _i < 2; ++_i) \
        __builtin_amdgcn_global_load_lds((const unsigned*)((const char*)(gbase) + (voff)[_i]), (PG8_LAS unsigned*)(lds + (bufoff) + ldsw + _i * 8192), 16, 0, 0); } while (0)
#define PG8_LDA(dst, b, h) do { _Pragma("unroll") for (int m = 0; m < 4; ++m) _Pragma("unroll") for (int k = 0; k < 2; ++k) dst[m][k] = *(const PG8_LAS bf16x8*)(lds + PG8_SA(b, h) + aoff + m * 2048 + k * 1024); } while (0)
#define PG8_LDB(dst, b, h) do { _Pragma("unroll") for (int n = 0; n < 2; ++n) _Pragma("unroll") for (int k = 0; k < 2; ++k) dst[n][k] = *(const PG8_LAS bf16x8*)(lds + PG8_SB(b, h) + boff + n * 2048 + k * 1024); } while (0)
#define PG8_MMA(ai, bj, At, Bt) do { __builtin_amdgcn_s_setprio(1); _Pragma("unroll") for (int m = 0; m < 4; ++m) _Pragma("unroll") for (int n = 0; n < 2; ++n) _Pragma("unroll") for (int k = 0; k < 2; ++k) \
        acc[ai][bj][m][n] = __builtin_amdgcn_mfma_f32_16x16x32_bf16(Bt[n][k], At[m][k], acc[ai][bj][m][n], 0, 0, 0); __builtin_amdgcn_s_setprio(0); } while (0)
#define PG8_WAIT_V(n) asm volatile("s_waitcnt vmcnt(" #n ")" ::: "memory")
#define PG8_WAIT_L(n) asm volatile("s_waitcnt lgkmcnt(" #n ")" ::: "memory")
#define PG8_BAR __builtin_amdgcn_s_barrier()
#define PG8_SCHED __builtin_amdgcn_sched_barrier(0)
    Unit cur, nxt; int ui = 0;
    if (!S.next(0, cur)) return;
    f32x4 acc[2][2][4][2];
#pragma unroll
    for (int a = 0; a < 2; ++a)
#pragma unroll
        for (int b = 0; b < 2; ++b)
#pragma unroll
            for (int m = 0; m < 4; ++m)
#pragma unroll
                for (int n = 0; n < 2; ++n) { float z_ = 0.f; asm volatile("" : "+v"(z_)); acc[a][b][m][n] = (f32x4){z_, z_, z_, z_}; }
    bf16x8 At[4][2], B0[2][2], B1[2][2];
    const char* cA = (const char*)g.A + (g.pn_per_ab ? (size_t)(cur.pn / g.pn_per_ab) * g.ab_stride : (size_t)0) + (size_t)cur.pm * tstep; const char* cB = (const char*)g.Bt + (size_t)cur.pn * tstep;
    S.a_ready(cur);
    if constexpr (SP2) {
        PG8_STAGE(PG8_SB(0, 0), cB, voffB); PG8_STAGE(PG8_SB(0, 1), cB + hstep, voffB); PG8_STAGE(PG8_SA(0, 0), cA, voffA); PG8_STAGE(PG8_SA(0, 1), cA + hstep, voffA);
        if (wr == 1) PG8_BAR;
        PG8_WAIT_V(2); PG8_BAR;
        PG8_STAGE(PG8_SB(1, 0), cB + kstep, voffB); PG8_STAGE(PG8_SA(1, 0), cA + kstep, voffA); PG8_STAGE(PG8_SB(1, 1), cB + hstep + kstep, voffB);
        PG8_WAIT_V(6); PG8_BAR;
    } else {
        PG8_STAGE(PG8_SB(0, 0), cB, voffB); PG8_STAGE(PG8_SA(0, 0), cA, voffA); PG8_STAGE(PG8_SB(0, 1), cB + hstep, voffB); PG8_STAGE(PG8_SA(0, 1), cA + hstep, voffA);
        if (wr == 1) PG8_BAR;
        PG8_WAIT_V(4); PG8_BAR;
        PG8_STAGE(PG8_SB(1, 0), cB + kstep, voffB); PG8_STAGE(PG8_SA(1, 0), cA + kstep, voffA); PG8_STAGE(PG8_SB(1, 1), cB + hstep + kstep, voffB);
        PG8_WAIT_V(6); PG8_BAR;
    }
    for (;;) {
        const bool has_next = S.next(ui + 1, nxt);
        const char* nA = has_next ? (const char*)g.A + (g.pn_per_ab ? (size_t)(nxt.pn / g.pn_per_ab) * g.ab_stride : (size_t)0) + (size_t)nxt.pm * tstep : cA; const char* nB = has_next ? (const char*)g.Bt + (size_t)nxt.pn * tstep : cB;
#pragma unroll 1
        for (int t = 0; t < nt; t += 2) {
            const bool last = (t == nt - 2);
            const char* a1 = cA + (size_t)(t + 1) * kstep;
            const char* a2 = last ? nA : cA + (size_t)(t + 2) * kstep; const char* b2 = last ? nB : cB + (size_t)(t + 2) * kstep;
            const char* a3 = a2 + kstep; const char* b3 = b2 + kstep;
            if (last && has_next) S.a_ready(nxt);
            if constexpr (SP2) {
            PG8_LDB(B0, 0, 0); PG8_LDB(B1, 0, 1); PG8_SCHED; PG8_LDA(At, 0, 0); PG8_STAGE(PG8_SA(1, 1), a1 + hstep, voffA);
            PG8_WAIT_V(8); PG8_WAIT_L(0); PG8_BAR; PG8_MMA(0, 0, At, B0); PG8_MMA(0, 1, At, B1); PG8_BAR; PG8_SCHED;
            PG8_LDA(At, 0, 1); PG8_STAGE(PG8_SB(0, 0), b2, voffB); PG8_STAGE(PG8_SB(0, 1), b2 + hstep, voffB); PG8_STAGE(PG8_SA(0, 0), a2, voffA);
            PG8_WAIT_V(8); PG8_WAIT_L(0); PG8_BAR; PG8_MMA(1, 0, At, B0); PG8_MMA(1, 1, At, B1); PG8_BAR; PG8_SCHED;
            PG8_LDB(B0, 1, 0); PG8_LDB(B1, 1, 1); PG8_SCHED; PG8_LDA(At, 1, 0); PG8_STAGE(PG8_SA(0, 1), a2 + hstep, voffA);
            PG8_WAIT_V(8); PG8_WAIT_L(0); PG8_BAR; PG8_MMA(0, 0, At, B0); PG8_MMA(0, 1, At, B1); PG8_BAR; PG8_SCHED;
            PG8_LDA(At, 1, 1); PG8_STAGE(PG8_SB(1, 0), b3, voffB); PG8_STAGE(PG8_SB(1, 1), b3 + hstep, voffB); PG8_STAGE(PG8_SA(1, 0), a3, voffA);
            PG8_WAIT_V(8); PG8_WAIT_L(0); PG8_BAR; PG8_MMA(1, 0, At, B0); PG8_MMA(1, 1, At, B1); PG8_BAR; PG8_SCHED;
            } else {
            PG8_LDB(B0, 0, 0); PG8_SCHED; PG8_LDA(At, 0, 0); PG8_STAGE(PG8_SA(1, 1), a1 + hstep, voffA);
            PG8_WAIT_L(8); PG8_BAR; PG8_WAIT_L(0); PG8_MMA(0, 0, At, B0); PG8_BAR; PG8_SCHED;
            PG8_LDB(B1, 0, 1); PG8_STAGE(PG8_SB(0, 0), b2, voffB);
            PG8_BAR; PG8_WAIT_L(0); PG8_MMA(0, 1, At, B1); PG8_BAR;
            PG8_LDA(At, 0, 1); PG8_STAGE(PG8_SA(0, 0), a2, voffA);
            PG8_BAR; PG8_WAIT_L(0); PG8_MMA(1, 0, At, B0); PG8_BAR; PG8_SCHED;
            PG8_STAGE(PG8_SB(0, 1), b2 + hstep, voffB);
            PG8_WAIT_V(6); PG8_BAR; PG8_MMA(1, 1, At, B1); PG8_BAR;
            PG8_LDB(B0, 1, 0); PG8_SCHED; PG8_LDA(At, 1, 0); PG8_STAGE(PG8_SA(0, 1), a2 + hstep, voffA);
            PG8_WAIT_L(8); PG8_BAR; PG8_WAIT_L(0); PG8_MMA(0, 0, At, B0); PG8_BAR; PG8_SCHED;
            PG8_LDB(B1, 1, 1); PG8_STAGE(PG8_SB(1, 0), b3, voffB);
            PG8_BAR; PG8_WAIT_L(0); PG8_MMA(0, 1, At, B1); PG8_BAR;
            PG8_LDA(At, 1, 1); PG8_STAGE(PG8_SA(1, 0), a3, voffA);
            PG8_BAR; PG8_WAIT_L(0); PG8_MMA(1, 0, At, B0); PG8_BAR; PG8_SCHED;
            PG8_STAGE(PG8_SB(1, 1), b3 + hstep, voffB);
            PG8_WAIT_V(6); PG8_BAR; PG8_MMA(1, 1, At, B1); PG8_BAR;
            }
        }
        if constexpr (ALIGN_EPI) { if (wr == 0) PG8_BAR; }
        if constexpr (!Epi::AFTER_DRAIN) { E(acc, cur, wr, wc, fr, fq); S.done(cur); }
        if (!has_next) break;
#pragma unroll
        for (int a = 0; a < 2; ++a)
#pragma unroll
            for (int b = 0; b < 2; ++b)
#pragma unroll
                for (int m = 0; m < 4; ++m)
#pragma unroll
                    for (int n = 0; n < 2; ++n) { float z_ = 0.f; asm volatile("" : "+v"(z_)); acc[a][b][m][n] = (f32x4){z_, z_, z_, z_}; }
        cur = nxt; cA = nA; cB = nB; ++ui;
        if constexpr (ALIGN_EPI) { if (wr == 1) PG8_BAR; }
    }
    PG8_WAIT_V(0);
    if constexpr (!ALIGN_EPI) { if (wr == 0) PG8_BAR; }
    PG8_BAR;
    if constexpr (Epi::AFTER_DRAIN) { E.fused(acc, cur, wr, wc, fr, fq, lds, wid, lane); S.done(cur); }
#undef PG8_SA
#undef PG8_SB
#undef PG8_STAGE
#undef PG8_LDA
#undef PG8_LDB
#undef PG8_MMA
#undef PG8_WAIT_V
#undef PG8_WAIT_L
#undef PG8_BAR
#undef PG8_SCHED
}
}
typedef unsigned short bf16_t;
typedef short bf16x8 __attribute__((ext_vector_type(8)));
typedef float f32x4 __attribute__((ext_vector_type(4)));
typedef float f32x16 __attribute__((ext_vector_type(16)));
constexpr int LSEQ = 4112, TREAL = 16384, TG = 16448, TGP = 16640, NGRP = 3;
constexpr size_t SLOT_E = (size_t)TGP * 512;
constexpr size_t SLOT_B = SLOT_E * 2;
constexpr size_t MiB = 1u << 20;
constexpr size_t WS_XMETA = 1 * MiB, WS_DECAY = 2 * MiB, WS_SIDE = 3 * MiB + 512 * 1024, WS_W = 5 * MiB, WS_SLOTS = 53 * MiB;
constexpr size_t WS_NEED = WS_SLOTS + 25 * SLOT_B;
constexpr size_t WO_IN = 0, WO_G = 7864320, WO_BP = 12058624, WO_OUT = 14155776, WO_1 = 15204352, WO_2 = 19398656, WO_LR = 23592960;
constexpr int LDS_BYTES = 140 * 1024;
enum { I_XP = 0, I_XS, I_META, I_NMIX, I_WIN, I_LBL, I_ONORM, I_CONV, I_QN, I_KN, I_LAM, I_SUBLN, I_MU, I_W0, I_W2, I_A0, I_A2, I_G2, I_KK, I_KA, I_RK, I_LNG, I_LNB, I_WG, I_BP, I_WOUT, I_NMLP, I_W1, I_W2M };
struct Params { const float* in[29]; float* out; unsigned char* ws; };
typedef const __attribute__((address_space(4))) Params* KParamsPtr;
DEV KParamsPtr kparams() { KParamsPtr p = (KParamsPtr)__builtin_amdgcn_kernarg_segment_ptr(); asm volatile("" : "+s"(p)); return p; }
DEV Params load_params() { KParamsPtr p = kparams(); Params r;
#pragma unroll
    for (int i = 0; i < 29; ++i) r.in[i] = p->in[i];
    r.out = p->out; r.ws = p->ws; return r; }
DEV unsigned zero_u() { unsigned z = 0u; asm volatile("" : "+v"(z)); return z; }

#define ROWPRO const int tid_ = launder_tid(wv); const int lane = tid_ & 63; const int gw = bid * 8 + __builtin_amdgcn_readfirstlane(tid_ >> 6); const int ngw = nb * 8;
DEV float bf2f(unsigned short u) { return __uint_as_float((unsigned)u << 16); }
DEV unsigned pk2(float lo, float hi) { return pg8::cvt_pk_bf16(lo, hi); }
DEV void unpack8(const uint4 w, float* f) {
    f[0] = __uint_as_float(w.x << 16); f[1] = __uint_as_float(w.x & 0xffff0000u); f[2] = __uint_as_float(w.y << 16); f[3] = __uint_as_float(w.y & 0xffff0000u);
    f[4] = __uint_as_float(w.z << 16); f[5] = __uint_as_float(w.z & 0xffff0000u); f[6] = __uint_as_float(w.w << 16); f[7] = __uint_as_float(w.w & 0xffff0000u); }
DEV uint4 pack8(const float* f) { uint4 o; o.x = pk2(f[0], f[1]); o.y = pk2(f[2], f[3]); o.z = pk2(f[4], f[5]); o.w = pk2(f[6], f[7]); return o; }
DEV bf16_t* slotp(const Params& P, int s) { return (bf16_t*)(P.ws + WS_SLOTS + (size_t)s * SLOT_B); }
DEV int row_of(int sl, int p) { return p >= 16 ? sl * 4096 + p - 16 : TREAL + sl * 16 + p; }
DEV void pos_of(int r, int& sl, int& p) { if (r < TREAL) { sl = r >> 12; p = (r & 4095) + 16; } else { const int m = r - TREAL; sl = m >> 4; p = m & 15; } }
DEV float wave_sum(float v) {
#pragma unroll
    for (int o = 1; o < 64; o <<= 1) v += __shfl_xor(v, o);
    return v; }
DEV float red8(float v) { v += __shfl_xor(v, 1); v += __shfl_xor(v, 2); v += __shfl_xor(v, 4); return v; }
DEV f32x4 mfma16(bf16x8 a, bf16x8 b, f32x4 c) { return __builtin_amdgcn_mfma_f32_16x16x32_bf16(a, b, c, 0, 0, 0); }
DEV f32x16 mfma32(bf16x8 a, bf16x8 b, f32x16 c) { return __builtin_amdgcn_mfma_f32_32x32x16_bf16(a, b, c, 0, 0, 0); }
DEV const float* x_in_row(const Params& P, int g, int r) {
    if (r < TREAL) return (g < 2 ? P.in[I_XP] + (size_t)g * TREAL * 1024 : P.in[I_XS]) + (size_t)r * 1024;
    return P.in[I_META] + (size_t)((r - TREAL) & 15) * 1024; }
DEV float* x_cur_row(const Params& P, int g, int r) {
    if (r < TREAL) return P.out + ((size_t)g * TREAL + r) * 1024;
    const int m = r - TREAL;
    return (float*)(P.ws + WS_XMETA) + (size_t)(m < 64 ? g * 64 + m : ((m >> 6) - 1) * 64 + (m & 63)) * 1024; }

DEV int gate_row(int n) { const int br = n >> 10, c = n & 1023, pn = c >> 6, oc = c & 63, wc = oc >> 4, fq = (oc >> 2) & 3, i = oc & 3; return pn * 256 + (br >> 1) * 128 + wc * 32 + fq * 8 + (br & 1) * 4 + i; }
template <int MODE> DEV void wt_items(const float* __restrict__ W, int K, int N, bf16_t* WT, int row_off, float* scr, int gw, int ngw, int lane) {
    const int nblk = N >> 5, items = (K >> 6) * nblk;
    for (int it = gw; it < items; it += ngw) {
        const int kb = it / nblk, nbk = it - kb * nblk, k0 = 64 * kb, n0 = 32 * nbk;
#pragma unroll 8
        for (int i = 0; i < 32; ++i) { const int kk = 2 * i + (lane >> 5); scr[kk * 33 + (lane & 31)] = W[(size_t)(k0 + kk) * N + n0 + (lane & 31)]; }
        asm volatile("s_waitcnt lgkmcnt(0)" ::: "memory");
        const int c = lane & 7;
#pragma unroll
        for (int j = 0; j < 4; ++j) { const int n = (lane >> 3) + 8 * j; const float* sp = scr + (8 * c) * 33 + n;
            uint4 o; o.x = pk2(sp[0 * 33], sp[1 * 33]); o.y = pk2(sp[2 * 33], sp[3 * 33]); o.z = pk2(sp[4 * 33], sp[5 * 33]); o.w = pk2(sp[6 * 33], sp[7 * 33]);
            const int dr = MODE == 1 ? gate_row(n0 + n) : n0 + n + row_off;
            *(uint4*)(WT + (size_t)dr * K + k0 + 8 * c) = o; }
        asm volatile("s_waitcnt lgkmcnt(0)" ::: "memory");
    }
}
DEV void phase_weights(const Params& P0, int layer, unsigned char* lds, int bid, int nb, int wv) {
    Params P = load_params(); asm volatile("" : "+s"(P.ws));
    const int tid = launder_tid(wv), lane = tid & 63, w = __builtin_amdgcn_readfirstlane(tid >> 6);
    const int gtid = bid * 512 + tid, gth = nb * 512, gw = bid * 8 + w, ngw = nb * 8;
    float* scr = (float*)(lds + w * 8448);
    bf16_t* W = (bf16_t*)(P.ws + WS_W);
    wt_items<0>(P.in[I_WIN] + (size_t)layer * 1024 * 7552, 1024, 7552, W + WO_IN, 0, scr, gw, ngw, lane);
    for (int it = gtid; it < 128 * 128; it += gth) { const unsigned z = zero_u(); *(uint4*)(W + WO_IN + (size_t)7552 * 1024 + (size_t)it * 8) = make_uint4(z, z, z, z); }
    wt_items<1>(P.in[I_WG] + (size_t)layer * 1024 * 4096, 1024, 4096, W + WO_G, 0, scr, gw, ngw, lane);
    for (int n = 0; n < 4; ++n) wt_items<0>(P.in[I_BP] + (size_t)(layer * 4 + n) * 512 * 1024, 512, 1024, W + WO_BP, n * 1024, scr, gw, ngw, lane);
    wt_items<0>(P.in[I_WOUT] + (size_t)layer * 1024 * 1024, 1024, 1024, W + WO_OUT, 0, scr, gw, ngw, lane);
    wt_items<0>(P.in[I_W1] + (size_t)layer * 1024 * 4096, 1024, 4096, W + WO_1, 0, scr, gw, ngw, lane);
    wt_items<0>(P.in[I_W2M] + (size_t)layer * 4096 * 1024, 4096, 1024, W + WO_2, 0, scr, gw, ngw, lane);
    for (int it = gtid; it < 2560 * 48; it += gth) {
        const int row = it / 48, k8 = it - row * 48, seg = row >> 9, c = row & 511, k0 = k8 * 8;
        float v[8];
#pragma unroll
        for (int j = 0; j < 8; ++j) { const int k = k0 + j; float x = 0.f;
            if (seg == 0) { if (k < 64) x = P.in[I_W2][((size_t)(layer * 2 + 0) * 64 + k) * 512 + c]; }
            else if (seg == 1) { if (k >= 64 && k < 128) x = P.in[I_W2][((size_t)(layer * 2 + 1) * 64 + (k - 64)) * 512 + c]; }
            else if (seg == 2) { if (k >= 128 && k < 192) x = P.in[I_A2][((size_t)(layer * 2 + 0) * 64 + (k - 128)) * 512 + c]; }
            else if (seg == 3) { if (k >= 192 && k < 256) x = P.in[I_A2][((size_t)(layer * 2 + 1) * 64 + (k - 192)) * 512 + c]; }
            else { if (k >= 256) x = P.in[I_G2][((size_t)layer * 128 + (k - 256)) * 512 + c]; }
            v[j] = x; }
        *(uint4*)(W + WO_LR + (size_t)row * 384 + k0) = pack8(v);
    }
}

DEV void phase_rmsnorm(const Params& P0, int g, bool src_in, int gain_idx, int layer, int nrows, int nvalid, int bid, int nb, int wv) {
    Params P = load_params(); asm volatile("" : "+s"(P.ws));
    ROWPRO
    const float* gain = P.in[gain_idx] + layer * 1024;
    bf16_t* H = slotp(P, 0);
    for (int r = gw; r < nrows; r += ngw) {
        uint2* o8 = (uint2*)(H + (size_t)r * 1024) + lane;
        if (r >= nvalid) {
#pragma unroll
            for (int j = 0; j < 4; ++j) { const unsigned z = zero_u(); o8[64 * j] = make_uint2(z, z); }
            continue; }
        const f32x4* xr = (const f32x4*)(src_in ? x_in_row(P, g, r) : (const float*)x_cur_row(P, g, r)) + lane;
        f32x4 v[4]; float s = 0.f;
#pragma unroll
        for (int j = 0; j < 4; ++j) { v[j] = xr[64 * j]; s += (v[j].x * v[j].x + v[j].y * v[j].y) + (v[j].z * v[j].z + v[j].w * v[j].w); }
        const float rs = rsqrtf(wave_sum(s) * (1.f / 1024.f) + 1e-6f);
#pragma unroll
        for (int j = 0; j < 4; ++j) { const f32x4 gg = *((const f32x4*)gain + lane + 64 * j);
            o8[64 * j] = make_uint2(pk2(v[j].x * rs * gg.x, v[j].y * rs * gg.y), pk2(v[j].z * rs * gg.z, v[j].w * rs * gg.w)); }
    }
}
DEV void phase_da_prep(const Params& P0, int layer, int bid, int nb, int wv) {
    Params P = load_params(); asm volatile("" : "+s"(P.ws));
    ROWPRO
    const float inv8[8] = {1.0f, 0.19392274474868576f, 0.03760603093086393f, 0.007292664737217109f, 0.001414213562373095f, 0.0002742481756762073f, 5.318295896944988e-05f, 1.031338537721246e-05f};
    const int d0 = (lane & 7) * 8;
    float gq[8], gk[8];
#pragma unroll
    for (int j = 0; j < 8; ++j) { gq[j] = P.in[I_QN][layer * 64 + d0 + j]; gk[j] = P.in[I_KN][layer * 64 + d0 + j]; }
    for (int r = gw; r < TG; r += ngw) {
        int sl, p; pos_of(r, sl, p);
        float cs[8], sn[8];
#pragma unroll
        for (int j = 0; j < 8; ++j) { const float ang = (float)p * inv8[j]; double a = (double)ang; a -= 6.283185307179586 * __builtin_rint(a * 0.15915494309189535); const float rr = (float)a; cs[j] = __cosf(rr); sn[j] = __sinf(rr); }
#pragma unroll
        for (int which = 0; which < 2; ++which) {
            uint4* ptr = (uint4*)(slotp(P, 10 + which) + (size_t)r * 512) + lane;
            float f[8]; unpack8(*ptr, f);
            float ss = 0.f;
#pragma unroll
            for (int j = 0; j < 8; ++j) ss += f[j] * f[j];
            ss = red8(ss);
            const float rs = rsqrtf(ss * (1.f / 64.f) + 1e-6f);
#pragma unroll
            for (int j = 0; j < 8; ++j) f[j] = f[j] * rs * (which == 0 ? gq[j] : gk[j]);
#pragma unroll
            for (int j = 0; j < 8; ++j) { const float pr = __shfl_xor(f[j], 1);
                if ((lane & 7) == 0) f[j] = f[j] * cs[j] - pr * sn[j];
                else if ((lane & 7) == 1) f[j] = f[j] * cs[j] + pr * sn[j]; }
            if (which == 0) {
#pragma unroll
                for (int j = 0; j < 8; ++j) f[j] *= 0.18033688011112042f; }
            *ptr = pack8(f);
        }
    }
}
DEV void phase_conv(const Params& P0, int layer, int bid, int nb, int wv) {
    Params P = load_params(); asm volatile("" : "+s"(P.ws));
    ROWPRO
    const int c0 = lane * 8;
    float w0[8], w1[8], w2[8];
#pragma unroll
    for (int j = 0; j < 8; ++j) { w0[j] = P.in[I_CONV][(layer * 3 + 0) * 512 + c0 + j]; w1[j] = P.in[I_CONV][(layer * 3 + 1) * 512 + c0 + j]; w2[j] = P.in[I_CONV][(layer * 3 + 2) * 512 + c0 + j]; }
    const bf16_t* SB = slotp(P, 7); const bf16_t* SC = slotp(P, 8); const bf16_t* SH = slotp(P, 9); bf16_t* Y = slotp(P, 3);
    for (int r = gw; r < TG; r += ngw) {
        int sl, p; pos_of(r, sl, p);
        float acc[8], a[8], b[8];
        unpack8(*((const uint4*)(SC + (size_t)r * 512) + lane), a); unpack8(*((const uint4*)(SH + (size_t)r * 512) + lane), b);
#pragma unroll
        for (int j = 0; j < 8; ++j) acc[j] = a[j] * b[j] * w1[j];
        if (p > 0) { const int rp = row_of(sl, p - 1);
            unpack8(*((const uint4*)(SC + (size_t)rp * 512) + lane), a); unpack8(*((const uint4*)(SH + (size_t)rp * 512) + lane), b);
#pragma unroll
            for (int j = 0; j < 8; ++j) acc[j] += a[j] * b[j] * w0[j]; }
        if (p < LSEQ - 1) { const int rn = row_of(sl, p + 1);
            unpack8(*((const uint4*)(SC + (size_t)rn * 512) + lane), a); unpack8(*((const uint4*)(SH + (size_t)rn * 512) + lane), b);
#pragma unroll
            for (int j = 0; j < 8; ++j) acc[j] += a[j] * b[j] * w2[j]; }
        unpack8(*((const uint4*)(SB + (size_t)r * 512) + lane), a);
#pragma unroll
        for (int j = 0; j < 8; ++j) acc[j] *= a[j];
        *((uint4*)(Y + (size_t)r * 512) + lane) = pack8(acc);
    }
}
DEV void phase_rw_prep(const Params& P0, int layer, int bid, int nb, int wv) {
    Params P = load_params(); asm volatile("" : "+s"(P.ws));
    ROWPRO
    const float* mu = P.in[I_MU] + (size_t)layer * 1920;
    for (int r = gw; r < TG; r += ngw) {
        int sl, p; pos_of(r, sl, p);
        const int rp = p > 0 ? row_of(sl, p - 1) : -1, rn = p < LSEQ - 1 ? row_of(sl, p + 1) : -1;
#pragma unroll
        for (int grp = 0; grp < 4; ++grp) {
            if (grp == 3 && lane >= 48) break;
            const int c0 = (grp < 3 ? grp * 512 : 1536) + lane * 8;
            const bf16_t* src = slotp(P, 13 + (c0 >> 9)) + (c0 & 511);
            float u[8], up[8], un[8], xm[8];
            unpack8(*(const uint4*)(src + (size_t)r * 512), u);
            if (rp >= 0) unpack8(*(const uint4*)(src + (size_t)rp * 512), up); else {
#pragma unroll
                for (int j = 0; j < 8; ++j) up[j] = 0.f; }
            if (rn >= 0) unpack8(*(const uint4*)(src + (size_t)rn * 512), un); else {
#pragma unroll
                for (int j = 0; j < 8; ++j) un[j] = 0.f; }
#pragma unroll
            for (int j = 0; j < 8; ++j) xm[j] = u[j] + mu[c0 + j] * (0.5f * (up[j] + un[j]) - u[j]);
            if (grp < 3) {
                *((uint4*)(slotp(P, 17 + grp) + (size_t)r * 512) + lane) = pack8(xm);
                if (grp == 1) {
                    float kk[8], ss = 0.f;
#pragma unroll
                    for (int j = 0; j < 8; ++j) { kk[j] = xm[j] * P.in[I_KK][layer * 512 + c0 - 512 + j]; ss += kk[j] * kk[j]; }
                    ss = red8(ss);
                    const float inv = 1.0f / fmaxf(sqrtf(ss), 1e-12f);
#pragma unroll
                    for (int j = 0; j < 8; ++j) kk[j] *= inv;
                    *((uint4*)(slotp(P, 20) + (size_t)r * 512) + lane) = pack8(kk); }
            } else {
                const int a0 = lane * 8;
                float o[8];
#pragma unroll
                for (int j = 0; j < 8; ++j) { const float x = xm[j];
                    if (a0 < 128) { const float e = __expf(2.f * x); o[j] = 1.f - 2.f / (e + 1.f); }
                    else if (a0 < 256) o[j] = x;
                    else o[j] = 1.f / (1.f + __expf(-x)); }
                *((uint4*)(slotp(P, 21) + (size_t)r * 384) + lane) = pack8(o);
            }
        }
    }
    for (int r = TG + gw; r < TGP; r += ngw) if (lane < 48) { const unsigned z = zero_u(); *((uint4*)(slotp(P, 21) + (size_t)r * 384) + lane) = make_uint4(z, z, z, z); }
}
DEV void phase_rw_post(const Params& P0, int layer, int g, int nrows, int bid, int nb, int wv) {
    Params P = load_params(); asm volatile("" : "+s"(P.ws));
    ROWPRO
    const int c0 = lane * 8;
    float ka[8], rk[8], lg[8], lb[8];
#pragma unroll
    for (int j = 0; j < 8; ++j) { ka[j] = P.in[I_KA][layer * 512 + c0 + j]; rk[j] = P.in[I_RK][layer * 512 + c0 + j]; lg[j] = P.in[I_LNG][layer * 512 + c0 + j]; lb[j] = P.in[I_LNB][layer * 512 + c0 + j]; }
    for (int r = gw; r < nrows; r += ngw) {
        float of[8], ob[8], o[8];
        unpack8(*((const uint4*)(slotp(P, 15) + (size_t)r * 512) + lane), of); unpack8(*((const uint4*)(slotp(P, 16) + (size_t)r * 512) + lane), ob);
        float s = 0.f;
#pragma unroll
        for (int j = 0; j < 8; ++j) { o[j] = of[j] + ob[j]; s += o[j]; }
        const float mean = red8(s) * (1.f / 64.f);
        float q = 0.f;
#pragma unroll
        for (int j = 0; j < 8; ++j) { o[j] -= mean; q += o[j] * o[j]; }
        const float rs = rsqrtf(red8(q) * (1.f / 64.f) + 64e-5f);
        float rr[8], kk[8], vv[8], af[8], ab[8], gg[8];
        unpack8(*((const uint4*)(slotp(P, 17) + (size_t)r * 512) + lane), rr); unpack8(*((const uint4*)(slotp(P, 18) + (size_t)r * 512) + lane), kk);
        unpack8(*((const uint4*)(slotp(P, 19) + (size_t)r * 512) + lane), vv); unpack8(*((const uint4*)(slotp(P, 24) + (size_t)r * 512) + lane), af);
        unpack8(*((const uint4*)(slotp(P, 13) + (size_t)r * 512) + lane), ab); unpack8(*((const uint4*)(slotp(P, 14) + (size_t)r * 512) + lane), gg);
        float bs = 0.f;
#pragma unroll
        for (int j = 0; j < 8; ++j) { const float kd = kk[j] * (2.f + (af[j] + ab[j] - 2.f) * ka[j]); bs += rr[j] * kd * rk[j]; }
        bs = red8(bs);
        float y[8];
#pragma unroll
        for (int j = 0; j < 8; ++j) y[j] = (o[j] * rs * lg[j] + lb[j] + bs * vv[j]) * gg[j];
        const uint4 yv = pack8(y);
        *((uint4*)(slotp(P, 5) + (size_t)r * 512) + lane) = yv;
        if (layer == 0 && g < 2 && r >= TREAL) {
            bf16_t* sd = (bf16_t*)(P.ws + WS_SIDE) + (size_t)g * 4 * 64 * 512 + (size_t)(r - TREAL) * 512;
#pragma unroll
            for (int k = 0; k < 3; ++k) *((uint4*)(sd + (size_t)k * 64 * 512) + lane) = *((const uint4*)(slotp(P, 2 + k) + (size_t)r * 512) + lane);
            *((uint4*)(sd + (size_t)3 * 64 * 512) + lane) = yv; }
    }
    if (layer == 0 && g == 2) {
        for (int m2 = gw; m2 < 128; m2 += ngw) { const bf16_t* sd = (const bf16_t*)(P.ws + WS_SIDE) + (size_t)(m2 >> 6) * 4 * 64 * 512 + (size_t)(m2 & 63) * 512;
#pragma unroll
            for (int k = 0; k < 4; ++k) *((uint4*)(slotp(P, 2 + k) + (size_t)(TG + m2) * 512) + lane) = *((const uint4*)(sd + (size_t)k * 64 * 512) + lane); }
    }
}
DEV void hg_gate(float x, float lbv, float& lg, float& kk) {
    const float e = __expf(-fabsf(x)); const float sp = 1.f / (1.f + e);
    const float s = x >= 0.f ? sp : e * sp, s1 = x >= 0.f ? e * sp : sp;
    const float f = fmaxf(lbv, 1e-20f) + (1.f - lbv) * s;
    lg = __logf(f); kk = (1.f - lbv) * s1; }
DEV float hg_lb(const Params& P, int layer, int dir, int col) {
    if (layer == 0) return 0.f;
    const float a = P.in[I_LBL][(dir * 2 + 0) * 512 + col], b = P.in[I_LBL][(dir * 2 + 1) * 512 + col];
    return 1.f / (1.f + __expf(a - b)); }
DEV int hg_row(int sl, int c, int j, bool& valid) { if (c == 0) { valid = j < 16; return TREAL + sl * 16 + j; } valid = true; return sl * 4096 + (c - 1) * 64 + j; }
DEV void hg_cumsum(float* Lb, float* Bt, float* Seg, int dir, int tid) {
    const int ch = tid & 127, seg = tid >> 7;
    float v[16];
#pragma unroll
    for (int i = 0; i < 16; ++i) v[i] = Lb[(seg * 16 + i) * 128 + ch];
    if (dir == 0) {
#pragma unroll
        for (int i = 1; i < 16; ++i) v[i] += v[i - 1];
        Seg[seg * 128 + ch] = v[15];
    } else {
#pragma unroll
        for (int i = 14; i >= 0; --i) v[i] += v[i + 1];
        Seg[seg * 128 + ch] = v[0];
    }
    __syncthreads();
    const float s0 = Seg[ch], s1 = Seg[128 + ch], s2 = Seg[256 + ch], s3 = Seg[384 + ch];
    float off;
    if (dir == 0) off = seg == 0 ? 0.f : seg == 1 ? s0 : seg == 2 ? s0 + s1 : s0 + s1 + s2;
    else off = seg == 3 ? 0.f : seg == 2 ? s3 : seg == 1 ? s3 + s2 : s3 + s2 + s1;
#pragma unroll
    for (int i = 0; i < 16; ++i) Lb[(seg * 16 + i) * 128 + ch] = v[i] + off;
    if (seg == 0) Bt[ch] = (s0 + s1) + (s2 + s3);
}
DEV void phase_hg1(const Params& P0, int layer, unsigned char* lds, int bid, int nb, int wv) {
    Params P = load_params(); asm volatile("" : "+s"(P.ws));
    float* Lb = (float*)lds; bf16_t* KlT = (bf16_t*)(lds + 32768); bf16_t* VT = (bf16_t*)(lds + 32768 + 18432); float* Bt = (float*)(lds + 69632); float* Seg = (float*)(lds + 70656);
    float* X = (float*)slotp(P, 17); float* DC = (float*)(P.ws + WS_DECAY);
    const int tid = launder_tid(wv), lane = tid & 63, w = __builtin_amdgcn_readfirstlane(tid >> 6), j = tid >> 3, c0 = (tid & 7) * 16, l15 = lane & 15, quad = lane >> 4;
    for (int unit = bid; unit < 32 * 65; unit += nb) {
        const int chain = unit / 65, c = unit - chain * 65, sl = chain >> 3, head = (chain >> 1) & 3, dir = chain & 1;
        bool valid; const int r = hg_row(sl, c, j, valid);
        float lg[16], kk[16]; uint4 vv[2] = {make_uint4(0, 0, 0, 0), make_uint4(0, 0, 0, 0)};
        if (valid) {
            float fr[16];
            const uint4* fp = (const uint4*)(slotp(P, 3 + dir) + (size_t)r * 512 + head * 128 + c0);
            unpack8(fp[0], fr); unpack8(fp[1], fr + 8);
            const uint4* vp = (const uint4*)(slotp(P, 5) + (size_t)r * 512 + head * 128 + c0); vv[0] = vp[0]; vv[1] = vp[1];
#pragma unroll
            for (int e = 0; e < 16; ++e) hg_gate(fr[e], hg_lb(P, layer, dir, head * 128 + c0 + e), lg[e], kk[e]);
        } else {
#pragma unroll
            for (int e = 0; e < 16; ++e) { lg[e] = 0.f; kk[e] = 0.f; } }
#pragma unroll
        for (int e = 0; e < 16; e += 4) *(f32x4*)(Lb + j * 128 + c0 + e) = (f32x4){lg[e], lg[e + 1], lg[e + 2], lg[e + 3]};
        __syncthreads();
        hg_cumsum(Lb, Bt, Seg, dir, tid);
        __syncthreads();
        float vf[16]; unpack8(vv[0], vf); unpack8(vv[1], vf + 8);
#pragma unroll
        for (int e = 0; e < 16; ++e) { const float kl = kk[e] * __expf(Bt[c0 + e] - Lb[j * 128 + c0 + e]);
            KlT[(c0 + e) * 72 + j] = (bf16_t)(pk2(kl, 0.f) & 0xffffu); VT[(c0 + e) * 72 + j] = (bf16_t)(__float_as_uint(vf[e]) >> 16); }
        if (tid < 128) DC[(size_t)(chain * 65 + c) * 128 + tid] = __expf(Bt[tid]);
        __syncthreads();
        f32x4 acc[8];
#pragma unroll
        for (int ct = 0; ct < 8; ++ct) acc[ct] = (f32x4){0.f, 0.f, 0.f, 0.f};
#pragma unroll
        for (int ks = 0; ks < 2; ++ks) { const bf16x8 a = *(const bf16x8*)(VT + (w * 16 + l15) * 72 + ks * 32 + quad * 8);
#pragma unroll
            for (int ct = 0; ct < 8; ++ct) { const bf16x8 b = *(const bf16x8*)(KlT + (ct * 16 + l15) * 72 + ks * 32 + quad * 8); acc[ct] = mfma16(a, b, acc[ct]); } }
        float* xo = X + (size_t)(chain * 65 + c) * 16384;
#pragma unroll
        for (int ct = 0; ct < 8; ++ct)
#pragma unroll
            for (int jj = 0; jj < 4; ++jj) xo[(w * 16 + quad * 4 + jj) * 128 + ct * 16 + l15] = acc[ct][jj];
        __syncthreads();
    }
}
DEV void phase_hg2(const Params& P0, int bid, int nb, int wv) {
    Params P = load_params(); asm volatile("" : "+s"(P.ws));
    const int gtid = bid * 512 + launder_tid(wv), gth = nb * 512;
    f32x4* X = (f32x4*)slotp(P, 17); const f32x4* DC = (const f32x4*)(P.ws + WS_DECAY);
    for (int e = gtid; e < 32 * 4096; e += gth) {
        const int chain = e >> 12, e4 = e & 4095, dir = chain & 1;
        f32x4 S = (f32x4){0.f, 0.f, 0.f, 0.f};
#pragma unroll 5
        for (int step = 0; step < 65; ++step) { const int c = dir ? 64 - step : step;
            const size_t idx = (size_t)(chain * 65 + c) * 4096 + e4;
            const f32x4 kv = X[idx]; const f32x4 dc = DC[(size_t)(chain * 65 + c) * 32 + (e4 & 31)];
            X[idx] = S; S = dc * S + kv; }
    }
}
DEV void phase_hg3(const Params& P0, int layer, unsigned char* lds, int bid, int nb, int wv) {
    Params P = load_params(); asm volatile("" : "+s"(P.ws));
    float* Lb = (float*)lds; bf16_t* Qs = (bf16_t*)(lds + 32768); bf16_t* Ks = (bf16_t*)(lds + 50176); bf16_t* Am = (bf16_t*)(lds + 67584);
    bf16_t* VT = (bf16_t*)(lds + 76800); bf16_t* Sb = (bf16_t*)(lds + 95232); float* Bt = (float*)(lds + 130048); float* Seg = (float*)(lds + 132096); float* Ost = (float*)lds;
    const float* X = (const float*)slotp(P, 17);
    const int tid = launder_tid(wv), lane = tid & 63, w = __builtin_amdgcn_readfirstlane(tid >> 6), j = tid >> 3, c0 = (tid & 7) * 16, l15 = lane & 15, quad = lane >> 4;
    const int tt = w >> 1, st0 = (w & 1) * 2, vt0 = (w & 1) * 4;
    const int cfirst = layer == 0 ? 0 : 1;
    const int ncb = 65 - cfirst;
    for (int unit = bid; unit < 16 * ncb; unit += nb) {
        const int sh = unit / ncb, c = unit - sh * ncb + cfirst, sl = sh >> 2, head = sh & 3;
        bool valid; const int r = hg_row(sl, c, j, valid);
        float q[16]; uint4 gv[2] = {make_uint4(0, 0, 0, 0), make_uint4(0, 0, 0, 0)};
        if (valid) {
            const uint4* qp = (const uint4*)(slotp(P, 2) + (size_t)r * 512 + head * 128 + c0); unpack8(qp[0], q); unpack8(qp[1], q + 8);
            const uint4* vp = (const uint4*)(slotp(P, 5) + (size_t)r * 512 + head * 128 + c0); float vf[16]; unpack8(vp[0], vf); unpack8(vp[1], vf + 8);
#pragma unroll
            for (int e = 0; e < 16; ++e) VT[(c0 + e) * 72 + j] = (bf16_t)(__float_as_uint(vf[e]) >> 16);
            const uint4* gp = (const uint4*)(slotp(P, 6) + (size_t)r * 512 + head * 128 + c0); gv[0] = gp[0]; gv[1] = gp[1];
        } else {
#pragma unroll
            for (int e = 0; e < 16; ++e) { q[e] = 0.f; VT[(c0 + e) * 72 + j] = 0; } }
        f32x4 accA[2], accO[4];
#pragma unroll
        for (int i = 0; i < 2; ++i) accA[i] = (f32x4){0.f, 0.f, 0.f, 0.f};
#pragma unroll
        for (int i = 0; i < 4; ++i) accO[i] = (f32x4){0.f, 0.f, 0.f, 0.f};
#pragma unroll 1
        for (int dir = 0; dir < 2; ++dir) {
            float lg[16], kk[16];
            if (valid) { float fr[16];
                const uint4* fp = (const uint4*)(slotp(P, 3 + dir) + (size_t)r * 512 + head * 128 + c0); unpack8(fp[0], fr); unpack8(fp[1], fr + 8);
#pragma unroll
                for (int e = 0; e < 16; ++e) hg_gate(fr[e], hg_lb(P, layer, dir, head * 128 + c0 + e), lg[e], kk[e]);
            } else {
#pragma unroll
                for (int e = 0; e < 16; ++e) { lg[e] = 0.f; kk[e] = 0.f; } }
#pragma unroll
            for (int e = 0; e < 16; e += 4) *(f32x4*)(Lb + j * 128 + c0 + e) = (f32x4){lg[e], lg[e + 1], lg[e + 2], lg[e + 3]};
            __syncthreads();
            hg_cumsum(Lb, Bt, Seg, dir, tid);
            __syncthreads();
            {
                float qs[16], ks[16];
#pragma unroll
                for (int e = 0; e < 16; ++e) { const float b = Lb[j * 128 + c0 + e], rf = Lb[32 * 128 + c0 + e]; qs[e] = q[e] * __expf(b - rf); ks[e] = kk[e] * __expf(rf - b); }
                *(uint4*)(Qs + j * 136 + c0) = pack8(qs); *(uint4*)(Qs + j * 136 + c0 + 8) = pack8(qs + 8);
                *(uint4*)(Ks + j * 136 + c0) = pack8(ks); *(uint4*)(Ks + j * 136 + c0 + 8) = pack8(ks + 8);
            }
            {
                const int chain = sl * 8 + head * 2 + dir; const f32x4* xs = (const f32x4*)(X + (size_t)(chain * 65 + c) * 16384 + (size_t)(tid >> 2) * 128 + (tid & 3) * 32);
#pragma unroll
                for (int i = 0; i < 4; ++i) { const f32x4 a = xs[2 * i], b = xs[2 * i + 1]; uint4 o; o.x = pk2(a[0], a[1]); o.y = pk2(a[2], a[3]); o.z = pk2(b[0], b[1]); o.w = pk2(b[2], b[3]);
                    *(uint4*)(Sb + (tid >> 2) * 136 + (tid & 3) * 32 + i * 8) = o; }
            }
            __syncthreads();
            {
                f32x4 t0 = (f32x4){0.f, 0.f, 0.f, 0.f}, t1 = t0;
#pragma unroll
                for (int k4 = 0; k4 < 4; ++k4) { const bf16x8 a = *(const bf16x8*)(Qs + (tt * 16 + l15) * 136 + k4 * 32 + quad * 8);
                    const bf16x8 b0 = *(const bf16x8*)(Ks + ((st0 + 0) * 16 + l15) * 136 + k4 * 32 + quad * 8); const bf16x8 b1 = *(const bf16x8*)(Ks + ((st0 + 1) * 16 + l15) * 136 + k4 * 32 + quad * 8);
                    t0 = mfma16(a, b0, t0); t1 = mfma16(a, b1, t1); }
#pragma unroll
                for (int jj = 0; jj < 4; ++jj) { const int t = tt * 16 + quad * 4 + jj, s0 = (st0 + 0) * 16 + l15, s1 = (st0 + 1) * 16 + l15;
                    const bool k0 = dir == 0 ? s0 <= t : s0 >= t, k1 = dir == 0 ? s1 <= t : s1 >= t;
                    accA[0][jj] += k0 ? t0[jj] : 0.f; accA[1][jj] += k1 ? t1[jj] : 0.f; }
            }
            __syncthreads();
            {   float qg[16];
#pragma unroll
                for (int e = 0; e < 16; ++e) qg[e] = q[e] * __expf(Lb[j * 128 + c0 + e]);
                *(uint4*)(Qs + j * 136 + c0) = pack8(qg); *(uint4*)(Qs + j * 136 + c0 + 8) = pack8(qg + 8); }
            __syncthreads();
#pragma unroll
            for (int k4 = 0; k4 < 4; ++k4) { const bf16x8 a = *(const bf16x8*)(Qs + (tt * 16 + l15) * 136 + k4 * 32 + quad * 8);
#pragma unroll
                for (int v4 = 0; v4 < 4; ++v4) { const bf16x8 b = *(const bf16x8*)(Sb + ((vt0 + v4) * 16 + l15) * 136 + k4 * 32 + quad * 8); accO[v4] = mfma16(a, b, accO[v4]); } }
            __syncthreads();
        }
#pragma unroll
        for (int s2 = 0; s2 < 2; ++s2)
#pragma unroll
            for (int jj = 0; jj < 4; ++jj) Am[(tt * 16 + quad * 4 + jj) * 72 + (st0 + s2) * 16 + l15] = (bf16_t)(pk2(accA[s2][jj], 0.f) & 0xffffu);
        __syncthreads();
#pragma unroll
        for (int ks = 0; ks < 2; ++ks) { const bf16x8 a = *(const bf16x8*)(Am + (tt * 16 + l15) * 72 + ks * 32 + quad * 8);
#pragma unroll
            for (int v4 = 0; v4 < 4; ++v4) { const bf16x8 b = *(const bf16x8*)(VT + ((vt0 + v4) * 16 + l15) * 72 + ks * 32 + quad * 8); accO[v4] = mfma16(a, b, accO[v4]); } }
#pragma unroll
        for (int v4 = 0; v4 < 4; ++v4)
#pragma unroll
            for (int jj = 0; jj < 4; ++jj) Ost[(tt * 16 + quad * 4 + jj) * 132 + (vt0 + v4) * 16 + l15] = accO[v4][jj];
        __syncthreads();
        {   float o[16], ss = 0.f;
#pragma unroll
            for (int e = 0; e < 16; ++e) { o[e] = Ost[j * 132 + c0 + e]; ss += o[e] * o[e]; }
            ss = red8(ss);
            const float rs = rsqrtf(ss * (1.f / 128.f) + 1e-6f);
            float gf[16]; unpack8(gv[0], gf); unpack8(gv[1], gf + 8);
#pragma unroll
            for (int e = 0; e < 16; ++e) { const float gg = gf[e]; o[e] = o[e] * rs * P.in[I_ONORM][layer * 512 + head * 128 + c0 + e] * (gg / (1.f + __expf(-gg))); }
            if (valid) { uint4* yp = (uint4*)(slotp(P, 2) + (size_t)r * 512 + head * 128 + c0); yp[0] = pack8(o); yp[1] = pack8(o + 8); }
        }
        __syncthreads();
    }
}
DEV void phase_vtrans(const Params& P0, unsigned char* lds, int bid, int nb, int wv) {
    Params P = load_params(); asm volatile("" : "+s"(P.ws));
    bf16_t* T = (bf16_t*)lds;
    const bf16_t* V = slotp(P, 12); bf16_t* VTg = slotp(P, 6);
    const int tid = launder_tid(wv);
    for (int unit = bid; unit < 4 * 65 * 8; unit += nb) {
        const int sl = unit / 520, rem = unit - sl * 520, pt = rem >> 3, vdt = rem & 7;
        { const int tok = tid >> 3, c8 = (tid & 7) * 8, p = pt * 64 + tok;
          uint4 v = make_uint4(0, 0, 0, 0);
          if (p < LSEQ) v = *(const uint4*)(V + (size_t)row_of(sl, p) * 512 + vdt * 64 + c8);
          *(uint4*)(T + tok * 72 + c8) = v; }
        __syncthreads();
        { const int vd = tid >> 3, t8 = (tid & 7) * 8;
          unsigned short e[8];
#pragma unroll
          for (int i = 0; i < 8; ++i) { const int pp = t8 + i; const int sp = (pp & ~12) | (((pp >> 2) & 1) << 3) | (((pp >> 3) & 1) << 2); e[i] = T[sp * 72 + vd]; }
          uint4 o; o.x = e[0] | ((unsigned)e[1] << 16); o.y = e[2] | ((unsigned)e[3] << 16); o.z = e[4] | ((unsigned)e[5] << 16); o.w = e[6] | ((unsigned)e[7] << 16);
          *(uint4*)(VTg + (size_t)(sl * 512 + vdt * 64 + vd) * 4160 + pt * 64 + t8) = o; }
        __syncthreads();
    }
}
DEV int crow(int r, int hi) { return (r & 3) + 8 * (r >> 2) + 4 * hi; }
typedef unsigned u32x4_t __attribute__((ext_vector_type(4)));
struct AttnStage { u32x4_t k0, k1, v0, v1; };
DEV void attn_stage_load(const Params& P, int sl, int head, int kt, int tid, AttnStage& st) {
    const bf16_t* Kg = slotp(P, 11); const bf16_t* VTg = slotp(P, 6);
    { const int ci = tid, krow = ci >> 4, kc = ci & 15; const int p = kt * 64 + krow; const int r = p < LSEQ ? row_of(sl, p) : 0; st.k0 = *(const u32x4_t*)(Kg + (size_t)r * 512 + head * 128 + kc * 8); }
    { const int ci = tid + 512, krow = ci >> 4, kc = ci & 15; const int p = kt * 64 + krow; const int r = p < LSEQ ? row_of(sl, p) : 0; st.k1 = *(const u32x4_t*)(Kg + (size_t)r * 512 + head * 128 + kc * 8); }
    { const int vi = tid, vrow = vi >> 3, vc = vi & 7; st.v0 = *(const u32x4_t*)(VTg + (size_t)(sl * 512 + head * 128 + vrow) * 4160 + kt * 64 + vc * 8); }
    { const int vi = tid + 512, vrow = vi >> 3, vc = vi & 7; st.v1 = *(const u32x4_t*)(VTg + (size_t)(sl * 512 + head * 128 + vrow) * 4160 + kt * 64 + vc * 8); }
}
DEV void attn_stage_store(unsigned char* buf, int tid, const AttnStage& st) {
    bf16_t* Kt = (bf16_t*)buf; bf16_t* Vt = (bf16_t*)(buf + 17408);
    { const int ci = tid, krow = ci >> 4, kc = ci & 15; *(u32x4_t*)(Kt + krow * 136 + kc * 8) = st.k0; }
    { const int ci = tid + 512, krow = ci >> 4, kc = ci & 15; *(u32x4_t*)(Kt + krow * 136 + kc * 8) = st.k1; }
    { const int vi = tid, vrow = vi >> 3, vc = vi & 7; *(u32x4_t*)(Vt + vrow * 72 + vc * 8) = st.v0; }
    { const int vi = tid + 512, vrow = vi >> 3, vc = vi & 7; *(u32x4_t*)(Vt + vrow * 72 + vc * 8) = st.v1; }
}
DEV void phase_attn(const Params& P0, int layer, unsigned char* lds, int bid, int nb, int wv) {
    Params P = load_params(); asm volatile("" : "+s"(P.ws));
    const int tid = launder_tid(wv), lane = tid & 63, w = __builtin_amdgcn_readfirstlane(tid >> 6), map = w >> 2, qsub = w & 3, qi = lane & 31, hi = lane >> 5;
    const float lam_init = layer == 0 ? 0.2f : 0.35550906759096934f;
    float lam;
    { const float* lp = P.in[I_LAM] + (size_t)layer * 256; float s1 = 0.f, s2 = 0.f;
      for (int i = 0; i < 64; ++i) { s1 += lp[i] * lp[64 + i]; s2 += lp[128 + i] * lp[192 + i]; }
      lam = __expf(s1) - __expf(s2) + lam_init; }
    const int nqb = layer == 0 ? 33 : 32;
    float* Ex = (float*)lds;
    const bool xmap = (nb & 7) == 0;
    const int ustart = xmap ? (bid >> 3) : bid, ustep = xmap ? (nb >> 3) : nb, uend = xmap ? 2 * nqb : 16 * nqb;
    for (int unit = ustart; unit < uend; unit += ustep) {
        const int sh = xmap ? 2 * (bid & 7) + unit / nqb : unit / nqb, qb = unit % nqb, sl = sh >> 2, head = sh & 3;
        const int qrow0 = qb < 32 ? sl * 4096 + qb * 128 : TREAL + sl * 16; const int nvalid = qb < 32 ? 128 : 16;
        bf16x8 Qf[4];
        { const bf16_t* qp = slotp(P, 10) + (size_t)(qrow0 + qsub * 32 + qi) * 512 + head * 128 + map * 64 + hi * 8;
#pragma unroll
          for (int ds = 0; ds < 4; ++ds) Qf[ds] = *(const bf16x8*)(qp + ds * 16); }
        AttnStage st;
        attn_stage_load(P, sl, head, 0, tid, st); attn_stage_store(lds, tid, st);
        __syncthreads();
        f32x16 O[4];
#pragma unroll
        for (int v = 0; v < 4; ++v)
#pragma unroll
            for (int r = 0; r < 16; ++r) O[v][r] = 0.f;
        float m_run = -INFINITY, l_run = 0.f;
#pragma unroll 1
        for (int kt = 0; kt < 65; ++kt) {
            if (kt + 1 < 65) attn_stage_load(P, sl, head, kt + 1, tid, st);
            const unsigned char* buf = lds + (kt & 1) * 35840;
            const bf16_t* Kb = (const bf16_t*)buf; const bf16_t* Vb = (const bf16_t*)(buf + 17408);
            f32x16 S0, S1;
#pragma unroll
            for (int r = 0; r < 16; ++r) { S0[r] = 0.f; S1[r] = 0.f; }
#pragma unroll
            for (int ds = 0; ds < 4; ++ds) {
                const bf16x8 a0 = *(const bf16x8*)(Kb + qi * 136 + map * 64 + ds * 16 + hi * 8);
                const bf16x8 a1 = *(const bf16x8*)(Kb + (32 + qi) * 136 + map * 64 + ds * 16 + hi * 8);
                S0 = mfma32(a0, Qf[ds], S0); S1 = mfma32(a1, Qf[ds], S1); }
            if (kt == 64) {
#pragma unroll
                for (int r = 0; r < 16; ++r) { if (crow(r, hi) >= 16) S0[r] = -INFINITY; S1[r] = -INFINITY; } }
            float mx = -INFINITY;
#pragma unroll
            for (int r = 0; r < 16; ++r) mx = fmaxf(mx, fmaxf(S0[r], S1[r]));
            mx = fmaxf(mx, __shfl_xor(mx, 32));
            const float m_new = fmaxf(m_run, mx); const float alpha = __builtin_amdgcn_exp2f(m_run - m_new); m_run = m_new;
            float ps = 0.f;
#pragma unroll
            for (int r = 0; r < 16; ++r) { S0[r] = __builtin_amdgcn_exp2f(S0[r] - m_new); S1[r] = __builtin_amdgcn_exp2f(S1[r] - m_new); ps += S0[r] + S1[r]; }
            l_run = l_run * alpha + ps;
            if (__builtin_amdgcn_ballot_w64(alpha != 1.0f) != 0ull) {
#pragma unroll
                for (int v = 0; v < 4; ++v)
#pragma unroll
                    for (int r = 0; r < 16; ++r) O[v][r] *= alpha; }
            bf16x8 pf[2][2];
#pragma unroll
            for (int half = 0; half < 2; ++half) {
                uint4 a, b;
                a.x = pk2(S0[half * 8 + 0], S0[half * 8 + 1]); a.y = pk2(S0[half * 8 + 2], S0[half * 8 + 3]); a.z = pk2(S0[half * 8 + 4], S0[half * 8 + 5]); a.w = pk2(S0[half * 8 + 6], S0[half * 8 + 7]);
                b.x = pk2(S1[half * 8 + 0], S1[half * 8 + 1]); b.y = pk2(S1[half * 8 + 2], S1[half * 8 + 3]); b.z = pk2(S1[half * 8 + 4], S1[half * 8 + 5]); b.w = pk2(S1[half * 8 + 6], S1[half * 8 + 7]);
                pf[0][half] = __builtin_bit_cast(bf16x8, a); pf[1][half] = __builtin_bit_cast(bf16x8, b); }
#pragma unroll
            for (int v = 0; v < 4; ++v)
#pragma unroll
                for (int sub = 0; sub < 2; ++sub)
#pragma unroll
                    for (int half = 0; half < 2; ++half) {
                        const bf16x8 av = *(const bf16x8*)(Vb + (v * 32 + qi) * 72 + sub * 32 + half * 16 + hi * 8);
                        O[v] = mfma32(av, pf[sub][half], O[v]); }
            if (kt + 1 < 65) attn_stage_store(lds + ((kt + 1) & 1) * 35840, tid, st);
            __syncthreads();
        }
        const float l_tot = l_run + __shfl_xor(l_run, 32); const float inv = 1.0f / l_tot;
        if (map == 1) {
#pragma unroll
            for (int v = 0; v < 4; ++v)
#pragma unroll
                for (int r = 0; r < 16; ++r) Ex[(qsub * 32 + qi) * 132 + v * 32 + crow(r, hi)] = O[v][r] * inv; }
        __syncthreads();
        if (map == 0) {
            float ss = 0.f;
#pragma unroll
            for (int v = 0; v < 4; ++v)
#pragma unroll
                for (int r = 0; r < 16; ++r) { const float o = O[v][r] * inv - lam * Ex[(qsub * 32 + qi) * 132 + v * 32 + crow(r, hi)]; O[v][r] = o; ss += o * o; }
            ss += __shfl_xor(ss, 32);
            const float rs = rsqrtf(ss * (1.f / 128.f) + 1e-5f) * (1.f - lam_init);
            if (qsub * 32 + qi < nvalid) {
                bf16_t* yp = slotp(P, 4) + (size_t)(qrow0 + qsub * 32 + qi) * 512 + head * 128;
#pragma unroll
                for (int v = 0; v < 4; ++v)
#pragma unroll
                    for (int rg = 0; rg < 4; ++rg) { const int vd0 = v * 32 + 8 * rg + 4 * hi; const f32x4 gg = *(const f32x4*)(P.in[I_SUBLN] + layer * 128 + vd0);
                        uint2 o; o.x = pk2(O[v][rg * 4 + 0] * rs * gg[0], O[v][rg * 4 + 1] * rs * gg[1]); o.y = pk2(O[v][rg * 4 + 2] * rs * gg[2], O[v][rg * 4 + 3] * rs * gg[3]);
                        *(uint2*)(yp + vd0) = o; } }
        }
        __syncthreads();
    }
}
DEV float dpp_f(float x, const int ctrl) { return x; }
template <int CTRL> DEV float dppmov(float x) { return __builtin_bit_cast(float, __builtin_amdgcn_update_dpp(0, __builtin_bit_cast(int, x), CTRL, 0xf, 0xf, true)); }
DEV float sum16(float x) { x += dppmov<0xB1>(x); x += dppmov<0x4E>(x); x += dppmov<0x141>(x); x += dppmov<0x140>(x); return x; }
constexpr int RW_CH = 16, RW_BUF_F = 5120 + 256 + 4096, RW_BUFB = RW_BUF_F * 4;
struct RwRegs { u32x4_t r, k, kk, e, a, v; };
DEV void unpack8v(const u32x4_t w, float* f) { unpack8(make_uint4(w.x, w.y, w.z, w.w), f); }
DEV void rw_stage_load(const Params& P, RwRegs& g, int sl, int head, int dir, int qr, int ck, int t) {
    if (t < 128) { const int step = t >> 3, ch8 = (t & 7) * 8, sidx = ck * RW_CH + step;
        if (sidx < LSEQ) { const int p = dir ? LSEQ - 1 - sidx : sidx; const size_t ro = (size_t)row_of(sl, p) * 512 + head * 64 + ch8;
            g.r = *(const u32x4_t*)(slotp(P, 17) + ro); g.k = *(const u32x4_t*)(slotp(P, 18) + ro); g.kk = *(const u32x4_t*)(slotp(P, 20) + ro);
            g.e = *(const u32x4_t*)(slotp(P, 22 + dir) + ro); g.a = *(const u32x4_t*)(slotp(P, dir == 0 ? 24 : 13) + ro); } }
    if (t < 32) { const int tt = t, s2 = tt >> 1, r8 = (tt & 1) * 8, si2 = ck * RW_CH + s2;
        if (si2 < LSEQ) { const int p2 = dir ? LSEQ - 1 - si2 : si2; g.v = *(const u32x4_t*)(slotp(P, 19) + (size_t)row_of(sl, p2) * 512 + head * 64 + qr * 16 + r8); } }
}
DEV void rw_stage_write(const Params& P, int layer, unsigned char* buf, const RwRegs& g, int head, int ck, int t) {
    float* Rr = (float*)buf; float* Ww = Rr + 1024; float* Kd = Ww + 1024; float* Kk = Kd + 1024; float* Bb = Kk + 1024; float* Vs = Bb + 1024;
    if (t < 128) { const int step = t >> 3, ch8 = (t & 7) * 8, sidx = ck * RW_CH + step;
        if (sidx < LSEQ) {
            float r[8], k[8], kk[8], e[8], a[8];
            unpack8v(g.r, r); unpack8v(g.k, k); unpack8v(g.kk, kk); unpack8v(g.e, e); unpack8v(g.a, a);
            float ww[8], kd[8], bb[8];
#pragma unroll
            for (int j = 0; j < 8; ++j) { ww[j] = __expf(-e[j]); kd[j] = k[j] * (1.f + (a[j] - 1.f) * P.in[I_KA][layer * 512 + head * 64 + ch8 + j]); bb[j] = kk[j] * a[j]; }
            const int o = step * 64 + ch8;
            *(f32x4*)(Rr + o) = (f32x4){r[0], r[1], r[2], r[3]}; *(f32x4*)(Rr + o + 4) = (f32x4){r[4], r[5], r[6], r[7]};
            *(f32x4*)(Ww + o) = (f32x4){ww[0], ww[1], ww[2], ww[3]}; *(f32x4*)(Ww + o + 4) = (f32x4){ww[4], ww[5], ww[6], ww[7]};
            *(f32x4*)(Kd + o) = (f32x4){kd[0], kd[1], kd[2], kd[3]}; *(f32x4*)(Kd + o + 4) = (f32x4){kd[4], kd[5], kd[6], kd[7]};
            *(f32x4*)(Kk + o) = (f32x4){kk[0], kk[1], kk[2], kk[3]}; *(f32x4*)(Kk + o + 4) = (f32x4){kk[4], kk[5], kk[6], kk[7]};
            *(f32x4*)(Bb + o) = (f32x4){bb[0], bb[1], bb[2], bb[3]}; *(f32x4*)(Bb + o + 4) = (f32x4){bb[4], bb[5], bb[6], bb[7]};
        } }
    if (t < 32) { const int tt = t, s2 = tt >> 1, r8 = (tt & 1) * 8, si2 = ck * RW_CH + s2;
        if (si2 < LSEQ) { float v[8]; unpack8v(g.v, v);
            *(f32x4*)(Vs + s2 * 16 + r8) = (f32x4){v[0], v[1], v[2], v[3]}; *(f32x4*)(Vs + s2 * 16 + r8 + 4) = (f32x4){v[4], v[5], v[6], v[7]}; } }
}
DEV void rw_flush(const Params& P, const unsigned char* buf, int sl, int head, int dir, int qr, int ck, int t) {
    if (t >= 160 && t < 192) { const float* Op = (const float*)buf + 5376; const int tt = t - 160, s2 = tt >> 1, r8 = (tt & 1) * 8, sidx = ck * RW_CH + s2;
        if (sidx < LSEQ) { const int p = dir ? LSEQ - 1 - sidx : sidx; float o[8];
#pragma unroll
            for (int j = 0; j < 8; ++j) { const int row = r8 + j; const f32x4* q = (const f32x4*)(Op + s2 * 256 + (row >> 2) * 64 + (row & 3) * 16);
                const f32x4 a = q[0], b = q[1], c = q[2], d = q[3];
                o[j] = ((a[0] + a[1]) + (a[2] + a[3])) + ((b[0] + b[1]) + (b[2] + b[3])) + (((c[0] + c[1]) + (c[2] + c[3])) + ((d[0] + d[1]) + (d[2] + d[3]))); }
            *(uint4*)(slotp(P, 15 + dir) + (size_t)row_of(sl, p) * 512 + head * 64 + qr * 16 + r8) = pack8(o); } }
}
DEV void phase_rw_scan(const Params& P0, int layer, unsigned char* lds, int bid, int nb, int wv) {
    Params P = load_params(); asm volatile("" : "+s"(P.ws));
    const int tid = launder_tid(wv), lane = tid & 63, w = __builtin_amdgcn_readfirstlane(tid >> 6), li = lane & 15, rl = (w & 3) * 4 + (lane >> 4);
    constexpr int NCK = (LSEQ + RW_CH - 1) / RW_CH;
    typedef float f32x2 __attribute__((ext_vector_type(2)));
    for (int unit = bid; unit < 256; unit += nb) {
        const int sl = unit >> 6, head = (unit >> 3) & 7, dir = (unit >> 2) & 1, qr = unit & 3;
        f32x2 SA = (f32x2){0.f, 0.f}, SB = (f32x2){0.f, 0.f};
        RwRegs g; g.r = g.k = g.kk = g.e = g.a = g.v = (u32x4_t){0u, 0u, 0u, 0u};
        if (w >= 4) { rw_stage_load(P, g, sl, head, dir, qr, 0, tid - 256); rw_stage_write(P, layer, lds, g, head, 0, tid - 256); rw_stage_load(P, g, sl, head, dir, qr, 1, tid - 256); }
        __syncthreads();
#pragma unroll 1
        for (int ck = 0; ck < NCK; ++ck) {
            unsigned char* buf = lds + (ck & 1) * RW_BUFB;
            if (w >= 4) {
                if (ck + 1 < NCK) rw_stage_write(P, layer, lds + ((ck + 1) & 1) * RW_BUFB, g, head, ck + 1, tid - 256);
                if (ck + 2 < NCK) rw_stage_load(P, g, sl, head, dir, qr, ck + 2, tid - 256);
                if (ck > 0) rw_flush(P, lds + ((ck - 1) & 1) * RW_BUFB, sl, head, dir, qr, ck - 1, tid - 256);
            } else {
                const float* Rr = (const float*)buf + li * 4; const float* Vs = (const float*)buf + 5120 + rl; float* Op = (float*)buf + 5376 + w * 64 + lane;
                const int ns = (LSEQ - ck * RW_CH) < RW_CH ? (LSEQ - ck * RW_CH) : RW_CH;
                f32x4 rr = *(const f32x4*)(Rr), ww = *(const f32x4*)(Rr + 1024), kd = *(const f32x4*)(Rr + 2048), kk = *(const f32x4*)(Rr + 3072), bb = *(const f32x4*)(Rr + 4096); float vv = Vs[0];
#pragma unroll 4
                for (int i = 0; i < ns; ++i) {
                    const int in = i < RW_CH - 1 ? i + 1 : RW_CH - 1;
                    const f32x4 rr_n = *(const f32x4*)(Rr + in * 64), ww_n = *(const f32x4*)(Rr + 1024 + in * 64), kd_n = *(const f32x4*)(Rr + 2048 + in * 64);
                    const f32x4 kk_n = *(const f32x4*)(Rr + 3072 + in * 64), bb_n = *(const f32x4*)(Rr + 4096 + in * 64); const float vv_n = Vs[in * 16];
                    f32x2 p = SA * (f32x2){kk[0], kk[1]}; p = __builtin_elementwise_fma(SB, (f32x2){kk[2], kk[3]}, p);
                    const f32x2 vv2 = (f32x2){vv, vv};
                    const f32x2 ta = vv2 * (f32x2){kd[0], kd[1]}, tb = vv2 * (f32x2){kd[2], kd[3]};
                    const float sa = -sum16(p[0] + p[1]);
                    const f32x2 sa2 = (f32x2){sa, sa};
                    SA = __builtin_elementwise_fma(SA, (f32x2){ww[0], ww[1]}, __builtin_elementwise_fma(sa2, (f32x2){bb[0], bb[1]}, ta));
                    SB = __builtin_elementwise_fma(SB, (f32x2){ww[2], ww[3]}, __builtin_elementwise_fma(sa2, (f32x2){bb[2], bb[3]}, tb));
                    f32x2 q = SA * (f32x2){rr[0], rr[1]}; q = __builtin_elementwise_fma(SB, (f32x2){rr[2], rr[3]}, q);
                    Op[i * 256] = q[0] + q[1];
                    rr = rr_n; ww = ww_n; kd = kd_n; kk = kk_n; bb = bb_n; vv = vv_n;
                }
            }
            __syncthreads();
        }
        if (w >= 4) rw_flush(P, lds + ((NCK - 1) & 1) * RW_BUFB, sl, head, dir, qr, NCK - 1, tid - 256);
        __syncthreads();
    }
}
#define LAS __attribute__((address_space(3)))
#define XB_TMO      128
#define XB_XCNT(j)  (256  + 64 * (j))
#define XB_XSUB(j)  (1280 + 64 * (j))
#define XB_XGEN(j)  (2304 + 64 * (j))
#define XB_TOP      3328
#define XB_TOPGEN   3392
#define XCD_BAR_WORDS 3456
#define XB_SPIN_CAP (1u << 18)

__device__ __forceinline__ unsigned xb_ld(unsigned* p)              { return __hip_atomic_load(p, __ATOMIC_RELAXED, __HIP_MEMORY_SCOPE_AGENT); }
__device__ __forceinline__ unsigned xb_add(unsigned* p, unsigned v) { return __hip_atomic_fetch_add(p, v, __ATOMIC_RELAXED, __HIP_MEMORY_SCOPE_AGENT); }
__device__ __forceinline__ unsigned xb_xcc_id() { return (unsigned)__builtin_amdgcn_s_getreg((3 << 11) | 20) & 0xFu; }
#define XB_SPIN(cond, bar) do { unsigned _sp = 0; while (cond) { __builtin_amdgcn_s_sleep(1); \
    if ((++_sp & 255u) == 0u) { if (xb_ld(&(bar)[XB_TMO])) break; if (_sp > XB_SPIN_CAP) { atomicAdd(&(bar)[XB_TMO], 1u); break; } } } } while (0)

struct XcdBarrier {
    unsigned* bar; unsigned x;
    volatile LAS unsigned* st;
};

__device__ __forceinline__ XcdBarrier xcd_barrier_post(unsigned* bar, volatile LAS unsigned* st, int wv) {
    XcdBarrier b; b.bar = bar; b.x = xb_xcc_id(); b.st = st;
    if (launder_tid(wv) == 0) (void)xb_add(&bar[XB_XCNT(b.x)], 1u);
    return b;
}
__device__ __forceinline__ void xcd_barrier_complete(unsigned* bar, unsigned x, unsigned& nloc, unsigned& nx) {
    const unsigned G = gridDim.x * gridDim.y * gridDim.z;
    unsigned sum, cnt, mine, sp = 0u;
    for (;;) {
        sum = 0u; cnt = 0u; mine = 0u;
#pragma unroll
        for (unsigned j = 0; j < 16; ++j) { const unsigned c = xb_ld(&bar[XB_XCNT(j)]); sum += c; cnt += (c > 0u) ? 1u : 0u; mine = (j == x) ? c : mine; }
        if (sum == G) break;
        __builtin_amdgcn_s_sleep(1);
        if ((++sp & 255u) == 0u) { if (xb_ld(&bar[XB_TMO])) break; if (sp > XB_SPIN_CAP) { atomicAdd(&bar[XB_TMO], 1u); break; } }
    }
    nloc = mine > 0u ? mine : 1u; nx = cnt > 0u ? cnt : 1u;
}

__device__ __forceinline__ void xcd_barrier(const XcdBarrier& b, int wv) {
    asm volatile("s_waitcnt vmcnt(0)" ::: "memory");
    __syncthreads();
    if (launder_tid(wv) == 0) {
        unsigned* bar = b.bar;
        __builtin_amdgcn_s_waitcnt(0);
        unsigned nloc = b.st[0], nx = b.st[1];
        if (nloc == 0u) { xcd_barrier_complete(bar, b.x, nloc, nx); b.st[0] = nloc; b.st[1] = nx; }
        const unsigned old = xb_add(&bar[XB_XSUB(b.x)], 1u);
        const unsigned gen = old / nloc;
        if (old + 1u == (gen + 1u) * nloc) {
            __builtin_amdgcn_fence(__ATOMIC_RELEASE, "agent");
            asm volatile("s_waitcnt vmcnt(0)" ::: "memory");
            const unsigned og = xb_add(&bar[XB_TOP], 1u);
            const unsigned tg = og / nx;
            if (og + 1u == (tg + 1u) * nx) xb_add(&bar[XB_TOPGEN], 1u);
            else XB_SPIN(xb_ld(&bar[XB_TOPGEN]) == tg, bar);
            __builtin_amdgcn_fence(__ATOMIC_ACQUIRE, "agent");
            xb_add(&bar[XB_XGEN(b.x)], 1u);
            asm volatile("s_waitcnt vmcnt(0)" ::: "memory");
        } else {
            XB_SPIN(xb_ld(&bar[XB_XGEN(b.x)]) == gen, bar);
            __builtin_amdgcn_fence(__ATOMIC_ACQUIRE, "agent");
            asm volatile("s_waitcnt vmcnt(0)" ::: "memory");
        }
    }
    __syncthreads();
}

__global__ void __launch_bounds__(512) mega_fwd(Params P) {
    extern __shared__ __attribute__((aligned(16))) unsigned char lds[];
    cg::grid_group grid = cg::this_grid();
    const int bid = blockIdx.x, nb = gridDim.x; const int wv = __builtin_amdgcn_readfirstlane(threadIdx.x >> 6);
    volatile LAS unsigned* MISC = (volatile LAS unsigned*)((LAS unsigned char*)lds + 131072 + 256);
    if (threadIdx.x < 4) MISC[threadIdx.x] = 0u;
    __syncthreads();
    XcdBarrier xbar;
    { Params Pb = load_params(); xbar = xcd_barrier_post((unsigned*)Pb.ws, MISC, wv); }
#define GSYNC() xcd_barrier(xbar, wv)
    PG8_LAS unsigned char* ldsl = (PG8_LAS unsigned char*)lds;
#pragma unroll 1
    for (int layer_ = 0; layer_ < 2; ++layer_) {
        phase_weights(P, lsd(layer_), lds, bid, nb, wv);
        grid.sync();
#pragma unroll 1
        for (int g_ = 0; g_ < NGRP; ++g_) {
            #define Mpost ((lsd(layer_) == 0 && lsd(g_) == 2) ? TGP : TREAL)
#define NVALID ((lsd(layer_) == 0 && lsd(g_) == 2) ? TG + 128 : TG)
            phase_rmsnorm(P, lsd(g_), lsd(layer_) == 0, I_NMIX, lsd(layer_), TGP, NVALID, bid, nb, wv);
            if (PROBE == 5) { phase_rmsnorm(P, lsd(g_), lsd(layer_) == 0, I_NMIX, lsd(layer_), TGP, NVALID, bid, nb, wv); }
            GSYNC();
            if (PROBE == 6) { for (int q_ = 0; q_ < 15; ++q_) GSYNC(); }
            for (int rep_ = 0; rep_ < (PROBE == 3 ? 2 : 1); ++rep_)
            { Params Pl = load_params(); asm volatile("" : "+s"(Pl.ws)); pg8::bf16_t* W = (pg8::bf16_t*)(Pl.ws + WS_W); pg8::Gemm gm{slotp(Pl, 0), W + WO_IN, TGP, 7680, 1024, 0, 0}; pg8::StaticOrder S; S.init(TGP, 7680, nb, bid);
              pg8::EpiBf<0> E{slotp(Pl, 2), 512, SLOT_E};
              pg8::gemm_phase<pg8::EpiBf<0>, pg8::StaticOrder, true, true>(ldsl, gm, S, E, wv); }
            GSYNC();
            phase_da_prep(P, lsd(layer_), bid, nb, wv);
            phase_hg1(P, lsd(layer_), lds, bid, nb, wv);
            if (PROBE == 4) { phase_hg1(P, lsd(layer_), lds, bid, nb, wv); }
            GSYNC();
            phase_hg2(P, bid, nb, wv);
            GSYNC();
            phase_hg3(P, lsd(layer_), lds, bid, nb, wv);
            GSYNC();
            phase_conv(P, lsd(layer_), bid, nb, wv);
            if (PROBE == 5) { phase_conv(P, lsd(layer_), bid, nb, wv); }
            phase_vtrans(P, lds, bid, nb, wv);
            if (PROBE == 5) { phase_vtrans(P, lds, bid, nb, wv); }
            phase_rw_prep(P, lsd(layer_), bid, nb, wv);
            if (PROBE == 5) { phase_rw_prep(P, lsd(layer_), bid, nb, wv); }
            GSYNC();
            { Params Pl = load_params(); asm volatile("" : "+s"(Pl.ws)); pg8::bf16_t* W = (pg8::bf16_t*)(Pl.ws + WS_W); pg8::Gemm gm{slotp(Pl, 21), W + WO_LR, TGP, 2560, 384, 0, 0}; pg8::StaticOrder S; S.init(TGP, 2560, nb, bid);
              pg8::EpiLR E{slotp(Pl, 22), slotp(Pl, 23), slotp(Pl, 24), slotp(Pl, 13), slotp(Pl, 14), Pl.in[I_W0] + lsd(layer_) * 1024, Pl.in[I_A0] + lsd(layer_) * 1024};
              pg8::gemm_phase<pg8::EpiLR, pg8::StaticOrder, true, true>(ldsl, gm, S, E, wv); }
            phase_attn(P, lsd(layer_), lds, bid, nb, wv);
            if (PROBE == 2) { phase_attn(P, lsd(layer_), lds, bid, nb, wv); }
            GSYNC();
            phase_rw_scan(P, lsd(layer_), lds, bid, nb, wv);
            if (PROBE == 1) { phase_rw_scan(P, lsd(layer_), lds, bid, nb, wv); }
            GSYNC();
            phase_rw_post(P, lsd(layer_), lsd(g_), lsd(layer_) == 0 ? TG : TREAL, bid, nb, wv);
            if (PROBE == 5) { phase_rw_post(P, lsd(layer_), lsd(g_), lsd(layer_) == 0 ? TG : TREAL, bid, nb, wv); }
            GSYNC();
            { Params Pl = load_params(); asm volatile("" : "+s"(Pl.ws)); pg8::bf16_t* W = (pg8::bf16_t*)(Pl.ws + WS_W); pg8::Gemm gm{slotp(Pl, 2), W + WO_BP, Mpost, 4096, 512, 4, SLOT_B}; pg8::StaticOrder S; S.init(Mpost, 4096, nb, bid);
              pg8::EpiBf<0> E{slotp(Pl, 6), 4096, 0};
              pg8::gemm_phase<pg8::EpiBf<0>, pg8::StaticOrder, true, true>(ldsl, gm, S, E, wv); }
            GSYNC();
            { Params Pl = load_params(); asm volatile("" : "+s"(Pl.ws)); pg8::bf16_t* W = (pg8::bf16_t*)(Pl.ws + WS_W); pg8::Gemm gm{slotp(Pl, 0), W + WO_G, Mpost, 4096, 1024, 0, 0}; pg8::StaticOrder S; S.init(Mpost, 4096, nb, bid);
              pg8::EpiGate E{slotp(Pl, 6), slotp(Pl, 14)};
              pg8::gemm_phase<pg8::EpiGate, pg8::StaticOrder, true, true>(ldsl, gm, S, E, wv); }
            GSYNC();
            { Params Pl = load_params(); asm volatile("" : "+s"(Pl.ws)); pg8::bf16_t* W = (pg8::bf16_t*)(Pl.ws + WS_W); pg8::Gemm gm{slotp(Pl, 14), W + WO_OUT, Mpost, 1024, 1024, 0, 0}; pg8::StaticOrder S; S.init(Mpost, 1024, nb, bid);
              pg8::EpiResid E{lsd(layer_) == 0 ? x_in_row(Pl, lsd(g_), 0) : (const float*)x_cur_row(Pl, lsd(g_), 0), lsd(layer_) == 0 ? Pl.in[I_META] : (const float*)nullptr, x_cur_row(Pl, lsd(g_), 0), (float*)(Pl.ws + WS_XMETA), lsd(g_), NVALID};
              pg8::gemm_phase<pg8::EpiResid, pg8::StaticOrder, true, true>(ldsl, gm, S, E, wv); }
            GSYNC();
            phase_rmsnorm(P, lsd(g_), false, I_NMLP, lsd(layer_), Mpost, NVALID, bid, nb, wv);
            if (PROBE == 5) { phase_rmsnorm(P, lsd(g_), false, I_NMLP, lsd(layer_), Mpost, NVALID, bid, nb, wv); }
            GSYNC();
            for (int rep_ = 0; rep_ < (PROBE == 7 ? 2 : 1); ++rep_)
            { Params Pl = load_params(); asm volatile("" : "+s"(Pl.ws)); pg8::bf16_t* W = (pg8::bf16_t*)(Pl.ws + WS_W); pg8::Gemm gm{slotp(Pl, 0), W + WO_1, Mpost, 4096, 1024, 0, 0}; pg8::StaticOrder S; S.init(Mpost, 4096, nb, bid);
              pg8::EpiBf<1> E{slotp(Pl, 6), 4096, 0};
              pg8::gemm_phase<pg8::EpiBf<1>, pg8::StaticOrder, true, true>(ldsl, gm, S, E, wv); }
            GSYNC();
            { Params Pl = load_params(); asm volatile("" : "+s"(Pl.ws)); pg8::bf16_t* W = (pg8::bf16_t*)(Pl.ws + WS_W); pg8::Gemm gm{slotp(Pl, 6), W + WO_2, Mpost, 1024, 4096, 0, 0}; pg8::StaticOrder S; S.init(Mpost, 1024, nb, bid);
              pg8::EpiResid E{(const float*)x_cur_row(Pl, lsd(g_), 0), (const float*)nullptr, x_cur_row(Pl, lsd(g_), 0), (float*)(Pl.ws + WS_XMETA), lsd(g_), NVALID};
              pg8::gemm_phase<pg8::EpiResid, pg8::StaticOrder, true, true>(ldsl, gm, S, E, wv); }
            GSYNC();
        }
    }
}

extern "C" void kernel_launch(void* const* d_in, const int* in_sizes, int n_in, void* d_out, int out_size, void* d_ws, size_t ws_size, hipStream_t stream) {
    static int grid = 0;
    if (grid == 0) {
        if (n_in != 29 || ws_size < WS_NEED) { fprintf(stderr, "kernel_launch: need 29 inputs and %zu bytes of workspace; got %d, %zu\n", (size_t)WS_NEED, n_in, ws_size); grid = -1; return; }
        int dev = 0, cus = 0, per_cu = 0;
        if (hipGetDevice(&dev) != hipSuccess || hipDeviceGetAttribute(&cus, hipDeviceAttributeMultiprocessorCount, dev) != hipSuccess) { grid = -1; return; }
        if (hipFuncSetAttribute((const void*)mega_fwd, hipFuncAttributeMaxDynamicSharedMemorySize, LDS_BYTES) != hipSuccess) { fprintf(stderr, "kernel_launch: hipFuncSetAttribute failed\n"); grid = -1; return; }
        if (hipOccupancyMaxActiveBlocksPerMultiprocessor(&per_cu, (const void*)mega_fwd, 512, LDS_BYTES) != hipSuccess || per_cu < 1) { fprintf(stderr, "kernel_launch: occupancy query says %d\n", per_cu); per_cu = 1; }
        (void)hipGetLastError();
        grid = cus;
    }
    if (grid < 0) return;
    if (hipMemsetAsync(d_ws, 0, 16384, stream) != hipSuccess) { fprintf(stderr, "kernel_launch: memset failed\n"); return; }
    Params p{};
    for (int i = 0; i < 29; ++i) p.in[i] = (const float*)d_in[i];
    p.out = (float*)d_out; p.ws = (unsigned char*)d_ws;
    void* args[] = {&p};
    hipError_t e = hipLaunchCooperativeKernel((const void*)mega_fwd, dim3(grid), dim3(512), args, LDS_BYTES, stream);
    if (e != hipSuccess) fprintf(stderr, "kernel_launch: cooperative launch failed: %s (grid %d)\n", hipGetErrorString(e), grid);
}
```

```cpp
#include <hip/hip_runtime.h>
#include <hip/hip_cooperative_groups.h>
#include <cstdio>
#include <cstdint>
namespace cg = cooperative_groups;
#define PROBE 0
#define DEV __device__ __forceinline__
__device__ __forceinline__ int lsd(int x) { asm volatile("" : "+s"(x)); return x; }
__device__ __forceinline__ int launder_tid(int wv) { int l; asm volatile("v_mbcnt_lo_u32_b32 %0, -1, 0\n\tv_mbcnt_hi_u32_b32 %0, -1, %0" : "=v"(l)); return wv * 64 + l; }
namespace pg8 {
#define PG8_LAS __attribute__((address_space(3)))
typedef unsigned short bf16_t;
typedef short bf16x8 __attribute__((ext_vector_type(8)));
typedef float f32x4 __attribute__((ext_vector_type(4)));
typedef unsigned u32x4 __attribute__((ext_vector_type(4)));
constexpr int BM = 256, BK = 64, HALF = 128, HTB = HALF * BK * 2  , STAGE_BYTES = 8 * HTB, NXCD = 8, WGM = 8;

__host__ __device__ __forceinline__ int lds_byte(int r, int c) { const int st = (r >> 4) * 2 + (c >> 5), rr = r & 15, cc = c & 31, ob = rr * 64 + cc * 2; return st * 1024 + (ob ^ (((ob >> 9) & 1) << 5)); }
__host__ __device__ __forceinline__ void stage_rc(int b, int& R, int& C) { const int st = b / 1024, sb = b % 1024, swz = sb ^ (((sb >> 9) & 1) << 5); R = (st >> 1) * 16 + swz / 64; C = (st & 1) * 32 + (swz % 64) / 2; }
__host__ __device__ __forceinline__ int perm32(int rho) { const int n = rho >> 4, i = rho & 15; return 8 * (i >> 2) + 4 * n + (i & 3); }

struct Unit { int pm, pn; };
struct Gemm { const bf16_t* A; const bf16_t* Bt; int M, N, K; int pn_per_ab; size_t ab_stride; };

struct StaticOrder {
    int nM, nN, nwg, G, c;
    __host__ __device__ void init(int M, int N, int G_, int c_) { nM = M / BM; nN = N / BM; nwg = nM * nN; G = G_; c = c_; }
    __host__ __device__ bool next(int i, Unit& u) const {
        const long L = (long)i * G + c; if (L >= nwg) return false;
        int wgid = (int)L; { const int q = nwg / NXCD, r = nwg % NXCD, xcd = wgid % NXCD, off = wgid / NXCD; wgid = (xcd < r ? xcd * (q + 1) : r * (q + 1) + (xcd - r) * q) + off; }
        const int nig = WGM * nN, gid = wgid / nig, fm = gid * WGM, gsz = (nM - fm) < WGM ? (nM - fm) : WGM;
        u.pm = fm + ((wgid % nig) % gsz); u.pn = (wgid % nig) / gsz; return true;
    }
    __device__ __forceinline__ void a_ready(const Unit&) const {}
    __device__ __forceinline__ void done(const Unit&) const {}
};

__device__ __forceinline__ unsigned cvt_pk_bf16(float lo, float hi) { unsigned r; asm volatile("v_cvt_pk_bf16_f32 %0, %1, %2" : "=v"(r) : "v"(lo), "v"(hi)); return r; }
typedef float f32x2 __attribute__((ext_vector_type(2)));
__device__ __forceinline__ float sigm(float x) { return __builtin_amdgcn_rcpf(1.0f + __expf(-x)); }
template <int ACT  > struct EpiBf {
    static constexpr bool PERM = true, AFTER_DRAIN = false;
    bf16_t* O; int ldc; size_t gstride;
    __device__ __forceinline__ void operator()(const f32x4 (&acc)[2][2][4][2], const Unit& u, int wr, int wc, int fr, int fq) const {
        const int row0 = u.pm * BM + wr * 64 + fr; int colt = u.pn * BM; bf16_t* base = O; int ld = ldc;
        if (gstride) { const int t = colt >> 9; colt &= 511; base += (size_t)t * gstride; ld = 512; }
        const int col0 = colt + wc * 32 + 8 * fq;
#pragma unroll
        for (int ai = 0; ai < 2; ++ai)
#pragma unroll
            for (int m = 0; m < 4; ++m) { bf16_t* rowp = base + (size_t)(row0 + ai * HALF + m * 16) * ld + col0;
#pragma unroll
                for (int bj = 0; bj < 2; ++bj) { f32x4 v0 = acc[ai][bj][m][0], v1 = acc[ai][bj][m][1];
                    if (ACT == 1) {
#pragma unroll
                        for (int i = 0; i < 4; ++i) { float a = fmaxf(v0[i], 0.f), b = fmaxf(v1[i], 0.f); v0[i] = a * a; v1[i] = b * b; } }
                    u32x4 w; w.x = cvt_pk_bf16(v0[0], v0[1]); w.y = cvt_pk_bf16(v0[2], v0[3]); w.z = cvt_pk_bf16(v1[0], v1[1]); w.w = cvt_pk_bf16(v1[2], v1[3]);
                    *(u32x4*)(rowp + bj * HALF) = w; } }
    }
};
struct EpiLR {
    static constexpr bool PERM = true, AFTER_DRAIN = false;
    bf16_t *s0, *s1, *s2, *s3, *s4; const float* w0; const float* a0;
    __device__ __forceinline__ void operator()(const f32x4 (&acc)[2][2][4][2], const Unit& u, int wr, int wc, int fr, int fq) const {
        const int row0 = u.pm * BM + wr * 64 + fr; const int colg = u.pn * BM; const int seg = colg >> 9; const int cb = colg & 511;
        bf16_t* base = seg == 0 ? s0 : seg == 1 ? s1 : seg == 2 ? s2 : seg == 3 ? s3 : s4;
        const int col0 = cb + wc * 32 + 8 * fq;
        const float* bsrc = seg < 2 ? w0 + seg * 512 : a0 + (seg & 1) * 512;
        const float sc = seg < 2 ? 0.6065306597f : 1.0f; const float bm = seg < 4 ? 1.f : 0.f; const bool act = seg < 4;
#pragma unroll
        for (int bj = 0; bj < 2; ++bj) {
            const f32x4 b0 = *(const f32x4*)(bsrc + col0 + bj * HALF) * bm, b1 = *(const f32x4*)(bsrc + col0 + bj * HALF + 4) * bm;
#pragma unroll
            for (int ai = 0; ai < 2; ++ai)
#pragma unroll
                for (int m = 0; m < 4; ++m) { bf16_t* rowp = base + (size_t)(row0 + ai * HALF + m * 16) * 512 + col0;
                    f32x4 v0 = acc[ai][bj][m][0] + b0, v1 = acc[ai][bj][m][1] + b1;
#pragma unroll
                    for (int i = 0; i < 4; ++i) { const float g0 = sc * sigm(v0[i]), g1 = sc * sigm(v1[i]); v0[i] = act ? g0 : v0[i]; v1[i] = act ? g1 : v1[i]; }
                    u32x4 w; w.x = cvt_pk_bf16(v0[0], v0[1]); w.y = cvt_pk_bf16(v0[2], v0[3]); w.z = cvt_pk_bf16(v1[0], v1[1]); w.w = cvt_pk_bf16(v1[2], v1[3]);
                    *(u32x4*)(rowp + bj * HALF) = w; __builtin_amdgcn_sched_barrier(0); }
        }
    }
};
struct EpiGate {
    static constexpr bool PERM = true, AFTER_DRAIN = false;
    const bf16_t* Pm; bf16_t* Mg;
    __device__ __forceinline__ void operator()(const f32x4 (&acc)[2][2][4][2], const Unit& u, int wr, int wc, int fr, int fq) const {
        const int row0 = u.pm * BM + wr * 64 + fr; const int ocol = u.pn * 64 + wc * 16 + fq * 4;
#pragma unroll
        for (int ai = 0; ai < 2; ++ai)
#pragma unroll
            for (int m = 0; m < 4; ++m) { const size_t row = (size_t)(row0 + ai * HALF + m * 16);
                float s0 = 0.f, s1 = 0.f, s2 = 0.f, s3 = 0.f;
#pragma unroll
                for (int bj = 0; bj < 2; ++bj)
#pragma unroll
                    for (int n = 0; n < 2; ++n) { const int br = bj * 2 + n;
                        const uint2 pw = *(const uint2*)(Pm + row * 4096 + br * 1024 + ocol);
                        const f32x4 a = acc[ai][bj][m][n];
                        s0 += sigm(a[0]) * __uint_as_float(pw.x << 16); s1 += sigm(a[1]) * __uint_as_float(pw.x & 0xffff0000u);
                        s2 += sigm(a[2]) * __uint_as_float(pw.y << 16); s3 += sigm(a[3]) * __uint_as_float(pw.y & 0xffff0000u); }
                uint2 o; o.x = cvt_pk_bf16(s0, s1); o.y = cvt_pk_bf16(s2, s3);
                *(uint2*)(Mg + row * 1024 + ocol) = o; }
    }
};
struct EpiResid {
    static constexpr bool PERM = true, AFTER_DRAIN = false;
    const float* om; const float* mt; float* nm; float* xmb; int g; int rlim;
    __device__ __forceinline__ void operator()(const f32x4 (&acc)[2][2][4][2], const Unit& u, int wr, int wc, int fr, int fq) const {
        const int row0 = u.pm * BM + wr * 64 + fr; const int col0 = u.pn * BM + wc * 32 + 8 * fq;
#pragma unroll
        for (int ai = 0; ai < 2; ++ai)
#pragma unroll
            for (int m = 0; m < 4; ++m) { const int r = row0 + ai * HALF + m * 16;
                if (r < rlim) {
                    const int mi = r - 16384;
                    float* dmeta = xmb + (size_t)(mi < 64 ? g * 64 + mi : ((mi >> 6) - 1) * 64 + (mi & 63)) * 1024;
                    const float* src = r < 16384 ? om + (size_t)r * 1024 : (mt ? mt + (size_t)(mi & 15) * 1024 : (const float*)dmeta);
                    float* dst = r < 16384 ? nm + (size_t)r * 1024 : dmeta;
#pragma unroll
                    for (int bj = 0; bj < 2; ++bj)
#pragma unroll
                        for (int n = 0; n < 2; ++n) { const int c = col0 + bj * HALF + 4 * n;
                            const f32x4 xo = *(const f32x4*)(src + c); *(f32x4*)(dst + c) = xo + acc[ai][bj][m][n]; } } }
    }
};
template <class Epi, class Sched, bool ALIGN_EPI = false, bool SP2 = false>
__device__ __forceinline__ void gemm_phase(PG8_LAS unsigned char* lds, const Gemm g, const Sched& S, const Epi& E, int wv) {
    const int tid = launder_tid(wv), wid = __builtin_amdgcn_readfirstlane(tid >> 6), lane = tid & 63, wr = wid >> 2, wc = wid & 3, fr = lane & 15, fq = lane >> 4;
    const int K = g.K, nt = K / BK;
    unsigned voffA[2], voffB[2];
#pragma unroll
    for (int i = 0; i < 2; ++i) { int R, C; stage_rc(tid * 16 + i * 8192, R, C); const int Rb = Epi::PERM ? ((R & ~31) + perm32(R & 31)) : R;
        voffA[i] = (unsigned)(R * K + C) * 2u; voffB[i] = (unsigned)(Rb * K + C) * 2u; }
    const size_t kstep = (size_t)(BK * 2);
    const size_t hstep = (size_t)HALF * K * 2;
    const size_t tstep = 2 * hstep;
    const unsigned ldsw = (unsigned)wid * 1024u;
    const int aoff = lds_byte(wr * 64 + fr, fq * 8), boff = lds_byte(wc * 32 + fr, fq * 8);
#define PG8_SA(b, h) (((b) * 2 + (h)) * HTB)
#define PG8_SB(b, h) ((4 + (b) * 2 + (h)) * HTB)
#define PG8_STAGE(bufoff, gbase, voff) do { _Pragma("unroll") for (int _i = 0; _i < 2; ++_i) \
        __builtin_amdgcn_global_load_lds((const unsigned*)((const char*)(gbase) + (voff)[_i]), (PG8_LAS unsigned*)(lds + (bufoff) + ldsw + _i * 8192), 16, 0, 0); } while (0)
#define PG8_LDA(dst, b, h) do { _Pragma("unroll") for (int m = 0; m < 4; ++m) _Pragma("unroll") for (int k = 0; k < 2; ++k) dst[m][k] = *(const PG8_LAS bf16x8*)(lds + PG8_SA(b, h) + aoff + m * 2048 + k * 1024); } while (0)
#define PG8_LDB(dst, b, h) do { _Pragma("unroll") for (int n = 0; n < 2; ++n) _Pragma("unroll") for (int k = 0; k < 2; ++k) dst[n][k] = *(const PG8_LAS bf16x8*)(lds + PG8_SB(b, h) + boff + n * 2048 + k * 1024); } while (0)
#define PG8_MMA(ai, bj, At, Bt) do { __builtin_amdgcn_s_setprio(1); _Pragma("unroll") for (int m = 0; m < 4; ++m) _Pragma("unroll") for (int n = 0; n < 2; ++n) _Pragma("unroll") for (int k = 0; k < 2; ++k) \
        acc[ai][bj][m][n] = __builtin_amdgcn_mfma_f32_16x16x32_bf16(Bt[n][k], At[m][k], acc[ai][bj][m][n], 0, 0, 0); __builtin_amdgcn_s_setprio(0); } while (0)
#define PG8_WAIT_V(n) asm volatile("s_waitcnt vmcnt(" #n ")" ::: "memory")
#define PG8_WAIT_L(n) asm volatile("s_waitcnt lgkmcnt(" #n ")" ::: "memory")
#define PG8_BAR __builtin_amdgcn_s_barrier()
#define PG8_SCHED __builtin_amdgcn_sched_barrier(0)
    Unit cur, nxt; int ui = 0;
    if (!S.next(0, cur)) return;
    f32x4 acc[2][2][4][2];
#pragma unroll
    for (int a = 0; a < 2; ++a)
#pragma unroll
        for (int b = 0; b < 2; ++b)
#pragma unroll
            for (int m = 0; m < 4; ++m)
#pragma unroll
                for (int n = 0; n < 2; ++n) { float z_ = 0.f; asm volatile("" : "+v"(z_)); acc[a][b][m][n] = (f32x4){z_, z_, z_, z_}; }
    bf16x8 At[4][2], B0[2][2], B1[2][2];
    const char* cA = (const char*)g.A + (g.pn_per_ab ? (size_t)(cur.pn / g.pn_per_ab) * g.ab_stride : (size_t)0) + (size_t)cur.pm * tstep; const char* cB = (const char*)g.Bt + (size_t)cur.pn * tstep;
    S.a_ready(cur);
    if constexpr (SP2) {
        PG8_STAGE(PG8_SB(0, 0), cB, voffB); PG8_STAGE(PG8_SB(0, 1), cB + hstep, voffB); PG8_STAGE(PG8_SA(0, 0), cA, voffA); PG8_STAGE(PG8_SA(0, 1), cA + hstep, voffA);
        if (wr == 1) PG8_BAR;
        PG8_WAIT_V(2); PG8_BAR;
        PG8_STAGE(PG8_SB(1, 0), cB + kstep, voffB); PG8_STAGE(PG8_SA(1, 0), cA + kstep, voffA); PG8_STAGE(PG8_SB(1, 1), cB + hstep + kstep, voffB);
        PG8_WAIT_V(6); PG8_BAR;
    } else {
        PG8_STAGE(PG8_SB(0, 0), cB, voffB); PG8_STAGE(PG8_SA(0, 0), cA, voffA); PG8_STAGE(PG8_SB(0, 1), cB + hstep, voffB); PG8_STAGE(PG8_SA(0, 1), cA + hstep, voffA);
        if (wr == 1) PG8_BAR;
        PG8_WAIT_V(4); PG8_BAR;
        PG8_STAGE(PG8_SB(1, 0), cB + kstep, voffB); PG8_STAGE(PG8_SA(1, 0), cA + kstep, voffA); PG8_STAGE(PG8_SB(1, 1), cB + hstep + kstep, voffB);
        PG8_WAIT_V(6); PG8_BAR;
    }
    for (;;) {
        const bool has_next = S.next(ui + 1, nxt);
        const char* nA = has_next ? (const char*)g.A + (g.pn_per_ab ? (size_t)(nxt.pn / g.pn_per_ab) * g.ab_stride : (size_t)0) + (size_t)nxt.pm * tstep : cA; const char* nB = has_next ? (const char*)g.Bt + (size_t)nxt.pn * tstep : cB;
#pragma unroll 1
        for (int t = 0; t < nt; t += 2) {
            const bool last = (t == nt - 2);
            const char* a1 = cA + (size_t)(t + 1) * kstep;
            const char* a2 = last ? nA : cA + (size_t)(t + 2) * kstep; const char* b2 = last ? nB : cB + (size_t)(t + 2) * kstep;
            const char* a3 = a2 + kstep; const char* b3 = b2 + kstep;
            if (last && has_next) S.a_ready(nxt);
            if constexpr (SP2) {
            PG8_LDB(B0, 0, 0); PG8_LDB(B1, 0, 1); PG8_SCHED; PG8_LDA(At, 0, 0); PG8_STAGE(PG8_SA(1, 1), a1 + hstep, voffA);
            PG8_WAIT_V(8); PG8_WAIT_L(0); PG8_BAR; PG8_MMA(0, 0, At, B0); PG8_MMA(0, 1, At, B1); PG8_BAR; PG8_SCHED;
            PG8_LDA(At, 0, 1); PG8_STAGE(PG8_SB(0, 0), b2, voffB); PG8_STAGE(PG8_SB(0, 1), b2 + hstep, voffB); PG8_STAGE(PG8_SA(0, 0), a2, voffA);
            PG8_WAIT_V(8); PG8_WAIT_L(0); PG8_BAR; PG8_MMA(1, 0, At, B0); PG8_MMA(1, 1, At, B1); PG8_BAR; PG8_SCHED;
            PG8_LDB(B0, 1, 0); PG8_LDB(B1, 1, 1); PG8_SCHED; PG8_LDA(At, 1, 0); PG8_STAGE(PG8_SA(0, 1), a2 + hstep, voffA);
            PG8_WAIT_V(8); PG8_WAIT_L(0); PG8_BAR; PG8_MMA(0, 0, At, B0); PG8_MMA(0, 1, At, B1); PG8_BAR; PG8_SCHED;
            PG8_LDA(At, 1, 1); PG8_STAGE(PG8_SB(1, 0), b3, voffB); PG8_STAGE(PG8_SB(1, 1), b3 + hstep, voffB); PG8_STAGE(PG8_SA(1, 0), a3, voffA);
            PG8_WAIT_V(8); PG8_WAIT_L(0); PG8_BAR; PG8_MMA(1, 0, At, B0); PG8_MMA(1, 1, At, B1); PG8_BAR; PG8_SCHED;
            } else {
            PG8_LDB(B0, 0, 0); PG8_SCHED; PG8_LDA(At, 0, 0); PG8_STAGE(PG8_SA(1, 1), a1 + hstep, voffA);
            PG8_WAIT_L(8); PG8_BAR; PG8_WAIT_L(0); PG8_MMA(0, 0, At, B0); PG8_BAR; PG8_SCHED;
            PG8_LDB(B1, 0, 1); PG8_STAGE(PG8_SB(0, 0), b2, voffB);
            PG8_BAR; PG8_WAIT_L(0); PG8_MMA(0, 1, At, B1); PG8_BAR;
            PG8_LDA(At, 0, 1); PG8_STAGE(PG8_SA(0, 0), a2, voffA);
            PG8_BAR; PG8_WAIT_L(0); PG8_MMA(1, 0, At, B0); PG8_BAR; PG8_SCHED;
            PG8_STAGE(PG8_SB(0, 1), b2 + hstep, voffB);
            PG8_WAIT_V(6); PG8_BAR; PG8_MMA(1, 1, At, B1); PG8_BAR;
            PG8_LDB(B0, 1, 0); PG8_SCHED; PG8_LDA(At, 1, 0); PG8_STAGE(PG8_SA(0, 1), a2 + hstep, voffA);
            PG8_WAIT_L(8); PG8_BAR; PG8_WAIT_L(0); PG8_MMA(0, 0, At, B0); PG8_BAR; PG8_SCHED;
            PG8_LDB(B1, 1, 1); PG8_STAGE(PG8_SB(1, 0), b3, voffB);
            PG8_BAR; PG8_WAIT_L(0); PG8_MMA(0, 1, At, B1); PG8_BAR;
            PG8_LDA(At, 1, 1); PG8_STAGE(PG8_SA(1, 0), a3, voffA);
            PG8_BAR; PG8_WAIT_L(0); PG8_MMA(1, 0, At, B0); PG8_BAR; PG8_SCHED;
            PG8_STAGE(PG8_SB(1, 1), b3 + hstep, voffB);
            PG8_WAIT_V(6); PG8_BAR; PG8_MMA(1, 1, At, B1); PG8_BAR;
            }
        }
        if constexpr (ALIGN_EPI) { if (wr == 0) PG8_BAR; }
        if constexpr (!Epi::AFTER_DRAIN) { E(acc, cur, wr, wc, fr, fq); S.done(cur); }
        if (!has_next) break;
#pragma unroll
        for (int a = 0; a < 2; ++a)
#pragma unroll
            for (int b = 0; b < 2; ++b)
#pragma unroll
                for (int m = 0; m < 4; ++m)
#pragma unroll
                    for (int n = 0; n < 2; ++n) { float z_ = 0.f; asm volatile("" : "+v"(z_)); acc[a][b][m][n] = (f32x4){z_, z_, z_, z_}; }
        cur = nxt; cA = nA; cB = nB; ++ui;
        if constexpr (ALIGN_EPI) { if (wr == 1) PG8_BAR; }
    }
    PG8_WAIT_V(0);
    if constexpr (!ALIGN_EPI) { if (wr == 0) PG8_BAR; }
    PG8_BAR;
    if constexpr (Epi::AFTER_DRAIN) { E.fused(acc, cur, wr, wc, fr, fq, lds, wid, lane); S.done(cur); }
#undef PG8_SA
#undef PG8_SB
#undef PG8_STAGE
#undef PG8_LDA
#undef PG8_LDB
#undef PG8_MMA
#undef PG8_WAIT_V
#undef PG8_WAIT_L
#undef PG8_BAR
#undef PG8_SCHED
}
}
typedef unsigned short bf16_t;
typedef short bf16x8 __attribute__((ext_vector_type(8)));
typedef float f32x4 __attribute__((ext_vector_type(4)));
typedef float f32x16 __attribute__((ext_vector_type(16)));
constexpr int LSEQ = 4112, TREAL = 16384, TG = 16448, TGP = 16640, NGRP = 3;
constexpr size_t SLOT_E = (size_t)TGP * 512;
constexpr size_t SLOT_B = SLOT_E * 2;
constexpr size_t MiB = 1u << 20;
constexpr size_t WS_XMETA = 1 * MiB, WS_DECAY = 2 * MiB, WS_SIDE = 3 * MiB + 512 * 1024, WS_W = 5 * MiB, WS_SLOTS = 53 * MiB;
constexpr size_t WS_NEED = WS_SLOTS + 25 * SLOT_B;
constexpr size_t WO_IN = 0, WO_G = 7864320, WO_BP = 12058624, WO_OUT = 14155776, WO_1 = 15204352, WO_2 = 19398656, WO_LR = 23592960;
constexpr int LDS_BYTES = 140 * 1024;
enum { I_XP = 0, I_XS, I_META, I_NMIX, I_WIN, I_LBL, I_ONORM, I_CONV, I_QN, I_KN, I_LAM, I_SUBLN, I_MU, I_W0, I_W2, I_A0, I_A2, I_G2, I_KK, I_KA, I_RK, I_LNG, I_LNB, I_WG, I_BP, I_WOUT, I_NMLP, I_W1, I_W2M };
struct Params { const float* in[29]; float* out; unsigned char* ws; };
typedef const __attribute__((address_space(4))) Params* KParamsPtr;
DEV KParamsPtr kparams() { KParamsPtr p = (KParamsPtr)__builtin_amdgcn_kernarg_segment_ptr(); asm volatile("" : "+s"(p)); return p; }
DEV Params load_params() { KParamsPtr p = kparams(); Params r;
#pragma unroll
    for (int i = 0; i < 29; ++i) r.in[i] = p->in[i];
    r.out = p->out; r.ws = p->ws; return r; }
DEV unsigned zero_u() { unsigned z = 0u; asm volatile("" : "+v"(z)); return z; }

#define ROWPRO const int tid_ = launder_tid(wv); const int lane = tid_ & 63; const int gw = bid * 8 + __builtin_amdgcn_readfirstlane(tid_ >> 6); const int ngw = nb * 8;
DEV float bf2f(unsigned short u) { return __uint_as_float((unsigned)u << 16); }
DEV unsigned pk2(float lo, float hi) { return pg8::cvt_pk_bf16(lo, hi); }
DEV void unpack8(const uint4 w, float* f) {
    f[0] = __uint_as_float(w.x << 16); f[1] = __uint_as_float(w.x & 0xffff0000u); f[2] = __uint_as_float(w.y << 16); f[3] = __uint_as_float(w.y & 0xffff0000u);
    f[4] = __uint_as_float(w.z << 16); f[5] = __uint_as_float(w.z & 0xffff0000u); f[6] = __uint_as_float(w.w << 16); f[7] = __uint_as_float(w.w & 0xffff0000u); }
DEV uint4 pack8(const float* f) { uint4 o; o.x = pk2(f[0], f[1]); o.y = pk2(f[2], f[3]); o.z = pk2(f[4], f[5]); o.w = pk2(f[6], f[7]); return o; }
DEV bf16_t* slotp(const Params& P, int s) { return (bf16_t*)(P.ws + WS_SLOTS + (size_t)s * SLOT_B); }
DEV int row_of(int sl, int p) { return p >= 16 ? sl * 4096 + p - 16 : TREAL + sl * 16 + p; }
DEV void pos_of(int r, int& sl, int& p) { if (r < TREAL) { sl = r >> 12; p = (r & 4095) + 16; } else { const int m = r - TREAL; sl = m >> 4; p = m & 15; } }
DEV float wave_sum(float v) {
#pragma unroll
    for (int o = 1; o < 64; o <<= 1) v += __shfl_xor(v, o);
    return v; }
DEV float red8(float v) { v += __shfl_xor(v, 1); v += __shfl_xor(v, 2); v += __shfl_xor(v, 4); return v; }
DEV f32x4 mfma16(bf16x8 a, bf16x8 b, f32x4 c) { return __builtin_amdgcn_mfma_f32_16x16x32_bf16(a, b, c, 0, 0, 0); }
DEV f32x16 mfma32(bf16x8 a, bf16x8 b, f32x16 c) { return __builtin_amdgcn_mfma_f32_32x32x16_bf16(a, b, c, 0, 0, 0); }
DEV const float* x_in_row(const Params& P, int g, int r) {
    if (r < TREAL) return (g < 2 ? P.in[I_XP] + (size_t)g * TREAL * 1024 : P.in[I_XS]) + (size_t)r * 1024;
    return P.in[I_META] + (size_t)((r - TREAL) & 15) * 1024; }
DEV float* x_cur_row(const Params& P, int g, int r) {
    if (r < TREAL) return P.out + ((size_t)g * TREAL + r) * 1024;
    const int m = r - TREAL;
    return (float*)(P.ws + WS_XMETA) + (size_t)(m < 64 ? g * 64 + m : ((m >> 6) - 1) * 64 + (m & 63)) * 1024; }

DEV int gate_row(int n) { const int br = n >> 10, c = n & 1023, pn = c >> 6, oc = c & 63, wc = oc >> 4, fq = (oc >> 2) & 3, i = oc & 3; return pn * 256 + (br >> 1) * 128 + wc * 32 + fq * 8 + (br & 1) * 4 + i; }
template <int MODE> DEV void wt_items(const float* __restrict__ W, int K, int N, bf16_t* WT, int row_off, float* scr, int gw, int ngw, int lane) {
    const int nblk = N >> 5, items = (K >> 6) * nblk;
    for (int it = gw; it < items; it += ngw) {
        const int kb = it / nblk, nbk = it - kb * nblk, k0 = 64 * kb, n0 = 32 * nbk;
#pragma unroll 8
        for (int i = 0; i < 32; ++i) { const int kk = 2 * i + (lane >> 5); scr[kk * 33 + (lane & 31)] = W[(size_t)(k0 + kk) * N + n0 + (lane & 31)]; }
        asm volatile("s_waitcnt lgkmcnt(0)" ::: "memory");
        const int c = lane & 7;
#pragma unroll
        for (int j = 0; j < 4; ++j) { const int n = (lane >> 3) + 8 * j; const float* sp = scr + (8 * c) * 33 + n;
            uint4 o; o.x = pk2(sp[0 * 33], sp[1 * 33]); o.y = pk2(sp[2 * 33], sp[3 * 33]); o.z = pk2(sp[4 * 33], sp[5 * 33]); o.w = pk2(sp[6 * 33], sp[7 * 33]);
            const int dr = MODE == 1 ? gate_row(n0 + n) : n0 + n + row_off;
            *(uint4*)(WT + (size_t)dr * K + k0 + 8 * c) = o; }
        asm volatile("s_waitcnt lgkmcnt(0)" ::: "memory");
    }
}
DEV void phase_weights(const Params& P0, int layer, unsigned char* lds, int bid, int nb, int wv) {
    Params P = load_params(); asm volatile("" : "+s"(P.ws));
    const int tid = launder_tid(wv), lane = tid & 63, w = __builtin_amdgcn_readfirstlane(tid >> 6);
    const int gtid = bid * 512 + tid, gth = nb * 512, gw = bid * 8 + w, ngw = nb * 8;
    float* scr = (float*)(lds + w * 8448);
    bf16_t* W = (bf16_t*)(P.ws + WS_W);
    wt_items<0>(P.in[I_WIN] + (size_t)layer * 1024 * 7552, 1024, 7552, W + WO_IN, 0, scr, gw, ngw, lane);
    for (int it = gtid; it < 128 * 128; it += gth) { const unsigned z = zero_u(); *(uint4*)(W + WO_IN + (size_t)7552 * 1024 + (size_t)it * 8) = make_uint4(z, z, z, z); }
    wt_items<1>(P.in[I_WG] + (size_t)layer * 1024 * 4096, 1024, 4096, W + WO_G, 0, scr, gw, ngw, lane);
    for (int n = 0; n < 4; ++n) wt_items<0>(P.in[I_BP] + (size_t)(layer * 4 + n) * 512 * 1024, 512, 1024, W + WO_BP, n * 1024, scr, gw, ngw, lane);
    wt_items<0>(P.in[I_WOUT] + (size_t)layer * 1024 * 1024, 1024, 1024, W + WO_OUT, 0, scr, gw, ngw, lane);
    wt_items<0>(P.in[I_W1] + (size_t)layer * 1024 * 4096, 1024, 4096, W + WO_1, 0, scr, gw, ngw, lane);
    wt_items<0>(P.in[I_W2M] + (size_t)layer * 4096 * 1024, 4096, 1024, W + WO_2, 0, scr, gw, ngw, lane);
    for (int it = gtid; it < 2560 * 48; it += gth) {
        const int row = it / 48, k8 = it - row * 48, seg = row >> 9, c = row & 511, k0 = k8 * 8;
        float v[8];
#pragma unroll
        for (int j = 0; j < 8; ++j) { const int k = k0 + j; float x = 0.f;
            if (seg == 0) { if (k < 64) x = P.in[I_W2][((size_t)(layer * 2 + 0) * 64 + k) * 512 + c]; }
            else if (seg == 1) { if (k >= 64 && k < 128) x = P.in[I_W2][((size_t)(layer * 2 + 1) * 64 + (k - 64)) * 512 + c]; }
            else if (seg == 2) { if (k >= 128 && k < 192) x = P.in[I_A2][((size_t)(layer * 2 + 0) * 64 + (k - 128)) * 512 + c]; }
            else if (seg == 3) { if (k >= 192 && k < 256) x = P.in[I_A2][((size_t)(layer * 2 + 1) * 64 + (k - 192)) * 512 + c]; }
            else { if (k >= 256) x = P.in[I_G2][((size_t)layer * 128 + (k - 256)) * 512 + c]; }
            v[j] = x; }
        *(uint4*)(W + WO_LR + (size_t)row * 384 + k0) = pack8(v);
    }
}

DEV void phase_rmsnorm(const Params& P0, int g, bool src_in, int gain_idx, int layer, int nrows, int nvalid, int bid, int nb, int wv) {
    Params P = load_params(); asm volatile("" : "+s"(P.ws));
    ROWPRO
    const float* gain = P.in[gain_idx] + layer * 1024;
    bf16_t* H = slotp(P, 0);
    for (int r = gw; r < nrows; r += ngw) {
        uint2* o8 = (uint2*)(H + (size_t)r * 1024) + lane;
        if (r >= nvalid) {
#pragma unroll
            for (int j = 0; j < 4; ++j) { const unsigned z = zero_u(); o8[64 * j] = make_uint2(z, z); }
            continue; }
        const f32x4* xr = (const f32x4*)(src_in ? x_in_row(P, g, r) : (const float*)x_cur_row(P, g, r)) + lane;
        f32x4 v[4]; float s = 0.f;
#pragma unroll
        for (int j = 0; j < 4; ++j) { v[j] = xr[64 * j]; s += (v[j].x * v[j].x + v[j].y * v[j].y) + (v[j].z * v[j].z + v[j].w * v[j].w); }
        const float rs = rsqrtf(wave_sum(s) * (1.f / 1024.f) + 1e-6f);
#pragma unroll
        for (int j = 0; j < 4; ++j) { const f32x4 gg = *((const f32x4*)gain + lane + 64 * j);
            o8[64 * j] = make_uint2(pk2(v[j].x * rs * gg.x, v[j].y * rs * gg.y), pk2(v[j].z * rs * gg.z, v[j].w * rs * gg.w)); }
    }
}
DEV void phase_da_prep(const Params& P0, int layer, int bid, int nb, int wv) {
    Params P = load_params(); asm volatile("" : "+s"(P.ws));
    ROWPRO
    const float inv8[8] = {1.0f, 0.19392274474868576f, 0.03760603093086393f, 0.007292664737217109f, 0.001414213562373095f, 0.0002742481756762073f, 5.318295896944988e-05f, 1.031338537721246e-05f};
    const int d0 = (lane & 7) * 8;
    float gq[8], gk[8];
#pragma unroll
    for (int j = 0; j < 8; ++j) { gq[j] = P.in[I_QN][layer * 64 + d0 + j]; gk[j] = P.in[I_KN][layer * 64 + d0 + j]; }
    for (int r = gw; r < TG; r += ngw) {
        int sl, p; pos_of(r, sl, p);
        float cs[8], sn[8];
#pragma unroll
        for (int j = 0; j < 8; ++j) { const float ang = (float)p * inv8[j]; double a = (double)ang; a -= 6.283185307179586 * __builtin_rint(a * 0.15915494309189535); const float rr = (float)a; cs[j] = __cosf(rr); sn[j] = __sinf(rr); }
#pragma unroll
        for (int which = 0; which < 2; ++which) {
            uint4* ptr = (uint4*)(slotp(P, 10 + which) + (size_t)r * 512) + lane;
            float f[8]; unpack8(*ptr, f);
            float ss = 0.f;
#pragma unroll
            for (int j = 0; j < 8; ++j) ss += f[j] * f[j];
            ss = red8(ss);
            const float rs = rsqrtf(ss * (1.f / 64.f) + 1e-6f);
#pragma unroll
            for (int j = 0; j < 8; ++j) f[j] = f[j] * rs * (which == 0 ? gq[j] : gk[j]);
#pragma unroll
            for (int j = 0; j < 8; ++j) { const float pr = __shfl_xor(f[j], 1);
                if ((lane & 7) == 0) f[j] = f[j] * cs[j] - pr * sn[j];
                else if ((lane & 7) == 1) f[j] = f[j] * cs[j] + pr * sn[j]; }
            if (which == 0) {
#pragma unroll
                for (int j = 0; j < 8; ++j) f[j] *= 0.18033688011112042f; }
            *ptr = pack8(f);
        }
    }
}
DEV void phase_conv(const Params& P0, int layer, int bid, int nb, int wv) {
    Params P = load_params(); asm volatile("" : "+s"(P.ws));
    ROWPRO
    const int c0 = lane * 8;
    float w0[8], w1[8], w2[8];
#pragma unroll
    for (int j = 0; j < 8; ++j) { w0[j] = P.in[I_CONV][(layer * 3 + 0) * 512 + c0 + j]; w1[j] = P.in[I_CONV][(layer * 3 + 1) * 512 + c0 + j]; w2[j] = P.in[I_CONV][(layer * 3 + 2) * 512 + c0 + j]; }
    const bf16_t* SB = slotp(P, 7); const bf16_t* SC = slotp(P, 8); const bf16_t* SH = slotp(P, 9); bf16_t* Y = slotp(P, 3);
    for (int r = gw; r < TG; r += ngw) {
        int sl, p; pos_of(r, sl, p);
        float acc[8], a[8], b[8];
        unpack8(*((const uint4*)(SC + (size_t)r * 512) + lane), a); unpack8(*((const uint4*)(SH + (size_t)r * 512) + lane), b);
#pragma unroll
        for (int j = 0; j < 8; ++j) acc[j] = a[j] * b[j] * w1[j];
        if (p > 0) { const int rp = row_of(sl, p - 1);
            unpack8(*((const uint4*)(SC + (size_t)rp * 512) + lane), a); unpack8(*((const uint4*)(SH + (size_t)rp * 512) + lane), b);
#pragma unroll
            for (int j = 0; j < 8; ++j) acc[j] += a[j] * b[j] * w0[j]; }
        if (p < LSEQ - 1) { const int rn = row_of(sl, p + 1);
            unpack8(*((const uint4*)(SC + (size_t)rn * 512) + lane), a); unpack8(*((const uint4*)(SH + (size_t)rn * 512) + lane), b);
#pragma unroll
            for (int j = 0; j < 8; ++j) acc[j] += a[j] * b[j] * w2[j]; }
        unpack8(*((const uint4*)(SB + (size_t)r * 512) + lane), a);
#pragma unroll
        for (int j = 0; j < 8; ++j) acc[j] *= a[j];
        *((uint4*)(Y + (size_t)r * 512) + lane) = pack8(acc);
    }
}
DEV void phase_rw_prep(const Params& P0, int layer, int bid, int nb, int wv) {
    Params P = load_params(); asm volatile("" : "+s"(P.ws));
    ROWPRO
    const float* mu = P.in[I_MU] + (size_t)layer * 1920;
    for (int r = gw; r < TG; r += ngw) {
        int sl, p; pos_of(r, sl, p);
        const int rp = p > 0 ? row_of(sl, p - 1) : -1, rn = p < LSEQ - 1 ? row_of(sl, p + 1) : -1;
#pragma unroll
        for (int grp = 0; grp < 4; ++grp) {
            if (grp == 3 && lane >= 48) break;
            const int c0 = (grp < 3 ? grp * 512 : 1536) + lane * 8;
            const bf16_t* src = slotp(P, 13 + (c0 >> 9)) + (c0 & 511);
            float u[8], up[8], un[8], xm[8];
            unpack8(*(const uint4*)(src + (size_t)r * 512), u);
            if (rp >= 0) unpack8(*(const uint4*)(src + (size_t)rp * 512), up); else {
#pragma unroll
                for (int j = 0; j < 8; ++j) up[j] = 0.f; }
            if (rn >= 0) unpack8(*(const uint4*)(src + (size_t)rn * 512), un); else {
#pragma unroll
                for (int j = 0; j < 8; ++j) un[j] = 0.f; }
#pragma unroll
            for (int j = 0; j < 8; ++j) xm[j] = u[j] + mu[c0 + j] * (0.5f * (up[j] + un[j]) - u[j]);
            if (grp < 3) {
                *((uint4*)(slotp(P, 17 + grp) + (size_t)r * 512) + lane) = pack8(xm);
                if (grp == 1) {
                    float kk[8], ss = 0.f;
#pragma unroll
                    for (int j = 0; j < 8; ++j) { kk[j] = xm[j] * P.in[I_KK][layer * 512 + c0 - 512 + j]; ss += kk[j] * kk[j]; }
                    ss = red8(ss);
                    const float inv = 1.0f / fmaxf(sqrtf(ss), 1e-12f);
#pragma unroll
                    for (int j = 0; j < 8; ++j) kk[j] *= inv;
                    *((uint4*)(slotp(P, 20) + (size_t)r * 512) + lane) = pack8(kk); }
            } else {
                const int a0 = lane * 8;
                float o[8];
#pragma unroll
                for (int j = 0; j < 8; ++j) { const float x = xm[j];
                    if (a0 < 128) { const float e = __expf(2.f * x); o[j] = 1.f - 2.f / (e + 1.f); }
                    else if (a0 < 256) o[j] = x;
                    else o[j] = 1.f / (1.f + __expf(-x)); }
                *((uint4*)(slotp(P, 21) + (size_t)r * 384) + lane) = pack8(o);
            }
        }
    }
    for (int r = TG + gw; r < TGP; r += ngw) if (lane < 48) { const unsigned z = zero_u(); *((uint4*)(slotp(P, 21) + (size_t)r * 384) + lane) = make_uint4(z, z, z, z); }
}
DEV void phase_rw_post(const Params& P0, int layer, int g, int nrows, int bid, int nb, int wv) {
    Params P = load_params(); asm volatile("" : "+s"(P.ws));
    ROWPRO
    const int c0 = lane * 8;
    float ka[8], rk[8], lg[8], lb[8];
#pragma unroll
    for (int j = 0; j < 8; ++j) { ka[j] = P.in[I_KA][layer * 512 + c0 + j]; rk[j] = P.in[I_RK][layer * 512 + c0 + j]; lg[j] = P.in[I_LNG][layer * 512 + c0 + j]; lb[j] = P.in[I_LNB][layer * 512 + c0 + j]; }
    for (int r = gw; r < nrows; r += ngw) {
        float of[8], ob[8], o[8];
        unpack8(*((const uint4*)(slotp(P, 15) + (size_t)r * 512) + lane), of); unpack8(*((const uint4*)(slotp(P, 16) + (size_t)r * 512) + lane), ob);
        float s = 0.f;
#pragma unroll
        for (int j = 0; j < 8; ++j) { o[j] = of[j] + ob[j]; s += o[j]; }
        const float mean = red8(s) * (1.f / 64.f);
        float q = 0.f;
#pragma unroll
        for (int j = 0; j < 8; ++j) { o[j] -= mean; q += o[j] * o[j]; }
        const float rs = rsqrtf(red8(q) * (1.f / 64.f) + 64e-5f);
        float rr[8], kk[8], vv[8], af[8], ab[8], gg[8];
        unpack8(*((const uint4*)(slotp(P, 17) + (size_t)r * 512) + lane), rr); unpack8(*((const uint4*)(slotp(P, 18) + (size_t)r * 512) + lane), kk);
        unpack8(*((const uint4*)(slotp(P, 19) + (size_t)r * 512) + lane), vv); unpack8(*((const uint4*)(slotp(P, 24) + (size_t)r * 512) + lane), af);
        unpack8(*((const uint4*)(slotp(P, 13) + (size_t)r * 512) + lane), ab); unpack8(*((const uint4*)(slotp(P, 14) + (size_t)r * 512) + lane), gg);
        float bs = 0.f;
#pragma unroll
        for (int j = 0; j < 8; ++j) { const float kd = kk[j] * (2.f + (af[j] + ab[j] - 2.f) * ka[j]); bs += rr[j] * kd * rk[j]; }
        bs = red8(bs);
        float y[8];
#pragma unroll
        for (int j = 0; j < 8; ++j) y[j] = (o[j] * rs * lg[j] + lb[j] + bs * vv[j]) * gg[j];
        const uint4 yv = pack8(y);
        *((uint4*)(slotp(P, 5) + (size_t)r * 512) + lane) = yv;
        if (layer == 0 && g < 2 && r >= TREAL) {
            bf16_t* sd = (bf16_t*)(P.ws + WS_SIDE) + (size_t)g * 4 * 64 * 512 + (size_t)(r - TREAL) * 512;
#pragma unroll
            for (int k = 0; k < 3; ++k) *((uint4*)(sd + (size_t)k * 64 * 512) + lane) = *((const uint4*)(slotp(P, 2 + k) + (size_t)r * 512) + lane);
            *((uint4*)(sd + (size_t)3 * 64 * 512) + lane) = yv; }
    }
    if (layer == 0 && g == 2) {
        for (int m2 = gw; m2 < 128; m2 += ngw) { const bf16_t* sd = (const bf16_t*)(P.ws + WS_SIDE) + (size_t)(m2 >> 6) * 4 * 64 * 512 + (size_t)(m2 & 63) * 512;
#pragma unroll
            for (int k = 0; k < 4; ++k) *((uint4*)(slotp(P, 2 + k) + (size_t)(TG + m2) * 512) + lane) = *((const uint4*)(sd + (size_t)k * 64 * 512) + lane); }
    }
}
DEV void hg_gate(float x, float lbv, float& lg, float& kk) {
    const float e = __expf(-fabsf(x)); const float sp = 1.f / (1.f + e);
    const float s = x >= 0.f ? sp : e * sp, s1 = x >= 0.f ? e * sp : sp;
    const float f = fmaxf(lbv, 1e-20f) + (1.f - lbv) * s;
    lg = __logf(f); kk = (1.f - lbv) * s1; }
DEV float hg_lb(const Params& P, int layer, int dir, int col) {
    if (layer == 0) return 0.f;
    const float a = P.in[I_LBL][(dir * 2 + 0) * 512 + col], b = P.in[I_LBL][(dir * 2 + 1) * 512 + col];
    return 1.f / (1.f + __expf(a - b)); }
DEV int hg_row(int sl, int c, int j, bool& valid) { if (c == 0) { valid = j < 16; return TREAL + sl * 16 + j; } valid = true; return sl * 4096 + (c - 1) * 64 + j; }
DEV void hg_cumsum(float* Lb, float* Bt, float* Seg, int dir, int tid) {
    const int ch = tid & 127, seg = tid >> 7;
    float v[16];
#pragma unroll
    for (int i = 0; i < 16; ++i) v[i] = Lb[(seg * 16 + i) * 128 + ch];
    if (dir == 0) {
#pragma unroll
        for (int i = 1; i < 16; ++i) v[i] += v[i - 1];
        Seg[seg * 128 + ch] = v[15];
    } else {
#pragma unroll
        for (int i = 14; i >= 0; --i) v[i] += v[i + 1];
        Seg[seg * 128 + ch] = v[0];
    }
    __syncthreads();
    const float s0 = Seg[ch], s1 = Seg[128 + ch], s2 = Seg[256 + ch], s3 = Seg[384 + ch];
    float off;
    if (dir == 0) off = seg == 0 ? 0.f : seg == 1 ? s0 : seg == 2 ? s0 + s1 : s0 + s1 + s2;
    else off = seg == 3 ? 0.f : seg == 2 ? s3 : seg == 1 ? s3 + s2 : s3 + s2 + s1;
#pragma unroll
    for (int i = 0; i < 16; ++i) Lb[(seg * 16 + i) * 128 + ch] = v[i] + off;
    if (seg == 0) Bt[ch] = (s0 + s1) + (s2 + s3);
}
DEV void phase_hg1(const Params& P0, int layer, unsigned char* lds, int bid, int nb, int wv) {
    Params P = load_params(); asm volatile("" : "+s"(P.ws));
    float* Lb = (float*)lds; bf16_t* KlT = (bf16_t*)(lds + 32768); bf16_t* VT = (bf16_t*)(lds + 32768 + 18432); float* Bt = (float*)(lds + 69632); float* Seg = (float*)(lds + 70656);
    float* X = (float*)slotp(P, 17); float* DC = (float*)(P.ws + WS_DECAY);
    const int tid = launder_tid(wv), lane = tid & 63, w = __builtin_amdgcn_readfirstlane(tid >> 6), j = tid >> 3, c0 = (tid & 7) * 16, l15 = lane & 15, quad = lane >> 4;
    for (int unit = bid; unit < 32 * 65; unit += nb) {
        const int chain = unit / 65, c = unit - chain * 65, sl = chain >> 3, head = (chain >> 1) & 3, dir = chain & 1;
        bool valid; const int r = hg_row(sl, c, j, valid);
        float lg[16], kk[16]; uint4 vv[2] = {make_uint4(0, 0, 0, 0), make_uint4(0, 0, 0, 0)};
        if (valid) {
            float fr[16];
            const uint4* fp = (const uint4*)(slotp(P, 3 + dir) + (size_t)r * 512 + head * 128 + c0);
            unpack8(fp[0], fr); unpack8(fp[1], fr + 8);
            const uint4* vp = (const uint4*)(slotp(P, 5) + (size_t)r * 512 + head * 128 + c0); vv[0] = vp[0]; vv[1] = vp[1];
#pragma unroll
            for (int e = 0; e < 16; ++e) hg_gate(fr[e], hg_lb(P, layer, dir, head * 128 + c0 + e), lg[e], kk[e]);
        } else {
#pragma unroll
            for (int e = 0; e < 16; ++e) { lg[e] = 0.f; kk[e] = 0.f; } }
#pragma unroll
        for (int e = 0; e < 16; e += 4) *(f32x4*)(Lb + j * 128 + c0 + e) = (f32x4){lg[e], lg[e + 1], lg[e + 2], lg[e + 3]};
        __syncthreads();
        hg_cumsum(Lb, Bt, Seg, dir, tid);
        __syncthreads();
        float vf[16]; unpack8(vv[0], vf); unpack8(vv[1], vf + 8);
#pragma unroll
        for (int e = 0; e < 16; ++e) { const float kl = kk[e] * __expf(Bt[c0 + e] - Lb[j * 128 + c0 + e]);
            KlT[(c0 + e) * 72 + j] = (bf16_t)(pk2(kl, 0.f) & 0xffffu); VT[(c0 + e) * 72 + j] = (bf16_t)(__float_as_uint(vf[e]) >> 16); }
        if (tid < 128) DC[(size_t)(chain * 65 + c) * 128 + tid] = __expf(Bt[tid]);
        __syncthreads();
        f32x4 acc[8];
#pragma unroll
        for (int ct = 0; ct < 8; ++ct) acc[ct] = (f32x4){0.f, 0.f, 0.f, 0.f};
#pragma unroll
        for (int ks = 0; ks < 2; ++ks) { const bf16x8 a = *(const bf16x8*)(VT + (w * 16 + l15) * 72 + ks * 32 + quad * 8);
#pragma unroll
            for (int ct = 0; ct < 8; ++ct) { const bf16x8 b = *(const bf16x8*)(KlT + (ct * 16 + l15) * 72 + ks * 32 + quad * 8); acc[ct] = mfma16(a, b, acc[ct]); } }
        float* xo = X + (size_t)(chain * 65 + c) * 16384;
#pragma unroll
        for (int ct = 0; ct < 8; ++ct)
#pragma unroll
            for (int jj = 0; jj < 4; ++jj) xo[(w * 16 + quad * 4 + jj) * 128 + ct * 16 + l15] = acc[ct][jj];
        __syncthreads();
    }
}
DEV void phase_hg2(const Params& P0, int bid, int nb, int wv) {
    Params P = load_params(); asm volatile("" : "+s"(P.ws));
    const int gtid = bid * 512 + launder_tid(wv), gth = nb * 512;
    f32x4* X = (f32x4*)slotp(P, 17); const f32x4* DC = (const f32x4*)(P.ws + WS_DECAY);
    for (int e = gtid; e < 32 * 4096; e += gth) {
        const int chain = e >> 12, e4 = e & 4095, dir = chain & 1;
        f32x4 S = (f32x4){0.f, 0.f, 0.f, 0.f};
#pragma unroll 5
        for (int step = 0; step < 65; ++step) { const int c = dir ? 64 - step : step;
            const size_t idx = (size_t)(chain * 65 + c) * 4096 + e4;
            const f32x4 kv = X[idx]; const f32x4 dc = DC[(size_t)(chain * 65 + c) * 32 + (e4 & 31)];
            X[idx] = S; S = dc * S + kv; }
    }
}
DEV void phase_hg3(const Params& P0, int layer, unsigned char* lds, int bid, int nb, int wv) {
    Params P = load_params(); asm volatile("" : "+s"(P.ws));
    float* Lb = (float*)lds; bf16_t* Qs = (bf16_t*)(lds + 32768); bf16_t* Ks = (bf16_t*)(lds + 50176); bf16_t* Am = (bf16_t*)(lds + 67584);
    bf16_t* VT = (bf16_t*)(lds + 76800); bf16_t* Sb = (bf16_t*)(lds + 95232); float* Bt = (float*)(lds + 130048); float* Seg = (float*)(lds + 132096); float* Ost = (float*)lds;
    const float* X = (const float*)slotp(P, 17);
    const int tid = launder_tid(wv), lane = tid & 63, w = __builtin_amdgcn_readfirstlane(tid >> 6), j = tid >> 3, c0 = (tid & 7) * 16, l15 = lane & 15, quad = lane >> 4;
    const int tt = w >> 1, st0 = (w & 1) * 2, vt0 = (w & 1) * 4;
    const int cfirst = layer == 0 ? 0 : 1;
    const int ncb = 65 - cfirst;
    for (int unit = bid; unit < 16 * ncb; unit += nb) {
        const int sh = unit / ncb, c = unit - sh * ncb + cfirst, sl = sh >> 2, head = sh & 3;
        bool valid; const int r = hg_row(sl, c, j, valid);
        float q[16]; uint4 gv[2] = {make_uint4(0, 0, 0, 0), make_uint4(0, 0, 0, 0)};
        if (valid) {
            const uint4* qp = (const uint4*)(slotp(P, 2) + (size_t)r * 512 + head * 128 + c0); unpack8(qp[0], q); unpack8(qp[1], q + 8);
            const uint4* vp = (const uint4*)(slotp(P, 5) + (size_t)r * 512 + head * 128 + c0); float vf[16]; unpack8(vp[0], vf); unpack8(vp[1], vf + 8);
#pragma unroll
            for (int e = 0; e < 16; ++e) VT[(c0 + e) * 72 + j] = (bf16_t)(__float_as_uint(vf[e]) >> 16);
            const uint4* gp = (const uint4*)(slotp(P, 6) + (size_t)r * 512 + head * 128 + c0); gv[0] = gp[0]; gv[1] = gp[1];
        } else {
#pragma unroll
            for (int e = 0; e < 16; ++e) { q[e] = 0.f; VT[(c0 + e) * 72 + j] = 0; } }
        f32x4 accA[2], accO[4];
#pragma unroll
        for (int i = 0; i < 2; ++i) accA[i] = (f32x4){0.f, 0.f, 0.f, 0.f};
#pragma unroll
        for (int i = 0; i < 4; ++i) accO[i] = (f32x4){0.f, 0.f, 0.f, 0.f};
#pragma unroll 1
        for (int dir = 0; dir < 2; ++dir) {
            float lg[16], kk[16];
            if (valid) { float fr[16];
                const uint4* fp = (const uint4*)(slotp(P, 3 + dir) + (size_t)r * 512 + head * 128 + c0); unpack8(fp[0], fr); unpack8(fp[1], fr + 8);
#pragma unroll
                for (int e = 0; e < 16; ++e) hg_gate(fr[e], hg_lb(P, layer, dir, head * 128 + c0 + e), lg[e], kk[e]);
            } else {
#pragma unroll
                for (int e = 0; e < 16; ++e) { lg[e] = 0.f; kk[e] = 0.f; } }
#pragma unroll
            for (int e = 0; e < 16; e += 4) *(f32x4*)(Lb + j * 128 + c0 + e) = (f32x4){lg[e], lg[e + 1], lg[e + 2], lg[e + 3]};
            __syncthreads();
            hg_cumsum(Lb, Bt, Seg, dir, tid);
            __syncthreads();
            {
                float qs[16], ks[16];
#pragma unroll
                for (int e = 0; e < 16; ++e) { const float b = Lb[j * 128 + c0 + e], rf = Lb[32 * 128 + c0 + e]; qs[e] = q[e] * __expf(b - rf); ks[e] = kk[e] * __expf(rf - b); }
                *(uint4*)(Qs + j * 136 + c0) = pack8(qs); *(uint4*)(Qs + j * 136 + c0 + 8) = pack8(qs + 8);
                *(uint4*)(Ks + j * 136 + c0) = pack8(ks); *(uint4*)(Ks + j * 136 + c0 + 8) = pack8(ks + 8);
            }
            {
                const int chain = sl * 8 + head * 2 + dir; const f32x4* xs = (const f32x4*)(X + (size_t)(chain * 65 + c) * 16384 + (size_t)(tid >> 2) * 128 + (tid & 3) * 32);
#pragma unroll
                for (int i = 0; i < 4; ++i) { const f32x4 a = xs[2 * i], b = xs[2 * i + 1]; uint4 o; o.x = pk2(a[0], a[1]); o.y = pk2(a[2], a[3]); o.z = pk2(b[0], b[1]); o.w = pk2(b[2], b[3]);
                    *(uint4*)(Sb + (tid >> 2) * 136 + (tid & 3) * 32 + i * 8) = o; }
            }
            __syncthreads();
            {
                f32x4 t0 = (f32x4){0.f, 0.f, 0.f, 0.f}, t1 = t0;
#pragma unroll
                for (int k4 = 0; k4 < 4; ++k4) { const bf16x8 a = *(const bf16x8*)(Qs + (tt * 16 + l15) * 136 + k4 * 32 + quad * 8);
                    const bf16x8 b0 = *(const bf16x8*)(Ks + ((st0 + 0) * 16 + l15) * 136 + k4 * 32 + quad * 8); const bf16x8 b1 = *(const bf16x8*)(Ks + ((st0 + 1) * 16 + l15) * 136 + k4 * 32 + quad * 8);
                    t0 = mfma16(a, b0, t0); t1 = mfma16(a, b1, t1); }
#pragma unroll
                for (int jj = 0; jj < 4; ++jj) { const int t = tt * 16 + quad * 4 + jj, s0 = (st0 + 0) * 16 + l15, s1 = (st0 + 1) * 16 + l15;
                    const bool k0 = dir == 0 ? s0 <= t : s0 >= t, k1 = dir == 0 ? s1 <= t : s1 >= t;
                    accA[0][jj] += k0 ? t0[jj] : 0.f; accA[1][jj] += k1 ? t1[jj] : 0.f; }
            }
            __syncthreads();
            {   float qg[16];
#pragma unroll
                for (int e = 0; e < 16; ++e) qg[e] = q[e] * __expf(Lb[j * 128 + c0 + e]);
                *(uint4*)(Qs + j * 136 + c0) = pack8(qg); *(uint4*)(Qs + j * 136 + c0 + 8) = pack8(qg + 8); }
            __syncthreads();
#pragma unroll
            for (int k4 = 0; k4 < 4; ++k4) { const bf16x8 a = *(const bf16x8*)(Qs + (tt * 16 + l15) * 136 + k4 * 32 + quad * 8);
#pragma unroll
                for (int v4 = 0; v4 < 4; ++v4) { const bf16x8 b = *(const bf16x8*)(Sb + ((vt0 + v4) * 16 + l15) * 136 + k4 * 32 + quad * 8); accO[v4] = mfma16(a, b, accO[v4]); } }
            __syncthreads();
        }
#pragma unroll
        for (int s2 = 0; s2 < 2; ++s2)
#pragma unroll
            for (int jj = 0; jj < 4; ++jj) Am[(tt * 16 + quad * 4 + jj) * 72 + (st0 + s2) * 16 + l15] = (bf16_t)(pk2(accA[s2][jj], 0.f) & 0xffffu);
        __syncthreads();
#pragma unroll
        for (int ks = 0; ks < 2; ++ks) { const bf16x8 a = *(const bf16x8*)(Am + (tt * 16 + l15) * 72 + ks * 32 + quad * 8);
#pragma unroll
            for (int v4 = 0; v4 < 4; ++v4) { const bf16x8 b = *(const bf16x8*)(VT + ((vt0 + v4) * 16 + l15) * 72 + ks * 32 + quad * 8); accO[v4] = mfma16(a, b, accO[v4]); } }
#pragma unroll
        for (int v4 = 0; v4 < 4; ++v4)
#pragma unroll
            for (int jj = 0; jj < 4; ++jj) Ost[(tt * 16 + quad * 4 + jj) * 132 + (vt0 + v4) * 16 + l15] = accO[v4][jj];
        __syncthreads();
        {   float o[16], ss = 0.f;
#pragma unroll
            for (int e = 0; e < 16; ++e) { o[e] = Ost[j * 132 + c0 + e]; ss += o[e] * o[e]; }
            ss = red8(ss);
            const float rs = rsqrtf(ss * (1.f / 128.f) + 1e-6f);
            float gf[16]; unpack8(gv[0], gf); unpack8(gv[1], gf + 8);
#pragma unroll
            for (int e = 0; e < 16; ++e) { const float gg = gf[e]; o[e] = o[e] * rs * P.in[I_ONORM][layer * 512 + head * 128 + c0 + e] * (gg / (1.f + __expf(-gg))); }
            if (valid) { uint4* yp = (uint4*)(slotp(P, 2) + (size_t)r * 512 + head * 128 + c0); yp[0] = pack8(o); yp[1] = pack8(o + 8); }
        }
        __syncthreads();
    }
}
DEV void phase_vtrans(const Params& P0, unsigned char* lds, int bid, int nb, int wv) {
    Params P = load_params(); asm volatile("" : "+s"(P.ws));
    bf16_t* T = (bf16_t*)lds;
    const bf16_t* V = slotp(P, 12); bf16_t* VTg = slotp(P, 6);
    const int tid = launder_tid(wv);
    for (int unit = bid; unit < 4 * 65 * 8; unit += nb) {
        const int sl = unit / 520, rem = unit - sl * 520, pt = rem >> 3, vdt = rem & 7;
        { const int tok = tid >> 3, c8 = (tid & 7) * 8, p = pt * 64 + tok;
          uint4 v = make_uint4(0, 0, 0, 0);
          if (p < LSEQ) v = *(const uint4*)(V + (size_t)row_of(sl, p) * 512 + vdt * 64 + c8);
          *(uint4*)(T + tok * 72 + c8) = v; }
        __syncthreads();
        { const int vd = tid >> 3, t8 = (tid & 7) * 8;
          unsigned short e[8];
#pragma unroll
          for (int i = 0; i < 8; ++i) { const int pp = t8 + i; const int sp = (pp & ~12) | (((pp >> 2) & 1) << 3) | (((pp >> 3) & 1) << 2); e[i] = T[sp * 72 + vd]; }
          uint4 o; o.x = e[0] | ((unsigned)e[1] << 16); o.y = e[2] | ((unsigned)e[3] << 16); o.z = e[4] | ((unsigned)e[5] << 16); o.w = e[6] | ((unsigned)e[7] << 16);
          *(uint4*)(VTg + (size_t)(sl * 512 + vdt * 64 + vd) * 4160 + pt * 64 + t8) = o; }
        __syncthreads();
    }
}
DEV int crow(int r, int hi) { return (r & 3) + 8 * (r >> 2) + 4 * hi; }
typedef unsigned u32x4_t __attribute__((ext_vector_type(4)));
struct AttnStage { u32x4_t k0, k1, v0, v1; };
DEV void attn_stage_load(const Params& P, int sl, int head, int kt, int tid, AttnStage& st) {
    const bf16_t* Kg = slotp(P, 11); const bf16_t* VTg = slotp(P, 6);
    { const int ci = tid, krow = ci >> 4, kc = ci & 15; const int p = kt * 64 + krow; const int r = p < LSEQ ? row_of(sl, p) : 0; st.k0 = *(const u32x4_t*)(Kg + (size_t)r * 512 + head * 128 + kc * 8); }
    { const int ci = tid + 512, krow = ci >> 4, kc = ci & 15; const int p = kt * 64 + krow; const int r = p < LSEQ ? row_of(sl, p) : 0; st.k1 = *(const u32x4_t*)(Kg + (size_t)r * 512 + head * 128 + kc * 8); }
    { const int vi = tid, vrow = vi >> 3, vc = vi & 7; st.v0 = *(const u32x4_t*)(VTg + (size_t)(sl * 512 + head * 128 + vrow) * 4160 + kt * 64 + vc * 8); }
    { const int vi = tid + 512, vrow = vi >> 3, vc = vi & 7; st.v1 = *(const u32x4_t*)(VTg + (size_t)(sl * 512 + head * 128 + vrow) * 4160 + kt * 64 + vc * 8); }
}
DEV void attn_stage_store(unsigned char* buf, int tid, const AttnStage& st) {
    bf16_t* Kt = (bf16_t*)buf; bf16_t* Vt = (bf16_t*)(buf + 17408);
    { const int ci = tid, krow = ci >> 4, kc = ci & 15; *(u32x4_t*)(Kt + krow * 136 + kc * 8) = st.k0; }
    { const int ci = tid + 512, krow = ci >> 4, kc = ci & 15; *(u32x4_t*)(Kt + krow * 136 + kc * 8) = st.k1; }
    { const int vi = tid, vrow = vi >> 3, vc = vi & 7; *(u32x4_t*)(Vt + vrow * 72 + vc * 8) = st.v0; }
    { const int vi = tid + 512, vrow = vi >> 3, vc = vi & 7; *(u32x4_t*)(Vt + vrow * 72 + vc * 8) = st.v1; }
}
DEV void phase_attn(const Params& P0, int layer, unsigned char* lds, int bid, int nb, int wv) {
    Params P = load_params(); asm volatile("" : "+s"(P.ws));
    const int tid = launder_tid(wv), lane = tid & 63, w = __builtin_amdgcn_readfirstlane(tid >> 6), map = w >> 2, qsub = w & 3, qi = lane & 31, hi = lane >> 5;
    const float lam_init = layer == 0 ? 0.2f : 0.35550906759096934f;
    float lam;
    { const float* lp = P.in[I_LAM] + (size_t)layer * 256; float s1 = 0.f, s2 = 0.f;
      for (int i = 0; i < 64; ++i) { s1 += lp[i] * lp[64 + i]; s2 += lp[128 + i] * lp[192 + i]; }
      lam = __expf(s1) - __expf(s2) + lam_init; }
    const int nqb = layer == 0 ? 33 : 32;
    float* Ex = (float*)lds;
    const bool xmap = (nb & 7) == 0;
    const int ustart = xmap ? (bid >> 3) : bid, ustep = xmap ? (nb >> 3) : nb, uend = xmap ? 2 * nqb : 16 * nqb;
    for (int unit = ustart; unit < uend; unit += ustep) {
        const int sh = xmap ? 2 * (bid & 7) + unit / nqb : unit / nqb, qb = unit % nqb, sl = sh >> 2, head = sh & 3;
        const int qrow0 = qb < 32 ? sl * 4096 + qb * 128 : TREAL + sl * 16; const int nvalid = qb < 32 ? 128 : 16;
        bf16x8 Qf[4];
        { const bf16_t* qp = slotp(P, 10) + (size_t)(qrow0 + qsub * 32 + qi) * 512 + head * 128 + map * 64 + hi * 8;
#pragma unroll
          for (int ds = 0; ds < 4; ++ds) Qf[ds] = *(const bf16x8*)(qp + ds * 16); }
        AttnStage st;
        attn_stage_load(P, sl, head, 0, tid, st); attn_stage_store(lds, tid, st); attn_stage_load(P, sl, head, 1, tid, st);
        __syncthreads();
        f32x16 O[4];
#pragma unroll
        for (int v = 0; v < 4; ++v)
#pragma unroll
            for (int r = 0; r < 16; ++r) O[v][r] = 0.f;
        float m_run = -INFINITY, l_run = 0.f;
#pragma unroll 1
        for (int kt = 0; kt < 65; ++kt) {
            if (kt + 1 < 65) attn_stage_store(lds + ((kt + 1) & 1) * 35840, tid, st);
            if (kt + 2 < 65) attn_stage_load(P, sl, head, kt + 2, tid, st);
            const unsigned char* buf = lds + (kt & 1) * 35840;
            const bf16_t* Kb = (const bf16_t*)buf; const bf16_t* Vb = (const bf16_t*)(buf + 17408);
            f32x16 S0, S1;
#pragma unroll
            for (int r = 0; r < 16; ++r) { S0[r] = 0.f; S1[r] = 0.f; }
#pragma unroll
            for (int ds = 0; ds < 4; ++ds) {
                const bf16x8 a0 = *(const bf16x8*)(Kb + qi * 136 + map * 64 + ds * 16 + hi * 8);
                const bf16x8 a1 = *(const bf16x8*)(Kb + (32 + qi) * 136 + map * 64 + ds * 16 + hi * 8);
                S0 = mfma32(a0, Qf[ds], S0); S1 = mfma32(a1, Qf[ds], S1); }
            if (kt == 64) {
#pragma unroll
                for (int r = 0; r < 16; ++r) { if (crow(r, hi) >= 16) S0[r] = -INFINITY; S1[r] = -INFINITY; } }
            float mx = -INFINITY;
#pragma unroll
            for (int r = 0; r < 16; ++r) mx = fmaxf(mx, fmaxf(S0[r], S1[r]));
            { const auto sw = __builtin_amdgcn_permlane32_swap(__float_as_uint(mx), __float_as_uint(mx), false, false); mx = fmaxf(__uint_as_float(sw[0]), __uint_as_float(sw[1])); }
            const float m_new = fmaxf(m_run, mx); const float alpha = __builtin_amdgcn_exp2f(m_run - m_new); m_run = m_new;
            float ps = 0.f;
#pragma unroll
            for (int r = 0; r < 16; ++r) { S0[r] = __builtin_amdgcn_exp2f(S0[r] - m_new); S1[r] = __builtin_amdgcn_exp2f(S1[r] - m_new); ps += S0[r] + S1[r]; }
            l_run = l_run * alpha + ps;
            if (__builtin_amdgcn_ballot_w64(alpha != 1.0f) != 0ull) {
#pragma unroll
                for (int v = 0; v < 4; ++v)
#pragma unroll
                    for (int r = 0; r < 16; ++r) O[v][r] *= alpha; }
            bf16x8 pf[2][2];
#pragma unroll
            for (int half = 0; half < 2; ++half) {
                uint4 a, b;
                a.x = pk2(S0[half * 8 + 0], S0[half * 8 + 1]); a.y = pk2(S0[half * 8 + 2], S0[half * 8 + 3]); a.z = pk2(S0[half * 8 + 4], S0[half * 8 + 5]); a.w = pk2(S0[half * 8 + 6], S0[half * 8 + 7]);
                b.x = pk2(S1[half * 8 + 0], S1[half * 8 + 1]); b.y = pk2(S1[half * 8 + 2], S1[half * 8 + 3]); b.z = pk2(S1[half * 8 + 4], S1[half * 8 + 5]); b.w = pk2(S1[half * 8 + 6], S1[half * 8 + 7]);
                pf[0][half] = __builtin_bit_cast(bf16x8, a); pf[1][half] = __builtin_bit_cast(bf16x8, b); }
#pragma unroll
            for (int v = 0; v < 4; ++v)
#pragma unroll
                for (int sub = 0; sub < 2; ++sub)
#pragma unroll
                    for (int half = 0; half < 2; ++half) {
                        const bf16x8 av = *(const bf16x8*)(Vb + (v * 32 + qi) * 72 + sub * 32 + half * 16 + hi * 8);
                        O[v] = mfma32(av, pf[sub][half], O[v]); }
            __syncthreads();
        }
        const float l_tot = l_run + __shfl_xor(l_run, 32); const float inv = 1.0f / l_tot;
        if (map == 1) {
#pragma unroll
            for (int v = 0; v < 4; ++v)
#pragma unroll
                for (int r = 0; r < 16; ++r) Ex[(qsub * 32 + qi) * 132 + v * 32 + crow(r, hi)] = O[v][r] * inv; }
        __syncthreads();
        if (map == 0) {
            float ss = 0.f;
#pragma unroll
            for (int v = 0; v < 4; ++v)
#pragma unroll
                for (int r = 0; r < 16; ++r) { const float o = O[v][r] * inv - lam * Ex[(qsub * 32 + qi) * 132 + v * 32 + crow(r, hi)]; O[v][r] = o; ss += o * o; }
            ss += __shfl_xor(ss, 32);
            const float rs = rsqrtf(ss * (1.f / 128.f) + 1e-5f) * (1.f - lam_init);
            if (qsub * 32 + qi < nvalid) {
                bf16_t* yp = slotp(P, 4) + (size_t)(qrow0 + qsub * 32 + qi) * 512 + head * 128;
#pragma unroll
                for (int v = 0; v < 4; ++v)
#pragma unroll
                    for (int rg = 0; rg < 4; ++rg) { const int vd0 = v * 32 + 8 * rg + 4 * hi; const f32x4 gg = *(const f32x4*)(P.in[I_SUBLN] + layer * 128 + vd0);
                        uint2 o; o.x = pk2(O[v][rg * 4 + 0] * rs * gg[0], O[v][rg * 4 + 1] * rs * gg[1]); o.y = pk2(O[v][rg * 4 + 2] * rs * gg[2], O[v][rg * 4 + 3] * rs * gg[3]);
                        *(uint2*)(yp + vd0) = o; } }
        }
        __syncthreads();
    }
}
DEV float dpp_f(float x, const int ctrl) { return x; }
template <int CTRL> DEV float dppmov(float x) { return __builtin_bit_cast(float, __builtin_amdgcn_update_dpp(0, __builtin_bit_cast(int, x), CTRL, 0xf, 0xf, true)); }
DEV float sum16(float x) { x += dppmov<0xB1>(x); x += dppmov<0x4E>(x); x += dppmov<0x141>(x); x += dppmov<0x140>(x); return x; }
constexpr int RW_CH = 16, RW_BUF_F = 5120 + 256 + 4096, RW_BUFB = RW_BUF_F * 4;
struct RwRegs { u32x4_t r, k, kk, e, a, v; };
DEV void unpack8v(const u32x4_t w, float* f) { unpack8(make_uint4(w.x, w.y, w.z, w.w), f); }
DEV void rw_stage_load(const Params& P, RwRegs& g, int sl, int head, int dir, int qr, int ck, int t) {
    if (t < 128) { const int step = t >> 3, ch8 = (t & 7) * 8, sidx = ck * RW_CH + step;
        if (sidx < LSEQ) { const int p = dir ? LSEQ - 1 - sidx : sidx; const size_t ro = (size_t)row_of(sl, p) * 512 + head * 64 + ch8;
            g.r = *(const u32x4_t*)(slotp(P, 17) + ro); g.k = *(const u32x4_t*)(slotp(P, 18) + ro); g.kk = *(const u32x4_t*)(slotp(P, 20) + ro);
            g.e = *(const u32x4_t*)(slotp(P, 22 + dir) + ro); g.a = *(const u32x4_t*)(slotp(P, dir == 0 ? 24 : 13) + ro); } }
    if (t < 32) { const int tt = t, s2 = tt >> 1, r8 = (tt & 1) * 8, si2 = ck * RW_CH + s2;
        if (si2 < LSEQ) { const int p2 = dir ? LSEQ - 1 - si2 : si2; g.v = *(const u32x4_t*)(slotp(P, 19) + (size_t)row_of(sl, p2) * 512 + head * 64 + qr * 16 + r8); } }
}
DEV void rw_stage_write(const Params& P, int layer, unsigned char* buf, const RwRegs& g, int head, int ck, int t) {
    float* Rr = (float*)buf; float* Ww = Rr + 1024; float* Kd = Ww + 1024; float* Kk = Kd + 1024; float* Bb = Kk + 1024; float* Vs = Bb + 1024;
    if (t < 128) { const int step = t >> 3, ch8 = (t & 7) * 8, sidx = ck * RW_CH + step;
        if (sidx < LSEQ) {
            float r[8], k[8], kk[8], e[8], a[8];
            unpack8v(g.r, r); unpack8v(g.k, k); unpack8v(g.kk, kk); unpack8v(g.e, e); unpack8v(g.a, a);
            float ww[8], kd[8], bb[8];
#pragma unroll
            for (int j = 0; j < 8; ++j) { ww[j] = __expf(-e[j]); kd[j] = k[j] * (1.f + (a[j] - 1.f) * P.in[I_KA][layer * 512 + head * 64 + ch8 + j]); bb[j] = kk[j] * a[j]; }
            const int o = step * 64 + ch8;
            *(f32x4*)(Rr + o) = (f32x4){r[0], r[1], r[2], r[3]}; *(f32x4*)(Rr + o + 4) = (f32x4){r[4], r[5], r[6], r[7]};
            *(f32x4*)(Ww + o) = (f32x4){ww[0], ww[1], ww[2], ww[3]}; *(f32x4*)(Ww + o + 4) = (f32x4){ww[4], ww[5], ww[6], ww[7]};
            *(f32x4*)(Kd + o) = (f32x4){kd[0], kd[1], kd[2], kd[3]}; *(f32x4*)(Kd + o + 4) = (f32x4){kd[4], kd[5], kd[6], kd[7]};
            *(f32x4*)(Kk + o) = (f32x4){kk[0], kk[1], kk[2], kk[3]}; *(f32x4*)(Kk + o + 4) = (f32x4){kk[4], kk[5], kk[6], kk[7]};
            *(f32x4*)(Bb + o) = (f32x4){bb[0], bb[1], bb[2], bb[3]}; *(f32x4*)(Bb + o + 4) = (f32x4){bb[4], bb[5], bb[6], bb[7]};
        } }
    if (t < 32) { const int tt = t, s2 = tt >> 1, r8 = (tt & 1) * 8, si2 = ck * RW_CH + s2;
        if (si2 < LSEQ) { float v[8]; unpack8v(g.v, v);
            *(f32x4*)(Vs + s2 * 16 + r8) = (f32x4){v[0], v[1], v[2], v[3]}; *(f32x4*)(Vs + s2 * 16 + r8 + 4) = (f32x4){v[4], v[5], v[6], v[7]}; } }
}
DEV void rw_flush(const Params& P, const unsigned char* buf, int sl, int head, int dir, int qr, int ck, int t) {
    if (t >= 160 && t < 192) { const float* Op = (const float*)buf + 5376; const int tt = t - 160, s2 = tt >> 1, r8 = (tt & 1) * 8, sidx = ck * RW_CH + s2;
        if (sidx < LSEQ) { const int p = dir ? LSEQ - 1 - sidx : sidx; float o[8];
#pragma unroll
            for (int j = 0; j < 8; ++j) { const int row = r8 + j; const f32x4* q = (const f32x4*)(Op + s2 * 256 + (row >> 2) * 64 + (row & 3) * 16);
                const f32x4 a = q[0], b = q[1], c = q[2], d = q[3];
                o[j] = ((a[0] + a[1]) + (a[2] + a[3])) + ((b[0] + b[1]) + (b[2] + b[3])) + (((c[0] + c[1]) + (c[2] + c[3])) + ((d[0] + d[1]) + (d[2] + d[3]))); }
            *(uint4*)(slotp(P, 15 + dir) + (size_t)row_of(sl, p) * 512 + head * 64 + qr * 16 + r8) = pack8(o); } }
}
DEV void phase_rw_scan(const Params& P0, int layer, unsigned char* lds, int bid, int nb, int wv) {
    Params P = load_params(); asm volatile("" : "+s"(P.ws));
    const int tid = launder_tid(wv), lane = tid & 63, w = __builtin_amdgcn_readfirstlane(tid >> 6), li = lane & 15, rl = (w & 3) * 4 + (lane >> 4);
    constexpr int NCK = (LSEQ + RW_CH - 1) / RW_CH;
    typedef float f32x2 __attribute__((ext_vector_type(2)));
    for (int unit = bid; unit < 256; unit += nb) {
        const int sl = unit >> 6, head = (unit >> 3) & 7, dir = (unit >> 2) & 1, qr = unit & 3;
        f32x2 SA = (f32x2){0.f, 0.f}, SB = (f32x2){0.f, 0.f};
        RwRegs g; g.r = g.k = g.kk = g.e = g.a = g.v = (u32x4_t){0u, 0u, 0u, 0u};
        if (w >= 4) { rw_stage_load(P, g, sl, head, dir, qr, 0, tid - 256); rw_stage_write(P, layer, lds, g, head, 0, tid - 256); rw_stage_load(P, g, sl, head, dir, qr, 1, tid - 256); }
        __syncthreads();
#pragma unroll 1
        for (int ck = 0; ck < NCK; ++ck) {
            unsigned char* buf = lds + (ck & 1) * RW_BUFB;
            if (w >= 4) {
                if (ck + 1 < NCK) rw_stage_write(P, layer, lds + ((ck + 1) & 1) * RW_BUFB, g, head, ck + 1, tid - 256);
                if (ck + 2 < NCK) rw_stage_load(P, g, sl, head, dir, qr, ck + 2, tid - 256);
                if (ck > 0) rw_flush(P, lds + ((ck - 1) & 1) * RW_BUFB, sl, head, dir, qr, ck - 1, tid - 256);
            } else {
                const float* Rr = (const float*)buf + li * 4; const float* Vs = (const float*)buf + 5120 + rl; float* Op = (float*)buf + 5376 + w * 64 + lane;
                const int ns = (LSEQ - ck * RW_CH) < RW_CH ? (LSEQ - ck * RW_CH) : RW_CH;
                f32x4 rr = *(const f32x4*)(Rr), ww = *(const f32x4*)(Rr + 1024), kd = *(const f32x4*)(Rr + 2048), kk = *(const f32x4*)(Rr + 3072), bb = *(const f32x4*)(Rr + 4096); float vv = Vs[0];
#pragma unroll 2
                for (int i = 0; i < ns; ++i) {
                    const int in = i < RW_CH - 1 ? i + 1 : RW_CH - 1;
                    const f32x4 rr_n = *(const f32x4*)(Rr + in * 64), ww_n = *(const f32x4*)(Rr + 1024 + in * 64), kd_n = *(const f32x4*)(Rr + 2048 + in * 64);
                    const f32x4 kk_n = *(const f32x4*)(Rr + 3072 + in * 64), bb_n = *(const f32x4*)(Rr + 4096 + in * 64); const float vv_n = Vs[in * 16];
                    f32x2 p = SA * (f32x2){kk[0], kk[1]}; p = __builtin_elementwise_fma(SB, (f32x2){kk[2], kk[3]}, p);
                    const f32x2 vv2 = (f32x2){vv, vv};
                    const f32x2 ta = vv2 * (f32x2){kd[0], kd[1]}, tb = vv2 * (f32x2){kd[2], kd[3]};
                    const float sa = -sum16(p[0] + p[1]);
                    const f32x2 sa2 = (f32x2){sa, sa};
                    SA = __builtin_elementwise_fma(SA, (f32x2){ww[0], ww[1]}, __builtin_elementwise_fma(sa2, (f32x2){bb[0], bb[1]}, ta));
                    SB = __builtin_elementwise_fma(SB, (f32x2){ww[2], ww[3]}, __builtin_elementwise_fma(sa2, (f32x2){bb[2], bb[3]}, tb));
                    f32x2 q = SA * (f32x2){rr[0], rr[1]}; q = __builtin_elementwise_fma(SB, (f32x2){rr[2], rr[3]}, q);
                    Op[i * 256] = q[0] + q[1];
                    rr = rr_n; ww = ww_n; kd = kd_n; kk = kk_n; bb = bb_n; vv = vv_n;
                }
            }
            __syncthreads();
        }
        if (w >= 4) rw_flush(P, lds + ((NCK - 1) & 1) * RW_BUFB, sl, head, dir, qr, NCK - 1, tid - 256);
        __syncthreads();
    }
}
#define LAS __attribute__((address_space(3)))
#define XB_TMO      128
#define XB_XCNT(j)  (256  + 64 * (j))
#define XB_XSUB(j)  (1280 + 64 * (j))
#define XB_XGEN(j)  (2304 + 64 * (j))
#define XB_TOP      3328
#define XB_TOPGEN   3392
#define XCD_BAR_WORDS 3456
#define XB_SPIN_CAP (1u << 18)

__device__ __forceinline__ unsigned xb_ld(unsigned* p)              { return __hip_atomic_load(p, __ATOMIC_RELAXED, __HIP_MEMORY_SCOPE_AGENT); }
__device__ __forceinline__ unsigned xb_add(unsigned* p, unsigned v) { return __hip_atomic_fetch_add(p, v, __ATOMIC_RELAXED, __HIP_MEMORY_SCOPE_AGENT); }
__device__ __forceinline__ unsigned xb_xcc_id() { return (unsigned)__builtin_amdgcn_s_getreg((3 << 11) | 20) & 0xFu; }
#define XB_SPIN(cond, bar) do { unsigned _sp = 0; while (cond) { __builtin_amdgcn_s_sleep(1); \
    if ((++_sp & 255u) == 0u) { if (xb_ld(&(bar)[XB_TMO])) break; if (_sp > XB_SPIN_CAP) { atomicAdd(&(bar)[XB_TMO], 1u); break; } } } } while (0)

struct XcdBarrier {
    unsigned* bar; unsigned x;
    volatile LAS unsigned* st;
};

__device__ __forceinline__ XcdBarrier xcd_barrier_post(unsigned* bar, volatile LAS unsigned* st, int wv) {
    XcdBarrier b; b.bar = bar; b.x = xb_xcc_id(); b.st = st;
    if (launder_tid(wv) == 0) (void)xb_add(&bar[XB_XCNT(b.x)], 1u);
    return b;
}
__device__ __forceinline__ void xcd_barrier_complete(unsigned* bar, unsigned x, unsigned& nloc, unsigned& nx) {
    const unsigned G = gridDim.x * gridDim.y * gridDim.z;
    unsigned sum, cnt, mine, sp = 0u;
    for (;;) {
        sum = 0u; cnt = 0u; mine = 0u;
#pragma unroll
        for (unsigned j = 0; j < 16; ++j) { const unsigned c = xb_ld(&bar[XB_XCNT(j)]); sum += c; cnt += (c > 0u) ? 1u : 0u; mine = (j == x) ? c : mine; }
        if (sum == G) break;
        __builtin_amdgcn_s_sleep(1);
        if ((++sp & 255u) == 0u) { if (xb_ld(&bar[XB_TMO])) break; if (sp > XB_SPIN_CAP) { atomicAdd(&bar[XB_TMO], 1u); break; } }
    }
    nloc = mine > 0u ? mine : 1u; nx = cnt > 0u ? cnt : 1u;
}

__device__ __forceinline__ void xcd_barrier(const XcdBarrier& b, int wv) {
    asm volatile("s_waitcnt vmcnt(0)" ::: "memory");
    __syncthreads();
    if (launder_tid(wv) == 0) {
        unsigned* bar = b.bar;
        __builtin_amdgcn_s_waitcnt(0);
        unsigned nloc = b.st[0], nx = b.st[1];
        if (nloc == 0u) { xcd_barrier_complete(bar, b.x, nloc, nx); b.st[0] = nloc; b.st[1] = nx; }
        const unsigned old = xb_add(&bar[XB_XSUB(b.x)], 1u);
        const unsigned gen = old / nloc;
        if (old + 1u == (gen + 1u) * nloc) {
            __builtin_amdgcn_fence(__ATOMIC_RELEASE, "agent");
            asm volatile("s_waitcnt vmcnt(0)" ::: "memory");
            const unsigned og = xb_add(&bar[XB_TOP], 1u);
            const unsigned tg = og / nx;
            if (og + 1u == (tg + 1u) * nx) xb_add(&bar[XB_TOPGEN], 1u);
            else XB_SPIN(xb_ld(&bar[XB_TOPGEN]) == tg, bar);
            __builtin_amdgcn_fence(__ATOMIC_ACQUIRE, "agent");
            xb_add(&bar[XB_XGEN(b.x)], 1u);
            asm volatile("s_waitcnt vmcnt(0)" ::: "memory");
        } else {
            XB_SPIN(xb_ld(&bar[XB_XGEN(b.x)]) == gen, bar);
            __builtin_amdgcn_fence(__ATOMIC_ACQUIRE, "agent");
            asm volatile("s_waitcnt vmcnt(0)" ::: "memory");
        }
    }
    __syncthreads();
}

__global__ void __launch_bounds__(512) mega_fwd(Params P) {
    extern __shared__ __attribute__((aligned(16))) unsigned char lds[];
    cg::grid_group grid = cg::this_grid();
    const int bid = blockIdx.x, nb = gridDim.x; const int wv = __builtin_amdgcn_readfirstlane(threadIdx.x >> 6);
    volatile LAS unsigned* MISC = (volatile LAS unsigned*)((LAS unsigned char*)lds + 131072 + 256);
    if (threadIdx.x < 4) MISC[threadIdx.x] = 0u;
    __syncthreads();
    XcdBarrier xbar;
    { Params Pb = load_params(); xbar = xcd_barrier_post((unsigned*)Pb.ws, MISC, wv); }
#define GSYNC() xcd_barrier(xbar, wv)
    PG8_LAS unsigned char* ldsl = (PG8_LAS unsigned char*)lds;
#pragma unroll 1
    for (int layer_ = 0; layer_ < 2; ++layer_) {
        phase_weights(P, lsd(layer_), lds, bid, nb, wv);
        grid.sync();
#pragma unroll 1
        for (int g_ = 0; g_ < NGRP; ++g_) {
            #define Mpost ((lsd(layer_) == 0 && lsd(g_) == 2) ? TGP : TREAL)
#define NVALID ((lsd(layer_) == 0 && lsd(g_) == 2) ? TG + 128 : TG)
            phase_rmsnorm(P, lsd(g_), lsd(layer_) == 0, I_NMIX, lsd(layer_), TGP, NVALID, bid, nb, wv);
            if (PROBE == 5) { phase_rmsnorm(P, lsd(g_), lsd(layer_) == 0, I_NMIX, lsd(layer_), TGP, NVALID, bid, nb, wv); }
            GSYNC();
            if (PROBE == 6) { for (int q_ = 0; q_ < 15; ++q_) GSYNC(); }
            for (int rep_ = 0; rep_ < (PROBE == 3 ? 2 : 1); ++rep_)
            { Params Pl = load_params(); asm volatile("" : "+s"(Pl.ws)); pg8::bf16_t* W = (pg8::bf16_t*)(Pl.ws + WS_W); pg8::Gemm gm{slotp(Pl, 0), W + WO_IN, TGP, 7680, 1024, 0, 0}; pg8::StaticOrder S; S.init(TGP, 7680, nb, bid);
              pg8::EpiBf<0> E{slotp(Pl, 2), 512, SLOT_E};
              pg8::gemm_phase<pg8::EpiBf<0>, pg8::StaticOrder, true, true>(ldsl, gm, S, E, wv); }
            GSYNC();
            phase_da_prep(P, lsd(layer_), bid, nb, wv);
            phase_hg1(P, lsd(layer_), lds, bid, nb, wv);
            if (PROBE == 4) { phase_hg1(P, lsd(layer_), lds, bid, nb, wv); }
            GSYNC();
            phase_hg2(P, bid, nb, wv);
            GSYNC();
            phase_hg3(P, lsd(layer_), lds, bid, nb, wv);
            GSYNC();
            phase_conv(P, lsd(layer_), bid, nb, wv);
            if (PROBE == 5) { phase_conv(P, lsd(layer_), bid, nb, wv); }
            phase_vtrans(P, lds, bid, nb, wv);
            if (PROBE == 5) { phase_vtrans(P, lds, bid, nb, wv); }
            phase_rw_prep(P, lsd(layer_), bid, nb, wv);
            if (PROBE == 5) { phase_rw_prep(P, lsd(layer_), bid, nb, wv); }
            GSYNC();
            { Params Pl = load_params(); asm volatile("" : "+s"(Pl.ws)); pg8::bf16_t* W = (pg8::bf16_t*)(Pl.ws + WS_W); pg8::Gemm gm{slotp(Pl, 21), W + WO_LR, TGP, 2560, 384, 0, 0}; pg8::StaticOrder S; S.init(TGP, 2560, nb, bid);
              pg8::EpiLR E{slotp(Pl, 22), slotp(Pl, 23), slotp(Pl, 24), slotp(Pl, 13), slotp(Pl, 14), Pl.in[I_W0] + lsd(layer_) * 1024, Pl.in[I_A0] + lsd(layer_) * 1024};
              pg8::gemm_phase<pg8::EpiLR, pg8::StaticOrder, true, true>(ldsl, gm, S, E, wv); }
            phase_attn(P, lsd(layer_), lds, bid, nb, wv);
            if (PROBE == 2) { phase_attn(P, lsd(layer_), lds, bid, nb, wv); }
            GSYNC();
            phase_rw_scan(P, lsd(layer_), lds, bid, nb, wv);
            if (PROBE == 1) { phase_rw_scan(P, lsd(layer_), lds, bid, nb, wv); }
            GSYNC();
            phase_rw_post(P, lsd(layer_), lsd(g_), lsd(layer_) == 0 ? TG : TREAL, bid, nb, wv);
            if (PROBE == 5) { phase_rw_post(P, lsd(layer_), lsd(g_), lsd(layer_) == 0 ? TG : TREAL, bid, nb, wv); }
            GSYNC();
            { Params Pl = load_params(); asm volatile("" : "+s"(Pl.ws)); pg8::bf16_t* W = (pg8::bf16_t*)(Pl.ws + WS_W); pg8::Gemm gm{slotp(Pl, 2), W + WO_BP, Mpost, 4096, 512, 4, SLOT_B}; pg8::StaticOrder S; S.init(Mpost, 4096, nb, bid);
              pg8::EpiBf<0> E{slotp(Pl, 6), 4096, 0};
              pg8::gemm_phase<pg8::EpiBf<0>, pg8::StaticOrder, true, true>(ldsl, gm, S, E, wv); }
            GSYNC();
            { Params Pl = load_params(); asm volatile("" : "+s"(Pl.ws)); pg8::bf16_t* W = (pg8::bf16_t*)(Pl.ws + WS_W); pg8::Gemm gm{slotp(Pl, 0), W + WO_G, Mpost, 4096, 1024, 0, 0}; pg8::StaticOrder S; S.init(Mpost, 4096, nb, bid);
              pg8::EpiGate E{slotp(Pl, 6), slotp(Pl, 14)};
              pg8::gemm_phase<pg8::EpiGate, pg8::StaticOrder, true, true>(ldsl, gm, S, E, wv); }
            GSYNC();
            { Params Pl = load_params(); asm volatile("" : "+s"(Pl.ws)); pg8::bf16_t* W = (pg8::bf16_t*)(Pl.ws + WS_W); pg8::Gemm gm{slotp(Pl, 14), W + WO_OUT, Mpost, 1024, 1024, 0, 0}; pg8::StaticOrder S; S.init(Mpost, 1024, nb, bid);
              pg8::EpiResid E{lsd(layer_) == 0 ? x_in_row(Pl, lsd(g_), 0) : (const float*)x_cur_row(Pl, lsd(g_), 0), lsd(layer_) == 0 ? Pl.in[I_META] : (const float*)nullptr, x_cur_row(Pl, lsd(g_), 0), (float*)(Pl.ws + WS_XMETA), lsd(g_), NVALID};
              pg8::gemm_phase<pg8::EpiResid, pg8::StaticOrder, true, true>(ldsl, gm, S, E, wv); }
            GSYNC();
            phase_rmsnorm(P, lsd(g_), false, I_NMLP, lsd(layer_), Mpost, NVALID, bid, nb, wv);
            if (PROBE == 5) { phase_rmsnorm(P, lsd(g_), false, I_NMLP, lsd(layer_), Mpost, NVALID, bid, nb, wv); }
            GSYNC();
            for (int rep_ = 0; rep_ < (PROBE == 7 ? 2 : 1); ++rep_)
            { Params Pl = load_params(); asm volatile("" : "+s"(Pl.ws)); pg8::bf16_t* W = (pg8::bf16_t*)(Pl.ws + WS_W); pg8::Gemm gm{slotp(Pl, 0), W + WO_1, Mpost, 4096, 1024, 0, 0}; pg8::StaticOrder S; S.init(Mpost, 4096, nb, bid);
              pg8::EpiBf<1> E{slotp(Pl, 6), 4096, 0};
              pg8::gemm_phase<pg8::EpiBf<1>, pg8::StaticOrder, true, true>(ldsl, gm, S, E, wv); }
            GSYNC();
            { Params Pl = load_params(); asm volatile("" : "+s"(Pl.ws)); pg8::bf16_t* W = (pg8::bf16_t*)(Pl.ws + WS_W); pg8::Gemm gm{slotp(Pl, 6), W + WO_2, Mpost, 1024, 4096, 0, 0}; pg8::StaticOrder S; S.init(Mpost, 1024, nb, bid);
              pg8::EpiResid E{(const float*)x_cur_row(Pl, lsd(g_), 0), (const float*)nullptr, x_cur_row(Pl, lsd(g_), 0), (float*)(Pl.ws + WS_XMETA), lsd(g_), NVALID};
              pg8::gemm_phase<pg8::EpiResid, pg8::StaticOrder, true, true>(ldsl, gm, S, E, wv); }
            GSYNC();
        }
    }
}

extern "C" void kernel_launch(void* const* d_in, const int* in_sizes, int n_in, void* d_out, int out_size, void* d_ws, size_t ws_size, hipStream_t stream) {
    static int grid = 0;
    if (grid == 0) {
        if (n_in != 29 || ws_size < WS_NEED) { fprintf(stderr, "kernel_launch: need 29 inputs and %zu bytes of workspace; got %d, %zu\n", (size_t)WS_NEED, n_in, ws_size); grid = -1; return; }
        int dev = 0, cus = 0, per_cu = 0;
        if (hipGetDevice(&dev) != hipSuccess || hipDeviceGetAttribute(&cus, hipDeviceAttributeMultiprocessorCount, dev) != hipSuccess) { grid = -1; return; }
        if (hipFuncSetAttribute((const void*)mega_fwd, hipFuncAttributeMaxDynamicSharedMemorySize, LDS_BYTES) != hipSuccess) { fprintf(stderr, "kernel_launch: hipFuncSetAttribute failed\n"); grid = -1; return; }
        if (hipOccupancyMaxActiveBlocksPerMultiprocessor(&per_cu, (const void*)mega_fwd, 512, LDS_BYTES) != hipSuccess || per_cu < 1) { fprintf(stderr, "kernel_launch: occupancy query says %d\n", per_cu); per_cu = 1; }
        (void)hipGetLastError();
        grid = cus;
    }
    if (grid < 0) return;
    if (hipMemsetAsync(d_ws, 0, 16384, stream) != hipSuccess) { fprintf(stderr, "kernel_launch: memset failed\n"); return; }
    Params p{};
    for (int i = 0; i < 29; ++i) p.in[i] = (const float*)d_in[i];
    p.out = (float*)d_out; p.ws = (unsigned char*)d_ws;
    void* args[] = {&p};
    hipError_t e = hipLaunchCooperativeKernel((const void*)mega_fwd, dim3(grid), dim3(512), args, LDS_BYTES, stream);
    if (e != hipSuccess) fprintf(stderr, "kernel_launch: cooperative launch failed: %s (grid %d)\n", hipGetErrorString(e), grid);
}
```

```cpp
#include <hip/hip_runtime.h>
#include <hip/hip_cooperative_groups.h>
#include <cstdio>
#include <cstdint>
namespace cg = cooperative_groups;
#define PROBE 0
#define DEV __device__ __forceinline__
__device__ __forceinline__ int lsd(int x) { asm volatile("" : "+s"(x)); return x; }
__device__ __forceinline__ int launder_tid(int wv) { int l; asm volatile("v_mbcnt_lo_u32_b32 %0, -1, 0\n\tv_mbcnt_hi_u32_b32 %0, -1, %0" : "=v"(l)); return wv * 64 + l; }
namespace pg8 {
#define PG8_LAS __attribute__((address_space(3)))
typedef unsigned short bf16_t;
typedef short bf16x8 __attribute__((ext_vector_type(8)));
typedef float f32x4 __attribute__((ext_vector_type(4)));
typedef unsigned u32x4 __attribute__((ext_vector_type(4)));
constexpr int BM = 256, BK = 64, HALF = 128, HTB = HALF * BK * 2  , STAGE_BYTES = 8 * HTB, NXCD = 8, WGM = 8;

__host__ __device__ __forceinline__ int lds_byte(int r, int c) { const int st = (r >> 4) * 2 + (c >> 5), rr = r & 15, cc = c & 31, ob = rr * 64 + cc * 2; return st * 1024 + (ob ^ (((ob >> 9) & 1) << 5)); }
__host__ __device__ __forceinline__ void stage_rc(int b, int& R, int& C) { const int st = b / 1024, sb = b % 1024, swz = sb ^ (((sb >> 9) & 1) << 5); R = (st >> 1) * 16 + swz / 64; C = (st & 1) * 32 + (swz % 64) / 2; }
__host__ __device__ __forceinline__ int perm32(int rho) { const int n = rho >> 4, i = rho & 15; return 8 * (i >> 2) + 4 * n + (i & 3); }

struct Unit { int pm, pn; };
struct Gemm { const bf16_t* A; const bf16_t* Bt; int M, N, K; int pn_per_ab; size_t ab_stride; };

struct StaticOrder {
    int nM, nN, nwg, G, c;
    __host__ __device__ void init(int M, int N, int G_, int c_) { nM = M / BM; nN = N / BM; nwg = nM * nN; G = G_; c = c_; }
    __host__ __device__ bool next(int i, Unit& u) const {
        const long L = (long)i * G + c; if (L >= nwg) return false;
        int wgid = (int)L; { const int q = nwg / NXCD, r = nwg % NXCD, xcd = wgid % NXCD, off = wgid / NXCD; wgid = (xcd < r ? xcd * (q + 1) : r * (q + 1) + (xcd - r) * q) + off; }
        const int nig = WGM * nN, gid = wgid / nig, fm = gid * WGM, gsz = (nM - fm) < WGM ? (nM - fm) : WGM;
        u.pm = fm + ((wgid % nig) % gsz); u.pn = (wgid % nig) / gsz; return true;
    }
    __device__ __forceinline__ void a_ready(const Unit&) const {}
    __device__ __forceinline__ void done(const Unit&) const {}
};

typedef float f32x2cv_t __attribute__((ext_vector_type(2))); typedef __bf16 bf16x2cv_t __attribute__((ext_vector_type(2)));
__device__ __forceinline__ unsigned cvt_pk_bf16(float lo, float hi) { const f32x2cv_t v = {lo, hi}; const bf16x2cv_t b = __builtin_convertvector(v, bf16x2cv_t); return __builtin_bit_cast(unsigned, b); }
typedef float f32x2 __attribute__((ext_vector_type(2)));
__device__ __forceinline__ float sigm(float x) { return __builtin_amdgcn_rcpf(1.0f + __expf(-x)); }
template <int ACT  > struct EpiBf {
    static constexpr bool PERM = true, AFTER_DRAIN = false;
    bf16_t* O; int ldc; size_t gstride;
    __device__ __forceinline__ void operator()(const f32x4 (&acc)[2][2][4][2], const Unit& u, int wr, int wc, int fr, int fq) const {
        const int row0 = u.pm * BM + wr * 64 + fr; int colt = u.pn * BM; bf16_t* base = O; int ld = ldc;
        if (gstride) { const int t = colt >> 9; colt &= 511; base += (size_t)t * gstride; ld = 512; }
        const int col0 = colt + wc * 32 + 8 * fq;
#pragma unroll
        for (int ai = 0; ai < 2; ++ai)
#pragma unroll
            for (int m = 0; m < 4; ++m) { bf16_t* rowp = base + (size_t)(row0 + ai * HALF + m * 16) * ld + col0;
#pragma unroll
                for (int bj = 0; bj < 2; ++bj) { f32x4 v0 = acc[ai][bj][m][0], v1 = acc[ai][bj][m][1];
                    if (ACT == 1) {
#pragma unroll
                        for (int i = 0; i < 4; ++i) { float a = fmaxf(v0[i], 0.f), b = fmaxf(v1[i], 0.f); v0[i] = a * a; v1[i] = b * b; } }
                    u32x4 w; w.x = cvt_pk_bf16(v0[0], v0[1]); w.y = cvt_pk_bf16(v0[2], v0[3]); w.z = cvt_pk_bf16(v1[0], v1[1]); w.w = cvt_pk_bf16(v1[2], v1[3]);
                    *(u32x4*)(rowp + bj * HALF) = w; } }
    }
};
struct EpiLR {
    static constexpr bool PERM = true, AFTER_DRAIN = false;
    bf16_t *s0, *s1, *s2, *s3, *s4; const float* w0; const float* a0;
    __device__ __forceinline__ void operator()(const f32x4 (&acc)[2][2][4][2], const Unit& u, int wr, int wc, int fr, int fq) const {
        const int row0 = u.pm * BM + wr * 64 + fr; const int colg = u.pn * BM; const int seg = colg >> 9; const int cb = colg & 511;
        bf16_t* base = seg == 0 ? s0 : seg == 1 ? s1 : seg == 2 ? s2 : seg == 3 ? s3 : s4;
        const int col0 = cb + wc * 32 + 8 * fq;
        const float* bsrc = seg < 2 ? w0 + seg * 512 : a0 + (seg & 1) * 512;
        const float sc = seg < 2 ? 0.6065306597f : 1.0f; const float bm = seg < 4 ? 1.f : 0.f; const bool act = seg < 4;
#pragma unroll
        for (int bj = 0; bj < 2; ++bj) {
            const f32x4 b0 = *(const f32x4*)(bsrc + col0 + bj * HALF) * bm, b1 = *(const f32x4*)(bsrc + col0 + bj * HALF + 4) * bm;
#pragma unroll
            for (int ai = 0; ai < 2; ++ai)
#pragma unroll
                for (int m = 0; m < 4; ++m) { bf16_t* rowp = base + (size_t)(row0 + ai * HALF + m * 16) * 512 + col0;
                    f32x4 v0 = acc[ai][bj][m][0] + b0, v1 = acc[ai][bj][m][1] + b1;
#pragma unroll
                    for (int i = 0; i < 4; ++i) { const float g0 = sc * sigm(v0[i]), g1 = sc * sigm(v1[i]); v0[i] = act ? g0 : v0[i]; v1[i] = act ? g1 : v1[i]; }
                    u32x4 w; w.x = cvt_pk_bf16(v0[0], v0[1]); w.y = cvt_pk_bf16(v0[2], v0[3]); w.z = cvt_pk_bf16(v1[0], v1[1]); w.w = cvt_pk_bf16(v1[2], v1[3]);
                    *(u32x4*)(rowp + bj * HALF) = w; __builtin_amdgcn_sched_barrier(0); }
        }
    }
};
struct EpiGate {
    static constexpr bool PERM = true, AFTER_DRAIN = false;
    const bf16_t* Pm; bf16_t* Mg;
    __device__ __forceinline__ void operator()(const f32x4 (&acc)[2][2][4][2], const Unit& u, int wr, int wc, int fr, int fq) const {
        const int row0 = u.pm * BM + wr * 64 + fr; const int ocol = u.pn * 64 + wc * 16 + fq * 4;
#pragma unroll
        for (int ai = 0; ai < 2; ++ai)
#pragma unroll
            for (int m = 0; m < 4; ++m) { const size_t row = (size_t)(row0 + ai * HALF + m * 16);
                float s0 = 0.f, s1 = 0.f, s2 = 0.f, s3 = 0.f;
#pragma unroll
                for (int bj = 0; bj < 2; ++bj)
#pragma unroll
                    for (int n = 0; n < 2; ++n) { const int br = bj * 2 + n;
                        const uint2 pw = *(const uint2*)(Pm + row * 4096 + br * 1024 + ocol);
                        const f32x4 a = acc[ai][bj][m][n];
                        s0 += sigm(a[0]) * __uint_as_float(pw.x << 16); s1 += sigm(a[1]) * __uint_as_float(pw.x & 0xffff0000u);
                        s2 += sigm(a[2]) * __uint_as_float(pw.y << 16); s3 += sigm(a[3]) * __uint_as_float(pw.y & 0xffff0000u); }
                uint2 o; o.x = cvt_pk_bf16(s0, s1); o.y = cvt_pk_bf16(s2, s3);
                *(uint2*)(Mg + row * 1024 + ocol) = o; }
    }
};
struct EpiResid {
    static constexpr bool PERM = true, AFTER_DRAIN = false;
    const float* om; const float* mt; float* nm; float* xmb; int g; int rlim;
    __device__ __forceinline__ void operator()(const f32x4 (&acc)[2][2][4][2], const Unit& u, int wr, int wc, int fr, int fq) const {
        const int row0 = u.pm * BM + wr * 64 + fr; const int col0 = u.pn * BM + wc * 32 + 8 * fq;
#pragma unroll
        for (int ai = 0; ai < 2; ++ai)
#pragma unroll
            for (int m = 0; m < 4; ++m) { const int r = row0 + ai * HALF + m * 16;
                if (r < rlim) {
                    const int mi = r - 16384;
                    float* dmeta = xmb + (size_t)(mi < 64 ? g * 64 + mi : ((mi >> 6) - 1) * 64 + (mi & 63)) * 1024;
                    const float* src = r < 16384 ? om + (size_t)r * 1024 : (mt ? mt + (size_t)(mi & 15) * 1024 : (const float*)dmeta);
                    float* dst = r < 16384 ? nm + (size_t)r * 1024 : dmeta;
#pragma unroll
                    for (int bj = 0; bj < 2; ++bj)
#pragma unroll
                        for (int n = 0; n < 2; ++n) { const int c = col0 + bj * HALF + 4 * n;
                            const f32x4 xo = *(const f32x4*)(src + c); *(f32x4*)(dst + c) = xo + acc[ai][bj][m][n]; } } }
    }
};
template <class Epi, class Sched, bool ALIGN_EPI = false, bool SP2 = false>
__device__ __forceinline__ void gemm_phase(PG8_LAS unsigned char* lds, const Gemm g, const Sched& S, const Epi& E, int wv) {
    const int tid = launder_tid(wv), wid = __builtin_amdgcn_readfirstlane(tid >> 6), lane = tid & 63, wr = wid >> 2, wc = wid & 3, fr = lane & 15, fq = lane >> 4;
    const int K = g.K, nt = K / BK;
    unsigned voffA[2], voffB[2];
#pragma unroll
    for (int i = 0; i < 2; ++i) { int R, C; stage_rc(tid * 16 + i * 8192, R, C); const int Rb = Epi::PERM ? ((R & ~31) + perm32(R & 31)) : R;
        voffA[i] = (unsigned)(R * K + C) * 2u; voffB[i] = (unsigned)(Rb * K + C) * 2u; }
    const size_t kstep = (size_t)(BK * 2);
    const size_t hstep = (size_t)HALF * K * 2;
    const size_t tstep = 2 * hstep;
    const unsigned ldsw = (unsigned)wid * 1024u;
    const int aoff = lds_byte(wr * 64 + fr, fq * 8), boff = lds_byte(wc * 32 + fr, fq * 8);
#define PG8_SA(b, h) (((b) * 2 + (h)) * HTB)
#define PG8_SB(b, h) ((4 + (b) * 2 + (h)) * HTB)
#define PG8_STAGE(bufoff, gbase, voff) do { _Pragma("unroll") for (int _i = 0; _i < 2; ++_i) \
        __builtin_amdgcn_global_load_lds((const unsigned*)((const char*)(gbase) + (voff)[_i]), (PG8_LAS unsigned*)(lds + (bufoff) + ldsw + _i * 8192), 16, 0, 0); } while (0)
#define PG8_LDA(dst, b, h) do { _Pragma("unroll") for (int m = 0; m < 4; ++m) _Pragma("unroll") for (int k = 0; k < 2; ++k) dst[m][k] = *(const PG8_LAS bf16x8*)(lds + PG8_SA(b, h) + aoff + m * 2048 + k * 1024); } while (0)
#define PG8_LDB(dst, b, h) do { _Pragma("unroll") for (int n = 0; n < 2; ++n) _Pragma("unroll") for (int k = 0; k < 2; ++k) dst[n][k] = *(const PG8_LAS bf16x8*)(lds + PG8_SB(b, h) + boff + n * 2048 + k * 1024); } while (0)
#define PG8_MMA(ai, bj, At, Bt) do { __builtin_amdgcn_s_setprio(1); _Pragma("unroll") for (int m = 0; m < 4; ++m) _Pragma("unroll") for (int n = 0; n < 2; ++n) _Pragma("unroll") for (int k = 0; k < 2; ++k) \
        acc[ai][bj][m][n] = __builtin_amdgcn_mfma_f32_16x16x32_bf16(Bt[n][k], At[m][k], acc[ai][bj][m][n], 0, 0, 0); __builtin_amdgcn_s_setprio(0); } while (0)
#define PG8_WAIT_V(n) asm volatile("s_waitcnt vmcnt(" #n ")" ::: "memory")
#define PG8_WAIT_L(n) asm volatile("s_waitcnt lgkmcnt(" #n ")" ::: "memory")
#define PG8_BAR __builtin_amdgcn_s_barrier()
#define PG8_SCHED __builtin_amdgcn_sched_barrier(0)
    Unit cur, nxt; int ui = 0;
    if (!S.next(0, cur)) return;
    f32x4 acc[2][2][4][2];
#pragma unroll
    for (int a = 0; a < 2; ++a)
#pragma unroll
        for (int b = 0; b < 2; ++b)
#pragma unroll
            for (int m = 0; m < 4; ++m)
#pragma unroll
                for (int n = 0; n < 2; ++n) { float z_ = 0.f; asm volatile("" : "+v"(z_)); acc[a][b][m][n] = (f32x4){z_, z_, z_, z_}; }
    bf16x8 At[4][2], B0[2][2], B1[2][2];
    const char* cA = (const char*)g.A + (g.pn_per_ab ? (size_t)(cur.pn / g.pn_per_ab) * g.ab_stride : (size_t)0) + (size_t)cur.pm * tstep; const char* cB = (const char*)g.Bt + (size_t)cur.pn * tstep;
    S.a_ready(cur);
    if constexpr (SP2) {
        PG8_STAGE(PG8_SB(0, 0), cB, voffB); PG8_STAGE(PG8_SB(0, 1), cB + hstep, voffB); PG8_STAGE(PG8_SA(0, 0), cA, voffA); PG8_STAGE(PG8_SA(0, 1), cA + hstep, voffA);
        if (wr == 1) PG8_BAR;
        PG8_WAIT_V(2); PG8_BAR;
        PG8_STAGE(PG8_SB(1, 0), cB + kstep, voffB); PG8_STAGE(PG8_SA(1, 0), cA + kstep, voffA); PG8_STAGE(PG8_SB(1, 1), cB + hstep + kstep, voffB);
        PG8_WAIT_V(6); PG8_BAR;
    } else {
        PG8_STAGE(PG8_SB(0, 0), cB, voffB); PG8_STAGE(PG8_SA(0, 0), cA, voffA); PG8_STAGE(PG8_SB(0, 1), cB + hstep, voffB); PG8_STAGE(PG8_SA(0, 1), cA + hstep, voffA);
        if (wr == 1) PG8_BAR;
        PG8_WAIT_V(4); PG8_BAR;
        PG8_STAGE(PG8_SB(1, 0), cB + kstep, voffB); PG8_STAGE(PG8_SA(1, 0), cA + kstep, voffA); PG8_STAGE(PG8_SB(1, 1), cB + hstep + kstep, voffB);
        PG8_WAIT_V(6); PG8_BAR;
    }
    for (;;) {
        const bool has_next = S.next(ui + 1, nxt);
        const char* nA = has_next ? (const char*)g.A + (g.pn_per_ab ? (size_t)(nxt.pn / g.pn_per_ab) * g.ab_stride : (size_t)0) + (size_t)nxt.pm * tstep : cA; const char* nB = has_next ? (const char*)g.Bt + (size_t)nxt.pn * tstep : cB;
#pragma unroll 1
        for (int t = 0; t < nt; t += 2) {
            const bool last = (t == nt - 2);
            const char* a1 = cA + (size_t)(t + 1) * kstep;
            const char* a2 = last ? nA : cA + (size_t)(t + 2) * kstep; const char* b2 = last ? nB : cB + (size_t)(t + 2) * kstep;
            const char* a3 = a2 + kstep; const char* b3 = b2 + kstep;
            if (last && has_next) S.a_ready(nxt);
            if constexpr (SP2) {
            PG8_LDB(B0, 0, 0); PG8_LDB(B1, 0, 1); PG8_SCHED; PG8_LDA(At, 0, 0); PG8_STAGE(PG8_SA(1, 1), a1 + hstep, voffA);
            PG8_WAIT_V(8); PG8_WAIT_L(0); PG8_BAR; PG8_MMA(0, 0, At, B0); PG8_MMA(0, 1, At, B1); PG8_BAR; PG8_SCHED;
            PG8_LDA(At, 0, 1); PG8_STAGE(PG8_SB(0, 0), b2, voffB); PG8_STAGE(PG8_SB(0, 1), b2 + hstep, voffB); PG8_STAGE(PG8_SA(0, 0), a2, voffA);
            PG8_WAIT_V(8); PG8_WAIT_L(0); PG8_BAR; PG8_MMA(1, 0, At, B0); PG8_MMA(1, 1, At, B1); PG8_BAR; PG8_SCHED;
            PG8_LDB(B0, 1, 0); PG8_LDB(B1, 1, 1); PG8_SCHED; PG8_LDA(At, 1, 0); PG8_STAGE(PG8_SA(0, 1), a2 + hstep, voffA);
            PG8_WAIT_V(8); PG8_WAIT_L(0); PG8_BAR; PG8_MMA(0, 0, At, B0); PG8_MMA(0, 1, At, B1); PG8_BAR; PG8_SCHED;
            PG8_LDA(At, 1, 1); PG8_STAGE(PG8_SB(1, 0), b3, voffB); PG8_STAGE(PG8_SB(1, 1), b3 + hstep, voffB); PG8_STAGE(PG8_SA(1, 0), a3, voffA);
            PG8_WAIT_V(8); PG8_WAIT_L(0); PG8_BAR; PG8_MMA(1, 0, At, B0); PG8_MMA(1, 1, At, B1); PG8_BAR; PG8_SCHED;
            } else {
            PG8_LDB(B0, 0, 0); PG8_SCHED; PG8_LDA(At, 0, 0); PG8_STAGE(PG8_SA(1, 1), a1 + hstep, voffA);
            PG8_WAIT_L(8); PG8_BAR; PG8_WAIT_L(0); PG8_MMA(0, 0, At, B0); PG8_BAR; PG8_SCHED;
            PG8_LDB(B1, 0, 1); PG8_STAGE(PG8_SB(0, 0), b2, voffB);
            PG8_BAR; PG8_WAIT_L(0); PG8_MMA(0, 1, At, B1); PG8_BAR;
            PG8_LDA(At, 0, 1); PG8_STAGE(PG8_SA(0, 0), a2, voffA);
            PG8_BAR; PG8_WAIT_L(0); PG8_MMA(1, 0, At, B0); PG8_BAR; PG8_SCHED;
            PG8_STAGE(PG8_SB(0, 1), b2 + hstep, voffB);
            PG8_WAIT_V(6); PG8_BAR; PG8_MMA(1, 1, At, B1); PG8_BAR;
            PG8_LDB(B0, 1, 0); PG8_SCHED; PG8_LDA(At, 1, 0); PG8_STAGE(PG8_SA(0, 1), a2 + hstep, voffA);
            PG8_WAIT_L(8); PG8_BAR; PG8_WAIT_L(0); PG8_MMA(0, 0, At, B0); PG8_BAR; PG8_SCHED;
            PG8_LDB(B1, 1, 1); PG8_STAGE(PG8_SB(1, 0), b3, voffB);
            PG8_BAR; PG8_WAIT_L(0); PG8_MMA(0, 1, At, B1); PG8_BAR;
            PG8_LDA(At, 1, 1); PG8_STAGE(PG8_SA(1, 0), a3, voffA);
            PG8_BAR; PG8_WAIT_L(0); PG8_MMA(1, 0, At, B0); PG8_BAR; PG8_SCHED;
            PG8_STAGE(PG8_SB(1, 1), b3 + hstep, voffB);
            PG8_WAIT_V(6); PG8_BAR; PG8_MMA(1, 1, At, B1); PG8_BAR;
            }
        }
        if constexpr (ALIGN_EPI) { if (wr == 0) PG8_BAR; }
        if constexpr (!Epi::AFTER_DRAIN) { E(acc, cur, wr, wc, fr, fq); S.done(cur); }
        if (!has_next) break;
#pragma unroll
        for (int a = 0; a < 2; ++a)
#pragma unroll
            for (int b = 0; b < 2; ++b)
#pragma unroll
                for (int m = 0; m < 4; ++m)
#pragma unroll
                    for (int n = 0; n < 2; ++n) { float z_ = 0.f; asm volatile("" : "+v"(z_)); acc[a][b][m][n] = (f32x4){z_, z_, z_, z_}; }
        cur = nxt; cA = nA; cB = nB; ++ui;
        if constexpr (ALIGN_EPI) { if (wr == 1) PG8_BAR; }
    }
    PG8_WAIT_V(0);
    if constexpr (!ALIGN_EPI) { if (wr == 0) PG8_BAR; }
    PG8_BAR;
    if constexpr (Epi::AFTER_DRAIN) { E.fused(acc, cur, wr, wc, fr, fq, lds, wid, lane); S.done(cur); }
#undef PG8_SA
#undef PG8_SB
#undef PG8_STAGE
#undef PG8_LDA
#undef PG8_LDB
#undef PG8_MMA
#undef PG8_WAIT_V
#undef PG8_WAIT_L
#undef PG8_BAR
#undef PG8_SCHED
}
}
typedef unsigned short bf16_t;
typedef short bf16x8 __attribute__((ext_vector_type(8)));
typedef float f32x4 __attribute__((ext_vector_type(4)));
typedef float f32x16 __attribute__((ext_vector_type(16)));
constexpr int LSEQ = 4112, TREAL = 16384, TG = 16448, TGP = 16640, NGRP = 3;
constexpr size_t SLOT_E = (size_t)TGP * 512;
constexpr size_t SLOT_B = SLOT_E * 2;
constexpr size_t MiB = 1u << 20;
constexpr size_t WS_XMETA = 1 * MiB, WS_DECAY = 2 * MiB, WS_SIDE = 3 * MiB + 512 * 1024, WS_W = 5 * MiB, WS_SLOTS = 53 * MiB;
constexpr size_t WS_NEED = WS_SLOTS + 25 * SLOT_B;
constexpr size_t WO_IN = 0, WO_G = 7864320, WO_BP = 12058624, WO_OUT = 14155776, WO_1 = 15204352, WO_2 = 19398656, WO_LR = 23592960;
constexpr int LDS_BYTES = 140 * 1024;
enum { I_XP = 0, I_XS, I_META, I_NMIX, I_WIN, I_LBL, I_ONORM, I_CONV, I_QN, I_KN, I_LAM, I_SUBLN, I_MU, I_W0, I_W2, I_A0, I_A2, I_G2, I_KK, I_KA, I_RK, I_LNG, I_LNB, I_WG, I_BP, I_WOUT, I_NMLP, I_W1, I_W2M };
struct Params { const float* in[29]; float* out; unsigned char* ws; };
typedef const __attribute__((address_space(4))) Params* KParamsPtr;
DEV KParamsPtr kparams() { KParamsPtr p = (KParamsPtr)__builtin_amdgcn_kernarg_segment_ptr(); asm volatile("" : "+s"(p)); return p; }
DEV Params load_params() { KParamsPtr p = kparams(); Params r;
#pragma unroll
    for (int i = 0; i < 29; ++i) r.in[i] = p->in[i];
    r.out = p->out; r.ws = p->ws; return r; }
DEV unsigned zero_u() { unsigned z = 0u; asm volatile("" : "+v"(z)); return z; }

#define ROWPRO const int tid_ = launder_tid(wv); const int lane = tid_ & 63; const int gw = bid * 8 + __builtin_amdgcn_readfirstlane(tid_ >> 6); const int ngw = nb * 8;
DEV float bf2f(unsigned short u) { return __uint_as_float((unsigned)u << 16); }
DEV unsigned pk2(float lo, float hi) { return pg8::cvt_pk_bf16(lo, hi); }
DEV void unpack8(const uint4 w, float* f) {
    f[0] = __uint_as_float(w.x << 16); f[1] = __uint_as_float(w.x & 0xffff0000u); f[2] = __uint_as_float(w.y << 16); f[3] = __uint_as_float(w.y & 0xffff0000u);
    f[4] = __uint_as_float(w.z << 16); f[5] = __uint_as_float(w.z & 0xffff0000u); f[6] = __uint_as_float(w.w << 16); f[7] = __uint_as_float(w.w & 0xffff0000u); }
DEV uint4 pack8(const float* f) { uint4 o; o.x = pk2(f[0], f[1]); o.y = pk2(f[2], f[3]); o.z = pk2(f[4], f[5]); o.w = pk2(f[6], f[7]); return o; }
DEV bf16_t* slotp(const Params& P, int s) { return (bf16_t*)(P.ws + WS_SLOTS + (size_t)s * SLOT_B); }
DEV int row_of(int sl, int p) { return p >= 16 ? sl * 4096 + p - 16 : TREAL + sl * 16 + p; }
DEV void pos_of(int r, int& sl, int& p) { if (r < TREAL) { sl = r >> 12; p = (r & 4095) + 16; } else { const int m = r - TREAL; sl = m >> 4; p = m & 15; } }
DEV float wave_sum(float v) {
#pragma unroll
    for (int o = 1; o < 64; o <<= 1) v += __shfl_xor(v, o);
    return v; }
DEV float red8(float v) { v += __shfl_xor(v, 1); v += __shfl_xor(v, 2); v += __shfl_xor(v, 4); return v; }
DEV f32x4 mfma16(bf16x8 a, bf16x8 b, f32x4 c) { return __builtin_amdgcn_mfma_f32_16x16x32_bf16(a, b, c, 0, 0, 0); }
DEV f32x16 mfma32(bf16x8 a, bf16x8 b, f32x16 c) { return __builtin_amdgcn_mfma_f32_32x32x16_bf16(a, b, c, 0, 0, 0); }
DEV const float* x_in_row(const Params& P, int g, int r) {
    if (r < TREAL) return (g < 2 ? P.in[I_XP] + (size_t)g * TREAL * 1024 : P.in[I_XS]) + (size_t)r * 1024;
    return P.in[I_META] + (size_t)((r - TREAL) & 15) * 1024; }
DEV float* x_cur_row(const Params& P, int g, int r) {
    if (r < TREAL) return P.out + ((size_t)g * TREAL + r) * 1024;
    const int m = r - TREAL;
    return (float*)(P.ws + WS_XMETA) + (size_t)(m < 64 ? g * 64 + m : ((m >> 6) - 1) * 64 + (m & 63)) * 1024; }

DEV int gate_row(int n) { const int br = n >> 10, c = n & 1023, pn = c >> 6, oc = c & 63, wc = oc >> 4, fq = (oc >> 2) & 3, i = oc & 3; return pn * 256 + (br >> 1) * 128 + wc * 32 + fq * 8 + (br & 1) * 4 + i; }
template <int MODE> DEV void wt_items(const float* __restrict__ W, int K, int N, bf16_t* WT, int row_off, float* scr, int gw, int ngw, int lane) {
    const int nblk = N >> 5, items = (K >> 6) * nblk;
    for (int it = gw; it < items; it += ngw) {
        const int kb = it / nblk, nbk = it - kb * nblk, k0 = 64 * kb, n0 = 32 * nbk;
#pragma unroll 8
        for (int i = 0; i < 32; ++i) { const int kk = 2 * i + (lane >> 5); scr[kk * 33 + (lane & 31)] = W[(size_t)(k0 + kk) * N + n0 + (lane & 31)]; }
        asm volatile("s_waitcnt lgkmcnt(0)" ::: "memory");
        const int c = lane & 7;
#pragma unroll
        for (int j = 0; j < 4; ++j) { const int n = (lane >> 3) + 8 * j; const float* sp = scr + (8 * c) * 33 + n;
            uint4 o; o.x = pk2(sp[0 * 33], sp[1 * 33]); o.y = pk2(sp[2 * 33], sp[3 * 33]); o.z = pk2(sp[4 * 33], sp[5 * 33]); o.w = pk2(sp[6 * 33], sp[7 * 33]);
            const int dr = MODE == 1 ? gate_row(n0 + n) : n0 + n + row_off;
            *(uint4*)(WT + (size_t)dr * K + k0 + 8 * c) = o; }
        asm volatile("s_waitcnt lgkmcnt(0)" ::: "memory");
    }
}
DEV void phase_weights(const Params& P0, int layer, unsigned char* lds, int bid, int nb, int wv) {
    Params P = load_params(); asm volatile("" : "+s"(P.ws));
    const int tid = launder_tid(wv), lane = tid & 63, w = __builtin_amdgcn_readfirstlane(tid >> 6);
    const int gtid = bid * 512 + tid, gth = nb * 512, gw = bid * 8 + w, ngw = nb * 8;
    float* scr = (float*)(lds + w * 8448);
    bf16_t* W = (bf16_t*)(P.ws + WS_W);
    wt_items<0>(P.in[I_WIN] + (size_t)layer * 1024 * 7552, 1024, 7552, W + WO_IN, 0, scr, gw, ngw, lane);
    for (int it = gtid; it < 128 * 128; it += gth) { const unsigned z = zero_u(); *(uint4*)(W + WO_IN + (size_t)7552 * 1024 + (size_t)it * 8) = make_uint4(z, z, z, z); }
    wt_items<1>(P.in[I_WG] + (size_t)layer * 1024 * 4096, 1024, 4096, W + WO_G, 0, scr, gw, ngw, lane);
    for (int n = 0; n < 4; ++n) wt_items<0>(P.in[I_BP] + (size_t)(layer * 4 + n) * 512 * 1024, 512, 1024, W + WO_BP, n * 1024, scr, gw, ngw, lane);
    wt_items<0>(P.in[I_WOUT] + (size_t)layer * 1024 * 1024, 1024, 1024, W + WO_OUT, 0, scr, gw, ngw, lane);
    wt_items<0>(P.in[I_W1] + (size_t)layer * 1024 * 4096, 1024, 4096, W + WO_1, 0, scr, gw, ngw, lane);
    wt_items<0>(P.in[I_W2M] + (size_t)layer * 4096 * 1024, 4096, 1024, W + WO_2, 0, scr, gw, ngw, lane);
    for (int it = gtid; it < 2560 * 48; it += gth) {
        const int row = it / 48, k8 = it - row * 48, seg = row >> 9, c = row & 511, k0 = k8 * 8;
        float v[8];
#pragma unroll
        for (int j = 0; j < 8; ++j) { const int k = k0 + j; float x = 0.f;
            if (seg == 0) { if (k < 64) x = P.in[I_W2][((size_t)(layer * 2 + 0) * 64 + k) * 512 + c]; }
            else if (seg == 1) { if (k >= 64 && k < 128) x = P.in[I_W2][((size_t)(layer * 2 + 1) * 64 + (k - 64)) * 512 + c]; }
            else if (seg == 2) { if (k >= 128 && k < 192) x = P.in[I_A2][((size_t)(layer * 2 + 0) * 64 + (k - 128)) * 512 + c]; }
            else if (seg == 3) { if (k >= 192 && k < 256) x = P.in[I_A2][((size_t)(layer * 2 + 1) * 64 + (k - 192)) * 512 + c]; }
            else { if (k >= 256) x = P.in[I_G2][((size_t)layer * 128 + (k - 256)) * 512 + c]; }
            v[j] = x; }
        *(uint4*)(W + WO_LR + (size_t)row * 384 + k0) = pack8(v);
    }
}

DEV void phase_rmsnorm(const Params& P0, int g, bool src_in, int gain_idx, int layer, int nrows, int nvalid, int bid, int nb, int wv) {
    Params P = load_params(); asm volatile("" : "+s"(P.ws));
    ROWPRO
    const float* gain = P.in[gain_idx] + layer * 1024;
    bf16_t* H = slotp(P, 0);
    for (int r = gw; r < nrows; r += ngw) {
        uint2* o8 = (uint2*)(H + (size_t)r * 1024) + lane;
        if (r >= nvalid) {
#pragma unroll
            for (int j = 0; j < 4; ++j) { const unsigned z = zero_u(); o8[64 * j] = make_uint2(z, z); }
            continue; }
        const f32x4* xr = (const f32x4*)(src_in ? x_in_row(P, g, r) : (const float*)x_cur_row(P, g, r)) + lane;
        f32x4 v[4]; float s = 0.f;
#pragma unroll
        for (int j = 0; j < 4; ++j) { v[j] = xr[64 * j]; s += (v[j].x * v[j].x + v[j].y * v[j].y) + (v[j].z * v[j].z + v[j].w * v[j].w); }
        const float rs = rsqrtf(wave_sum(s) * (1.f / 1024.f) + 1e-6f);
#pragma unroll
        for (int j = 0; j < 4; ++j) { const f32x4 gg = *((const f32x4*)gain + lane + 64 * j);
            o8[64 * j] = make_uint2(pk2(v[j].x * rs * gg.x, v[j].y * rs * gg.y), pk2(v[j].z * rs * gg.z, v[j].w * rs * gg.w)); }
    }
}
DEV void phase_da_prep(const Params& P0, int layer, int bid, int nb, int wv) {
    Params P = load_params(); asm volatile("" : "+s"(P.ws));
    ROWPRO
    const float inv8[8] = {1.0f, 0.19392274474868576f, 0.03760603093086393f, 0.007292664737217109f, 0.001414213562373095f, 0.0002742481756762073f, 5.318295896944988e-05f, 1.031338537721246e-05f};
    const int d0 = (lane & 7) * 8;
    float gq[8], gk[8];
#pragma unroll
    for (int j = 0; j < 8; ++j) { gq[j] = P.in[I_QN][layer * 64 + d0 + j]; gk[j] = P.in[I_KN][layer * 64 + d0 + j]; }
    for (int r = gw; r < TG; r += ngw) {
        int sl, p; pos_of(r, sl, p);
        float cs[8], sn[8];
#pragma unroll
        for (int j = 0; j < 8; ++j) { const float ang = (float)p * inv8[j]; double a = (double)ang; a -= 6.283185307179586 * __builtin_rint(a * 0.15915494309189535); const float rr = (float)a; cs[j] = __cosf(rr); sn[j] = __sinf(rr); }
#pragma unroll
        for (int which = 0; which < 2; ++which) {
            uint4* ptr = (uint4*)(slotp(P, 10 + which) + (size_t)r * 512) + lane;
            float f[8]; unpack8(*ptr, f);
            float ss = 0.f;
#pragma unroll
            for (int j = 0; j < 8; ++j) ss += f[j] * f[j];
            ss = red8(ss);
            const float rs = rsqrtf(ss * (1.f / 64.f) + 1e-6f);
#pragma unroll
            for (int j = 0; j < 8; ++j) f[j] = f[j] * rs * (which == 0 ? gq[j] : gk[j]);
#pragma unroll
            for (int j = 0; j < 8; ++j) { const float pr = __shfl_xor(f[j], 1);
                if ((lane & 7) == 0) f[j] = f[j] * cs[j] - pr * sn[j];
                else if ((lane & 7) == 1) f[j] = f[j] * cs[j] + pr * sn[j]; }
            if (which == 0) {
#pragma unroll
                for (int j = 0; j < 8; ++j) f[j] *= 0.18033688011112042f; }
            *ptr = pack8(f);
        }
    }
}
DEV void phase_conv(const Params& P0, int layer, int bid, int nb, int wv) {
    Params P = load_params(); asm volatile("" : "+s"(P.ws));
    ROWPRO
    const int c0 = lane * 8;
    float w0[8], w1[8], w2[8];
#pragma unroll
    for (int j = 0; j < 8; ++j) { w0[j] = P.in[I_CONV][(layer * 3 + 0) * 512 + c0 + j]; w1[j] = P.in[I_CONV][(layer * 3 + 1) * 512 + c0 + j]; w2[j] = P.in[I_CONV][(layer * 3 + 2) * 512 + c0 + j]; }
    const bf16_t* SB = slotp(P, 7); const bf16_t* SC = slotp(P, 8); const bf16_t* SH = slotp(P, 9); bf16_t* Y = slotp(P, 3);
    for (int r = gw; r < TG; r += ngw) {
        int sl, p; pos_of(r, sl, p);
        float acc[8], a[8], b[8];
        unpack8(*((const uint4*)(SC + (size_t)r * 512) + lane), a); unpack8(*((const uint4*)(SH + (size_t)r * 512) + lane), b);
#pragma unroll
        for (int j = 0; j < 8; ++j) acc[j] = a[j] * b[j] * w1[j];
        if (p > 0) { const int rp = row_of(sl, p - 1);
            unpack8(*((const uint4*)(SC + (size_t)rp * 512) + lane), a); unpack8(*((const uint4*)(SH + (size_t)rp * 512) + lane), b);
#pragma unroll
            for (int j = 0; j < 8; ++j) acc[j] += a[j] * b[j] * w0[j]; }
        if (p < LSEQ - 1) { const int rn = row_of(sl, p + 1);
            unpack8(*((const uint4*)(SC + (size_t)rn * 512) + lane), a); unpack8(*((const uint4*)(SH + (size_t)rn * 512) + lane), b);
#pragma unroll
            for (int j = 0; j < 8; ++j) acc[j] += a[j] * b[j] * w2[j]; }
        unpack8(*((const uint4*)(SB + (size_t)r * 512) + lane), a);
#pragma unroll
        for (int j = 0; j < 8; ++j) acc[j] *= a[j];
        *((uint4*)(Y + (size_t)r * 512) + lane) = pack8(acc);
    }
}
DEV void phase_rw_prep(const Params& P0, int layer, int bid, int nb, int wv) {
    Params P = load_params(); asm volatile("" : "+s"(P.ws));
    ROWPRO
    const float* mu = P.in[I_MU] + (size_t)layer * 1920;
    for (int r = gw; r < TG; r += ngw) {
        int sl, p; pos_of(r, sl, p);
        const int rp = p > 0 ? row_of(sl, p - 1) : -1, rn = p < LSEQ - 1 ? row_of(sl, p + 1) : -1;
#pragma unroll
        for (int grp = 0; grp < 4; ++grp) {
            if (grp == 3 && lane >= 48) break;
            const int c0 = (grp < 3 ? grp * 512 : 1536) + lane * 8;
            const bf16_t* src = slotp(P, 13 + (c0 >> 9)) + (c0 & 511);
            float u[8], up[8], un[8], xm[8];
            unpack8(*(const uint4*)(src + (size_t)r * 512), u);
            if (rp >= 0) unpack8(*(const uint4*)(src + (size_t)rp * 512), up); else {
#pragma unroll
                for (int j = 0; j < 8; ++j) up[j] = 0.f; }
            if (rn >= 0) unpack8(*(const uint4*)(src + (size_t)rn * 512), un); else {
#pragma unroll
                for (int j = 0; j < 8; ++j) un[j] = 0.f; }
#pragma unroll
            for (int j = 0; j < 8; ++j) xm[j] = u[j] + mu[c0 + j] * (0.5f * (up[j] + un[j]) - u[j]);
            if (grp < 3) {
                *((uint4*)(slotp(P, 17 + grp) + (size_t)r * 512) + lane) = pack8(xm);
                if (grp == 1) {
                    float kk[8], ss = 0.f;
#pragma unroll
                    for (int j = 0; j < 8; ++j) { kk[j] = xm[j] * P.in[I_KK][layer * 512 + c0 - 512 + j]; ss += kk[j] * kk[j]; }
                    ss = red8(ss);
                    const float inv = 1.0f / fmaxf(sqrtf(ss), 1e-12f);
#pragma unroll
                    for (int j = 0; j < 8; ++j) kk[j] *= inv;
                    *((uint4*)(slotp(P, 20) + (size_t)r * 512) + lane) = pack8(kk); }
            } else {
                const int a0 = lane * 8;
                float o[8];
#pragma unroll
                for (int j = 0; j < 8; ++j) { const float x = xm[j];
                    if (a0 < 128) { const float e = __expf(2.f * x); o[j] = 1.f - 2.f / (e + 1.f); }
                    else if (a0 < 256) o[j] = x;
                    else o[j] = 1.f / (1.f + __expf(-x)); }
                *((uint4*)(slotp(P, 21) + (size_t)r * 384) + lane) = pack8(o);
            }
        }
    }
    for (int r = TG + gw; r < TGP; r += ngw) if (lane < 48) { const unsigned z = zero_u(); *((uint4*)(slotp(P, 21) + (size_t)r * 384) + lane) = make_uint4(z, z, z, z); }
}
DEV void phase_rw_post(const Params& P0, int layer, int g, int nrows, int bid, int nb, int wv) {
    Params P = load_params(); asm volatile("" : "+s"(P.ws));
    ROWPRO
    const int c0 = lane * 8;
    float ka[8], rk[8], lg[8], lb[8];
#pragma unroll
    for (int j = 0; j < 8; ++j) { ka[j] = P.in[I_KA][layer * 512 + c0 + j]; rk[j] = P.in[I_RK][layer * 512 + c0 + j]; lg[j] = P.in[I_LNG][layer * 512 + c0 + j]; lb[j] = P.in[I_LNB][layer * 512 + c0 + j]; }
    for (int r = gw; r < nrows; r += ngw) {
        float of[8], ob[8], o[8];
        unpack8(*((const uint4*)(slotp(P, 15) + (size_t)r * 512) + lane), of); unpack8(*((const uint4*)(slotp(P, 16) + (size_t)r * 512) + lane), ob);
        float s = 0.f;
#pragma unroll
        for (int j = 0; j < 8; ++j) { o[j] = of[j] + ob[j]; s += o[j]; }
        const float mean = red8(s) * (1.f / 64.f);
        float q = 0.f;
#pragma unroll
        for (int j = 0; j < 8; ++j) { o[j] -= mean; q += o[j] * o[j]; }
        const float rs = rsqrtf(red8(q) * (1.f / 64.f) + 64e-5f);
        float rr[8], kk[8], vv[8], af[8], ab[8], gg[8];
        unpack8(*((const uint4*)(slotp(P, 17) + (size_t)r * 512) + lane), rr); unpack8(*((const uint4*)(slotp(P, 18) + (size_t)r * 512) + lane), kk);
        unpack8(*((const uint4*)(slotp(P, 19) + (size_t)r * 512) + lane), vv); unpack8(*((const uint4*)(slotp(P, 24) + (size_t)r * 512) + lane), af);
        unpack8(*((const uint4*)(slotp(P, 13) + (size_t)r * 512) + lane), ab); unpack8(*((const uint4*)(slotp(P, 14) + (size_t)r * 512) + lane), gg);
        float bs = 0.f;
#pragma unroll
        for (int j = 0; j < 8; ++j) { const float kd = kk[j] * (2.f + (af[j] + ab[j] - 2.f) * ka[j]); bs += rr[j] * kd * rk[j]; }
        bs = red8(bs);
        float y[8];
#pragma unroll
        for (int j = 0; j < 8; ++j) y[j] = (o[j] * rs * lg[j] + lb[j] + bs * vv[j]) * gg[j];
        const uint4 yv = pack8(y);
        *((uint4*)(slotp(P, 5) + (size_t)r * 512) + lane) = yv;
        if (layer == 0 && g < 2 && r >= TREAL) {
            bf16_t* sd = (bf16_t*)(P.ws + WS_SIDE) + (size_t)g * 4 * 64 * 512 + (size_t)(r - TREAL) * 512;
#pragma unroll
            for (int k = 0; k < 3; ++k) *((uint4*)(sd + (size_t)k * 64 * 512) + lane) = *((const uint4*)(slotp(P, 2 + k) + (size_t)r * 512) + lane);
            *((uint4*)(sd + (size_t)3 * 64 * 512) + lane) = yv; }
    }
    if (layer == 0 && g == 2) {
        for (int m2 = gw; m2 < 128; m2 += ngw) { const bf16_t* sd = (const bf16_t*)(P.ws + WS_SIDE) + (size_t)(m2 >> 6) * 4 * 64 * 512 + (size_t)(m2 & 63) * 512;
#pragma unroll
            for (int k = 0; k < 4; ++k) *((uint4*)(slotp(P, 2 + k) + (size_t)(TG + m2) * 512) + lane) = *((const uint4*)(sd + (size_t)k * 64 * 512) + lane); }
    }
}
DEV void hg_gate(float x, float lbv, float& lg, float& kk) {
    const float e = __expf(-fabsf(x)); const float sp = 1.f / (1.f + e);
    const float s = x >= 0.f ? sp : e * sp, s1 = x >= 0.f ? e * sp : sp;
    const float f = fmaxf(lbv, 1e-20f) + (1.f - lbv) * s;
    lg = __logf(f); kk = (1.f - lbv) * s1; }
DEV float hg_lb(const Params& P, int layer, int dir, int col) {
    if (layer == 0) return 0.f;
    const float a = P.in[I_LBL][(dir * 2 + 0) * 512 + col], b = P.in[I_LBL][(dir * 2 + 1) * 512 + col];
    return 1.f / (1.f + __expf(a - b)); }
DEV int hg_row(int sl, int c, int j, bool& valid) { if (c == 0) { valid = j < 16; return TREAL + sl * 16 + j; } valid = true; return sl * 4096 + (c - 1) * 64 + j; }
DEV void hg_cumsum(float* Lb, float* Bt, float* Seg, int dir, int tid) {
    const int ch = tid & 127, seg = tid >> 7;
    float v[16];
#pragma unroll
    for (int i = 0; i < 16; ++i) v[i] = Lb[(seg * 16 + i) * 128 + ch];
    if (dir == 0) {
#pragma unroll
        for (int i = 1; i < 16; ++i) v[i] += v[i - 1];
        Seg[seg * 128 + ch] = v[15];
    } else {
#pragma unroll
        for (int i = 14; i >= 0; --i) v[i] += v[i + 1];
        Seg[seg * 128 + ch] = v[0];
    }
    __syncthreads();
    const float s0 = Seg[ch], s1 = Seg[128 + ch], s2 = Seg[256 + ch], s3 = Seg[384 + ch];
    float off;
    if (dir == 0) off = seg == 0 ? 0.f : seg == 1 ? s0 : seg == 2 ? s0 + s1 : s0 + s1 + s2;
    else off = seg == 3 ? 0.f : seg == 2 ? s3 : seg == 1 ? s3 + s2 : s3 + s2 + s1;
#pragma unroll
    for (int i = 0; i < 16; ++i) Lb[(seg * 16 + i) * 128 + ch] = v[i] + off;
    if (seg == 0) Bt[ch] = (s0 + s1) + (s2 + s3);
}
DEV void phase_hg1(const Params& P0, int layer, unsigned char* lds, int bid, int nb, int wv) {
    Params P = load_params(); asm volatile("" : "+s"(P.ws));
    float* Lb = (float*)lds; bf16_t* KlT = (bf16_t*)(lds + 32768); bf16_t* VT = (bf16_t*)(lds + 32768 + 18432); float* Bt = (float*)(lds + 69632); float* Seg = (float*)(lds + 70656);
    float* X = (float*)slotp(P, 17); float* DC = (float*)(P.ws + WS_DECAY);
    const int tid = launder_tid(wv), lane = tid & 63, w = __builtin_amdgcn_readfirstlane(tid >> 6), j = tid >> 3, c0 = (tid & 7) * 16, l15 = lane & 15, quad = lane >> 4;
    for (int unit = bid; unit < 32 * 65; unit += nb) {
        const int chain = unit / 65, c = unit - chain * 65, sl = chain >> 3, head = (chain >> 1) & 3, dir = chain & 1;
        bool valid; const int r = hg_row(sl, c, j, valid);
        float lg[16], kk[16]; uint4 vv[2] = {make_uint4(0, 0, 0, 0), make_uint4(0, 0, 0, 0)};
        if (valid) {
            float fr[16];
            const uint4* fp = (const uint4*)(slotp(P, 3 + dir) + (size_t)r * 512 + head * 128 + c0);
            unpack8(fp[0], fr); unpack8(fp[1], fr + 8);
            const uint4* vp = (const uint4*)(slotp(P, 5) + (size_t)r * 512 + head * 128 + c0); vv[0] = vp[0]; vv[1] = vp[1];
#pragma unroll
            for (int e = 0; e < 16; ++e) hg_gate(fr[e], hg_lb(P, layer, dir, head * 128 + c0 + e), lg[e], kk[e]);
        } else {
#pragma unroll
            for (int e = 0; e < 16; ++e) { lg[e] = 0.f; kk[e] = 0.f; } }
#pragma unroll
        for (int e = 0; e < 16; e += 4) *(f32x4*)(Lb + j * 128 + c0 + e) = (f32x4){lg[e], lg[e + 1], lg[e + 2], lg[e + 3]};
        __syncthreads();
        hg_cumsum(Lb, Bt, Seg, dir, tid);
        __syncthreads();
        float vf[16]; unpack8(vv[0], vf); unpack8(vv[1], vf + 8);
#pragma unroll
        for (int e = 0; e < 16; ++e) { const float kl = kk[e] * __expf(Bt[c0 + e] - Lb[j * 128 + c0 + e]);
            KlT[(c0 + e) * 72 + j] = (bf16_t)(pk2(kl, 0.f) & 0xffffu); VT[(c0 + e) * 72 + j] = (bf16_t)(__float_as_uint(vf[e]) >> 16); }
        if (tid < 128) DC[(size_t)(chain * 65 + c) * 128 + tid] = __expf(Bt[tid]);
        __syncthreads();
        f32x4 acc[8];
#pragma unroll
        for (int ct = 0; ct < 8; ++ct) acc[ct] = (f32x4){0.f, 0.f, 0.f, 0.f};
#pragma unroll
        for (int ks = 0; ks < 2; ++ks) { const bf16x8 a = *(const bf16x8*)(VT + (w * 16 + l15) * 72 + ks * 32 + quad * 8);
#pragma unroll
            for (int ct = 0; ct < 8; ++ct) { const bf16x8 b = *(const bf16x8*)(KlT + (ct * 16 + l15) * 72 + ks * 32 + quad * 8); acc[ct] = mfma16(a, b, acc[ct]); } }
        float* xo = X + (size_t)(chain * 65 + c) * 16384;
#pragma unroll
        for (int ct = 0; ct < 8; ++ct)
#pragma unroll
            for (int jj = 0; jj < 4; ++jj) xo[(w * 16 + quad * 4 + jj) * 128 + ct * 16 + l15] = acc[ct][jj];
        __syncthreads();
    }
}
DEV void phase_hg2(const Params& P0, int bid, int nb, int wv) {
    Params P = load_params(); asm volatile("" : "+s"(P.ws));
    const int gtid = bid * 512 + launder_tid(wv), gth = nb * 512;
    f32x4* X = (f32x4*)slotp(P, 17); const f32x4* DC = (const f32x4*)(P.ws + WS_DECAY);
    for (int e = gtid; e < 32 * 4096; e += gth) {
        const int chain = e >> 12, e4 = e & 4095, dir = chain & 1;
        f32x4 S = (f32x4){0.f, 0.f, 0.f, 0.f};
#pragma unroll 5
        for (int step = 0; step < 65; ++step) { const int c = dir ? 64 - step : step;
            const size_t idx = (size_t)(chain * 65 + c) * 4096 + e4;
            const f32x4 kv = X[idx]; const f32x4 dc = DC[(size_t)(chain * 65 + c) * 32 + (e4 & 31)];
            X[idx] = S; S = dc * S + kv; }
    }
}
DEV void phase_hg3(const Params& P0, int layer, unsigned char* lds, int bid, int nb, int wv) {
    Params P = load_params(); asm volatile("" : "+s"(P.ws));
    float* Lb = (float*)lds; bf16_t* Qs = (bf16_t*)(lds + 32768); bf16_t* Ks = (bf16_t*)(lds + 50176); bf16_t* Am = (bf16_t*)(lds + 67584);
    bf16_t* VT = (bf16_t*)(lds + 76800); bf16_t* Sb = (bf16_t*)(lds + 95232); float* Bt = (float*)(lds + 130048); float* Seg = (float*)(lds + 132096); float* Ost = (float*)lds;
    const float* X = (const float*)slotp(P, 17);
    const int tid = launder_tid(wv), lane = tid & 63, w = __builtin_amdgcn_readfirstlane(tid >> 6), j = tid >> 3, c0 = (tid & 7) * 16, l15 = lane & 15, quad = lane >> 4;
    const int tt = w >> 1, st0 = (w & 1) * 2, vt0 = (w & 1) * 4;
    const int cfirst = layer == 0 ? 0 : 1;
    const int ncb = 65 - cfirst;
    for (int unit = bid; unit < 16 * ncb; unit += nb) {
        const int sh = unit / ncb, c = unit - sh * ncb + cfirst, sl = sh >> 2, head = sh & 3;
        bool valid; const int r = hg_row(sl, c, j, valid);
        float q[16]; uint4 gv[2] = {make_uint4(0, 0, 0, 0), make_uint4(0, 0, 0, 0)};
        if (valid) {
            const uint4* qp = (const uint4*)(slotp(P, 2) + (size_t)r * 512 + head * 128 + c0); unpack8(qp[0], q); unpack8(qp[1], q + 8);
            const uint4* vp = (const uint4*)(slotp(P, 5) + (size_t)r * 512 + head * 128 + c0); float vf[16]; unpack8(vp[0], vf); unpack8(vp[1], vf + 8);
#pragma unroll
            for (int e = 0; e < 16; ++e) VT[(c0 + e) * 72 + j] = (bf16_t)(__float_as_uint(vf[e]) >> 16);
            const uint4* gp = (const uint4*)(slotp(P, 6) + (size_t)r * 512 + head * 128 + c0); gv[0] = gp[0]; gv[1] = gp[1];
        } else {
#pragma unroll
            for (int e = 0; e < 16; ++e) { q[e] = 0.f; VT[(c0 + e) * 72 + j] = 0; } }
        f32x4 accA[2], accO[4];
#pragma unroll
        for (int i = 0; i < 2; ++i) accA[i] = (f32x4){0.f, 0.f, 0.f, 0.f};
#pragma unroll
        for (int i = 0; i < 4; ++i) accO[i] = (f32x4){0.f, 0.f, 0.f, 0.f};
#pragma unroll 1
        for (int dir = 0; dir < 2; ++dir) {
            float lg[16], kk[16];
            if (valid) { float fr[16];
                const uint4* fp = (const uint4*)(slotp(P, 3 + dir) + (size_t)r * 512 + head * 128 + c0); unpack8(fp[0], fr); unpack8(fp[1], fr + 8);
#pragma unroll
                for (int e = 0; e < 16; ++e) hg_gate(fr[e], hg_lb(P, layer, dir, head * 128 + c0 + e), lg[e], kk[e]);
            } else {
#pragma unroll
                for (int e = 0; e < 16; ++e) { lg[e] = 0.f; kk[e] = 0.f; } }
#pragma unroll
            for (int e = 0; e < 16; e += 4) *(f32x4*)(Lb + j * 128 + c0 + e) = (f32x4){lg[e], lg[e + 1], lg[e + 2], lg[e + 3]};
            __syncthreads();
            hg_cumsum(Lb, Bt, Seg, dir, tid);
            __syncthreads();
            {
                float qs[16], ks[16];
#pragma unroll
                for (int e = 0; e < 16; ++e) { const float b = Lb[j * 128 + c0 + e], rf = Lb[32 * 128 + c0 + e]; qs[e] = q[e] * __expf(b - rf); ks[e] = kk[e] * __expf(rf - b); }
                *(uint4*)(Qs + j * 136 + c0) = pack8(qs); *(uint4*)(Qs + j * 136 + c0 + 8) = pack8(qs + 8);
                *(uint4*)(Ks + j * 136 + c0) = pack8(ks); *(uint4*)(Ks + j * 136 + c0 + 8) = pack8(ks + 8);
            }
            {
                const int chain = sl * 8 + head * 2 + dir; const f32x4* xs = (const f32x4*)(X + (size_t)(chain * 65 + c) * 16384 + (size_t)(tid >> 2) * 128 + (tid & 3) * 32);
#pragma unroll
                for (int i = 0; i < 4; ++i) { const f32x4 a = xs[2 * i], b = xs[2 * i + 1]; uint4 o; o.x = pk2(a[0], a[1]); o.y = pk2(a[2], a[3]); o.z = pk2(b[0], b[1]); o.w = pk2(b[2], b[3]);
                    *(uint4*)(Sb + (tid >> 2) * 136 + (tid & 3) * 32 + i * 8) = o; }
            }
            __syncthreads();
            {
                f32x4 t0 = (f32x4){0.f, 0.f, 0.f, 0.f}, t1 = t0;
#pragma unroll
                for (int k4 = 0; k4 < 4; ++k4) { const bf16x8 a = *(const bf16x8*)(Qs + (tt * 16 + l15) * 136 + k4 * 32 + quad * 8);
                    const bf16x8 b0 = *(const bf16x8*)(Ks + ((st0 + 0) * 16 + l15) * 136 + k4 * 32 + quad * 8); const bf16x8 b1 = *(const bf16x8*)(Ks + ((st0 + 1) * 16 + l15) * 136 + k4 * 32 + quad * 8);
                    t0 = mfma16(a, b0, t0); t1 = mfma16(a, b1, t1); }
#pragma unroll
                for (int jj = 0; jj < 4; ++jj) { const int t = tt * 16 + quad * 4 + jj, s0 = (st0 + 0) * 16 + l15, s1 = (st0 + 1) * 16 + l15;
                    const bool k0 = dir == 0 ? s0 <= t : s0 >= t, k1 = dir == 0 ? s1 <= t : s1 >= t;
                    accA[0][jj] += k0 ? t0[jj] : 0.f; accA[1][jj] += k1 ? t1[jj] : 0.f; }
            }
            __syncthreads();
            {   float qg[16];
#pragma unroll
                for (int e = 0; e < 16; ++e) qg[e] = q[e] * __expf(Lb[j * 128 + c0 + e]);
                *(uint4*)(Qs + j * 136 + c0) = pack8(qg); *(uint4*)(Qs + j * 136 + c0 + 8) = pack8(qg + 8); }
            __syncthreads();
#pragma unroll
            for (int k4 = 0; k4 < 4; ++k4) { const bf16x8 a = *(const bf16x8*)(Qs + (tt * 16 + l15) * 136 + k4 * 32 + quad * 8);
#pragma unroll
                for (int v4 = 0; v4 < 4; ++v4) { const bf16x8 b = *(const bf16x8*)(Sb + ((vt0 + v4) * 16 + l15) * 136 + k4 * 32 + quad * 8); accO[v4] = mfma16(a, b, accO[v4]); } }
            __syncthreads();
        }
#pragma unroll
        for (int s2 = 0; s2 < 2; ++s2)
#pragma unroll
            for (int jj = 0; jj < 4; ++jj) Am[(tt * 16 + quad * 4 + jj) * 72 + (st0 + s2) * 16 + l15] = (bf16_t)(pk2(accA[s2][jj], 0.f) & 0xffffu);
        __syncthreads();
#pragma unroll
        for (int ks = 0; ks < 2; ++ks) { const bf16x8 a = *(const bf16x8*)(Am + (tt * 16 + l15) * 72 + ks * 32 + quad * 8);
#pragma unroll
            for (int v4 = 0; v4 < 4; ++v4) { const bf16x8 b = *(const bf16x8*)(VT + ((vt0 + v4) * 16 + l15) * 72 + ks * 32 + quad * 8); accO[v4] = mfma16(a, b, accO[v4]); } }
#pragma unroll
        for (int v4 = 0; v4 < 4; ++v4)
#pragma unroll
            for (int jj = 0; jj < 4; ++jj) Ost[(tt * 16 + quad * 4 + jj) * 132 + (vt0 + v4) * 16 + l15] = accO[v4][jj];
        __syncthreads();
        {   float o[16], ss = 0.f;
#pragma unroll
            for (int e = 0; e < 16; ++e) { o[e] = Ost[j * 132 + c0 + e]; ss += o[e] * o[e]; }
            ss = red8(ss);
            const float rs = rsqrtf(ss * (1.f / 128.f) + 1e-6f);
            float gf[16]; unpack8(gv[0], gf); unpack8(gv[1], gf + 8);
#pragma unroll
            for (int e = 0; e < 16; ++e) { const float gg = gf[e]; o[e] = o[e] * rs * P.in[I_ONORM][layer * 512 + head * 128 + c0 + e] * (gg / (1.f + __expf(-gg))); }
            if (valid) { uint4* yp = (uint4*)(slotp(P, 2) + (size_t)r * 512 + head * 128 + c0); yp[0] = pack8(o); yp[1] = pack8(o + 8); }
        }
        __syncthreads();
    }
}
DEV void phase_vtrans(const Params& P0, unsigned char* lds, int bid, int nb, int wv) {
    Params P = load_params(); asm volatile("" : "+s"(P.ws));
    bf16_t* T = (bf16_t*)lds;
    const bf16_t* V = slotp(P, 12); bf16_t* VTg = slotp(P, 6);
    const int tid = launder_tid(wv);
    for (int unit = bid; unit < 4 * 65 * 8; unit += nb) {
        const int sl = unit / 520, rem = unit - sl * 520, pt = rem >> 3, vdt = rem & 7;
        { const int tok = tid >> 3, c8 = (tid & 7) * 8, p = pt * 64 + tok;
          uint4 v = make_uint4(0, 0, 0, 0);
          if (p < LSEQ) v = *(const uint4*)(V + (size_t)row_of(sl, p) * 512 + vdt * 64 + c8);
          *(uint4*)(T + tok * 72 + c8) = v; }
        __syncthreads();
        { const int vd = tid >> 3, t8 = (tid & 7) * 8;
          unsigned short e[8];
#pragma unroll
          for (int i = 0; i < 8; ++i) { const int pp = t8 + i; const int sp = (pp & ~12) | (((pp >> 2) & 1) << 3) | (((pp >> 3) & 1) << 2); e[i] = T[sp * 72 + vd]; }
          uint4 o; o.x = e[0] | ((unsigned)e[1] << 16); o.y = e[2] | ((unsigned)e[3] << 16); o.z = e[4] | ((unsigned)e[5] << 16); o.w = e[6] | ((unsigned)e[7] << 16);
          *(uint4*)(VTg + (size_t)(sl * 512 + vdt * 64 + vd) * 4160 + pt * 64 + t8) = o; }
        __syncthreads();
    }
}
DEV int crow(int r, int hi) { return (r & 3) + 8 * (r >> 2) + 4 * hi; }
typedef unsigned u32x4_t __attribute__((ext_vector_type(4)));
struct AttnStage { u32x4_t k0, k1, v0, v1; };
DEV void attn_stage_load(const Params& P, int sl, int head, int kt, int tid, AttnStage& st) {
    const bf16_t* Kg = slotp(P, 11); const bf16_t* VTg = slotp(P, 6);
    { const int ci = tid, krow = ci >> 4, kc = ci & 15; const int p = kt * 64 + krow; const int r = p < LSEQ ? row_of(sl, p) : 0; st.k0 = *(const u32x4_t*)(Kg + (size_t)r * 512 + head * 128 + kc * 8); }
    { const int ci = tid + 512, krow = ci >> 4, kc = ci & 15; const int p = kt * 64 + krow; const int r = p < LSEQ ? row_of(sl, p) : 0; st.k1 = *(const u32x4_t*)(Kg + (size_t)r * 512 + head * 128 + kc * 8); }
    { const int vi = tid, vrow = vi >> 3, vc = vi & 7; st.v0 = *(const u32x4_t*)(VTg + (size_t)(sl * 512 + head * 128 + vrow) * 4160 + kt * 64 + vc * 8); }
    { const int vi = tid + 512, vrow = vi >> 3, vc = vi & 7; st.v1 = *(const u32x4_t*)(VTg + (size_t)(sl * 512 + head * 128 + vrow) * 4160 + kt * 64 + vc * 8); }
}
DEV void attn_stage_store(unsigned char* buf, int tid, const AttnStage& st) {
    bf16_t* Kt = (bf16_t*)buf; bf16_t* Vt = (bf16_t*)(buf + 17408);
    { const int ci = tid, krow = ci >> 4, kc = ci & 15; *(u32x4_t*)(Kt + krow * 136 + kc * 8) = st.k0; }
    { const int ci = tid + 512, krow = ci >> 4, kc = ci & 15; *(u32x4_t*)(Kt + krow * 136 + kc * 8) = st.k1; }
    { const int vi = tid, vrow = vi >> 3, vc = vi & 7; *(u32x4_t*)(Vt + vrow * 72 + vc * 8) = st.v0; }
    { const int vi = tid + 512, vrow = vi >> 3, vc = vi & 7; *(u32x4_t*)(Vt + vrow * 72 + vc * 8) = st.v1; }
}
DEV void phase_attn(const Params& P0, int layer, unsigned char* lds, int bid, int nb, int wv) {
    Params P = load_params(); asm volatile("" : "+s"(P.ws));
    const int tid = launder_tid(wv), lane = tid & 63, w = __builtin_amdgcn_readfirstlane(tid >> 6), map = w >> 2, qsub = w & 3, qi = lane & 31, hi = lane >> 5;
    const float lam_init = layer == 0 ? 0.2f : 0.35550906759096934f;
    float lam;
    { const float* lp = P.in[I_LAM] + (size_t)layer * 256; float s1 = 0.f, s2 = 0.f;
      for (int i = 0; i < 64; ++i) { s1 += lp[i] * lp[64 + i]; s2 += lp[128 + i] * lp[192 + i]; }
      lam = __expf(s1) - __expf(s2) + lam_init; }
    const int nqb = layer == 0 ? 33 : 32;
    float* Ex = (float*)lds;
    const bool xmap = (nb & 7) == 0;
    const int ustart = xmap ? (bid >> 3) : bid, ustep = xmap ? (nb >> 3) : nb, uend = xmap ? 2 * nqb : 16 * nqb;
    for (int unit = ustart; unit < uend; unit += ustep) {
        const int sh = xmap ? 2 * (bid & 7) + unit / nqb : unit / nqb, qb = unit % nqb, sl = sh >> 2, head = sh & 3;
        const int qrow0 = qb < 32 ? sl * 4096 + qb * 128 : TREAL + sl * 16; const int nvalid = qb < 32 ? 128 : 16;
        bf16x8 Qf[4];
        { const bf16_t* qp = slotp(P, 10) + (size_t)(qrow0 + qsub * 32 + qi) * 512 + head * 128 + map * 64 + hi * 8;
#pragma unroll
          for (int ds = 0; ds < 4; ++ds) Qf[ds] = *(const bf16x8*)(qp + ds * 16); }
        AttnStage st;
        attn_stage_load(P, sl, head, 0, tid, st); attn_stage_store(lds, tid, st); attn_stage_load(P, sl, head, 1, tid, st);
        __syncthreads();
        f32x16 O[4];
#pragma unroll
        for (int v = 0; v < 4; ++v)
#pragma unroll
            for (int r = 0; r < 16; ++r) O[v][r] = 0.f;
        float m_run = -INFINITY, l_run = 0.f;
#pragma unroll 1
        for (int kt = 0; kt < 65; ++kt) {
            if (kt + 1 < 65) attn_stage_store(lds + ((kt + 1) & 1) * 35840, tid, st);
            if (kt + 2 < 65) attn_stage_load(P, sl, head, kt + 2, tid, st);
            const unsigned char* buf = lds + (kt & 1) * 35840;
            const bf16_t* Kb = (const bf16_t*)buf; const bf16_t* Vb = (const bf16_t*)(buf + 17408);
            f32x16 S0, S1;
#pragma unroll
            for (int r = 0; r < 16; ++r) { S0[r] = 0.f; S1[r] = 0.f; }
#pragma unroll
            for (int ds = 0; ds < 4; ++ds) {
                const bf16x8 a0 = *(const bf16x8*)(Kb + qi * 136 + map * 64 + ds * 16 + hi * 8);
                const bf16x8 a1 = *(const bf16x8*)(Kb + (32 + qi) * 136 + map * 64 + ds * 16 + hi * 8);
                S0 = mfma32(a0, Qf[ds], S0); S1 = mfma32(a1, Qf[ds], S1); }
            if (kt == 64) {
#pragma unroll
                for (int r = 0; r < 16; ++r) { if (crow(r, hi) >= 16) S0[r] = -INFINITY; S1[r] = -INFINITY; } }
            float mx = -INFINITY;
#pragma unroll
            for (int r = 0; r < 16; ++r) mx = fmaxf(mx, fmaxf(S0[r], S1[r]));
            { const auto sw = __builtin_amdgcn_permlane32_swap(__float_as_uint(mx), __float_as_uint(mx), false, false); mx = fmaxf(__uint_as_float(sw[0]), __uint_as_float(sw[1])); }
            const float m_new = fmaxf(m_run, mx); const float alpha = __builtin_amdgcn_exp2f(m_run - m_new); m_run = m_new;
            float ps = 0.f;
#pragma unroll
            for (int r = 0; r < 16; ++r) { S0[r] = __builtin_amdgcn_exp2f(S0[r] - m_new); S1[r] = __builtin_amdgcn_exp2f(S1[r] - m_new); ps += S0[r] + S1[r]; }
            l_run = l_run * alpha + ps;
            if (__builtin_amdgcn_ballot_w64(alpha != 1.0f) != 0ull) {
#pragma unroll
                for (int v = 0; v < 4; ++v)
#pragma unroll
                    for (int r = 0; r < 16; ++r) O[v][r] *= alpha; }
            bf16x8 pf[2][2];
#pragma unroll
            for (int half = 0; half < 2; ++half) {
                uint4 a, b;
                a.x = pk2(S0[half * 8 + 0], S0[half * 8 + 1]); a.y = pk2(S0[half * 8 + 2], S0[half * 8 + 3]); a.z = pk2(S0[half * 8 + 4], S0[half * 8 + 5]); a.w = pk2(S0[half * 8 + 6], S0[half * 8 + 7]);
                b.x = pk2(S1[half * 8 + 0], S1[half * 8 + 1]); b.y = pk2(S1[half * 8 + 2], S1[half * 8 + 3]); b.z = pk2(S1[half * 8 + 4], S1[half * 8 + 5]); b.w = pk2(S1[half * 8 + 6], S1[half * 8 + 7]);
                pf[0][half] = __builtin_bit_cast(bf16x8, a); pf[1][half] = __builtin_bit_cast(bf16x8, b); }
#pragma unroll
            for (int v = 0; v < 4; ++v)
#pragma unroll
                for (int sub = 0; sub < 2; ++sub)
#pragma unroll
                    for (int half = 0; half < 2; ++half) {
                        const bf16x8 av = *(const bf16x8*)(Vb + (v * 32 + qi) * 72 + sub * 32 + half * 16 + hi * 8);
                        O[v] = mfma32(av, pf[sub][half], O[v]); }
            __syncthreads();
        }
        const float l_tot = l_run + __shfl_xor(l_run, 32); const float inv = 1.0f / l_tot;
        if (map == 1) {
#pragma unroll
            for (int v = 0; v < 4; ++v)
#pragma unroll
                for (int r = 0; r < 16; ++r) Ex[(qsub * 32 + qi) * 132 + v * 32 + crow(r, hi)] = O[v][r] * inv; }
        __syncthreads();
        if (map == 0) {
            float ss = 0.f;
#pragma unroll
            for (int v = 0; v < 4; ++v)
#pragma unroll
                for (int r = 0; r < 16; ++r) { const float o = O[v][r] * inv - lam * Ex[(qsub * 32 + qi) * 132 + v * 32 + crow(r, hi)]; O[v][r] = o; ss += o * o; }
            ss += __shfl_xor(ss, 32);
            const float rs = rsqrtf(ss * (1.f / 128.f) + 1e-5f) * (1.f - lam_init);
            if (qsub * 32 + qi < nvalid) {
                bf16_t* yp = slotp(P, 4) + (size_t)(qrow0 + qsub * 32 + qi) * 512 + head * 128;
#pragma unroll
                for (int v = 0; v < 4; ++v)
#pragma unroll
                    for (int rg = 0; rg < 4; ++rg) { const int vd0 = v * 32 + 8 * rg + 4 * hi; const f32x4 gg = *(const f32x4*)(P.in[I_SUBLN] + layer * 128 + vd0);
                        uint2 o; o.x = pk2(O[v][rg * 4 + 0] * rs * gg[0], O[v][rg * 4 + 1] * rs * gg[1]); o.y = pk2(O[v][rg * 4 + 2] * rs * gg[2], O[v][rg * 4 + 3] * rs * gg[3]);
                        *(uint2*)(yp + vd0) = o; } }
        }
        __syncthreads();
    }
}
DEV float dpp_f(float x, const int ctrl) { return x; }
template <int CTRL> DEV float dppmov(float x) { return __builtin_bit_cast(float, __builtin_amdgcn_update_dpp(0, __builtin_bit_cast(int, x), CTRL, 0xf, 0xf, true)); }
DEV float sum16(float x) { x += dppmov<0xB1>(x); x += dppmov<0x4E>(x); x += dppmov<0x141>(x); x += dppmov<0x140>(x); return x; }
constexpr int RW_CH = 16, RW_BUF_F = 5120 + 256 + 4096, RW_BUFB = RW_BUF_F * 4;
struct RwRegs { u32x4_t r, k, kk, e, a, v; };
DEV void unpack8v(const u32x4_t w, float* f) { unpack8(make_uint4(w.x, w.y, w.z, w.w), f); }
DEV void rw_stage_load(const Params& P, RwRegs& g, int sl, int head, int dir, int qr, int ck, int t) {
    if (t < 128) { const int step = t >> 3, ch8 = (t & 7) * 8, sidx = ck * RW_CH + step;
        if (sidx < LSEQ) { const int p = dir ? LSEQ - 1 - sidx : sidx; const size_t ro = (size_t)row_of(sl, p) * 512 + head * 64 + ch8;
            g.r = *(const u32x4_t*)(slotp(P, 17) + ro); g.k = *(const u32x4_t*)(slotp(P, 18) + ro); g.kk = *(const u32x4_t*)(slotp(P, 20) + ro);
            g.e = *(const u32x4_t*)(slotp(P, 22 + dir) + ro); g.a = *(const u32x4_t*)(slotp(P, dir == 0 ? 24 : 13) + ro); } }
    if (t < 32) { const int tt = t, s2 = tt >> 1, r8 = (tt & 1) * 8, si2 = ck * RW_CH + s2;
        if (si2 < LSEQ) { const int p2 = dir ? LSEQ - 1 - si2 : si2; g.v = *(const u32x4_t*)(slotp(P, 19) + (size_t)row_of(sl, p2) * 512 + head * 64 + qr * 16 + r8); } }
}
DEV void rw_stage_write(const Params& P, int layer, unsigned char* buf, const RwRegs& g, int head, int ck, int t) {
    float* Rr = (float*)buf; float* Ww = Rr + 1024; float* Kd = Ww + 1024; float* Kk = Kd + 1024; float* Bb = Kk + 1024; float* Vs = Bb + 1024;
    if (t < 128) { const int step = t >> 3, ch8 = (t & 7) * 8, sidx = ck * RW_CH + step;
        if (sidx < LSEQ) {
            float r[8], k[8], kk[8], e[8], a[8];
            unpack8v(g.r, r); unpack8v(g.k, k); unpack8v(g.kk, kk); unpack8v(g.e, e); unpack8v(g.a, a);
            float ww[8], kd[8], bb[8];
#pragma unroll
            for (int j = 0; j < 8; ++j) { ww[j] = __expf(-e[j]); kd[j] = k[j] * (1.f + (a[j] - 1.f) * P.in[I_KA][layer * 512 + head * 64 + ch8 + j]); bb[j] = kk[j] * a[j]; }
            const int o = step * 64 + ch8;
            *(f32x4*)(Rr + o) = (f32x4){r[0], r[1], r[2], r[3]}; *(f32x4*)(Rr + o + 4) = (f32x4){r[4], r[5], r[6], r[7]};
            *(f32x4*)(Ww + o) = (f32x4){ww[0], ww[1], ww[2], ww[3]}; *(f32x4*)(Ww + o + 4) = (f32x4){ww[4], ww[5], ww[6], ww[7]};
            *(f32x4*)(Kd + o) = (f32x4){kd[0], kd[1], kd[2], kd[3]}; *(f32x4*)(Kd + o + 4) = (f32x4){kd[4], kd[5], kd[6], kd[7]};
            *(f32x4*)(Kk + o) = (f32x4){kk[0], kk[1], kk[2], kk[3]}; *(f32x4*)(Kk + o + 4) = (f32x4){kk[4], kk[5], kk[6], kk[7]};
            *(f32x4*)(Bb + o) = (f32x4){bb[0], bb[1], bb[2], bb[3]}; *(f32x4*)(Bb + o + 4) = (f32x4){bb[4], bb[5], bb[6], bb[7]};
        } }
    if (t < 32) { const int tt = t, s2 = tt >> 1, r8 = (tt & 1) * 8, si2 = ck * RW_CH + s2;
        if (si2 < LSEQ) { float v[8]; unpack8v(g.v, v);
            *(f32x4*)(Vs + s2 * 16 + r8) = (f32x4){v[0], v[1], v[2], v[3]}; *(f32x4*)(Vs + s2 * 16 + r8 + 4) = (f32x4){v[4], v[5], v[6], v[7]}; } }
}
DEV void rw_flush(const Params& P, const unsigned char* buf, int sl, int head, int dir, int qr, int ck, int t) {
    if (t >= 160 && t < 192) { const float* Op = (const float*)buf + 5376; const int tt = t - 160, s2 = tt >> 1, r8 = (tt & 1) * 8, sidx = ck * RW_CH + s2;
        if (sidx < LSEQ) { const int p = dir ? LSEQ - 1 - sidx : sidx; float o[8];
#pragma unroll
            for (int j = 0; j < 8; ++j) { const int row = r8 + j; const f32x4* q = (const f32x4*)(Op + s2 * 256 + (row >> 2) * 64 + (row & 3) * 16);
                const f32x4 a = q[0], b = q[1], c = q[2], d = q[3];
                o[j] = ((a[0] + a[1]) + (a[2] + a[3])) + ((b[0] + b[1]) + (b[2] + b[3])) + (((c[0] + c[1]) + (c[2] + c[3])) + ((d[0] + d[1]) + (d[2] + d[3]))); }
            *(uint4*)(slotp(P, 15 + dir) + (size_t)row_of(sl, p) * 512 + head * 64 + qr * 16 + r8) = pack8(o); } }
}
DEV void phase_rw_scan(const Params& P0, int layer, unsigned char* lds, int bid, int nb, int wv) {
    Params P = load_params(); asm volatile("" : "+s"(P.ws));
    const int tid = launder_tid(wv), lane = tid & 63, w = __builtin_amdgcn_readfirstlane(tid >> 6), li = lane & 15, rl = (w & 3) * 4 + (lane >> 4);
    constexpr int NCK = (LSEQ + RW_CH - 1) / RW_CH;
    typedef float f32x2 __attribute__((ext_vector_type(2)));
    for (int unit = bid; unit < 256; unit += nb) {
        const int sl = unit >> 6, head = (unit >> 3) & 7, dir = (unit >> 2) & 1, qr = unit & 3;
        f32x2 SA = (f32x2){0.f, 0.f}, SB = (f32x2){0.f, 0.f};
        RwRegs g; g.r = g.k = g.kk = g.e = g.a = g.v = (u32x4_t){0u, 0u, 0u, 0u};
        if (w >= 4) { rw_stage_load(P, g, sl, head, dir, qr, 0, tid - 256); rw_stage_write(P, layer, lds, g, head, 0, tid - 256); rw_stage_load(P, g, sl, head, dir, qr, 1, tid - 256); }
        __syncthreads();
#pragma unroll 1
        for (int ck = 0; ck < NCK; ++ck) {
            unsigned char* buf = lds + (ck & 1) * RW_BUFB;
            if (w >= 4) {
                if (ck + 1 < NCK) rw_stage_write(P, layer, lds + ((ck + 1) & 1) * RW_BUFB, g, head, ck + 1, tid - 256);
                if (ck + 2 < NCK) rw_stage_load(P, g, sl, head, dir, qr, ck + 2, tid - 256);
                if (ck > 0) rw_flush(P, lds + ((ck - 1) & 1) * RW_BUFB, sl, head, dir, qr, ck - 1, tid - 256);
            } else {
                const float* Rr = (const float*)buf + li * 4; const float* Vs = (const float*)buf + 5120 + rl; float* Op = (float*)buf + 5376 + w * 64 + lane;
                const int ns = (LSEQ - ck * RW_CH) < RW_CH ? (LSEQ - ck * RW_CH) : RW_CH;
                f32x4 rr = *(const f32x4*)(Rr), ww = *(const f32x4*)(Rr + 1024), kd = *(const f32x4*)(Rr + 2048), kk = *(const f32x4*)(Rr + 3072), bb = *(const f32x4*)(Rr + 4096); float vv = Vs[0];
#pragma unroll 2
                for (int i = 0; i < ns; ++i) {
                    const int in = i < RW_CH - 1 ? i + 1 : RW_CH - 1;
                    const f32x4 rr_n = *(const f32x4*)(Rr + in * 64), ww_n = *(const f32x4*)(Rr + 1024 + in * 64), kd_n = *(const f32x4*)(Rr + 2048 + in * 64);
                    const f32x4 kk_n = *(const f32x4*)(Rr + 3072 + in * 64), bb_n = *(const f32x4*)(Rr + 4096 + in * 64); const float vv_n = Vs[in * 16];
                    f32x2 p = SA * (f32x2){kk[0], kk[1]}; p = __builtin_elementwise_fma(SB, (f32x2){kk[2], kk[3]}, p);
                    const f32x2 vv2 = (f32x2){vv, vv};
                    const f32x2 ta = vv2 * (f32x2){kd[0], kd[1]}, tb = vv2 * (f32x2){kd[2], kd[3]};
                    const float sa = -sum16(p[0] + p[1]);
                    const f32x2 sa2 = (f32x2){sa, sa};
                    SA = __builtin_elementwise_fma(SA, (f32x2){ww[0], ww[1]}, __builtin_elementwise_fma(sa2, (f32x2){bb[0], bb[1]}, ta));
                    SB = __builtin_elementwise_fma(SB, (f32x2){ww[2], ww[3]}, __builtin_elementwise_fma(sa2, (f32x2){bb[2], bb[3]}, tb));
                    f32x2 q = SA * (f32x2){rr[0], rr[1]}; q = __builtin_elementwise_fma(SB, (f32x2){rr[2], rr[3]}, q);
                    Op[i * 256] = q[0] + q[1];
                    rr = rr_n; ww = ww_n; kd = kd_n; kk = kk_n; bb = bb_n; vv = vv_n;
                }
            }
            __syncthreads();
        }
        if (w >= 4) rw_flush(P, lds + ((NCK - 1) & 1) * RW_BUFB, sl, head, dir, qr, NCK - 1, tid - 256);
        __syncthreads();
    }
}
static_assert(LSEQ == 257 * 16, "chunked RWKV assumes whole 16-step chunks");
constexpr int RWC_REC = 8960, RWC_NCK = 257;
DEV unsigned char* rwc_rec(const Params& P, int dir, int idx) {
    if (dir == 0) return (unsigned char*)slotp(P, 5) + (size_t)idx * RWC_REC;
    if (idx < 5705) return (unsigned char*)slotp(P, 10) + (size_t)idx * RWC_REC;
    if (idx < 7606) return (unsigned char*)slotp(P, 21) + (size_t)(idx - 5705) * RWC_REC;
    return (unsigned char*)slotp(P, 5) + (size_t)(8224 + idx - 7606) * RWC_REC; }
DEV int rwc_slot(int c) { return (((c >> 5) * 4 + ((c >> 2) & 3)) * 8) + ((c >> 4) & 1) * 4 + (c & 3); }
DEV void phase_rwc_pre(const Params& P0, int layer, unsigned char* lds, int bid, int nb, int wv) {
    Params P = load_params(); asm volatile("" : "+s"(P.ws));
    const int tid = launder_tid(wv), lane = tid & 63, w = __builtin_amdgcn_readfirstlane(tid >> 6), l15 = lane & 15, quad = lane >> 4;
    unsigned char* wl = lds + w * 15616;
    bf16_t* Bt = (bf16_t*)wl; bf16_t* Dt = Bt + 16 * 72; bf16_t* Ak = Dt + 16 * 72; bf16_t* Rt = Ak + 16 * 72;
    float* Mb = (float*)(wl + 9216); float* Md = Mb + 256; float* Gb = Md + 256; float* Gd = Gb + 256; float* Tm = Gd + 256; float* Nm = Tm + 256;
    const float ka = P.in[I_KA][layer * 512 + 0];  (void)ka;
    for (int unit2 = bid * 8 + w; unit2 < 2 * 32 * RWC_NCK; unit2 += nb * 8) {
        const int dir = unit2 >= 32 * RWC_NCK ? 1 : 0; const int unit = unit2 - dir * 32 * RWC_NCK;
        const int sh = unit / RWC_NCK, ck = unit - sh * RWC_NCK, sl = sh >> 3, head = sh & 7;
        const float kac = P.in[I_KA][layer * 512 + head * 64 + lane];
        float ak[16], bt[16], dt[16], rt[16];
        float g = 1.f;
#pragma unroll
        for (int t = 0; t < 16; ++t) {
            const int sidx = ck * 16 + t;
            const int p = dir ? LSEQ - 1 - sidx : sidx; const size_t ro = (size_t)row_of(sl, p) * 512 + head * 64 + lane;
            const float r = bf2f(slotp(P, 17)[ro]), k = bf2f(slotp(P, 18)[ro]), kk = bf2f(slotp(P, 20)[ro]), e = bf2f(slotp(P, 22 + dir)[ro]), a = bf2f(slotp(P, dir == 0 ? 24 : 13)[ro]);
            const float wdec = __expf(-e), kd = k * (1.f + (a - 1.f) * kac), b = kk * a;
            ak[t] = g * kk; g *= wdec; const float gi = 1.0f / g; bt[t] = b * gi; dt[t] = kd * gi; rt[t] = g * r;
        }
        const float gC = g;
#pragma unroll
        for (int t = 0; t < 16; ++t) { Bt[t * 72 + lane] = (bf16_t)(pk2(bt[t], 0.f) & 0xffffu); Dt[t * 72 + lane] = (bf16_t)(pk2(dt[t], 0.f) & 0xffffu);
            Ak[t * 72 + lane] = (bf16_t)(pk2(ak[t], 0.f) & 0xffffu); Rt[t * 72 + lane] = (bf16_t)(pk2(rt[t], 0.f) & 0xffffu); }
        asm volatile("s_waitcnt lgkmcnt(0)" ::: "memory");
        {
            f32x4 mb = (f32x4){0.f, 0.f, 0.f, 0.f}, md = mb, gb = mb, gd = mb;
#pragma unroll
            for (int ks = 0; ks < 2; ++ks) {
                const bf16x8 fb = *(const bf16x8*)(Bt + l15 * 72 + ks * 32 + quad * 8), fd = *(const bf16x8*)(Dt + l15 * 72 + ks * 32 + quad * 8);
                const bf16x8 fa = *(const bf16x8*)(Ak + l15 * 72 + ks * 32 + quad * 8), fr = *(const bf16x8*)(Rt + l15 * 72 + ks * 32 + quad * 8);
                mb = mfma16(fb, fa, mb); md = mfma16(fd, fa, md); gb = mfma16(fb, fr, gb); gd = mfma16(fd, fr, gd); }
#pragma unroll
            for (int jj = 0; jj < 4; ++jj) { const int j = quad * 4 + jj, t = l15;
                Mb[j * 16 + t] = j < t ? mb[jj] : 0.f; Md[j * 16 + t] = j < t ? md[jj] : 0.f; Gb[j * 16 + t] = j <= t ? gb[jj] : 0.f; Gd[j * 16 + t] = j <= t ? gd[jj] : 0.f; }
        }
        asm volatile("s_waitcnt lgkmcnt(0)" ::: "memory");
        {
            float tc[16];
#pragma unroll
            for (int i = 15; i >= 0; --i) { float acc = (i == l15) ? 1.f : 0.f;
#pragma unroll
                for (int l = i + 1; l < 16; ++l) acc -= Mb[i * 16 + l] * tc[l];
                tc[i] = acc; }
            if (quad == 0) {
#pragma unroll
                for (int i = 0; i < 16; ++i) Tm[i * 16 + l15] = tc[i]; }
        }
        asm volatile("s_waitcnt lgkmcnt(0)" ::: "memory");
        {
            float n4[4] = {0.f, 0.f, 0.f, 0.f};
#pragma unroll
            for (int l = 0; l < 16; ++l) { const float tv = Tm[l * 16 + l15];
#pragma unroll
                for (int jj = 0; jj < 4; ++jj) n4[jj] += Md[(quad * 4 + jj) * 16 + l] * tv; }
#pragma unroll
            for (int jj = 0; jj < 4; ++jj) Nm[(quad * 4 + jj) * 16 + l15] = n4[jj];
        }
        asm volatile("s_waitcnt lgkmcnt(0)" ::: "memory");
        unsigned char* rec = rwc_rec(P, dir, unit);
        {
            float q4[4];
#pragma unroll
            for (int jj = 0; jj < 4; ++jj) q4[jj] = Gd[(quad * 4 + jj) * 16 + l15];
#pragma unroll
            for (int l = 0; l < 16; ++l) { const float gv = Gb[l * 16 + l15];
#pragma unroll
                for (int jj = 0; jj < 4; ++jj) q4[jj] -= Nm[(quad * 4 + jj) * 16 + l] * gv; }
            *(uint2*)((bf16_t*)(rec + 8192) + l15 * 16 + quad * 4) = make_uint2(pk2(q4[0], q4[1]), pk2(q4[2], q4[3]));
        }
        {
            float ap[16], rp[16], ps[16];
#pragma unroll
            for (int t = 0; t < 16; ++t) { float acc = 0.f;
#pragma unroll
                for (int j = 0; j < 16; ++j) acc += ak[j] * Tm[j * 16 + t];
                ap[t] = acc; }
#pragma unroll
            for (int t = 0; t < 16; ++t) { float acc = rt[t];
#pragma unroll
                for (int j = 0; j < 16; ++j) acc -= ap[j] * Gb[j * 16 + t];
                rp[t] = acc; }
#pragma unroll
            for (int j = 0; j < 16; ++j) { float acc = dt[j];
#pragma unroll
                for (int l = 0; l < 16; ++l) acc -= Nm[j * 16 + l] * bt[l];
                ps[j] = acc * gC; }
            bf16_t* AP = (bf16_t*)rec; bf16_t* RP = AP + 1024; const int so = rwc_slot(lane);
#pragma unroll
            for (int t = 0; t < 16; ++t) { AP[t * 64 + so] = (bf16_t)(pk2(ap[t], 0.f) & 0xffffu); RP[t * 64 + so] = (bf16_t)(pk2(rp[t], 0.f) & 0xffffu); }
            float nb_[16];
#pragma unroll
            for (int t = 0; t < 16; ++t) nb_[t] = -bt[t] * gC;
            uint4* BP = (uint4*)(rec + 4096) + lane * 2; BP[0] = pack8(nb_); BP[1] = pack8(nb_ + 8);
            uint4* PP = (uint4*)(rec + 6144) + lane * 2; PP[0] = pack8(ps); PP[1] = pack8(ps + 8);
            ((float*)(rec + 8704))[lane] = gC;
        }
        asm volatile("s_waitcnt lgkmcnt(0)" ::: "memory");
    }
}
struct RwcRegs { u32x4_t a, b, c, v; };
DEV void rwc_load(const Params& P, RwcRegs& g, int sh, int dir, int ck, int t) {
    const unsigned char* rec = rwc_rec(P, dir, sh * RWC_NCK + ck);
    g.a = *(const u32x4_t*)(rec + (size_t)t * 16); g.b = *(const u32x4_t*)(rec + (size_t)(t + 256) * 16);
    if (t < 48) g.c = *(const u32x4_t*)(rec + (size_t)(t + 512) * 16);
    if (t < 128) { const int j = t >> 3, r8 = (t & 7) * 8, sidx = ck * 16 + j; const int sc = sidx < LSEQ ? sidx : LSEQ - 1; const int p = dir ? LSEQ - 1 - sc : sc;
        g.v = *(const u32x4_t*)(slotp(P, 19) + (size_t)row_of(sh >> 3, p) * 512 + (sh & 7) * 64 + r8); if (sidx >= LSEQ) g.v = (u32x4_t){0u, 0u, 0u, 0u}; }
}
DEV void rwc_store(unsigned char* buf, const RwcRegs& g, int t) {
    *(u32x4_t*)(buf + t * 16) = g.a; *(u32x4_t*)(buf + (t + 256) * 16) = g.b;
    if (t < 48) *(u32x4_t*)(buf + (t + 512) * 16) = g.c;
    if (t < 128) { bf16_t* VsT = (bf16_t*)(buf + RWC_REC); const int j = t >> 3, r8 = (t & 7) * 8;
        VsT[(r8 + 0) * 16 + j] = (bf16_t)(g.v.x & 0xffffu); VsT[(r8 + 1) * 16 + j] = (bf16_t)(g.v.x >> 16); VsT[(r8 + 2) * 16 + j] = (bf16_t)(g.v.y & 0xffffu); VsT[(r8 + 3) * 16 + j] = (bf16_t)(g.v.y >> 16);
        VsT[(r8 + 4) * 16 + j] = (bf16_t)(g.v.z & 0xffffu); VsT[(r8 + 5) * 16 + j] = (bf16_t)(g.v.z >> 16); VsT[(r8 + 6) * 16 + j] = (bf16_t)(g.v.w & 0xffffu); VsT[(r8 + 7) * 16 + j] = (bf16_t)(g.v.w >> 16); }
}
DEV void phase_rwc_scan(const Params& P0, unsigned char* lds, int bid, int nb, int wv) {
    Params P = load_params(); asm volatile("" : "+s"(P.ws));
    const int tid = launder_tid(wv), lane = tid & 63, w = __builtin_amdgcn_readfirstlane(tid >> 6), l15 = lane & 15, quad = lane >> 4;
    constexpr int BUFB = RWC_REC + 2048;
    for (int u2 = bid; u2 < 64; u2 += nb) {
        const int sh = u2 & 31, dir = u2 >> 5; const int sl = sh >> 3, head = sh & 7;
        f32x4 ST[4];
#pragma unroll
        for (int ct = 0; ct < 4; ++ct) ST[ct] = (f32x4){0.f, 0.f, 0.f, 0.f};
        RwcRegs g; g.a = g.b = g.c = g.v = (u32x4_t){0u, 0u, 0u, 0u};
        if (w >= 4) { rwc_load(P, g, sh, dir, 0, tid - 256); rwc_store(lds, g, tid - 256); rwc_load(P, g, sh, dir, 1, tid - 256); }
        __syncthreads();
#pragma unroll 1
        for (int ck = 0; ck < RWC_NCK; ++ck) {
            const unsigned char* buf = lds + (ck & 1) * BUFB;
            if (w >= 4) {
                if (ck + 1 < RWC_NCK) rwc_store(lds + ((ck + 1) & 1) * BUFB, g, tid - 256);
                if (ck + 2 < RWC_NCK) rwc_load(P, g, sh, dir, ck + 2, tid - 256);
            } else {
                const bf16_t* AP = (const bf16_t*)buf; const bf16_t* RP = AP + 1024; const bf16_t* BP = (const bf16_t*)(buf + 4096); const bf16_t* PP = (const bf16_t*)(buf + 6144);
                const bf16_t* QP = (const bf16_t*)(buf + 8192); const float* GC = (const float*)(buf + 8704); const bf16_t* VsT = (const bf16_t*)(buf + RWC_REC);
                const u32x4_t z4 = (u32x4_t){0u, 0u, 0u, 0u};
                u32x4_t sb0, sb1;
                sb0.x = pk2(ST[0][0], ST[0][1]); sb0.y = pk2(ST[0][2], ST[0][3]); sb0.z = pk2(ST[1][0], ST[1][1]); sb0.w = pk2(ST[1][2], ST[1][3]);
                sb1.x = pk2(ST[2][0], ST[2][1]); sb1.y = pk2(ST[2][2], ST[2][3]); sb1.z = pk2(ST[3][0], ST[3][1]); sb1.w = pk2(ST[3][2], ST[3][3]);
                const bf16x8 SB0 = __builtin_bit_cast(bf16x8, sb0), SB1 = __builtin_bit_cast(bf16x8, sb1);
                const bf16x8 a0 = *(const bf16x8*)(AP + l15 * 64 + (0 * 4 + quad) * 8), a1 = *(const bf16x8*)(AP + l15 * 64 + (1 * 4 + quad) * 8);
                const bf16x8 r0 = *(const bf16x8*)(RP + l15 * 64 + (0 * 4 + quad) * 8), r1 = *(const bf16x8*)(RP + l15 * 64 + (1 * 4 + quad) * 8);
                const u32x4_t vq = quad < 2 ? *(const u32x4_t*)(VsT + (w * 16 + l15) * 16 + quad * 8) : z4;
                const u32x4_t qq = quad < 2 ? *(const u32x4_t*)(QP + l15 * 16 + quad * 8) : z4;
                const bf16x8 VB = __builtin_bit_cast(bf16x8, vq), QA = __builtin_bit_cast(bf16x8, qq);
                f32x4 Wt = (f32x4){0.f, 0.f, 0.f, 0.f}, Ot = Wt;
                Wt = mfma16(a0, SB0, Wt); Wt = mfma16(a1, SB1, Wt);
                Ot = mfma16(r0, SB0, Ot); Ot = mfma16(r1, SB1, Ot); Ot = mfma16(QA, VB, Ot);
                u32x4_t wb; wb.x = pk2(Wt[0], Wt[1]); wb.y = pk2(Wt[2], Wt[3]); wb.z = 0u; wb.w = 0u;
                const bf16x8 WB = __builtin_bit_cast(bf16x8, wb);
#pragma unroll
                for (int ct = 0; ct < 4; ++ct) {
                    const f32x4 gc = *(const f32x4*)(GC + ct * 16 + quad * 4);
                    const uint2 bq = *(const uint2*)(BP + (ct * 16 + l15) * 16 + quad * 4);
                    u32x4_t ba; ba.x = bq.x; ba.y = bq.y; ba.z = 0u; ba.w = 0u;
                    const u32x4_t pq = quad < 2 ? *(const u32x4_t*)(PP + (ct * 16 + l15) * 16 + quad * 8) : z4;
                    f32x4 acc = ST[ct] * gc;
                    acc = mfma16(__builtin_bit_cast(bf16x8, ba), WB, acc);
                    acc = mfma16(__builtin_bit_cast(bf16x8, pq), VB, acc);
                    ST[ct] = acc;
                }
                bf16_t* Oo = slotp(P, 15 + dir);
#pragma unroll
                for (int jj = 0; jj < 4; ++jj) { const int sidx = ck * 16 + quad * 4 + jj;
                    if (sidx < LSEQ) { const int p = dir ? LSEQ - 1 - sidx : sidx; Oo[(size_t)row_of(sl, p) * 512 + head * 64 + w * 16 + l15] = (bf16_t)(pk2(Ot[jj], 0.f) & 0xffffu); } }
            }
            __syncthreads();
        }
    }
}

#define LAS __attribute__((address_space(3)))
#define XB_TMO      128
#define XB_XCNT(j)  (256  + 64 * (j))
#define XB_XSUB(j)  (1280 + 64 * (j))
#define XB_XGEN(j)  (2304 + 64 * (j))
#define XB_TOP      3328
#define XB_TOPGEN   3392
#define XCD_BAR_WORDS 3456
#define XB_SPIN_CAP (1u << 18)

__device__ __forceinline__ unsigned xb_ld(unsigned* p)              { return __hip_atomic_load(p, __ATOMIC_RELAXED, __HIP_MEMORY_SCOPE_AGENT); }
__device__ __forceinline__ unsigned xb_add(unsigned* p, unsigned v) { return __hip_atomic_fetch_add(p, v, __ATOMIC_RELAXED, __HIP_MEMORY_SCOPE_AGENT); }
__device__ __forceinline__ unsigned xb_xcc_id() { return (unsigned)__builtin_amdgcn_s_getreg((3 << 11) | 20) & 0xFu; }
#define XB_SPIN(cond, bar) do { unsigned _sp = 0; while (cond) { __builtin_amdgcn_s_sleep(1); \
    if ((++_sp & 255u) == 0u) { if (xb_ld(&(bar)[XB_TMO])) break; if (_sp > XB_SPIN_CAP) { atomicAdd(&(bar)[XB_TMO], 1u); break; } } } } while (0)

struct XcdBarrier {
    unsigned* bar; unsigned x;
    volatile LAS unsigned* st;
};

__device__ __forceinline__ XcdBarrier xcd_barrier_post(unsigned* bar, volatile LAS unsigned* st, int wv) {
    XcdBarrier b; b.bar = bar; b.x = xb_xcc_id(); b.st = st;
    if (launder_tid(wv) == 0) (void)xb_add(&bar[XB_XCNT(b.x)], 1u);
    return b;
}
__device__ __forceinline__ void xcd_barrier_complete(unsigned* bar, unsigned x, unsigned& nloc, unsigned& nx) {
    const unsigned G = gridDim.x * gridDim.y * gridDim.z;
    unsigned sum, cnt, mine, sp = 0u;
    for (;;) {
        sum = 0u; cnt = 0u; mine = 0u;
#pragma unroll
        for (unsigned j = 0; j < 16; ++j) { const unsigned c = xb_ld(&bar[XB_XCNT(j)]); sum += c; cnt += (c > 0u) ? 1u : 0u; mine = (j == x) ? c : mine; }
        if (sum == G) break;
        __builtin_amdgcn_s_sleep(1);
        if ((++sp & 255u) == 0u) { if (xb_ld(&bar[XB_TMO])) break; if (sp > XB_SPIN_CAP) { atomicAdd(&bar[XB_TMO], 1u); break; } }
    }
    nloc = mine > 0u ? mine : 1u; nx = cnt > 0u ? cnt : 1u;
}

__device__ __forceinline__ void xcd_barrier(const XcdBarrier& b, int wv) {
    asm volatile("s_waitcnt vmcnt(0)" ::: "memory");
    __syncthreads();
    if (launder_tid(wv) == 0) {
        unsigned* bar = b.bar;
        __builtin_amdgcn_s_waitcnt(0);
        unsigned nloc = b.st[0], nx = b.st[1];
        if (nloc == 0u) { xcd_barrier_complete(bar, b.x, nloc, nx); b.st[0] = nloc; b.st[1] = nx; }
        const unsigned old = xb_add(&bar[XB_XSUB(b.x)], 1u);
        const unsigned gen = old / nloc;
        if (old + 1u == (gen + 1u) * nloc) {
            __builtin_amdgcn_fence(__ATOMIC_RELEASE, "agent");
            asm volatile("s_waitcnt vmcnt(0)" ::: "memory");
            const unsigned og = xb_add(&bar[XB_TOP], 1u);
            const unsigned tg = og / nx;
            if (og + 1u == (tg + 1u) * nx) xb_add(&bar[XB_TOPGEN], 1u);
            else XB_SPIN(xb_ld(&bar[XB_TOPGEN]) == tg, bar);
            __builtin_amdgcn_fence(__ATOMIC_ACQUIRE, "agent");
            xb_add(&bar[XB_XGEN(b.x)], 1u);
            asm volatile("s_waitcnt vmcnt(0)" ::: "memory");
        } else {
            XB_SPIN(xb_ld(&bar[XB_XGEN(b.x)]) == gen, bar);
            __builtin_amdgcn_fence(__ATOMIC_ACQUIRE, "agent");
            asm volatile("s_waitcnt vmcnt(0)" ::: "memory");
        }
    }
    __syncthreads();
}

__global__ void __launch_bounds__(512) mega_fwd(Params P) {
    extern __shared__ __attribute__((aligned(16))) unsigned char lds[];
    cg::grid_group grid = cg::this_grid();
    const int bid = blockIdx.x, nb = gridDim.x; const int wv = __builtin_amdgcn_readfirstlane(threadIdx.x >> 6);
    volatile LAS unsigned* MISC = (volatile LAS unsigned*)((LAS unsigned char*)lds + 131072 + 256);
    if (threadIdx.x < 4) MISC[threadIdx.x] = 0u;
    __syncthreads();
    XcdBarrier xbar;
    { Params Pb = load_params(); xbar = xcd_barrier_post((unsigned*)Pb.ws, MISC, wv); }
#define GSYNC() xcd_barrier(xbar, wv)
    PG8_LAS unsigned char* ldsl = (PG8_LAS unsigned char*)lds;
#pragma unroll 1
    for (int layer_ = 0; layer_ < 2; ++layer_) {
        phase_weights(P, lsd(layer_), lds, bid, nb, wv);
        grid.sync();
#pragma unroll 1
        for (int g_ = 0; g_ < NGRP; ++g_) {
            #define Mpost ((lsd(layer_) == 0 && lsd(g_) == 2) ? TGP : TREAL)
#define NVALID ((lsd(layer_) == 0 && lsd(g_) == 2) ? TG + 128 : TG)
            phase_rmsnorm(P, lsd(g_), lsd(layer_) == 0, I_NMIX, lsd(layer_), TGP, NVALID, bid, nb, wv);
            if (PROBE == 5) { phase_rmsnorm(P, lsd(g_), lsd(layer_) == 0, I_NMIX, lsd(layer_), TGP, NVALID, bid, nb, wv); }
            GSYNC();
            if (PROBE == 6) { for (int q_ = 0; q_ < 15; ++q_) GSYNC(); }
            for (int rep_ = 0; rep_ < (PROBE == 3 ? 2 : 1); ++rep_)
            { Params Pl = load_params(); asm volatile("" : "+s"(Pl.ws)); pg8::bf16_t* W = (pg8::bf16_t*)(Pl.ws + WS_W); pg8::Gemm gm{slotp(Pl, 0), W + WO_IN, TGP, 7680, 1024, 0, 0}; pg8::StaticOrder S; S.init(TGP, 7680, nb, bid);
              pg8::EpiBf<0> E{slotp(Pl, 2), 512, SLOT_E};
              pg8::gemm_phase<pg8::EpiBf<0>, pg8::StaticOrder, true, true>(ldsl, gm, S, E, wv); }
            GSYNC();
            phase_da_prep(P, lsd(layer_), bid, nb, wv);
            phase_hg1(P, lsd(layer_), lds, bid, nb, wv);
            if (PROBE == 4) { phase_hg1(P, lsd(layer_), lds, bid, nb, wv); }
            GSYNC();
            phase_hg2(P, bid, nb, wv);
            GSYNC();
            phase_hg3(P, lsd(layer_), lds, bid, nb, wv);
            GSYNC();
            phase_conv(P, lsd(layer_), bid, nb, wv);
            if (PROBE == 5) { phase_conv(P, lsd(layer_), bid, nb, wv); }
            phase_vtrans(P, lds, bid, nb, wv);
            if (PROBE == 5) { phase_vtrans(P, lds, bid, nb, wv); }
            phase_rw_prep(P, lsd(layer_), bid, nb, wv);
            if (PROBE == 5) { phase_rw_prep(P, lsd(layer_), bid, nb, wv); }
            GSYNC();
            { Params Pl = load_params(); asm volatile("" : "+s"(Pl.ws)); pg8::bf16_t* W = (pg8::bf16_t*)(Pl.ws + WS_W); pg8::Gemm gm{slotp(Pl, 21), W + WO_LR, TGP, 2560, 384, 0, 0}; pg8::StaticOrder S; S.init(TGP, 2560, nb, bid);
              pg8::EpiLR E{slotp(Pl, 22), slotp(Pl, 23), slotp(Pl, 24), slotp(Pl, 13), slotp(Pl, 14), Pl.in[I_W0] + lsd(layer_) * 1024, Pl.in[I_A0] + lsd(layer_) * 1024};
              pg8::gemm_phase<pg8::EpiLR, pg8::StaticOrder, true, true>(ldsl, gm, S, E, wv); }
            phase_attn(P, lsd(layer_), lds, bid, nb, wv);
            if (PROBE == 2) { phase_attn(P, lsd(layer_), lds, bid, nb, wv); }
            GSYNC();
            phase_rwc_pre(P, lsd(layer_), lds, bid, nb, wv);
            if (PROBE == 12) { phase_rwc_pre(P, lsd(layer_), lds, bid, nb, wv); }
            GSYNC();
            phase_rwc_scan(P, lds, bid, nb, wv);
            GSYNC();
            phase_rw_post(P, lsd(layer_), lsd(g_), lsd(layer_) == 0 ? TG : TREAL, bid, nb, wv);
            if (PROBE == 5) { phase_rw_post(P, lsd(layer_), lsd(g_), lsd(layer_) == 0 ? TG : TREAL, bid, nb, wv); }
            GSYNC();
            { Params Pl = load_params(); asm volatile("" : "+s"(Pl.ws)); pg8::bf16_t* W = (pg8::bf16_t*)(Pl.ws + WS_W); pg8::Gemm gm{slotp(Pl, 2), W + WO_BP, Mpost, 4096, 512, 4, SLOT_B}; pg8::StaticOrder S; S.init(Mpost, 4096, nb, bid);
              pg8::EpiBf<0> E{slotp(Pl, 6), 4096, 0};
              pg8::gemm_phase<pg8::EpiBf<0>, pg8::StaticOrder, true, true>(ldsl, gm, S, E, wv); }
            GSYNC();
            { Params Pl = load_params(); asm volatile("" : "+s"(Pl.ws)); pg8::bf16_t* W = (pg8::bf16_t*)(Pl.ws + WS_W); pg8::Gemm gm{slotp(Pl, 0), W + WO_G, Mpost, 4096, 1024, 0, 0}; pg8::StaticOrder S; S.init(Mpost, 4096, nb, bid);
              pg8::EpiGate E{slotp(Pl, 6), slotp(Pl, 14)};
              pg8::gemm_phase<pg8::EpiGate, pg8::StaticOrder, true, true>(ldsl, gm, S, E, wv); }
            GSYNC();
            { Params Pl = load_params(); asm volatile("" : "+s"(Pl.ws)); pg8::bf16_t* W = (pg8::bf16_t*)(Pl.ws + WS_W); pg8::Gemm gm{slotp(Pl, 14), W + WO_OUT, Mpost, 1024, 1024, 0, 0}; pg8::StaticOrder S; S.init(Mpost, 1024, nb, bid);
              pg8::EpiResid E{lsd(layer_) == 0 ? x_in_row(Pl, lsd(g_), 0) : (const float*)x_cur_row(Pl, lsd(g_), 0), lsd(layer_) == 0 ? Pl.in[I_META] : (const float*)nullptr, x_cur_row(Pl, lsd(g_), 0), (float*)(Pl.ws + WS_XMETA), lsd(g_), NVALID};
              pg8::gemm_phase<pg8::EpiResid, pg8::StaticOrder, true, true>(ldsl, gm, S, E, wv); }
            GSYNC();
            phase_rmsnorm(P, lsd(g_), false, I_NMLP, lsd(layer_), Mpost, NVALID, bid, nb, wv);
            if (PROBE == 5) { phase_rmsnorm(P, lsd(g_), false, I_NMLP, lsd(layer_), Mpost, NVALID, bid, nb, wv); }
            GSYNC();
            for (int rep_ = 0; rep_ < (PROBE == 7 ? 2 : 1); ++rep_)
            { Params Pl = load_params(); asm volatile("" : "+s"(Pl.ws)); pg8::bf16_t* W = (pg8::bf16_t*)(Pl.ws + WS_W); pg8::Gemm gm{slotp(Pl, 0), W + WO_1, Mpost, 4096, 1024, 0, 0}; pg8::StaticOrder S; S.init(Mpost, 4096, nb, bid);
              pg8::EpiBf<1> E{slotp(Pl, 6), 4096, 0};
              pg8::gemm_phase<pg8::EpiBf<1>, pg8::StaticOrder, true, true>(ldsl, gm, S, E, wv); }
            GSYNC();
            { Params Pl = load_params(); asm volatile("" : "+s"(Pl.ws)); pg8::bf16_t* W = (pg8::bf16_t*)(Pl.ws + WS_W); pg8::Gemm gm{slotp(Pl, 6), W + WO_2, Mpost, 1024, 4096, 0, 0}; pg8::StaticOrder S; S.init(Mpost, 1024, nb, bid);
              pg8::EpiResid E{(const float*)x_cur_row(Pl, lsd(g_), 0), (const float*)nullptr, x_cur_row(Pl, lsd(g_), 0), (float*)(Pl.ws + WS_XMETA), lsd(g_), NVALID};
              pg8::gemm_phase<pg8::EpiResid, pg8::StaticOrder, true, true>(ldsl, gm, S, E, wv); }
            GSYNC();
        }
    }
}

extern "C" void kernel_launch(void* const* d_in, const int* in_sizes, int n_in, void* d_out, int out_size, void* d_ws, size_t ws_size, hipStream_t stream) {
    static int grid = 0;
    if (grid == 0) {
        if (n_in != 29 || ws_size < WS_NEED) { fprintf(stderr, "kernel_launch: need 29 inputs and %zu bytes of workspace; got %d, %zu\n", (size_t)WS_NEED, n_in, ws_size); grid = -1; return; }
        int dev = 0, cus = 0, per_cu = 0;
        if (hipGetDevice(&dev) != hipSuccess || hipDeviceGetAttribute(&cus, hipDeviceAttributeMultiprocessorCount, dev) != hipSuccess) { grid = -1; return; }
        if (hipFuncSetAttribute((const void*)mega_fwd, hipFuncAttributeMaxDynamicSharedMemorySize, LDS_BYTES) != hipSuccess) { fprintf(stderr, "kernel_launch: hipFuncSetAttribute failed\n"); grid = -1; return; }
        if (hipOccupancyMaxActiveBlocksPerMultiprocessor(&per_cu, (const void*)mega_fwd, 512, LDS_BYTES) != hipSuccess || per_cu < 1) { fprintf(stderr, "kernel_launch: occupancy query says %d\n", per_cu); per_cu = 1; }
        (void)hipGetLastError();
        grid = cus;
    }
    if (grid < 0) return;
    if (hipMemsetAsync(d_ws, 0, 16384, stream) != hipSuccess) { fprintf(stderr, "kernel_launch: memset failed\n"); return; }
    Params p{};
    for (int i = 0; i < 29; ++i) p.in[i] = (const float*)d_in[i];
    p.out = (float*)d_out; p.ws = (unsigned char*)d_ws;
    void* args[] = {&p};
    hipError_t e = hipLaunchCooperativeKernel((const void*)mega_fwd, dim3(grid), dim3(512), args, LDS_BYTES, stream);
    if (e != hipSuccess) fprintf(stderr, "kernel_launch: cooperative launch failed: %s (grid %d)\n", hipGetErrorString(e), grid);
}
```

```cpp
#include <hip/hip_runtime.h>
#include <hip/hip_cooperative_groups.h>
#include <cstdio>
#include <cstdint>
namespace cg = cooperative_groups;
#define PROBE 0
#define DEV __device__ __forceinline__
__device__ __forceinline__ int lsd(int x) { asm volatile("" : "+s"(x)); return x; }
__device__ __forceinline__ int launder_tid(int wv) { int l; asm volatile("v_mbcnt_lo_u32_b32 %0, -1, 0\n\tv_mbcnt_hi_u32_b32 %0, -1, %0" : "=v"(l)); return wv * 64 + l; }
namespace pg8 {
#define PG8_LAS __attribute__((address_space(3)))
typedef unsigned short bf16_t;
typedef short bf16x8 __attribute__((ext_vector_type(8)));
typedef float f32x4 __attribute__((ext_vector_type(4)));
typedef unsigned u32x4 __attribute__((ext_vector_type(4)));
constexpr int BM = 256, BK = 64, HALF = 128, HTB = HALF * BK * 2  , STAGE_BYTES = 8 * HTB, NXCD = 8, WGM = 8;

__host__ __device__ __forceinline__ int lds_byte(int r, int c) { const int st = (r >> 4) * 2 + (c >> 5), rr = r & 15, cc = c & 31, ob = rr * 64 + cc * 2; return st * 1024 + (ob ^ (((ob >> 9) & 1) << 5)); }
__host__ __device__ __forceinline__ void stage_rc(int b, int& R, int& C) { const int st = b / 1024, sb = b % 1024, swz = sb ^ (((sb >> 9) & 1) << 5); R = (st >> 1) * 16 + swz / 64; C = (st & 1) * 32 + (swz % 64) / 2; }
__host__ __device__ __forceinline__ int perm32(int rho) { const int n = rho >> 4, i = rho & 15; return 8 * (i >> 2) + 4 * n + (i & 3); }

struct Unit { int pm, pn; };
struct Gemm { const bf16_t* A; const bf16_t* Bt; int M, N, K; int pn_per_ab; size_t ab_stride; };

struct StaticOrder {
    int nM, nN, nwg, G, c;
    __host__ __device__ void init(int M, int N, int G_, int c_) { nM = M / BM; nN = N / BM; nwg = nM * nN; G = G_; c = c_; }
    __host__ __device__ bool next(int i, Unit& u) const {
        const long L = (long)i * G + c; if (L >= nwg) return false;
        int wgid = (int)L; { const int q = nwg / NXCD, r = nwg % NXCD, xcd = wgid % NXCD, off = wgid / NXCD; wgid = (xcd < r ? xcd * (q + 1) : r * (q + 1) + (xcd - r) * q) + off; }
        const int nig = WGM * nN, gid = wgid / nig, fm = gid * WGM, gsz = (nM - fm) < WGM ? (nM - fm) : WGM;
        u.pm = fm + ((wgid % nig) % gsz); u.pn = (wgid % nig) / gsz; return true;
    }
    __device__ __forceinline__ void a_ready(const Unit&) const {}
    __device__ __forceinline__ void done(const Unit&) const {}
};

typedef float f32x2cv_t __attribute__((ext_vector_type(2))); typedef __bf16 bf16x2cv_t __attribute__((ext_vector_type(2)));
__device__ __forceinline__ unsigned cvt_pk_bf16(float lo, float hi) { const f32x2cv_t v = {lo, hi}; const bf16x2cv_t b = __builtin_convertvector(v, bf16x2cv_t); return __builtin_bit_cast(unsigned, b); }
typedef float f32x2 __attribute__((ext_vector_type(2)));
__device__ __forceinline__ float sigm(float x) { return __builtin_amdgcn_rcpf(1.0f + __expf(-x)); }
template <int ACT  > struct EpiBf {
    static constexpr bool PERM = true, AFTER_DRAIN = false;
    bf16_t* O; int ldc; size_t gstride;
    __device__ __forceinline__ void operator()(const f32x4 (&acc)[2][2][4][2], const Unit& u, int wr, int wc, int fr, int fq) const {
        const int row0 = u.pm * BM + wr * 64 + fr; int colt = u.pn * BM; bf16_t* base = O; int ld = ldc;
        if (gstride) { const int t = colt >> 9; colt &= 511; base += (size_t)t * gstride; ld = 512; }
        const int col0 = colt + wc * 32 + 8 * fq;
#pragma unroll
        for (int ai = 0; ai < 2; ++ai)
#pragma unroll
            for (int m = 0; m < 4; ++m) { bf16_t* rowp = base + (size_t)(row0 + ai * HALF + m * 16) * ld + col0;
#pragma unroll
                for (int bj = 0; bj < 2; ++bj) { f32x4 v0 = acc[ai][bj][m][0], v1 = acc[ai][bj][m][1];
                    if (ACT == 1) {
#pragma unroll
                        for (int i = 0; i < 4; ++i) { float a = fmaxf(v0[i], 0.f), b = fmaxf(v1[i], 0.f); v0[i] = a * a; v1[i] = b * b; } }
                    u32x4 w; w.x = cvt_pk_bf16(v0[0], v0[1]); w.y = cvt_pk_bf16(v0[2], v0[3]); w.z = cvt_pk_bf16(v1[0], v1[1]); w.w = cvt_pk_bf16(v1[2], v1[3]);
                    *(u32x4*)(rowp + bj * HALF) = w; } }
    }
};
struct EpiLR {
    static constexpr bool PERM = true, AFTER_DRAIN = false;
    bf16_t *s0, *s1, *s2, *s3, *s4; const float* w0; const float* a0;
    __device__ __forceinline__ void operator()(const f32x4 (&acc)[2][2][4][2], const Unit& u, int wr, int wc, int fr, int fq) const {
        const int row0 = u.pm * BM + wr * 64 + fr; const int colg = u.pn * BM; const int seg = colg >> 9; const int cb = colg & 511;
        bf16_t* base = seg == 0 ? s0 : seg == 1 ? s1 : seg == 2 ? s2 : seg == 3 ? s3 : s4;
        const int col0 = cb + wc * 32 + 8 * fq;
        const float* bsrc = seg < 2 ? w0 + seg * 512 : a0 + (seg & 1) * 512;
        const float sc = seg < 2 ? 0.6065306597f : 1.0f; const float bm = seg < 4 ? 1.f : 0.f; const bool act = seg < 4;
#pragma unroll
        for (int bj = 0; bj < 2; ++bj) {
            const f32x4 b0 = *(const f32x4*)(bsrc + col0 + bj * HALF) * bm, b1 = *(const f32x4*)(bsrc + col0 + bj * HALF + 4) * bm;
#pragma unroll
            for (int ai = 0; ai < 2; ++ai)
#pragma unroll
                for (int m = 0; m < 4; ++m) { bf16_t* rowp = base + (size_t)(row0 + ai * HALF + m * 16) * 512 + col0;
                    f32x4 v0 = acc[ai][bj][m][0] + b0, v1 = acc[ai][bj][m][1] + b1;
#pragma unroll
                    for (int i = 0; i < 4; ++i) { const float g0 = sc * sigm(v0[i]), g1 = sc * sigm(v1[i]); v0[i] = act ? g0 : v0[i]; v1[i] = act ? g1 : v1[i]; }
                    u32x4 w; w.x = cvt_pk_bf16(v0[0], v0[1]); w.y = cvt_pk_bf16(v0[2], v0[3]); w.z = cvt_pk_bf16(v1[0], v1[1]); w.w = cvt_pk_bf16(v1[2], v1[3]);
                    *(u32x4*)(rowp + bj * HALF) = w; __builtin_amdgcn_sched_barrier(0); }
        }
    }
};
struct EpiGate {
    static constexpr bool PERM = true, AFTER_DRAIN = false;
    const bf16_t* Pm; bf16_t* Mg;
    __device__ __forceinline__ void operator()(const f32x4 (&acc)[2][2][4][2], const Unit& u, int wr, int wc, int fr, int fq) const {
        const int row0 = u.pm * BM + wr * 64 + fr; const int ocol = u.pn * 64 + wc * 16 + fq * 4;
#pragma unroll
        for (int ai = 0; ai < 2; ++ai)
#pragma unroll
            for (int m = 0; m < 4; ++m) { const size_t row = (size_t)(row0 + ai * HALF + m * 16);
                float s0 = 0.f, s1 = 0.f, s2 = 0.f, s3 = 0.f;
#pragma unroll
                for (int bj = 0; bj < 2; ++bj)
#pragma unroll
                    for (int n = 0; n < 2; ++n) { const int br = bj * 2 + n;
                        const uint2 pw = *(const uint2*)(Pm + row * 4096 + br * 1024 + ocol);
                        const f32x4 a = acc[ai][bj][m][n];
                        s0 += sigm(a[0]) * __uint_as_float(pw.x << 16); s1 += sigm(a[1]) * __uint_as_float(pw.x & 0xffff0000u);
                        s2 += sigm(a[2]) * __uint_as_float(pw.y << 16); s3 += sigm(a[3]) * __uint_as_float(pw.y & 0xffff0000u); }
                uint2 o; o.x = cvt_pk_bf16(s0, s1); o.y = cvt_pk_bf16(s2, s3);
                *(uint2*)(Mg + row * 1024 + ocol) = o; }
    }
};
struct EpiResid {
    static constexpr bool PERM = true, AFTER_DRAIN = false;
    const float* om; const float* mt; float* nm; float* xmb; int g; int rlim;
    __device__ __forceinline__ void operator()(const f32x4 (&acc)[2][2][4][2], const Unit& u, int wr, int wc, int fr, int fq) const {
        const int row0 = u.pm * BM + wr * 64 + fr; const int col0 = u.pn * BM + wc * 32 + 8 * fq;
#pragma unroll
        for (int ai = 0; ai < 2; ++ai)
#pragma unroll
            for (int m = 0; m < 4; ++m) { const int r = row0 + ai * HALF + m * 16;
                if (r < rlim) {
                    const int mi = r - 16384;
                    float* dmeta = xmb + (size_t)(mi < 64 ? g * 64 + mi : ((mi >> 6) - 1) * 64 + (mi & 63)) * 1024;
                    const float* src = r < 16384 ? om + (size_t)r * 1024 : (mt ? mt + (size_t)(mi & 15) * 1024 : (const float*)dmeta);
                    float* dst = r < 16384 ? nm + (size_t)r * 1024 : dmeta;
#pragma unroll
                    for (int bj = 0; bj < 2; ++bj)
#pragma unroll
                        for (int n = 0; n < 2; ++n) { const int c = col0 + bj * HALF + 4 * n;
                            const f32x4 xo = *(const f32x4*)(src + c); *(f32x4*)(dst + c) = xo + acc[ai][bj][m][n]; } } }
    }
};
template <class Epi, class Sched, bool ALIGN_EPI = false, bool SP2 = false>
__device__ __forceinline__ void gemm_phase(PG8_LAS unsigned char* lds, const Gemm g, const Sched& S, const Epi& E, int wv) {
    const int tid = launder_tid(wv), wid = __builtin_amdgcn_readfirstlane(tid >> 6), lane = tid & 63, wr = wid >> 2, wc = wid & 3, fr = lane & 15, fq = lane >> 4;
    const int K = g.K, nt = K / BK;
    unsigned voffA[2], voffB[2];
#pragma unroll
    for (int i = 0; i < 2; ++i) { int R, C; stage_rc(tid * 16 + i * 8192, R, C); const int Rb = Epi::PERM ? ((R & ~31) + perm32(R & 31)) : R;
        voffA[i] = (unsigned)(R * K + C) * 2u; voffB[i] = (unsigned)(Rb * K + C) * 2u; }
    const size_t kstep = (size_t)(BK * 2);
    const size_t hstep = (size_t)HALF * K * 2;
    const size_t tstep = 2 * hstep;
    const unsigned ldsw = (unsigned)wid * 1024u;
    const int aoff = lds_byte(wr * 64 + fr, fq * 8), boff = lds_byte(wc * 32 + fr, fq * 8);
#define PG8_SA(b, h) (((b) * 2 + (h)) * HTB)
#define PG8_SB(b, h) ((4 + (b) * 2 + (h)) * HTB)
#define PG8_STAGE(bufoff, gbase, voff) do { _Pragma("unroll") for (int _i = 0; _i < 2; ++_i) \
        __builtin_amdgcn_global_load_lds((const unsigned*)((const char*)(gbase) + (voff)[_i]), (PG8_LAS unsigned*)(lds + (bufoff) + ldsw + _i * 8192), 16, 0, 0); } while (0)
#define PG8_LDA(dst, b, h) do { _Pragma("unroll") for (int m = 0; m < 4; ++m) _Pragma("unroll") for (int k = 0; k < 2; ++k) dst[m][k] = *(const PG8_LAS bf16x8*)(lds + PG8_SA(b, h) + aoff + m * 2048 + k * 1024); } while (0)
#define PG8_LDB(dst, b, h) do { _Pragma("unroll") for (int n = 0; n < 2; ++n) _Pragma("unroll") for (int k = 0; k < 2; ++k) dst[n][k] = *(const PG8_LAS bf16x8*)(lds + PG8_SB(b, h) + boff + n * 2048 + k * 1024); } while (0)
#define PG8_MMA(ai, bj, At, Bt) do { __builtin_amdgcn_s_setprio(1); _Pragma("unroll") for (int m = 0; m < 4; ++m) _Pragma("unroll") for (int n = 0; n < 2; ++n) _Pragma("unroll") for (int k = 0; k < 2; ++k) \
        acc[ai][bj][m][n] = __builtin_amdgcn_mfma_f32_16x16x32_bf16(Bt[n][k], At[m][k], acc[ai][bj][m][n], 0, 0, 0); __builtin_amdgcn_s_setprio(0); } while (0)
#define PG8_WAIT_V(n) asm volatile("s_waitcnt vmcnt(" #n ")" ::: "memory")
#define PG8_WAIT_L(n) asm volatile("s_waitcnt lgkmcnt(" #n ")" ::: "memory")
#define PG8_BAR __builtin_amdgcn_s_barrier()
#define PG8_SCHED __builtin_amdgcn_sched_barrier(0)
    Unit cur, nxt; int ui = 0;
    if (!S.next(0, cur)) return;
    f32x4 acc[2][2][4][2];
#pragma unroll
    for (int a = 0; a < 2; ++a)
#pragma unroll
        for (int b = 0; b < 2; ++b)
#pragma unroll
            for (int m = 0; m < 4; ++m)
#pragma unroll
                for (int n = 0; n < 2; ++n) { float z_ = 0.f; asm volatile("" : "+v"(z_)); acc[a][b][m][n] = (f32x4){z_, z_, z_, z_}; }
    bf16x8 At[4][2], B0[2][2], B1[2][2];
    const char* cA = (const char*)g.A + (g.pn_per_ab ? (size_t)(cur.pn / g.pn_per_ab) * g.ab_stride : (size_t)0) + (size_t)cur.pm * tstep; const char* cB = (const char*)g.Bt + (size_t)cur.pn * tstep;
    S.a_ready(cur);
    if constexpr (SP2) {
        PG8_STAGE(PG8_SB(0, 0), cB, voffB); PG8_STAGE(PG8_SB(0, 1), cB + hstep, voffB); PG8_STAGE(PG8_SA(0, 0), cA, voffA); PG8_STAGE(PG8_SA(0, 1), cA + hstep, voffA);
        if (wr == 1) PG8_BAR;
        PG8_WAIT_V(2); PG8_BAR;
        PG8_STAGE(PG8_SB(1, 0), cB + kstep, voffB); PG8_STAGE(PG8_SA(1, 0), cA + kstep, voffA); PG8_STAGE(PG8_SB(1, 1), cB + hstep + kstep, voffB);
        PG8_WAIT_V(6); PG8_BAR;
    } else {
        PG8_STAGE(PG8_SB(0, 0), cB, voffB); PG8_STAGE(PG8_SA(0, 0), cA, voffA); PG8_STAGE(PG8_SB(0, 1), cB + hstep, voffB); PG8_STAGE(PG8_SA(0, 1), cA + hstep, voffA);
        if (wr == 1) PG8_BAR;
        PG8_WAIT_V(4); PG8_BAR;
        PG8_STAGE(PG8_SB(1, 0), cB + kstep, voffB); PG8_STAGE(PG8_SA(1, 0), cA + kstep, voffA); PG8_STAGE(PG8_SB(1, 1), cB + hstep + kstep, voffB);
        PG8_WAIT_V(6); PG8_BAR;
    }
    for (;;) {
        const bool has_next = S.next(ui + 1, nxt);
        const char* nA = has_next ? (const char*)g.A + (g.pn_per_ab ? (size_t)(nxt.pn / g.pn_per_ab) * g.ab_stride : (size_t)0) + (size_t)nxt.pm * tstep : cA; const char* nB = has_next ? (const char*)g.Bt + (size_t)nxt.pn * tstep : cB;
#pragma unroll 1
        for (int t = 0; t < nt; t += 2) {
            const bool last = (t == nt - 2);
            const char* a1 = cA + (size_t)(t + 1) * kstep;
            const char* a2 = last ? nA : cA + (size_t)(t + 2) * kstep; const char* b2 = last ? nB : cB + (size_t)(t + 2) * kstep;
            const char* a3 = a2 + kstep; const char* b3 = b2 + kstep;
            if (last && has_next) S.a_ready(nxt);
            if constexpr (SP2) {
            PG8_LDB(B0, 0, 0); PG8_LDB(B1, 0, 1); PG8_SCHED; PG8_LDA(At, 0, 0); PG8_STAGE(PG8_SA(1, 1), a1 + hstep, voffA);
            PG8_WAIT_V(8); PG8_WAIT_L(0); PG8_BAR; PG8_MMA(0, 0, At, B0); PG8_MMA(0, 1, At, B1); PG8_BAR; PG8_SCHED;
            PG8_LDA(At, 0, 1); PG8_STAGE(PG8_SB(0, 0), b2, voffB); PG8_STAGE(PG8_SB(0, 1), b2 + hstep, voffB); PG8_STAGE(PG8_SA(0, 0), a2, voffA);
            PG8_WAIT_V(8); PG8_WAIT_L(0); PG8_BAR; PG8_MMA(1, 0, At, B0); PG8_MMA(1, 1, At, B1); PG8_BAR; PG8_SCHED;
            PG8_LDB(B0, 1, 0); PG8_LDB(B1, 1, 1); PG8_SCHED; PG8_LDA(At, 1, 0); PG8_STAGE(PG8_SA(0, 1), a2 + hstep, voffA);
            PG8_WAIT_V(8); PG8_WAIT_L(0); PG8_BAR; PG8_MMA(0, 0, At, B0); PG8_MMA(0, 1, At, B1); PG8_BAR; PG8_SCHED;
            PG8_LDA(At, 1, 1); PG8_STAGE(PG8_SB(1, 0), b3, voffB); PG8_STAGE(PG8_SB(1, 1), b3 + hstep, voffB); PG8_STAGE(PG8_SA(1, 0), a3, voffA);
            PG8_WAIT_V(8); PG8_WAIT_L(0); PG8_BAR; PG8_MMA(1, 0, At, B0); PG8_MMA(1, 1, At, B1); PG8_BAR; PG8_SCHED;
            } else {
            PG8_LDB(B0, 0, 0); PG8_SCHED; PG8_LDA(At, 0, 0); PG8_STAGE(PG8_SA(1, 1), a1 + hstep, voffA);
            PG8_WAIT_L(8); PG8_BAR; PG8_WAIT_L(0); PG8_MMA(0, 0, At, B0); PG8_BAR; PG8_SCHED;
            PG8_LDB(B1, 0, 1); PG8_STAGE(PG8_SB(0, 0), b2, voffB);
            PG8_BAR; PG8_WAIT_L(0); PG8_MMA(0, 1, At, B1); PG8_BAR;
            PG8_LDA(At, 0, 1); PG8_STAGE(PG8_SA(0, 0), a2, voffA);
            PG8_BAR; PG8_WAIT_L(0); PG8_MMA(1, 0, At, B0); PG8_BAR; PG8_SCHED;
            PG8_STAGE(PG8_SB(0, 1), b2 + hstep, voffB);
            PG8_WAIT_V(6); PG8_BAR; PG8_MMA(1, 1, At, B1); PG8_BAR;
            PG8_LDB(B0, 1, 0); PG8_SCHED; PG8_LDA(At, 1, 0); PG8_STAGE(PG8_SA(0, 1), a2 + hstep, voffA);
            PG8_WAIT_L(8); PG8_BAR; PG8_WAIT_L(0); PG8_MMA(0, 0, At, B0); PG8_BAR; PG8_SCHED;
            PG8_LDB(B1, 1, 1); PG8_STAGE(PG8_SB(1, 0), b3, voffB);
            PG8_BAR; PG8_WAIT_L(0); PG8_MMA(0, 1, At, B1); PG8_BAR;
            PG8_LDA(At, 1, 1); PG8_STAGE(PG8_SA(1, 0), a3, voffA);
            PG8_BAR; PG8_WAIT_L(0); PG8_MMA(1, 0, At, B0); PG8_BAR; PG8_SCHED;
            PG8_STAGE(PG8_SB(1, 1), b3 + hstep, voffB);
            PG8_WAIT_V(6); PG8_BAR; PG8_MMA(1, 1, At, B1); PG8_BAR;
            }
        }
        if constexpr (ALIGN_EPI) { if (wr == 0) PG8_BAR; }
        if constexpr (!Epi::AFTER_DRAIN) { E(acc, cur, wr, wc, fr, fq); S.done(cur); }
        if (!has_next) break;
#pragma unroll
        for (int a = 0; a < 2; ++a)
#pragma unroll
            for (int b = 0; b < 2; ++b)
#pragma unroll
                for (int m = 0; m < 4; ++m)
#pragma unroll
                    for (int n = 0; n < 2; ++n) { float z_ = 0.f; asm volatile("" : "+v"(z_)); acc[a][b][m][n] = (f32x4){z_, z_, z_, z_}; }
        cur = nxt; cA = nA; cB = nB; ++ui;
        if constexpr (ALIGN_EPI) { if (wr == 1) PG8_BAR; }
    }
    PG8_WAIT_V(0);
    if constexpr (!ALIGN_EPI) { if (wr == 0) PG8_BAR; }
    PG8_BAR;
    if constexpr (Epi::AFTER_DRAIN) { E.fused(acc, cur, wr, wc, fr, fq, lds, wid, lane); S.done(cur); }
#undef PG8_SA
#undef PG8_SB
#undef PG8_STAGE
#undef PG8_LDA
#undef PG8_LDB
#undef PG8_MMA
#undef PG8_WAIT_V
#undef PG8_WAIT_L
#undef PG8_BAR
#undef PG8_SCHED
}
}
typedef unsigned short bf16_t;
typedef short bf16x8 __attribute__((ext_vector_type(8)));
typedef float f32x4 __attribute__((ext_vector_type(4)));
typedef float f32x16 __attribute__((ext_vector_type(16)));
constexpr int LSEQ = 4112, TREAL = 16384, TG = 16448, TGP = 16640, NGRP = 3;
constexpr size_t SLOT_E = (size_t)TGP * 512;
constexpr size_t SLOT_B = SLOT_E * 2;
constexpr size_t MiB = 1u << 20;
constexpr size_t WS_XMETA = 1 * MiB, WS_DECAY = 2 * MiB, WS_SIDE = 3 * MiB + 512 * 1024, WS_W = 5 * MiB, WS_SLOTS = 53 * MiB;
constexpr size_t WS_NEED = WS_SLOTS + 25 * SLOT_B;
constexpr size_t WO_IN = 0, WO_G = 7864320, WO_BP = 12058624, WO_OUT = 14155776, WO_1 = 15204352, WO_2 = 19398656, WO_LR = 23592960;
constexpr int LDS_BYTES = 140 * 1024;
enum { I_XP = 0, I_XS, I_META, I_NMIX, I_WIN, I_LBL, I_ONORM, I_CONV, I_QN, I_KN, I_LAM, I_SUBLN, I_MU, I_W0, I_W2, I_A0, I_A2, I_G2, I_KK, I_KA, I_RK, I_LNG, I_LNB, I_WG, I_BP, I_WOUT, I_NMLP, I_W1, I_W2M };
struct Params { const float* in[29]; float* out; unsigned char* ws; };
typedef const __attribute__((address_space(4))) Params* KParamsPtr;
DEV KParamsPtr kparams() { KParamsPtr p = (KParamsPtr)__builtin_amdgcn_kernarg_segment_ptr(); asm volatile("" : "+s"(p)); return p; }
DEV Params load_params() { KParamsPtr p = kparams(); Params r;
#pragma unroll
    for (int i = 0; i < 29; ++i) r.in[i] = p->in[i];
    r.out = p->out; r.ws = p->ws; return r; }
DEV unsigned zero_u() { unsigned z = 0u; asm volatile("" : "+v"(z)); return z; }

#define ROWPRO const int tid_ = launder_tid(wv); const int lane = tid_ & 63; const int gw = bid * 8 + __builtin_amdgcn_readfirstlane(tid_ >> 6); const int ngw = nb * 8;
DEV float bf2f(unsigned short u) { return __uint_as_float((unsigned)u << 16); }
DEV unsigned pk2(float lo, float hi) { return pg8::cvt_pk_bf16(lo, hi); }
DEV void unpack8(const uint4 w, float* f) {
    f[0] = __uint_as_float(w.x << 16); f[1] = __uint_as_float(w.x & 0xffff0000u); f[2] = __uint_as_float(w.y << 16); f[3] = __uint_as_float(w.y & 0xffff0000u);
    f[4] = __uint_as_float(w.z << 16); f[5] = __uint_as_float(w.z & 0xffff0000u); f[6] = __uint_as_float(w.w << 16); f[7] = __uint_as_float(w.w & 0xffff0000u); }
DEV uint4 pack8(const float* f) { uint4 o; o.x = pk2(f[0], f[1]); o.y = pk2(f[2], f[3]); o.z = pk2(f[4], f[5]); o.w = pk2(f[6], f[7]); return o; }
DEV bf16_t* slotp(const Params& P, int s) { return (bf16_t*)(P.ws + WS_SLOTS + (size_t)s * SLOT_B); }
DEV int row_of(int sl, int p) { return p >= 16 ? sl * 4096 + p - 16 : TREAL + sl * 16 + p; }
DEV void pos_of(int r, int& sl, int& p) { if (r < TREAL) { sl = r >> 12; p = (r & 4095) + 16; } else { const int m = r - TREAL; sl = m >> 4; p = m & 15; } }
DEV float wave_sum(float v) {
#pragma unroll
    for (int o = 1; o < 64; o <<= 1) v += __shfl_xor(v, o);
    return v; }
DEV float red8(float v) { v += __shfl_xor(v, 1); v += __shfl_xor(v, 2); v += __shfl_xor(v, 4); return v; }
DEV f32x4 mfma16(bf16x8 a, bf16x8 b, f32x4 c) { return __builtin_amdgcn_mfma_f32_16x16x32_bf16(a, b, c, 0, 0, 0); }
DEV f32x16 mfma32(bf16x8 a, bf16x8 b, f32x16 c) { return __builtin_amdgcn_mfma_f32_32x32x16_bf16(a, b, c, 0, 0, 0); }
DEV const float* x_in_row(const Params& P, int g, int r) {
    if (r < TREAL) return (g < 2 ? P.in[I_XP] + (size_t)g * TREAL * 1024 : P.in[I_XS]) + (size_t)r * 1024;
    return P.in[I_META] + (size_t)((r - TREAL) & 15) * 1024; }
DEV float* x_cur_row(const Params& P, int g, int r) {
    if (r < TREAL) return P.out + ((size_t)g * TREAL + r) * 1024;
    const int m = r - TREAL;
    return (float*)(P.ws + WS_XMETA) + (size_t)(m < 64 ? g * 64 + m : ((m >> 6) - 1) * 64 + (m & 63)) * 1024; }

DEV int gate_row(int n) { const int br = n >> 10, c = n & 1023, pn = c >> 6, oc = c & 63, wc = oc >> 4, fq = (oc >> 2) & 3, i = oc & 3; return pn * 256 + (br >> 1) * 128 + wc * 32 + fq * 8 + (br & 1) * 4 + i; }
template <int MODE> DEV void wt_items(const float* __restrict__ W, int K, int N, bf16_t* WT, int row_off, float* scr, int gw, int ngw, int lane) {
    const int nblk = N >> 5, items = (K >> 6) * nblk;
    for (int it = gw; it < items; it += ngw) {
        const int kb = it / nblk, nbk = it - kb * nblk, k0 = 64 * kb, n0 = 32 * nbk;
#pragma unroll 8
        for (int i = 0; i < 32; ++i) { const int kk = 2 * i + (lane >> 5); scr[kk * 33 + (lane & 31)] = W[(size_t)(k0 + kk) * N + n0 + (lane & 31)]; }
        asm volatile("s_waitcnt lgkmcnt(0)" ::: "memory");
        const int c = lane & 7;
#pragma unroll
        for (int j = 0; j < 4; ++j) { const int n = (lane >> 3) + 8 * j; const float* sp = scr + (8 * c) * 33 + n;
            uint4 o; o.x = pk2(sp[0 * 33], sp[1 * 33]); o.y = pk2(sp[2 * 33], sp[3 * 33]); o.z = pk2(sp[4 * 33], sp[5 * 33]); o.w = pk2(sp[6 * 33], sp[7 * 33]);
            const int dr = MODE == 1 ? gate_row(n0 + n) : n0 + n + row_off;
            *(uint4*)(WT + (size_t)dr * K + k0 + 8 * c) = o; }
        asm volatile("s_waitcnt lgkmcnt(0)" ::: "memory");
    }
}
DEV void phase_weights(const Params& P0, int layer, unsigned char* lds, int bid, int nb, int wv) {
    Params P = load_params(); asm volatile("" : "+s"(P.ws));
    const int tid = launder_tid(wv), lane = tid & 63, w = __builtin_amdgcn_readfirstlane(tid >> 6);
    const int gtid = bid * 512 + tid, gth = nb * 512, gw = bid * 8 + w, ngw = nb * 8;
    float* scr = (float*)(lds + w * 8448);
    bf16_t* W = (bf16_t*)(P.ws + WS_W);
    wt_items<0>(P.in[I_WIN] + (size_t)layer * 1024 * 7552, 1024, 7552, W + WO_IN, 0, scr, gw, ngw, lane);
    for (int it = gtid; it < 128 * 128; it += gth) { const unsigned z = zero_u(); *(uint4*)(W + WO_IN + (size_t)7552 * 1024 + (size_t)it * 8) = make_uint4(z, z, z, z); }
    wt_items<1>(P.in[I_WG] + (size_t)layer * 1024 * 4096, 1024, 4096, W + WO_G, 0, scr, gw, ngw, lane);
    for (int n = 0; n < 4; ++n) wt_items<0>(P.in[I_BP] + (size_t)(layer * 4 + n) * 512 * 1024, 512, 1024, W + WO_BP, n * 1024, scr, gw, ngw, lane);
    wt_items<0>(P.in[I_WOUT] + (size_t)layer * 1024 * 1024, 1024, 1024, W + WO_OUT, 0, scr, gw, ngw, lane);
    wt_items<0>(P.in[I_W1] + (size_t)layer * 1024 * 4096, 1024, 4096, W + WO_1, 0, scr, gw, ngw, lane);
    wt_items<0>(P.in[I_W2M] + (size_t)layer * 4096 * 1024, 4096, 1024, W + WO_2, 0, scr, gw, ngw, lane);
    for (int it = gtid; it < 2560 * 48; it += gth) {
        const int row = it / 48, k8 = it - row * 48, seg = row >> 9, c = row & 511, k0 = k8 * 8;
        float v[8];
#pragma unroll
        for (int j = 0; j < 8; ++j) { const int k = k0 + j; float x = 0.f;
            if (seg == 0) { if (k < 64) x = P.in[I_W2][((size_t)(layer * 2 + 0) * 64 + k) * 512 + c]; }
            else if (seg == 1) { if (k >= 64 && k < 128) x = P.in[I_W2][((size_t)(layer * 2 + 1) * 64 + (k - 64)) * 512 + c]; }
            else if (seg == 2) { if (k >= 128 && k < 192) x = P.in[I_A2][((size_t)(layer * 2 + 0) * 64 + (k - 128)) * 512 + c]; }
            else if (seg == 3) { if (k >= 192 && k < 256) x = P.in[I_A2][((size_t)(layer * 2 + 1) * 64 + (k - 192)) * 512 + c]; }
            else { if (k >= 256) x = P.in[I_G2][((size_t)layer * 128 + (k - 256)) * 512 + c]; }
            v[j] = x; }
        *(uint4*)(W + WO_LR + (size_t)row * 384 + k0) = pack8(v);
    }
}

DEV void phase_rmsnorm(const Params& P0, int g, bool src_in, int gain_idx, int layer, int nrows, int nvalid, int bid, int nb, int wv) {
    Params P = load_params(); asm volatile("" : "+s"(P.ws));
    ROWPRO
    const float* gain = P.in[gain_idx] + layer * 1024;
    bf16_t* H = slotp(P, 0);
    for (int r = gw; r < nrows; r += ngw) {
        uint2* o8 = (uint2*)(H + (size_t)r * 1024) + lane;
        if (r >= nvalid) {
#pragma unroll
            for (int j = 0; j < 4; ++j) { const unsigned z = zero_u(); o8[64 * j] = make_uint2(z, z); }
            continue; }
        const f32x4* xr = (const f32x4*)(src_in ? x_in_row(P, g, r) : (const float*)x_cur_row(P, g, r)) + lane;
        f32x4 v[4]; float s = 0.f;
#pragma unroll
        for (int j = 0; j < 4; ++j) { v[j] = xr[64 * j]; s += (v[j].x * v[j].x + v[j].y * v[j].y) + (v[j].z * v[j].z + v[j].w * v[j].w); }
        const float rs = rsqrtf(wave_sum(s) * (1.f / 1024.f) + 1e-6f);
#pragma unroll
        for (int j = 0; j < 4; ++j) { const f32x4 gg = *((const f32x4*)gain + lane + 64 * j);
            o8[64 * j] = make_uint2(pk2(v[j].x * rs * gg.x, v[j].y * rs * gg.y), pk2(v[j].z * rs * gg.z, v[j].w * rs * gg.w)); }
    }
}
DEV void phase_da_prep(const Params& P0, int layer, int bid, int nb, int wv) {
    Params P = load_params(); asm volatile("" : "+s"(P.ws));
    ROWPRO
    const float inv8[8] = {1.0f, 0.19392274474868576f, 0.03760603093086393f, 0.007292664737217109f, 0.001414213562373095f, 0.0002742481756762073f, 5.318295896944988e-05f, 1.031338537721246e-05f};
    const int d0 = (lane & 7) * 8;
    float gq[8], gk[8];
#pragma unroll
    for (int j = 0; j < 8; ++j) { gq[j] = P.in[I_QN][layer * 64 + d0 + j]; gk[j] = P.in[I_KN][layer * 64 + d0 + j]; }
    for (int r = gw; r < TG; r += ngw) {
        int sl, p; pos_of(r, sl, p);
        float cs[8], sn[8];
#pragma unroll
        for (int j = 0; j < 8; ++j) { const float ang = (float)p * inv8[j]; double a = (double)ang; a -= 6.283185307179586 * __builtin_rint(a * 0.15915494309189535); const float rr = (float)a; cs[j] = __cosf(rr); sn[j] = __sinf(rr); }
#pragma unroll
        for (int which = 0; which < 2; ++which) {
            uint4* ptr = (uint4*)(slotp(P, 10 + which) + (size_t)r * 512) + lane;
            float f[8]; unpack8(*ptr, f);
            float ss = 0.f;
#pragma unroll
            for (int j = 0; j < 8; ++j) ss += f[j] * f[j];
            ss = red8(ss);
            const float rs = rsqrtf(ss * (1.f / 64.f) + 1e-6f);
#pragma unroll
            for (int j = 0; j < 8; ++j) f[j] = f[j] * rs * (which == 0 ? gq[j] : gk[j]);
#pragma unroll
            for (int j = 0; j < 8; ++j) { const float pr = __shfl_xor(f[j], 1);
                if ((lane & 7) == 0) f[j] = f[j] * cs[j] - pr * sn[j];
                else if ((lane & 7) == 1) f[j] = f[j] * cs[j] + pr * sn[j]; }
            if (which == 0) {
#pragma unroll
                for (int j = 0; j < 8; ++j) f[j] *= 0.18033688011112042f; }
            *ptr = pack8(f);
        }
    }
}
DEV void phase_conv(const Params& P0, int layer, int bid, int nb, int wv) {
    Params P = load_params(); asm volatile("" : "+s"(P.ws));
    ROWPRO
    const int c0 = lane * 8;
    float w0[8], w1[8], w2[8];
#pragma unroll
    for (int j = 0; j < 8; ++j) { w0[j] = P.in[I_CONV][(layer * 3 + 0) * 512 + c0 + j]; w1[j] = P.in[I_CONV][(layer * 3 + 1) * 512 + c0 + j]; w2[j] = P.in[I_CONV][(layer * 3 + 2) * 512 + c0 + j]; }
    const bf16_t* SB = slotp(P, 7); const bf16_t* SC = slotp(P, 8); const bf16_t* SH = slotp(P, 9); bf16_t* Y = slotp(P, 3);
    for (int r = gw; r < TG; r += ngw) {
        int sl, p; pos_of(r, sl, p);
        float acc[8], a[8], b[8];
        unpack8(*((const uint4*)(SC + (size_t)r * 512) + lane), a); unpack8(*((const uint4*)(SH + (size_t)r * 512) + lane), b);
#pragma unroll
        for (int j = 0; j < 8; ++j) acc[j] = a[j] * b[j] * w1[j];
        if (p > 0) { const int rp = row_of(sl, p - 1);
            unpack8(*((const uint4*)(SC + (size_t)rp * 512) + lane), a); unpack8(*((const uint4*)(SH + (size_t)rp * 512) + lane), b);
#pragma unroll
            for (int j = 0; j < 8; ++j) acc[j] += a[j] * b[j] * w0[j]; }
        if (p < LSEQ - 1) { const int rn = row_of(sl, p + 1);
            unpack8(*((const uint4*)(SC + (size_t)rn * 512) + lane), a); unpack8(*((const uint4*)(SH + (size_t)rn * 512) + lane), b);
#pragma unroll
            for (int j = 0; j < 8; ++j) acc[j] += a[j] * b[j] * w2[j]; }
        unpack8(*((const uint4*)(SB + (size_t)r * 512) + lane), a);
#pragma unroll
        for (int j = 0; j < 8; ++j) acc[j] *= a[j];
        *((uint4*)(Y + (size_t)r * 512) + lane) = pack8(acc);
    }
}
DEV void phase_rw_prep(const Params& P0, int layer, int bid, int nb, int wv) {
    Params P = load_params(); asm volatile("" : "+s"(P.ws));
    ROWPRO
    const float* mu = P.in[I_MU] + (size_t)layer * 1920;
    for (int r = gw; r < TG; r += ngw) {
        int sl, p; pos_of(r, sl, p);
        const int rp = p > 0 ? row_of(sl, p - 1) : -1, rn = p < LSEQ - 1 ? row_of(sl, p + 1) : -1;
#pragma unroll
        for (int grp = 0; grp < 4; ++grp) {
            if (grp == 3 && lane >= 48) break;
            const int c0 = (grp < 3 ? grp * 512 : 1536) + lane * 8;
            const bf16_t* src = slotp(P, 13 + (c0 >> 9)) + (c0 & 511);
            float u[8], up[8], un[8], xm[8];
            unpack8(*(const uint4*)(src + (size_t)r * 512), u);
            if (rp >= 0) unpack8(*(const uint4*)(src + (size_t)rp * 512), up); else {
#pragma unroll
                for (int j = 0; j < 8; ++j) up[j] = 0.f; }
            if (rn >= 0) unpack8(*(const uint4*)(src + (size_t)rn * 512), un); else {
#pragma unroll
                for (int j = 0; j < 8; ++j) un[j] = 0.f; }
#pragma unroll
            for (int j = 0; j < 8; ++j) xm[j] = u[j] + mu[c0 + j] * (0.5f * (up[j] + un[j]) - u[j]);
            if (grp < 3) {
                *((uint4*)(slotp(P, 17 + grp) + (size_t)r * 512) + lane) = pack8(xm);
                if (grp == 1) {
                    float kk[8], ss = 0.f;
#pragma unroll
                    for (int j = 0; j < 8; ++j) { kk[j] = xm[j] * P.in[I_KK][layer * 512 + c0 - 512 + j]; ss += kk[j] * kk[j]; }
                    ss = red8(ss);
                    const float inv = 1.0f / fmaxf(sqrtf(ss), 1e-12f);
#pragma unroll
                    for (int j = 0; j < 8; ++j) kk[j] *= inv;
                    *((uint4*)(slotp(P, 20) + (size_t)r * 512) + lane) = pack8(kk); }
            } else {
                const int a0 = lane * 8;
                float o[8];
#pragma unroll
                for (int j = 0; j < 8; ++j) { const float x = xm[j];
                    if (a0 < 128) { const float e = __expf(2.f * x); o[j] = 1.f - 2.f / (e + 1.f); }
                    else if (a0 < 256) o[j] = x;
                    else o[j] = 1.f / (1.f + __expf(-x)); }
                *((uint4*)(slotp(P, 21) + (size_t)r * 384) + lane) = pack8(o);
            }
        }
    }
    for (int r = TG + gw; r < TGP; r += ngw) if (lane < 48) { const unsigned z = zero_u(); *((uint4*)(slotp(P, 21) + (size_t)r * 384) + lane) = make_uint4(z, z, z, z); }
}
DEV void phase_rw_post(const Params& P0, int layer, int g, int nrows, int bid, int nb, int wv) {
    Params P = load_params(); asm volatile("" : "+s"(P.ws));
    ROWPRO
    const int c0 = lane * 8;
    float ka[8], rk[8], lg[8], lb[8];
#pragma unroll
    for (int j = 0; j < 8; ++j) { ka[j] = P.in[I_KA][layer * 512 + c0 + j]; rk[j] = P.in[I_RK][layer * 512 + c0 + j]; lg[j] = P.in[I_LNG][layer * 512 + c0 + j]; lb[j] = P.in[I_LNB][layer * 512 + c0 + j]; }
    for (int r = gw; r < nrows; r += ngw) {
        float of[8], ob[8], o[8];
        unpack8(*((const uint4*)(slotp(P, 15) + (size_t)r * 512) + lane), of); unpack8(*((const uint4*)(slotp(P, 16) + (size_t)r * 512) + lane), ob);
        float s = 0.f;
#pragma unroll
        for (int j = 0; j < 8; ++j) { o[j] = of[j] + ob[j]; s += o[j]; }
        const float mean = red8(s) * (1.f / 64.f);
        float q = 0.f;
#pragma unroll
        for (int j = 0; j < 8; ++j) { o[j] -= mean; q += o[j] * o[j]; }
        const float rs = rsqrtf(red8(q) * (1.f / 64.f) + 64e-5f);
        float rr[8], kk[8], vv[8], af[8], ab[8], gg[8];
        unpack8(*((const uint4*)(slotp(P, 17) + (size_t)r * 512) + lane), rr); unpack8(*((const uint4*)(slotp(P, 18) + (size_t)r * 512) + lane), kk);
        unpack8(*((const uint4*)(slotp(P, 19) + (size_t)r * 512) + lane), vv); unpack8(*((const uint4*)(slotp(P, 24) + (size_t)r * 512) + lane), af);
        unpack8(*((const uint4*)(slotp(P, 13) + (size_t)r * 512) + lane), ab); unpack8(*((const uint4*)(slotp(P, 14) + (size_t)r * 512) + lane), gg);
        float bs = 0.f;
#pragma unroll
        for (int j = 0; j < 8; ++j) { const float kd = kk[j] * (2.f + (af[j] + ab[j] - 2.f) * ka[j]); bs += rr[j] * kd * rk[j]; }
        bs = red8(bs);
        float y[8];
#pragma unroll
        for (int j = 0; j < 8; ++j) y[j] = (o[j] * rs * lg[j] + lb[j] + bs * vv[j]) * gg[j];
        const uint4 yv = pack8(y);
        *((uint4*)(slotp(P, 5) + (size_t)r * 512) + lane) = yv;
        if (layer == 0 && g < 2 && r >= TREAL) {
            bf16_t* sd = (bf16_t*)(P.ws + WS_SIDE) + (size_t)g * 4 * 64 * 512 + (size_t)(r - TREAL) * 512;
#pragma unroll
            for (int k = 0; k < 3; ++k) *((uint4*)(sd + (size_t)k * 64 * 512) + lane) = *((const uint4*)(slotp(P, 2 + k) + (size_t)r * 512) + lane);
            *((uint4*)(sd + (size_t)3 * 64 * 512) + lane) = yv; }
    }
    if (layer == 0 && g == 2) {
        for (int m2 = gw; m2 < 128; m2 += ngw) { const bf16_t* sd = (const bf16_t*)(P.ws + WS_SIDE) + (size_t)(m2 >> 6) * 4 * 64 * 512 + (size_t)(m2 & 63) * 512;
#pragma unroll
            for (int k = 0; k < 4; ++k) *((uint4*)(slotp(P, 2 + k) + (size_t)(TG + m2) * 512) + lane) = *((const uint4*)(sd + (size_t)k * 64 * 512) + lane); }
    }
}
DEV void hg_gate(float x, float lbv, float& lg, float& kk) {
    const float e = __expf(-fabsf(x)); const float sp = 1.f / (1.f + e);
    const float s = x >= 0.f ? sp : e * sp, s1 = x >= 0.f ? e * sp : sp;
    const float f = fmaxf(lbv, 1e-20f) + (1.f - lbv) * s;
    lg = __logf(f); kk = (1.f - lbv) * s1; }
DEV float hg_lb(const Params& P, int layer, int dir, int col) {
    if (layer == 0) return 0.f;
    const float a = P.in[I_LBL][(dir * 2 + 0) * 512 + col], b = P.in[I_LBL][(dir * 2 + 1) * 512 + col];
    return 1.f / (1.f + __expf(a - b)); }
DEV int hg_row(int sl, int c, int j, bool& valid) { if (c == 0) { valid = j < 16; return TREAL + sl * 16 + j; } valid = true; return sl * 4096 + (c - 1) * 64 + j; }
DEV void hg_cumsum(float* Lb, float* Bt, float* Seg, int dir, int tid) {
    const int ch = tid & 127, seg = tid >> 7;
    float v[16];
#pragma unroll
    for (int i = 0; i < 16; ++i) v[i] = Lb[(seg * 16 + i) * 128 + ch];
    if (dir == 0) {
#pragma unroll
        for (int i = 1; i < 16; ++i) v[i] += v[i - 1];
        Seg[seg * 128 + ch] = v[15];
    } else {
#pragma unroll
        for (int i = 14; i >= 0; --i) v[i] += v[i + 1];
        Seg[seg * 128 + ch] = v[0];
    }
    __syncthreads();
    const float s0 = Seg[ch], s1 = Seg[128 + ch], s2 = Seg[256 + ch], s3 = Seg[384 + ch];
    float off;
    if (dir == 0) off = seg == 0 ? 0.f : seg == 1 ? s0 : seg == 2 ? s0 + s1 : s0 + s1 + s2;
    else off = seg == 3 ? 0.f : seg == 2 ? s3 : seg == 1 ? s3 + s2 : s3 + s2 + s1;
#pragma unroll
    for (int i = 0; i < 16; ++i) Lb[(seg * 16 + i) * 128 + ch] = v[i] + off;
    if (seg == 0) Bt[ch] = (s0 + s1) + (s2 + s3);
}
DEV void phase_hg1(const Params& P0, int layer, unsigned char* lds, int bid, int nb, int wv) {
    Params P = load_params(); asm volatile("" : "+s"(P.ws));
    float* Lb = (float*)lds; bf16_t* KlT = (bf16_t*)(lds + 32768); bf16_t* VT = (bf16_t*)(lds + 32768 + 18432); float* Bt = (float*)(lds + 69632); float* Seg = (float*)(lds + 70656);
    float* X = (float*)slotp(P, 17); float* DC = (float*)(P.ws + WS_DECAY);
    const int tid = launder_tid(wv), lane = tid & 63, w = __builtin_amdgcn_readfirstlane(tid >> 6), j = tid >> 3, c0 = (tid & 7) * 16, l15 = lane & 15, quad = lane >> 4;
    for (int unit = bid; unit < 32 * 65; unit += nb) {
        const int chain = unit / 65, c = unit - chain * 65, sl = chain >> 3, head = (chain >> 1) & 3, dir = chain & 1;
        bool valid; const int r = hg_row(sl, c, j, valid);
        float lg[16], kk[16]; uint4 vv[2] = {make_uint4(0, 0, 0, 0), make_uint4(0, 0, 0, 0)};
        if (valid) {
            float fr[16];
            const uint4* fp = (const uint4*)(slotp(P, 3 + dir) + (size_t)r * 512 + head * 128 + c0);
            unpack8(fp[0], fr); unpack8(fp[1], fr + 8);
            const uint4* vp = (const uint4*)(slotp(P, 5) + (size_t)r * 512 + head * 128 + c0); vv[0] = vp[0]; vv[1] = vp[1];
#pragma unroll
            for (int e = 0; e < 16; ++e) hg_gate(fr[e], hg_lb(P, layer, dir, head * 128 + c0 + e), lg[e], kk[e]);
        } else {
#pragma unroll
            for (int e = 0; e < 16; ++e) { lg[e] = 0.f; kk[e] = 0.f; } }
#pragma unroll
        for (int e = 0; e < 16; e += 4) *(f32x4*)(Lb + j * 128 + c0 + e) = (f32x4){lg[e], lg[e + 1], lg[e + 2], lg[e + 3]};
        __syncthreads();
        hg_cumsum(Lb, Bt, Seg, dir, tid);
        __syncthreads();
        float vf[16]; unpack8(vv[0], vf); unpack8(vv[1], vf + 8);
#pragma unroll
        for (int e = 0; e < 16; ++e) { const float kl = kk[e] * __expf(Bt[c0 + e] - Lb[j * 128 + c0 + e]);
            KlT[(c0 + e) * 72 + j] = (bf16_t)(pk2(kl, 0.f) & 0xffffu); VT[(c0 + e) * 72 + j] = (bf16_t)(__float_as_uint(vf[e]) >> 16); }
        if (tid < 128) DC[(size_t)(chain * 65 + c) * 128 + tid] = __expf(Bt[tid]);
        __syncthreads();
        f32x4 acc[8];
#pragma unroll
        for (int ct = 0; ct < 8; ++ct) acc[ct] = (f32x4){0.f, 0.f, 0.f, 0.f};
#pragma unroll
        for (int ks = 0; ks < 2; ++ks) { const bf16x8 a = *(const bf16x8*)(VT + (w * 16 + l15) * 72 + ks * 32 + quad * 8);
#pragma unroll
            for (int ct = 0; ct < 8; ++ct) { const bf16x8 b = *(const bf16x8*)(KlT + (ct * 16 + l15) * 72 + ks * 32 + quad * 8); acc[ct] = mfma16(a, b, acc[ct]); } }
        float* xo = X + (size_t)(chain * 65 + c) * 16384;
#pragma unroll
        for (int ct = 0; ct < 8; ++ct)
#pragma unroll
            for (int jj = 0; jj < 4; ++jj) xo[(w * 16 + quad * 4 + jj) * 128 + ct * 16 + l15] = acc[ct][jj];
        __syncthreads();
    }
}
DEV void phase_hg2(const Params& P0, int bid, int nb, int wv) {
    Params P = load_params(); asm volatile("" : "+s"(P.ws));
    const int gtid = bid * 512 + launder_tid(wv), gth = nb * 512;
    f32x4* X = (f32x4*)slotp(P, 17); const f32x4* DC = (const f32x4*)(P.ws + WS_DECAY);
    for (int e = gtid; e < 32 * 4096; e += gth) {
        const int chain = e >> 12, e4 = e & 4095, dir = chain & 1;
        f32x4 S = (f32x4){0.f, 0.f, 0.f, 0.f};
#pragma unroll 5
        for (int step = 0; step < 65; ++step) { const int c = dir ? 64 - step : step;
            const size_t idx = (size_t)(chain * 65 + c) * 4096 + e4;
            const f32x4 kv = X[idx]; const f32x4 dc = DC[(size_t)(chain * 65 + c) * 32 + (e4 & 31)];
            X[idx] = S; S = dc * S + kv; }
    }
}
DEV void phase_hg3(const Params& P0, int layer, unsigned char* lds, int bid, int nb, int wv) {
    Params P = load_params(); asm volatile("" : "+s"(P.ws));
    float* Lb = (float*)lds; bf16_t* Qs = (bf16_t*)(lds + 32768); bf16_t* Ks = (bf16_t*)(lds + 50176); bf16_t* Am = (bf16_t*)(lds + 67584);
    bf16_t* VT = (bf16_t*)(lds + 76800); bf16_t* Sb = (bf16_t*)(lds + 95232); float* Bt = (float*)(lds + 130048); float* Seg = (float*)(lds + 132096); float* Ost = (float*)lds;
    const float* X = (const float*)slotp(P, 17);
    const int tid = launder_tid(wv), lane = tid & 63, w = __builtin_amdgcn_readfirstlane(tid >> 6), j = tid >> 3, c0 = (tid & 7) * 16, l15 = lane & 15, quad = lane >> 4;
    const int tt = w >> 1, st0 = (w & 1) * 2, vt0 = (w & 1) * 4;
    const int cfirst = layer == 0 ? 0 : 1;
    const int ncb = 65 - cfirst;
    for (int unit = bid; unit < 16 * ncb; unit += nb) {
        const int sh = unit / ncb, c = unit - sh * ncb + cfirst, sl = sh >> 2, head = sh & 3;
        bool valid; const int r = hg_row(sl, c, j, valid);
        float q[16]; uint4 gv[2] = {make_uint4(0, 0, 0, 0), make_uint4(0, 0, 0, 0)};
        if (valid) {
            const uint4* qp = (const uint4*)(slotp(P, 2) + (size_t)r * 512 + head * 128 + c0); unpack8(qp[0], q); unpack8(qp[1], q + 8);
            const uint4* vp = (const uint4*)(slotp(P, 5) + (size_t)r * 512 + head * 128 + c0); float vf[16]; unpack8(vp[0], vf); unpack8(vp[1], vf + 8);
#pragma unroll
            for (int e = 0; e < 16; ++e) VT[(c0 + e) * 72 + j] = (bf16_t)(__float_as_uint(vf[e]) >> 16);
            const uint4* gp = (const uint4*)(slotp(P, 6) + (size_t)r * 512 + head * 128 + c0); gv[0] = gp[0]; gv[1] = gp[1];
        } else {
#pragma unroll
            for (int e = 0; e < 16; ++e) { q[e] = 0.f; VT[(c0 + e) * 72 + j] = 0; } }
        f32x4 accA[2], accO[4];
#pragma unroll
        for (int i = 0; i < 2; ++i) accA[i] = (f32x4){0.f, 0.f, 0.f, 0.f};
#pragma unroll
        for (int i = 0; i < 4; ++i) accO[i] = (f32x4){0.f, 0.f, 0.f, 0.f};
#pragma unroll 1
        for (int dir = 0; dir < 2; ++dir) {
            float lg[16], kk[16];
            if (valid) { float fr[16];
                const uint4* fp = (const uint4*)(slotp(P, 3 + dir) + (size_t)r * 512 + head * 128 + c0); unpack8(fp[0], fr); unpack8(fp[1], fr + 8);
#pragma unroll
                for (int e = 0; e < 16; ++e) hg_gate(fr[e], hg_lb(P, layer, dir, head * 128 + c0 + e), lg[e], kk[e]);
            } else {
#pragma unroll
                for (int e = 0; e < 16; ++e) { lg[e] = 0.f; kk[e] = 0.f; } }
#pragma unroll
            for (int e = 0; e < 16; e += 4) *(f32x4*)(Lb + j * 128 + c0 + e) = (f32x4){lg[e], lg[e + 1], lg[e + 2], lg[e + 3]};
            __syncthreads();
            hg_cumsum(Lb, Bt, Seg, dir, tid);
            __syncthreads();
            {
                float qs[16], ks[16];
#pragma unroll
                for (int e = 0; e < 16; ++e) { const float b = Lb[j * 128 + c0 + e], rf = Lb[32 * 128 + c0 + e]; qs[e] = q[e] * __expf(b - rf); ks[e] = kk[e] * __expf(rf - b); }
                *(uint4*)(Qs + j * 136 + c0) = pack8(qs); *(uint4*)(Qs + j * 136 + c0 + 8) = pack8(qs + 8);
                *(uint4*)(Ks + j * 136 + c0) = pack8(ks); *(uint4*)(Ks + j * 136 + c0 + 8) = pack8(ks + 8);
            }
            {
                const int chain = sl * 8 + head * 2 + dir; const f32x4* xs = (const f32x4*)(X + (size_t)(chain * 65 + c) * 16384 + (size_t)(tid >> 2) * 128 + (tid & 3) * 32);
#pragma unroll
                for (int i = 0; i < 4; ++i) { const f32x4 a = xs[2 * i], b = xs[2 * i + 1]; uint4 o; o.x = pk2(a[0], a[1]); o.y = pk2(a[2], a[3]); o.z = pk2(b[0], b[1]); o.w = pk2(b[2], b[3]);
                    *(uint4*)(Sb + (tid >> 2) * 136 + (tid & 3) * 32 + i * 8) = o; }
            }
            __syncthreads();
            {
                f32x4 t0 = (f32x4){0.f, 0.f, 0.f, 0.f}, t1 = t0;
#pragma unroll
                for (int k4 = 0; k4 < 4; ++k4) { const bf16x8 a = *(const bf16x8*)(Qs + (tt * 16 + l15) * 136 + k4 * 32 + quad * 8);
                    const bf16x8 b0 = *(const bf16x8*)(Ks + ((st0 + 0) * 16 + l15) * 136 + k4 * 32 + quad * 8); const bf16x8 b1 = *(const bf16x8*)(Ks + ((st0 + 1) * 16 + l15) * 136 + k4 * 32 + quad * 8);
                    t0 = mfma16(a, b0, t0); t1 = mfma16(a, b1, t1); }
#pragma unroll
                for (int jj = 0; jj < 4; ++jj) { const int t = tt * 16 + quad * 4 + jj, s0 = (st0 + 0) * 16 + l15, s1 = (st0 + 1) * 16 + l15;
                    const bool k0 = dir == 0 ? s0 <= t : s0 >= t, k1 = dir == 0 ? s1 <= t : s1 >= t;
                    accA[0][jj] += k0 ? t0[jj] : 0.f; accA[1][jj] += k1 ? t1[jj] : 0.f; }
            }
            __syncthreads();
            {   float qg[16];
#pragma unroll
                for (int e = 0; e < 16; ++e) qg[e] = q[e] * __expf(Lb[j * 128 + c0 + e]);
                *(uint4*)(Qs + j * 136 + c0) = pack8(qg); *(uint4*)(Qs + j * 136 + c0 + 8) = pack8(qg + 8); }
            __syncthreads();
#pragma unroll
            for (int k4 = 0; k4 < 4; ++k4) { const bf16x8 a = *(const bf16x8*)(Qs + (tt * 16 + l15) * 136 + k4 * 32 + quad * 8);
#pragma unroll
                for (int v4 = 0; v4 < 4; ++v4) { const bf16x8 b = *(const bf16x8*)(Sb + ((vt0 + v4) * 16 + l15) * 136 + k4 * 32 + quad * 8); accO[v4] = mfma16(a, b, accO[v4]); } }
            __syncthreads();
        }
#pragma unroll
        for (int s2 = 0; s2 < 2; ++s2)
#pragma unroll
            for (int jj = 0; jj < 4; ++jj) Am[(tt * 16 + quad * 4 + jj) * 72 + (st0 + s2) * 16 + l15] = (bf16_t)(pk2(accA[s2][jj], 0.f) & 0xffffu);
        __syncthreads();
#pragma unroll
        for (int ks = 0; ks < 2; ++ks) { const bf16x8 a = *(const bf16x8*)(Am + (tt * 16 + l15) * 72 + ks * 32 + quad * 8);
#pragma unroll
            for (int v4 = 0; v4 < 4; ++v4) { const bf16x8 b = *(const bf16x8*)(VT + ((vt0 + v4) * 16 + l15) * 72 + ks * 32 + quad * 8); accO[v4] = mfma16(a, b, accO[v4]); } }
#pragma unroll
        for (int v4 = 0; v4 < 4; ++v4)
#pragma unroll
            for (int jj = 0; jj < 4; ++jj) Ost[(tt * 16 + quad * 4 + jj) * 132 + (vt0 + v4) * 16 + l15] = accO[v4][jj];
        __syncthreads();
        {   float o[16], ss = 0.f;
#pragma unroll
            for (int e = 0; e < 16; ++e) { o[e] = Ost[j * 132 + c0 + e]; ss += o[e] * o[e]; }
            ss = red8(ss);
            const float rs = rsqrtf(ss * (1.f / 128.f) + 1e-6f);
            float gf[16]; unpack8(gv[0], gf); unpack8(gv[1], gf + 8);
#pragma unroll
            for (int e = 0; e < 16; ++e) { const float gg = gf[e]; o[e] = o[e] * rs * P.in[I_ONORM][layer * 512 + head * 128 + c0 + e] * (gg / (1.f + __expf(-gg))); }
            if (valid) { uint4* yp = (uint4*)(slotp(P, 2) + (size_t)r * 512 + head * 128 + c0); yp[0] = pack8(o); yp[1] = pack8(o + 8); }
        }
        __syncthreads();
    }
}
DEV void phase_vtrans(const Params& P0, unsigned char* lds, int bid, int nb, int wv) {
    Params P = load_params(); asm volatile("" : "+s"(P.ws));
    bf16_t* T = (bf16_t*)lds;
    const bf16_t* V = slotp(P, 12); bf16_t* VTg = slotp(P, 6);
    const int tid = launder_tid(wv);
    for (int unit = bid; unit < 4 * 65 * 8; unit += nb) {
        const int sl = unit / 520, rem = unit - sl * 520, pt = rem >> 3, vdt = rem & 7;
        { const int tok = tid >> 3, c8 = (tid & 7) * 8, p = pt * 64 + tok;
          uint4 v = make_uint4(0, 0, 0, 0);
          if (p < LSEQ) v = *(const uint4*)(V + (size_t)row_of(sl, p) * 512 + vdt * 64 + c8);
          *(uint4*)(T + tok * 72 + c8) = v; }
        __syncthreads();
        { const int vd = tid >> 3, t8 = (tid & 7) * 8;
          unsigned short e[8];
#pragma unroll
          for (int i = 0; i < 8; ++i) { const int pp = t8 + i; const int sp = (pp & ~12) | (((pp >> 2) & 1) << 3) | (((pp >> 3) & 1) << 2); e[i] = T[sp * 72 + vd]; }
          uint4 o; o.x = e[0] | ((unsigned)e[1] << 16); o.y = e[2] | ((unsigned)e[3] << 16); o.z = e[4] | ((unsigned)e[5] << 16); o.w = e[6] | ((unsigned)e[7] << 16);
          *(uint4*)(VTg + (size_t)(sl * 512 + vdt * 64 + vd) * 4160 + pt * 64 + t8) = o; }
        __syncthreads();
    }
}
DEV int crow(int r, int hi) { return (r & 3) + 8 * (r >> 2) + 4 * hi; }
typedef unsigned u32x4_t __attribute__((ext_vector_type(4)));
struct AttnStage { u32x4_t k0, k1, v0, v1; };
DEV void attn_stage_load(const Params& P, int sl, int head, int kt, int tid, AttnStage& st) {
    const bf16_t* Kg = slotp(P, 11); const bf16_t* VTg = slotp(P, 6);
    { const int ci = tid, krow = ci >> 4, kc = ci & 15; const int p = kt * 64 + krow; const int r = p < LSEQ ? row_of(sl, p) : 0; st.k0 = *(const u32x4_t*)(Kg + (size_t)r * 512 + head * 128 + kc * 8); }
    { const int ci = tid + 512, krow = ci >> 4, kc = ci & 15; const int p = kt * 64 + krow; const int r = p < LSEQ ? row_of(sl, p) : 0; st.k1 = *(const u32x4_t*)(Kg + (size_t)r * 512 + head * 128 + kc * 8); }
    { const int vi = tid, vrow = vi >> 3, vc = vi & 7; st.v0 = *(const u32x4_t*)(VTg + (size_t)(sl * 512 + head * 128 + vrow) * 4160 + kt * 64 + vc * 8); }
    { const int vi = tid + 512, vrow = vi >> 3, vc = vi & 7; st.v1 = *(const u32x4_t*)(VTg + (size_t)(sl * 512 + head * 128 + vrow) * 4160 + kt * 64 + vc * 8); }
}
DEV void attn_stage_store(unsigned char* buf, int tid, const AttnStage& st) {
    bf16_t* Kt = (bf16_t*)buf; bf16_t* Vt = (bf16_t*)(buf + 17408);
    { const int ci = tid, krow = ci >> 4, kc = ci & 15; *(u32x4_t*)(Kt + krow * 136 + kc * 8) = st.k0; }
    { const int ci = tid + 512, krow = ci >> 4, kc = ci & 15; *(u32x4_t*)(Kt + krow * 136 + kc * 8) = st.k1; }
    { const int vi = tid, vrow = vi >> 3, vc = vi & 7; *(u32x4_t*)(Vt + vrow * 72 + vc * 8) = st.v0; }
    { const int vi = tid + 512, vrow = vi >> 3, vc = vi & 7; *(u32x4_t*)(Vt + vrow * 72 + vc * 8) = st.v1; }
}
DEV void phase_attn(const Params& P0, int layer, unsigned char* lds, int bid, int nb, int wv) {
    Params P = load_params(); asm volatile("" : "+s"(P.ws));
    const int tid = launder_tid(wv), lane = tid & 63, w = __builtin_amdgcn_readfirstlane(tid >> 6), map = w >> 2, qsub = w & 3, qi = lane & 31, hi = lane >> 5;
    const float lam_init = layer == 0 ? 0.2f : 0.35550906759096934f;
    float lam;
    { const float* lp = P.in[I_LAM] + (size_t)layer * 256; float s1 = 0.f, s2 = 0.f;
      for (int i = 0; i < 64; ++i) { s1 += lp[i] * lp[64 + i]; s2 += lp[128 + i] * lp[192 + i]; }
      lam = __expf(s1) - __expf(s2) + lam_init; }
    const int nqb = layer == 0 ? 33 : 32;
    float* Ex = (float*)lds;
    const bool xmap = (nb & 7) == 0;
    const int ustart = xmap ? (bid >> 3) : bid, ustep = xmap ? (nb >> 3) : nb, uend = xmap ? 2 * nqb : 16 * nqb;
    for (int unit = ustart; unit < uend; unit += ustep) {
        const int sh = xmap ? 2 * (bid & 7) + unit / nqb : unit / nqb, qb = unit % nqb, sl = sh >> 2, head = sh & 3;
        const int qrow0 = qb < 32 ? sl * 4096 + qb * 128 : TREAL + sl * 16; const int nvalid = qb < 32 ? 128 : 16;
        bf16x8 Qf[4];
        { const bf16_t* qp = slotp(P, 10) + (size_t)(qrow0 + qsub * 32 + qi) * 512 + head * 128 + map * 64 + hi * 8;
#pragma unroll
          for (int ds = 0; ds < 4; ++ds) Qf[ds] = *(const bf16x8*)(qp + ds * 16); }
        AttnStage st;
        attn_stage_load(P, sl, head, 0, tid, st); attn_stage_store(lds, tid, st); attn_stage_load(P, sl, head, 1, tid, st);
        __syncthreads();
        f32x16 O[4];
#pragma unroll
        for (int v = 0; v < 4; ++v)
#pragma unroll
            for (int r = 0; r < 16; ++r) O[v][r] = 0.f;
        float m_run = -INFINITY, l_run = 0.f;
#pragma unroll 1
        for (int kt = 0; kt < 65; ++kt) {
            if (kt + 1 < 65) attn_stage_store(lds + ((kt + 1) & 1) * 35840, tid, st);
            if (kt + 2 < 65) attn_stage_load(P, sl, head, kt + 2, tid, st);
            const unsigned char* buf = lds + (kt & 1) * 35840;
            const bf16_t* Kb = (const bf16_t*)buf; const bf16_t* Vb = (const bf16_t*)(buf + 17408);
            f32x16 S0, S1;
#pragma unroll
            for (int r = 0; r < 16; ++r) { S0[r] = 0.f; S1[r] = 0.f; }
#pragma unroll
            for (int ds = 0; ds < 4; ++ds) {
                const bf16x8 a0 = *(const bf16x8*)(Kb + qi * 136 + map * 64 + ds * 16 + hi * 8);
                const bf16x8 a1 = *(const bf16x8*)(Kb + (32 + qi) * 136 + map * 64 + ds * 16 + hi * 8);
                S0 = mfma32(a0, Qf[ds], S0); S1 = mfma32(a1, Qf[ds], S1); }
            if (kt == 64) {
#pragma unroll
                for (int r = 0; r < 16; ++r) { if (crow(r, hi) >= 16) S0[r] = -INFINITY; S1[r] = -INFINITY; } }
            float mx = -INFINITY;
#pragma unroll
            for (int r = 0; r < 16; ++r) mx = fmaxf(mx, fmaxf(S0[r], S1[r]));
            { const auto sw = __builtin_amdgcn_permlane32_swap(__float_as_uint(mx), __float_as_uint(mx), false, false); mx = fmaxf(__uint_as_float(sw[0]), __uint_as_float(sw[1])); }
            const float m_new = fmaxf(m_run, mx); const float alpha = __builtin_amdgcn_exp2f(m_run - m_new); m_run = m_new;
            float ps = 0.f;
#pragma unroll
            for (int r = 0; r < 16; ++r) { S0[r] = __builtin_amdgcn_exp2f(S0[r] - m_new); S1[r] = __builtin_amdgcn_exp2f(S1[r] - m_new); ps += S0[r] + S1[r]; }
            l_run = l_run * alpha + ps;
            if (__builtin_amdgcn_ballot_w64(alpha != 1.0f) != 0ull) {
#pragma unroll
                for (int v = 0; v < 4; ++v)
#pragma unroll
                    for (int r = 0; r < 16; ++r) O[v][r] *= alpha; }
            bf16x8 pf[2][2];
#pragma unroll
            for (int half = 0; half < 2; ++half) {
                uint4 a, b;
                a.x = pk2(S0[half * 8 + 0], S0[half * 8 + 1]); a.y = pk2(S0[half * 8 + 2], S0[half * 8 + 3]); a.z = pk2(S0[half * 8 + 4], S0[half * 8 + 5]); a.w = pk2(S0[half * 8 + 6], S0[half * 8 + 7]);
                b.x = pk2(S1[half * 8 + 0], S1[half * 8 + 1]); b.y = pk2(S1[half * 8 + 2], S1[half * 8 + 3]); b.z = pk2(S1[half * 8 + 4], S1[half * 8 + 5]); b.w = pk2(S1[half * 8 + 6], S1[half * 8 + 7]);
                pf[0][half] = __builtin_bit_cast(bf16x8, a); pf[1][half] = __builtin_bit_cast(bf16x8, b); }
#pragma unroll
            for (int v = 0; v < 4; ++v)
#pragma unroll
                for (int sub = 0; sub < 2; ++sub)
#pragma unroll
                    for (int half = 0; half < 2; ++half) {
                        const bf16x8 av = *(const bf16x8*)(Vb + (v * 32 + qi) * 72 + sub * 32 + half * 16 + hi * 8);
                        O[v] = mfma32(av, pf[sub][half], O[v]); }
            __syncthreads();
        }
        const float l_tot = l_run + __shfl_xor(l_run, 32); const float inv = 1.0f / l_tot;
        if (map == 1) {
#pragma unroll
            for (int v = 0; v < 4; ++v)
#pragma unroll
                for (int r = 0; r < 16; ++r) Ex[(qsub * 32 + qi) * 132 + v * 32 + crow(r, hi)] = O[v][r] * inv; }
        __syncthreads();
        if (map == 0) {
            float ss = 0.f;
#pragma unroll
            for (int v = 0; v < 4; ++v)
#pragma unroll
                for (int r = 0; r < 16; ++r) { const float o = O[v][r] * inv - lam * Ex[(qsub * 32 + qi) * 132 + v * 32 + crow(r, hi)]; O[v][r] = o; ss += o * o; }
            ss += __shfl_xor(ss, 32);
            const float rs = rsqrtf(ss * (1.f / 128.f) + 1e-5f) * (1.f - lam_init);
            if (qsub * 32 + qi < nvalid) {
                bf16_t* yp = slotp(P, 4) + (size_t)(qrow0 + qsub * 32 + qi) * 512 + head * 128;
#pragma unroll
                for (int v = 0; v < 4; ++v)
#pragma unroll
                    for (int rg = 0; rg < 4; ++rg) { const int vd0 = v * 32 + 8 * rg + 4 * hi; const f32x4 gg = *(const f32x4*)(P.in[I_SUBLN] + layer * 128 + vd0);
                        uint2 o; o.x = pk2(O[v][rg * 4 + 0] * rs * gg[0], O[v][rg * 4 + 1] * rs * gg[1]); o.y = pk2(O[v][rg * 4 + 2] * rs * gg[2], O[v][rg * 4 + 3] * rs * gg[3]);
                        *(uint2*)(yp + vd0) = o; } }
        }
        __syncthreads();
    }
}
DEV float dpp_f(float x, const int ctrl) { return x; }
template <int CTRL> DEV float dppmov(float x) { return __builtin_bit_cast(float, __builtin_amdgcn_update_dpp(0, __builtin_bit_cast(int, x), CTRL, 0xf, 0xf, true)); }
DEV float sum16(float x) { x += dppmov<0xB1>(x); x += dppmov<0x4E>(x); x += dppmov<0x141>(x); x += dppmov<0x140>(x); return x; }
constexpr int RW_CH = 16, RW_BUF_F = 5120 + 256 + 4096, RW_BUFB = RW_BUF_F * 4;
struct RwRegs { u32x4_t r, k, kk, e, a, v; };
DEV void unpack8v(const u32x4_t w, float* f) { unpack8(make_uint4(w.x, w.y, w.z, w.w), f); }
DEV void rw_stage_load(const Params& P, RwRegs& g, int sl, int head, int dir, int qr, int ck, int t) {
    if (t < 128) { const int step = t >> 3, ch8 = (t & 7) * 8, sidx = ck * RW_CH + step;
        if (sidx < LSEQ) { const int p = dir ? LSEQ - 1 - sidx : sidx; const size_t ro = (size_t)row_of(sl, p) * 512 + head * 64 + ch8;
            g.r = *(const u32x4_t*)(slotp(P, 17) + ro); g.k = *(const u32x4_t*)(slotp(P, 18) + ro); g.kk = *(const u32x4_t*)(slotp(P, 20) + ro);
            g.e = *(const u32x4_t*)(slotp(P, 22 + dir) + ro); g.a = *(const u32x4_t*)(slotp(P, dir == 0 ? 24 : 13) + ro); } }
    if (t < 32) { const int tt = t, s2 = tt >> 1, r8 = (tt & 1) * 8, si2 = ck * RW_CH + s2;
        if (si2 < LSEQ) { const int p2 = dir ? LSEQ - 1 - si2 : si2; g.v = *(const u32x4_t*)(slotp(P, 19) + (size_t)row_of(sl, p2) * 512 + head * 64 + qr * 16 + r8); } }
}
DEV void rw_stage_write(const Params& P, int layer, unsigned char* buf, const RwRegs& g, int head, int ck, int t) {
    float* Rr = (float*)buf; float* Ww = Rr + 1024; float* Kd = Ww + 1024; float* Kk = Kd + 1024; float* Bb = Kk + 1024; float* Vs = Bb + 1024;
    if (t < 128) { const int step = t >> 3, ch8 = (t & 7) * 8, sidx = ck * RW_CH + step;
        if (sidx < LSEQ) {
            float r[8], k[8], kk[8], e[8], a[8];
            unpack8v(g.r, r); unpack8v(g.k, k); unpack8v(g.kk, kk); unpack8v(g.e, e); unpack8v(g.a, a);
            float ww[8], kd[8], bb[8];
#pragma unroll
            for (int j = 0; j < 8; ++j) { ww[j] = __expf(-e[j]); kd[j] = k[j] * (1.f + (a[j] - 1.f) * P.in[I_KA][layer * 512 + head * 64 + ch8 + j]); bb[j] = kk[j] * a[j]; }
            const int o = step * 64 + ch8;
            *(f32x4*)(Rr + o) = (f32x4){r[0], r[1], r[2], r[3]}; *(f32x4*)(Rr + o + 4) = (f32x4){r[4], r[5], r[6], r[7]};
            *(f32x4*)(Ww + o) = (f32x4){ww[0], ww[1], ww[2], ww[3]}; *(f32x4*)(Ww + o + 4) = (f32x4){ww[4], ww[5], ww[6], ww[7]};
            *(f32x4*)(Kd + o) = (f32x4){kd[0], kd[1], kd[2], kd[3]}; *(f32x4*)(Kd + o + 4) = (f32x4){kd[4], kd[5], kd[6], kd[7]};
            *(f32x4*)(Kk + o) = (f32x4){kk[0], kk[1], kk[2], kk[3]}; *(f32x4*)(Kk + o + 4) = (f32x4){kk[4], kk[5], kk[6], kk[7]};
            *(f32x4*)(Bb + o) = (f32x4){bb[0], bb[1], bb[2], bb[3]}; *(f32x4*)(Bb + o + 4) = (f32x4){bb[4], bb[5], bb[6], bb[7]};
        } }
    if (t < 32) { const int tt = t, s2 = tt >> 1, r8 = (tt & 1) * 8, si2 = ck * RW_CH + s2;
        if (si2 < LSEQ) { float v[8]; unpack8v(g.v, v);
            *(f32x4*)(Vs + s2 * 16 + r8) = (f32x4){v[0], v[1], v[2], v[3]}; *(f32x4*)(Vs + s2 * 16 + r8 + 4) = (f32x4){v[4], v[5], v[6], v[7]}; } }
}
DEV void rw_flush(const Params& P, const unsigned char* buf, int sl, int head, int dir, int qr, int ck, int t) {
    if (t >= 160 && t < 192) { const float* Op = (const float*)buf + 5376; const int tt = t - 160, s2 = tt >> 1, r8 = (tt & 1) * 8, sidx = ck * RW_CH + s2;
        if (sidx < LSEQ) { const int p = dir ? LSEQ - 1 - sidx : sidx; float o[8];
#pragma unroll
            for (int j = 0; j < 8; ++j) { const int row = r8 + j; const f32x4* q = (const f32x4*)(Op + s2 * 256 + (row >> 2) * 64 + (row & 3) * 16);
                const f32x4 a = q[0], b = q[1], c = q[2], d = q[3];
                o[j] = ((a[0] + a[1]) + (a[2] + a[3])) + ((b[0] + b[1]) + (b[2] + b[3])) + (((c[0] + c[1]) + (c[2] + c[3])) + ((d[0] + d[1]) + (d[2] + d[3]))); }
            *(uint4*)(slotp(P, 15 + dir) + (size_t)row_of(sl, p) * 512 + head * 64 + qr * 16 + r8) = pack8(o); } }
}
DEV void phase_rw_scan(const Params& P0, int layer, unsigned char* lds, int bid, int nb, int wv) {
    Params P = load_params(); asm volatile("" : "+s"(P.ws));
    const int tid = launder_tid(wv), lane = tid & 63, w = __builtin_amdgcn_readfirstlane(tid >> 6), li = lane & 15, rl = (w & 3) * 4 + (lane >> 4);
    constexpr int NCK = (LSEQ + RW_CH - 1) / RW_CH;
    typedef float f32x2 __attribute__((ext_vector_type(2)));
    for (int unit = bid; unit < 256; unit += nb) {
        const int sl = unit >> 6, head = (unit >> 3) & 7, dir = (unit >> 2) & 1, qr = unit & 3;
        f32x2 SA = (f32x2){0.f, 0.f}, SB = (f32x2){0.f, 0.f};
        RwRegs g; g.r = g.k = g.kk = g.e = g.a = g.v = (u32x4_t){0u, 0u, 0u, 0u};
        if (w >= 4) { rw_stage_load(P, g, sl, head, dir, qr, 0, tid - 256); rw_stage_write(P, layer, lds, g, head, 0, tid - 256); rw_stage_load(P, g, sl, head, dir, qr, 1, tid - 256); }
        __syncthreads();
#pragma unroll 1
        for (int ck = 0; ck < NCK; ++ck) {
            unsigned char* buf = lds + (ck & 1) * RW_BUFB;
            if (w >= 4) {
                if (ck + 1 < NCK) rw_stage_write(P, layer, lds + ((ck + 1) & 1) * RW_BUFB, g, head, ck + 1, tid - 256);
                if (ck + 2 < NCK) rw_stage_load(P, g, sl, head, dir, qr, ck + 2, tid - 256);
                if (ck > 0) rw_flush(P, lds + ((ck - 1) & 1) * RW_BUFB, sl, head, dir, qr, ck - 1, tid - 256);
            } else {
                const float* Rr = (const float*)buf + li * 4; const float* Vs = (const float*)buf + 5120 + rl; float* Op = (float*)buf + 5376 + w * 64 + lane;
                const int ns = (LSEQ - ck * RW_CH) < RW_CH ? (LSEQ - ck * RW_CH) : RW_CH;
                f32x4 rr = *(const f32x4*)(Rr), ww = *(const f32x4*)(Rr + 1024), kd = *(const f32x4*)(Rr + 2048), kk = *(const f32x4*)(Rr + 3072), bb = *(const f32x4*)(Rr + 4096); float vv = Vs[0];
#pragma unroll 2
                for (int i = 0; i < ns; ++i) {
                    const int in = i < RW_CH - 1 ? i + 1 : RW_CH - 1;
                    const f32x4 rr_n = *(const f32x4*)(Rr + in * 64), ww_n = *(const f32x4*)(Rr + 1024 + in * 64), kd_n = *(const f32x4*)(Rr + 2048 + in * 64);
                    const f32x4 kk_n = *(const f32x4*)(Rr + 3072 + in * 64), bb_n = *(const f32x4*)(Rr + 4096 + in * 64); const float vv_n = Vs[in * 16];
                    f32x2 p = SA * (f32x2){kk[0], kk[1]}; p = __builtin_elementwise_fma(SB, (f32x2){kk[2], kk[3]}, p);
                    const f32x2 vv2 = (f32x2){vv, vv};
                    const f32x2 ta = vv2 * (f32x2){kd[0], kd[1]}, tb = vv2 * (f32x2){kd[2], kd[3]};
                    const float sa = -sum16(p[0] + p[1]);
                    const f32x2 sa2 = (f32x2){sa, sa};
                    SA = __builtin_elementwise_fma(SA, (f32x2){ww[0], ww[1]}, __builtin_elementwise_fma(sa2, (f32x2){bb[0], bb[1]}, ta));
                    SB = __builtin_elementwise_fma(SB, (f32x2){ww[2], ww[3]}, __builtin_elementwise_fma(sa2, (f32x2){bb[2], bb[3]}, tb));
                    f32x2 q = SA * (f32x2){rr[0], rr[1]}; q = __builtin_elementwise_fma(SB, (f32x2){rr[2], rr[3]}, q);
                    Op[i * 256] = q[0] + q[1];
                    rr = rr_n; ww = ww_n; kd = kd_n; kk = kk_n; bb = bb_n; vv = vv_n;
                }
            }
            __syncthreads();
        }
        if (w >= 4) rw_flush(P, lds + ((NCK - 1) & 1) * RW_BUFB, sl, head, dir, qr, NCK - 1, tid - 256);
        __syncthreads();
    }
}
static_assert(LSEQ == 257 * 16, "chunked RWKV assumes whole 16-step chunks");
constexpr int RWC_REC = 8960, RWC_NCK = 257;
DEV unsigned char* rwc_rec(const Params& P, int dir, int idx) {
    if (dir == 0) return (unsigned char*)slotp(P, 5) + (size_t)idx * RWC_REC;
    if (idx < 5705) return (unsigned char*)slotp(P, 10) + (size_t)idx * RWC_REC;
    if (idx < 7606) return (unsigned char*)slotp(P, 21) + (size_t)(idx - 5705) * RWC_REC;
    return (unsigned char*)slotp(P, 5) + (size_t)(8224 + idx - 7606) * RWC_REC; }
DEV int rwc_slot(int c) { return (((c >> 5) * 4 + ((c >> 2) & 3)) * 8) + ((c >> 4) & 1) * 4 + (c & 3); }
DEV void phase_rwc_pre(const Params& P0, int layer, unsigned char* lds, int bid, int nb, int wv) {
    Params P = load_params(); asm volatile("" : "+s"(P.ws));
    const int tid = launder_tid(wv), lane = tid & 63, w = __builtin_amdgcn_readfirstlane(tid >> 6), l15 = lane & 15, quad = lane >> 4;
    unsigned char* wl = lds + w * 15616;
    bf16_t* Bt = (bf16_t*)wl; bf16_t* Dt = Bt + 16 * 72; bf16_t* Ak = Dt + 16 * 72; bf16_t* Rt = Ak + 16 * 72;
    float* Mb = (float*)(wl + 9216); float* Md = Mb + 256; float* Gb = Md + 256; float* Gd = Gb + 256; float* Tm = Gd + 256; float* Nm = Tm + 256;
    const float ka = P.in[I_KA][layer * 512 + 0];  (void)ka;
    for (int unit2 = bid * 8 + w; unit2 < 2 * 32 * RWC_NCK; unit2 += nb * 8) {
        const int dir = unit2 >= 32 * RWC_NCK ? 1 : 0; const int unit = unit2 - dir * 32 * RWC_NCK;
        const int sh = unit / RWC_NCK, ck = unit - sh * RWC_NCK, sl = sh >> 3, head = sh & 7;
        const float kac = P.in[I_KA][layer * 512 + head * 64 + lane];
        float ak[16], bt[16], dt[16], rt[16];
        typedef const __attribute__((address_space(1))) unsigned short* gu16p;
        const gu16p pR = (gu16p)slotp(P, 17), pK = (gu16p)slotp(P, 18), pKK = (gu16p)slotp(P, 20), pE = (gu16p)slotp(P, 22 + dir), pA = (gu16p)slotp(P, dir == 0 ? 24 : 13);
        unsigned short r16[16], k16[16], q16[16], e16[16], a16[16];
#pragma unroll
        for (int t = 0; t < 16; ++t) {
            const int sidx = ck * 16 + t;
            const int p = dir ? LSEQ - 1 - sidx : sidx; const size_t ro = (size_t)row_of(sl, p) * 512 + head * 64 + lane;
            r16[t] = pR[ro]; k16[t] = pK[ro]; q16[t] = pKK[ro]; e16[t] = pE[ro]; a16[t] = pA[ro]; }
        float g = 1.f;
#pragma unroll
        for (int t = 0; t < 16; ++t) {
            const float r = bf2f(r16[t]), k = bf2f(k16[t]), kk = bf2f(q16[t]), e = bf2f(e16[t]), a = bf2f(a16[t]);
            const float wdec = __expf(-e), kd = k * (1.f + (a - 1.f) * kac), b = kk * a;
            ak[t] = g * kk; g *= wdec; const float gi = __builtin_amdgcn_rcpf(g); bt[t] = b * gi; dt[t] = kd * gi; rt[t] = g * r;
        }
        const float gC = g;
#pragma unroll
        for (int t = 0; t < 16; ++t) { Bt[t * 72 + lane] = (bf16_t)(pk2(bt[t], 0.f) & 0xffffu); Dt[t * 72 + lane] = (bf16_t)(pk2(dt[t], 0.f) & 0xffffu);
            Ak[t * 72 + lane] = (bf16_t)(pk2(ak[t], 0.f) & 0xffffu); Rt[t * 72 + lane] = (bf16_t)(pk2(rt[t], 0.f) & 0xffffu); }
        asm volatile("s_waitcnt lgkmcnt(0)" ::: "memory");
        {
            f32x4 mb = (f32x4){0.f, 0.f, 0.f, 0.f}, md = mb, gb = mb, gd = mb;
#pragma unroll
            for (int ks = 0; ks < 2; ++ks) {
                const bf16x8 fb = *(const bf16x8*)(Bt + l15 * 72 + ks * 32 + quad * 8), fd = *(const bf16x8*)(Dt + l15 * 72 + ks * 32 + quad * 8);
                const bf16x8 fa = *(const bf16x8*)(Ak + l15 * 72 + ks * 32 + quad * 8), fr = *(const bf16x8*)(Rt + l15 * 72 + ks * 32 + quad * 8);
                mb = mfma16(fb, fa, mb); md = mfma16(fd, fa, md); gb = mfma16(fb, fr, gb); gd = mfma16(fd, fr, gd); }
#pragma unroll
            for (int jj = 0; jj < 4; ++jj) { const int j = quad * 4 + jj, t = l15;
                Mb[j * 16 + t] = j < t ? mb[jj] : 0.f; Md[j * 16 + t] = j < t ? md[jj] : 0.f; Gb[j * 16 + t] = j <= t ? gb[jj] : 0.f; Gd[j * 16 + t] = j <= t ? gd[jj] : 0.f; }
        }
        asm volatile("s_waitcnt lgkmcnt(0)" ::: "memory");
        {
            float tc[16];
#pragma unroll
            for (int i = 15; i >= 0; --i) { float acc = (i == l15) ? 1.f : 0.f;
                float mr[16];
#pragma unroll
                for (int q4 = (i + 1) >> 2; q4 < 4; ++q4) { const f32x4 m4 = *(const f32x4*)(Mb + i * 16 + q4 * 4); mr[q4 * 4] = m4[0]; mr[q4 * 4 + 1] = m4[1]; mr[q4 * 4 + 2] = m4[2]; mr[q4 * 4 + 3] = m4[3]; }
#pragma unroll
                for (int l = i + 1; l < 16; ++l) acc -= mr[l] * tc[l];
                tc[i] = acc; }
            if (quad == 0) {
#pragma unroll
                for (int i = 0; i < 16; ++i) Tm[i * 16 + l15] = tc[i]; }
        }
        asm volatile("s_waitcnt lgkmcnt(0)" ::: "memory");
        {
            float n4[4] = {0.f, 0.f, 0.f, 0.f};
#pragma unroll
            for (int l = 0; l < 16; ++l) { const float tv = Tm[l * 16 + l15];
#pragma unroll
                for (int jj = 0; jj < 4; ++jj) n4[jj] += Md[(quad * 4 + jj) * 16 + l] * tv; }
#pragma unroll
            for (int jj = 0; jj < 4; ++jj) Nm[(quad * 4 + jj) * 16 + l15] = n4[jj];
        }
        asm volatile("s_waitcnt lgkmcnt(0)" ::: "memory");
        unsigned char* rec = rwc_rec(P, dir, unit);
        {
            float q4[4];
#pragma unroll
            for (int jj = 0; jj < 4; ++jj) q4[jj] = Gd[(quad * 4 + jj) * 16 + l15];
#pragma unroll
            for (int l = 0; l < 16; ++l) { const float gv = Gb[l * 16 + l15];
#pragma unroll
                for (int jj = 0; jj < 4; ++jj) q4[jj] -= Nm[(quad * 4 + jj) * 16 + l] * gv; }
            *(uint2*)((bf16_t*)(rec + 8192) + l15 * 16 + quad * 4) = make_uint2(pk2(q4[0], q4[1]), pk2(q4[2], q4[3]));
        }
        {
            float ap[16], rp[16], ps[16];
#pragma unroll
            for (int t = 0; t < 16; ++t) { ap[t] = 0.f; rp[t] = rt[t]; }
#pragma unroll
            for (int j = 0; j < 16; ++j) {
#pragma unroll
                for (int q4 = j >> 2; q4 < 4; ++q4) { const f32x4 r4 = *(const f32x4*)(Tm + j * 16 + q4 * 4);
#pragma unroll
                    for (int e = 0; e < 4; ++e) ap[q4 * 4 + e] += ak[j] * r4[e]; } }
#pragma unroll
            for (int j = 0; j < 16; ++j) {
#pragma unroll
                for (int q4 = j >> 2; q4 < 4; ++q4) { const f32x4 r4 = *(const f32x4*)(Gb + j * 16 + q4 * 4);
#pragma unroll
                    for (int e = 0; e < 4; ++e) rp[q4 * 4 + e] -= ap[j] * r4[e]; } }
#pragma unroll
            for (int j = 0; j < 16; ++j) { float acc = dt[j];
#pragma unroll
                for (int q4 = j >> 2; q4 < 4; ++q4) { const f32x4 r4 = *(const f32x4*)(Nm + j * 16 + q4 * 4);
#pragma unroll
                    for (int e = 0; e < 4; ++e) acc -= r4[e] * bt[q4 * 4 + e]; }
                ps[j] = acc * gC; }
            bf16_t* AP = (bf16_t*)rec; bf16_t* RP = AP + 1024; const int so = rwc_slot(lane);
#pragma unroll
            for (int t = 0; t < 16; ++t) { AP[t * 64 + so] = (bf16_t)(pk2(ap[t], 0.f) & 0xffffu); RP[t * 64 + so] = (bf16_t)(pk2(rp[t], 0.f) & 0xffffu); }
            float nb_[16];
#pragma unroll
            for (int t = 0; t < 16; ++t) nb_[t] = -bt[t] * gC;
            uint4* BP = (uint4*)(rec + 4096) + lane * 2; BP[0] = pack8(nb_); BP[1] = pack8(nb_ + 8);
            uint4* PP = (uint4*)(rec + 6144) + lane * 2; PP[0] = pack8(ps); PP[1] = pack8(ps + 8);
            ((float*)(rec + 8704))[lane] = gC;
        }
        asm volatile("s_waitcnt lgkmcnt(0)" ::: "memory");
    }
}
struct RwcRegs { u32x4_t a, b, c, v; };
DEV void rwc_load(const Params& P, RwcRegs& g, int sh, int dir, int ck, int t) {
    const unsigned char* rec = rwc_rec(P, dir, sh * RWC_NCK + ck);
    g.a = *(const u32x4_t*)(rec + (size_t)t * 16); g.b = *(const u32x4_t*)(rec + (size_t)(t + 256) * 16);
    if (t < 48) g.c = *(const u32x4_t*)(rec + (size_t)(t + 512) * 16);
    if (t < 128) { const int j = t >> 3, r8 = (t & 7) * 8, sidx = ck * 16 + j; const int sc = sidx < LSEQ ? sidx : LSEQ - 1; const int p = dir ? LSEQ - 1 - sc : sc;
        g.v = *(const u32x4_t*)(slotp(P, 19) + (size_t)row_of(sh >> 3, p) * 512 + (sh & 7) * 64 + r8); if (sidx >= LSEQ) g.v = (u32x4_t){0u, 0u, 0u, 0u}; }
}
DEV void rwc_store(unsigned char* buf, const RwcRegs& g, int t) {
    *(u32x4_t*)(buf + t * 16) = g.a; *(u32x4_t*)(buf + (t + 256) * 16) = g.b;
    if (t < 48) *(u32x4_t*)(buf + (t + 512) * 16) = g.c;
    if (t < 128) { bf16_t* VsT = (bf16_t*)(buf + RWC_REC); const int j = t >> 3, r8 = (t & 7) * 8;
        VsT[(r8 + 0) * 16 + j] = (bf16_t)(g.v.x & 0xffffu); VsT[(r8 + 1) * 16 + j] = (bf16_t)(g.v.x >> 16); VsT[(r8 + 2) * 16 + j] = (bf16_t)(g.v.y & 0xffffu); VsT[(r8 + 3) * 16 + j] = (bf16_t)(g.v.y >> 16);
        VsT[(r8 + 4) * 16 + j] = (bf16_t)(g.v.z & 0xffffu); VsT[(r8 + 5) * 16 + j] = (bf16_t)(g.v.z >> 16); VsT[(r8 + 6) * 16 + j] = (bf16_t)(g.v.w & 0xffffu); VsT[(r8 + 7) * 16 + j] = (bf16_t)(g.v.w >> 16); }
}
DEV void phase_rwc_scan(const Params& P0, unsigned char* lds, int bid, int nb, int wv) {
    Params P = load_params(); asm volatile("" : "+s"(P.ws));
    const int tid = launder_tid(wv), lane = tid & 63, w = __builtin_amdgcn_readfirstlane(tid >> 6), l15 = lane & 15, quad = lane >> 4;
    constexpr int BUFB = RWC_REC + 2048;
    for (int u2 = bid; u2 < 64; u2 += nb) {
        const int sh = u2 & 31, dir = u2 >> 5; const int sl = sh >> 3, head = sh & 7;
        f32x4 ST[4];
#pragma unroll
        for (int ct = 0; ct < 4; ++ct) ST[ct] = (f32x4){0.f, 0.f, 0.f, 0.f};
        RwcRegs g; g.a = g.b = g.c = g.v = (u32x4_t){0u, 0u, 0u, 0u};
        if (w >= 4) { rwc_load(P, g, sh, dir, 0, tid - 256); rwc_store(lds, g, tid - 256); rwc_load(P, g, sh, dir, 1, tid - 256); }
        __syncthreads();
#pragma unroll 1
        for (int ck = 0; ck < RWC_NCK; ++ck) {
            const unsigned char* buf = lds + (ck & 1) * BUFB;
            if (w >= 4) {
                if (ck + 1 < RWC_NCK) rwc_store(lds + ((ck + 1) & 1) * BUFB, g, tid - 256);
                if (ck + 2 < RWC_NCK) rwc_load(P, g, sh, dir, ck + 2, tid - 256);
            } else {
                const bf16_t* AP = (const bf16_t*)buf; const bf16_t* RP = AP + 1024; const bf16_t* BP = (const bf16_t*)(buf + 4096); const bf16_t* PP = (const bf16_t*)(buf + 6144);
                const bf16_t* QP = (const bf16_t*)(buf + 8192); const float* GC = (const float*)(buf + 8704); const bf16_t* VsT = (const bf16_t*)(buf + RWC_REC);
                const u32x4_t z4 = (u32x4_t){0u, 0u, 0u, 0u};
                u32x4_t sb0, sb1;
                sb0.x = pk2(ST[0][0], ST[0][1]); sb0.y = pk2(ST[0][2], ST[0][3]); sb0.z = pk2(ST[1][0], ST[1][1]); sb0.w = pk2(ST[1][2], ST[1][3]);
                sb1.x = pk2(ST[2][0], ST[2][1]); sb1.y = pk2(ST[2][2], ST[2][3]); sb1.z = pk2(ST[3][0], ST[3][1]); sb1.w = pk2(ST[3][2], ST[3][3]);
                const bf16x8 SB0 = __builtin_bit_cast(bf16x8, sb0), SB1 = __builtin_bit_cast(bf16x8, sb1);
                const bf16x8 a0 = *(const bf16x8*)(AP + l15 * 64 + (0 * 4 + quad) * 8), a1 = *(const bf16x8*)(AP + l15 * 64 + (1 * 4 + quad) * 8);
                const bf16x8 r0 = *(const bf16x8*)(RP + l15 * 64 + (0 * 4 + quad) * 8), r1 = *(const bf16x8*)(RP + l15 * 64 + (1 * 4 + quad) * 8);
                const u32x4_t vq = quad < 2 ? *(const u32x4_t*)(VsT + (w * 16 + l15) * 16 + quad * 8) : z4;
                const u32x4_t qq = quad < 2 ? *(const u32x4_t*)(QP + l15 * 16 + quad * 8) : z4;
                const bf16x8 VB = __builtin_bit_cast(bf16x8, vq), QA = __builtin_bit_cast(bf16x8, qq);
                f32x4 Wt = (f32x4){0.f, 0.f, 0.f, 0.f}, Ot = Wt;
                Wt = mfma16(a0, SB0, Wt); Wt = mfma16(a1, SB1, Wt);
                Ot = mfma16(r0, SB0, Ot); Ot = mfma16(r1, SB1, Ot); Ot = mfma16(QA, VB, Ot);
                u32x4_t wb; wb.x = pk2(Wt[0], Wt[1]); wb.y = pk2(Wt[2], Wt[3]); wb.z = 0u; wb.w = 0u;
                const bf16x8 WB = __builtin_bit_cast(bf16x8, wb);
#pragma unroll
                for (int ct = 0; ct < 4; ++ct) {
                    const f32x4 gc = *(const f32x4*)(GC + ct * 16 + quad * 4);
                    const uint2 bq = *(const uint2*)(BP + (ct * 16 + l15) * 16 + quad * 4);
                    u32x4_t ba; ba.x = bq.x; ba.y = bq.y; ba.z = 0u; ba.w = 0u;
                    const u32x4_t pq = quad < 2 ? *(const u32x4_t*)(PP + (ct * 16 + l15) * 16 + quad * 8) : z4;
                    f32x4 acc = ST[ct] * gc;
                    acc = mfma16(__builtin_bit_cast(bf16x8, ba), WB, acc);
                    acc = mfma16(__builtin_bit_cast(bf16x8, pq), VB, acc);
                    ST[ct] = acc;
                }
                bf16_t* Oo = slotp(P, 15 + dir);
#pragma unroll
                for (int jj = 0; jj < 4; ++jj) { const int sidx = ck * 16 + quad * 4 + jj;
                    if (sidx < LSEQ) { const int p = dir ? LSEQ - 1 - sidx : sidx; Oo[(size_t)row_of(sl, p) * 512 + head * 64 + w * 16 + l15] = (bf16_t)(pk2(Ot[jj], 0.f) & 0xffffu); } }
            }
            __syncthreads();
        }
    }
}

#define LAS __attribute__((address_space(3)))
#define XB_TMO      128
#define XB_XCNT(j)  (256  + 64 * (j))
#define XB_XSUB(j)  (1280 + 64 * (j))
#define XB_XGEN(j)  (2304 + 64 * (j))
#define XB_TOP      3328
#define XB_TOPGEN   3392
#define XCD_BAR_WORDS 3456
#define XB_SPIN_CAP (1u << 18)

__device__ __forceinline__ unsigned xb_ld(unsigned* p)              { return __hip_atomic_load(p, __ATOMIC_RELAXED, __HIP_MEMORY_SCOPE_AGENT); }
__device__ __forceinline__ unsigned xb_add(unsigned* p, unsigned v) { return __hip_atomic_fetch_add(p, v, __ATOMIC_RELAXED, __HIP_MEMORY_SCOPE_AGENT); }
__device__ __forceinline__ unsigned xb_xcc_id() { return (unsigned)__builtin_amdgcn_s_getreg((3 << 11) | 20) & 0xFu; }
#define XB_SPIN(cond, bar) do { unsigned _sp = 0; while (cond) { __builtin_amdgcn_s_sleep(1); \
    if ((++_sp & 255u) == 0u) { if (xb_ld(&(bar)[XB_TMO])) break; if (_sp > XB_SPIN_CAP) { atomicAdd(&(bar)[XB_TMO], 1u); break; } } } } while (0)

struct XcdBarrier {
    unsigned* bar; unsigned x;
    volatile LAS unsigned* st;
};

__device__ __forceinline__ XcdBarrier xcd_barrier_post(unsigned* bar, volatile LAS unsigned* st, int wv) {
    XcdBarrier b; b.bar = bar; b.x = xb_xcc_id(); b.st = st;
    if (launder_tid(wv) == 0) (void)xb_add(&bar[XB_XCNT(b.x)], 1u);
    return b;
}
__device__ __forceinline__ void xcd_barrier_complete(unsigned* bar, unsigned x, unsigned& nloc, unsigned& nx) {
    const unsigned G = gridDim.x * gridDim.y * gridDim.z;
    unsigned sum, cnt, mine, sp = 0u;
    for (;;) {
        sum = 0u; cnt = 0u; mine = 0u;
#pragma unroll
        for (unsigned j = 0; j < 16; ++j) { const unsigned c = xb_ld(&bar[XB_XCNT(j)]); sum += c; cnt += (c > 0u) ? 1u : 0u; mine = (j == x) ? c : mine; }
        if (sum == G) break;
        __builtin_amdgcn_s_sleep(1);
        if ((++sp & 255u) == 0u) { if (xb_ld(&bar[XB_TMO])) break; if (sp > XB_SPIN_CAP) { atomicAdd(&bar[XB_TMO], 1u); break; } }
    }
    nloc = mine > 0u ? mine : 1u; nx = cnt > 0u ? cnt : 1u;
}

__device__ __forceinline__ void xcd_barrier(const XcdBarrier& b, int wv) {
    asm volatile("s_waitcnt vmcnt(0)" ::: "memory");
    __syncthreads();
    if (launder_tid(wv) == 0) {
        unsigned* bar = b.bar;
        __builtin_amdgcn_s_waitcnt(0);
        unsigned nloc = b.st[0], nx = b.st[1];
        if (nloc == 0u) { xcd_barrier_complete(bar, b.x, nloc, nx); b.st[0] = nloc; b.st[1] = nx; }
        const unsigned old = xb_add(&bar[XB_XSUB(b.x)], 1u);
        const unsigned gen = old / nloc;
        if (old + 1u == (gen + 1u) * nloc) {
            __builtin_amdgcn_fence(__ATOMIC_RELEASE, "agent");
            asm volatile("s_waitcnt vmcnt(0)" ::: "memory");
            const unsigned og = xb_add(&bar[XB_TOP], 1u);
            const unsigned tg = og / nx;
            if (og + 1u == (tg + 1u) * nx) xb_add(&bar[XB_TOPGEN], 1u);
            else XB_SPIN(xb_ld(&bar[XB_TOPGEN]) == tg, bar);
            __builtin_amdgcn_fence(__ATOMIC_ACQUIRE, "agent");
            xb_add(&bar[XB_XGEN(b.x)], 1u);
            asm volatile("s_waitcnt vmcnt(0)" ::: "memory");
        } else {
            XB_SPIN(xb_ld(&bar[XB_XGEN(b.x)]) == gen, bar);
            __builtin_amdgcn_fence(__ATOMIC_ACQUIRE, "agent");
            asm volatile("s_waitcnt vmcnt(0)" ::: "memory");
        }
    }
    __syncthreads();
}

__global__ void __launch_bounds__(512) mega_fwd(Params P) {
    extern __shared__ __attribute__((aligned(16))) unsigned char lds[];
    cg::grid_group grid = cg::this_grid();
    const int bid = blockIdx.x, nb = gridDim.x; const int wv = __builtin_amdgcn_readfirstlane(threadIdx.x >> 6);
    volatile LAS unsigned* MISC = (volatile LAS unsigned*)((LAS unsigned char*)lds + 131072 + 256);
    if (threadIdx.x < 4) MISC[threadIdx.x] = 0u;
    __syncthreads();
    XcdBarrier xbar;
    { Params Pb = load_params(); xbar = xcd_barrier_post((unsigned*)Pb.ws, MISC, wv); }
#define GSYNC() xcd_barrier(xbar, wv)
    PG8_LAS unsigned char* ldsl = (PG8_LAS unsigned char*)lds;
#pragma unroll 1
    for (int layer_ = 0; layer_ < 2; ++layer_) {
        phase_weights(P, lsd(layer_), lds, bid, nb, wv);
        grid.sync();
#pragma unroll 1
        for (int g_ = 0; g_ < NGRP; ++g_) {
            #define Mpost ((lsd(layer_) == 0 && lsd(g_) == 2) ? TGP : TREAL)
#define NVALID ((lsd(layer_) == 0 && lsd(g_) == 2) ? TG + 128 : TG)
            phase_rmsnorm(P, lsd(g_), lsd(layer_) == 0, I_NMIX, lsd(layer_), TGP, NVALID, bid, nb, wv);
            if (PROBE == 5) { phase_rmsnorm(P, lsd(g_), lsd(layer_) == 0, I_NMIX, lsd(layer_), TGP, NVALID, bid, nb, wv); }
            GSYNC();
            if (PROBE == 6) { for (int q_ = 0; q_ < 15; ++q_) GSYNC(); }
            for (int rep_ = 0; rep_ < (PROBE == 3 ? 2 : 1); ++rep_)
            { Params Pl = load_params(); asm volatile("" : "+s"(Pl.ws)); pg8::bf16_t* W = (pg8::bf16_t*)(Pl.ws + WS_W); pg8::Gemm gm{slotp(Pl, 0), W + WO_IN, TGP, 7680, 1024, 0, 0}; pg8::StaticOrder S; S.init(TGP, 7680, nb, bid);
              pg8::EpiBf<0> E{slotp(Pl, 2), 512, SLOT_E};
              pg8::gemm_phase<pg8::EpiBf<0>, pg8::StaticOrder, true, true>(ldsl, gm, S, E, wv); }
            GSYNC();
            phase_da_prep(P, lsd(layer_), bid, nb, wv);
            phase_hg1(P, lsd(layer_), lds, bid, nb, wv);
            if (PROBE == 4) { phase_hg1(P, lsd(layer_), lds, bid, nb, wv); }
            GSYNC();
            phase_hg2(P, bid, nb, wv);
            GSYNC();
            phase_hg3(P, lsd(layer_), lds, bid, nb, wv);
            GSYNC();
            phase_conv(P, lsd(layer_), bid, nb, wv);
            if (PROBE == 5) { phase_conv(P, lsd(layer_), bid, nb, wv); }
            phase_vtrans(P, lds, bid, nb, wv);
            if (PROBE == 5) { phase_vtrans(P, lds, bid, nb, wv); }
            phase_rw_prep(P, lsd(layer_), bid, nb, wv);
            if (PROBE == 5) { phase_rw_prep(P, lsd(layer_), bid, nb, wv); }
            GSYNC();
            { Params Pl = load_params(); asm volatile("" : "+s"(Pl.ws)); pg8::bf16_t* W = (pg8::bf16_t*)(Pl.ws + WS_W); pg8::Gemm gm{slotp(Pl, 21), W + WO_LR, TGP, 2560, 384, 0, 0}; pg8::StaticOrder S; S.init(TGP, 2560, nb, bid);
              pg8::EpiLR E{slotp(Pl, 22), slotp(Pl, 23), slotp(Pl, 24), slotp(Pl, 13), slotp(Pl, 14), Pl.in[I_W0] + lsd(layer_) * 1024, Pl.in[I_A0] + lsd(layer_) * 1024};
              pg8::gemm_phase<pg8::EpiLR, pg8::StaticOrder, true, true>(ldsl, gm, S, E, wv); }
            phase_attn(P, lsd(layer_), lds, bid, nb, wv);
            if (PROBE == 2) { phase_attn(P, lsd(layer_), lds, bid, nb, wv); }
            GSYNC();
            phase_rwc_pre(P, lsd(layer_), lds, bid, nb, wv);
            if (PROBE == 12) { phase_rwc_pre(P, lsd(layer_), lds, bid, nb, wv); }
            GSYNC();
            phase_rwc_scan(P, lds, bid, nb, wv);
            GSYNC();
            phase_rw_post(P, lsd(layer_), lsd(g_), lsd(layer_) == 0 ? TG : TREAL, bid, nb, wv);
            if (PROBE == 5) { phase_rw_post(P, lsd(layer_), lsd(g_), lsd(layer_) == 0 ? TG : TREAL, bid, nb, wv); }
            GSYNC();
            { Params Pl = load_params(); asm volatile("" : "+s"(Pl.ws)); pg8::bf16_t* W = (pg8::bf16_t*)(Pl.ws + WS_W); pg8::Gemm gm{slotp(Pl, 2), W + WO_BP, Mpost, 4096, 512, 4, SLOT_B}; pg8::StaticOrder S; S.init(Mpost, 4096, nb, bid);
              pg8::EpiBf<0> E{slotp(Pl, 6), 4096, 0};
              pg8::gemm_phase<pg8::EpiBf<0>, pg8::StaticOrder, true, true>(ldsl, gm, S, E, wv); }
            GSYNC();
            { Params Pl = load_params(); asm volatile("" : "+s"(Pl.ws)); pg8::bf16_t* W = (pg8::bf16_t*)(Pl.ws + WS_W); pg8::Gemm gm{slotp(Pl, 0), W + WO_G, Mpost, 4096, 1024, 0, 0}; pg8::StaticOrder S; S.init(Mpost, 4096, nb, bid);
              pg8::EpiGate E{slotp(Pl, 6), slotp(Pl, 14)};
              pg8::gemm_phase<pg8::EpiGate, pg8::StaticOrder, true, true>(ldsl, gm, S, E, wv); }
            GSYNC();
            { Params Pl = load_params(); asm volatile("" : "+s"(Pl.ws)); pg8::bf16_t* W = (pg8::bf16_t*)(Pl.ws + WS_W); pg8::Gemm gm{slotp(Pl, 14), W + WO_OUT, Mpost, 1024, 1024, 0, 0}; pg8::StaticOrder S; S.init(Mpost, 1024, nb, bid);
              pg8::EpiResid E{lsd(layer_) == 0 ? x_in_row(Pl, lsd(g_), 0) : (const float*)x_cur_row(Pl, lsd(g_), 0), lsd(layer_) == 0 ? Pl.in[I_META] : (const float*)nullptr, x_cur_row(Pl, lsd(g_), 0), (float*)(Pl.ws + WS_XMETA), lsd(g_), NVALID};
              pg8::gemm_phase<pg8::EpiResid, pg8::StaticOrder, true, true>(ldsl, gm, S, E, wv); }
            GSYNC();
            phase_rmsnorm(P, lsd(g_), false, I_NMLP, lsd(layer_), Mpost, NVALID, bid, nb, wv);
            if (PROBE == 5) { phase_rmsnorm(P, lsd(g_), false, I_NMLP, lsd(layer_), Mpost, NVALID, bid, nb, wv); }
            GSYNC();
            for (int rep_ = 0; rep_ < (PROBE == 7 ? 2 : 1); ++rep_)
            { Params Pl = load_params(); asm volatile("" : "+s"(Pl.ws)); pg8::bf16_t* W = (pg8::bf16_t*)(Pl.ws + WS_W); pg8::Gemm gm{slotp(Pl, 0), W + WO_1, Mpost, 4096, 1024, 0, 0}; pg8::StaticOrder S; S.init(Mpost, 4096, nb, bid);
              pg8::EpiBf<1> E{slotp(Pl, 6), 4096, 0};
              pg8::gemm_phase<pg8::EpiBf<1>, pg8::StaticOrder, true, true>(ldsl, gm, S, E, wv); }
            GSYNC();
            { Params Pl = load_params(); asm volatile("" : "+s"(Pl.ws)); pg8::bf16_t* W = (pg8::bf16_t*)(Pl.ws + WS_W); pg8::Gemm gm{slotp(Pl, 6), W + WO_2, Mpost, 1024, 4096, 0, 0}; pg8::StaticOrder S; S.init(Mpost, 1024, nb, bid);
              pg8::EpiResid E{(const float*)x_cur_row(Pl, lsd(g_), 0), (const float*)nullptr, x_cur_row(Pl, lsd(g_), 0), (float*)(Pl.ws + WS_XMETA), lsd(g_), NVALID};
              pg8::gemm_phase<pg8::EpiResid, pg8::StaticOrder, true, true>(ldsl, gm, S, E, wv); }
            GSYNC();
        }
    }
}

extern "C" void kernel_launch(void* const* d_in, const int* in_sizes, int n_in, void* d_out, int out_size, void* d_ws, size_t ws_size, hipStream_t stream) {
    static int grid = 0;
    if (grid == 0) {
        if (n_in != 29 || ws_size < WS_NEED) { fprintf(stderr, "kernel_launch: need 29 inputs and %zu bytes of workspace; got %d, %zu\n", (size_t)WS_NEED, n_in, ws_size); grid = -1; return; }
        int dev = 0, cus = 0, per_cu = 0;
        if (hipGetDevice(&dev) != hipSuccess || hipDeviceGetAttribute(&cus, hipDeviceAttributeMultiprocessorCount, dev) != hipSuccess) { grid = -1; return; }
        if (hipFuncSetAttribute((const void*)mega_fwd, hipFuncAttributeMaxDynamicSharedMemorySize, LDS_BYTES) != hipSuccess) { fprintf(stderr, "kernel_launch: hipFuncSetAttribute failed\n"); grid = -1; return; }
        if (hipOccupancyMaxActiveBlocksPerMultiprocessor(&per_cu, (const void*)mega_fwd, 512, LDS_BYTES) != hipSuccess || per_cu < 1) { fprintf(stderr, "kernel_launch: occupancy query says %d\n", per_cu); per_cu = 1; }
        (void)hipGetLastError();
        grid = cus;
    }
    if (grid < 0) return;
    if (hipMemsetAsync(d_ws, 0, 16384, stream) != hipSuccess) { fprintf(stderr, "kernel_launch: memset failed\n"); return; }
    Params p{};
    for (int i = 0; i < 29; ++i) p.in[i] = (const float*)d_in[i];
    p.out = (float*)d_out; p.ws = (unsigned char*)d_ws;
    void* args[] = {&p};
    hipError_t e = hipLaunchCooperativeKernel((const void*)mega_fwd, dim3(grid), dim3(512), args, LDS_BYTES, stream);
    if (e != hipSuccess) fprintf(stderr, "kernel_launch: cooperative launch failed: %s (grid %d)\n", hipGetErrorString(e), grid);
}
```

```cpp
#include <hip/hip_runtime.h>
#include <hip/hip_cooperative_groups.h>
#include <cstdio>
#include <cstdint>
namespace cg = cooperative_groups;
#define PROBE 0
#define DEV __device__ __forceinline__
__device__ __forceinline__ int lsd(int x) { asm volatile("" : "+s"(x)); return x; }
__device__ __forceinline__ int launder_tid(int wv) { int l; asm volatile("v_mbcnt_lo_u32_b32 %0, -1, 0\n\tv_mbcnt_hi_u32_b32 %0, -1, %0" : "=v"(l)); return wv * 64 + l; }
namespace pg8 {
#define PG8_LAS __attribute__((address_space(3)))
typedef unsigned short bf16_t;
typedef short bf16x8 __attribute__((ext_vector_type(8)));
typedef float f32x4 __attribute__((ext_vector_type(4)));
typedef unsigned u32x4 __attribute__((ext_vector_type(4)));
constexpr int BM = 256, BK = 64, HALF = 128, HTB = HALF * BK * 2  , STAGE_BYTES = 8 * HTB, NXCD = 8, WGM = 8;

__host__ __device__ __forceinline__ int lds_byte(int r, int c) { const int st = (r >> 4) * 2 + (c >> 5), rr = r & 15, cc = c & 31, ob = rr * 64 + cc * 2; return st * 1024 + (ob ^ (((ob >> 9) & 1) << 5)); }
__host__ __device__ __forceinline__ void stage_rc(int b, int& R, int& C) { const int st = b / 1024, sb = b % 1024, swz = sb ^ (((sb >> 9) & 1) << 5); R = (st >> 1) * 16 + swz / 64; C = (st & 1) * 32 + (swz % 64) / 2; }
__host__ __device__ __forceinline__ int perm32(int rho) { const int n = rho >> 4, i = rho & 15; return 8 * (i >> 2) + 4 * n + (i & 3); }

struct Unit { int pm, pn; };
struct Gemm { const bf16_t* A; const bf16_t* Bt; int M, N, K; int pn_per_ab; size_t ab_stride; };

struct StaticOrder {
    int nM, nN, nwg, G, c;
    __host__ __device__ void init(int M, int N, int G_, int c_) { nM = M / BM; nN = N / BM; nwg = nM * nN; G = G_; c = c_; }
    __host__ __device__ bool next(int i, Unit& u) const {
        const long L = (long)i * G + c; if (L >= nwg) return false;
        int wgid = (int)L; { const int q = nwg / NXCD, r = nwg % NXCD, xcd = wgid % NXCD, off = wgid / NXCD; wgid = (xcd < r ? xcd * (q + 1) : r * (q + 1) + (xcd - r) * q) + off; }
        const int nig = WGM * nN, gid = wgid / nig, fm = gid * WGM, gsz = (nM - fm) < WGM ? (nM - fm) : WGM;
        u.pm = fm + ((wgid % nig) % gsz); u.pn = (wgid % nig) / gsz; return true;
    }
    __device__ __forceinline__ void a_ready(const Unit&) const {}
    __device__ __forceinline__ void done(const Unit&) const {}
};

typedef float f32x2cv_t __attribute__((ext_vector_type(2))); typedef __bf16 bf16x2cv_t __attribute__((ext_vector_type(2)));
__device__ __forceinline__ unsigned cvt_pk_bf16(float lo, float hi) { const f32x2cv_t v = {lo, hi}; const bf16x2cv_t b = __builtin_convertvector(v, bf16x2cv_t); return __builtin_bit_cast(unsigned, b); }
typedef float f32x2 __attribute__((ext_vector_type(2)));
__device__ __forceinline__ float sigm(float x) { return __builtin_amdgcn_rcpf(1.0f + __expf(-x)); }
template <int ACT  > struct EpiBf {
    static constexpr bool PERM = true, AFTER_DRAIN = false;
    bf16_t* O; int ldc; size_t gstride;
    __device__ __forceinline__ void operator()(const f32x4 (&acc)[2][2][4][2], const Unit& u, int wr, int wc, int fr, int fq) const {
        const int row0 = u.pm * BM + wr * 64 + fr; int colt = u.pn * BM; bf16_t* base = O; int ld = ldc;
        if (gstride) { const int t = colt >> 9; colt &= 511; base += (size_t)t * gstride; ld = 512; }
        const int col0 = colt + wc * 32 + 8 * fq;
#pragma unroll
        for (int ai = 0; ai < 2; ++ai)
#pragma unroll
            for (int m = 0; m < 4; ++m) { bf16_t* rowp = base + (size_t)(row0 + ai * HALF + m * 16) * ld + col0;
#pragma unroll
                for (int bj = 0; bj < 2; ++bj) { f32x4 v0 = acc[ai][bj][m][0], v1 = acc[ai][bj][m][1];
                    if (ACT == 1) {
#pragma unroll
                        for (int i = 0; i < 4; ++i) { float a = fmaxf(v0[i], 0.f), b = fmaxf(v1[i], 0.f); v0[i] = a * a; v1[i] = b * b; } }
                    u32x4 w; w.x = cvt_pk_bf16(v0[0], v0[1]); w.y = cvt_pk_bf16(v0[2], v0[3]); w.z = cvt_pk_bf16(v1[0], v1[1]); w.w = cvt_pk_bf16(v1[2], v1[3]);
                    *(u32x4*)(rowp + bj * HALF) = w; } }
    }
};
struct EpiLR {
    static constexpr bool PERM = true, AFTER_DRAIN = false;
    bf16_t *s0, *s1, *s2, *s3, *s4; const float* w0; const float* a0;
    __device__ __forceinline__ void operator()(const f32x4 (&acc)[2][2][4][2], const Unit& u, int wr, int wc, int fr, int fq) const {
        const int row0 = u.pm * BM + wr * 64 + fr; const int colg = u.pn * BM; const int seg = colg >> 9; const int cb = colg & 511;
        bf16_t* base = seg == 0 ? s0 : seg == 1 ? s1 : seg == 2 ? s2 : seg == 3 ? s3 : s4;
        const int col0 = cb + wc * 32 + 8 * fq;
        const float* bsrc = seg < 2 ? w0 + seg * 512 : a0 + (seg & 1) * 512;
        const float sc = seg < 2 ? 0.6065306597f : 1.0f; const float bm = seg < 4 ? 1.f : 0.f; const bool act = seg < 4;
#pragma unroll
        for (int bj = 0; bj < 2; ++bj) {
            const f32x4 b0 = *(const f32x4*)(bsrc + col0 + bj * HALF) * bm, b1 = *(const f32x4*)(bsrc + col0 + bj * HALF + 4) * bm;
#pragma unroll
            for (int ai = 0; ai < 2; ++ai)
#pragma unroll
                for (int m = 0; m < 4; ++m) { bf16_t* rowp = base + (size_t)(row0 + ai * HALF + m * 16) * 512 + col0;
                    f32x4 v0 = acc[ai][bj][m][0] + b0, v1 = acc[ai][bj][m][1] + b1;
#pragma unroll
                    for (int i = 0; i < 4; ++i) { const float g0 = sc * sigm(v0[i]), g1 = sc * sigm(v1[i]); v0[i] = act ? g0 : v0[i]; v1[i] = act ? g1 : v1[i]; }
                    u32x4 w; w.x = cvt_pk_bf16(v0[0], v0[1]); w.y = cvt_pk_bf16(v0[2], v0[3]); w.z = cvt_pk_bf16(v1[0], v1[1]); w.w = cvt_pk_bf16(v1[2], v1[3]);
                    *(u32x4*)(rowp + bj * HALF) = w; __builtin_amdgcn_sched_barrier(0); }
        }
    }
};
struct EpiGate {
    static constexpr bool PERM = true, AFTER_DRAIN = false;
    const bf16_t* Pm; bf16_t* Mg;
    __device__ __forceinline__ void operator()(const f32x4 (&acc)[2][2][4][2], const Unit& u, int wr, int wc, int fr, int fq) const {
        const int row0 = u.pm * BM + wr * 64 + fr; const int ocol = u.pn * 64 + wc * 16 + fq * 4;
#pragma unroll
        for (int ai = 0; ai < 2; ++ai)
#pragma unroll
            for (int m = 0; m < 4; ++m) { const size_t row = (size_t)(row0 + ai * HALF + m * 16);
                float s0 = 0.f, s1 = 0.f, s2 = 0.f, s3 = 0.f;
#pragma unroll
                for (int bj = 0; bj < 2; ++bj)
#pragma unroll
                    for (int n = 0; n < 2; ++n) { const int br = bj * 2 + n;
                        const uint2 pw = *(const uint2*)(Pm + row * 4096 + br * 1024 + ocol);
                        const f32x4 a = acc[ai][bj][m][n];
                        s0 += sigm(a[0]) * __uint_as_float(pw.x << 16); s1 += sigm(a[1]) * __uint_as_float(pw.x & 0xffff0000u);
                        s2 += sigm(a[2]) * __uint_as_float(pw.y << 16); s3 += sigm(a[3]) * __uint_as_float(pw.y & 0xffff0000u); }
                uint2 o; o.x = cvt_pk_bf16(s0, s1); o.y = cvt_pk_bf16(s2, s3);
                *(uint2*)(Mg + row * 1024 + ocol) = o; }
    }
};
struct EpiResid {
    static constexpr bool PERM = true, AFTER_DRAIN = false;
    const float* om; const float* mt; float* nm; float* xmb; int g; int rlim;
    __device__ __forceinline__ void operator()(const f32x4 (&acc)[2][2][4][2], const Unit& u, int wr, int wc, int fr, int fq) const {
        const int row0 = u.pm * BM + wr * 64 + fr; const int col0 = u.pn * BM + wc * 32 + 8 * fq;
#pragma unroll
        for (int ai = 0; ai < 2; ++ai)
#pragma unroll
            for (int m = 0; m < 4; ++m) { const int r = row0 + ai * HALF + m * 16;
                if (r < rlim) {
                    const int mi = r - 16384;
                    float* dmeta = xmb + (size_t)(mi < 64 ? g * 64 + mi : ((mi >> 6) - 1) * 64 + (mi & 63)) * 1024;
                    const float* src = r < 16384 ? om + (size_t)r * 1024 : (mt ? mt + (size_t)(mi & 15) * 1024 : (const float*)dmeta);
                    float* dst = r < 16384 ? nm + (size_t)r * 1024 : dmeta;
#pragma unroll
                    for (int bj = 0; bj < 2; ++bj)
#pragma unroll
                        for (int n = 0; n < 2; ++n) { const int c = col0 + bj * HALF + 4 * n;
                            const f32x4 xo = *(const f32x4*)(src + c); *(f32x4*)(dst + c) = xo + acc[ai][bj][m][n]; } } }
    }
};
template <class Epi, class Sched, bool ALIGN_EPI = false, bool SP2 = false>
__device__ __forceinline__ void gemm_phase(PG8_LAS unsigned char* lds, const Gemm g, const Sched& S, const Epi& E, int wv) {
    const int tid = launder_tid(wv), wid = __builtin_amdgcn_readfirstlane(tid >> 6), lane = tid & 63, wr = wid >> 2, wc = wid & 3, fr = lane & 15, fq = lane >> 4;
    const int K = g.K, nt = K / BK;
    unsigned voffA[2], voffB[2];
#pragma unroll
    for (int i = 0; i < 2; ++i) { int R, C; stage_rc(tid * 16 + i * 8192, R, C); const int Rb = Epi::PERM ? ((R & ~31) + perm32(R & 31)) : R;
        voffA[i] = (unsigned)(R * K + C) * 2u; voffB[i] = (unsigned)(Rb * K + C) * 2u; }
    const size_t kstep = (size_t)(BK * 2);
    const size_t hstep = (size_t)HALF * K * 2;
    const size_t tstep = 2 * hstep;
    const unsigned ldsw = (unsigned)wid * 1024u;
    const int aoff = lds_byte(wr * 64 + fr, fq * 8), boff = lds_byte(wc * 32 + fr, fq * 8);
#define PG8_SA(b, h) (((b) * 2 + (h)) * HTB)
#define PG8_SB(b, h) ((4 + (b) * 2 + (h)) * HTB)
#define PG8_STAGE(bufoff, gbase, voff) do { _Pragma("unroll") for (int _i = 0; _i < 2; ++_i) \
        __builtin_amdgcn_global_load_lds((const unsigned*)((const char*)(gbase) + (voff)[_i]), (PG8_LAS unsigned*)(lds + (bufoff) + ldsw + _i * 8192), 16, 0, 0); } while (0)
#define PG8_LDA(dst, b, h) do { _Pragma("unroll") for (int m = 0; m < 4; ++m) _Pragma("unroll") for (int k = 0; k < 2; ++k) dst[m][k] = *(const PG8_LAS bf16x8*)(lds + PG8_SA(b, h) + aoff + m * 2048 + k * 1024); } while (0)
#define PG8_LDB(dst, b, h) do { _Pragma("unroll") for (int n = 0; n < 2; ++n) _Pragma("unroll") for (int k = 0; k < 2; ++k) dst[n][k] = *(const PG8_LAS bf16x8*)(lds + PG8_SB(b, h) + boff + n * 2048 + k * 1024); } while (0)
#define PG8_MMA(ai, bj, At, Bt) do { __builtin_amdgcn_s_setprio(1); _Pragma("unroll") for (int m = 0; m < 4; ++m) _Pragma("unroll") for (int n = 0; n < 2; ++n) _Pragma("unroll") for (int k = 0; k < 2; ++k) \
        acc[ai][bj][m][n] = __builtin_amdgcn_mfma_f32_16x16x32_bf16(Bt[n][k], At[m][k], acc[ai][bj][m][n], 0, 0, 0); __builtin_amdgcn_s_setprio(0); } while (0)
#define PG8_WAIT_V(n) asm volatile("s_waitcnt vmcnt(" #n ")" ::: "memory")
#define PG8_WAIT_L(n) asm volatile("s_waitcnt lgkmcnt(" #n ")" ::: "memory")
#define PG8_BAR __builtin_amdgcn_s_barrier()
#define PG8_SCHED __builtin_amdgcn_sched_barrier(0)
    Unit cur, nxt; int ui = 0;
    if (!S.next(0, cur)) return;
    f32x4 acc[2][2][4][2];
#pragma unroll
    for (int a = 0; a < 2; ++a)
#pragma unroll
        for (int b = 0; b < 2; ++b)
#pragma unroll
            for (int m = 0; m < 4; ++m)
#pragma unroll
                for (int n = 0; n < 2; ++n) { float z_ = 0.f; asm volatile("" : "+v"(z_)); acc[a][b][m][n] = (f32x4){z_, z_, z_, z_}; }
    bf16x8 At[4][2], B0[2][2], B1[2][2];
    const char* cA = (const char*)g.A + (g.pn_per_ab ? (size_t)(cur.pn / g.pn_per_ab) * g.ab_stride : (size_t)0) + (size_t)cur.pm * tstep; const char* cB = (const char*)g.Bt + (size_t)cur.pn * tstep;
    S.a_ready(cur);
    if constexpr (SP2) {
        PG8_STAGE(PG8_SB(0, 0), cB, voffB); PG8_STAGE(PG8_SB(0, 1), cB + hstep, voffB); PG8_STAGE(PG8_SA(0, 0), cA, voffA); PG8_STAGE(PG8_SA(0, 1), cA + hstep, voffA);
        if (wr == 1) PG8_BAR;
        PG8_WAIT_V(2); PG8_BAR;
        PG8_STAGE(PG8_SB(1, 0), cB + kstep, voffB); PG8_STAGE(PG8_SA(1, 0), cA + kstep, voffA); PG8_STAGE(PG8_SB(1, 1), cB + hstep + kstep, voffB);
        PG8_WAIT_V(6); PG8_BAR;
    } else {
        PG8_STAGE(PG8_SB(0, 0), cB, voffB); PG8_STAGE(PG8_SA(0, 0), cA, voffA); PG8_STAGE(PG8_SB(0, 1), cB + hstep, voffB); PG8_STAGE(PG8_SA(0, 1), cA + hstep, voffA);
        if (wr == 1) PG8_BAR;
        PG8_WAIT_V(4); PG8_BAR;
        PG8_STAGE(PG8_SB(1, 0), cB + kstep, voffB); PG8_STAGE(PG8_SA(1, 0), cA + kstep, voffA); PG8_STAGE(PG8_SB(1, 1), cB + hstep + kstep, voffB);
        PG8_WAIT_V(6); PG8_BAR;
    }
    for (;;) {
        const bool has_next = S.next(ui + 1, nxt);
        const char* nA = has_next ? (const char*)g.A + (g.pn_per_ab ? (size_t)(nxt.pn / g.pn_per_ab) * g.ab_stride : (size_t)0) + (size_t)nxt.pm * tstep : cA; const char* nB = has_next ? (const char*)g.Bt + (size_t)nxt.pn * tstep : cB;
#pragma unroll 1
        for (int t = 0; t < nt; t += 2) {
            const bool last = (t == nt - 2);
            const char* a1 = cA + (size_t)(t + 1) * kstep;
            const char* a2 = last ? nA : cA + (size_t)(t + 2) * kstep; const char* b2 = last ? nB : cB + (size_t)(t + 2) * kstep;
            const char* a3 = a2 + kstep; const char* b3 = b2 + kstep;
            if (last && has_next) S.a_ready(nxt);
            if constexpr (SP2) {
            PG8_LDB(B0, 0, 0); PG8_LDB(B1, 0, 1); PG8_SCHED; PG8_LDA(At, 0, 0); PG8_STAGE(PG8_SA(1, 1), a1 + hstep, voffA);
            PG8_WAIT_V(8); PG8_WAIT_L(0); PG8_BAR; PG8_MMA(0, 0, At, B0); PG8_MMA(0, 1, At, B1); PG8_BAR; PG8_SCHED;
            PG8_LDA(At, 0, 1); PG8_STAGE(PG8_SB(0, 0), b2, voffB); PG8_STAGE(PG8_SB(0, 1), b2 + hstep, voffB); PG8_STAGE(PG8_SA(0, 0), a2, voffA);
            PG8_WAIT_V(8); PG8_WAIT_L(0); PG8_BAR; PG8_MMA(1, 0, At, B0); PG8_MMA(1, 1, At, B1); PG8_BAR; PG8_SCHED;
            PG8_LDB(B0, 1, 0); PG8_LDB(B1, 1, 1); PG8_SCHED; PG8_LDA(At, 1, 0); PG8_STAGE(PG8_SA(0, 1), a2 + hstep, voffA);
            PG8_WAIT_V(8); PG8_WAIT_L(0); PG8_BAR; PG8_MMA(0, 0, At, B0); PG8_MMA(0, 1, At, B1); PG8_BAR; PG8_SCHED;
            PG8_LDA(At, 1, 1); PG8_STAGE(PG8_SB(1, 0), b3, voffB); PG8_STAGE(PG8_SB(1, 1), b3 + hstep, voffB); PG8_STAGE(PG8_SA(1, 0), a3, voffA);
            PG8_WAIT_V(8); PG8_WAIT_L(0); PG8_BAR; PG8_MMA(1, 0, At, B0); PG8_MMA(1, 1, At, B1); PG8_BAR; PG8_SCHED;
            } else {
            PG8_LDB(B0, 0, 0); PG8_SCHED; PG8_LDA(At, 0, 0); PG8_STAGE(PG8_SA(1, 1), a1 + hstep, voffA);
            PG8_WAIT_L(8); PG8_BAR; PG8_WAIT_L(0); PG8_MMA(0, 0, At, B0); PG8_BAR; PG8_SCHED;
            PG8_LDB(B1, 0, 1); PG8_STAGE(PG8_SB(0, 0), b2, voffB);
            PG8_BAR; PG8_WAIT_L(0); PG8_MMA(0, 1, At, B1); PG8_BAR;
            PG8_LDA(At, 0, 1); PG8_STAGE(PG8_SA(0, 0), a2, voffA);
            PG8_BAR; PG8_WAIT_L(0); PG8_MMA(1, 0, At, B0); PG8_BAR; PG8_SCHED;
            PG8_STAGE(PG8_SB(0, 1), b2 + hstep, voffB);
            PG8_WAIT_V(6); PG8_BAR; PG8_MMA(1, 1, At, B1); PG8_BAR;
            PG8_LDB(B0, 1, 0); PG8_SCHED; PG8_LDA(At, 1, 0); PG8_STAGE(PG8_SA(0, 1), a2 + hstep, voffA);
            PG8_WAIT_L(8); PG8_BAR; PG8_WAIT_L(0); PG8_MMA(0, 0, At, B0); PG8_BAR; PG8_SCHED;
            PG8_LDB(B1, 1, 1); PG8_STAGE(PG8_SB(1, 0), b3, voffB);
            PG8_BAR; PG8_WAIT_L(0); PG8_MMA(0, 1, At, B1); PG8_BAR;
            PG8_LDA(At, 1, 1); PG8_STAGE(PG8_SA(1, 0), a3, voffA);
            PG8_BAR; PG8_WAIT_L(0); PG8_MMA(1, 0, At, B0); PG8_BAR; PG8_SCHED;
            PG8_STAGE(PG8_SB(1, 1), b3 + hstep, voffB);
            PG8_WAIT_V(6); PG8_BAR; PG8_MMA(1, 1, At, B1); PG8_BAR;
            }
        }
        if constexpr (ALIGN_EPI) { if (wr == 0) PG8_BAR; }
        if constexpr (!Epi::AFTER_DRAIN) { E(acc, cur, wr, wc, fr, fq); S.done(cur); }
        if (!has_next) break;
#pragma unroll
        for (int a = 0; a < 2; ++a)
#pragma unroll
            for (int b = 0; b < 2; ++b)
#pragma unroll
                for (int m = 0; m < 4; ++m)
#pragma unroll
                    for (int n = 0; n < 2; ++n) { float z_ = 0.f; asm volatile("" : "+v"(z_)); acc[a][b][m][n] = (f32x4){z_, z_, z_, z_}; }
        cur = nxt; cA = nA; cB = nB; ++ui;
        if constexpr (ALIGN_EPI) { if (wr == 1) PG8_BAR; }
    }
    PG8_WAIT_V(0);
    if constexpr (!ALIGN_EPI) { if (wr == 0) PG8_BAR; }
    PG8_BAR;
    if constexpr (Epi::AFTER_DRAIN) { E.fused(acc, cur, wr, wc, fr, fq, lds, wid, lane); S.done(cur); }
#undef PG8_SA
#undef PG8_SB
#undef PG8_STAGE
#undef PG8_LDA
#undef PG8_LDB
#undef PG8_MMA
#undef PG8_WAIT_V
#undef PG8_WAIT_L
#undef PG8_BAR
#undef PG8_SCHED
}
}
typedef unsigned short bf16_t;
typedef short bf16x8 __attribute__((ext_vector_type(8)));
typedef float f32x4 __attribute__((ext_vector_type(4)));
typedef float f32x16 __attribute__((ext_vector_type(16)));
constexpr int LSEQ = 4112, TREAL = 16384, TG = 16448, TGP = 16640, NGRP = 3;
constexpr size_t SLOT_E = (size_t)TGP * 512;
constexpr size_t SLOT_B = SLOT_E * 2;
constexpr size_t MiB = 1u << 20;
constexpr size_t WS_XMETA = 1 * MiB, WS_DECAY = 2 * MiB, WS_SIDE = 3 * MiB + 512 * 1024, WS_W = 5 * MiB, WS_SLOTS = 53 * MiB;
constexpr size_t WS_NEED = 512 * MiB;
static_assert(WS_SLOTS + 25 * SLOT_B + (size_t)(16448 - 11408) * 8960 <= 512 * MiB, "record tail fits the workspace");
constexpr size_t WO_IN = 0, WO_G = 7864320, WO_BP = 12058624, WO_OUT = 14155776, WO_1 = 15204352, WO_2 = 19398656, WO_LR = 23592960;
constexpr int LDS_BYTES = 140 * 1024;
enum { I_XP = 0, I_XS, I_META, I_NMIX, I_WIN, I_LBL, I_ONORM, I_CONV, I_QN, I_KN, I_LAM, I_SUBLN, I_MU, I_W0, I_W2, I_A0, I_A2, I_G2, I_KK, I_KA, I_RK, I_LNG, I_LNB, I_WG, I_BP, I_WOUT, I_NMLP, I_W1, I_W2M };
struct Params { const float* in[29]; float* out; unsigned char* ws; };
typedef const __attribute__((address_space(4))) Params* KParamsPtr;
DEV KParamsPtr kparams() { KParamsPtr p = (KParamsPtr)__builtin_amdgcn_kernarg_segment_ptr(); asm volatile("" : "+s"(p)); return p; }
DEV Params load_params() { KParamsPtr p = kparams(); Params r;
#pragma unroll
    for (int i = 0; i < 29; ++i) r.in[i] = p->in[i];
    r.out = p->out; r.ws = p->ws; return r; }
DEV unsigned zero_u() { unsigned z = 0u; asm volatile("" : "+v"(z)); return z; }

#define ROWPRO const int tid_ = launder_tid(wv); const int lane = tid_ & 63; const int gw = bid * 8 + __builtin_amdgcn_readfirstlane(tid_ >> 6); const int ngw = nb * 8;
DEV float bf2f(unsigned short u) { return __uint_as_float((unsigned)u << 16); }
DEV unsigned pk2(float lo, float hi) { return pg8::cvt_pk_bf16(lo, hi); }
DEV void unpack8(const uint4 w, float* f) {
    f[0] = __uint_as_float(w.x << 16); f[1] = __uint_as_float(w.x & 0xffff0000u); f[2] = __uint_as_float(w.y << 16); f[3] = __uint_as_float(w.y & 0xffff0000u);
    f[4] = __uint_as_float(w.z << 16); f[5] = __uint_as_float(w.z & 0xffff0000u); f[6] = __uint_as_float(w.w << 16); f[7] = __uint_as_float(w.w & 0xffff0000u); }
DEV uint4 pack8(const float* f) { uint4 o; o.x = pk2(f[0], f[1]); o.y = pk2(f[2], f[3]); o.z = pk2(f[4], f[5]); o.w = pk2(f[6], f[7]); return o; }
DEV bf16_t* slotp(const Params& P, int s) { return (bf16_t*)(P.ws + WS_SLOTS + (size_t)s * SLOT_B); }
DEV int row_of(int sl, int p) { return p >= 16 ? sl * 4096 + p - 16 : TREAL + sl * 16 + p; }
DEV void pos_of(int r, int& sl, int& p) { if (r < TREAL) { sl = r >> 12; p = (r & 4095) + 16; } else { const int m = r - TREAL; sl = m >> 4; p = m & 15; } }
DEV float wave_sum(float v) {
#pragma unroll
    for (int o = 1; o < 64; o <<= 1) v += __shfl_xor(v, o);
    return v; }
DEV float red8(float v) { v += __shfl_xor(v, 1); v += __shfl_xor(v, 2); v += __shfl_xor(v, 4); return v; }
DEV f32x4 mfma16(bf16x8 a, bf16x8 b, f32x4 c) { return __builtin_amdgcn_mfma_f32_16x16x32_bf16(a, b, c, 0, 0, 0); }
DEV f32x16 mfma32(bf16x8 a, bf16x8 b, f32x16 c) { return __builtin_amdgcn_mfma_f32_32x32x16_bf16(a, b, c, 0, 0, 0); }
DEV const float* x_in_row(const Params& P, int g, int r) {
    if (r < TREAL) return (g < 2 ? P.in[I_XP] + (size_t)g * TREAL * 1024 : P.in[I_XS]) + (size_t)r * 1024;
    return P.in[I_META] + (size_t)((r - TREAL) & 15) * 1024; }
DEV float* x_cur_row(const Params& P, int g, int r) {
    if (r < TREAL) return P.out + ((size_t)g * TREAL + r) * 1024;
    const int m = r - TREAL;
    return (float*)(P.ws + WS_XMETA) + (size_t)(m < 64 ? g * 64 + m : ((m >> 6) - 1) * 64 + (m & 63)) * 1024; }

DEV int gate_row(int n) { const int br = n >> 10, c = n & 1023, pn = c >> 6, oc = c & 63, wc = oc >> 4, fq = (oc >> 2) & 3, i = oc & 3; return pn * 256 + (br >> 1) * 128 + wc * 32 + fq * 8 + (br & 1) * 4 + i; }
template <int MODE> DEV void wt_items(const float* __restrict__ W, int K, int N, bf16_t* WT, int row_off, float* scr, int gw, int ngw, int lane) {
    const int nblk = N >> 5, items = (K >> 6) * nblk;
    for (int it = gw; it < items; it += ngw) {
        const int kb = it / nblk, nbk = it - kb * nblk, k0 = 64 * kb, n0 = 32 * nbk;
#pragma unroll 8
        for (int i = 0; i < 32; ++i) { const int kk = 2 * i + (lane >> 5); scr[kk * 33 + (lane & 31)] = W[(size_t)(k0 + kk) * N + n0 + (lane & 31)]; }
        asm volatile("s_waitcnt lgkmcnt(0)" ::: "memory");
        const int c = lane & 7;
#pragma unroll
        for (int j = 0; j < 4; ++j) { const int n = (lane >> 3) + 8 * j; const float* sp = scr + (8 * c) * 33 + n;
            uint4 o; o.x = pk2(sp[0 * 33], sp[1 * 33]); o.y = pk2(sp[2 * 33], sp[3 * 33]); o.z = pk2(sp[4 * 33], sp[5 * 33]); o.w = pk2(sp[6 * 33], sp[7 * 33]);
            const int dr = MODE == 1 ? gate_row(n0 + n) : n0 + n + row_off;
            *(uint4*)(WT + (size_t)dr * K + k0 + 8 * c) = o; }
        asm volatile("s_waitcnt lgkmcnt(0)" ::: "memory");
    }
}
DEV void phase_weights(const Params& P0, int layer, unsigned char* lds, int bid, int nb, int wv) {
    Params P = load_params(); asm volatile("" : "+s"(P.ws));
    const int tid = launder_tid(wv), lane = tid & 63, w = __builtin_amdgcn_readfirstlane(tid >> 6);
    const int gtid = bid * 512 + tid, gth = nb * 512, gw = bid * 8 + w, ngw = nb * 8;
    float* scr = (float*)(lds + w * 8448);
    bf16_t* W = (bf16_t*)(P.ws + WS_W);
    wt_items<0>(P.in[I_WIN] + (size_t)layer * 1024 * 7552, 1024, 7552, W + WO_IN, 0, scr, gw, ngw, lane);
    for (int it = gtid; it < 128 * 128; it += gth) { const unsigned z = zero_u(); *(uint4*)(W + WO_IN + (size_t)7552 * 1024 + (size_t)it * 8) = make_uint4(z, z, z, z); }
    wt_items<1>(P.in[I_WG] + (size_t)layer * 1024 * 4096, 1024, 4096, W + WO_G, 0, scr, gw, ngw, lane);
    for (int n = 0; n < 4; ++n) wt_items<0>(P.in[I_BP] + (size_t)(layer * 4 + n) * 512 * 1024, 512, 1024, W + WO_BP, n * 1024, scr, gw, ngw, lane);
    wt_items<0>(P.in[I_WOUT] + (size_t)layer * 1024 * 1024, 1024, 1024, W + WO_OUT, 0, scr, gw, ngw, lane);
    wt_items<0>(P.in[I_W1] + (size_t)layer * 1024 * 4096, 1024, 4096, W + WO_1, 0, scr, gw, ngw, lane);
    wt_items<0>(P.in[I_W2M] + (size_t)layer * 4096 * 1024, 4096, 1024, W + WO_2, 0, scr, gw, ngw, lane);
    for (int it = gtid; it < 2560 * 48; it += gth) {
        const int row = it / 48, k8 = it - row * 48, seg = row >> 9, c = row & 511, k0 = k8 * 8;
        float v[8];
#pragma unroll
        for (int j = 0; j < 8; ++j) { const int k = k0 + j; float x = 0.f;
            if (seg == 0) { if (k < 64) x = P.in[I_W2][((size_t)(layer * 2 + 0) * 64 + k) * 512 + c]; }
            else if (seg == 1) { if (k >= 64 && k < 128) x = P.in[I_W2][((size_t)(layer * 2 + 1) * 64 + (k - 64)) * 512 + c]; }
            else if (seg == 2) { if (k >= 128 && k < 192) x = P.in[I_A2][((size_t)(layer * 2 + 0) * 64 + (k - 128)) * 512 + c]; }
            else if (seg == 3) { if (k >= 192 && k < 256) x = P.in[I_A2][((size_t)(layer * 2 + 1) * 64 + (k - 192)) * 512 + c]; }
            else { if (k >= 256) x = P.in[I_G2][((size_t)layer * 128 + (k - 256)) * 512 + c]; }
            v[j] = x; }
        *(uint4*)(W + WO_LR + (size_t)row * 384 + k0) = pack8(v);
    }
}

DEV void phase_rmsnorm(const Params& P0, int g, bool src_in, int gain_idx, int layer, int nrows, int nvalid, int bid, int nb, int wv) {
    Params P = load_params(); asm volatile("" : "+s"(P.ws));
    ROWPRO
    const float* gain = P.in[gain_idx] + layer * 1024;
    bf16_t* H = slotp(P, 0);
    for (int r = gw; r < nrows; r += ngw) {
        uint2* o8 = (uint2*)(H + (size_t)r * 1024) + lane;
        if (r >= nvalid) {
#pragma unroll
            for (int j = 0; j < 4; ++j) { const unsigned z = zero_u(); o8[64 * j] = make_uint2(z, z); }
            continue; }
        const f32x4* xr = (const f32x4*)(src_in ? x_in_row(P, g, r) : (const float*)x_cur_row(P, g, r)) + lane;
        f32x4 v[4]; float s = 0.f;
#pragma unroll
        for (int j = 0; j < 4; ++j) { v[j] = xr[64 * j]; s += (v[j].x * v[j].x + v[j].y * v[j].y) + (v[j].z * v[j].z + v[j].w * v[j].w); }
        const float rs = rsqrtf(wave_sum(s) * (1.f / 1024.f) + 1e-6f);
#pragma unroll
        for (int j = 0; j < 4; ++j) { const f32x4 gg = *((const f32x4*)gain + lane + 64 * j);
            o8[64 * j] = make_uint2(pk2(v[j].x * rs * gg.x, v[j].y * rs * gg.y), pk2(v[j].z * rs * gg.z, v[j].w * rs * gg.w)); }
    }
}
DEV void phase_da_prep(const Params& P0, int layer, int bid, int nb, int wv) {
    Params P = load_params(); asm volatile("" : "+s"(P.ws));
    ROWPRO
    const float inv8[8] = {1.0f, 0.19392274474868576f, 0.03760603093086393f, 0.007292664737217109f, 0.001414213562373095f, 0.0002742481756762073f, 5.318295896944988e-05f, 1.031338537721246e-05f};
    const int d0 = (lane & 7) * 8;
    float gq[8], gk[8];
#pragma unroll
    for (int j = 0; j < 8; ++j) { gq[j] = P.in[I_QN][layer * 64 + d0 + j]; gk[j] = P.in[I_KN][layer * 64 + d0 + j]; }
    for (int r = gw; r < TG; r += ngw) {
        int sl, p; pos_of(r, sl, p);
        float cs[8], sn[8];
#pragma unroll
        for (int j = 0; j < 8; ++j) { const float ang = (float)p * inv8[j]; double a = (double)ang; a -= 6.283185307179586 * __builtin_rint(a * 0.15915494309189535); const float rr = (float)a; cs[j] = __cosf(rr); sn[j] = __sinf(rr); }
#pragma unroll
        for (int which = 0; which < 2; ++which) {
            uint4* ptr = (uint4*)(slotp(P, 10 + which) + (size_t)r * 512) + lane;
            float f[8]; unpack8(*ptr, f);
            float ss = 0.f;
#pragma unroll
            for (int j = 0; j < 8; ++j) ss += f[j] * f[j];
            ss = red8(ss);
            const float rs = rsqrtf(ss * (1.f / 64.f) + 1e-6f);
#pragma unroll
            for (int j = 0; j < 8; ++j) f[j] = f[j] * rs * (which == 0 ? gq[j] : gk[j]);
#pragma unroll
            for (int j = 0; j < 8; ++j) { const float pr = __shfl_xor(f[j], 1);
                if ((lane & 7) == 0) f[j] = f[j] * cs[j] - pr * sn[j];
                else if ((lane & 7) == 1) f[j] = f[j] * cs[j] + pr * sn[j]; }
            if (which == 0) {
#pragma unroll
                for (int j = 0; j < 8; ++j) f[j] *= 0.18033688011112042f; }
            *ptr = pack8(f);
        }
    }
}
DEV void phase_conv(const Params& P0, int layer, int bid, int nb, int wv) {
    Params P = load_params(); asm volatile("" : "+s"(P.ws));
    ROWPRO
    const int c0 = lane * 8;
    float w0[8], w1[8], w2[8];
#pragma unroll
    for (int j = 0; j < 8; ++j) { w0[j] = P.in[I_CONV][(layer * 3 + 0) * 512 + c0 + j]; w1[j] = P.in[I_CONV][(layer * 3 + 1) * 512 + c0 + j]; w2[j] = P.in[I_CONV][(layer * 3 + 2) * 512 + c0 + j]; }
    const bf16_t* SB = slotp(P, 7); const bf16_t* SC = slotp(P, 8); const bf16_t* SH = slotp(P, 9); bf16_t* Y = slotp(P, 3);
    for (int r = gw; r < TG; r += ngw) {
        int sl, p; pos_of(r, sl, p);
        float acc[8], a[8], b[8];
        unpack8(*((const uint4*)(SC + (size_t)r * 512) + lane), a); unpack8(*((const uint4*)(SH + (size_t)r * 512) + lane), b);
#pragma unroll
        for (int j = 0; j < 8; ++j) acc[j] = a[j] * b[j] * w1[j];
        if (p > 0) { const int rp = row_of(sl, p - 1);
            unpack8(*((const uint4*)(SC + (size_t)rp * 512) + lane), a); unpack8(*((const uint4*)(SH + (size_t)rp * 512) + lane), b);
#pragma unroll
            for (int j = 0; j < 8; ++j) acc[j] += a[j] * b[j] * w0[j]; }
        if (p < LSEQ - 1) { const int rn = row_of(sl, p + 1);
            unpack8(*((const uint4*)(SC + (size_t)rn * 512) + lane), a); unpack8(*((const uint4*)(SH + (size_t)rn * 512) + lane), b);
#pragma unroll
            for (int j = 0; j < 8; ++j) acc[j] += a[j] * b[j] * w2[j]; }
        unpack8(*((const uint4*)(SB + (size_t)r * 512) + lane), a);
#pragma unroll
        for (int j = 0; j < 8; ++j) acc[j] *= a[j];
        *((uint4*)(Y + (size_t)r * 512) + lane) = pack8(acc);
    }
}
DEV void phase_rw_prep(const Params& P0, int layer, int bid, int nb, int wv) {
    Params P = load_params(); asm volatile("" : "+s"(P.ws));
    ROWPRO
    const float* mu = P.in[I_MU] + (size_t)layer * 1920;
    for (int r = gw; r < TG; r += ngw) {
        int sl, p; pos_of(r, sl, p);
        const int rp = p > 0 ? row_of(sl, p - 1) : -1, rn = p < LSEQ - 1 ? row_of(sl, p + 1) : -1;
#pragma unroll
        for (int grp = 0; grp < 4; ++grp) {
            if (grp == 3 && lane >= 48) break;
            const int c0 = (grp < 3 ? grp * 512 : 1536) + lane * 8;
            const bf16_t* src = slotp(P, 13 + (c0 >> 9)) + (c0 & 511);
            float u[8], up[8], un[8], xm[8];
            unpack8(*(const uint4*)(src + (size_t)r * 512), u);
            if (rp >= 0) unpack8(*(const uint4*)(src + (size_t)rp * 512), up); else {
#pragma unroll
                for (int j = 0; j < 8; ++j) up[j] = 0.f; }
            if (rn >= 0) unpack8(*(const uint4*)(src + (size_t)rn * 512), un); else {
#pragma unroll
                for (int j = 0; j < 8; ++j) un[j] = 0.f; }
#pragma unroll
            for (int j = 0; j < 8; ++j) xm[j] = u[j] + mu[c0 + j] * (0.5f * (up[j] + un[j]) - u[j]);
            if (grp < 3) {
                *((uint4*)(slotp(P, 17 + grp) + (size_t)r * 512) + lane) = pack8(xm);
                if (grp == 1) {
                    float kk[8], ss = 0.f;
#pragma unroll
                    for (int j = 0; j < 8; ++j) { kk[j] = xm[j] * P.in[I_KK][layer * 512 + c0 - 512 + j]; ss += kk[j] * kk[j]; }
                    ss = red8(ss);
                    const float inv = 1.0f / fmaxf(sqrtf(ss), 1e-12f);
#pragma unroll
                    for (int j = 0; j < 8; ++j) kk[j] *= inv;
                    *((uint4*)(slotp(P, 20) + (size_t)r * 512) + lane) = pack8(kk); }
            } else {
                const int a0 = lane * 8;
                float o[8];
#pragma unroll
                for (int j = 0; j < 8; ++j) { const float x = xm[j];
                    if (a0 < 128) { const float e = __expf(2.f * x); o[j] = 1.f - 2.f / (e + 1.f); }
                    else if (a0 < 256) o[j] = x;
                    else o[j] = 1.f / (1.f + __expf(-x)); }
                *((uint4*)(slotp(P, 21) + (size_t)r * 384) + lane) = pack8(o);
            }
        }
    }
    for (int r = TG + gw; r < TGP; r += ngw) if (lane < 48) { const unsigned z = zero_u(); *((uint4*)(slotp(P, 21) + (size_t)r * 384) + lane) = make_uint4(z, z, z, z); }
}
DEV void phase_rw_post(const Params& P0, int layer, int g, int nrows, int bid, int nb, int wv) {
    Params P = load_params(); asm volatile("" : "+s"(P.ws));
    ROWPRO
    const int c0 = lane * 8;
    float ka[8], rk[8], lg[8], lb[8];
#pragma unroll
    for (int j = 0; j < 8; ++j) { ka[j] = P.in[I_KA][layer * 512 + c0 + j]; rk[j] = P.in[I_RK][layer * 512 + c0 + j]; lg[j] = P.in[I_LNG][layer * 512 + c0 + j]; lb[j] = P.in[I_LNB][layer * 512 + c0 + j]; }
    for (int r = gw; r < nrows; r += ngw) {
        float of[8], ob[8], o[8];
        unpack8(*((const uint4*)(slotp(P, 15) + (size_t)r * 512) + lane), of); unpack8(*((const uint4*)(slotp(P, 16) + (size_t)r * 512) + lane), ob);
        float s = 0.f;
#pragma unroll
        for (int j = 0; j < 8; ++j) { o[j] = of[j] + ob[j]; s += o[j]; }
        const float mean = red8(s) * (1.f / 64.f);
        float q = 0.f;
#pragma unroll
        for (int j = 0; j < 8; ++j) { o[j] -= mean; q += o[j] * o[j]; }
        const float rs = rsqrtf(red8(q) * (1.f / 64.f) + 64e-5f);
        float rr[8], kk[8], vv[8], af[8], ab[8], gg[8];
        unpack8(*((const uint4*)(slotp(P, 17) + (size_t)r * 512) + lane), rr); unpack8(*((const uint4*)(slotp(P, 18) + (size_t)r * 512) + lane), kk);
        unpack8(*((const uint4*)(slotp(P, 19) + (size_t)r * 512) + lane), vv); unpack8(*((const uint4*)(slotp(P, 24) + (size_t)r * 512) + lane), af);
        unpack8(*((const uint4*)(slotp(P, 13) + (size_t)r * 512) + lane), ab); unpack8(*((const uint4*)(slotp(P, 14) + (size_t)r * 512) + lane), gg);
        float bs = 0.f;
#pragma unroll
        for (int j = 0; j < 8; ++j) { const float kd = kk[j] * (2.f + (af[j] + ab[j] - 2.f) * ka[j]); bs += rr[j] * kd * rk[j]; }
        bs = red8(bs);
        float y[8];
#pragma unroll
        for (int j = 0; j < 8; ++j) y[j] = (o[j] * rs * lg[j] + lb[j] + bs * vv[j]) * gg[j];
        const uint4 yv = pack8(y);
        *((uint4*)(slotp(P, 5) + (size_t)r * 512) + lane) = yv;
        if (layer == 0 && g < 2 && r >= TREAL) {
            bf16_t* sd = (bf16_t*)(P.ws + WS_SIDE) + (size_t)g * 4 * 64 * 512 + (size_t)(r - TREAL) * 512;
#pragma unroll
            for (int k = 0; k < 3; ++k) *((uint4*)(sd + (size_t)k * 64 * 512) + lane) = *((const uint4*)(slotp(P, 2 + k) + (size_t)r * 512) + lane);
            *((uint4*)(sd + (size_t)3 * 64 * 512) + lane) = yv; }
    }
    if (layer == 0 && g == 2) {
        for (int m2 = gw; m2 < 128; m2 += ngw) { const bf16_t* sd = (const bf16_t*)(P.ws + WS_SIDE) + (size_t)(m2 >> 6) * 4 * 64 * 512 + (size_t)(m2 & 63) * 512;
#pragma unroll
            for (int k = 0; k < 4; ++k) *((uint4*)(slotp(P, 2 + k) + (size_t)(TG + m2) * 512) + lane) = *((const uint4*)(sd + (size_t)k * 64 * 512) + lane); }
    }
}
DEV void hg_gate(float x, float lbv, float& lg, float& kk) {
    const float e = __expf(-fabsf(x)); const float sp = 1.f / (1.f + e);
    const float s = x >= 0.f ? sp : e * sp, s1 = x >= 0.f ? e * sp : sp;
    const float f = fmaxf(lbv, 1e-20f) + (1.f - lbv) * s;
    lg = __logf(f); kk = (1.f - lbv) * s1; }
DEV float hg_lb(const Params& P, int layer, int dir, int col) {
    if (layer == 0) return 0.f;
    const float a = P.in[I_LBL][(dir * 2 + 0) * 512 + col], b = P.in[I_LBL][(dir * 2 + 1) * 512 + col];
    return 1.f / (1.f + __expf(a - b)); }
DEV int hg_row(int sl, int c, int j, bool& valid) { if (c == 0) { valid = j < 16; return TREAL + sl * 16 + j; } valid = true; return sl * 4096 + (c - 1) * 64 + j; }
DEV void hg_cumsum(float* Lb, float* Bt, float* Seg, int dir, int tid) {
    const int ch = tid & 127, seg = tid >> 7;
    float v[16];
#pragma unroll
    for (int i = 0; i < 16; ++i) v[i] = Lb[(seg * 16 + i) * 128 + ch];
    if (dir == 0) {
#pragma unroll
        for (int i = 1; i < 16; ++i) v[i] += v[i - 1];
        Seg[seg * 128 + ch] = v[15];
    } else {
#pragma unroll
        for (int i = 14; i >= 0; --i) v[i] += v[i + 1];
        Seg[seg * 128 + ch] = v[0];
    }
    __syncthreads();
    const float s0 = Seg[ch], s1 = Seg[128 + ch], s2 = Seg[256 + ch], s3 = Seg[384 + ch];
    float off;
    if (dir == 0) off = seg == 0 ? 0.f : seg == 1 ? s0 : seg == 2 ? s0 + s1 : s0 + s1 + s2;
    else off = seg == 3 ? 0.f : seg == 2 ? s3 : seg == 1 ? s3 + s2 : s3 + s2 + s1;
#pragma unroll
    for (int i = 0; i < 16; ++i) Lb[(seg * 16 + i) * 128 + ch] = v[i] + off;
    if (seg == 0) Bt[ch] = (s0 + s1) + (s2 + s3);
}
DEV void phase_hg1(const Params& P0, int layer, unsigned char* lds, int bid, int nb, int wv) {
    Params P = load_params(); asm volatile("" : "+s"(P.ws));
    float* Lb = (float*)lds; bf16_t* KlT = (bf16_t*)(lds + 32768); bf16_t* VT = (bf16_t*)(lds + 32768 + 18432); float* Bt = (float*)(lds + 69632); float* Seg = (float*)(lds + 70656);
    float* X = (float*)slotp(P, 17); float* DC = (float*)(P.ws + WS_DECAY);
    const int tid = launder_tid(wv), lane = tid & 63, w = __builtin_amdgcn_readfirstlane(tid >> 6), j = tid >> 3, c0 = (tid & 7) * 16, l15 = lane & 15, quad = lane >> 4;
    for (int unit = bid; unit < 32 * 65; unit += nb) {
        const int chain = unit / 65, c = unit - chain * 65, sl = chain >> 3, head = (chain >> 1) & 3, dir = chain & 1;
        bool valid; const int r = hg_row(sl, c, j, valid);
        float lg[16], kk[16]; uint4 vv[2] = {make_uint4(0, 0, 0, 0), make_uint4(0, 0, 0, 0)};
        if (valid) {
            float fr[16];
            const uint4* fp = (const uint4*)(slotp(P, 3 + dir) + (size_t)r * 512 + head * 128 + c0);
            unpack8(fp[0], fr); unpack8(fp[1], fr + 8);
            const uint4* vp = (const uint4*)(slotp(P, 5) + (size_t)r * 512 + head * 128 + c0); vv[0] = vp[0]; vv[1] = vp[1];
#pragma unroll
            for (int e = 0; e < 16; ++e) hg_gate(fr[e], hg_lb(P, layer, dir, head * 128 + c0 + e), lg[e], kk[e]);
        } else {
#pragma unroll
            for (int e = 0; e < 16; ++e) { lg[e] = 0.f; kk[e] = 0.f; } }
#pragma unroll
        for (int e = 0; e < 16; e += 4) *(f32x4*)(Lb + j * 128 + c0 + e) = (f32x4){lg[e], lg[e + 1], lg[e + 2], lg[e + 3]};
        __syncthreads();
        hg_cumsum(Lb, Bt, Seg, dir, tid);
        __syncthreads();
        float vf[16]; unpack8(vv[0], vf); unpack8(vv[1], vf + 8);
#pragma unroll
        for (int e = 0; e < 16; ++e) { const float kl = kk[e] * __expf(Bt[c0 + e] - Lb[j * 128 + c0 + e]);
            KlT[(c0 + e) * 72 + j] = (bf16_t)(pk2(kl, 0.f) & 0xffffu); VT[(c0 + e) * 72 + j] = (bf16_t)(__float_as_uint(vf[e]) >> 16); }
        if (tid < 128) DC[(size_t)(chain * 65 + c) * 128 + tid] = __expf(Bt[tid]);
        __syncthreads();
        f32x4 acc[8];
#pragma unroll
        for (int ct = 0; ct < 8; ++ct) acc[ct] = (f32x4){0.f, 0.f, 0.f, 0.f};
#pragma unroll
        for (int ks = 0; ks < 2; ++ks) { const bf16x8 a = *(const bf16x8*)(VT + (w * 16 + l15) * 72 + ks * 32 + quad * 8);
#pragma unroll
            for (int ct = 0; ct < 8; ++ct) { const bf16x8 b = *(const bf16x8*)(KlT + (ct * 16 + l15) * 72 + ks * 32 + quad * 8); acc[ct] = mfma16(a, b, acc[ct]); } }
        float* xo = X + (size_t)(chain * 65 + c) * 16384;
#pragma unroll
        for (int ct = 0; ct < 8; ++ct)
#pragma unroll
            for (int jj = 0; jj < 4; ++jj) xo[(w * 16 + quad * 4 + jj) * 128 + ct * 16 + l15] = acc[ct][jj];
        __syncthreads();
    }
}
DEV void phase_hg2(const Params& P0, int bid, int nb, int wv) {
    Params P = load_params(); asm volatile("" : "+s"(P.ws));
    const int gtid = bid * 512 + launder_tid(wv), gth = nb * 512;
    f32x4* X = (f32x4*)slotp(P, 17); const f32x4* DC = (const f32x4*)(P.ws + WS_DECAY);
    for (int e = gtid; e < 32 * 4096; e += gth) {
        const int chain = e >> 12, e4 = e & 4095, dir = chain & 1;
        f32x4 S = (f32x4){0.f, 0.f, 0.f, 0.f};
#pragma unroll 5
        for (int step = 0; step < 65; ++step) { const int c = dir ? 64 - step : step;
            const size_t idx = (size_t)(chain * 65 + c) * 4096 + e4;
            const f32x4 kv = X[idx]; const f32x4 dc = DC[(size_t)(chain * 65 + c) * 32 + (e4 & 31)];
            X[idx] = S; S = dc * S + kv; }
    }
}
DEV void phase_hg3(const Params& P0, int layer, unsigned char* lds, int bid, int nb, int wv) {
    Params P = load_params(); asm volatile("" : "+s"(P.ws));
    float* Lb = (float*)lds; bf16_t* Qs = (bf16_t*)(lds + 32768); bf16_t* Ks = (bf16_t*)(lds + 50176); bf16_t* Am = (bf16_t*)(lds + 67584);
    bf16_t* VT = (bf16_t*)(lds + 76800); bf16_t* Sb = (bf16_t*)(lds + 95232); float* Bt = (float*)(lds + 130048); float* Seg = (float*)(lds + 132096); float* Ost = (float*)lds;
    const float* X = (const float*)slotp(P, 17);
    const int tid = launder_tid(wv), lane = tid & 63, w = __builtin_amdgcn_readfirstlane(tid >> 6), j = tid >> 3, c0 = (tid & 7) * 16, l15 = lane & 15, quad = lane >> 4;
    const int tt = w >> 1, st0 = (w & 1) * 2, vt0 = (w & 1) * 4;
    const int cfirst = layer == 0 ? 0 : 1;
    const int ncb = 65 - cfirst;
    for (int unit = bid; unit < 16 * ncb; unit += nb) {
        const int sh = unit / ncb, c = unit - sh * ncb + cfirst, sl = sh >> 2, head = sh & 3;
        bool valid; const int r = hg_row(sl, c, j, valid);
        float q[16]; uint4 gv[2] = {make_uint4(0, 0, 0, 0), make_uint4(0, 0, 0, 0)};
        if (valid) {
            const uint4* qp = (const uint4*)(slotp(P, 2) + (size_t)r * 512 + head * 128 + c0); unpack8(qp[0], q); unpack8(qp[1], q + 8);
            const uint4* vp = (const uint4*)(slotp(P, 5) + (size_t)r * 512 + head * 128 + c0); float vf[16]; unpack8(vp[0], vf); unpack8(vp[1], vf + 8);
#pragma unroll
            for (int e = 0; e < 16; ++e) VT[(c0 + e) * 72 + j] = (bf16_t)(__float_as_uint(vf[e]) >> 16);
            const uint4* gp = (const uint4*)(slotp(P, 6) + (size_t)r * 512 + head * 128 + c0); gv[0] = gp[0]; gv[1] = gp[1];
        } else {
#pragma unroll
            for (int e = 0; e < 16; ++e) { q[e] = 0.f; VT[(c0 + e) * 72 + j] = 0; } }
        f32x4 accA[2], accO[4];
#pragma unroll
        for (int i = 0; i < 2; ++i) accA[i] = (f32x4){0.f, 0.f, 0.f, 0.f};
#pragma unroll
        for (int i = 0; i < 4; ++i) accO[i] = (f32x4){0.f, 0.f, 0.f, 0.f};
#pragma unroll 1
        for (int dir = 0; dir < 2; ++dir) {
            float lg[16], kk[16];
            if (valid) { float fr[16];
                const uint4* fp = (const uint4*)(slotp(P, 3 + dir) + (size_t)r * 512 + head * 128 + c0); unpack8(fp[0], fr); unpack8(fp[1], fr + 8);
#pragma unroll
                for (int e = 0; e < 16; ++e) hg_gate(fr[e], hg_lb(P, layer, dir, head * 128 + c0 + e), lg[e], kk[e]);
            } else {
#pragma unroll
                for (int e = 0; e < 16; ++e) { lg[e] = 0.f; kk[e] = 0.f; } }
#pragma unroll
            for (int e = 0; e < 16; e += 4) *(f32x4*)(Lb + j * 128 + c0 + e) = (f32x4){lg[e], lg[e + 1], lg[e + 2], lg[e + 3]};
            __syncthreads();
            hg_cumsum(Lb, Bt, Seg, dir, tid);
            __syncthreads();
            {
                float qs[16], ks[16];
#pragma unroll
                for (int e = 0; e < 16; ++e) { const float b = Lb[j * 128 + c0 + e], rf = Lb[32 * 128 + c0 + e]; qs[e] = q[e] * __expf(b - rf); ks[e] = kk[e] * __expf(rf - b); }
                *(uint4*)(Qs + j * 136 + c0) = pack8(qs); *(uint4*)(Qs + j * 136 + c0 + 8) = pack8(qs + 8);
                *(uint4*)(Ks + j * 136 + c0) = pack8(ks); *(uint4*)(Ks + j * 136 + c0 + 8) = pack8(ks + 8);
            }
            {
                const int chain = sl * 8 + head * 2 + dir; const f32x4* xs = (const f32x4*)(X + (size_t)(chain * 65 + c) * 16384 + (size_t)(tid >> 2) * 128 + (tid & 3) * 32);
#pragma unroll
                for (int i = 0; i < 4; ++i) { const f32x4 a = xs[2 * i], b = xs[2 * i + 1]; uint4 o; o.x = pk2(a[0], a[1]); o.y = pk2(a[2], a[3]); o.z = pk2(b[0], b[1]); o.w = pk2(b[2], b[3]);
                    *(uint4*)(Sb + (tid >> 2) * 136 + (tid & 3) * 32 + i * 8) = o; }
            }
            __syncthreads();
            {
                f32x4 t0 = (f32x4){0.f, 0.f, 0.f, 0.f}, t1 = t0;
#pragma unroll
                for (int k4 = 0; k4 < 4; ++k4) { const bf16x8 a = *(const bf16x8*)(Qs + (tt * 16 + l15) * 136 + k4 * 32 + quad * 8);
                    const bf16x8 b0 = *(const bf16x8*)(Ks + ((st0 + 0) * 16 + l15) * 136 + k4 * 32 + quad * 8); const bf16x8 b1 = *(const bf16x8*)(Ks + ((st0 + 1) * 16 + l15) * 136 + k4 * 32 + quad * 8);
                    t0 = mfma16(a, b0, t0); t1 = mfma16(a, b1, t1); }
#pragma unroll
                for (int jj = 0; jj < 4; ++jj) { const int t = tt * 16 + quad * 4 + jj, s0 = (st0 + 0) * 16 + l15, s1 = (st0 + 1) * 16 + l15;
                    const bool k0 = dir == 0 ? s0 <= t : s0 >= t, k1 = dir == 0 ? s1 <= t : s1 >= t;
                    accA[0][jj] += k0 ? t0[jj] : 0.f; accA[1][jj] += k1 ? t1[jj] : 0.f; }
            }
            __syncthreads();
            {   float qg[16];
#pragma unroll
                for (int e = 0; e < 16; ++e) qg[e] = q[e] * __expf(Lb[j * 128 + c0 + e]);
                *(uint4*)(Qs + j * 136 + c0) = pack8(qg); *(uint4*)(Qs + j * 136 + c0 + 8) = pack8(qg + 8); }
            __syncthreads();
#pragma unroll
            for (int k4 = 0; k4 < 4; ++k4) { const bf16x8 a = *(const bf16x8*)(Qs + (tt * 16 + l15) * 136 + k4 * 32 + quad * 8);
#pragma unroll
                for (int v4 = 0; v4 < 4; ++v4) { const bf16x8 b = *(const bf16x8*)(Sb + ((vt0 + v4) * 16 + l15) * 136 + k4 * 32 + quad * 8); accO[v4] = mfma16(a, b, accO[v4]); } }
            __syncthreads();
        }
#pragma unroll
        for (int s2 = 0; s2 < 2; ++s2)
#pragma unroll
            for (int jj = 0; jj < 4; ++jj) Am[(tt * 16 + quad * 4 + jj) * 72 + (st0 + s2) * 16 + l15] = (bf16_t)(pk2(accA[s2][jj], 0.f) & 0xffffu);
        __syncthreads();
#pragma unroll
        for (int ks = 0; ks < 2; ++ks) { const bf16x8 a = *(const bf16x8*)(Am + (tt * 16 + l15) * 72 + ks * 32 + quad * 8);
#pragma unroll
            for (int v4 = 0; v4 < 4; ++v4) { const bf16x8 b = *(const bf16x8*)(VT + ((vt0 + v4) * 16 + l15) * 72 + ks * 32 + quad * 8); accO[v4] = mfma16(a, b, accO[v4]); } }
#pragma unroll
        for (int v4 = 0; v4 < 4; ++v4)
#pragma unroll
            for (int jj = 0; jj < 4; ++jj) Ost[(tt * 16 + quad * 4 + jj) * 132 + (vt0 + v4) * 16 + l15] = accO[v4][jj];
        __syncthreads();
        {   float o[16], ss = 0.f;
#pragma unroll
            for (int e = 0; e < 16; ++e) { o[e] = Ost[j * 132 + c0 + e]; ss += o[e] * o[e]; }
            ss = red8(ss);
            const float rs = rsqrtf(ss * (1.f / 128.f) + 1e-6f);
            float gf[16]; unpack8(gv[0], gf); unpack8(gv[1], gf + 8);
#pragma unroll
            for (int e = 0; e < 16; ++e) { const float gg = gf[e]; o[e] = o[e] * rs * P.in[I_ONORM][layer * 512 + head * 128 + c0 + e] * (gg / (1.f + __expf(-gg))); }
            if (valid) { uint4* yp = (uint4*)(slotp(P, 2) + (size_t)r * 512 + head * 128 + c0); yp[0] = pack8(o); yp[1] = pack8(o + 8); }
        }
        __syncthreads();
    }
}
DEV void phase_vtrans(const Params& P0, unsigned char* lds, int bid, int nb, int wv) {
    Params P = load_params(); asm volatile("" : "+s"(P.ws));
    bf16_t* T = (bf16_t*)lds;
    const bf16_t* V = slotp(P, 12); bf16_t* VTg = slotp(P, 6);
    const int tid = launder_tid(wv);
    for (int unit = bid; unit < 4 * 65 * 8; unit += nb) {
        const int sl = unit / 520, rem = unit - sl * 520, pt = rem >> 3, vdt = rem & 7;
        { const int tok = tid >> 3, c8 = (tid & 7) * 8, p = pt * 64 + tok;
          uint4 v = make_uint4(0, 0, 0, 0);
          if (p < LSEQ) v = *(const uint4*)(V + (size_t)row_of(sl, p) * 512 + vdt * 64 + c8);
          *(uint4*)(T + tok * 72 + c8) = v; }
        __syncthreads();
        { const int vd = tid >> 3, t8 = (tid & 7) * 8;
          unsigned short e[8];
#pragma unroll
          for (int i = 0; i < 8; ++i) { const int pp = t8 + i; const int sp = (pp & ~12) | (((pp >> 2) & 1) << 3) | (((pp >> 3) & 1) << 2); e[i] = T[sp * 72 + vd]; }
          uint4 o; o.x = e[0] | ((unsigned)e[1] << 16); o.y = e[2] | ((unsigned)e[3] << 16); o.z = e[4] | ((unsigned)e[5] << 16); o.w = e[6] | ((unsigned)e[7] << 16);
          *(uint4*)(VTg + (size_t)(sl * 512 + vdt * 64 + vd) * 4160 + pt * 64 + t8) = o; }
        __syncthreads();
    }
}
DEV int crow(int r, int hi) { return (r & 3) + 8 * (r >> 2) + 4 * hi; }
typedef unsigned u32x4_t __attribute__((ext_vector_type(4)));
struct AttnStage { u32x4_t k0, k1, v0, v1; };
DEV void attn_stage_load(const Params& P, int sl, int head, int kt, int tid, AttnStage& st) {
    const bf16_t* Kg = slotp(P, 11); const bf16_t* VTg = slotp(P, 6);
    { const int ci = tid, krow = ci >> 4, kc = ci & 15; const int p = kt * 64 + krow; const int r = p < LSEQ ? row_of(sl, p) : 0; st.k0 = *(const u32x4_t*)(Kg + (size_t)r * 512 + head * 128 + kc * 8); }
    { const int ci = tid + 512, krow = ci >> 4, kc = ci & 15; const int p = kt * 64 + krow; const int r = p < LSEQ ? row_of(sl, p) : 0; st.k1 = *(const u32x4_t*)(Kg + (size_t)r * 512 + head * 128 + kc * 8); }
    { const int vi = tid, vrow = vi >> 3, vc = vi & 7; st.v0 = *(const u32x4_t*)(VTg + (size_t)(sl * 512 + head * 128 + vrow) * 4160 + kt * 64 + vc * 8); }
    { const int vi = tid + 512, vrow = vi >> 3, vc = vi & 7; st.v1 = *(const u32x4_t*)(VTg + (size_t)(sl * 512 + head * 128 + vrow) * 4160 + kt * 64 + vc * 8); }
}
DEV void attn_stage_store(unsigned char* buf, int tid, const AttnStage& st) {
    bf16_t* Kt = (bf16_t*)buf; bf16_t* Vt = (bf16_t*)(buf + 17408);
    { const int ci = tid, krow = ci >> 4, kc = ci & 15; *(u32x4_t*)(Kt + krow * 136 + kc * 8) = st.k0; }
    { const int ci = tid + 512, krow = ci >> 4, kc = ci & 15; *(u32x4_t*)(Kt + krow * 136 + kc * 8) = st.k1; }
    { const int vi = tid, vrow = vi >> 3, vc = vi & 7; *(u32x4_t*)(Vt + vrow * 72 + vc * 8) = st.v0; }
    { const int vi = tid + 512, vrow = vi >> 3, vc = vi & 7; *(u32x4_t*)(Vt + vrow * 72 + vc * 8) = st.v1; }
}
DEV void phase_attn(const Params& P0, int layer, unsigned char* lds, int ufirst, int ustride, int wv) {
    Params P = load_params(); asm volatile("" : "+s"(P.ws));
    const int tid = launder_tid(wv), lane = tid & 63, w = __builtin_amdgcn_readfirstlane(tid >> 6), map = w >> 2, qsub = w & 3, qi = lane & 31, hi = lane >> 5;
    const float lam_init = layer == 0 ? 0.2f : 0.35550906759096934f;
    float lam;
    { const float* lp = P.in[I_LAM] + (size_t)layer * 256; float s1 = 0.f, s2 = 0.f;
      for (int i = 0; i < 64; ++i) { s1 += lp[i] * lp[64 + i]; s2 += lp[128 + i] * lp[192 + i]; }
      lam = __expf(s1) - __expf(s2) + lam_init; }
    const int nqb = layer == 0 ? 33 : 32;
    float* Ex = (float*)lds;
    for (int unit = ufirst; unit < 16 * nqb; unit += ustride) {
        const int sh = unit / nqb, qb = unit - sh * nqb, sl = sh >> 2, head = sh & 3;
        const int qrow0 = qb < 32 ? sl * 4096 + qb * 128 : TREAL + sl * 16; const int nvalid = qb < 32 ? 128 : 16;
        bf16x8 Qf[4];
        { const bf16_t* qp = slotp(P, 10) + (size_t)(qrow0 + qsub * 32 + qi) * 512 + head * 128 + map * 64 + hi * 8;
#pragma unroll
          for (int ds = 0; ds < 4; ++ds) Qf[ds] = *(const bf16x8*)(qp + ds * 16); }
        AttnStage st;
        attn_stage_load(P, sl, head, 0, tid, st); attn_stage_store(lds, tid, st); attn_stage_load(P, sl, head, 1, tid, st);
        __syncthreads();
        f32x16 O[4];
#pragma unroll
        for (int v = 0; v < 4; ++v)
#pragma unroll
            for (int r = 0; r < 16; ++r) O[v][r] = 0.f;
        float m_run = -INFINITY, l_run = 0.f;
#pragma unroll 1
        for (int kt = 0; kt < 65; ++kt) {
            if (kt + 1 < 65) attn_stage_store(lds + ((kt + 1) & 1) * 35840, tid, st);
            if (kt + 2 < 65) attn_stage_load(P, sl, head, kt + 2, tid, st);
            const unsigned char* buf = lds + (kt & 1) * 35840;
            const bf16_t* Kb = (const bf16_t*)buf; const bf16_t* Vb = (const bf16_t*)(buf + 17408);
            f32x16 S0, S1;
#pragma unroll
            for (int r = 0; r < 16; ++r) { S0[r] = 0.f; S1[r] = 0.f; }
#pragma unroll
            for (int ds = 0; ds < 4; ++ds) {
                const bf16x8 a0 = *(const bf16x8*)(Kb + qi * 136 + map * 64 + ds * 16 + hi * 8);
                const bf16x8 a1 = *(const bf16x8*)(Kb + (32 + qi) * 136 + map * 64 + ds * 16 + hi * 8);
                S0 = mfma32(a0, Qf[ds], S0); S1 = mfma32(a1, Qf[ds], S1); }
            if (kt == 64) {
#pragma unroll
                for (int r = 0; r < 16; ++r) { if (crow(r, hi) >= 16) S0[r] = -INFINITY; S1[r] = -INFINITY; } }
            float mx = -INFINITY;
#pragma unroll
            for (int r = 0; r < 16; ++r) mx = fmaxf(mx, fmaxf(S0[r], S1[r]));
            { const auto sw = __builtin_amdgcn_permlane32_swap(__float_as_uint(mx), __float_as_uint(mx), false, false); mx = fmaxf(__uint_as_float(sw[0]), __uint_as_float(sw[1])); }
            const float m_new = fmaxf(m_run, mx); const float alpha = __builtin_amdgcn_exp2f(m_run - m_new); m_run = m_new;
            float ps = 0.f;
#pragma unroll
            for (int r = 0; r < 16; ++r) { S0[r] = __builtin_amdgcn_exp2f(S0[r] - m_new); S1[r] = __builtin_amdgcn_exp2f(S1[r] - m_new); ps += S0[r] + S1[r]; }
            l_run = l_run * alpha + ps;
            if (__builtin_amdgcn_ballot_w64(alpha != 1.0f) != 0ull) {
#pragma unroll
                for (int v = 0; v < 4; ++v)
#pragma unroll
                    for (int r = 0; r < 16; ++r) O[v][r] *= alpha; }
            bf16x8 pf[2][2];
#pragma unroll
            for (int half = 0; half < 2; ++half) {
                uint4 a, b;
                a.x = pk2(S0[half * 8 + 0], S0[half * 8 + 1]); a.y = pk2(S0[half * 8 + 2], S0[half * 8 + 3]); a.z = pk2(S0[half * 8 + 4], S0[half * 8 + 5]); a.w = pk2(S0[half * 8 + 6], S0[half * 8 + 7]);
                b.x = pk2(S1[half * 8 + 0], S1[half * 8 + 1]); b.y = pk2(S1[half * 8 + 2], S1[half * 8 + 3]); b.z = pk2(S1[half * 8 + 4], S1[half * 8 + 5]); b.w = pk2(S1[half * 8 + 6], S1[half * 8 + 7]);
                pf[0][half] = __builtin_bit_cast(bf16x8, a); pf[1][half] = __builtin_bit_cast(bf16x8, b); }
#pragma unroll
            for (int v = 0; v < 4; ++v)
#pragma unroll
                for (int sub = 0; sub < 2; ++sub)
#pragma unroll
                    for (int half = 0; half < 2; ++half) {
                        const bf16x8 av = *(const bf16x8*)(Vb + (v * 32 + qi) * 72 + sub * 32 + half * 16 + hi * 8);
                        O[v] = mfma32(av, pf[sub][half], O[v]); }
            __syncthreads();
        }
        const float l_tot = l_run + __shfl_xor(l_run, 32); const float inv = 1.0f / l_tot;
        if (map == 1) {
#pragma unroll
            for (int v = 0; v < 4; ++v)
#pragma unroll
                for (int r = 0; r < 16; ++r) Ex[(qsub * 32 + qi) * 132 + v * 32 + crow(r, hi)] = O[v][r] * inv; }
        __syncthreads();
        if (map == 0) {
            float ss = 0.f;
#pragma unroll
            for (int v = 0; v < 4; ++v)
#pragma unroll
                for (int r = 0; r < 16; ++r) { const float o = O[v][r] * inv - lam * Ex[(qsub * 32 + qi) * 132 + v * 32 + crow(r, hi)]; O[v][r] = o; ss += o * o; }
            ss += __shfl_xor(ss, 32);
            const float rs = rsqrtf(ss * (1.f / 128.f) + 1e-5f) * (1.f - lam_init);
            if (qsub * 32 + qi < nvalid) {
                bf16_t* yp = slotp(P, 4) + (size_t)(qrow0 + qsub * 32 + qi) * 512 + head * 128;
#pragma unroll
                for (int v = 0; v < 4; ++v)
#pragma unroll
                    for (int rg = 0; rg < 4; ++rg) { const int vd0 = v * 32 + 8 * rg + 4 * hi; const f32x4 gg = *(const f32x4*)(P.in[I_SUBLN] + layer * 128 + vd0);
                        uint2 o; o.x = pk2(O[v][rg * 4 + 0] * rs * gg[0], O[v][rg * 4 + 1] * rs * gg[1]); o.y = pk2(O[v][rg * 4 + 2] * rs * gg[2], O[v][rg * 4 + 3] * rs * gg[3]);
                        *(uint2*)(yp + vd0) = o; } }
        }
        __syncthreads();
    }
}
DEV float dpp_f(float x, const int ctrl) { return x; }
template <int CTRL> DEV float dppmov(float x) { return __builtin_bit_cast(float, __builtin_amdgcn_update_dpp(0, __builtin_bit_cast(int, x), CTRL, 0xf, 0xf, true)); }
DEV float sum16(float x) { x += dppmov<0xB1>(x); x += dppmov<0x4E>(x); x += dppmov<0x141>(x); x += dppmov<0x140>(x); return x; }
constexpr int RW_CH = 16, RW_BUF_F = 5120 + 256 + 4096, RW_BUFB = RW_BUF_F * 4;
struct RwRegs { u32x4_t r, k, kk, e, a, v; };
DEV void unpack8v(const u32x4_t w, float* f) { unpack8(make_uint4(w.x, w.y, w.z, w.w), f); }
DEV void rw_stage_load(const Params& P, RwRegs& g, int sl, int head, int dir, int qr, int ck, int t) {
    if (t < 128) { const int step = t >> 3, ch8 = (t & 7) * 8, sidx = ck * RW_CH + step;
        if (sidx < LSEQ) { const int p = dir ? LSEQ - 1 - sidx : sidx; const size_t ro = (size_t)row_of(sl, p) * 512 + head * 64 + ch8;
            g.r = *(const u32x4_t*)(slotp(P, 17) + ro); g.k = *(const u32x4_t*)(slotp(P, 18) + ro); g.kk = *(const u32x4_t*)(slotp(P, 20) + ro);
            g.e = *(const u32x4_t*)(slotp(P, 22 + dir) + ro); g.a = *(const u32x4_t*)(slotp(P, dir == 0 ? 24 : 13) + ro); } }
    if (t < 32) { const int tt = t, s2 = tt >> 1, r8 = (tt & 1) * 8, si2 = ck * RW_CH + s2;
        if (si2 < LSEQ) { const int p2 = dir ? LSEQ - 1 - si2 : si2; g.v = *(const u32x4_t*)(slotp(P, 19) + (size_t)row_of(sl, p2) * 512 + head * 64 + qr * 16 + r8); } }
}
DEV void rw_stage_write(const Params& P, int layer, unsigned char* buf, const RwRegs& g, int head, int ck, int t) {
    float* Rr = (float*)buf; float* Ww = Rr + 1024; float* Kd = Ww + 1024; float* Kk = Kd + 1024; float* Bb = Kk + 1024; float* Vs = Bb + 1024;
    if (t < 128) { const int step = t >> 3, ch8 = (t & 7) * 8, sidx = ck * RW_CH + step;
        if (sidx < LSEQ) {
            float r[8], k[8], kk[8], e[8], a[8];
            unpack8v(g.r, r); unpack8v(g.k, k); unpack8v(g.kk, kk); unpack8v(g.e, e); unpack8v(g.a, a);
            float ww[8], kd[8], bb[8];
#pragma unroll
            for (int j = 0; j < 8; ++j) { ww[j] = __expf(-e[j]); kd[j] = k[j] * (1.f + (a[j] - 1.f) * P.in[I_KA][layer * 512 + head * 64 + ch8 + j]); bb[j] = kk[j] * a[j]; }
            const int o = step * 64 + ch8;
            *(f32x4*)(Rr + o) = (f32x4){r[0], r[1], r[2], r[3]}; *(f32x4*)(Rr + o + 4) = (f32x4){r[4], r[5], r[6], r[7]};
            *(f32x4*)(Ww + o) = (f32x4){ww[0], ww[1], ww[2], ww[3]}; *(f32x4*)(Ww + o + 4) = (f32x4){ww[4], ww[5], ww[6], ww[7]};
            *(f32x4*)(Kd + o) = (f32x4){kd[0], kd[1], kd[2], kd[3]}; *(f32x4*)(Kd + o + 4) = (f32x4){kd[4], kd[5], kd[6], kd[7]};
            *(f32x4*)(Kk + o) = (f32x4){kk[0], kk[1], kk[2], kk[3]}; *(f32x4*)(Kk + o + 4) = (f32x4){kk[4], kk[5], kk[6], kk[7]};
            *(f32x4*)(Bb + o) = (f32x4){bb[0], bb[1], bb[2], bb[3]}; *(f32x4*)(Bb + o + 4) = (f32x4){bb[4], bb[5], bb[6], bb[7]};
        } }
    if (t < 32) { const int tt = t, s2 = tt >> 1, r8 = (tt & 1) * 8, si2 = ck * RW_CH + s2;
        if (si2 < LSEQ) { float v[8]; unpack8v(g.v, v);
            *(f32x4*)(Vs + s2 * 16 + r8) = (f32x4){v[0], v[1], v[2], v[3]}; *(f32x4*)(Vs + s2 * 16 + r8 + 4) = (f32x4){v[4], v[5], v[6], v[7]}; } }
}
DEV void rw_flush(const Params& P, const unsigned char* buf, int sl, int head, int dir, int qr, int ck, int t) {
    if (t >= 160 && t < 192) { const float* Op = (const float*)buf + 5376; const int tt = t - 160, s2 = tt >> 1, r8 = (tt & 1) * 8, sidx = ck * RW_CH + s2;
        if (sidx < LSEQ) { const int p = dir ? LSEQ - 1 - sidx : sidx; float o[8];
#pragma unroll
            for (int j = 0; j < 8; ++j) { const int row = r8 + j; const f32x4* q = (const f32x4*)(Op + s2 * 256 + (row >> 2) * 64 + (row & 3) * 16);
                const f32x4 a = q[0], b = q[1], c = q[2], d = q[3];
                o[j] = ((a[0] + a[1]) + (a[2] + a[3])) + ((b[0] + b[1]) + (b[2] + b[3])) + (((c[0] + c[1]) + (c[2] + c[3])) + ((d[0] + d[1]) + (d[2] + d[3]))); }
            *(uint4*)(slotp(P, 15 + dir) + (size_t)row_of(sl, p) * 512 + head * 64 + qr * 16 + r8) = pack8(o); } }
}
DEV void phase_rw_scan(const Params& P0, int layer, unsigned char* lds, int bid, int nb, int wv) {
    Params P = load_params(); asm volatile("" : "+s"(P.ws));
    const int tid = launder_tid(wv), lane = tid & 63, w = __builtin_amdgcn_readfirstlane(tid >> 6), li = lane & 15, rl = (w & 3) * 4 + (lane >> 4);
    constexpr int NCK = (LSEQ + RW_CH - 1) / RW_CH;
    typedef float f32x2 __attribute__((ext_vector_type(2)));
    for (int unit = bid; unit < 256; unit += nb) {
        const int sl = unit >> 6, head = (unit >> 3) & 7, dir = (unit >> 2) & 1, qr = unit & 3;
        f32x2 SA = (f32x2){0.f, 0.f}, SB = (f32x2){0.f, 0.f};
        RwRegs g; g.r = g.k = g.kk = g.e = g.a = g.v = (u32x4_t){0u, 0u, 0u, 0u};
        if (w >= 4) { rw_stage_load(P, g, sl, head, dir, qr, 0, tid - 256); rw_stage_write(P, layer, lds, g, head, 0, tid - 256); rw_stage_load(P, g, sl, head, dir, qr, 1, tid - 256); }
        __syncthreads();
#pragma unroll 1
        for (int ck = 0; ck < NCK; ++ck) {
            unsigned char* buf = lds + (ck & 1) * RW_BUFB;
            if (w >= 4) {
                if (ck + 1 < NCK) rw_stage_write(P, layer, lds + ((ck + 1) & 1) * RW_BUFB, g, head, ck + 1, tid - 256);
                if (ck + 2 < NCK) rw_stage_load(P, g, sl, head, dir, qr, ck + 2, tid - 256);
                if (ck > 0) rw_flush(P, lds + ((ck - 1) & 1) * RW_BUFB, sl, head, dir, qr, ck - 1, tid - 256);
            } else {
                const float* Rr = (const float*)buf + li * 4; const float* Vs = (const float*)buf + 5120 + rl; float* Op = (float*)buf + 5376 + w * 64 + lane;
                const int ns = (LSEQ - ck * RW_CH) < RW_CH ? (LSEQ - ck * RW_CH) : RW_CH;
                f32x4 rr = *(const f32x4*)(Rr), ww = *(const f32x4*)(Rr + 1024), kd = *(const f32x4*)(Rr + 2048), kk = *(const f32x4*)(Rr + 3072), bb = *(const f32x4*)(Rr + 4096); float vv = Vs[0];
#pragma unroll 2
                for (int i = 0; i < ns; ++i) {
                    const int in = i < RW_CH - 1 ? i + 1 : RW_CH - 1;
                    const f32x4 rr_n = *(const f32x4*)(Rr + in * 64), ww_n = *(const f32x4*)(Rr + 1024 + in * 64), kd_n = *(const f32x4*)(Rr + 2048 + in * 64);
                    const f32x4 kk_n = *(const f32x4*)(Rr + 3072 + in * 64), bb_n = *(const f32x4*)(Rr + 4096 + in * 64); const float vv_n = Vs[in * 16];
                    f32x2 p = SA * (f32x2){kk[0], kk[1]}; p = __builtin_elementwise_fma(SB, (f32x2){kk[2], kk[3]}, p);
                    const f32x2 vv2 = (f32x2){vv, vv};
                    const f32x2 ta = vv2 * (f32x2){kd[0], kd[1]}, tb = vv2 * (f32x2){kd[2], kd[3]};
                    const float sa = -sum16(p[0] + p[1]);
                    const f32x2 sa2 = (f32x2){sa, sa};
                    SA = __builtin_elementwise_fma(SA, (f32x2){ww[0], ww[1]}, __builtin_elementwise_fma(sa2, (f32x2){bb[0], bb[1]}, ta));
                    SB = __builtin_elementwise_fma(SB, (f32x2){ww[2], ww[3]}, __builtin_elementwise_fma(sa2, (f32x2){bb[2], bb[3]}, tb));
                    f32x2 q = SA * (f32x2){rr[0], rr[1]}; q = __builtin_elementwise_fma(SB, (f32x2){rr[2], rr[3]}, q);
                    Op[i * 256] = q[0] + q[1];
                    rr = rr_n; ww = ww_n; kd = kd_n; kk = kk_n; bb = bb_n; vv = vv_n;
                }
            }
            __syncthreads();
        }
        if (w >= 4) rw_flush(P, lds + ((NCK - 1) & 1) * RW_BUFB, sl, head, dir, qr, NCK - 1, tid - 256);
        __syncthreads();
    }
}
static_assert(LSEQ == 257 * 16, "chunked RWKV assumes whole 16-step chunks");
constexpr int RWC_REC = 8960, RWC_NCK = 257;
DEV unsigned char* rwc_rec(const Params& P, int dir, int idx) {
    const int gi = dir * 8224 + idx;
    if (gi < 1901) return (unsigned char*)slotp(P, 5) + (size_t)gi * RWC_REC;
    if (gi < 7606) return (unsigned char*)slotp(P, 7) + (size_t)(gi - 1901) * RWC_REC;
    if (gi < 9507) return (unsigned char*)slotp(P, 12) + (size_t)(gi - 7606) * RWC_REC;
    if (gi < 11408) return (unsigned char*)slotp(P, 21) + (size_t)(gi - 9507) * RWC_REC;
    return P.ws + WS_SLOTS + 25 * SLOT_B + (size_t)(gi - 11408) * RWC_REC; }
DEV int rwc_slot(int c) { return (((c >> 5) * 4 + ((c >> 2) & 3)) * 8) + ((c >> 4) & 1) * 4 + (c & 3); }
DEV void phase_rwc_pre(const Params& P0, int layer, unsigned char* lds, int bid, int nb, int wv) {
    Params P = load_params(); asm volatile("" : "+s"(P.ws));
    const int tid = launder_tid(wv), lane = tid & 63, w = __builtin_amdgcn_readfirstlane(tid >> 6), l15 = lane & 15, quad = lane >> 4;
    unsigned char* wl = lds + w * 15616;
    bf16_t* Bt = (bf16_t*)wl; bf16_t* Dt = Bt + 16 * 72; bf16_t* Ak = Dt + 16 * 72; bf16_t* Rt = Ak + 16 * 72;
    float* Mb = (float*)(wl + 9216); float* Md = Mb + 256; float* Gb = Md + 256; float* Gd = Gb + 256; float* Tm = Gd + 256; float* Nm = Tm + 256;
    const float ka = P.in[I_KA][layer * 512 + 0];  (void)ka;
    for (int unit2 = bid * 8 + w; unit2 < 2 * 32 * RWC_NCK; unit2 += nb * 8) {
        const int dir = unit2 >= 32 * RWC_NCK ? 1 : 0; const int unit = unit2 - dir * 32 * RWC_NCK;
        const int sh = unit / RWC_NCK, ck = unit - sh * RWC_NCK, sl = sh >> 3, head = sh & 7;
        const float kac = P.in[I_KA][layer * 512 + head * 64 + lane];
        float ak[16], bt[16], dt[16], rt[16];
        typedef const __attribute__((address_space(1))) unsigned short* gu16p;
        const gu16p pR = (gu16p)slotp(P, 17), pK = (gu16p)slotp(P, 18), pKK = (gu16p)slotp(P, 20), pE = (gu16p)slotp(P, 22 + dir), pA = (gu16p)slotp(P, dir == 0 ? 24 : 13);
        unsigned short r16[16], k16[16], q16[16], e16[16], a16[16];
#pragma unroll
        for (int t = 0; t < 16; ++t) {
            const int sidx = ck * 16 + t;
            const int p = dir ? LSEQ - 1 - sidx : sidx; const size_t ro = (size_t)row_of(sl, p) * 512 + head * 64 + lane;
            r16[t] = pR[ro]; k16[t] = pK[ro]; q16[t] = pKK[ro]; e16[t] = pE[ro]; a16[t] = pA[ro]; }
        float g = 1.f;
#pragma unroll
        for (int t = 0; t < 16; ++t) {
            const float r = bf2f(r16[t]), k = bf2f(k16[t]), kk = bf2f(q16[t]), e = bf2f(e16[t]), a = bf2f(a16[t]);
            const float wdec = __expf(-e), kd = k * (1.f + (a - 1.f) * kac), b = kk * a;
            ak[t] = g * kk; g *= wdec; const float gi = __builtin_amdgcn_rcpf(g); bt[t] = b * gi; dt[t] = kd * gi; rt[t] = g * r;
        }
        const float gC = g;
#pragma unroll
        for (int t = 0; t < 16; ++t) { Bt[t * 72 + lane] = (bf16_t)(pk2(bt[t], 0.f) & 0xffffu); Dt[t * 72 + lane] = (bf16_t)(pk2(dt[t], 0.f) & 0xffffu);
            Ak[t * 72 + lane] = (bf16_t)(pk2(ak[t], 0.f) & 0xffffu); Rt[t * 72 + lane] = (bf16_t)(pk2(rt[t], 0.f) & 0xffffu); }
        asm volatile("s_waitcnt lgkmcnt(0)" ::: "memory");
        {
            f32x4 mb = (f32x4){0.f, 0.f, 0.f, 0.f}, md = mb, gb = mb, gd = mb;
#pragma unroll
            for (int ks = 0; ks < 2; ++ks) {
                const bf16x8 fb = *(const bf16x8*)(Bt + l15 * 72 + ks * 32 + quad * 8), fd = *(const bf16x8*)(Dt + l15 * 72 + ks * 32 + quad * 8);
                const bf16x8 fa = *(const bf16x8*)(Ak + l15 * 72 + ks * 32 + quad * 8), fr = *(const bf16x8*)(Rt + l15 * 72 + ks * 32 + quad * 8);
                mb = mfma16(fb, fa, mb); md = mfma16(fd, fa, md); gb = mfma16(fb, fr, gb); gd = mfma16(fd, fr, gd); }
#pragma unroll
            for (int jj = 0; jj < 4; ++jj) { const int j = quad * 4 + jj, t = l15;
                Mb[j * 16 + t] = j < t ? mb[jj] : 0.f; Md[j * 16 + t] = j < t ? md[jj] : 0.f; Gb[j * 16 + t] = j <= t ? gb[jj] : 0.f; Gd[j * 16 + t] = j <= t ? gd[jj] : 0.f; }
        }
        asm volatile("s_waitcnt lgkmcnt(0)" ::: "memory");
        {
            float tc[16];
#pragma unroll
            for (int i = 15; i >= 0; --i) { float acc = (i == l15) ? 1.f : 0.f;
                float mr[16];
#pragma unroll
                for (int q4 = (i + 1) >> 2; q4 < 4; ++q4) { const f32x4 m4 = *(const f32x4*)(Mb + i * 16 + q4 * 4); mr[q4 * 4] = m4[0]; mr[q4 * 4 + 1] = m4[1]; mr[q4 * 4 + 2] = m4[2]; mr[q4 * 4 + 3] = m4[3]; }
#pragma unroll
                for (int l = i + 1; l < 16; ++l) acc -= mr[l] * tc[l];
                tc[i] = acc; }
            if (quad == 0) {
#pragma unroll
                for (int i = 0; i < 16; ++i) Tm[i * 16 + l15] = tc[i]; }
        }
        asm volatile("s_waitcnt lgkmcnt(0)" ::: "memory");
        {
            float n4[4] = {0.f, 0.f, 0.f, 0.f};
#pragma unroll
            for (int l = 0; l < 16; ++l) { const float tv = Tm[l * 16 + l15];
#pragma unroll
                for (int jj = 0; jj < 4; ++jj) n4[jj] += Md[(quad * 4 + jj) * 16 + l] * tv; }
#pragma unroll
            for (int jj = 0; jj < 4; ++jj) Nm[(quad * 4 + jj) * 16 + l15] = n4[jj];
        }
        asm volatile("s_waitcnt lgkmcnt(0)" ::: "memory");
        unsigned char* rec = rwc_rec(P, dir, unit);
        {
            float q4[4];
#pragma unroll
            for (int jj = 0; jj < 4; ++jj) q4[jj] = Gd[(quad * 4 + jj) * 16 + l15];
#pragma unroll
            for (int l = 0; l < 16; ++l) { const float gv = Gb[l * 16 + l15];
#pragma unroll
                for (int jj = 0; jj < 4; ++jj) q4[jj] -= Nm[(quad * 4 + jj) * 16 + l] * gv; }
            *(uint2*)((bf16_t*)(rec + 8192) + l15 * 16 + quad * 4) = make_uint2(pk2(q4[0], q4[1]), pk2(q4[2], q4[3]));
        }
        {
            float ap[16], rp[16], ps[16];
#pragma unroll
            for (int t = 0; t < 16; ++t) { ap[t] = 0.f; rp[t] = rt[t]; }
#pragma unroll
            for (int j = 0; j < 16; ++j) {
#pragma unroll
                for (int q4 = j >> 2; q4 < 4; ++q4) { const f32x4 r4 = *(const f32x4*)(Tm + j * 16 + q4 * 4);
#pragma unroll
                    for (int e = 0; e < 4; ++e) ap[q4 * 4 + e] += ak[j] * r4[e]; } }
#pragma unroll
            for (int j = 0; j < 16; ++j) {
#pragma unroll
                for (int q4 = j >> 2; q4 < 4; ++q4) { const f32x4 r4 = *(const f32x4*)(Gb + j * 16 + q4 * 4);
#pragma unroll
                    for (int e = 0; e < 4; ++e) rp[q4 * 4 + e] -= ap[j] * r4[e]; } }
#pragma unroll
            for (int j = 0; j < 16; ++j) { float acc = dt[j];
#pragma unroll
                for (int q4 = j >> 2; q4 < 4; ++q4) { const f32x4 r4 = *(const f32x4*)(Nm + j * 16 + q4 * 4);
#pragma unroll
                    for (int e = 0; e < 4; ++e) acc -= r4[e] * bt[q4 * 4 + e]; }
                ps[j] = acc * gC; }
            bf16_t* AP = (bf16_t*)rec; bf16_t* RP = AP + 1024; const int so = rwc_slot(lane);
#pragma unroll
            for (int t = 0; t < 16; ++t) { AP[t * 64 + so] = (bf16_t)(pk2(ap[t], 0.f) & 0xffffu); RP[t * 64 + so] = (bf16_t)(pk2(rp[t], 0.f) & 0xffffu); }
            float nb_[16];
#pragma unroll
            for (int t = 0; t < 16; ++t) nb_[t] = -bt[t] * gC;
            uint4* BP = (uint4*)(rec + 4096) + lane * 2; BP[0] = pack8(nb_); BP[1] = pack8(nb_ + 8);
            uint4* PP = (uint4*)(rec + 6144) + lane * 2; PP[0] = pack8(ps); PP[1] = pack8(ps + 8);
            ((float*)(rec + 8704))[lane] = gC;
        }
        asm volatile("s_waitcnt lgkmcnt(0)" ::: "memory");
    }
}
struct RwcRegs { u32x4_t a, b, c, v; };
DEV void rwc_load(const Params& P, RwcRegs& g, int sh, int dir, int ck, int t) {
    const unsigned char* rec = rwc_rec(P, dir, sh * RWC_NCK + ck);
    g.a = *(const u32x4_t*)(rec + (size_t)t * 16); g.b = *(const u32x4_t*)(rec + (size_t)(t + 256) * 16);
    if (t < 48) g.c = *(const u32x4_t*)(rec + (size_t)(t + 512) * 16);
    if (t < 128) { const int j = t >> 3, r8 = (t & 7) * 8, sidx = ck * 16 + j; const int sc = sidx < LSEQ ? sidx : LSEQ - 1; const int p = dir ? LSEQ - 1 - sc : sc;
        g.v = *(const u32x4_t*)(slotp(P, 19) + (size_t)row_of(sh >> 3, p) * 512 + (sh & 7) * 64 + r8); if (sidx >= LSEQ) g.v = (u32x4_t){0u, 0u, 0u, 0u}; }
}
DEV void rwc_store(unsigned char* buf, const RwcRegs& g, int t) {
    *(u32x4_t*)(buf + t * 16) = g.a; *(u32x4_t*)(buf + (t + 256) * 16) = g.b;
    if (t < 48) *(u32x4_t*)(buf + (t + 512) * 16) = g.c;
    if (t < 128) { bf16_t* VsT = (bf16_t*)(buf + RWC_REC); const int j = t >> 3, r8 = (t & 7) * 8;
        VsT[(r8 + 0) * 16 + j] = (bf16_t)(g.v.x & 0xffffu); VsT[(r8 + 1) * 16 + j] = (bf16_t)(g.v.x >> 16); VsT[(r8 + 2) * 16 + j] = (bf16_t)(g.v.y & 0xffffu); VsT[(r8 + 3) * 16 + j] = (bf16_t)(g.v.y >> 16);
        VsT[(r8 + 4) * 16 + j] = (bf16_t)(g.v.z & 0xffffu); VsT[(r8 + 5) * 16 + j] = (bf16_t)(g.v.z >> 16); VsT[(r8 + 6) * 16 + j] = (bf16_t)(g.v.w & 0xffffu); VsT[(r8 + 7) * 16 + j] = (bf16_t)(g.v.w >> 16); }
}
DEV void phase_rwc_scan(const Params& P0, unsigned char* lds, int bid, int nb, int wv) {
    Params P = load_params(); asm volatile("" : "+s"(P.ws));
    const int tid = launder_tid(wv), lane = tid & 63, w = __builtin_amdgcn_readfirstlane(tid >> 6), l15 = lane & 15, quad = lane >> 4;
    constexpr int BUFB = RWC_REC + 2048;
    for (int u2 = bid; u2 < 64; u2 += nb) {
        const int sh = u2 & 31, dir = u2 >> 5; const int sl = sh >> 3, head = sh & 7;
        f32x4 ST[4];
#pragma unroll
        for (int ct = 0; ct < 4; ++ct) ST[ct] = (f32x4){0.f, 0.f, 0.f, 0.f};
        RwcRegs g; g.a = g.b = g.c = g.v = (u32x4_t){0u, 0u, 0u, 0u};
        if (w >= 4) { rwc_load(P, g, sh, dir, 0, tid - 256); rwc_store(lds, g, tid - 256); rwc_load(P, g, sh, dir, 1, tid - 256); }
        __syncthreads();
#pragma unroll 1
        for (int ck = 0; ck < RWC_NCK; ++ck) {
            const unsigned char* buf = lds + (ck & 1) * BUFB;
            if (w >= 4) {
                if (ck + 1 < RWC_NCK) rwc_store(lds + ((ck + 1) & 1) * BUFB, g, tid - 256);
                if (ck + 2 < RWC_NCK) rwc_load(P, g, sh, dir, ck + 2, tid - 256);
            } else {
                const bf16_t* AP = (const bf16_t*)buf; const bf16_t* RP = AP + 1024; const bf16_t* BP = (const bf16_t*)(buf + 4096); const bf16_t* PP = (const bf16_t*)(buf + 6144);
                const bf16_t* QP = (const bf16_t*)(buf + 8192); const float* GC = (const float*)(buf + 8704); const bf16_t* VsT = (const bf16_t*)(buf + RWC_REC);
                const u32x4_t z4 = (u32x4_t){0u, 0u, 0u, 0u};
                u32x4_t sb0, sb1;
                sb0.x = pk2(ST[0][0], ST[0][1]); sb0.y = pk2(ST[0][2], ST[0][3]); sb0.z = pk2(ST[1][0], ST[1][1]); sb0.w = pk2(ST[1][2], ST[1][3]);
                sb1.x = pk2(ST[2][0], ST[2][1]); sb1.y = pk2(ST[2][2], ST[2][3]); sb1.z = pk2(ST[3][0], ST[3][1]); sb1.w = pk2(ST[3][2], ST[3][3]);
                const bf16x8 SB0 = __builtin_bit_cast(bf16x8, sb0), SB1 = __builtin_bit_cast(bf16x8, sb1);
                const bf16x8 a0 = *(const bf16x8*)(AP + l15 * 64 + (0 * 4 + quad) * 8), a1 = *(const bf16x8*)(AP + l15 * 64 + (1 * 4 + quad) * 8);
                const bf16x8 r0 = *(const bf16x8*)(RP + l15 * 64 + (0 * 4 + quad) * 8), r1 = *(const bf16x8*)(RP + l15 * 64 + (1 * 4 + quad) * 8);
                const u32x4_t vq = quad < 2 ? *(const u32x4_t*)(VsT + (w * 16 + l15) * 16 + quad * 8) : z4;
                const u32x4_t qq = quad < 2 ? *(const u32x4_t*)(QP + l15 * 16 + quad * 8) : z4;
                const bf16x8 VB = __builtin_bit_cast(bf16x8, vq), QA = __builtin_bit_cast(bf16x8, qq);
                f32x4 Wt = (f32x4){0.f, 0.f, 0.f, 0.f}, Ot = Wt;
                Wt = mfma16(a0, SB0, Wt); Wt = mfma16(a1, SB1, Wt);
                Ot = mfma16(r0, SB0, Ot); Ot = mfma16(r1, SB1, Ot); Ot = mfma16(QA, VB, Ot);
                u32x4_t wb; wb.x = pk2(Wt[0], Wt[1]); wb.y = pk2(Wt[2], Wt[3]); wb.z = 0u; wb.w = 0u;
                const bf16x8 WB = __builtin_bit_cast(bf16x8, wb);
#pragma unroll
                for (int ct = 0; ct < 4; ++ct) {
                    const f32x4 gc = *(const f32x4*)(GC + ct * 16 + quad * 4);
                    const uint2 bq = *(const uint2*)(BP + (ct * 16 + l15) * 16 + quad * 4);
                    u32x4_t ba; ba.x = bq.x; ba.y = bq.y; ba.z = 0u; ba.w = 0u;
                    const u32x4_t pq = quad < 2 ? *(const u32x4_t*)(PP + (ct * 16 + l15) * 16 + quad * 8) : z4;
                    f32x4 acc = ST[ct] * gc;
                    acc = mfma16(__builtin_bit_cast(bf16x8, ba), WB, acc);
                    acc = mfma16(__builtin_bit_cast(bf16x8, pq), VB, acc);
                    ST[ct] = acc;
                }
                bf16_t* Oo = slotp(P, 15 + dir);
#pragma unroll
                for (int jj = 0; jj < 4; ++jj) { const int sidx = ck * 16 + quad * 4 + jj;
                    if (sidx < LSEQ) { const int p = dir ? LSEQ - 1 - sidx : sidx; Oo[(size_t)row_of(sl, p) * 512 + head * 64 + w * 16 + l15] = (bf16_t)(pk2(Ot[jj], 0.f) & 0xffffu); } }
            }
            __syncthreads();
        }
    }
}

#define LAS __attribute__((address_space(3)))
#define XB_TMO      128
#define XB_XCNT(j)  (256  + 64 * (j))
#define XB_XSUB(j)  (1280 + 64 * (j))
#define XB_XGEN(j)  (2304 + 64 * (j))
#define XB_TOP      3328
#define XB_TOPGEN   3392
#define XCD_BAR_WORDS 3456
#define XB_SPIN_CAP (1u << 18)

__device__ __forceinline__ unsigned xb_ld(unsigned* p)              { return __hip_atomic_load(p, __ATOMIC_RELAXED, __HIP_MEMORY_SCOPE_AGENT); }
__device__ __forceinline__ unsigned xb_add(unsigned* p, unsigned v) { return __hip_atomic_fetch_add(p, v, __ATOMIC_RELAXED, __HIP_MEMORY_SCOPE_AGENT); }
__device__ __forceinline__ unsigned xb_xcc_id() { return (unsigned)__builtin_amdgcn_s_getreg((3 << 11) | 20) & 0xFu; }
#define XB_SPIN(cond, bar) do { unsigned _sp = 0; while (cond) { __builtin_amdgcn_s_sleep(1); \
    if ((++_sp & 255u) == 0u) { if (xb_ld(&(bar)[XB_TMO])) break; if (_sp > XB_SPIN_CAP) { atomicAdd(&(bar)[XB_TMO], 1u); break; } } } } while (0)

struct XcdBarrier {
    unsigned* bar; unsigned x;
    volatile LAS unsigned* st;
};

__device__ __forceinline__ XcdBarrier xcd_barrier_post(unsigned* bar, volatile LAS unsigned* st, int wv) {
    XcdBarrier b; b.bar = bar; b.x = xb_xcc_id(); b.st = st;
    if (launder_tid(wv) == 0) (void)xb_add(&bar[XB_XCNT(b.x)], 1u);
    return b;
}
__device__ __forceinline__ void xcd_barrier_complete(unsigned* bar, unsigned x, unsigned& nloc, unsigned& nx) {
    const unsigned G = gridDim.x * gridDim.y * gridDim.z;
    unsigned sum, cnt, mine, sp = 0u;
    for (;;) {
        sum = 0u; cnt = 0u; mine = 0u;
#pragma unroll
        for (unsigned j = 0; j < 16; ++j) { const unsigned c = xb_ld(&bar[XB_XCNT(j)]); sum += c; cnt += (c > 0u) ? 1u : 0u; mine = (j == x) ? c : mine; }
        if (sum == G) break;
        __builtin_amdgcn_s_sleep(1);
        if ((++sp & 255u) == 0u) { if (xb_ld(&bar[XB_TMO])) break; if (sp > XB_SPIN_CAP) { atomicAdd(&bar[XB_TMO], 1u); break; } }
    }
    nloc = mine > 0u ? mine : 1u; nx = cnt > 0u ? cnt : 1u;
}

__device__ __forceinline__ void xcd_barrier(const XcdBarrier& b, int wv) {
    asm volatile("s_waitcnt vmcnt(0)" ::: "memory");
    __syncthreads();
    if (launder_tid(wv) == 0) {
        unsigned* bar = b.bar;
        __builtin_amdgcn_s_waitcnt(0);
        unsigned nloc = b.st[0], nx = b.st[1];
        if (nloc == 0u) { xcd_barrier_complete(bar, b.x, nloc, nx); b.st[0] = nloc; b.st[1] = nx; }
        const unsigned old = xb_add(&bar[XB_XSUB(b.x)], 1u);
        const unsigned gen = old / nloc;
        if (old + 1u == (gen + 1u) * nloc) {
            __builtin_amdgcn_fence(__ATOMIC_RELEASE, "agent");
            asm volatile("s_waitcnt vmcnt(0)" ::: "memory");
            const unsigned og = xb_add(&bar[XB_TOP], 1u);
            const unsigned tg = og / nx;
            if (og + 1u == (tg + 1u) * nx) xb_add(&bar[XB_TOPGEN], 1u);
            else XB_SPIN(xb_ld(&bar[XB_TOPGEN]) == tg, bar);
            __builtin_amdgcn_fence(__ATOMIC_ACQUIRE, "agent");
            xb_add(&bar[XB_XGEN(b.x)], 1u);
            asm volatile("s_waitcnt vmcnt(0)" ::: "memory");
        } else {
            XB_SPIN(xb_ld(&bar[XB_XGEN(b.x)]) == gen, bar);
            __builtin_amdgcn_fence(__ATOMIC_ACQUIRE, "agent");
            asm volatile("s_waitcnt vmcnt(0)" ::: "memory");
        }
    }
    __syncthreads();
}

__global__ void __launch_bounds__(512) mega_fwd(Params P) {
    extern __shared__ __attribute__((aligned(16))) unsigned char lds[];
    cg::grid_group grid = cg::this_grid();
    const int bid = blockIdx.x, nb = gridDim.x; const int wv = __builtin_amdgcn_readfirstlane(threadIdx.x >> 6);
    volatile LAS unsigned* MISC = (volatile LAS unsigned*)((LAS unsigned char*)lds + 131072 + 256);
    if (threadIdx.x < 4) MISC[threadIdx.x] = 0u;
    __syncthreads();
    XcdBarrier xbar;
    { Params Pb = load_params(); xbar = xcd_barrier_post((unsigned*)Pb.ws, MISC, wv); }
#define GSYNC() xcd_barrier(xbar, wv)
    PG8_LAS unsigned char* ldsl = (PG8_LAS unsigned char*)lds;
#pragma unroll 1
    for (int layer_ = 0; layer_ < 2; ++layer_) {
        phase_weights(P, lsd(layer_), lds, bid, nb, wv);
        grid.sync();
#pragma unroll 1
        for (int g_ = 0; g_ < NGRP; ++g_) {
            #define Mpost ((lsd(layer_) == 0 && lsd(g_) == 2) ? TGP : TREAL)
#define NVALID ((lsd(layer_) == 0 && lsd(g_) == 2) ? TG + 128 : TG)
            phase_rmsnorm(P, lsd(g_), lsd(layer_) == 0, I_NMIX, lsd(layer_), TGP, NVALID, bid, nb, wv);
            if (PROBE == 5) { phase_rmsnorm(P, lsd(g_), lsd(layer_) == 0, I_NMIX, lsd(layer_), TGP, NVALID, bid, nb, wv); }
            GSYNC();
            if (PROBE == 6) { for (int q_ = 0; q_ < 15; ++q_) GSYNC(); }
            for (int rep_ = 0; rep_ < (PROBE == 3 ? 2 : 1); ++rep_)
            { Params Pl = load_params(); asm volatile("" : "+s"(Pl.ws)); pg8::bf16_t* W = (pg8::bf16_t*)(Pl.ws + WS_W); pg8::Gemm gm{slotp(Pl, 0), W + WO_IN, TGP, 7680, 1024, 0, 0}; pg8::StaticOrder S; S.init(TGP, 7680, nb, bid);
              pg8::EpiBf<0> E{slotp(Pl, 2), 512, SLOT_E};
              pg8::gemm_phase<pg8::EpiBf<0>, pg8::StaticOrder, true, true>(ldsl, gm, S, E, wv); }
            GSYNC();
            phase_da_prep(P, lsd(layer_), bid, nb, wv);
            phase_hg1(P, lsd(layer_), lds, bid, nb, wv);
            if (PROBE == 4) { phase_hg1(P, lsd(layer_), lds, bid, nb, wv); }
            GSYNC();
            phase_hg2(P, bid, nb, wv);
            GSYNC();
            phase_hg3(P, lsd(layer_), lds, bid, nb, wv);
            GSYNC();
            phase_conv(P, lsd(layer_), bid, nb, wv);
            if (PROBE == 5) { phase_conv(P, lsd(layer_), bid, nb, wv); }
            phase_vtrans(P, lds, bid, nb, wv);
            if (PROBE == 5) { phase_vtrans(P, lds, bid, nb, wv); }
            phase_rw_prep(P, lsd(layer_), bid, nb, wv);
            if (PROBE == 5) { phase_rw_prep(P, lsd(layer_), bid, nb, wv); }
            GSYNC();
            { Params Pl = load_params(); asm volatile("" : "+s"(Pl.ws)); pg8::bf16_t* W = (pg8::bf16_t*)(Pl.ws + WS_W); pg8::Gemm gm{slotp(Pl, 21), W + WO_LR, TGP, 2560, 384, 0, 0}; pg8::StaticOrder S; S.init(TGP, 2560, nb, bid);
              pg8::EpiLR E{slotp(Pl, 22), slotp(Pl, 23), slotp(Pl, 24), slotp(Pl, 13), slotp(Pl, 14), Pl.in[I_W0] + lsd(layer_) * 1024, Pl.in[I_A0] + lsd(layer_) * 1024};
              pg8::gemm_phase<pg8::EpiLR, pg8::StaticOrder, true, true>(ldsl, gm, S, E, wv); }
            GSYNC();
            phase_rwc_pre(P, lsd(layer_), lds, bid, nb, wv);
            GSYNC();
            if (nb >= 128) {
                if (bid < 64) { phase_rwc_scan(P, lds, bid, nb, wv); __syncthreads(); phase_attn(P, lsd(layer_), lds, bid, 1 << 20, wv); }
                else phase_attn(P, lsd(layer_), lds, 64 + (bid - 64), nb - 64, wv);
            } else { phase_rwc_scan(P, lds, bid, nb, wv); __syncthreads(); phase_attn(P, lsd(layer_), lds, bid, nb, wv); }
            GSYNC();
            phase_rw_post(P, lsd(layer_), lsd(g_), lsd(layer_) == 0 ? TG : TREAL, bid, nb, wv);
            if (PROBE == 5) { phase_rw_post(P, lsd(layer_), lsd(g_), lsd(layer_) == 0 ? TG : TREAL, bid, nb, wv); }
            GSYNC();
            { Params Pl = load_params(); asm volatile("" : "+s"(Pl.ws)); pg8::bf16_t* W = (pg8::bf16_t*)(Pl.ws + WS_W); pg8::Gemm gm{slotp(Pl, 2), W + WO_BP, Mpost, 4096, 512, 4, SLOT_B}; pg8::StaticOrder S; S.init(Mpost, 4096, nb, bid);
              pg8::EpiBf<0> E{slotp(Pl, 6), 4096, 0};
              pg8::gemm_phase<pg8::EpiBf<0>, pg8::StaticOrder, true, true>(ldsl, gm, S, E, wv); }
            GSYNC();
            { Params Pl = load_params(); asm volatile("" : "+s"(Pl.ws)); pg8::bf16_t* W = (pg8::bf16_t*)(Pl.ws + WS_W); pg8::Gemm gm{slotp(Pl, 0), W + WO_G, Mpost, 4096, 1024, 0, 0}; pg8::StaticOrder S; S.init(Mpost, 4096, nb, bid);
              pg8::EpiGate E{slotp(Pl, 6), slotp(Pl, 14)};
              pg8::gemm_phase<pg8::EpiGate, pg8::StaticOrder, true, true>(ldsl, gm, S, E, wv); }
            GSYNC();
            { Params Pl = load_params(); asm volatile("" : "+s"(Pl.ws)); pg8::bf16_t* W = (pg8::bf16_t*)(Pl.ws + WS_W); pg8::Gemm gm{slotp(Pl, 14), W + WO_OUT, Mpost, 1024, 1024, 0, 0}; pg8::StaticOrder S; S.init(Mpost, 1024, nb, bid);
              pg8::EpiResid E{lsd(layer_) == 0 ? x_in_row(Pl, lsd(g_), 0) : (const float*)x_cur_row(Pl, lsd(g_), 0), lsd(layer_) == 0 ? Pl.in[I_META] : (const float*)nullptr, x_cur_row(Pl, lsd(g_), 0), (float*)(Pl.ws + WS_XMETA), lsd(g_), NVALID};
              pg8::gemm_phase<pg8::EpiResid, pg8::StaticOrder, true, true>(ldsl, gm, S, E, wv); }
            GSYNC();
            phase_rmsnorm(P, lsd(g_), false, I_NMLP, lsd(layer_), Mpost, NVALID, bid, nb, wv);
            if (PROBE == 5) { phase_rmsnorm(P, lsd(g_), false, I_NMLP, lsd(layer_), Mpost, NVALID, bid, nb, wv); }
            GSYNC();
            for (int rep_ = 0; rep_ < (PROBE == 7 ? 2 : 1); ++rep_)
            { Params Pl = load_params(); asm volatile("" : "+s"(Pl.ws)); pg8::bf16_t* W = (pg8::bf16_t*)(Pl.ws + WS_W); pg8::Gemm gm{slotp(Pl, 0), W + WO_1, Mpost, 4096, 1024, 0, 0}; pg8::StaticOrder S; S.init(Mpost, 4096, nb, bid);
              pg8::EpiBf<1> E{slotp(Pl, 6), 4096, 0};
              pg8::gemm_phase<pg8::EpiBf<1>, pg8::StaticOrder, true, true>(ldsl, gm, S, E, wv); }
            GSYNC();
            { Params Pl = load_params(); asm volatile("" : "+s"(Pl.ws)); pg8::bf16_t* W = (pg8::bf16_t*)(Pl.ws + WS_W); pg8::Gemm gm{slotp(Pl, 6), W + WO_2, Mpost, 1024, 4096, 0, 0}; pg8::StaticOrder S; S.init(Mpost, 1024, nb, bid);
              pg8::EpiResid E{(const float*)x_cur_row(Pl, lsd(g_), 0), (const float*)nullptr, x_cur_row(Pl, lsd(g_), 0), (float*)(Pl.ws + WS_XMETA), lsd(g_), NVALID};
              pg8::gemm_phase<pg8::EpiResid, pg8::StaticOrder, true, true>(ldsl, gm, S, E, wv); }
            GSYNC();
        }
    }
}

extern "C" void kernel_launch(void* const* d_in, const int* in_sizes, int n_in, void* d_out, int out_size, void* d_ws, size_t ws_size, hipStream_t stream) {
    static int grid = 0;
    if (grid == 0) {
        if (n_in != 29 || ws_size < WS_NEED) { fprintf(stderr, "kernel_launch: need 29 inputs and %zu bytes of workspace; got %d, %zu\n", (size_t)WS_NEED, n_in, ws_size); grid = -1; return; }
        int dev = 0, cus = 0, per_cu = 0;
        if (hipGetDevice(&dev) != hipSuccess || hipDeviceGetAttribute(&cus, hipDeviceAttributeMultiprocessorCount, dev) != hipSuccess) { grid = -1; return; }
        if (hipFuncSetAttribute((const void*)mega_fwd, hipFuncAttributeMaxDynamicSharedMemorySize, LDS_BYTES) != hipSuccess) { fprintf(stderr, "kernel_launch: hipFuncSetAttribute failed\n"); grid = -1; return; }
        if (hipOccupancyMaxActiveBlocksPerMultiprocessor(&per_cu, (const void*)mega_fwd, 512, LDS_BYTES) != hipSuccess || per_cu < 1) { fprintf(stderr, "kernel_launch: occupancy query says %d\n", per_cu); per_cu = 1; }
        (void)hipGetLastError();
        grid = cus;
    }
    if (grid < 0) return;
    if (hipMemsetAsync(d_ws, 0, 16384, stream) != hipSuccess) { fprintf(stderr, "kernel_launch: memset failed\n"); return; }
    Params p{};
    for (int i = 0; i < 29; ++i) p.in[i] = (const float*)d_in[i];
    p.out = (float*)d_out; p.ws = (unsigned char*)d_ws;
    void* args[] = {&p};
    hipError_t e = hipLaunchCooperativeKernel((const void*)mega_fwd, dim3(grid), dim3(512), args, LDS_BYTES, stream);
    if (e != hipSuccess) fprintf(stderr, "kernel_launch: cooperative launch failed: %s (grid %d)\n", hipGetErrorString(e), grid);
}
```

```cpp
#include <hip/hip_runtime.h>
#include <hip/hip_cooperative_groups.h>
#include <cstdio>
#include <cstdint>
namespace cg = cooperative_groups;
#define PROBE 0
#define DEV __device__ __forceinline__
__device__ __forceinline__ int lsd(int x) { asm volatile("" : "+s"(x)); return x; }
__device__ __forceinline__ int launder_tid(int wv) { int l; asm volatile("v_mbcnt_lo_u32_b32 %0, -1, 0\n\tv_mbcnt_hi_u32_b32 %0, -1, %0" : "=v"(l)); return wv * 64 + l; }
namespace pg8 {
#define PG8_LAS __attribute__((address_space(3)))
typedef unsigned short bf16_t;
typedef short bf16x8 __attribute__((ext_vector_type(8)));
typedef float f32x4 __attribute__((ext_vector_type(4)));
typedef unsigned u32x4 __attribute__((ext_vector_type(4)));
constexpr int BM = 256, BK = 64, HALF = 128, HTB = HALF * BK * 2  , STAGE_BYTES = 8 * HTB, NXCD = 8, WGM = 8;

__host__ __device__ __forceinline__ int lds_byte(int r, int c) { const int st = (r >> 4) * 2 + (c >> 5), rr = r & 15, cc = c & 31, ob = rr * 64 + cc * 2; return st * 1024 + (ob ^ (((ob >> 9) & 1) << 5)); }
__host__ __device__ __forceinline__ void stage_rc(int b, int& R, int& C) { const int st = b / 1024, sb = b % 1024, swz = sb ^ (((sb >> 9) & 1) << 5); R = (st >> 1) * 16 + swz / 64; C = (st & 1) * 32 + (swz % 64) / 2; }
__host__ __device__ __forceinline__ int perm32(int rho) { const int n = rho >> 4, i = rho & 15; return 8 * (i >> 2) + 4 * n + (i & 3); }

struct Unit { int pm, pn; };
struct Gemm { const bf16_t* A; const bf16_t* Bt; int M, N, K; int pn_per_ab; size_t ab_stride; };

struct StaticOrder {
    int nM, nN, nwg, G, c;
    __host__ __device__ void init(int M, int N, int G_, int c_) { nM = M / BM; nN = N / BM; nwg = nM * nN; G = G_; c = c_; }
    __host__ __device__ bool next(int i, Unit& u) const {
        const long L = (long)i * G + c; if (L >= nwg) return false;
        int wgid = (int)L; { const int q = nwg / NXCD, r = nwg % NXCD, xcd = wgid % NXCD, off = wgid / NXCD; wgid = (xcd < r ? xcd * (q + 1) : r * (q + 1) + (xcd - r) * q) + off; }
        const int nig = WGM * nN, gid = wgid / nig, fm = gid * WGM, gsz = (nM - fm) < WGM ? (nM - fm) : WGM;
        u.pm = fm + ((wgid % nig) % gsz); u.pn = (wgid % nig) / gsz; return true;
    }
    __device__ __forceinline__ void a_ready(const Unit&) const {}
    __device__ __forceinline__ void done(const Unit&) const {}
};

typedef float f32x2cv_t __attribute__((ext_vector_type(2))); typedef __bf16 bf16x2cv_t __attribute__((ext_vector_type(2)));
__device__ __forceinline__ unsigned cvt_pk_bf16(float lo, float hi) { const f32x2cv_t v = {lo, hi}; const bf16x2cv_t b = __builtin_convertvector(v, bf16x2cv_t); return __builtin_bit_cast(unsigned, b); }
typedef float f32x2 __attribute__((ext_vector_type(2)));
__device__ __forceinline__ float sigm(float x) { return __builtin_amdgcn_rcpf(1.0f + __expf(-x)); }
template <int ACT  > struct EpiBf {
    static constexpr bool PERM = true, AFTER_DRAIN = false;
    bf16_t* O; int ldc; size_t gstride;
    __device__ __forceinline__ void operator()(const f32x4 (&acc)[2][2][4][2], const Unit& u, int wr, int wc, int fr, int fq) const {
        const int row0 = u.pm * BM + wr * 64 + fr; int colt = u.pn * BM; bf16_t* base = O; int ld = ldc;
        if (gstride) { const int t = colt >> 9; colt &= 511; base += (size_t)t * gstride; ld = 512; }
        const int col0 = colt + wc * 32 + 8 * fq;
#pragma unroll
        for (int ai = 0; ai < 2; ++ai)
#pragma unroll
            for (int m = 0; m < 4; ++m) { bf16_t* rowp = base + (size_t)(row0 + ai * HALF + m * 16) * ld + col0;
#pragma unroll
                for (int bj = 0; bj < 2; ++bj) { f32x4 v0 = acc[ai][bj][m][0], v1 = acc[ai][bj][m][1];
                    if (ACT == 1) {
#pragma unroll
                        for (int i = 0; i < 4; ++i) { float a = fmaxf(v0[i], 0.f), b = fmaxf(v1[i], 0.f); v0[i] = a * a; v1[i] = b * b; } }
                    u32x4 w; w.x = cvt_pk_bf16(v0[0], v0[1]); w.y = cvt_pk_bf16(v0[2], v0[3]); w.z = cvt_pk_bf16(v1[0], v1[1]); w.w = cvt_pk_bf16(v1[2], v1[3]);
                    *(u32x4*)(rowp + bj * HALF) = w; } }
    }
};
struct EpiLR {
    static constexpr bool PERM = true, AFTER_DRAIN = false;
    bf16_t *s0, *s1, *s2, *s3, *s4; const float* w0; const float* a0;
    __device__ __forceinline__ void operator()(const f32x4 (&acc)[2][2][4][2], const Unit& u, int wr, int wc, int fr, int fq) const {
        const int row0 = u.pm * BM + wr * 64 + fr; const int colg = u.pn * BM; const int seg = colg >> 9; const int cb = colg & 511;
        bf16_t* base = seg == 0 ? s0 : seg == 1 ? s1 : seg == 2 ? s2 : seg == 3 ? s3 : s4;
        const int col0 = cb + wc * 32 + 8 * fq;
        const float* bsrc = seg < 2 ? w0 + seg * 512 : a0 + (seg & 1) * 512;
        const float sc = seg < 2 ? 0.6065306597f : 1.0f; const float bm = seg < 4 ? 1.f : 0.f; const bool act = seg < 4;
#pragma unroll
        for (int bj = 0; bj < 2; ++bj) {
            const f32x4 b0 = *(const f32x4*)(bsrc + col0 + bj * HALF) * bm, b1 = *(const f32x4*)(bsrc + col0 + bj * HALF + 4) * bm;
#pragma unroll
            for (int ai = 0; ai < 2; ++ai)
#pragma unroll
                for (int m = 0; m < 4; ++m) { bf16_t* rowp = base + (size_t)(row0 + ai * HALF + m * 16) * 512 + col0;
                    f32x4 v0 = acc[ai][bj][m][0] + b0, v1 = acc[ai][bj][m][1] + b1;
#pragma unroll
                    for (int i = 0; i < 4; ++i) { const float g0 = sc * sigm(v0[i]), g1 = sc * sigm(v1[i]); v0[i] = act ? g0 : v0[i]; v1[i] = act ? g1 : v1[i]; }
                    u32x4 w; w.x = cvt_pk_bf16(v0[0], v0[1]); w.y = cvt_pk_bf16(v0[2], v0[3]); w.z = cvt_pk_bf16(v1[0], v1[1]); w.w = cvt_pk_bf16(v1[2], v1[3]);
                    *(u32x4*)(rowp + bj * HALF) = w; __builtin_amdgcn_sched_barrier(0); }
        }
    }
};
struct EpiGate {
    static constexpr bool PERM = true, AFTER_DRAIN = false;
    const bf16_t* Pm; bf16_t* Mg;
    __device__ __forceinline__ void operator()(const f32x4 (&acc)[2][2][4][2], const Unit& u, int wr, int wc, int fr, int fq) const {
        const int row0 = u.pm * BM + wr * 64 + fr; const int ocol = u.pn * 64 + wc * 16 + fq * 4;
#pragma unroll
        for (int ai = 0; ai < 2; ++ai)
#pragma unroll
            for (int m = 0; m < 4; ++m) { const size_t row = (size_t)(row0 + ai * HALF + m * 16);
                float s0 = 0.f, s1 = 0.f, s2 = 0.f, s3 = 0.f;
#pragma unroll
                for (int bj = 0; bj < 2; ++bj)
#pragma unroll
                    for (int n = 0; n < 2; ++n) { const int br = bj * 2 + n;
                        const uint2 pw = *(const uint2*)(Pm + row * 4096 + br * 1024 + ocol);
                        const f32x4 a = acc[ai][bj][m][n];
                        s0 += sigm(a[0]) * __uint_as_float(pw.x << 16); s1 += sigm(a[1]) * __uint_as_float(pw.x & 0xffff0000u);
                        s2 += sigm(a[2]) * __uint_as_float(pw.y << 16); s3 += sigm(a[3]) * __uint_as_float(pw.y & 0xffff0000u); }
                uint2 o; o.x = cvt_pk_bf16(s0, s1); o.y = cvt_pk_bf16(s2, s3);
                *(uint2*)(Mg + row * 1024 + ocol) = o; }
    }
};
struct EpiResid {
    static constexpr bool PERM = true, AFTER_DRAIN = false;
    const float* om; const float* mt; float* nm; float* xmb; int g; int rlim;
    __device__ __forceinline__ void operator()(const f32x4 (&acc)[2][2][4][2], const Unit& u, int wr, int wc, int fr, int fq) const {
        const int row0 = u.pm * BM + wr * 64 + fr; const int col0 = u.pn * BM + wc * 32 + 8 * fq;
#pragma unroll
        for (int ai = 0; ai < 2; ++ai)
#pragma unroll
            for (int m = 0; m < 4; ++m) { const int r = row0 + ai * HALF + m * 16;
                if (r < rlim) {
                    const int mi = r - 16384;
                    float* dmeta = xmb + (size_t)(mi < 64 ? g * 64 + mi : ((mi >> 6) - 1) * 64 + (mi & 63)) * 1024;
                    const float* src = r < 16384 ? om + (size_t)r * 1024 : (mt ? mt + (size_t)(mi & 15) * 1024 : (const float*)dmeta);
                    float* dst = r < 16384 ? nm + (size_t)r * 1024 : dmeta;
#pragma unroll
                    for (int bj = 0; bj < 2; ++bj)
#pragma unroll
                        for (int n = 0; n < 2; ++n) { const int c = col0 + bj * HALF + 4 * n;
                            const f32x4 xo = *(const f32x4*)(src + c); *(f32x4*)(dst + c) = xo + acc[ai][bj][m][n]; } } }
    }
};
template <class Epi, class Sched, bool ALIGN_EPI = false, bool SP2 = false>
__device__ __forceinline__ void gemm_phase(PG8_LAS unsigned char* lds, const Gemm g, const Sched& S, const Epi& E, int wv) {
    const int tid = launder_tid(wv), wid = __builtin_amdgcn_readfirstlane(tid >> 6), lane = tid & 63, wr = wid >> 2, wc = wid & 3, fr = lane & 15, fq = lane >> 4;
    const int K = g.K, nt = K / BK;
    unsigned voffA[2], voffB[2];
#pragma unroll
    for (int i = 0; i < 2; ++i) { int R, C; stage_rc(tid * 16 + i * 8192, R, C); const int Rb = Epi::PERM ? ((R & ~31) + perm32(R & 31)) : R;
        voffA[i] = (unsigned)(R * K + C) * 2u; voffB[i] = (unsigned)(Rb * K + C) * 2u; }
    const size_t kstep = (size_t)(BK * 2);
    const size_t hstep = (size_t)HALF * K * 2;
    const size_t tstep = 2 * hstep;
    const unsigned ldsw = (unsigned)wid * 1024u;
    const int aoff = lds_byte(wr * 64 + fr, fq * 8), boff = lds_byte(wc * 32 + fr, fq * 8);
#define PG8_SA(b, h) (((b) * 2 + (h)) * HTB)
#define PG8_SB(b, h) ((4 + (b) * 2 + (h)) * HTB)
#define PG8_STAGE(bufoff, gbase, voff) do { _Pragma("unroll") for (int _i = 0; _i < 2; ++_i) \
        __builtin_amdgcn_global_load_lds((const unsigned*)((const char*)(gbase) + (voff)[_i]), (PG8_LAS unsigned*)(lds + (bufoff) + ldsw + _i * 8192), 16, 0, 0); } while (0)
#define PG8_LDA(dst, b, h) do { _Pragma("unroll") for (int m = 0; m < 4; ++m) _Pragma("unroll") for (int k = 0; k < 2; ++k) dst[m][k] = *(const PG8_LAS bf16x8*)(lds + PG8_SA(b, h) + aoff + m * 2048 + k * 1024); } while (0)
#define PG8_LDB(dst, b, h) do { _Pragma("unroll") for (int n = 0; n < 2; ++n) _Pragma("unroll") for (int k = 0; k < 2; ++k) dst[n][k] = *(const PG8_LAS bf16x8*)(lds + PG8_SB(b, h) + boff + n * 2048 + k * 1024); } while (0)
#define PG8_MMA(ai, bj, At, Bt) do { __builtin_amdgcn_s_setprio(1); _Pragma("unroll") for (int m = 0; m < 4; ++m) _Pragma("unroll") for (int n = 0; n < 2; ++n) _Pragma("unroll") for (int k = 0; k < 2; ++k) \
        acc[ai][bj][m][n] = __builtin_amdgcn_mfma_f32_16x16x32_bf16(Bt[n][k], At[m][k], acc[ai][bj][m][n], 0, 0, 0); __builtin_amdgcn_s_setprio(0); } while (0)
#define PG8_WAIT_V(n) asm volatile("s_waitcnt vmcnt(" #n ")" ::: "memory")
#define PG8_WAIT_L(n) asm volatile("s_waitcnt lgkmcnt(" #n ")" ::: "memory")
#define PG8_BAR __builtin_amdgcn_s_barrier()
#define PG8_SCHED __builtin_amdgcn_sched_barrier(0)
    Unit cur, nxt; int ui = 0;
    if (!S.next(0, cur)) return;
    f32x4 acc[2][2][4][2];
#pragma unroll
    for (int a = 0; a < 2; ++a)
#pragma unroll
        for (int b = 0; b < 2; ++b)
#pragma unroll
            for (int m = 0; m < 4; ++m)
#pragma unroll
                for (int n = 0; n < 2; ++n) { float z_ = 0.f; asm volatile("" : "+v"(z_)); acc[a][b][m][n] = (f32x4){z_, z_, z_, z_}; }
    bf16x8 At[4][2], B0[2][2], B1[2][2];
    const char* cA = (const char*)g.A + (g.pn_per_ab ? (size_t)(cur.pn / g.pn_per_ab) * g.ab_stride : (size_t)0) + (size_t)cur.pm * tstep; const char* cB = (const char*)g.Bt + (size_t)cur.pn * tstep;
    S.a_ready(cur);
    if constexpr (SP2) {
        PG8_STAGE(PG8_SB(0, 0), cB, voffB); PG8_STAGE(PG8_SB(0, 1), cB + hstep, voffB); PG8_STAGE(PG8_SA(0, 0), cA, voffA); PG8_STAGE(PG8_SA(0, 1), cA + hstep, voffA);
        if (wr == 1) PG8_BAR;
        PG8_WAIT_V(2); PG8_BAR;
        PG8_STAGE(PG8_SB(1, 0), cB + kstep, voffB); PG8_STAGE(PG8_SA(1, 0), cA + kstep, voffA); PG8_STAGE(PG8_SB(1, 1), cB + hstep + kstep, voffB);
        PG8_WAIT_V(6); PG8_BAR;
    } else {
        PG8_STAGE(PG8_SB(0, 0), cB, voffB); PG8_STAGE(PG8_SA(0, 0), cA, voffA); PG8_STAGE(PG8_SB(0, 1), cB + hstep, voffB); PG8_STAGE(PG8_SA(0, 1), cA + hstep, voffA);
        if (wr == 1) PG8_BAR;
        PG8_WAIT_V(4); PG8_BAR;
        PG8_STAGE(PG8_SB(1, 0), cB + kstep, voffB); PG8_STAGE(PG8_SA(1, 0), cA + kstep, voffA); PG8_STAGE(PG8_SB(1, 1), cB + hstep + kstep, voffB);
        PG8_WAIT_V(6); PG8_BAR;
    }
    for (;;) {
        const bool has_next = S.next(ui + 1, nxt);
        const char* nA = has_next ? (const char*)g.A + (g.pn_per_ab ? (size_t)(nxt.pn / g.pn_per_ab) * g.ab_stride : (size_t)0) + (size_t)nxt.pm * tstep : cA; const char* nB = has_next ? (const char*)g.Bt + (size_t)nxt.pn * tstep : cB;
#pragma unroll 1
        for (int t = 0; t < nt; t += 2) {
            const bool last = (t == nt - 2);
            const char* a1 = cA + (size_t)(t + 1) * kstep;
            const char* a2 = last ? nA : cA + (size_t)(t + 2) * kstep; const char* b2 = last ? nB : cB + (size_t)(t + 2) * kstep;
            const char* a3 = a2 + kstep; const char* b3 = b2 + kstep;
            if (last && has_next) S.a_ready(nxt);
            if constexpr (SP2) {
            PG8_LDB(B0, 0, 0); PG8_LDB(B1, 0, 1); PG8_SCHED; PG8_LDA(At, 0, 0); PG8_STAGE(PG8_SA(1, 1), a1 + hstep, voffA);
            PG8_WAIT_V(8); PG8_WAIT_L(0); PG8_BAR; PG8_MMA(0, 0, At, B0); PG8_MMA(0, 1, At, B1); PG8_BAR; PG8_SCHED;
            PG8_LDA(At, 0, 1); PG8_STAGE(PG8_SB(0, 0), b2, voffB); PG8_STAGE(PG8_SB(0, 1), b2 + hstep, voffB); PG8_STAGE(PG8_SA(0, 0), a2, voffA);
            PG8_WAIT_V(8); PG8_WAIT_L(0); PG8_BAR; PG8_MMA(1, 0, At, B0); PG8_MMA(1, 1, At, B1); PG8_BAR; PG8_SCHED;
            PG8_LDB(B0, 1, 0); PG8_LDB(B1, 1, 1); PG8_SCHED; PG8_LDA(At, 1, 0); PG8_STAGE(PG8_SA(0, 1), a2 + hstep, voffA);
            PG8_WAIT_V(8); PG8_WAIT_L(0); PG8_BAR; PG8_MMA(0, 0, At, B0); PG8_MMA(0, 1, At, B1); PG8_BAR; PG8_SCHED;
            PG8_LDA(At, 1, 1); PG8_STAGE(PG8_SB(1, 0), b3, voffB); PG8_STAGE(PG8_SB(1, 1), b3 + hstep, voffB); PG8_STAGE(PG8_SA(1, 0), a3, voffA);
            PG8_WAIT_V(8); PG8_WAIT_L(0); PG8_BAR; PG8_MMA(1, 0, At, B0); PG8_MMA(1, 1, At, B1); PG8_BAR; PG8_SCHED;
            } else {
            PG8_LDB(B0, 0, 0); PG8_SCHED; PG8_LDA(At, 0, 0); PG8_STAGE(PG8_SA(1, 1), a1 + hstep, voffA);
            PG8_WAIT_L(8); PG8_BAR; PG8_WAIT_L(0); PG8_MMA(0, 0, At, B0); PG8_BAR; PG8_SCHED;
            PG8_LDB(B1, 0, 1); PG8_STAGE(PG8_SB(0, 0), b2, voffB);
            PG8_BAR; PG8_WAIT_L(0); PG8_MMA(0, 1, At, B1); PG8_BAR;
            PG8_LDA(At, 0, 1); PG8_STAGE(PG8_SA(0, 0), a2, voffA);
            PG8_BAR; PG8_WAIT_L(0); PG8_MMA(1, 0, At, B0); PG8_BAR; PG8_SCHED;
            PG8_STAGE(PG8_SB(0, 1), b2 + hstep, voffB);
            PG8_WAIT_V(6); PG8_BAR; PG8_MMA(1, 1, At, B1); PG8_BAR;
            PG8_LDB(B0, 1, 0); PG8_SCHED; PG8_LDA(At, 1, 0); PG8_STAGE(PG8_SA(0, 1), a2 + hstep, voffA);
            PG8_WAIT_L(8); PG8_BAR; PG8_WAIT_L(0); PG8_MMA(0, 0, At, B0); PG8_BAR; PG8_SCHED;
            PG8_LDB(B1, 1, 1); PG8_STAGE(PG8_SB(1, 0), b3, voffB);
            PG8_BAR; PG8_WAIT_L(0); PG8_MMA(0, 1, At, B1); PG8_BAR;
            PG8_LDA(At, 1, 1); PG8_STAGE(PG8_SA(1, 0), a3, voffA);
            PG8_BAR; PG8_WAIT_L(0); PG8_MMA(1, 0, At, B0); PG8_BAR; PG8_SCHED;
            PG8_STAGE(PG8_SB(1, 1), b3 + hstep, voffB);
            PG8_WAIT_V(6); PG8_BAR; PG8_MMA(1, 1, At, B1); PG8_BAR;
            }
        }
        if constexpr (ALIGN_EPI) { if (wr == 0) PG8_BAR; }
        if constexpr (!Epi::AFTER_DRAIN) { E(acc, cur, wr, wc, fr, fq); S.done(cur); }
        if (!has_next) break;
#pragma unroll
        for (int a = 0; a < 2; ++a)
#pragma unroll
            for (int b = 0; b < 2; ++b)
#pragma unroll
                for (int m = 0; m < 4; ++m)
#pragma unroll
                    for (int n = 0; n < 2; ++n) { float z_ = 0.f; asm volatile("" : "+v"(z_)); acc[a][b][m][n] = (f32x4){z_, z_, z_, z_}; }
        cur = nxt; cA = nA; cB = nB; ++ui;
        if constexpr (ALIGN_EPI) { if (wr == 1) PG8_BAR; }
    }
    PG8_WAIT_V(0);
    if constexpr (!ALIGN_EPI) { if (wr == 0) PG8_BAR; }
    PG8_BAR;
    if constexpr (Epi::AFTER_DRAIN) { E.fused(acc, cur, wr, wc, fr, fq, lds, wid, lane); S.done(cur); }
#undef PG8_SA
#undef PG8_SB
#undef PG8_STAGE
#undef PG8_LDA
#undef PG8_LDB
#undef PG8_MMA
#undef PG8_WAIT_V
#undef PG8_WAIT_L
#undef PG8_BAR
#undef PG8_SCHED
}
}
typedef unsigned short bf16_t;
typedef short bf16x8 __attribute__((ext_vector_type(8)));
typedef float f32x4 __attribute__((ext_vector_type(4)));
typedef float f32x16 __attribute__((ext_vector_type(16)));
constexpr int LSEQ = 4112, TREAL = 16384, TG = 16448, TGP = 16640, NGRP = 3;
constexpr size_t SLOT_E = (size_t)TGP * 512;
constexpr size_t SLOT_B = SLOT_E * 2;
constexpr size_t MiB = 1u << 20;
constexpr size_t WS_XMETA = 1 * MiB, WS_DECAY = 2 * MiB, WS_SIDE = 3 * MiB + 512 * 1024, WS_W = 5 * MiB, WS_SLOTS = 53 * MiB;
constexpr size_t WS_NEED = 512 * MiB;
static_assert(WS_SLOTS + 25 * SLOT_B + (size_t)(16448 - 11408) * 8960 <= 512 * MiB, "record tail fits the workspace");
constexpr size_t WO_IN = 0, WO_G = 7864320, WO_BP = 12058624, WO_OUT = 14155776, WO_1 = 15204352, WO_2 = 19398656, WO_LR = 23592960;
constexpr int LDS_BYTES = 140 * 1024;
enum { I_XP = 0, I_XS, I_META, I_NMIX, I_WIN, I_LBL, I_ONORM, I_CONV, I_QN, I_KN, I_LAM, I_SUBLN, I_MU, I_W0, I_W2, I_A0, I_A2, I_G2, I_KK, I_KA, I_RK, I_LNG, I_LNB, I_WG, I_BP, I_WOUT, I_NMLP, I_W1, I_W2M };
struct Params { const float* in[29]; float* out; unsigned char* ws; };
#define GPTR(T, p) ((T*)(__attribute__((address_space(1))) T*)(p))
typedef const __attribute__((address_space(4))) Params* KParamsPtr;
typedef unsigned u32x4g_t __attribute__((ext_vector_type(4)));
#define GLD16(p) (*(const __attribute__((address_space(1))) u32x4g_t*)(p))
DEV KParamsPtr kparams() { KParamsPtr p = (KParamsPtr)__builtin_amdgcn_kernarg_segment_ptr(); asm volatile("" : "+s"(p)); return p; }
DEV Params load_params() { KParamsPtr p = kparams(); Params r;
#pragma unroll
    for (int i = 0; i < 29; ++i) r.in[i] = GPTR(const float, p->in[i]);
    r.out = GPTR(float, p->out); r.ws = p->ws; return r; }
DEV unsigned zero_u() { unsigned z = 0u; asm volatile("" : "+v"(z)); return z; }

#define ROWPRO const int tid_ = launder_tid(wv); const int lane = tid_ & 63; const int gw = bid * 8 + __builtin_amdgcn_readfirstlane(tid_ >> 6); const int ngw = nb * 8;
DEV float bf2f(unsigned short u) { return __uint_as_float((unsigned)u << 16); }
DEV unsigned pk2(float lo, float hi) { return pg8::cvt_pk_bf16(lo, hi); }
DEV void unpack8(const uint4 w, float* f) {
    f[0] = __uint_as_float(w.x << 16); f[1] = __uint_as_float(w.x & 0xffff0000u); f[2] = __uint_as_float(w.y << 16); f[3] = __uint_as_float(w.y & 0xffff0000u);
    f[4] = __uint_as_float(w.z << 16); f[5] = __uint_as_float(w.z & 0xffff0000u); f[6] = __uint_as_float(w.w << 16); f[7] = __uint_as_float(w.w & 0xffff0000u); }
DEV uint4 pack8(const float* f) { uint4 o; o.x = pk2(f[0], f[1]); o.y = pk2(f[2], f[3]); o.z = pk2(f[4], f[5]); o.w = pk2(f[6], f[7]); return o; }
DEV bf16_t* slotp(const Params& P, int s) { return GPTR(bf16_t, P.ws + WS_SLOTS + (size_t)s * SLOT_B); }
DEV int row_of(int sl, int p) { return p >= 16 ? sl * 4096 + p - 16 : TREAL + sl * 16 + p; }
DEV void pos_of(int r, int& sl, int& p) { if (r < TREAL) { sl = r >> 12; p = (r & 4095) + 16; } else { const int m = r - TREAL; sl = m >> 4; p = m & 15; } }
DEV float wave_sum(float v) {
#pragma unroll
    for (int o = 1; o < 64; o <<= 1) v += __shfl_xor(v, o);
    return v; }
DEV float red8(float v) { v += __shfl_xor(v, 1); v += __shfl_xor(v, 2); v += __shfl_xor(v, 4); return v; }
DEV f32x4 mfma16(bf16x8 a, bf16x8 b, f32x4 c) { return __builtin_amdgcn_mfma_f32_16x16x32_bf16(a, b, c, 0, 0, 0); }
DEV f32x16 mfma32(bf16x8 a, bf16x8 b, f32x16 c) { return __builtin_amdgcn_mfma_f32_32x32x16_bf16(a, b, c, 0, 0, 0); }
DEV const float* x_in_row(const Params& P, int g, int r) {
    if (r < TREAL) return (g < 2 ? P.in[I_XP] + (size_t)g * TREAL * 1024 : P.in[I_XS]) + (size_t)r * 1024;
    return P.in[I_META] + (size_t)((r - TREAL) & 15) * 1024; }
DEV float* x_cur_row(const Params& P, int g, int r) {
    if (r < TREAL) return P.out + ((size_t)g * TREAL + r) * 1024;
    const int m = r - TREAL;
    return GPTR(float, P.ws + WS_XMETA) + (size_t)(m < 64 ? g * 64 + m : ((m >> 6) - 1) * 64 + (m & 63)) * 1024; }

DEV int gate_row(int n) { const int br = n >> 10, c = n & 1023, pn = c >> 6, oc = c & 63, wc = oc >> 4, fq = (oc >> 2) & 3, i = oc & 3; return pn * 256 + (br >> 1) * 128 + wc * 32 + fq * 8 + (br & 1) * 4 + i; }
template <int MODE> DEV void wt_items(const float* __restrict__ W, int K, int N, bf16_t* WT, int row_off, float* scr, int gw, int ngw, int lane) {
    const int nblk = N >> 5, items = (K >> 6) * nblk;
    for (int it = gw; it < items; it += ngw) {
        const int kb = it / nblk, nbk = it - kb * nblk, k0 = 64 * kb, n0 = 32 * nbk;
#pragma unroll 8
        for (int i = 0; i < 32; ++i) { const int kk = 2 * i + (lane >> 5); scr[kk * 33 + (lane & 31)] = W[(size_t)(k0 + kk) * N + n0 + (lane & 31)]; }
        asm volatile("s_waitcnt lgkmcnt(0)" ::: "memory");
        const int c = lane & 7;
#pragma unroll
        for (int j = 0; j < 4; ++j) { const int n = (lane >> 3) + 8 * j; const float* sp = scr + (8 * c) * 33 + n;
            uint4 o; o.x = pk2(sp[0 * 33], sp[1 * 33]); o.y = pk2(sp[2 * 33], sp[3 * 33]); o.z = pk2(sp[4 * 33], sp[5 * 33]); o.w = pk2(sp[6 * 33], sp[7 * 33]);
            const int dr = MODE == 1 ? gate_row(n0 + n) : n0 + n + row_off;
            *(uint4*)(WT + (size_t)dr * K + k0 + 8 * c) = o; }
        asm volatile("s_waitcnt lgkmcnt(0)" ::: "memory");
    }
}
DEV void phase_weights(const Params& P0, int layer, unsigned char* lds, int bid, int nb, int wv) {
    Params P = load_params(); asm volatile("" : "+s"(P.ws));
    const int tid = launder_tid(wv), lane = tid & 63, w = __builtin_amdgcn_readfirstlane(tid >> 6);
    const int gtid = bid * 512 + tid, gth = nb * 512, gw = bid * 8 + w, ngw = nb * 8;
    float* scr = (float*)(lds + w * 8448);
    bf16_t* W = GPTR(bf16_t, P.ws + WS_W);
    wt_items<0>(P.in[I_WIN] + (size_t)layer * 1024 * 7552, 1024, 7552, W + WO_IN, 0, scr, gw, ngw, lane);
    for (int it = gtid; it < 128 * 128; it += gth) { const unsigned z = zero_u(); *(uint4*)(W + WO_IN + (size_t)7552 * 1024 + (size_t)it * 8) = make_uint4(z, z, z, z); }
    wt_items<1>(P.in[I_WG] + (size_t)layer * 1024 * 4096, 1024, 4096, W + WO_G, 0, scr, gw, ngw, lane);
    for (int n = 0; n < 4; ++n) wt_items<0>(P.in[I_BP] + (size_t)(layer * 4 + n) * 512 * 1024, 512, 1024, W + WO_BP, n * 1024, scr, gw, ngw, lane);
    wt_items<0>(P.in[I_WOUT] + (size_t)layer * 1024 * 1024, 1024, 1024, W + WO_OUT, 0, scr, gw, ngw, lane);
    wt_items<0>(P.in[I_W1] + (size_t)layer * 1024 * 4096, 1024, 4096, W + WO_1, 0, scr, gw, ngw, lane);
    wt_items<0>(P.in[I_W2M] + (size_t)layer * 4096 * 1024, 4096, 1024, W + WO_2, 0, scr, gw, ngw, lane);
    for (int it = gtid; it < 2560 * 48; it += gth) {
        const int row = it / 48, k8 = it - row * 48, seg = row >> 9, c = row & 511, k0 = k8 * 8;
        float v[8];
#pragma unroll
        for (int j = 0; j < 8; ++j) { const int k = k0 + j; float x = 0.f;
            if (seg == 0) { if (k < 64) x = P.in[I_W2][((size_t)(layer * 2 + 0) * 64 + k) * 512 + c]; }
            else if (seg == 1) { if (k >= 64 && k < 128) x = P.in[I_W2][((size_t)(layer * 2 + 1) * 64 + (k - 64)) * 512 + c]; }
            else if (seg == 2) { if (k >= 128 && k < 192) x = P.in[I_A2][((size_t)(layer * 2 + 0) * 64 + (k - 128)) * 512 + c]; }
            else if (seg == 3) { if (k >= 192 && k < 256) x = P.in[I_A2][((size_t)(layer * 2 + 1) * 64 + (k - 192)) * 512 + c]; }
            else { if (k >= 256) x = P.in[I_G2][((size_t)layer * 128 + (k - 256)) * 512 + c]; }
            v[j] = x; }
        *(uint4*)(W + WO_LR + (size_t)row * 384 + k0) = pack8(v);
    }
}

DEV void phase_rmsnorm(const Params& P0, int g, bool src_in, int gain_idx, int layer, int nrows, int nvalid, int bid, int nb, int wv) {
    Params P = load_params(); asm volatile("" : "+s"(P.ws));
    ROWPRO
    const float* gain = P.in[gain_idx] + layer * 1024;
    bf16_t* H = slotp(P, 0);
    for (int r = gw; r < nrows; r += ngw) {
        uint2* o8 = (uint2*)(H + (size_t)r * 1024) + lane;
        if (r >= nvalid) {
#pragma unroll
            for (int j = 0; j < 4; ++j) { const unsigned z = zero_u(); o8[64 * j] = make_uint2(z, z); }
            continue; }
        const f32x4* xr = (const f32x4*)(src_in ? x_in_row(P, g, r) : (const float*)x_cur_row(P, g, r)) + lane;
        f32x4 v[4]; float s = 0.f;
#pragma unroll
        for (int j = 0; j < 4; ++j) { v[j] = xr[64 * j]; s += (v[j].x * v[j].x + v[j].y * v[j].y) + (v[j].z * v[j].z + v[j].w * v[j].w); }
        const float rs = rsqrtf(wave_sum(s) * (1.f / 1024.f) + 1e-6f);
#pragma unroll
        for (int j = 0; j < 4; ++j) { const f32x4 gg = *((const f32x4*)gain + lane + 64 * j);
            o8[64 * j] = make_uint2(pk2(v[j].x * rs * gg.x, v[j].y * rs * gg.y), pk2(v[j].z * rs * gg.z, v[j].w * rs * gg.w)); }
    }
}
DEV void phase_da_prep(const Params& P0, int layer, int bid, int nb, int wv) {
    Params P = load_params(); asm volatile("" : "+s"(P.ws));
    ROWPRO
    const float inv8[8] = {1.0f, 0.19392274474868576f, 0.03760603093086393f, 0.007292664737217109f, 0.001414213562373095f, 0.0002742481756762073f, 5.318295896944988e-05f, 1.031338537721246e-05f};
    const int d0 = (lane & 7) * 8;
    float gq[8], gk[8];
#pragma unroll
    for (int j = 0; j < 8; ++j) { gq[j] = P.in[I_QN][layer * 64 + d0 + j]; gk[j] = P.in[I_KN][layer * 64 + d0 + j]; }
    for (int r = gw; r < TG; r += ngw) {
        int sl, p; pos_of(r, sl, p);
        float cs[8], sn[8];
#pragma unroll
        for (int j = 0; j < 8; ++j) { const float ang = (float)p * inv8[j]; double a = (double)ang; a -= 6.283185307179586 * __builtin_rint(a * 0.15915494309189535); const float rr = (float)a; cs[j] = __cosf(rr); sn[j] = __sinf(rr); }
#pragma unroll
        for (int which = 0; which < 2; ++which) {
            uint4* ptr = (uint4*)(slotp(P, 10 + which) + (size_t)r * 512) + lane;
            float f[8]; unpack8(*ptr, f);
            float ss = 0.f;
#pragma unroll
            for (int j = 0; j < 8; ++j) ss += f[j] * f[j];
            ss = red8(ss);
            const float rs = rsqrtf(ss * (1.f / 64.f) + 1e-6f);
#pragma unroll
            for (int j = 0; j < 8; ++j) f[j] = f[j] * rs * (which == 0 ? gq[j] : gk[j]);
#pragma unroll
            for (int j = 0; j < 8; ++j) { const float pr = __shfl_xor(f[j], 1);
                if ((lane & 7) == 0) f[j] = f[j] * cs[j] - pr * sn[j];
                else if ((lane & 7) == 1) f[j] = f[j] * cs[j] + pr * sn[j]; }
            if (which == 0) {
#pragma unroll
                for (int j = 0; j < 8; ++j) f[j] *= 0.18033688011112042f; }
            *ptr = pack8(f);
        }
    }
}
DEV void phase_conv(const Params& P0, int layer, int bid, int nb, int wv) {
    Params P = load_params(); asm volatile("" : "+s"(P.ws));
    ROWPRO
    const int c0 = lane * 8;
    float w0[8], w1[8], w2[8];
#pragma unroll
    for (int j = 0; j < 8; ++j) { w0[j] = P.in[I_CONV][(layer * 3 + 0) * 512 + c0 + j]; w1[j] = P.in[I_CONV][(layer * 3 + 1) * 512 + c0 + j]; w2[j] = P.in[I_CONV][(layer * 3 + 2) * 512 + c0 + j]; }
    const bf16_t* SB = slotp(P, 7); const bf16_t* SC = slotp(P, 8); const bf16_t* SH = slotp(P, 9); bf16_t* Y = slotp(P, 3);
    for (int r = gw; r < TG; r += ngw) {
        int sl, p; pos_of(r, sl, p);
        float acc[8], a[8], b[8];
        unpack8(*((const uint4*)(SC + (size_t)r * 512) + lane), a); unpack8(*((const uint4*)(SH + (size_t)r * 512) + lane), b);
#pragma unroll
        for (int j = 0; j < 8; ++j) acc[j] = a[j] * b[j] * w1[j];
        if (p > 0) { const int rp = row_of(sl, p - 1);
            unpack8(*((const uint4*)(SC + (size_t)rp * 512) + lane), a); unpack8(*((const uint4*)(SH + (size_t)rp * 512) + lane), b);
#pragma unroll
            for (int j = 0; j < 8; ++j) acc[j] += a[j] * b[j] * w0[j]; }
        if (p < LSEQ - 1) { const int rn = row_of(sl, p + 1);
            unpack8(*((const uint4*)(SC + (size_t)rn * 512) + lane), a); unpack8(*((const uint4*)(SH + (size_t)rn * 512) + lane), b);
#pragma unroll
            for (int j = 0; j < 8; ++j) acc[j] += a[j] * b[j] * w2[j]; }
        unpack8(*((const uint4*)(SB + (size_t)r * 512) + lane), a);
#pragma unroll
        for (int j = 0; j < 8; ++j) acc[j] *= a[j];
        *((uint4*)(Y + (size_t)r * 512) + lane) = pack8(acc);
    }
}
DEV void phase_rw_prep(const Params& P0, int layer, int bid, int nb, int wv) {
    Params P = load_params(); asm volatile("" : "+s"(P.ws));
    ROWPRO
    const float* mu = P.in[I_MU] + (size_t)layer * 1920;
    for (int r = gw; r < TG; r += ngw) {
        int sl, p; pos_of(r, sl, p);
        const int rp = p > 0 ? row_of(sl, p - 1) : -1, rn = p < LSEQ - 1 ? row_of(sl, p + 1) : -1;
#pragma unroll
        for (int grp = 0; grp < 4; ++grp) {
            if (grp == 3 && lane >= 48) break;
            const int c0 = (grp < 3 ? grp * 512 : 1536) + lane * 8;
            const bf16_t* src = slotp(P, 13 + (c0 >> 9)) + (c0 & 511);
            float u[8], up[8], un[8], xm[8];
            unpack8(*(const uint4*)(src + (size_t)r * 512), u);
            if (rp >= 0) unpack8(*(const uint4*)(src + (size_t)rp * 512), up); else {
#pragma unroll
                for (int j = 0; j < 8; ++j) up[j] = 0.f; }
            if (rn >= 0) unpack8(*(const uint4*)(src + (size_t)rn * 512), un); else {
#pragma unroll
                for (int j = 0; j < 8; ++j) un[j] = 0.f; }
#pragma unroll
            for (int j = 0; j < 8; ++j) xm[j] = u[j] + mu[c0 + j] * (0.5f * (up[j] + un[j]) - u[j]);
            if (grp < 3) {
                *((uint4*)(slotp(P, 17 + grp) + (size_t)r * 512) + lane) = pack8(xm);
                if (grp == 1) {
                    float kk[8], ss = 0.f;
#pragma unroll
                    for (int j = 0; j < 8; ++j) { kk[j] = xm[j] * P.in[I_KK][layer * 512 + c0 - 512 + j]; ss += kk[j] * kk[j]; }
                    ss = red8(ss);
                    const float inv = 1.0f / fmaxf(sqrtf(ss), 1e-12f);
#pragma unroll
                    for (int j = 0; j < 8; ++j) kk[j] *= inv;
                    *((uint4*)(slotp(P, 20) + (size_t)r * 512) + lane) = pack8(kk); }
            } else {
                const int a0 = lane * 8;
                float o[8];
#pragma unroll
                for (int j = 0; j < 8; ++j) { const float x = xm[j];
                    if (a0 < 128) { const float e = __expf(2.f * x); o[j] = 1.f - 2.f / (e + 1.f); }
                    else if (a0 < 256) o[j] = x;
                    else o[j] = 1.f / (1.f + __expf(-x)); }
                *((uint4*)(slotp(P, 21) + (size_t)r * 384) + lane) = pack8(o);
            }
        }
    }
    for (int r = TG + gw; r < TGP; r += ngw) if (lane < 48) { const unsigned z = zero_u(); *((uint4*)(slotp(P, 21) + (size_t)r * 384) + lane) = make_uint4(z, z, z, z); }
}
DEV void phase_rw_post(const Params& P0, int layer, int g, int nrows, int bid, int nb, int wv) {
    Params P = load_params(); asm volatile("" : "+s"(P.ws));
    ROWPRO
    const int c0 = lane * 8;
    float ka[8], rk[8], lg[8], lb[8];
#pragma unroll
    for (int j = 0; j < 8; ++j) { ka[j] = P.in[I_KA][layer * 512 + c0 + j]; rk[j] = P.in[I_RK][layer * 512 + c0 + j]; lg[j] = P.in[I_LNG][layer * 512 + c0 + j]; lb[j] = P.in[I_LNB][layer * 512 + c0 + j]; }
    for (int r = gw; r < nrows; r += ngw) {
        float of[8], ob[8], o[8];
        unpack8(*((const uint4*)(slotp(P, 15) + (size_t)r * 512) + lane), of); unpack8(*((const uint4*)(slotp(P, 16) + (size_t)r * 512) + lane), ob);
        float s = 0.f;
#pragma unroll
        for (int j = 0; j < 8; ++j) { o[j] = of[j] + ob[j]; s += o[j]; }
        const float mean = red8(s) * (1.f / 64.f);
        float q = 0.f;
#pragma unroll
        for (int j = 0; j < 8; ++j) { o[j] -= mean; q += o[j] * o[j]; }
        const float rs = rsqrtf(red8(q) * (1.f / 64.f) + 64e-5f);
        float rr[8], kk[8], vv[8], af[8], ab[8], gg[8];
        unpack8(*((const uint4*)(slotp(P, 17) + (size_t)r * 512) + lane), rr); unpack8(*((const uint4*)(slotp(P, 18) + (size_t)r * 512) + lane), kk);
        unpack8(*((const uint4*)(slotp(P, 19) + (size_t)r * 512) + lane), vv); unpack8(*((const uint4*)(slotp(P, 24) + (size_t)r * 512) + lane), af);
        unpack8(*((const uint4*)(slotp(P, 13) + (size_t)r * 512) + lane), ab); unpack8(*((const uint4*)(slotp(P, 14) + (size_t)r * 512) + lane), gg);
        float bs = 0.f;
#pragma unroll
        for (int j = 0; j < 8; ++j) { const float kd = kk[j] * (2.f + (af[j] + ab[j] - 2.f) * ka[j]); bs += rr[j] * kd * rk[j]; }
        bs = red8(bs);
        float y[8];
#pragma unroll
        for (int j = 0; j < 8; ++j) y[j] = (o[j] * rs * lg[j] + lb[j] + bs * vv[j]) * gg[j];
        const uint4 yv = pack8(y);
        *((uint4*)(slotp(P, 5) + (size_t)r * 512) + lane) = yv;
        if (layer == 0 && g < 2 && r >= TREAL) {
            bf16_t* sd = GPTR(bf16_t, P.ws + WS_SIDE) + (size_t)g * 4 * 64 * 512 + (size_t)(r - TREAL) * 512;
#pragma unroll
            for (int k = 0; k < 3; ++k) *((uint4*)(sd + (size_t)k * 64 * 512) + lane) = *((const uint4*)(slotp(P, 2 + k) + (size_t)r * 512) + lane);
            *((uint4*)(sd + (size_t)3 * 64 * 512) + lane) = yv; }
    }
    if (layer == 0 && g == 2) {
        for (int m2 = gw; m2 < 128; m2 += ngw) { const bf16_t* sd = GPTR(const bf16_t, P.ws + WS_SIDE) + (size_t)(m2 >> 6) * 4 * 64 * 512 + (size_t)(m2 & 63) * 512;
#pragma unroll
            for (int k = 0; k < 4; ++k) *((uint4*)(slotp(P, 2 + k) + (size_t)(TG + m2) * 512) + lane) = *((const uint4*)(sd + (size_t)k * 64 * 512) + lane); }
    }
}
DEV void hg_gate(float x, float lbv, float& lg, float& kk) {
    const float e = __expf(-fabsf(x)); const float sp = 1.f / (1.f + e);
    const float s = x >= 0.f ? sp : e * sp, s1 = x >= 0.f ? e * sp : sp;
    const float f = fmaxf(lbv, 1e-20f) + (1.f - lbv) * s;
    lg = __logf(f); kk = (1.f - lbv) * s1; }
DEV float hg_lb(const Params& P, int layer, int dir, int col) {
    if (layer == 0) return 0.f;
    const float a = P.in[I_LBL][(dir * 2 + 0) * 512 + col], b = P.in[I_LBL][(dir * 2 + 1) * 512 + col];
    return 1.f / (1.f + __expf(a - b)); }
DEV int hg_row(int sl, int c, int j, bool& valid) { if (c == 0) { valid = j < 16; return TREAL + sl * 16 + j; } valid = true; return sl * 4096 + (c - 1) * 64 + j; }
DEV void hg_cumsum(float* Lb, float* Bt, float* Seg, int dir, int tid) {
    const int ch = tid & 127, seg = tid >> 7;
    float v[16];
#pragma unroll
    for (int i = 0; i < 16; ++i) v[i] = Lb[(seg * 16 + i) * 128 + ch];
    if (dir == 0) {
#pragma unroll
        for (int i = 1; i < 16; ++i) v[i] += v[i - 1];
        Seg[seg * 128 + ch] = v[15];
    } else {
#pragma unroll
        for (int i = 14; i >= 0; --i) v[i] += v[i + 1];
        Seg[seg * 128 + ch] = v[0];
    }
    __syncthreads();
    const float s0 = Seg[ch], s1 = Seg[128 + ch], s2 = Seg[256 + ch], s3 = Seg[384 + ch];
    float off;
    if (dir == 0) off = seg == 0 ? 0.f : seg == 1 ? s0 : seg == 2 ? s0 + s1 : s0 + s1 + s2;
    else off = seg == 3 ? 0.f : seg == 2 ? s3 : seg == 1 ? s3 + s2 : s3 + s2 + s1;
#pragma unroll
    for (int i = 0; i < 16; ++i) Lb[(seg * 16 + i) * 128 + ch] = v[i] + off;
    if (seg == 0) Bt[ch] = (s0 + s1) + (s2 + s3);
}
DEV void phase_hg1(const Params& P0, int layer, unsigned char* lds, int bid, int nb, int wv) {
    Params P = load_params(); asm volatile("" : "+s"(P.ws));
    float* Lb = (float*)lds; bf16_t* KlT = (bf16_t*)(lds + 32768); bf16_t* VT = (bf16_t*)(lds + 32768 + 18432); float* Bt = (float*)(lds + 69632); float* Seg = (float*)(lds + 70656);
    bf16_t* X = slotp(P, 17); float* DC = GPTR(float, P.ws + WS_DECAY);
    const int tid = launder_tid(wv), lane = tid & 63, w = __builtin_amdgcn_readfirstlane(tid >> 6), j = tid >> 3, c0 = (tid & 7) * 16, l15 = lane & 15, quad = lane >> 4;
    for (int unit = bid; unit < 32 * 65; unit += nb) {
        const int chain = unit / 65, c = unit - chain * 65, sl = chain >> 3, head = (chain >> 1) & 3, dir = chain & 1;
        bool valid; const int r = hg_row(sl, c, j, valid);
        float lg[16], kk[16]; uint4 vv[2] = {make_uint4(0, 0, 0, 0), make_uint4(0, 0, 0, 0)};
        if (valid) {
            float fr[16];
            const uint4* fp = (const uint4*)(slotp(P, 3 + dir) + (size_t)r * 512 + head * 128 + c0);
            unpack8(fp[0], fr); unpack8(fp[1], fr + 8);
            const uint4* vp = (const uint4*)(slotp(P, 5) + (size_t)r * 512 + head * 128 + c0); vv[0] = vp[0]; vv[1] = vp[1];
#pragma unroll
            for (int e = 0; e < 16; ++e) hg_gate(fr[e], hg_lb(P, layer, dir, head * 128 + c0 + e), lg[e], kk[e]);
        } else {
#pragma unroll
            for (int e = 0; e < 16; ++e) { lg[e] = 0.f; kk[e] = 0.f; } }
#pragma unroll
        for (int e = 0; e < 16; e += 4) *(f32x4*)(Lb + j * 128 + c0 + e) = (f32x4){lg[e], lg[e + 1], lg[e + 2], lg[e + 3]};
        __syncthreads();
        hg_cumsum(Lb, Bt, Seg, dir, tid);
        __syncthreads();
        float vf[16]; unpack8(vv[0], vf); unpack8(vv[1], vf + 8);
#pragma unroll
        for (int e = 0; e < 16; ++e) { const float kl = kk[e] * __expf(Bt[c0 + e] - Lb[j * 128 + c0 + e]);
            KlT[(c0 + e) * 72 + j] = (bf16_t)(pk2(kl, 0.f) & 0xffffu); VT[(c0 + e) * 72 + j] = (bf16_t)(__float_as_uint(vf[e]) >> 16); }
        if (tid < 128) DC[(size_t)(chain * 65 + c) * 128 + tid] = __expf(Bt[tid]);
        __syncthreads();
        f32x4 acc[8];
#pragma unroll
        for (int ct = 0; ct < 8; ++ct) acc[ct] = (f32x4){0.f, 0.f, 0.f, 0.f};
#pragma unroll
        for (int ks = 0; ks < 2; ++ks) { const bf16x8 a = *(const bf16x8*)(VT + (w * 16 + l15) * 72 + ks * 32 + quad * 8);
#pragma unroll
            for (int ct = 0; ct < 8; ++ct) { const bf16x8 b = *(const bf16x8*)(KlT + (ct * 16 + l15) * 72 + ks * 32 + quad * 8); acc[ct] = mfma16(b, a, acc[ct]); } }
        bf16_t* xo = X + (size_t)(chain * 65 + c) * 16384;
#pragma unroll
        for (int ct = 0; ct < 8; ++ct) *(uint2*)(xo + (w * 16 + l15) * 128 + ct * 16 + quad * 4) = make_uint2(pk2(acc[ct][0], acc[ct][1]), pk2(acc[ct][2], acc[ct][3]));
        __syncthreads();
    }
}
DEV void phase_hg2(const Params& P0, int bid, int nb, int wv) {
    Params P = load_params(); asm volatile("" : "+s"(P.ws));
    const int gtid = bid * 512 + launder_tid(wv), gth = nb * 512;
    uint2* X = (uint2*)slotp(P, 17); const f32x4* DC = GPTR(const f32x4, P.ws + WS_DECAY);
    for (int e = gtid; e < 32 * 4096; e += gth) {
        const int chain = e >> 12, e4 = e & 4095, dir = chain & 1;
        f32x4 S = (f32x4){0.f, 0.f, 0.f, 0.f};
#pragma unroll 5
        for (int step = 0; step < 65; ++step) { const int c = dir ? 64 - step : step;
            const size_t idx = (size_t)(chain * 65 + c) * 4096 + e4;
            const uint2 kvw = X[idx]; const f32x4 dc = DC[(size_t)(chain * 65 + c) * 32 + (e4 & 31)];
            const f32x4 kv = (f32x4){__uint_as_float(kvw.x << 16), __uint_as_float(kvw.x & 0xffff0000u), __uint_as_float(kvw.y << 16), __uint_as_float(kvw.y & 0xffff0000u)};
            X[idx] = make_uint2(pk2(S[0], S[1]), pk2(S[2], S[3])); S = dc * S + kv; }
    }
}
DEV void phase_hg3(const Params& P0, int layer, unsigned char* lds, int bid, int nb, int wv) {
    Params P = load_params(); asm volatile("" : "+s"(P.ws));
    float* Lb = (float*)lds; bf16_t* Qs = (bf16_t*)(lds + 32768); bf16_t* Ks = (bf16_t*)(lds + 50176); bf16_t* Am = (bf16_t*)(lds + 67584);
    bf16_t* VT = (bf16_t*)(lds + 76800); bf16_t* Sb = (bf16_t*)(lds + 95232); float* Bt = (float*)(lds + 130048); float* Seg = (float*)(lds + 132096); float* Ost = (float*)lds;
    const bf16_t* X = slotp(P, 17);
    const int tid = launder_tid(wv), lane = tid & 63, w = __builtin_amdgcn_readfirstlane(tid >> 6), j = tid >> 3, c0 = (tid & 7) * 16, l15 = lane & 15, quad = lane >> 4;
    const int tt = w >> 1, st0 = (w & 1) * 2, vt0 = (w & 1) * 4;
    const int cfirst = layer == 0 ? 0 : 1;
    const int ncb = 65 - cfirst;
    for (int unit = bid; unit < 16 * ncb; unit += nb) {
        const int sh = unit / ncb, c = unit - sh * ncb + cfirst, sl = sh >> 2, head = sh & 3;
        bool valid; const int r = hg_row(sl, c, j, valid);
        float q[16]; uint4 gv[2] = {make_uint4(0, 0, 0, 0), make_uint4(0, 0, 0, 0)};
        if (valid) {
            const uint4* qp = (const uint4*)(slotp(P, 2) + (size_t)r * 512 + head * 128 + c0); unpack8(qp[0], q); unpack8(qp[1], q + 8);
            const uint4* vp = (const uint4*)(slotp(P, 5) + (size_t)r * 512 + head * 128 + c0); float vf[16]; unpack8(vp[0], vf); unpack8(vp[1], vf + 8);
#pragma unroll
            for (int e = 0; e < 16; ++e) VT[(c0 + e) * 72 + j] = (bf16_t)(__float_as_uint(vf[e]) >> 16);
            const uint4* gp = (const uint4*)(slotp(P, 6) + (size_t)r * 512 + head * 128 + c0); gv[0] = gp[0]; gv[1] = gp[1];
        } else {
#pragma unroll
            for (int e = 0; e < 16; ++e) { q[e] = 0.f; VT[(c0 + e) * 72 + j] = 0; } }
        f32x4 accA[2], accO[4];
#pragma unroll
        for (int i = 0; i < 2; ++i) accA[i] = (f32x4){0.f, 0.f, 0.f, 0.f};
#pragma unroll
        for (int i = 0; i < 4; ++i) accO[i] = (f32x4){0.f, 0.f, 0.f, 0.f};
#pragma unroll 1
        for (int dir = 0; dir < 2; ++dir) {
            float lg[16], kk[16];
            if (valid) { float fr[16];
                const uint4* fp = (const uint4*)(slotp(P, 3 + dir) + (size_t)r * 512 + head * 128 + c0); unpack8(fp[0], fr); unpack8(fp[1], fr + 8);
#pragma unroll
                for (int e = 0; e < 16; ++e) hg_gate(fr[e], hg_lb(P, layer, dir, head * 128 + c0 + e), lg[e], kk[e]);
            } else {
#pragma unroll
                for (int e = 0; e < 16; ++e) { lg[e] = 0.f; kk[e] = 0.f; } }
#pragma unroll
            for (int e = 0; e < 16; e += 4) *(f32x4*)(Lb + j * 128 + c0 + e) = (f32x4){lg[e], lg[e + 1], lg[e + 2], lg[e + 3]};
            __syncthreads();
            hg_cumsum(Lb, Bt, Seg, dir, tid);
            __syncthreads();
            {
                float qs[16], ks[16];
#pragma unroll
                for (int e = 0; e < 16; ++e) { const float b = Lb[j * 128 + c0 + e], rf = Lb[32 * 128 + c0 + e]; qs[e] = q[e] * __expf(b - rf); ks[e] = kk[e] * __expf(rf - b); }
                *(uint4*)(Qs + j * 136 + c0) = pack8(qs); *(uint4*)(Qs + j * 136 + c0 + 8) = pack8(qs + 8);
                *(uint4*)(Ks + j * 136 + c0) = pack8(ks); *(uint4*)(Ks + j * 136 + c0 + 8) = pack8(ks + 8);
            }
            {
                const int chain = sl * 8 + head * 2 + dir; const uint4* xs = (const uint4*)(X + (size_t)(chain * 65 + c) * 16384 + (size_t)(tid >> 2) * 128 + (tid & 3) * 32);
#pragma unroll
                for (int i = 0; i < 4; ++i) *(uint4*)(Sb + (tid >> 2) * 136 + (tid & 3) * 32 + i * 8) = xs[i];
            }
            __syncthreads();
            {
                f32x4 t0 = (f32x4){0.f, 0.f, 0.f, 0.f}, t1 = t0;
#pragma unroll
                for (int k4 = 0; k4 < 4; ++k4) { const bf16x8 a = *(const bf16x8*)(Qs + (tt * 16 + l15) * 136 + k4 * 32 + quad * 8);
                    const bf16x8 b0 = *(const bf16x8*)(Ks + ((st0 + 0) * 16 + l15) * 136 + k4 * 32 + quad * 8); const bf16x8 b1 = *(const bf16x8*)(Ks + ((st0 + 1) * 16 + l15) * 136 + k4 * 32 + quad * 8);
                    t0 = mfma16(a, b0, t0); t1 = mfma16(a, b1, t1); }
#pragma unroll
                for (int jj = 0; jj < 4; ++jj) { const int t = tt * 16 + quad * 4 + jj, s0 = (st0 + 0) * 16 + l15, s1 = (st0 + 1) * 16 + l15;
                    const bool k0 = dir == 0 ? s0 <= t : s0 >= t, k1 = dir == 0 ? s1 <= t : s1 >= t;
                    accA[0][jj] += k0 ? t0[jj] : 0.f; accA[1][jj] += k1 ? t1[jj] : 0.f; }
            }
            __syncthreads();
            {   float qg[16];
#pragma unroll
                for (int e = 0; e < 16; ++e) qg[e] = q[e] * __expf(Lb[j * 128 + c0 + e]);
                *(uint4*)(Qs + j * 136 + c0) = pack8(qg); *(uint4*)(Qs + j * 136 + c0 + 8) = pack8(qg + 8); }
            __syncthreads();
#pragma unroll
            for (int k4 = 0; k4 < 4; ++k4) { const bf16x8 a = *(const bf16x8*)(Qs + (tt * 16 + l15) * 136 + k4 * 32 + quad * 8);
#pragma unroll
                for (int v4 = 0; v4 < 4; ++v4) { const bf16x8 b = *(const bf16x8*)(Sb + ((vt0 + v4) * 16 + l15) * 136 + k4 * 32 + quad * 8); accO[v4] = mfma16(a, b, accO[v4]); } }
            __syncthreads();
        }
#pragma unroll
        for (int s2 = 0; s2 < 2; ++s2)
#pragma unroll
            for (int jj = 0; jj < 4; ++jj) Am[(tt * 16 + quad * 4 + jj) * 72 + (st0 + s2) * 16 + l15] = (bf16_t)(pk2(accA[s2][jj], 0.f) & 0xffffu);
        __syncthreads();
#pragma unroll
        for (int ks = 0; ks < 2; ++ks) { const bf16x8 a = *(const bf16x8*)(Am + (tt * 16 + l15) * 72 + ks * 32 + quad * 8);
#pragma unroll
            for (int v4 = 0; v4 < 4; ++v4) { const bf16x8 b = *(const bf16x8*)(VT + ((vt0 + v4) * 16 + l15) * 72 + ks * 32 + quad * 8); accO[v4] = mfma16(a, b, accO[v4]); } }
#pragma unroll
        for (int v4 = 0; v4 < 4; ++v4)
#pragma unroll
            for (int jj = 0; jj < 4; ++jj) Ost[(tt * 16 + quad * 4 + jj) * 132 + (vt0 + v4) * 16 + l15] = accO[v4][jj];
        __syncthreads();
        {   float o[16], ss = 0.f;
#pragma unroll
            for (int e = 0; e < 16; ++e) { o[e] = Ost[j * 132 + c0 + e]; ss += o[e] * o[e]; }
            ss = red8(ss);
            const float rs = rsqrtf(ss * (1.f / 128.f) + 1e-6f);
            float gf[16]; unpack8(gv[0], gf); unpack8(gv[1], gf + 8);
#pragma unroll
            for (int e = 0; e < 16; ++e) { const float gg = gf[e]; o[e] = o[e] * rs * P.in[I_ONORM][layer * 512 + head * 128 + c0 + e] * (gg / (1.f + __expf(-gg))); }
            if (valid) { uint4* yp = (uint4*)(slotp(P, 2) + (size_t)r * 512 + head * 128 + c0); yp[0] = pack8(o); yp[1] = pack8(o + 8); }
        }
        __syncthreads();
    }
}
DEV void phase_vtrans(const Params& P0, unsigned char* lds, int bid, int nb, int wv) {
    Params P = load_params(); asm volatile("" : "+s"(P.ws));
    bf16_t* T = (bf16_t*)lds;
    const bf16_t* V = slotp(P, 12); bf16_t* VTg = slotp(P, 6);
    const int tid = launder_tid(wv);
    for (int unit = bid; unit < 4 * 65 * 8; unit += nb) {
        const int sl = unit / 520, rem = unit - sl * 520, pt = rem >> 3, vdt = rem & 7;
        { const int tok = tid >> 3, c8 = (tid & 7) * 8, p = pt * 64 + tok;
          uint4 v = make_uint4(0, 0, 0, 0);
          if (p < LSEQ) v = *(const uint4*)(V + (size_t)row_of(sl, p) * 512 + vdt * 64 + c8);
          *(uint4*)(T + tok * 72 + c8) = v; }
        __syncthreads();
        { const int vd = tid >> 3, t8 = (tid & 7) * 8;
          unsigned short e[8];
#pragma unroll
          for (int i = 0; i < 8; ++i) { const int pp = t8 + i; const int sp = (pp & ~12) | (((pp >> 2) & 1) << 3) | (((pp >> 3) & 1) << 2); e[i] = T[sp * 72 + vd]; }
          uint4 o; o.x = e[0] | ((unsigned)e[1] << 16); o.y = e[2] | ((unsigned)e[3] << 16); o.z = e[4] | ((unsigned)e[5] << 16); o.w = e[6] | ((unsigned)e[7] << 16);
          *(uint4*)(VTg + (size_t)(sl * 512 + vdt * 64 + vd) * 4160 + pt * 64 + t8) = o; }
        __syncthreads();
    }
}
DEV int crow(int r, int hi) { return (r & 3) + 8 * (r >> 2) + 4 * hi; }
typedef unsigned u32x4_t __attribute__((ext_vector_type(4)));
struct AttnStage { u32x4_t k0, k1, v0, v1; };
DEV void attn_stage_load(const Params& P, int sl, int head, int kt, int tid, AttnStage& st) {
    const bf16_t* Kg = slotp(P, 11); const bf16_t* VTg = slotp(P, 6);
    { const int ci = tid, krow = ci >> 4, kc = ci & 15; const int p = kt * 64 + krow; const int r = p < LSEQ ? row_of(sl, p) : 0; st.k0 = GLD16(Kg + (size_t)r * 512 + head * 128 + kc * 8); }
    { const int ci = tid + 512, krow = ci >> 4, kc = ci & 15; const int p = kt * 64 + krow; const int r = p < LSEQ ? row_of(sl, p) : 0; st.k1 = GLD16(Kg + (size_t)r * 512 + head * 128 + kc * 8); }
    { const int vi = tid, vrow = vi >> 3, vc = vi & 7; st.v0 = GLD16(VTg + (size_t)(sl * 512 + head * 128 + vrow) * 4160 + kt * 64 + vc * 8); }
    { const int vi = tid + 512, vrow = vi >> 3, vc = vi & 7; st.v1 = GLD16(VTg + (size_t)(sl * 512 + head * 128 + vrow) * 4160 + kt * 64 + vc * 8); }
}
DEV void attn_stage_store(unsigned char* buf, int tid, const AttnStage& st) {
    bf16_t* Kt = (bf16_t*)buf; bf16_t* Vt = (bf16_t*)(buf + 17408);
    { const int ci = tid, krow = ci >> 4, kc = ci & 15; *(u32x4_t*)(Kt + krow * 136 + kc * 8) = st.k0; }
    { const int ci = tid + 512, krow = ci >> 4, kc = ci & 15; *(u32x4_t*)(Kt + krow * 136 + kc * 8) = st.k1; }
    { const int vi = tid, vrow = vi >> 3, vc = vi & 7; *(u32x4_t*)(Vt + vrow * 72 + vc * 8) = st.v0; }
    { const int vi = tid + 512, vrow = vi >> 3, vc = vi & 7; *(u32x4_t*)(Vt + vrow * 72 + vc * 8) = st.v1; }
}
DEV void phase_attn(const Params& P0, int layer, unsigned char* lds, int ua, int ub, int uc, int wv) {
    Params P = load_params(); asm volatile("" : "+s"(P.ws));
    const int tid = launder_tid(wv), lane = tid & 63, w = __builtin_amdgcn_readfirstlane(tid >> 6), map = w >> 2, qsub = w & 3, qi = lane & 31, hi = lane >> 5;
    const float lam_init = layer == 0 ? 0.2f : 0.35550906759096934f;
    float lam;
    { const float* lp = P.in[I_LAM] + (size_t)layer * 256; float s1 = 0.f, s2 = 0.f;
      for (int i = 0; i < 64; ++i) { s1 += lp[i] * lp[64 + i]; s2 += lp[128 + i] * lp[192 + i]; }
      lam = __expf(s1) - __expf(s2) + lam_init; }
    float* Ex = (float*)lds;
#pragma unroll 1
    for (int ui = 0; ui < 3; ++ui) {
        const int unit = ui == 0 ? ua : (ui == 1 ? ub : uc);
        if (unit < 0) continue;
        const int sh = unit < 512 ? (unit >> 5) : unit - 512, qb = unit < 512 ? (unit & 31) : 32, sl = sh >> 2, head = sh & 3;
        const int qrow0 = qb < 32 ? sl * 4096 + qb * 128 : TREAL + sl * 16; const int nvalid = qb < 32 ? 128 : 16;
        bf16x8 Qf[4];
        { const bf16_t* qp = slotp(P, 10) + (size_t)(qrow0 + qsub * 32 + qi) * 512 + head * 128 + map * 64 + hi * 8;
#pragma unroll
          for (int ds = 0; ds < 4; ++ds) Qf[ds] = __builtin_bit_cast(bf16x8, GLD16(qp + ds * 16)); }
        AttnStage st;
        attn_stage_load(P, sl, head, 0, tid, st); attn_stage_store(lds, tid, st); attn_stage_load(P, sl, head, 1, tid, st);
        __syncthreads();
        f32x16 O[4];
#pragma unroll
        for (int v = 0; v < 4; ++v)
#pragma unroll
            for (int r = 0; r < 16; ++r) O[v][r] = 0.f;
        float m_run = -INFINITY, l_run = 0.f;
#pragma unroll 1
        for (int kt = 0; kt < 65; ++kt) {
            if (kt + 1 < 65) attn_stage_store(lds + ((kt + 1) & 1) * 35840, tid, st);
            if (kt + 2 < 65) attn_stage_load(P, sl, head, kt + 2, tid, st);
            const unsigned char* buf = lds + (kt & 1) * 35840;
            const bf16_t* Kb = (const bf16_t*)buf; const bf16_t* Vb = (const bf16_t*)(buf + 17408);
            f32x16 S0, S1;
#pragma unroll
            for (int r = 0; r < 16; ++r) { S0[r] = 0.f; S1[r] = 0.f; }
#pragma unroll
            for (int ds = 0; ds < 4; ++ds) {
                const bf16x8 a0 = *(const bf16x8*)(Kb + qi * 136 + map * 64 + ds * 16 + hi * 8);
                const bf16x8 a1 = *(const bf16x8*)(Kb + (32 + qi) * 136 + map * 64 + ds * 16 + hi * 8);
                S0 = mfma32(a0, Qf[ds], S0); S1 = mfma32(a1, Qf[ds], S1); }
            if (kt == 64) {
#pragma unroll
                for (int r = 0; r < 16; ++r) { if (crow(r, hi) >= 16) S0[r] = -INFINITY; S1[r] = -INFINITY; } }
            float mx = -INFINITY;
#pragma unroll
            for (int r = 0; r < 16; ++r) mx = fmaxf(mx, fmaxf(S0[r], S1[r]));
            { const auto sw = __builtin_amdgcn_permlane32_swap(__float_as_uint(mx), __float_as_uint(mx), false, false); mx = fmaxf(__uint_as_float(sw[0]), __uint_as_float(sw[1])); }
            const float m_new = fmaxf(m_run, mx); const float alpha = __builtin_amdgcn_exp2f(m_run - m_new); m_run = m_new;
            float ps = 0.f;
#pragma unroll
            for (int r = 0; r < 16; ++r) { S0[r] = __builtin_amdgcn_exp2f(S0[r] - m_new); S1[r] = __builtin_amdgcn_exp2f(S1[r] - m_new); ps += S0[r] + S1[r]; }
            l_run = l_run * alpha + ps;
            if (__builtin_amdgcn_ballot_w64(alpha != 1.0f) != 0ull) {
#pragma unroll
                for (int v = 0; v < 4; ++v)
#pragma unroll
                    for (int r = 0; r < 16; ++r) O[v][r] *= alpha; }
            bf16x8 pf[2][2];
#pragma unroll
            for (int half = 0; half < 2; ++half) {
                uint4 a, b;
                a.x = pk2(S0[half * 8 + 0], S0[half * 8 + 1]); a.y = pk2(S0[half * 8 + 2], S0[half * 8 + 3]); a.z = pk2(S0[half * 8 + 4], S0[half * 8 + 5]); a.w = pk2(S0[half * 8 + 6], S0[half * 8 + 7]);
                b.x = pk2(S1[half * 8 + 0], S1[half * 8 + 1]); b.y = pk2(S1[half * 8 + 2], S1[half * 8 + 3]); b.z = pk2(S1[half * 8 + 4], S1[half * 8 + 5]); b.w = pk2(S1[half * 8 + 6], S1[half * 8 + 7]);
                pf[0][half] = __builtin_bit_cast(bf16x8, a); pf[1][half] = __builtin_bit_cast(bf16x8, b); }
#pragma unroll
            for (int v = 0; v < 4; ++v)
#pragma unroll
                for (int sub = 0; sub < 2; ++sub)
#pragma unroll
                    for (int half = 0; half < 2; ++half) {
                        const bf16x8 av = *(const bf16x8*)(Vb + (v * 32 + qi) * 72 + sub * 32 + half * 16 + hi * 8);
                        O[v] = mfma32(av, pf[sub][half], O[v]); }
            __syncthreads();
        }
        const float l_tot = l_run + __shfl_xor(l_run, 32); const float inv = 1.0f / l_tot;
        if (map == 1) {
#pragma unroll
            for (int v = 0; v < 4; ++v)
#pragma unroll
                for (int r = 0; r < 16; ++r) Ex[(qsub * 32 + qi) * 132 + v * 32 + crow(r, hi)] = O[v][r] * inv; }
        __syncthreads();
        if (map == 0) {
            float ss = 0.f;
#pragma unroll
            for (int v = 0; v < 4; ++v)
#pragma unroll
                for (int r = 0; r < 16; ++r) { const float o = O[v][r] * inv - lam * Ex[(qsub * 32 + qi) * 132 + v * 32 + crow(r, hi)]; O[v][r] = o; ss += o * o; }
            ss += __shfl_xor(ss, 32);
            const float rs = rsqrtf(ss * (1.f / 128.f) + 1e-5f) * (1.f - lam_init);
            if (qsub * 32 + qi < nvalid) {
                bf16_t* yp = slotp(P, 4) + (size_t)(qrow0 + qsub * 32 + qi) * 512 + head * 128;
#pragma unroll
                for (int v = 0; v < 4; ++v)
#pragma unroll
                    for (int rg = 0; rg < 4; ++rg) { const int vd0 = v * 32 + 8 * rg + 4 * hi; const f32x4 gg = *(const f32x4*)(P.in[I_SUBLN] + layer * 128 + vd0);
                        uint2 o; o.x = pk2(O[v][rg * 4 + 0] * rs * gg[0], O[v][rg * 4 + 1] * rs * gg[1]); o.y = pk2(O[v][rg * 4 + 2] * rs * gg[2], O[v][rg * 4 + 3] * rs * gg[3]);
                        *(uint2*)(yp + vd0) = o; } }
        }
        __syncthreads();
    }
}
DEV float dpp_f(float x, const int ctrl) { return x; }
template <int CTRL> DEV float dppmov(float x) { return __builtin_bit_cast(float, __builtin_amdgcn_update_dpp(0, __builtin_bit_cast(int, x), CTRL, 0xf, 0xf, true)); }
DEV float sum16(float x) { x += dppmov<0xB1>(x); x += dppmov<0x4E>(x); x += dppmov<0x141>(x); x += dppmov<0x140>(x); return x; }
constexpr int RW_CH = 16, RW_BUF_F = 5120 + 256 + 4096, RW_BUFB = RW_BUF_F * 4;
struct RwRegs { u32x4_t r, k, kk, e, a, v; };
DEV void unpack8v(const u32x4_t w, float* f) { unpack8(make_uint4(w.x, w.y, w.z, w.w), f); }
DEV void rw_stage_load(const Params& P, RwRegs& g, int sl, int head, int dir, int qr, int ck, int t) {
    if (t < 128) { const int step = t >> 3, ch8 = (t & 7) * 8, sidx = ck * RW_CH + step;
        if (sidx < LSEQ) { const int p = dir ? LSEQ - 1 - sidx : sidx; const size_t ro = (size_t)row_of(sl, p) * 512 + head * 64 + ch8;
            g.r = *(const u32x4_t*)(slotp(P, 17) + ro); g.k = *(const u32x4_t*)(slotp(P, 18) + ro); g.kk = *(const u32x4_t*)(slotp(P, 20) + ro);
            g.e = *(const u32x4_t*)(slotp(P, 22 + dir) + ro); g.a = *(const u32x4_t*)(slotp(P, dir == 0 ? 24 : 13) + ro); } }
    if (t < 32) { const int tt = t, s2 = tt >> 1, r8 = (tt & 1) * 8, si2 = ck * RW_CH + s2;
        if (si2 < LSEQ) { const int p2 = dir ? LSEQ - 1 - si2 : si2; g.v = *(const u32x4_t*)(slotp(P, 19) + (size_t)row_of(sl, p2) * 512 + head * 64 + qr * 16 + r8); } }
}
DEV void rw_stage_write(const Params& P, int layer, unsigned char* buf, const RwRegs& g, int head, int ck, int t) {
    float* Rr = (float*)buf; float* Ww = Rr + 1024; float* Kd = Ww + 1024; float* Kk = Kd + 1024; float* Bb = Kk + 1024; float* Vs = Bb + 1024;
    if (t < 128) { const int step = t >> 3, ch8 = (t & 7) * 8, sidx = ck * RW_CH + step;
        if (sidx < LSEQ) {
            float r[8], k[8], kk[8], e[8], a[8];
            unpack8v(g.r, r); unpack8v(g.k, k); unpack8v(g.kk, kk); unpack8v(g.e, e); unpack8v(g.a, a);
            float ww[8], kd[8], bb[8];
#pragma unroll
            for (int j = 0; j < 8; ++j) { ww[j] = __expf(-e[j]); kd[j] = k[j] * (1.f + (a[j] - 1.f) * P.in[I_KA][layer * 512 + head * 64 + ch8 + j]); bb[j] = kk[j] * a[j]; }
            const int o = step * 64 + ch8;
            *(f32x4*)(Rr + o) = (f32x4){r[0], r[1], r[2], r[3]}; *(f32x4*)(Rr + o + 4) = (f32x4){r[4], r[5], r[6], r[7]};
            *(f32x4*)(Ww + o) = (f32x4){ww[0], ww[1], ww[2], ww[3]}; *(f32x4*)(Ww + o + 4) = (f32x4){ww[4], ww[5], ww[6], ww[7]};
            *(f32x4*)(Kd + o) = (f32x4){kd[0], kd[1], kd[2], kd[3]}; *(f32x4*)(Kd + o + 4) = (f32x4){kd[4], kd[5], kd[6], kd[7]};
            *(f32x4*)(Kk + o) = (f32x4){kk[0], kk[1], kk[2], kk[3]}; *(f32x4*)(Kk + o + 4) = (f32x4){kk[4], kk[5], kk[6], kk[7]};
            *(f32x4*)(Bb + o) = (f32x4){bb[0], bb[1], bb[2], bb[3]}; *(f32x4*)(Bb + o + 4) = (f32x4){bb[4], bb[5], bb[6], bb[7]};
        } }
    if (t < 32) { const int tt = t, s2 = tt >> 1, r8 = (tt & 1) * 8, si2 = ck * RW_CH + s2;
        if (si2 < LSEQ) { float v[8]; unpack8v(g.v, v);
            *(f32x4*)(Vs + s2 * 16 + r8) = (f32x4){v[0], v[1], v[2], v[3]}; *(f32x4*)(Vs + s2 * 16 + r8 + 4) = (f32x4){v[4], v[5], v[6], v[7]}; } }
}
DEV void rw_flush(const Params& P, const unsigned char* buf, int sl, int head, int dir, int qr, int ck, int t) {
    if (t >= 160 && t < 192) { const float* Op = (const float*)buf + 5376; const int tt = t - 160, s2 = tt >> 1, r8 = (tt & 1) * 8, sidx = ck * RW_CH + s2;
        if (sidx < LSEQ) { const int p = dir ? LSEQ - 1 - sidx : sidx; float o[8];
#pragma unroll
            for (int j = 0; j < 8; ++j) { const int row = r8 + j; const f32x4* q = (const f32x4*)(Op + s2 * 256 + (row >> 2) * 64 + (row & 3) * 16);
                const f32x4 a = q[0], b = q[1], c = q[2], d = q[3];
                o[j] = ((a[0] + a[1]) + (a[2] + a[3])) + ((b[0] + b[1]) + (b[2] + b[3])) + (((c[0] + c[1]) + (c[2] + c[3])) + ((d[0] + d[1]) + (d[2] + d[3]))); }
            *(uint4*)(slotp(P, 15 + dir) + (size_t)row_of(sl, p) * 512 + head * 64 + qr * 16 + r8) = pack8(o); } }
}
DEV void phase_rw_scan(const Params& P0, int layer, unsigned char* lds, int bid, int nb, int wv) {
    Params P = load_params(); asm volatile("" : "+s"(P.ws));
    const int tid = launder_tid(wv), lane = tid & 63, w = __builtin_amdgcn_readfirstlane(tid >> 6), li = lane & 15, rl = (w & 3) * 4 + (lane >> 4);
    constexpr int NCK = (LSEQ + RW_CH - 1) / RW_CH;
    typedef float f32x2 __attribute__((ext_vector_type(2)));
    for (int unit = bid; unit < 256; unit += nb) {
        const int sl = unit >> 6, head = (unit >> 3) & 7, dir = (unit >> 2) & 1, qr = unit & 3;
        f32x2 SA = (f32x2){0.f, 0.f}, SB = (f32x2){0.f, 0.f};
        RwRegs g; g.r = g.k = g.kk = g.e = g.a = g.v = (u32x4_t){0u, 0u, 0u, 0u};
        if (w >= 4) { rw_stage_load(P, g, sl, head, dir, qr, 0, tid - 256); rw_stage_write(P, layer, lds, g, head, 0, tid - 256); rw_stage_load(P, g, sl, head, dir, qr, 1, tid - 256); }
        __syncthreads();
#pragma unroll 1
        for (int ck = 0; ck < NCK; ++ck) {
            unsigned char* buf = lds + (ck & 1) * RW_BUFB;
            if (w >= 4) {
                if (ck + 1 < NCK) rw_stage_write(P, layer, lds + ((ck + 1) & 1) * RW_BUFB, g, head, ck + 1, tid - 256);
                if (ck + 2 < NCK) rw_stage_load(P, g, sl, head, dir, qr, ck + 2, tid - 256);
                if (ck > 0) rw_flush(P, lds + ((ck - 1) & 1) * RW_BUFB, sl, head, dir, qr, ck - 1, tid - 256);
            } else {
                const float* Rr = (const float*)buf + li * 4; const float* Vs = (const float*)buf + 5120 + rl; float* Op = (float*)buf + 5376 + w * 64 + lane;
                const int ns = (LSEQ - ck * RW_CH) < RW_CH ? (LSEQ - ck * RW_CH) : RW_CH;
                f32x4 rr = *(const f32x4*)(Rr), ww = *(const f32x4*)(Rr + 1024), kd = *(const f32x4*)(Rr + 2048), kk = *(const f32x4*)(Rr + 3072), bb = *(const f32x4*)(Rr + 4096); float vv = Vs[0];
#pragma unroll 2
                for (int i = 0; i < ns; ++i) {
                    const int in = i < RW_CH - 1 ? i + 1 : RW_CH - 1;
                    const f32x4 rr_n = *(const f32x4*)(Rr + in * 64), ww_n = *(const f32x4*)(Rr + 1024 + in * 64), kd_n = *(const f32x4*)(Rr + 2048 + in * 64);
                    const f32x4 kk_n = *(const f32x4*)(Rr + 3072 + in * 64), bb_n = *(const f32x4*)(Rr + 4096 + in * 64); const float vv_n = Vs[in * 16];
                    f32x2 p = SA * (f32x2){kk[0], kk[1]}; p = __builtin_elementwise_fma(SB, (f32x2){kk[2], kk[3]}, p);
                    const f32x2 vv2 = (f32x2){vv, vv};
                    const f32x2 ta = vv2 * (f32x2){kd[0], kd[1]}, tb = vv2 * (f32x2){kd[2], kd[3]};
                    const float sa = -sum16(p[0] + p[1]);
                    const f32x2 sa2 = (f32x2){sa, sa};
                    SA = __builtin_elementwise_fma(SA, (f32x2){ww[0], ww[1]}, __builtin_elementwise_fma(sa2, (f32x2){bb[0], bb[1]}, ta));
                    SB = __builtin_elementwise_fma(SB, (f32x2){ww[2], ww[3]}, __builtin_elementwise_fma(sa2, (f32x2){bb[2], bb[3]}, tb));
                    f32x2 q = SA * (f32x2){rr[0], rr[1]}; q = __builtin_elementwise_fma(SB, (f32x2){rr[2], rr[3]}, q);
                    Op[i * 256] = q[0] + q[1];
                    rr = rr_n; ww = ww_n; kd = kd_n; kk = kk_n; bb = bb_n; vv = vv_n;
                }
            }
            __syncthreads();
        }
        if (w >= 4) rw_flush(P, lds + ((NCK - 1) & 1) * RW_BUFB, sl, head, dir, qr, NCK - 1, tid - 256);
        __syncthreads();
    }
}
static_assert(LSEQ == 257 * 16, "chunked RWKV assumes whole 16-step chunks");
constexpr int RWC_REC = 8960, RWC_NCK = 257;
DEV unsigned char* rwc_rec(const Params& P, int dir, int idx) {
    const int gi = dir * 8224 + idx;
    if (gi < 1901) return (unsigned char*)slotp(P, 5) + (size_t)gi * RWC_REC;
    if (gi < 7606) return (unsigned char*)slotp(P, 7) + (size_t)(gi - 1901) * RWC_REC;
    if (gi < 9507) return (unsigned char*)slotp(P, 12) + (size_t)(gi - 7606) * RWC_REC;
    if (gi < 11408) return (unsigned char*)slotp(P, 21) + (size_t)(gi - 9507) * RWC_REC;
    return GPTR(unsigned char, P.ws + WS_SLOTS + 25 * SLOT_B + (size_t)(gi - 11408) * RWC_REC); }
DEV int rwc_slot(int c) { return (((c >> 5) * 4 + ((c >> 2) & 3)) * 8) + ((c >> 4) & 1) * 4 + (c & 3); }
DEV void phase_rwc_pre(const Params& P0, int layer, unsigned char* lds, int bid, int nb, int wv) {
    Params P = load_params(); asm volatile("" : "+s"(P.ws));
    const int tid = launder_tid(wv), lane = tid & 63, w = __builtin_amdgcn_readfirstlane(tid >> 6), l15 = lane & 15, quad = lane >> 4;
    unsigned char* wl = lds + w * 15616;
    bf16_t* Bt = (bf16_t*)wl; bf16_t* Dt = Bt + 16 * 72; bf16_t* Ak = Dt + 16 * 72; bf16_t* Rt = Ak + 16 * 72;
    float* Mb = (float*)(wl + 9216); float* Md = Mb + 256; float* Gb = Md + 256; float* Gd = Gb + 256; float* Tm = Gd + 256; float* Nm = Tm + 256;
    const float ka = P.in[I_KA][layer * 512 + 0];  (void)ka;
    for (int unit2 = bid * 8 + w; unit2 < 2 * 32 * RWC_NCK; unit2 += nb * 8) {
        const int dir = unit2 >= 32 * RWC_NCK ? 1 : 0; const int unit = unit2 - dir * 32 * RWC_NCK;
        const int sh = unit / RWC_NCK, ck = unit - sh * RWC_NCK, sl = sh >> 3, head = sh & 7;
        const float kac = P.in[I_KA][layer * 512 + head * 64 + lane];
        float ak[16], bt[16], dt[16], rt[16];
        typedef const __attribute__((address_space(1))) unsigned short* gu16p;
        const gu16p pR = (gu16p)slotp(P, 17), pK = (gu16p)slotp(P, 18), pKK = (gu16p)slotp(P, 20), pE = (gu16p)slotp(P, 22 + dir), pA = (gu16p)slotp(P, dir == 0 ? 24 : 13);
        unsigned short r16[16], k16[16], q16[16], e16[16], a16[16];
#pragma unroll
        for (int t = 0; t < 16; ++t) {
            const int sidx = ck * 16 + t;
            const int p = dir ? LSEQ - 1 - sidx : sidx; const size_t ro = (size_t)row_of(sl, p) * 512 + head * 64 + lane;
            r16[t] = pR[ro]; k16[t] = pK[ro]; q16[t] = pKK[ro]; e16[t] = pE[ro]; a16[t] = pA[ro]; }
        float g = 1.f;
#pragma unroll
        for (int t = 0; t < 16; ++t) {
            const float r = bf2f(r16[t]), k = bf2f(k16[t]), kk = bf2f(q16[t]), e = bf2f(e16[t]), a = bf2f(a16[t]);
            const float wdec = __expf(-e), kd = k * (1.f + (a - 1.f) * kac), b = kk * a;
            ak[t] = g * kk; g *= wdec; const float gi = __builtin_amdgcn_rcpf(g); bt[t] = b * gi; dt[t] = kd * gi; rt[t] = g * r;
        }
        const float gC = g;
#pragma unroll
        for (int t = 0; t < 16; ++t) { Bt[t * 72 + lane] = (bf16_t)(pk2(bt[t], 0.f) & 0xffffu); Dt[t * 72 + lane] = (bf16_t)(pk2(dt[t], 0.f) & 0xffffu);
            Ak[t * 72 + lane] = (bf16_t)(pk2(ak[t], 0.f) & 0xffffu); Rt[t * 72 + lane] = (bf16_t)(pk2(rt[t], 0.f) & 0xffffu); }
        asm volatile("s_waitcnt lgkmcnt(0)" ::: "memory");
        {
            f32x4 mb = (f32x4){0.f, 0.f, 0.f, 0.f}, md = mb, gb = mb, gd = mb;
#pragma unroll
            for (int ks = 0; ks < 2; ++ks) {
                const bf16x8 fb = *(const bf16x8*)(Bt + l15 * 72 + ks * 32 + quad * 8), fd = *(const bf16x8*)(Dt + l15 * 72 + ks * 32 + quad * 8);
                const bf16x8 fa = *(const bf16x8*)(Ak + l15 * 72 + ks * 32 + quad * 8), fr = *(const bf16x8*)(Rt + l15 * 72 + ks * 32 + quad * 8);
                mb = mfma16(fb, fa, mb); md = mfma16(fd, fa, md); gb = mfma16(fb, fr, gb); gd = mfma16(fd, fr, gd); }
#pragma unroll
            for (int jj = 0; jj < 4; ++jj) { const int j = quad * 4 + jj, t = l15;
                Mb[j * 16 + t] = j < t ? mb[jj] : 0.f; Md[j * 16 + t] = j < t ? md[jj] : 0.f; Gb[j * 16 + t] = j <= t ? gb[jj] : 0.f; Gd[j * 16 + t] = j <= t ? gd[jj] : 0.f; }
        }
        asm volatile("s_waitcnt lgkmcnt(0)" ::: "memory");
        {
            float tc[16];
#pragma unroll
            for (int i = 15; i >= 0; --i) { float acc = (i == l15) ? 1.f : 0.f;
                float mr[16];
#pragma unroll
                for (int q4 = (i + 1) >> 2; q4 < 4; ++q4) { const f32x4 m4 = *(const f32x4*)(Mb + i * 16 + q4 * 4); mr[q4 * 4] = m4[0]; mr[q4 * 4 + 1] = m4[1]; mr[q4 * 4 + 2] = m4[2]; mr[q4 * 4 + 3] = m4[3]; }
#pragma unroll
                for (int l = i + 1; l < 16; ++l) acc -= mr[l] * tc[l];
                tc[i] = acc; }
            if (quad == 0) {
#pragma unroll
                for (int i = 0; i < 16; ++i) Tm[i * 16 + l15] = tc[i]; }
        }
        asm volatile("s_waitcnt lgkmcnt(0)" ::: "memory");
        {
            float n4[4] = {0.f, 0.f, 0.f, 0.f};
#pragma unroll
            for (int l = 0; l < 16; ++l) { const float tv = Tm[l * 16 + l15];
#pragma unroll
                for (int jj = 0; jj < 4; ++jj) n4[jj] += Md[(quad * 4 + jj) * 16 + l] * tv; }
#pragma unroll
            for (int jj = 0; jj < 4; ++jj) Nm[(quad * 4 + jj) * 16 + l15] = n4[jj];
        }
        asm volatile("s_waitcnt lgkmcnt(0)" ::: "memory");
        unsigned char* rec = rwc_rec(P, dir, unit);
        {
            float q4[4];
#pragma unroll
            for (int jj = 0; jj < 4; ++jj) q4[jj] = Gd[(quad * 4 + jj) * 16 + l15];
#pragma unroll
            for (int l = 0; l < 16; ++l) { const float gv = Gb[l * 16 + l15];
#pragma unroll
                for (int jj = 0; jj < 4; ++jj) q4[jj] -= Nm[(quad * 4 + jj) * 16 + l] * gv; }
            *(uint2*)((bf16_t*)(rec + 8192) + l15 * 16 + quad * 4) = make_uint2(pk2(q4[0], q4[1]), pk2(q4[2], q4[3]));
        }
        {
            float ap[16], rp[16], ps[16];
#pragma unroll
            for (int t = 0; t < 16; ++t) { ap[t] = 0.f; rp[t] = rt[t]; }
#pragma unroll
            for (int j = 0; j < 16; ++j) {
#pragma unroll
                for (int q4 = j >> 2; q4 < 4; ++q4) { const f32x4 r4 = *(const f32x4*)(Tm + j * 16 + q4 * 4);
#pragma unroll
                    for (int e = 0; e < 4; ++e) ap[q4 * 4 + e] += ak[j] * r4[e]; } }
#pragma unroll
            for (int j = 0; j < 16; ++j) {
#pragma unroll
                for (int q4 = j >> 2; q4 < 4; ++q4) { const f32x4 r4 = *(const f32x4*)(Gb + j * 16 + q4 * 4);
#pragma unroll
                    for (int e = 0; e < 4; ++e) rp[q4 * 4 + e] -= ap[j] * r4[e]; } }
#pragma unroll
            for (int j = 0; j < 16; ++j) { float acc = dt[j];
#pragma unroll
                for (int q4 = j >> 2; q4 < 4; ++q4) { const f32x4 r4 = *(const f32x4*)(Nm + j * 16 + q4 * 4);
#pragma unroll
                    for (int e = 0; e < 4; ++e) acc -= r4[e] * bt[q4 * 4 + e]; }
                ps[j] = acc * gC; }
            bf16_t* AP = (bf16_t*)rec; bf16_t* RP = AP + 1024; const int so = rwc_slot(lane);
#pragma unroll
            for (int t = 0; t < 16; ++t) { AP[t * 64 + so] = (bf16_t)(pk2(ap[t], 0.f) & 0xffffu); RP[t * 64 + so] = (bf16_t)(pk2(rp[t], 0.f) & 0xffffu); }
            float nb_[16];
#pragma unroll
            for (int t = 0; t < 16; ++t) nb_[t] = -bt[t] * gC;
            uint4* BP = (uint4*)(rec + 4096) + lane * 2; BP[0] = pack8(nb_); BP[1] = pack8(nb_ + 8);
            uint4* PP = (uint4*)(rec + 6144) + lane * 2; PP[0] = pack8(ps); PP[1] = pack8(ps + 8);
            ((float*)(rec + 8704))[lane] = gC;
        }
        asm volatile("s_waitcnt lgkmcnt(0)" ::: "memory");
    }
}
struct RwcRegs { u32x4_t a, b, c, v; };
DEV void rwc_load(const Params& P, RwcRegs& g, int sh, int dir, int ck, int t) {
    const unsigned char* rec = rwc_rec(P, dir, sh * RWC_NCK + ck);
    g.a = GLD16(rec + (size_t)t * 16); g.b = GLD16(rec + (size_t)(t + 256) * 16);
    if (t < 48) g.c = GLD16(rec + (size_t)(t + 512) * 16);
    if (t < 128) { const int j = t >> 3, r8 = (t & 7) * 8, sidx = ck * 16 + j; const int sc = sidx < LSEQ ? sidx : LSEQ - 1; const int p = dir ? LSEQ - 1 - sc : sc;
        g.v = GLD16(slotp(P, 19) + (size_t)row_of(sh >> 3, p) * 512 + (sh & 7) * 64 + r8); if (sidx >= LSEQ) g.v = (u32x4_t){0u, 0u, 0u, 0u}; }
}
DEV void rwc_store(unsigned char* buf, const RwcRegs& g, int t) {
    *(u32x4_t*)(buf + t * 16) = g.a; *(u32x4_t*)(buf + (t + 256) * 16) = g.b;
    if (t < 48) *(u32x4_t*)(buf + (t + 512) * 16) = g.c;
    if (t < 128) { bf16_t* VsT = (bf16_t*)(buf + RWC_REC); const int j = t >> 3, r8 = (t & 7) * 8;
        VsT[(r8 + 0) * 16 + j] = (bf16_t)(g.v.x & 0xffffu); VsT[(r8 + 1) * 16 + j] = (bf16_t)(g.v.x >> 16); VsT[(r8 + 2) * 16 + j] = (bf16_t)(g.v.y & 0xffffu); VsT[(r8 + 3) * 16 + j] = (bf16_t)(g.v.y >> 16);
        VsT[(r8 + 4) * 16 + j] = (bf16_t)(g.v.z & 0xffffu); VsT[(r8 + 5) * 16 + j] = (bf16_t)(g.v.z >> 16); VsT[(r8 + 6) * 16 + j] = (bf16_t)(g.v.w & 0xffffu); VsT[(r8 + 7) * 16 + j] = (bf16_t)(g.v.w >> 16); }
}
DEV void phase_rwc_scan(const Params& P0, unsigned char* lds, int bid, int nb, int wv) {
    Params P = load_params(); asm volatile("" : "+s"(P.ws));
    const int tid = launder_tid(wv), lane = tid & 63, w = __builtin_amdgcn_readfirstlane(tid >> 6), l15 = lane & 15, quad = lane >> 4;
    constexpr int BUFB = RWC_REC + 2048;
    for (int u2 = bid; u2 < 64; u2 += nb) {
        const int sh = u2 & 31, dir = u2 >> 5; const int sl = sh >> 3, head = sh & 7;
        f32x4 ST[4];
#pragma unroll
        for (int ct = 0; ct < 4; ++ct) ST[ct] = (f32x4){0.f, 0.f, 0.f, 0.f};
        RwcRegs g; g.a = g.b = g.c = g.v = (u32x4_t){0u, 0u, 0u, 0u};
        if (w >= 4) { rwc_load(P, g, sh, dir, 0, tid - 256); rwc_store(lds, g, tid - 256); rwc_load(P, g, sh, dir, 1, tid - 256); }
        __syncthreads();
#pragma unroll 1
        for (int ck = 0; ck < RWC_NCK; ++ck) {
            const unsigned char* buf = lds + (ck & 1) * BUFB;
            if (w >= 4) {
                if (ck + 1 < RWC_NCK) rwc_store(lds + ((ck + 1) & 1) * BUFB, g, tid - 256);
                if (ck + 2 < RWC_NCK) rwc_load(P, g, sh, dir, ck + 2, tid - 256);
            } else {
                const bf16_t* AP = (const bf16_t*)buf; const bf16_t* RP = AP + 1024; const bf16_t* BP = (const bf16_t*)(buf + 4096); const bf16_t* PP = (const bf16_t*)(buf + 6144);
                const bf16_t* QP = (const bf16_t*)(buf + 8192); const float* GC = (const float*)(buf + 8704); const bf16_t* VsT = (const bf16_t*)(buf + RWC_REC);
                const u32x4_t z4 = (u32x4_t){0u, 0u, 0u, 0u};
                u32x4_t sb0, sb1;
                sb0.x = pk2(ST[0][0], ST[0][1]); sb0.y = pk2(ST[0][2], ST[0][3]); sb0.z = pk2(ST[1][0], ST[1][1]); sb0.w = pk2(ST[1][2], ST[1][3]);
                sb1.x = pk2(ST[2][0], ST[2][1]); sb1.y = pk2(ST[2][2], ST[2][3]); sb1.z = pk2(ST[3][0], ST[3][1]); sb1.w = pk2(ST[3][2], ST[3][3]);
                const bf16x8 SB0 = __builtin_bit_cast(bf16x8, sb0), SB1 = __builtin_bit_cast(bf16x8, sb1);
                const bf16x8 a0 = *(const bf16x8*)(AP + l15 * 64 + (0 * 4 + quad) * 8), a1 = *(const bf16x8*)(AP + l15 * 64 + (1 * 4 + quad) * 8);
                const bf16x8 r0 = *(const bf16x8*)(RP + l15 * 64 + (0 * 4 + quad) * 8), r1 = *(const bf16x8*)(RP + l15 * 64 + (1 * 4 + quad) * 8);
                const u32x4_t vq = quad < 2 ? *(const u32x4_t*)(VsT + (w * 16 + l15) * 16 + quad * 8) : z4;
                const u32x4_t qq = quad < 2 ? *(const u32x4_t*)(QP + l15 * 16 + quad * 8) : z4;
                f32x4 gcv[4]; uint2 bqv[4]; u32x4_t pqv[4];
#pragma unroll
                for (int ct = 0; ct < 4; ++ct) { gcv[ct] = *(const f32x4*)(GC + ct * 16 + quad * 4); bqv[ct] = *(const uint2*)(BP + (ct * 16 + l15) * 16 + quad * 4);
                    pqv[ct] = quad < 2 ? *(const u32x4_t*)(PP + (ct * 16 + l15) * 16 + quad * 8) : z4; }
                const bf16x8 VB = __builtin_bit_cast(bf16x8, vq), QA = __builtin_bit_cast(bf16x8, qq);
                f32x4 Wt = (f32x4){0.f, 0.f, 0.f, 0.f}, Ot = Wt;
                Wt = mfma16(a0, SB0, Wt); Wt = mfma16(a1, SB1, Wt);
                Ot = mfma16(r0, SB0, Ot); Ot = mfma16(r1, SB1, Ot); Ot = mfma16(QA, VB, Ot);
                u32x4_t wb; wb.x = pk2(Wt[0], Wt[1]); wb.y = pk2(Wt[2], Wt[3]); wb.z = 0u; wb.w = 0u;
                const bf16x8 WB = __builtin_bit_cast(bf16x8, wb);
#pragma unroll
                for (int ct = 0; ct < 4; ++ct) {
                    u32x4_t ba; ba.x = bqv[ct].x; ba.y = bqv[ct].y; ba.z = 0u; ba.w = 0u;
                    f32x4 acc = ST[ct] * gcv[ct];
                    acc = mfma16(__builtin_bit_cast(bf16x8, ba), WB, acc);
                    acc = mfma16(__builtin_bit_cast(bf16x8, pqv[ct]), VB, acc);
                    ST[ct] = acc;
                }
                bf16_t* Oo = slotp(P, 15 + dir);
#pragma unroll
                for (int jj = 0; jj < 4; ++jj) { const int sidx = ck * 16 + quad * 4 + jj;
                    if (sidx < LSEQ) { const int p = dir ? LSEQ - 1 - sidx : sidx; ((__attribute__((address_space(1))) bf16_t*)Oo)[(size_t)row_of(sl, p) * 512 + head * 64 + w * 16 + l15] = (bf16_t)(pk2(Ot[jj], 0.f) & 0xffffu); } }
            }
            __syncthreads();
        }
    }
}

#define LAS __attribute__((address_space(3)))
#define XB_TMO      128
#define XB_XCNT(j)  (256  + 64 * (j))
#define XB_XSUB(j)  (1280 + 64 * (j))
#define XB_XGEN(j)  (2304 + 64 * (j))
#define XB_TOP      3328
#define XB_TOPGEN   3392
#define XCD_BAR_WORDS 3456
#define XB_SPIN_CAP (1u << 18)

__device__ __forceinline__ unsigned xb_ld(unsigned* p)              { return __hip_atomic_load(p, __ATOMIC_RELAXED, __HIP_MEMORY_SCOPE_AGENT); }
__device__ __forceinline__ unsigned xb_add(unsigned* p, unsigned v) { return __hip_atomic_fetch_add(p, v, __ATOMIC_RELAXED, __HIP_MEMORY_SCOPE_AGENT); }
__device__ __forceinline__ unsigned xb_xcc_id() { return (unsigned)__builtin_amdgcn_s_getreg((3 << 11) | 20) & 0xFu; }
#define XB_SPIN(cond, bar) do { unsigned _sp = 0; while (cond) { __builtin_amdgcn_s_sleep(1); \
    if ((++_sp & 255u) == 0u) { if (xb_ld(&(bar)[XB_TMO])) break; if (_sp > XB_SPIN_CAP) { atomicAdd(&(bar)[XB_TMO], 1u); break; } } } } while (0)

struct XcdBarrier {
    unsigned* bar; unsigned x;
    volatile LAS unsigned* st;
};

__device__ __forceinline__ XcdBarrier xcd_barrier_post(unsigned* bar, volatile LAS unsigned* st, int wv) {
    XcdBarrier b; b.bar = bar; b.x = xb_xcc_id(); b.st = st;
    if (launder_tid(wv) == 0) (void)xb_add(&bar[XB_XCNT(b.x)], 1u);
    return b;
}
__device__ __forceinline__ void xcd_barrier_complete(unsigned* bar, unsigned x, unsigned& nloc, unsigned& nx) {
    const unsigned G = gridDim.x * gridDim.y * gridDim.z;
    unsigned sum, cnt, mine, sp = 0u;
    for (;;) {
        sum = 0u; cnt = 0u; mine = 0u;
#pragma unroll
        for (unsigned j = 0; j < 16; ++j) { const unsigned c = xb_ld(&bar[XB_XCNT(j)]); sum += c; cnt += (c > 0u) ? 1u : 0u; mine = (j == x) ? c : mine; }
        if (sum == G) break;
        __builtin_amdgcn_s_sleep(1);
        if ((++sp & 255u) == 0u) { if (xb_ld(&bar[XB_TMO])) break; if (sp > XB_SPIN_CAP) { atomicAdd(&bar[XB_TMO], 1u); break; } }
    }
    nloc = mine > 0u ? mine : 1u; nx = cnt > 0u ? cnt : 1u;
}

__device__ __forceinline__ void xcd_barrier(const XcdBarrier& b, int wv) {
    asm volatile("s_waitcnt vmcnt(0)" ::: "memory");
    __syncthreads();
    if (launder_tid(wv) == 0) {
        unsigned* bar = b.bar;
        __builtin_amdgcn_s_waitcnt(0);
        unsigned nloc = b.st[0], nx = b.st[1];
        if (nloc == 0u) { xcd_barrier_complete(bar, b.x, nloc, nx); b.st[0] = nloc; b.st[1] = nx; }
        const unsigned old = xb_add(&bar[XB_XSUB(b.x)], 1u);
        const unsigned gen = old / nloc;
        if (old + 1u == (gen + 1u) * nloc) {
            __builtin_amdgcn_fence(__ATOMIC_RELEASE, "agent");
            asm volatile("s_waitcnt vmcnt(0)" ::: "memory");
            const unsigned og = xb_add(&bar[XB_TOP], 1u);
            const unsigned tg = og / nx;
            if (og + 1u == (tg + 1u) * nx) xb_add(&bar[XB_TOPGEN], 1u);
            else XB_SPIN(xb_ld(&bar[XB_TOPGEN]) == tg, bar);
            __builtin_amdgcn_fence(__ATOMIC_ACQUIRE, "agent");
            xb_add(&bar[XB_XGEN(b.x)], 1u);
            asm volatile("s_waitcnt vmcnt(0)" ::: "memory");
        } else {
            XB_SPIN(xb_ld(&bar[XB_XGEN(b.x)]) == gen, bar);
            __builtin_amdgcn_fence(__ATOMIC_ACQUIRE, "agent");
            asm volatile("s_waitcnt vmcnt(0)" ::: "memory");
        }
    }
    __syncthreads();
}

__global__ void __launch_bounds__(512) mega_fwd(Params P) {
    extern __shared__ __attribute__((aligned(16))) unsigned char lds[];
    cg::grid_group grid = cg::this_grid();
    const int bid = blockIdx.x, nb = gridDim.x; const int wv = __builtin_amdgcn_readfirstlane(threadIdx.x >> 6);
    volatile LAS unsigned* MISC = (volatile LAS unsigned*)((LAS unsigned char*)lds + 131072 + 256);
    if (threadIdx.x < 4) MISC[threadIdx.x] = 0u;
    __syncthreads();
    XcdBarrier xbar;
    { Params Pb = load_params(); xbar = xcd_barrier_post((unsigned*)Pb.ws, MISC, wv); }
#define GSYNC() xcd_barrier(xbar, wv)
    PG8_LAS unsigned char* ldsl = (PG8_LAS unsigned char*)lds;
#pragma unroll 1
    for (int layer_ = 0; layer_ < 2; ++layer_) {
        phase_weights(P, lsd(layer_), lds, bid, nb, wv);
        grid.sync();
#pragma unroll 1
        for (int g_ = 0; g_ < NGRP; ++g_) {
            #define Mpost ((lsd(layer_) == 0 && lsd(g_) == 2) ? TGP : TREAL)
#define NVALID ((lsd(layer_) == 0 && lsd(g_) == 2) ? TG + 128 : TG)
            phase_rmsnorm(P, lsd(g_), lsd(layer_) == 0, I_NMIX, lsd(layer_), TGP, NVALID, bid, nb, wv);
            if (PROBE == 5) { phase_rmsnorm(P, lsd(g_), lsd(layer_) == 0, I_NMIX, lsd(layer_), TGP, NVALID, bid, nb, wv); }
            GSYNC();
            if (PROBE == 6) { for (int q_ = 0; q_ < 15; ++q_) GSYNC(); }
            for (int rep_ = 0; rep_ < (PROBE == 3 ? 2 : 1); ++rep_)
            { Params Pl = load_params(); asm volatile("" : "+s"(Pl.ws)); pg8::bf16_t* W = (pg8::bf16_t*)(Pl.ws + WS_W); pg8::Gemm gm{slotp(Pl, 0), W + WO_IN, TGP, 7680, 1024, 0, 0}; pg8::StaticOrder S; S.init(TGP, 7680, nb, bid);
              pg8::EpiBf<0> E{slotp(Pl, 2), 512, SLOT_E};
              pg8::gemm_phase<pg8::EpiBf<0>, pg8::StaticOrder, true, true>(ldsl, gm, S, E, wv); }
            GSYNC();
            phase_da_prep(P, lsd(layer_), bid, nb, wv);
            phase_hg1(P, lsd(layer_), lds, bid, nb, wv);
            if (PROBE == 4) { phase_hg1(P, lsd(layer_), lds, bid, nb, wv); }
            GSYNC();
            phase_hg2(P, bid, nb, wv);
            GSYNC();
            phase_hg3(P, lsd(layer_), lds, bid, nb, wv);
            GSYNC();
            phase_conv(P, lsd(layer_), bid, nb, wv);
            if (PROBE == 5) { phase_conv(P, lsd(layer_), bid, nb, wv); }
            phase_vtrans(P, lds, bid, nb, wv);
            if (PROBE == 5) { phase_vtrans(P, lds, bid, nb, wv); }
            phase_rw_prep(P, lsd(layer_), bid, nb, wv);
            if (PROBE == 5) { phase_rw_prep(P, lsd(layer_), bid, nb, wv); }
            GSYNC();
            { Params Pl = load_params(); asm volatile("" : "+s"(Pl.ws)); pg8::bf16_t* W = (pg8::bf16_t*)(Pl.ws + WS_W); pg8::Gemm gm{slotp(Pl, 21), W + WO_LR, TGP, 2560, 384, 0, 0}; pg8::StaticOrder S; S.init(TGP, 2560, nb, bid);
              pg8::EpiLR E{slotp(Pl, 22), slotp(Pl, 23), slotp(Pl, 24), slotp(Pl, 13), slotp(Pl, 14), Pl.in[I_W0] + lsd(layer_) * 1024, Pl.in[I_A0] + lsd(layer_) * 1024};
              pg8::gemm_phase<pg8::EpiLR, pg8::StaticOrder, true, true>(ldsl, gm, S, E, wv); }
            GSYNC();
            phase_rwc_pre(P, lsd(layer_), lds, bid, nb, wv);
            GSYNC();
            if (nb == 256) {
                const int nun = lsd(layer_) == 0 ? 528 : 512;
                if (bid < 64) { phase_rwc_scan(P, lds, bid, nb, wv); __syncthreads(); phase_attn(P, lsd(layer_), lds, bid, -1, -1, wv); }
                else { const int bq = bid - 64; phase_attn(P, lsd(layer_), lds, 64 + bq, 256 + bq, (448 + bq < nun) ? 448 + bq : -1, wv); }
            } else {
                phase_rwc_scan(P, lds, bid, nb, wv); __syncthreads();
                for (int u = bid; u < (lsd(layer_) == 0 ? 528 : 512); u += nb) phase_attn(P, lsd(layer_), lds, u, -1, -1, wv);
            }
            GSYNC();
            phase_rw_post(P, lsd(layer_), lsd(g_), lsd(layer_) == 0 ? TG : TREAL, bid, nb, wv);
            if (PROBE == 5) { phase_rw_post(P, lsd(layer_), lsd(g_), lsd(layer_) == 0 ? TG : TREAL, bid, nb, wv); }
            GSYNC();
            { Params Pl = load_params(); asm volatile("" : "+s"(Pl.ws)); pg8::bf16_t* W = (pg8::bf16_t*)(Pl.ws + WS_W); pg8::Gemm gm{slotp(Pl, 2), W + WO_BP, Mpost, 4096, 512, 4, SLOT_B}; pg8::StaticOrder S; S.init(Mpost, 4096, nb, bid);
              pg8::EpiBf<0> E{slotp(Pl, 6), 4096, 0};
              pg8::gemm_phase<pg8::EpiBf<0>, pg8::StaticOrder, true, true>(ldsl, gm, S, E, wv); }
            GSYNC();
            { Params Pl = load_params(); asm volatile("" : "+s"(Pl.ws)); pg8::bf16_t* W = (pg8::bf16_t*)(Pl.ws + WS_W); pg8::Gemm gm{slotp(Pl, 0), W + WO_G, Mpost, 4096, 1024, 0, 0}; pg8::StaticOrder S; S.init(Mpost, 4096, nb, bid);
              pg8::EpiGate E{slotp(Pl, 6), slotp(Pl, 14)};
              pg8::gemm_phase<pg8::EpiGate, pg8::StaticOrder, true, true>(ldsl, gm, S, E, wv); }
            GSYNC();
            { Params Pl = load_params(); asm volatile("" : "+s"(Pl.ws)); pg8::bf16_t* W = (pg8::bf16_t*)(Pl.ws + WS_W); pg8::Gemm gm{slotp(Pl, 14), W + WO_OUT, Mpost, 1024, 1024, 0, 0}; pg8::StaticOrder S; S.init(Mpost, 1024, nb, bid);
              pg8::EpiResid E{lsd(layer_) == 0 ? x_in_row(Pl, lsd(g_), 0) : (const float*)x_cur_row(Pl, lsd(g_), 0), lsd(layer_) == 0 ? Pl.in[I_META] : (const float*)nullptr, x_cur_row(Pl, lsd(g_), 0), GPTR(float, Pl.ws + WS_XMETA), lsd(g_), NVALID};
              pg8::gemm_phase<pg8::EpiResid, pg8::StaticOrder, true, true>(ldsl, gm, S, E, wv); }
            GSYNC();
            phase_rmsnorm(P, lsd(g_), false, I_NMLP, lsd(layer_), Mpost, NVALID, bid, nb, wv);
            if (PROBE == 5) { phase_rmsnorm(P, lsd(g_), false, I_NMLP, lsd(layer_), Mpost, NVALID, bid, nb, wv); }
            GSYNC();
            for (int rep_ = 0; rep_ < (PROBE == 7 ? 2 : 1); ++rep_)
            { Params Pl = load_params(); asm volatile("" : "+s"(Pl.ws)); pg8::bf16_t* W = (pg8::bf16_t*)(Pl.ws + WS_W); pg8::Gemm gm{slotp(Pl, 0), W + WO_1, Mpost, 4096, 1024, 0, 0}; pg8::StaticOrder S; S.init(Mpost, 4096, nb, bid);
              pg8::EpiBf<1> E{slotp(Pl, 6), 4096, 0};
              pg8::gemm_phase<pg8::EpiBf<1>, pg8::StaticOrder, true, true>(ldsl, gm, S, E, wv); }
            GSYNC();
            { Params Pl = load_params(); asm volatile("" : "+s"(Pl.ws)); pg8::bf16_t* W = (pg8::bf16_t*)(Pl.ws + WS_W); pg8::Gemm gm{slotp(Pl, 6), W + WO_2, Mpost, 1024, 4096, 0, 0}; pg8::StaticOrder S; S.init(Mpost, 1024, nb, bid);
              pg8::EpiResid E{(const float*)x_cur_row(Pl, lsd(g_), 0), (const float*)nullptr, x_cur_row(Pl, lsd(g_), 0), GPTR(float, Pl.ws + WS_XMETA), lsd(g_), NVALID};
              pg8::gemm_phase<pg8::EpiResid, pg8::StaticOrder, true, true>(ldsl, gm, S, E, wv); }
            GSYNC();
        }
    }
}

extern "C" void kernel_launch(void* const* d_in, const int* in_sizes, int n_in, void* d_out, int out_size, void* d_ws, size_t ws_size, hipStream_t stream) {
    static int grid = 0;
    if (grid == 0) {
        if (n_in != 29 || ws_size < WS_NEED) { fprintf(stderr, "kernel_launch: need 29 inputs and %zu bytes of workspace; got %d, %zu\n", (size_t)WS_NEED, n_in, ws_size); grid = -1; return; }
        int dev = 0, cus = 0, per_cu = 0;
        if (hipGetDevice(&dev) != hipSuccess || hipDeviceGetAttribute(&cus, hipDeviceAttributeMultiprocessorCount, dev) != hipSuccess) { grid = -1; return; }
        if (hipFuncSetAttribute((const void*)mega_fwd, hipFuncAttributeMaxDynamicSharedMemorySize, LDS_BYTES) != hipSuccess) { fprintf(stderr, "kernel_launch: hipFuncSetAttribute failed\n"); grid = -1; return; }
        if (hipOccupancyMaxActiveBlocksPerMultiprocessor(&per_cu, (const void*)mega_fwd, 512, LDS_BYTES) != hipSuccess || per_cu < 1) { fprintf(stderr, "kernel_launch: occupancy query says %d\n", per_cu); per_cu = 1; }
        (void)hipGetLastError();
        grid = cus;
    }
    if (grid < 0) return;
    if (hipMemsetAsync(d_ws, 0, 16384, stream) != hipSuccess) { fprintf(stderr, "kernel_launch: memset failed\n"); return; }
    Params p{};
    for (int i = 0; i < 29; ++i) p.in[i] = (const float*)d_in[i];
    p.out = (float*)d_out; p.ws = (unsigned char*)d_ws;
    void* args[] = {&p};
    hipError_t e = hipLaunchCooperativeKernel((const void*)mega_fwd, dim3(grid), dim3(512), args, LDS_BYTES, stream);
    if (e != hipSuccess) fprintf(stderr, "kernel_launch: cooperative launch failed: %s (grid %d)\n", hipGetErrorString(e), grid);
}
```

```cpp
#include <hip/hip_runtime.h>
#include <hip/hip_cooperative_groups.h>
#include <cstdio>
#include <cstdint>
namespace cg = cooperative_groups;
#define PROBE 0
#define DEV __device__ __forceinline__
__device__ __forceinline__ int lsd(int x) { asm volatile("" : "+s"(x)); return x; }
__device__ __forceinline__ int launder_tid(int wv) { int l; asm volatile("v_mbcnt_lo_u32_b32 %0, -1, 0\n\tv_mbcnt_hi_u32_b32 %0, -1, %0" : "=v"(l)); return wv * 64 + l; }
namespace pg8 {
#define PG8_LAS __attribute__((address_space(3)))
typedef unsigned short bf16_t;
typedef short bf16x8 __attribute__((ext_vector_type(8)));
typedef float f32x4 __attribute__((ext_vector_type(4)));
typedef unsigned u32x4 __attribute__((ext_vector_type(4)));
constexpr int BM = 256, BK = 64, HALF = 128, HTB = HALF * BK * 2  , STAGE_BYTES = 8 * HTB, NXCD = 8, WGM = 8;

__host__ __device__ __forceinline__ int lds_byte(int r, int c) { const int st = (r >> 4) * 2 + (c >> 5), rr = r & 15, cc = c & 31, ob = rr * 64 + cc * 2; return st * 1024 + (ob ^ (((ob >> 9) & 1) << 5)); }
__host__ __device__ __forceinline__ void stage_rc(int b, int& R, int& C) { const int st = b / 1024, sb = b % 1024, swz = sb ^ (((sb >> 9) & 1) << 5); R = (st >> 1) * 16 + swz / 64; C = (st & 1) * 32 + (swz % 64) / 2; }
__host__ __device__ __forceinline__ int perm32(int rho) { const int n = rho >> 4, i = rho & 15; return 8 * (i >> 2) + 4 * n + (i & 3); }

struct Unit { int pm, pn; };
struct Gemm { const bf16_t* A; const bf16_t* Bt; int M, N, K; int pn_per_ab; size_t ab_stride; };

struct StaticOrder {
    int nM, nN, nwg, G, c;
    __host__ __device__ void init(int M, int N, int G_, int c_) { nM = M / BM; nN = N / BM; nwg = nM * nN; G = G_; c = c_; }
    __host__ __device__ bool next(int i, Unit& u) const {
        const long L = (long)i * G + c; if (L >= nwg) return false;
        int wgid = (int)L; { const int q = nwg / NXCD, r = nwg % NXCD, xcd = wgid % NXCD, off = wgid / NXCD; wgid = (xcd < r ? xcd * (q + 1) : r * (q + 1) + (xcd - r) * q) + off; }
        const int nig = WGM * nN, gid = wgid / nig, fm = gid * WGM, gsz = (nM - fm) < WGM ? (nM - fm) : WGM;
        u.pm = fm + ((wgid % nig) % gsz); u.pn = (wgid % nig) / gsz; return true;
    }
    __device__ __forceinline__ void a_ready(const Unit&) const {}
    __device__ __forceinline__ void done(const Unit&) const {}
};

typedef float f32x2cv_t __attribute__((ext_vector_type(2))); typedef __bf16 bf16x2cv_t __attribute__((ext_vector_type(2)));
__device__ __forceinline__ unsigned cvt_pk_bf16(float lo, float hi) { const f32x2cv_t v = {lo, hi}; const bf16x2cv_t b = __builtin_convertvector(v, bf16x2cv_t); return __builtin_bit_cast(unsigned, b); }
typedef float f32x2 __attribute__((ext_vector_type(2)));
__device__ __forceinline__ float sigm(float x) { return __builtin_amdgcn_rcpf(1.0f + __expf(-x)); }
template <int ACT  > struct EpiBf {
    static constexpr bool PERM = true, AFTER_DRAIN = false;
    bf16_t* O; int ldc; size_t gstride;
    __device__ __forceinline__ void operator()(const f32x4 (&acc)[2][2][4][2], const Unit& u, int wr, int wc, int fr, int fq) const {
        const int row0 = u.pm * BM + wr * 64 + fr; int colt = u.pn * BM; bf16_t* base = O; int ld = ldc;
        if (gstride) { const int t = colt >> 9; colt &= 511; base += (size_t)t * gstride; ld = 512; }
        const int col0 = colt + wc * 32 + 8 * fq;
#pragma unroll
        for (int ai = 0; ai < 2; ++ai)
#pragma unroll
            for (int m = 0; m < 4; ++m) { bf16_t* rowp = base + (size_t)(row0 + ai * HALF + m * 16) * ld + col0;
#pragma unroll
                for (int bj = 0; bj < 2; ++bj) { f32x4 v0 = acc[ai][bj][m][0], v1 = acc[ai][bj][m][1];
                    if (ACT == 1) {
#pragma unroll
                        for (int i = 0; i < 4; ++i) { float a = fmaxf(v0[i], 0.f), b = fmaxf(v1[i], 0.f); v0[i] = a * a; v1[i] = b * b; } }
                    u32x4 w; w.x = cvt_pk_bf16(v0[0], v0[1]); w.y = cvt_pk_bf16(v0[2], v0[3]); w.z = cvt_pk_bf16(v1[0], v1[1]); w.w = cvt_pk_bf16(v1[2], v1[3]);
                    *(u32x4*)(rowp + bj * HALF) = w; } }
    }
};
struct EpiLR {
    static constexpr bool PERM = true, AFTER_DRAIN = false;
    bf16_t *s0, *s1, *s2, *s3, *s4; const float* w0; const float* a0;
    __device__ __forceinline__ void operator()(const f32x4 (&acc)[2][2][4][2], const Unit& u, int wr, int wc, int fr, int fq) const {
        const int row0 = u.pm * BM + wr * 64 + fr; const int colg = u.pn * BM; const int seg = colg >> 9; const int cb = colg & 511;
        bf16_t* base = seg == 0 ? s0 : seg == 1 ? s1 : seg == 2 ? s2 : seg == 3 ? s3 : s4;
        const int col0 = cb + wc * 32 + 8 * fq;
        const float* bsrc = seg < 2 ? w0 + seg * 512 : a0 + (seg & 1) * 512;
        const float sc = seg < 2 ? 0.6065306597f : 1.0f; const float bm = seg < 4 ? 1.f : 0.f; const bool act = seg < 4;
#pragma unroll
        for (int bj = 0; bj < 2; ++bj) {
            const f32x4 b0 = *(const f32x4*)(bsrc + col0 + bj * HALF) * bm, b1 = *(const f32x4*)(bsrc + col0 + bj * HALF + 4) * bm;
#pragma unroll
            for (int ai = 0; ai < 2; ++ai)
#pragma unroll
                for (int m = 0; m < 4; ++m) { bf16_t* rowp = base + (size_t)(row0 + ai * HALF + m * 16) * 512 + col0;
                    f32x4 v0 = acc[ai][bj][m][0] + b0, v1 = acc[ai][bj][m][1] + b1;
#pragma unroll
                    for (int i = 0; i < 4; ++i) { const float g0 = sc * sigm(v0[i]), g1 = sc * sigm(v1[i]); v0[i] = act ? g0 : v0[i]; v1[i] = act ? g1 : v1[i]; }
                    u32x4 w; w.x = cvt_pk_bf16(v0[0], v0[1]); w.y = cvt_pk_bf16(v0[2], v0[3]); w.z = cvt_pk_bf16(v1[0], v1[1]); w.w = cvt_pk_bf16(v1[2], v1[3]);
                    *(u32x4*)(rowp + bj * HALF) = w; __builtin_amdgcn_sched_barrier(0); }
        }
    }
};
struct EpiGate {
    static constexpr bool PERM = true, AFTER_DRAIN = false;
    const bf16_t* Pm; bf16_t* Mg;
    __device__ __forceinline__ void operator()(const f32x4 (&acc)[2][2][4][2], const Unit& u, int wr, int wc, int fr, int fq) const {
        const int row0 = u.pm * BM + wr * 64 + fr; const int ocol = u.pn * 64 + wc * 16 + fq * 4;
#pragma unroll
        for (int ai = 0; ai < 2; ++ai)
#pragma unroll
            for (int m = 0; m < 4; ++m) { const size_t row = (size_t)(row0 + ai * HALF + m * 16);
                float s0 = 0.f, s1 = 0.f, s2 = 0.f, s3 = 0.f;
#pragma unroll
                for (int bj = 0; bj < 2; ++bj)
#pragma unroll
                    for (int n = 0; n < 2; ++n) { const int br = bj * 2 + n;
                        const uint2 pw = *(const uint2*)(Pm + row * 4096 + br * 1024 + ocol);
                        const f32x4 a = acc[ai][bj][m][n];
                        s0 += sigm(a[0]) * __uint_as_float(pw.x << 16); s1 += sigm(a[1]) * __uint_as_float(pw.x & 0xffff0000u);
                        s2 += sigm(a[2]) * __uint_as_float(pw.y << 16); s3 += sigm(a[3]) * __uint_as_float(pw.y & 0xffff0000u); }
                uint2 o; o.x = cvt_pk_bf16(s0, s1); o.y = cvt_pk_bf16(s2, s3);
                *(uint2*)(Mg + row * 1024 + ocol) = o; }
    }
};
struct EpiResid {
    static constexpr bool PERM = true, AFTER_DRAIN = false;
    const float* om; const float* mt; float* nm; float* xmb; int g; int rlim;
    __device__ __forceinline__ void operator()(const f32x4 (&acc)[2][2][4][2], const Unit& u, int wr, int wc, int fr, int fq) const {
        const int row0 = u.pm * BM + wr * 64 + fr; const int col0 = u.pn * BM + wc * 32 + 8 * fq;
#pragma unroll
        for (int ai = 0; ai < 2; ++ai)
#pragma unroll
            for (int m = 0; m < 4; ++m) { const int r = row0 + ai * HALF + m * 16;
                if (r < rlim) {
                    const int mi = r - 16384;
                    float* dmeta = xmb + (size_t)(mi < 64 ? g * 64 + mi : ((mi >> 6) - 1) * 64 + (mi & 63)) * 1024;
                    const float* src = r < 16384 ? om + (size_t)r * 1024 : (mt ? mt + (size_t)(mi & 15) * 1024 : (const float*)dmeta);
                    float* dst = r < 16384 ? nm + (size_t)r * 1024 : dmeta;
#pragma unroll
                    for (int bj = 0; bj < 2; ++bj)
#pragma unroll
                        for (int n = 0; n < 2; ++n) { const int c = col0 + bj * HALF + 4 * n;
                            const f32x4 xo = *(const f32x4*)(src + c); *(f32x4*)(dst + c) = xo + acc[ai][bj][m][n]; } } }
    }
};
template <class Epi, class Sched, bool ALIGN_EPI = false, bool SP2 = false>
__device__ __forceinline__ void gemm_phase(PG8_LAS unsigned char* lds, const Gemm g, const Sched& S, const Epi& E, int wv) {
    const int tid = launder_tid(wv), wid = __builtin_amdgcn_readfirstlane(tid >> 6), lane = tid & 63, wr = wid >> 2, wc = wid & 3, fr = lane & 15, fq = lane >> 4;
    const int K = g.K, nt = K / BK;
    unsigned voffA[2], voffB[2];
#pragma unroll
    for (int i = 0; i < 2; ++i) { int R, C; stage_rc(tid * 16 + i * 8192, R, C); const int Rb = Epi::PERM ? ((R & ~31) + perm32(R & 31)) : R;
        voffA[i] = (unsigned)(R * K + C) * 2u; voffB[i] = (unsigned)(Rb * K + C) * 2u; }
    const size_t kstep = (size_t)(BK * 2);
    const size_t hstep = (size_t)HALF * K * 2;
    const size_t tstep = 2 * hstep;
    const unsigned ldsw = (unsigned)wid * 1024u;
    const int aoff = lds_byte(wr * 64 + fr, fq * 8), boff = lds_byte(wc * 32 + fr, fq * 8);
#define PG8_SA(b, h) (((b) * 2 + (h)) * HTB)
#define PG8_SB(b, h) ((4 + (b) * 2 + (h)) * HTB)
#define PG8_STAGE(bufoff, gbase, voff) do { _Pragma("unroll") for (int _i = 0; _i < 2; ++_i) \
        __builtin_amdgcn_global_load_lds((const unsigned*)((const char*)(gbase) + (voff)[_i]), (PG8_LAS unsigned*)(lds + (bufoff) + ldsw + _i * 8192), 16, 0, 0); } while (0)
#define PG8_LDA(dst, b, h) do { _Pragma("unroll") for (int m = 0; m < 4; ++m) _Pragma("unroll") for (int k = 0; k < 2; ++k) dst[m][k] = *(const PG8_LAS bf16x8*)(lds + PG8_SA(b, h) + aoff + m * 2048 + k * 1024); } while (0)
#define PG8_LDB(dst, b, h) do { _Pragma("unroll") for (int n = 0; n < 2; ++n) _Pragma("unroll") for (int k = 0; k < 2; ++k) dst[n][k] = *(const PG8_LAS bf16x8*)(lds + PG8_SB(b, h) + boff + n * 2048 + k * 1024); } while (0)
#define PG8_MMA(ai, bj, At, Bt) do { __builtin_amdgcn_s_setprio(1); _Pragma("unroll") for (int m = 0; m < 4; ++m) _Pragma("unroll") for (int n = 0; n < 2; ++n) _Pragma("unroll") for (int k = 0; k < 2; ++k) \
        acc[ai][bj][m][n] = __builtin_amdgcn_mfma_f32_16x16x32_bf16(Bt[n][k], At[m][k], acc[ai][bj][m][n], 0, 0, 0); __builtin_amdgcn_s_setprio(0); } while (0)
#define PG8_WAIT_V(n) asm volatile("s_waitcnt vmcnt(" #n ")" ::: "memory")
#define PG8_WAIT_L(n) asm volatile("s_waitcnt lgkmcnt(" #n ")" ::: "memory")
#define PG8_BAR __builtin_amdgcn_s_barrier()
#define PG8_SCHED __builtin_amdgcn_sched_barrier(0)
    Unit cur, nxt; int ui = 0;
    if (!S.next(0, cur)) return;
    f32x4 acc[2][2][4][2];
#pragma unroll
    for (int a = 0; a < 2; ++a)
#pragma unroll
        for (int b = 0; b < 2; ++b)
#pragma unroll
            for (int m = 0; m < 4; ++m)
#pragma unroll
                for (int n = 0; n < 2; ++n) { float z_ = 0.f; asm volatile("" : "+v"(z_)); acc[a][b][m][n] = (f32x4){z_, z_, z_, z_}; }
    bf16x8 At[4][2], B0[2][2], B1[2][2];
    const char* cA = (const char*)g.A + (g.pn_per_ab ? (size_t)(cur.pn / g.pn_per_ab) * g.ab_stride : (size_t)0) + (size_t)cur.pm * tstep; const char* cB = (const char*)g.Bt + (size_t)cur.pn * tstep;
    S.a_ready(cur);
    if constexpr (SP2) {
        PG8_STAGE(PG8_SB(0, 0), cB, voffB); PG8_STAGE(PG8_SB(0, 1), cB + hstep, voffB); PG8_STAGE(PG8_SA(0, 0), cA, voffA); PG8_STAGE(PG8_SA(0, 1), cA + hstep, voffA);
        if (wr == 1) PG8_BAR;
        PG8_WAIT_V(2); PG8_BAR;
        PG8_STAGE(PG8_SB(1, 0), cB + kstep, voffB); PG8_STAGE(PG8_SA(1, 0), cA + kstep, voffA); PG8_STAGE(PG8_SB(1, 1), cB + hstep + kstep, voffB);
        PG8_WAIT_V(6); PG8_BAR;
    } else {
        PG8_STAGE(PG8_SB(0, 0), cB, voffB); PG8_STAGE(PG8_SA(0, 0), cA, voffA); PG8_STAGE(PG8_SB(0, 1), cB + hstep, voffB); PG8_STAGE(PG8_SA(0, 1), cA + hstep, voffA);
        if (wr == 1) PG8_BAR;
        PG8_WAIT_V(4); PG8_BAR;
        PG8_STAGE(PG8_SB(1, 0), cB + kstep, voffB); PG8_STAGE(PG8_SA(1, 0), cA + kstep, voffA); PG8_STAGE(PG8_SB(1, 1), cB + hstep + kstep, voffB);
        PG8_WAIT_V(6); PG8_BAR;
    }
    for (;;) {
        const bool has_next = S.next(ui + 1, nxt);
        const char* nA = has_next ? (const char*)g.A + (g.pn_per_ab ? (size_t)(nxt.pn / g.pn_per_ab) * g.ab_stride : (size_t)0) + (size_t)nxt.pm * tstep : cA; const char* nB = has_next ? (const char*)g.Bt + (size_t)nxt.pn * tstep : cB;
#pragma unroll 1
        for (int t = 0; t < nt; t += 2) {
            const bool last = (t == nt - 2);
            const char* a1 = cA + (size_t)(t + 1) * kstep;
            const char* a2 = last ? nA : cA + (size_t)(t + 2) * kstep; const char* b2 = last ? nB : cB + (size_t)(t + 2) * kstep;
            const char* a3 = a2 + kstep; const char* b3 = b2 + kstep;
            if (last && has_next) S.a_ready(nxt);
            if constexpr (SP2) {
            PG8_LDB(B0, 0, 0); PG8_LDB(B1, 0, 1); PG8_SCHED; PG8_LDA(At, 0, 0); PG8_STAGE(PG8_SA(1, 1), a1 + hstep, voffA);
            PG8_WAIT_V(8); PG8_WAIT_L(0); PG8_BAR; PG8_MMA(0, 0, At, B0); PG8_MMA(0, 1, At, B1); PG8_BAR; PG8_SCHED;
            PG8_LDA(At, 0, 1); PG8_STAGE(PG8_SB(0, 0), b2, voffB); PG8_STAGE(PG8_SB(0, 1), b2 + hstep, voffB); PG8_STAGE(PG8_SA(0, 0), a2, voffA);
            PG8_WAIT_V(8); PG8_WAIT_L(0); PG8_BAR; PG8_MMA(1, 0, At, B0); PG8_MMA(1, 1, At, B1); PG8_BAR; PG8_SCHED;
            PG8_LDB(B0, 1, 0); PG8_LDB(B1, 1, 1); PG8_SCHED; PG8_LDA(At, 1, 0); PG8_STAGE(PG8_SA(0, 1), a2 + hstep, voffA);
            PG8_WAIT_V(8); PG8_WAIT_L(0); PG8_BAR; PG8_MMA(0, 0, At, B0); PG8_MMA(0, 1, At, B1); PG8_BAR; PG8_SCHED;
            PG8_LDA(At, 1, 1); PG8_STAGE(PG8_SB(1, 0), b3, voffB); PG8_STAGE(PG8_SB(1, 1), b3 + hstep, voffB); PG8_STAGE(PG8_SA(1, 0), a3, voffA);
            PG8_WAIT_V(8); PG8_WAIT_L(0); PG8_BAR; PG8_MMA(1, 0, At, B0); PG8_MMA(1, 1, At, B1); PG8_BAR; PG8_SCHED;
            } else {
            PG8_LDB(B0, 0, 0); PG8_SCHED; PG8_LDA(At, 0, 0); PG8_STAGE(PG8_SA(1, 1), a1 + hstep, voffA);
            PG8_WAIT_L(8); PG8_BAR; PG8_WAIT_L(0); PG8_MMA(0, 0, At, B0); PG8_BAR; PG8_SCHED;
            PG8_LDB(B1, 0, 1); PG8_STAGE(PG8_SB(0, 0), b2, voffB);
            PG8_BAR; PG8_WAIT_L(0); PG8_MMA(0, 1, At, B1); PG8_BAR;
            PG8_LDA(At, 0, 1); PG8_STAGE(PG8_SA(0, 0), a2, voffA);
            PG8_BAR; PG8_WAIT_L(0); PG8_MMA(1, 0, At, B0); PG8_BAR; PG8_SCHED;
            PG8_STAGE(PG8_SB(0, 1), b2 + hstep, voffB);
            PG8_WAIT_V(6); PG8_BAR; PG8_MMA(1, 1, At, B1); PG8_BAR;
            PG8_LDB(B0, 1, 0); PG8_SCHED; PG8_LDA(At, 1, 0); PG8_STAGE(PG8_SA(0, 1), a2 + hstep, voffA);
            PG8_WAIT_L(8); PG8_BAR; PG8_WAIT_L(0); PG8_MMA(0, 0, At, B0); PG8_BAR; PG8_SCHED;
            PG8_LDB(B1, 1, 1); PG8_STAGE(PG8_SB(1, 0), b3, voffB);
            PG8_BAR; PG8_WAIT_L(0); PG8_MMA(0, 1, At, B1); PG8_BAR;
            PG8_LDA(At, 1, 1); PG8_STAGE(PG8_SA(1, 0), a3, voffA);
            PG8_BAR; PG8_WAIT_L(0); PG8_MMA(1, 0, At, B0); PG8_BAR; PG8_SCHED;
            PG8_STAGE(PG8_SB(1, 1), b3 + hstep, voffB);
            PG8_WAIT_V(6); PG8_BAR; PG8_MMA(1, 1, At, B1); PG8_BAR;
            }
        }
        if constexpr (ALIGN_EPI) { if (wr == 0) PG8_BAR; }
        if constexpr (!Epi::AFTER_DRAIN) { E(acc, cur, wr, wc, fr, fq); S.done(cur); }
        if (!has_next) break;
#pragma unroll
        for (int a = 0; a < 2; ++a)
#pragma unroll
            for (int b = 0; b < 2; ++b)
#pragma unroll
                for (int m = 0; m < 4; ++m)
#pragma unroll
                    for (int n = 0; n < 2; ++n) { float z_ = 0.f; asm volatile("" : "+v"(z_)); acc[a][b][m][n] = (f32x4){z_, z_, z_, z_}; }
        cur = nxt; cA = nA; cB = nB; ++ui;
        if constexpr (ALIGN_EPI) { if (wr == 1) PG8_BAR; }
    }
    PG8_WAIT_V(0);
    if constexpr (!ALIGN_EPI) { if (wr == 0) PG8_BAR; }
    PG8_BAR;
    if constexpr (Epi::AFTER_DRAIN) { E.fused(acc, cur, wr, wc, fr, fq, lds, wid, lane); S.done(cur); }
#undef PG8_SA
#undef PG8_SB
#undef PG8_STAGE
#undef PG8_LDA
#undef PG8_LDB
#undef PG8_MMA
#undef PG8_WAIT_V
#undef PG8_WAIT_L
#undef PG8_BAR
#undef PG8_SCHED
}
}
typedef unsigned short bf16_t;
typedef short bf16x8 __attribute__((ext_vector_type(8)));
typedef float f32x4 __attribute__((ext_vector_type(4)));
typedef float f32x16 __attribute__((ext_vector_type(16)));
constexpr int LSEQ = 4112, TREAL = 16384, TG = 16448, TGP = 16640, NGRP = 3;
constexpr size_t SLOT_E = (size_t)TGP * 512;
constexpr size_t SLOT_B = SLOT_E * 2;
constexpr size_t MiB = 1u << 20;
constexpr size_t WS_XMETA = 1 * MiB, WS_DECAY = 2 * MiB, WS_SIDE = 3 * MiB + 512 * 1024, WS_W = 5 * MiB, WS_SLOTS = 53 * MiB;
constexpr size_t WS_NEED = 512 * MiB;
static_assert(WS_SLOTS + 25 * SLOT_B + (size_t)(16448 - 11408) * 8960 <= 512 * MiB, "record tail fits the workspace");
constexpr size_t WO_IN = 0, WO_G = 7864320, WO_BP = 12058624, WO_OUT = 14155776, WO_1 = 15204352, WO_2 = 19398656, WO_LR = 23592960;
constexpr int LDS_BYTES = 140 * 1024;
enum { I_XP = 0, I_XS, I_META, I_NMIX, I_WIN, I_LBL, I_ONORM, I_CONV, I_QN, I_KN, I_LAM, I_SUBLN, I_MU, I_W0, I_W2, I_A0, I_A2, I_G2, I_KK, I_KA, I_RK, I_LNG, I_LNB, I_WG, I_BP, I_WOUT, I_NMLP, I_W1, I_W2M };
struct Params { const float* in[29]; float* out; unsigned char* ws; };
#define GPTR(T, p) ((T*)(__attribute__((address_space(1))) T*)(p))
typedef const __attribute__((address_space(4))) Params* KParamsPtr;
typedef unsigned u32x4g_t __attribute__((ext_vector_type(4)));
#define GLD16(p) (*(const __attribute__((address_space(1))) u32x4g_t*)(p))
DEV KParamsPtr kparams() { KParamsPtr p = (KParamsPtr)__builtin_amdgcn_kernarg_segment_ptr(); asm volatile("" : "+s"(p)); return p; }
DEV Params load_params() { KParamsPtr p = kparams(); Params r;
#pragma unroll
    for (int i = 0; i < 29; ++i) r.in[i] = GPTR(const float, p->in[i]);
    r.out = GPTR(float, p->out); r.ws = p->ws; return r; }
DEV unsigned zero_u() { unsigned z = 0u; asm volatile("" : "+v"(z)); return z; }

#define ROWPRO const int tid_ = launder_tid(wv); const int lane = tid_ & 63; const int gw = bid * 8 + __builtin_amdgcn_readfirstlane(tid_ >> 6); const int ngw = nb * 8;
DEV float bf2f(unsigned short u) { return __uint_as_float((unsigned)u << 16); }
DEV unsigned pk2(float lo, float hi) { return pg8::cvt_pk_bf16(lo, hi); }
DEV void unpack8(const uint4 w, float* f) {
    f[0] = __uint_as_float(w.x << 16); f[1] = __uint_as_float(w.x & 0xffff0000u); f[2] = __uint_as_float(w.y << 16); f[3] = __uint_as_float(w.y & 0xffff0000u);
    f[4] = __uint_as_float(w.z << 16); f[5] = __uint_as_float(w.z & 0xffff0000u); f[6] = __uint_as_float(w.w << 16); f[7] = __uint_as_float(w.w & 0xffff0000u); }
DEV uint4 pack8(const float* f) { uint4 o; o.x = pk2(f[0], f[1]); o.y = pk2(f[2], f[3]); o.z = pk2(f[4], f[5]); o.w = pk2(f[6], f[7]); return o; }
DEV bf16_t* slotp(const Params& P, int s) { return GPTR(bf16_t, P.ws + WS_SLOTS + (size_t)s * SLOT_B); }
DEV int row_of(int sl, int p) { return p >= 16 ? sl * 4096 + p - 16 : TREAL + sl * 16 + p; }
DEV void pos_of(int r, int& sl, int& p) { if (r < TREAL) { sl = r >> 12; p = (r & 4095) + 16; } else { const int m = r - TREAL; sl = m >> 4; p = m & 15; } }
DEV float wave_sum(float v) {
#pragma unroll
    for (int o = 1; o < 64; o <<= 1) v += __shfl_xor(v, o);
    return v; }
DEV float red8(float v) { v += __shfl_xor(v, 1); v += __shfl_xor(v, 2); v += __shfl_xor(v, 4); return v; }
DEV f32x4 mfma16(bf16x8 a, bf16x8 b, f32x4 c) { return __builtin_amdgcn_mfma_f32_16x16x32_bf16(a, b, c, 0, 0, 0); }
DEV f32x16 mfma32(bf16x8 a, bf16x8 b, f32x16 c) { return __builtin_amdgcn_mfma_f32_32x32x16_bf16(a, b, c, 0, 0, 0); }
DEV const float* x_in_row(const Params& P, int g, int r) {
    if (r < TREAL) return (g < 2 ? P.in[I_XP] + (size_t)g * TREAL * 1024 : P.in[I_XS]) + (size_t)r * 1024;
    return P.in[I_META] + (size_t)((r - TREAL) & 15) * 1024; }
DEV float* x_cur_row(const Params& P, int g, int r) {
    if (r < TREAL) return P.out + ((size_t)g * TREAL + r) * 1024;
    const int m = r - TREAL;
    return GPTR(float, P.ws + WS_XMETA) + (size_t)(m < 64 ? g * 64 + m : ((m >> 6) - 1) * 64 + (m & 63)) * 1024; }

DEV int gate_row(int n) { const int br = n >> 10, c = n & 1023, pn = c >> 6, oc = c & 63, wc = oc >> 4, fq = (oc >> 2) & 3, i = oc & 3; return pn * 256 + (br >> 1) * 128 + wc * 32 + fq * 8 + (br & 1) * 4 + i; }
template <int MODE> DEV void wt_items(const float* __restrict__ W, int K, int N, bf16_t* WT, int row_off, float* scr, int gw, int ngw, int lane) {
    const int nblk = N >> 5, items = (K >> 6) * nblk;
    for (int it = gw; it < items; it += ngw) {
        const int kb = it / nblk, nbk = it - kb * nblk, k0 = 64 * kb, n0 = 32 * nbk;
#pragma unroll 8
        for (int i = 0; i < 32; ++i) { const int kk = 2 * i + (lane >> 5); scr[kk * 33 + (lane & 31)] = W[(size_t)(k0 + kk) * N + n0 + (lane & 31)]; }
        asm volatile("s_waitcnt lgkmcnt(0)" ::: "memory");
        const int c = lane & 7;
#pragma unroll
        for (int j = 0; j < 4; ++j) { const int n = (lane >> 3) + 8 * j; const float* sp = scr + (8 * c) * 33 + n;
            uint4 o; o.x = pk2(sp[0 * 33], sp[1 * 33]); o.y = pk2(sp[2 * 33], sp[3 * 33]); o.z = pk2(sp[4 * 33], sp[5 * 33]); o.w = pk2(sp[6 * 33], sp[7 * 33]);
            const int dr = MODE == 1 ? gate_row(n0 + n) : n0 + n + row_off;
            *(uint4*)(WT + (size_t)dr * K + k0 + 8 * c) = o; }
        asm volatile("s_waitcnt lgkmcnt(0)" ::: "memory");
    }
}
DEV void phase_weights(const Params& P0, int layer, unsigned char* lds, int bid, int nb, int wv) {
    Params P = load_params(); asm volatile("" : "+s"(P.ws));
    const int tid = launder_tid(wv), lane = tid & 63, w = __builtin_amdgcn_readfirstlane(tid >> 6);
    const int gtid = bid * 512 + tid, gth = nb * 512, gw = bid * 8 + w, ngw = nb * 8;
    float* scr = (float*)(lds + w * 8448);
    bf16_t* W = GPTR(bf16_t, P.ws + WS_W);
    wt_items<0>(P.in[I_WIN] + (size_t)layer * 1024 * 7552, 1024, 7552, W + WO_IN, 0, scr, gw, ngw, lane);
    for (int it = gtid; it < 128 * 128; it += gth) { const unsigned z = zero_u(); *(uint4*)(W + WO_IN + (size_t)7552 * 1024 + (size_t)it * 8) = make_uint4(z, z, z, z); }
    wt_items<1>(P.in[I_WG] + (size_t)layer * 1024 * 4096, 1024, 4096, W + WO_G, 0, scr, gw, ngw, lane);
    for (int n = 0; n < 4; ++n) wt_items<0>(P.in[I_BP] + (size_t)(layer * 4 + n) * 512 * 1024, 512, 1024, W + WO_BP, n * 1024, scr, gw, ngw, lane);
    wt_items<0>(P.in[I_WOUT] + (size_t)layer * 1024 * 1024, 1024, 1024, W + WO_OUT, 0, scr, gw, ngw, lane);
    wt_items<0>(P.in[I_W1] + (size_t)layer * 1024 * 4096, 1024, 4096, W + WO_1, 0, scr, gw, ngw, lane);
    wt_items<0>(P.in[I_W2M] + (size_t)layer * 4096 * 1024, 4096, 1024, W + WO_2, 0, scr, gw, ngw, lane);
    for (int it = gtid; it < 2560 * 48; it += gth) {
        const int row = it / 48, k8 = it - row * 48, seg = row >> 9, c = row & 511, k0 = k8 * 8;
        float v[8];
#pragma unroll
        for (int j = 0; j < 8; ++j) { const int k = k0 + j; float x = 0.f;
            if (seg == 0) { if (k < 64) x = P.in[I_W2][((size_t)(layer * 2 + 0) * 64 + k) * 512 + c]; }
            else if (seg == 1) { if (k >= 64 && k < 128) x = P.in[I_W2][((size_t)(layer * 2 + 1) * 64 + (k - 64)) * 512 + c]; }
            else if (seg == 2) { if (k >= 128 && k < 192) x = P.in[I_A2][((size_t)(layer * 2 + 0) * 64 + (k - 128)) * 512 + c]; }
            else if (seg == 3) { if (k >= 192 && k < 256) x = P.in[I_A2][((size_t)(layer * 2 + 1) * 64 + (k - 192)) * 512 + c]; }
            else { if (k >= 256) x = P.in[I_G2][((size_t)layer * 128 + (k - 256)) * 512 + c]; }
            v[j] = x; }
        *(uint4*)(W + WO_LR + (size_t)row * 384 + k0) = pack8(v);
    }
}

DEV void phase_rmsnorm(const Params& P0, int g, bool src_in, int gain_idx, int layer, int nrows, int nvalid, int bid, int nb, int wv) {
    Params P = load_params(); asm volatile("" : "+s"(P.ws));
    ROWPRO
    const float* gain = P.in[gain_idx] + layer * 1024;
    bf16_t* H = slotp(P, 0);
    for (int r = gw; r < nrows; r += ngw) {
        uint2* o8 = (uint2*)(H + (size_t)r * 1024) + lane;
        if (r >= nvalid) {
#pragma unroll
            for (int j = 0; j < 4; ++j) { const unsigned z = zero_u(); o8[64 * j] = make_uint2(z, z); }
            continue; }
        const f32x4* xr = (const f32x4*)(src_in ? x_in_row(P, g, r) : (const float*)x_cur_row(P, g, r)) + lane;
        f32x4 v[4]; float s = 0.f;
#pragma unroll
        for (int j = 0; j < 4; ++j) { v[j] = xr[64 * j]; s += (v[j].x * v[j].x + v[j].y * v[j].y) + (v[j].z * v[j].z + v[j].w * v[j].w); }
        const float rs = rsqrtf(wave_sum(s) * (1.f / 1024.f) + 1e-6f);
#pragma unroll
        for (int j = 0; j < 4; ++j) { const f32x4 gg = *((const f32x4*)gain + lane + 64 * j);
            o8[64 * j] = make_uint2(pk2(v[j].x * rs * gg.x, v[j].y * rs * gg.y), pk2(v[j].z * rs * gg.z, v[j].w * rs * gg.w)); }
    }
}
DEV void phase_da_prep(const Params& P0, int layer, int bid, int nb, int wv) {
    Params P = load_params(); asm volatile("" : "+s"(P.ws));
    ROWPRO
    const float inv8[8] = {1.0f, 0.19392274474868576f, 0.03760603093086393f, 0.007292664737217109f, 0.001414213562373095f, 0.0002742481756762073f, 5.318295896944988e-05f, 1.031338537721246e-05f};
    const int d0 = (lane & 7) * 8;
    float gq[8], gk[8];
#pragma unroll
    for (int j = 0; j < 8; ++j) { gq[j] = P.in[I_QN][layer * 64 + d0 + j]; gk[j] = P.in[I_KN][layer * 64 + d0 + j]; }
    for (int r = gw; r < TG; r += ngw) {
        int sl, p; pos_of(r, sl, p);
        float cs[8], sn[8];
#pragma unroll
        for (int j = 0; j < 8; ++j) { const float ang = (float)p * inv8[j]; double a = (double)ang; a -= 6.283185307179586 * __builtin_rint(a * 0.15915494309189535); const float rr = (float)a; cs[j] = __cosf(rr); sn[j] = __sinf(rr); }
#pragma unroll
        for (int which = 0; which < 2; ++which) {
            uint4* ptr = (uint4*)(slotp(P, 10 + which) + (size_t)r * 512) + lane;
            float f[8]; unpack8(*ptr, f);
            float ss = 0.f;
#pragma unroll
            for (int j = 0; j < 8; ++j) ss += f[j] * f[j];
            ss = red8(ss);
            const float rs = rsqrtf(ss * (1.f / 64.f) + 1e-6f);
#pragma unroll
            for (int j = 0; j < 8; ++j) f[j] = f[j] * rs * (which == 0 ? gq[j] : gk[j]);
#pragma unroll
            for (int j = 0; j < 8; ++j) { const float pr = __shfl_xor(f[j], 1);
                if ((lane & 7) == 0) f[j] = f[j] * cs[j] - pr * sn[j];
                else if ((lane & 7) == 1) f[j] = f[j] * cs[j] + pr * sn[j]; }
            if (which == 0) {
#pragma unroll
                for (int j = 0; j < 8; ++j) f[j] *= 0.18033688011112042f; }
            *ptr = pack8(f);
        }
    }
}
DEV void phase_conv(const Params& P0, int layer, int bid, int nb, int wv) {
    Params P = load_params(); asm volatile("" : "+s"(P.ws));
    ROWPRO
    const int c0 = lane * 8;
    float w0[8], w1[8], w2[8];
#pragma unroll
    for (int j = 0; j < 8; ++j) { w0[j] = P.in[I_CONV][(layer * 3 + 0) * 512 + c0 + j]; w1[j] = P.in[I_CONV][(layer * 3 + 1) * 512 + c0 + j]; w2[j] = P.in[I_CONV][(layer * 3 + 2) * 512 + c0 + j]; }
    const bf16_t* SB = slotp(P, 7); const bf16_t* SC = slotp(P, 8); const bf16_t* SH = slotp(P, 9); bf16_t* Y = slotp(P, 3);
    for (int r = gw; r < TG; r += ngw) {
        int sl, p; pos_of(r, sl, p);
        float acc[8], a[8], b[8];
        unpack8(*((const uint4*)(SC + (size_t)r * 512) + lane), a); unpack8(*((const uint4*)(SH + (size_t)r * 512) + lane), b);
#pragma unroll
        for (int j = 0; j < 8; ++j) acc[j] = a[j] * b[j] * w1[j];
        if (p > 0) { const int rp = row_of(sl, p - 1);
            unpack8(*((const uint4*)(SC + (size_t)rp * 512) + lane), a); unpack8(*((const uint4*)(SH + (size_t)rp * 512) + lane), b);
#pragma unroll
            for (int j = 0; j < 8; ++j) acc[j] += a[j] * b[j] * w0[j]; }
        if (p < LSEQ - 1) { const int rn = row_of(sl, p + 1);
            unpack8(*((const uint4*)(SC + (size_t)rn * 512) + lane), a); unpack8(*((const uint4*)(SH + (size_t)rn * 512) + lane), b);
#pragma unroll
            for (int j = 0; j < 8; ++j) acc[j] += a[j] * b[j] * w2[j]; }
        unpack8(*((const uint4*)(SB + (size_t)r * 512) + lane), a);
#pragma unroll
        for (int j = 0; j < 8; ++j) acc[j] *= a[j];
        *((uint4*)(Y + (size_t)r * 512) + lane) = pack8(acc);
    }
}
DEV void phase_rw_prep(const Params& P0, int layer, int bid, int nb, int wv) {
    Params P = load_params(); asm volatile("" : "+s"(P.ws));
    ROWPRO
    const float* mu = P.in[I_MU] + (size_t)layer * 1920;
    for (int r = gw; r < TG; r += ngw) {
        int sl, p; pos_of(r, sl, p);
        const int rp = p > 0 ? row_of(sl, p - 1) : -1, rn = p < LSEQ - 1 ? row_of(sl, p + 1) : -1;
#pragma unroll
        for (int grp = 0; grp < 4; ++grp) {
            if (grp == 3 && lane >= 48) break;
            const int c0 = (grp < 3 ? grp * 512 : 1536) + lane * 8;
            const bf16_t* src = slotp(P, 13 + (c0 >> 9)) + (c0 & 511);
            float u[8], up[8], un[8], xm[8];
            unpack8(*(const uint4*)(src + (size_t)r * 512), u);
            if (rp >= 0) unpack8(*(const uint4*)(src + (size_t)rp * 512), up); else {
#pragma unroll
                for (int j = 0; j < 8; ++j) up[j] = 0.f; }
            if (rn >= 0) unpack8(*(const uint4*)(src + (size_t)rn * 512), un); else {
#pragma unroll
                for (int j = 0; j < 8; ++j) un[j] = 0.f; }
#pragma unroll
            for (int j = 0; j < 8; ++j) xm[j] = u[j] + mu[c0 + j] * (0.5f * (up[j] + un[j]) - u[j]);
            if (grp < 3) {
                *((uint4*)(slotp(P, 17 + grp) + (size_t)r * 512) + lane) = pack8(xm);
                if (grp == 1) {
                    float kk[8], ss = 0.f;
#pragma unroll
                    for (int j = 0; j < 8; ++j) { kk[j] = xm[j] * P.in[I_KK][layer * 512 + c0 - 512 + j]; ss += kk[j] * kk[j]; }
                    ss = red8(ss);
                    const float inv = 1.0f / fmaxf(sqrtf(ss), 1e-12f);
#pragma unroll
                    for (int j = 0; j < 8; ++j) kk[j] *= inv;
                    *((uint4*)(slotp(P, 20) + (size_t)r * 512) + lane) = pack8(kk); }
            } else {
                const int a0 = lane * 8;
                float o[8];
#pragma unroll
                for (int j = 0; j < 8; ++j) { const float x = xm[j];
                    if (a0 < 128) { const float e = __expf(2.f * x); o[j] = 1.f - 2.f / (e + 1.f); }
                    else if (a0 < 256) o[j] = x;
                    else o[j] = 1.f / (1.f + __expf(-x)); }
                *((uint4*)(slotp(P, 21) + (size_t)r * 384) + lane) = pack8(o);
            }
        }
    }
    for (int r = TG + gw; r < TGP; r += ngw) if (lane < 48) { const unsigned z = zero_u(); *((uint4*)(slotp(P, 21) + (size_t)r * 384) + lane) = make_uint4(z, z, z, z); }
}
DEV void phase_rw_post(const Params& P0, int layer, int g, int nrows, int bid, int nb, int wv) {
    Params P = load_params(); asm volatile("" : "+s"(P.ws));
    ROWPRO
    const int c0 = lane * 8;
    float ka[8], rk[8], lg[8], lb[8];
#pragma unroll
    for (int j = 0; j < 8; ++j) { ka[j] = P.in[I_KA][layer * 512 + c0 + j]; rk[j] = P.in[I_RK][layer * 512 + c0 + j]; lg[j] = P.in[I_LNG][layer * 512 + c0 + j]; lb[j] = P.in[I_LNB][layer * 512 + c0 + j]; }
    for (int r = gw; r < nrows; r += ngw) {
        float of[8], ob[8], o[8];
        unpack8(*((const uint4*)(slotp(P, 15) + (size_t)r * 512) + lane), of); unpack8(*((const uint4*)(slotp(P, 16) + (size_t)r * 512) + lane), ob);
        float s = 0.f;
#pragma unroll
        for (int j = 0; j < 8; ++j) { o[j] = of[j] + ob[j]; s += o[j]; }
        const float mean = red8(s) * (1.f / 64.f);
        float q = 0.f;
#pragma unroll
        for (int j = 0; j < 8; ++j) { o[j] -= mean; q += o[j] * o[j]; }
        const float rs = rsqrtf(red8(q) * (1.f / 64.f) + 64e-5f);
        float rr[8], kk[8], vv[8], af[8], ab[8], gg[8];
        unpack8(*((const uint4*)(slotp(P, 17) + (size_t)r * 512) + lane), rr); unpack8(*((const uint4*)(slotp(P, 18) + (size_t)r * 512) + lane), kk);
        unpack8(*((const uint4*)(slotp(P, 19) + (size_t)r * 512) + lane), vv); unpack8(*((const uint4*)(slotp(P, 24) + (size_t)r * 512) + lane), af);
        unpack8(*((const uint4*)(slotp(P, 13) + (size_t)r * 512) + lane), ab); unpack8(*((const uint4*)(slotp(P, 14) + (size_t)r * 512) + lane), gg);
        float bs = 0.f;
#pragma unroll
        for (int j = 0; j < 8; ++j) { const float kd = kk[j] * (2.f + (af[j] + ab[j] - 2.f) * ka[j]); bs += rr[j] * kd * rk[j]; }
        bs = red8(bs);
        float y[8];
#pragma unroll
        for (int j = 0; j < 8; ++j) y[j] = (o[j] * rs * lg[j] + lb[j] + bs * vv[j]) * gg[j];
        const uint4 yv = pack8(y);
        *((uint4*)(slotp(P, 5) + (size_t)r * 512) + lane) = yv;
        if (layer == 0 && g < 2 && r >= TREAL) {
            bf16_t* sd = GPTR(bf16_t, P.ws + WS_SIDE) + (size_t)g * 4 * 64 * 512 + (size_t)(r - TREAL) * 512;
#pragma unroll
            for (int k = 0; k < 3; ++k) *((uint4*)(sd + (size_t)k * 64 * 512) + lane) = *((const uint4*)(slotp(P, 2 + k) + (size_t)r * 512) + lane);
            *((uint4*)(sd + (size_t)3 * 64 * 512) + lane) = yv; }
    }
    if (layer == 0 && g == 2) {
        for (int m2 = gw; m2 < 128; m2 += ngw) { const bf16_t* sd = GPTR(const bf16_t, P.ws + WS_SIDE) + (size_t)(m2 >> 6) * 4 * 64 * 512 + (size_t)(m2 & 63) * 512;
#pragma unroll
            for (int k = 0; k < 4; ++k) *((uint4*)(slotp(P, 2 + k) + (size_t)(TG + m2) * 512) + lane) = *((const uint4*)(sd + (size_t)k * 64 * 512) + lane); }
    }
}
DEV void hg_gate(float x, float lbv, float& lg, float& kk) {
    const float e = __expf(-fabsf(x)); const float sp = 1.f / (1.f + e);
    const float s = x >= 0.f ? sp : e * sp, s1 = x >= 0.f ? e * sp : sp;
    const float f = fmaxf(lbv, 1e-20f) + (1.f - lbv) * s;
    lg = __logf(f); kk = (1.f - lbv) * s1; }
DEV float hg_lb(const Params& P, int layer, int dir, int col) {
    if (layer == 0) return 0.f;
    const float a = P.in[I_LBL][(dir * 2 + 0) * 512 + col], b = P.in[I_LBL][(dir * 2 + 1) * 512 + col];
    return 1.f / (1.f + __expf(a - b)); }
DEV int hg_row(int sl, int c, int j, bool& valid) { if (c == 0) { valid = j < 16; return TREAL + sl * 16 + j; } valid = true; return sl * 4096 + (c - 1) * 64 + j; }
DEV void hg_cumsum(float* Lb, float* Bt, float* Seg, int dir, int tid) {
    const int ch = tid & 127, seg = tid >> 7;
    float v[16];
#pragma unroll
    for (int i = 0; i < 16; ++i) v[i] = Lb[(seg * 16 + i) * 128 + ch];
    if (dir == 0) {
#pragma unroll
        for (int i = 1; i < 16; ++i) v[i] += v[i - 1];
        Seg[seg * 128 + ch] = v[15];
    } else {
#pragma unroll
        for (int i = 14; i >= 0; --i) v[i] += v[i + 1];
        Seg[seg * 128 + ch] = v[0];
    }
    __syncthreads();
    const float s0 = Seg[ch], s1 = Seg[128 + ch], s2 = Seg[256 + ch], s3 = Seg[384 + ch];
    float off;
    if (dir == 0) off = seg == 0 ? 0.f : seg == 1 ? s0 : seg == 2 ? s0 + s1 : s0 + s1 + s2;
    else off = seg == 3 ? 0.f : seg == 2 ? s3 : seg == 1 ? s3 + s2 : s3 + s2 + s1;
#pragma unroll
    for (int i = 0; i < 16; ++i) Lb[(seg * 16 + i) * 128 + ch] = v[i] + off;
    if (seg == 0) Bt[ch] = (s0 + s1) + (s2 + s3);
}
DEV void phase_hg1(const Params& P0, int layer, unsigned char* lds, int bid, int nb, int wv) {
    Params P = load_params(); asm volatile("" : "+s"(P.ws));
    float* Lb = (float*)lds; bf16_t* KlT = (bf16_t*)(lds + 32768); bf16_t* VT = (bf16_t*)(lds + 32768 + 18432); float* Bt = (float*)(lds + 69632); float* Seg = (float*)(lds + 70656);
    bf16_t* X = slotp(P, 17); float* DC = GPTR(float, P.ws + WS_DECAY);
    const int tid = launder_tid(wv), lane = tid & 63, w = __builtin_amdgcn_readfirstlane(tid >> 6), j = tid >> 3, c0 = (tid & 7) * 16, l15 = lane & 15, quad = lane >> 4;
    for (int unit = bid; unit < 32 * 65; unit += nb) {
        const int chain = unit / 65, c = unit - chain * 65, sl = chain >> 3, head = (chain >> 1) & 3, dir = chain & 1;
        bool valid; const int r = hg_row(sl, c, j, valid);
        float lg[16], kk[16]; uint4 vv[2] = {make_uint4(0, 0, 0, 0), make_uint4(0, 0, 0, 0)};
        if (valid) {
            float fr[16];
            const uint4* fp = (const uint4*)(slotp(P, 3 + dir) + (size_t)r * 512 + head * 128 + c0);
            unpack8(fp[0], fr); unpack8(fp[1], fr + 8);
            const uint4* vp = (const uint4*)(slotp(P, 5) + (size_t)r * 512 + head * 128 + c0); vv[0] = vp[0]; vv[1] = vp[1];
#pragma unroll
            for (int e = 0; e < 16; ++e) hg_gate(fr[e], hg_lb(P, layer, dir, head * 128 + c0 + e), lg[e], kk[e]);
        } else {
#pragma unroll
            for (int e = 0; e < 16; ++e) { lg[e] = 0.f; kk[e] = 0.f; } }
#pragma unroll
        for (int e = 0; e < 16; e += 4) *(f32x4*)(Lb + j * 128 + c0 + e) = (f32x4){lg[e], lg[e + 1], lg[e + 2], lg[e + 3]};
        __syncthreads();
        hg_cumsum(Lb, Bt, Seg, dir, tid);
        __syncthreads();
        float vf[16]; unpack8(vv[0], vf); unpack8(vv[1], vf + 8);
#pragma unroll
        for (int e = 0; e < 16; ++e) { const float kl = kk[e] * __expf(Bt[c0 + e] - Lb[j * 128 + c0 + e]);
            KlT[(c0 + e) * 72 + j] = (bf16_t)(pk2(kl, 0.f) & 0xffffu); VT[(c0 + e) * 72 + j] = (bf16_t)(__float_as_uint(vf[e]) >> 16); }
        if (tid < 128) DC[(size_t)(chain * 65 + c) * 128 + tid] = __expf(Bt[tid]);
        __syncthreads();
        f32x4 acc[8];
#pragma unroll
        for (int ct = 0; ct < 8; ++ct) acc[ct] = (f32x4){0.f, 0.f, 0.f, 0.f};
#pragma unroll
        for (int ks = 0; ks < 2; ++ks) { const bf16x8 a = *(const bf16x8*)(VT + (w * 16 + l15) * 72 + ks * 32 + quad * 8);
#pragma unroll
            for (int ct = 0; ct < 8; ++ct) { const bf16x8 b = *(const bf16x8*)(KlT + (ct * 16 + l15) * 72 + ks * 32 + quad * 8); acc[ct] = mfma16(b, a, acc[ct]); } }
        bf16_t* xo = X + (size_t)(chain * 65 + c) * 16384;
#pragma unroll
        for (int ct = 0; ct < 8; ++ct) *(uint2*)(xo + (w * 16 + l15) * 128 + ct * 16 + quad * 4) = make_uint2(pk2(acc[ct][0], acc[ct][1]), pk2(acc[ct][2], acc[ct][3]));
        __syncthreads();
    }
}
DEV void phase_hg2(const Params& P0, int bid, int nb, int wv) {
    Params P = load_params(); asm volatile("" : "+s"(P.ws));
    const int gtid = bid * 512 + launder_tid(wv), gth = nb * 512;
    uint2* X = (uint2*)slotp(P, 17); const f32x4* DC = GPTR(const f32x4, P.ws + WS_DECAY);
    for (int e = gtid; e < 32 * 4096; e += gth) {
        const int chain = e >> 12, e4 = e & 4095, dir = chain & 1;
        f32x4 S = (f32x4){0.f, 0.f, 0.f, 0.f};
#pragma unroll 5
        for (int step = 0; step < 65; ++step) { const int c = dir ? 64 - step : step;
            const size_t idx = (size_t)(chain * 65 + c) * 4096 + e4;
            const uint2 kvw = X[idx]; const f32x4 dc = DC[(size_t)(chain * 65 + c) * 32 + (e4 & 31)];
            const f32x4 kv = (f32x4){__uint_as_float(kvw.x << 16), __uint_as_float(kvw.x & 0xffff0000u), __uint_as_float(kvw.y << 16), __uint_as_float(kvw.y & 0xffff0000u)};
            X[idx] = make_uint2(pk2(S[0], S[1]), pk2(S[2], S[3])); S = dc * S + kv; }
    }
}
DEV void phase_hg3(const Params& P0, int layer, unsigned char* lds, int bid, int nb, int wv) {
    Params P = load_params(); asm volatile("" : "+s"(P.ws));
    float* Lb = (float*)lds; bf16_t* Qs = (bf16_t*)(lds + 32768); bf16_t* Ks = (bf16_t*)(lds + 50176); bf16_t* Am = (bf16_t*)(lds + 67584);
    bf16_t* VT = (bf16_t*)(lds + 76800); bf16_t* Sb = (bf16_t*)(lds + 95232); float* Bt = (float*)(lds + 130048); float* Seg = (float*)(lds + 132096); float* Ost = (float*)lds;
    const bf16_t* X = slotp(P, 17);
    const int tid = launder_tid(wv), lane = tid & 63, w = __builtin_amdgcn_readfirstlane(tid >> 6), j = tid >> 3, c0 = (tid & 7) * 16, l15 = lane & 15, quad = lane >> 4;
    const int tt = w >> 1, st0 = (w & 1) * 2, vt0 = (w & 1) * 4;
    const int cfirst = layer == 0 ? 0 : 1;
    const int ncb = 65 - cfirst;
    for (int unit = bid; unit < 16 * ncb; unit += nb) {
        const int sh = unit / ncb, c = unit - sh * ncb + cfirst, sl = sh >> 2, head = sh & 3;
        bool valid; const int r = hg_row(sl, c, j, valid);
        float q[16]; uint4 gv[2] = {make_uint4(0, 0, 0, 0), make_uint4(0, 0, 0, 0)};
        if (valid) {
            const uint4* qp = (const uint4*)(slotp(P, 2) + (size_t)r * 512 + head * 128 + c0); unpack8(qp[0], q); unpack8(qp[1], q + 8);
            const uint4* vp = (const uint4*)(slotp(P, 5) + (size_t)r * 512 + head * 128 + c0); float vf[16]; unpack8(vp[0], vf); unpack8(vp[1], vf + 8);
#pragma unroll
            for (int e = 0; e < 16; ++e) VT[(c0 + e) * 72 + j] = (bf16_t)(__float_as_uint(vf[e]) >> 16);
            const uint4* gp = (const uint4*)(slotp(P, 6) + (size_t)r * 512 + head * 128 + c0); gv[0] = gp[0]; gv[1] = gp[1];
        } else {
#pragma unroll
            for (int e = 0; e < 16; ++e) { q[e] = 0.f; VT[(c0 + e) * 72 + j] = 0; } }
        f32x4 accA[2], accO[4];
#pragma unroll
        for (int i = 0; i < 2; ++i) accA[i] = (f32x4){0.f, 0.f, 0.f, 0.f};
#pragma unroll
        for (int i = 0; i < 4; ++i) accO[i] = (f32x4){0.f, 0.f, 0.f, 0.f};
#pragma unroll 1
        for (int dir = 0; dir < 2; ++dir) {
            float lg[16], kk[16];
            if (valid) { float fr[16];
                const uint4* fp = (const uint4*)(slotp(P, 3 + dir) + (size_t)r * 512 + head * 128 + c0); unpack8(fp[0], fr); unpack8(fp[1], fr + 8);
#pragma unroll
                for (int e = 0; e < 16; ++e) hg_gate(fr[e], hg_lb(P, layer, dir, head * 128 + c0 + e), lg[e], kk[e]);
            } else {
#pragma unroll
                for (int e = 0; e < 16; ++e) { lg[e] = 0.f; kk[e] = 0.f; } }
#pragma unroll
            for (int e = 0; e < 16; e += 4) *(f32x4*)(Lb + j * 128 + c0 + e) = (f32x4){lg[e], lg[e + 1], lg[e + 2], lg[e + 3]};
            __syncthreads();
            hg_cumsum(Lb, Bt, Seg, dir, tid);
            __syncthreads();
            {
                float qs[16], ks[16];
#pragma unroll
                for (int e = 0; e < 16; ++e) { const float b = Lb[j * 128 + c0 + e], rf = Lb[32 * 128 + c0 + e]; qs[e] = q[e] * __expf(b - rf); ks[e] = kk[e] * __expf(rf - b); }
                *(uint4*)(Qs + j * 136 + c0) = pack8(qs); *(uint4*)(Qs + j * 136 + c0 + 8) = pack8(qs + 8);
                *(uint4*)(Ks + j * 136 + c0) = pack8(ks); *(uint4*)(Ks + j * 136 + c0 + 8) = pack8(ks + 8);
            }
            {
                const int chain = sl * 8 + head * 2 + dir; const uint4* xs = (const uint4*)(X + (size_t)(chain * 65 + c) * 16384 + (size_t)(tid >> 2) * 128 + (tid & 3) * 32);
#pragma unroll
                for (int i = 0; i < 4; ++i) *(uint4*)(Sb + (tid >> 2) * 136 + (tid & 3) * 32 + i * 8) = xs[i];
            }
            __syncthreads();
            {
                f32x4 t0 = (f32x4){0.f, 0.f, 0.f, 0.f}, t1 = t0;
#pragma unroll
                for (int k4 = 0; k4 < 4; ++k4) { const bf16x8 a = *(const bf16x8*)(Qs + (tt * 16 + l15) * 136 + k4 * 32 + quad * 8);
                    const bf16x8 b0 = *(const bf16x8*)(Ks + ((st0 + 0) * 16 + l15) * 136 + k4 * 32 + quad * 8); const bf16x8 b1 = *(const bf16x8*)(Ks + ((st0 + 1) * 16 + l15) * 136 + k4 * 32 + quad * 8);
                    t0 = mfma16(a, b0, t0); t1 = mfma16(a, b1, t1); }
#pragma unroll
                for (int jj = 0; jj < 4; ++jj) { const int t = tt * 16 + quad * 4 + jj, s0 = (st0 + 0) * 16 + l15, s1 = (st0 + 1) * 16 + l15;
                    const bool k0 = dir == 0 ? s0 <= t : s0 >= t, k1 = dir == 0 ? s1 <= t : s1 >= t;
                    accA[0][jj] += k0 ? t0[jj] : 0.f; accA[1][jj] += k1 ? t1[jj] : 0.f; }
            }
            __syncthreads();
            {   float qg[16];
#pragma unroll
                for (int e = 0; e < 16; ++e) qg[e] = q[e] * __expf(Lb[j * 128 + c0 + e]);
                *(uint4*)(Qs + j * 136 + c0) = pack8(qg); *(uint4*)(Qs + j * 136 + c0 + 8) = pack8(qg + 8); }
            __syncthreads();
#pragma unroll
            for (int k4 = 0; k4 < 4; ++k4) { const bf16x8 a = *(const bf16x8*)(Qs + (tt * 16 + l15) * 136 + k4 * 32 + quad * 8);
#pragma unroll
                for (int v4 = 0; v4 < 4; ++v4) { const bf16x8 b = *(const bf16x8*)(Sb + ((vt0 + v4) * 16 + l15) * 136 + k4 * 32 + quad * 8); accO[v4] = mfma16(a, b, accO[v4]); } }
            __syncthreads();
        }
#pragma unroll
        for (int s2 = 0; s2 < 2; ++s2)
#pragma unroll
            for (int jj = 0; jj < 4; ++jj) Am[(tt * 16 + quad * 4 + jj) * 72 + (st0 + s2) * 16 + l15] = (bf16_t)(pk2(accA[s2][jj], 0.f) & 0xffffu);
        __syncthreads();
#pragma unroll
        for (int ks = 0; ks < 2; ++ks) { const bf16x8 a = *(const bf16x8*)(Am + (tt * 16 + l15) * 72 + ks * 32 + quad * 8);
#pragma unroll
            for (int v4 = 0; v4 < 4; ++v4) { const bf16x8 b = *(const bf16x8*)(VT + ((vt0 + v4) * 16 + l15) * 72 + ks * 32 + quad * 8); accO[v4] = mfma16(a, b, accO[v4]); } }
#pragma unroll
        for (int v4 = 0; v4 < 4; ++v4)
#pragma unroll
            for (int jj = 0; jj < 4; ++jj) Ost[(tt * 16 + quad * 4 + jj) * 132 + (vt0 + v4) * 16 + l15] = accO[v4][jj];
        __syncthreads();
        {   float o[16], ss = 0.f;
#pragma unroll
            for (int e = 0; e < 16; ++e) { o[e] = Ost[j * 132 + c0 + e]; ss += o[e] * o[e]; }
            ss = red8(ss);
            const float rs = rsqrtf(ss * (1.f / 128.f) + 1e-6f);
            float gf[16]; unpack8(gv[0], gf); unpack8(gv[1], gf + 8);
#pragma unroll
            for (int e = 0; e < 16; ++e) { const float gg = gf[e]; o[e] = o[e] * rs * P.in[I_ONORM][layer * 512 + head * 128 + c0 + e] * (gg / (1.f + __expf(-gg))); }
            if (valid) { uint4* yp = (uint4*)(slotp(P, 2) + (size_t)r * 512 + head * 128 + c0); yp[0] = pack8(o); yp[1] = pack8(o + 8); }
        }
        __syncthreads();
    }
}
DEV void phase_vtrans(const Params& P0, unsigned char* lds, int bid, int nb, int wv) {
    Params P = load_params(); asm volatile("" : "+s"(P.ws));
    bf16_t* T = (bf16_t*)lds;
    const bf16_t* V = slotp(P, 12); bf16_t* VTg = slotp(P, 6);
    const int tid = launder_tid(wv);
    for (int unit = bid; unit < 4 * 65 * 8; unit += nb) {
        const int sl = unit / 520, rem = unit - sl * 520, pt = rem >> 3, vdt = rem & 7;
        { const int tok = tid >> 3, c8 = (tid & 7) * 8, p = pt * 64 + tok;
          uint4 v = make_uint4(0, 0, 0, 0);
          if (p < LSEQ) v = *(const uint4*)(V + (size_t)row_of(sl, p) * 512 + vdt * 64 + c8);
          *(uint4*)(T + tok * 72 + c8) = v; }
        __syncthreads();
        { const int vd = tid >> 3, t8 = (tid & 7) * 8;
          unsigned short e[8];
#pragma unroll
          for (int i = 0; i < 8; ++i) { const int pp = t8 + i; const int sp = (pp & ~12) | (((pp >> 2) & 1) << 3) | (((pp >> 3) & 1) << 2); e[i] = T[sp * 72 + vd]; }
          uint4 o; o.x = e[0] | ((unsigned)e[1] << 16); o.y = e[2] | ((unsigned)e[3] << 16); o.z = e[4] | ((unsigned)e[5] << 16); o.w = e[6] | ((unsigned)e[7] << 16);
          *(uint4*)(VTg + (size_t)(sl * 512 + vdt * 64 + vd) * 4160 + pt * 64 + t8) = o; }
        __syncthreads();
    }
}
DEV int crow(int r, int hi) { return (r & 3) + 8 * (r >> 2) + 4 * hi; }
typedef unsigned u32x4_t __attribute__((ext_vector_type(4)));
struct AttnStage { u32x4_t k0, k1, v0, v1; };
DEV void attn_stage_load(const Params& P, int sl, int head, int kt, int tid, AttnStage& st) {
    const bf16_t* Kg = slotp(P, 11); const bf16_t* VTg = slotp(P, 6);
    { const int ci = tid, krow = ci >> 4, kc = ci & 15; const int p = kt * 64 + krow; const int r = p < LSEQ ? row_of(sl, p) : 0; st.k0 = GLD16(Kg + (size_t)r * 512 + head * 128 + kc * 8); }
    { const int ci = tid + 512, krow = ci >> 4, kc = ci & 15; const int p = kt * 64 + krow; const int r = p < LSEQ ? row_of(sl, p) : 0; st.k1 = GLD16(Kg + (size_t)r * 512 + head * 128 + kc * 8); }
    { const int vi = tid, vrow = vi >> 3, vc = vi & 7; st.v0 = GLD16(VTg + (size_t)(sl * 512 + head * 128 + vrow) * 4160 + kt * 64 + vc * 8); }
    { const int vi = tid + 512, vrow = vi >> 3, vc = vi & 7; st.v1 = GLD16(VTg + (size_t)(sl * 512 + head * 128 + vrow) * 4160 + kt * 64 + vc * 8); }
}
DEV void attn_stage_store(unsigned char* buf, int tid, const AttnStage& st) {
    bf16_t* Kt = (bf16_t*)buf; bf16_t* Vt = (bf16_t*)(buf + 17408);
    { const int ci = tid, krow = ci >> 4, kc = ci & 15; *(u32x4_t*)(Kt + krow * 136 + kc * 8) = st.k0; }
    { const int ci = tid + 512, krow = ci >> 4, kc = ci & 15; *(u32x4_t*)(Kt + krow * 136 + kc * 8) = st.k1; }
    { const int vi = tid, vrow = vi >> 3, vc = vi & 7; *(u32x4_t*)(Vt + vrow * 72 + vc * 8) = st.v0; }
    { const int vi = tid + 512, vrow = vi >> 3, vc = vi & 7; *(u32x4_t*)(Vt + vrow * 72 + vc * 8) = st.v1; }
}
DEV void phase_attn(const Params& P0, int layer, unsigned char* lds, int ua, int ub, int uc, int wv) {
    Params P = load_params(); asm volatile("" : "+s"(P.ws));
    const int tid = launder_tid(wv), lane = tid & 63, w = __builtin_amdgcn_readfirstlane(tid >> 6), map = w >> 2, qsub = w & 3, qi = lane & 31, hi = lane >> 5;
    const float lam_init = layer == 0 ? 0.2f : 0.35550906759096934f;
    float lam;
    { const float* lp = P.in[I_LAM] + (size_t)layer * 256; float s1 = 0.f, s2 = 0.f;
      for (int i = 0; i < 64; ++i) { s1 += lp[i] * lp[64 + i]; s2 += lp[128 + i] * lp[192 + i]; }
      lam = __expf(s1) - __expf(s2) + lam_init; }
    float* Ex = (float*)lds;
#pragma unroll 1
    for (int ui = 0; ui < 3; ++ui) {
        int unit = ui == 0 ? ua : (ui == 1 ? ub : uc);
        if (unit < 0) continue;
        const int ucode = unit; unit = ucode & 4095; const int hmode = ucode >> 12;
        const int sh = unit < 512 ? (unit >> 5) : unit - 512, qb = unit < 512 ? (unit & 31) : 32, sl = sh >> 2, head = sh & 3;
        const int qrow0 = qb < 32 ? sl * 4096 + qb * 128 : TREAL + sl * 16; const int nvalid = qb < 32 ? 128 : 16;
        const bool active = (qsub * 32 < nvalid) && (hmode == 0 || hmode >= 3 || (qsub >> 1) == hmode - 1);
        bf16x8 Qf[4];
        { const bf16_t* qp = slotp(P, 10) + (size_t)(qrow0 + qsub * 32 + qi) * 512 + head * 128 + map * 64 + hi * 8;
#pragma unroll
          for (int ds = 0; ds < 4; ++ds) Qf[ds] = __builtin_bit_cast(bf16x8, GLD16(qp + ds * 16)); }
        AttnStage st;
        const int kt0 = hmode == 4 ? 33 : 0, kt1 = hmode == 3 ? 33 : 65;
        attn_stage_load(P, sl, head, kt0, tid, st); attn_stage_store(lds + (kt0 & 1) * 35840, tid, st); attn_stage_load(P, sl, head, kt0 + 1, tid, st);
        __syncthreads();
        f32x16 O[4];
#pragma unroll
        for (int v = 0; v < 4; ++v)
#pragma unroll
            for (int r = 0; r < 16; ++r) O[v][r] = 0.f;
        float m_run = -INFINITY, l_run = 0.f;
#pragma unroll 1
        for (int kt = kt0; kt < kt1; ++kt) {
            if (kt + 1 < kt1) attn_stage_store(lds + ((kt + 1) & 1) * 35840, tid, st);
            if (kt + 2 < kt1) attn_stage_load(P, sl, head, kt + 2, tid, st);
            const unsigned char* buf = lds + (kt & 1) * 35840;
            const bf16_t* Kb = (const bf16_t*)buf; const bf16_t* Vb = (const bf16_t*)(buf + 17408);
            if (active) {
            f32x16 S0, S1;
#pragma unroll
            for (int r = 0; r < 16; ++r) { S0[r] = 0.f; S1[r] = 0.f; }
#pragma unroll
            for (int ds = 0; ds < 4; ++ds) {
                const bf16x8 a0 = *(const bf16x8*)(Kb + qi * 136 + map * 64 + ds * 16 + hi * 8);
                const bf16x8 a1 = *(const bf16x8*)(Kb + (32 + qi) * 136 + map * 64 + ds * 16 + hi * 8);
                S0 = mfma32(a0, Qf[ds], S0); S1 = mfma32(a1, Qf[ds], S1); }
            if (kt == 64) {
#pragma unroll
                for (int r = 0; r < 16; ++r) { if (crow(r, hi) >= 16) S0[r] = -INFINITY; S1[r] = -INFINITY; } }
            float mx = -INFINITY;
#pragma unroll
            for (int r = 0; r < 16; ++r) mx = fmaxf(mx, fmaxf(S0[r], S1[r]));
            { const auto sw = __builtin_amdgcn_permlane32_swap(__float_as_uint(mx), __float_as_uint(mx), false, false); mx = fmaxf(__uint_as_float(sw[0]), __uint_as_float(sw[1])); }
            const float m_new = fmaxf(m_run, mx); const float alpha = __builtin_amdgcn_exp2f(m_run - m_new); m_run = m_new;
            float ps = 0.f;
#pragma unroll
            for (int r = 0; r < 16; ++r) { S0[r] = __builtin_amdgcn_exp2f(S0[r] - m_new); S1[r] = __builtin_amdgcn_exp2f(S1[r] - m_new); ps += S0[r] + S1[r]; }
            l_run = l_run * alpha + ps;
            if (__builtin_amdgcn_ballot_w64(alpha != 1.0f) != 0ull) {
#pragma unroll
                for (int v = 0; v < 4; ++v)
#pragma unroll
                    for (int r = 0; r < 16; ++r) O[v][r] *= alpha; }
            bf16x8 pf[2][2];
#pragma unroll
            for (int half = 0; half < 2; ++half) {
                uint4 a, b;
                a.x = pk2(S0[half * 8 + 0], S0[half * 8 + 1]); a.y = pk2(S0[half * 8 + 2], S0[half * 8 + 3]); a.z = pk2(S0[half * 8 + 4], S0[half * 8 + 5]); a.w = pk2(S0[half * 8 + 6], S0[half * 8 + 7]);
                b.x = pk2(S1[half * 8 + 0], S1[half * 8 + 1]); b.y = pk2(S1[half * 8 + 2], S1[half * 8 + 3]); b.z = pk2(S1[half * 8 + 4], S1[half * 8 + 5]); b.w = pk2(S1[half * 8 + 6], S1[half * 8 + 7]);
                pf[0][half] = __builtin_bit_cast(bf16x8, a); pf[1][half] = __builtin_bit_cast(bf16x8, b); }
#pragma unroll
            for (int v = 0; v < 4; ++v)
#pragma unroll
                for (int sub = 0; sub < 2; ++sub)
#pragma unroll
                    for (int half = 0; half < 2; ++half) {
                        const bf16x8 av = *(const bf16x8*)(Vb + (v * 32 + qi) * 72 + sub * 32 + half * 16 + hi * 8);
                        O[v] = mfma32(av, pf[sub][half], O[v]); }
            }
            __syncthreads();
        }
        const float l_tot = l_run + __shfl_xor(l_run, 32); const float inv = 1.0f / l_tot;
        if (hmode >= 3) {
            float* pt = (float*)slotp(P, 22) + ((size_t)(((unit - 448) * 2 + (hmode - 3)) * 2 + map) * 128 + qsub * 32 + qi) * 130;
#pragma unroll
            for (int v = 0; v < 4; ++v)
#pragma unroll
                for (int rg = 0; rg < 4; ++rg) { float* d = pt + v * 32 + 8 * rg + 4 * hi; d[0] = O[v][rg * 4 + 0]; d[1] = O[v][rg * 4 + 1]; d[2] = O[v][rg * 4 + 2]; d[3] = O[v][rg * 4 + 3]; }
            if (hi == 0) { pt[128] = m_run; pt[129] = l_tot; }
            __syncthreads();
            continue; }
        if (map == 1) {
#pragma unroll
            for (int v = 0; v < 4; ++v)
#pragma unroll
                for (int r = 0; r < 16; ++r) Ex[(qsub * 32 + qi) * 132 + v * 32 + crow(r, hi)] = O[v][r] * inv; }
        __syncthreads();
        if (map == 0) {
            float ss = 0.f;
#pragma unroll
            for (int v = 0; v < 4; ++v)
#pragma unroll
                for (int r = 0; r < 16; ++r) { const float o = O[v][r] * inv - lam * Ex[(qsub * 32 + qi) * 132 + v * 32 + crow(r, hi)]; O[v][r] = o; ss += o * o; }
            ss += __shfl_xor(ss, 32);
            const float rs = rsqrtf(ss * (1.f / 128.f) + 1e-5f) * (1.f - lam_init);
            if (active && qsub * 32 + qi < nvalid) {
                bf16_t* yp = slotp(P, 4) + (size_t)(qrow0 + qsub * 32 + qi) * 512 + head * 128;
#pragma unroll
                for (int v = 0; v < 4; ++v)
#pragma unroll
                    for (int rg = 0; rg < 4; ++rg) { const int vd0 = v * 32 + 8 * rg + 4 * hi; const f32x4 gg = *(const f32x4*)(P.in[I_SUBLN] + layer * 128 + vd0);
                        uint2 o; o.x = pk2(O[v][rg * 4 + 0] * rs * gg[0], O[v][rg * 4 + 1] * rs * gg[1]); o.y = pk2(O[v][rg * 4 + 2] * rs * gg[2], O[v][rg * 4 + 3] * rs * gg[3]);
                        *(uint2*)(yp + vd0) = o; } }
        }
        __syncthreads();
    }
}
DEV float dpp_f(float x, const int ctrl) { return x; }
template <int CTRL> DEV float dppmov(float x) { return __builtin_bit_cast(float, __builtin_amdgcn_update_dpp(0, __builtin_bit_cast(int, x), CTRL, 0xf, 0xf, true)); }
DEV float sum16(float x) { x += dppmov<0xB1>(x); x += dppmov<0x4E>(x); x += dppmov<0x141>(x); x += dppmov<0x140>(x); return x; }
constexpr int RW_CH = 16, RW_BUF_F = 5120 + 256 + 4096, RW_BUFB = RW_BUF_F * 4;
struct RwRegs { u32x4_t r, k, kk, e, a, v; };
DEV void unpack8v(const u32x4_t w, float* f) { unpack8(make_uint4(w.x, w.y, w.z, w.w), f); }
DEV void rw_stage_load(const Params& P, RwRegs& g, int sl, int head, int dir, int qr, int ck, int t) {
    if (t < 128) { const int step = t >> 3, ch8 = (t & 7) * 8, sidx = ck * RW_CH + step;
        if (sidx < LSEQ) { const int p = dir ? LSEQ - 1 - sidx : sidx; const size_t ro = (size_t)row_of(sl, p) * 512 + head * 64 + ch8;
            g.r = *(const u32x4_t*)(slotp(P, 17) + ro); g.k = *(const u32x4_t*)(slotp(P, 18) + ro); g.kk = *(const u32x4_t*)(slotp(P, 20) + ro);
            g.e = *(const u32x4_t*)(slotp(P, 22 + dir) + ro); g.a = *(const u32x4_t*)(slotp(P, dir == 0 ? 24 : 13) + ro); } }
    if (t < 32) { const int tt = t, s2 = tt >> 1, r8 = (tt & 1) * 8, si2 = ck * RW_CH + s2;
        if (si2 < LSEQ) { const int p2 = dir ? LSEQ - 1 - si2 : si2; g.v = *(const u32x4_t*)(slotp(P, 19) + (size_t)row_of(sl, p2) * 512 + head * 64 + qr * 16 + r8); } }
}
DEV void rw_stage_write(const Params& P, int layer, unsigned char* buf, const RwRegs& g, int head, int ck, int t) {
    float* Rr = (float*)buf; float* Ww = Rr + 1024; float* Kd = Ww + 1024; float* Kk = Kd + 1024; float* Bb = Kk + 1024; float* Vs = Bb + 1024;
    if (t < 128) { const int step = t >> 3, ch8 = (t & 7) * 8, sidx = ck * RW_CH + step;
        if (sidx < LSEQ) {
            float r[8], k[8], kk[8], e[8], a[8];
            unpack8v(g.r, r); unpack8v(g.k, k); unpack8v(g.kk, kk); unpack8v(g.e, e); unpack8v(g.a, a);
            float ww[8], kd[8], bb[8];
#pragma unroll
            for (int j = 0; j < 8; ++j) { ww[j] = __expf(-e[j]); kd[j] = k[j] * (1.f + (a[j] - 1.f) * P.in[I_KA][layer * 512 + head * 64 + ch8 + j]); bb[j] = kk[j] * a[j]; }
            const int o = step * 64 + ch8;
            *(f32x4*)(Rr + o) = (f32x4){r[0], r[1], r[2], r[3]}; *(f32x4*)(Rr + o + 4) = (f32x4){r[4], r[5], r[6], r[7]};
            *(f32x4*)(Ww + o) = (f32x4){ww[0], ww[1], ww[2], ww[3]}; *(f32x4*)(Ww + o + 4) = (f32x4){ww[4], ww[5], ww[6], ww[7]};
            *(f32x4*)(Kd + o) = (f32x4){kd[0], kd[1], kd[2], kd[3]}; *(f32x4*)(Kd + o + 4) = (f32x4){kd[4], kd[5], kd[6], kd[7]};
            *(f32x4*)(Kk + o) = (f32x4){kk[0], kk[1], kk[2], kk[3]}; *(f32x4*)(Kk + o + 4) = (f32x4){kk[4], kk[5], kk[6], kk[7]};
            *(f32x4*)(Bb + o) = (f32x4){bb[0], bb[1], bb[2], bb[3]}; *(f32x4*)(Bb + o + 4) = (f32x4){bb[4], bb[5], bb[6], bb[7]};
        } }
    if (t < 32) { const int tt = t, s2 = tt >> 1, r8 = (tt & 1) * 8, si2 = ck * RW_CH + s2;
        if (si2 < LSEQ) { float v[8]; unpack8v(g.v, v);
            *(f32x4*)(Vs + s2 * 16 + r8) = (f32x4){v[0], v[1], v[2], v[3]}; *(f32x4*)(Vs + s2 * 16 + r8 + 4) = (f32x4){v[4], v[5], v[6], v[7]}; } }
}
DEV void rw_flush(const Params& P, const unsigned char* buf, int sl, int head, int dir, int qr, int ck, int t) {
    if (t >= 160 && t < 192) { const float* Op = (const float*)buf + 5376; const int tt = t - 160, s2 = tt >> 1, r8 = (tt & 1) * 8, sidx = ck * RW_CH + s2;
        if (sidx < LSEQ) { const int p = dir ? LSEQ - 1 - sidx : sidx; float o[8];
#pragma unroll
            for (int j = 0; j < 8; ++j) { const int row = r8 + j; const f32x4* q = (const f32x4*)(Op + s2 * 256 + (row >> 2) * 64 + (row & 3) * 16);
                const f32x4 a = q[0], b = q[1], c = q[2], d = q[3];
                o[j] = ((a[0] + a[1]) + (a[2] + a[3])) + ((b[0] + b[1]) + (b[2] + b[3])) + (((c[0] + c[1]) + (c[2] + c[3])) + ((d[0] + d[1]) + (d[2] + d[3]))); }
            *(uint4*)(slotp(P, 15 + dir) + (size_t)row_of(sl, p) * 512 + head * 64 + qr * 16 + r8) = pack8(o); } }
}
DEV void phase_rw_scan(const Params& P0, int layer, unsigned char* lds, int bid, int nb, int wv) {
    Params P = load_params(); asm volatile("" : "+s"(P.ws));
    const int tid = launder_tid(wv), lane = tid & 63, w = __builtin_amdgcn_readfirstlane(tid >> 6), li = lane & 15, rl = (w & 3) * 4 + (lane >> 4);
    constexpr int NCK = (LSEQ + RW_CH - 1) / RW_CH;
    typedef float f32x2 __attribute__((ext_vector_type(2)));
    for (int unit = bid; unit < 256; unit += nb) {
        const int sl = unit >> 6, head = (unit >> 3) & 7, dir = (unit >> 2) & 1, qr = unit & 3;
        f32x2 SA = (f32x2){0.f, 0.f}, SB = (f32x2){0.f, 0.f};
        RwRegs g; g.r = g.k = g.kk = g.e = g.a = g.v = (u32x4_t){0u, 0u, 0u, 0u};
        if (w >= 4) { rw_stage_load(P, g, sl, head, dir, qr, 0, tid - 256); rw_stage_write(P, layer, lds, g, head, 0, tid - 256); rw_stage_load(P, g, sl, head, dir, qr, 1, tid - 256); }
        __syncthreads();
#pragma unroll 1
        for (int ck = 0; ck < NCK; ++ck) {
            unsigned char* buf = lds + (ck & 1) * RW_BUFB;
            if (w >= 4) {
                if (ck + 1 < NCK) rw_stage_write(P, layer, lds + ((ck + 1) & 1) * RW_BUFB, g, head, ck + 1, tid - 256);
                if (ck + 2 < NCK) rw_stage_load(P, g, sl, head, dir, qr, ck + 2, tid - 256);
                if (ck > 0) rw_flush(P, lds + ((ck - 1) & 1) * RW_BUFB, sl, head, dir, qr, ck - 1, tid - 256);
            } else {
                const float* Rr = (const float*)buf + li * 4; const float* Vs = (const float*)buf + 5120 + rl; float* Op = (float*)buf + 5376 + w * 64 + lane;
                const int ns = (LSEQ - ck * RW_CH) < RW_CH ? (LSEQ - ck * RW_CH) : RW_CH;
                f32x4 rr = *(const f32x4*)(Rr), ww = *(const f32x4*)(Rr + 1024), kd = *(const f32x4*)(Rr + 2048), kk = *(const f32x4*)(Rr + 3072), bb = *(const f32x4*)(Rr + 4096); float vv = Vs[0];
#pragma unroll 2
                for (int i = 0; i < ns; ++i) {
                    const int in = i < RW_CH - 1 ? i + 1 : RW_CH - 1;
                    const f32x4 rr_n = *(const f32x4*)(Rr + in * 64), ww_n = *(const f32x4*)(Rr + 1024 + in * 64), kd_n = *(const f32x4*)(Rr + 2048 + in * 64);
                    const f32x4 kk_n = *(const f32x4*)(Rr + 3072 + in * 64), bb_n = *(const f32x4*)(Rr + 4096 + in * 64); const float vv_n = Vs[in * 16];
                    f32x2 p = SA * (f32x2){kk[0], kk[1]}; p = __builtin_elementwise_fma(SB, (f32x2){kk[2], kk[3]}, p);
                    const f32x2 vv2 = (f32x2){vv, vv};
                    const f32x2 ta = vv2 * (f32x2){kd[0], kd[1]}, tb = vv2 * (f32x2){kd[2], kd[3]};
                    const float sa = -sum16(p[0] + p[1]);
                    const f32x2 sa2 = (f32x2){sa, sa};
                    SA = __builtin_elementwise_fma(SA, (f32x2){ww[0], ww[1]}, __builtin_elementwise_fma(sa2, (f32x2){bb[0], bb[1]}, ta));
                    SB = __builtin_elementwise_fma(SB, (f32x2){ww[2], ww[3]}, __builtin_elementwise_fma(sa2, (f32x2){bb[2], bb[3]}, tb));
                    f32x2 q = SA * (f32x2){rr[0], rr[1]}; q = __builtin_elementwise_fma(SB, (f32x2){rr[2], rr[3]}, q);
                    Op[i * 256] = q[0] + q[1];
                    rr = rr_n; ww = ww_n; kd = kd_n; kk = kk_n; bb = bb_n; vv = vv_n;
                }
            }
            __syncthreads();
        }
        if (w >= 4) rw_flush(P, lds + ((NCK - 1) & 1) * RW_BUFB, sl, head, dir, qr, NCK - 1, tid - 256);
        __syncthreads();
    }
}
static_assert(LSEQ == 257 * 16, "chunked RWKV assumes whole 16-step chunks");
constexpr int RWC_REC = 8960, RWC_NCK = 257;
DEV unsigned char* rwc_rec(const Params& P, int dir, int idx) {
    const int gi = dir * 8224 + idx;
    if (gi < 1901) return (unsigned char*)slotp(P, 5) + (size_t)gi * RWC_REC;
    if (gi < 7606) return (unsigned char*)slotp(P, 7) + (size_t)(gi - 1901) * RWC_REC;
    if (gi < 9507) return (unsigned char*)slotp(P, 12) + (size_t)(gi - 7606) * RWC_REC;
    if (gi < 11408) return (unsigned char*)slotp(P, 21) + (size_t)(gi - 9507) * RWC_REC;
    return GPTR(unsigned char, P.ws + WS_SLOTS + 25 * SLOT_B + (size_t)(gi - 11408) * RWC_REC); }
DEV int rwc_slot(int c) { return (((c >> 5) * 4 + ((c >> 2) & 3)) * 8) + ((c >> 4) & 1) * 4 + (c & 3); }
DEV void phase_rwc_pre(const Params& P0, int layer, unsigned char* lds, int bid, int nb, int wv) {
    Params P = load_params(); asm volatile("" : "+s"(P.ws));
    const int tid = launder_tid(wv), lane = tid & 63, w = __builtin_amdgcn_readfirstlane(tid >> 6), l15 = lane & 15, quad = lane >> 4;
    unsigned char* wl = lds + w * 15616;
    bf16_t* Bt = (bf16_t*)wl; bf16_t* Dt = Bt + 16 * 72; bf16_t* Ak = Dt + 16 * 72; bf16_t* Rt = Ak + 16 * 72;
    float* Mb = (float*)(wl + 9216); float* Md = Mb + 256; float* Gb = Md + 256; float* Gd = Gb + 256; float* Tm = Gd + 256; float* Nm = Tm + 256;
    const float ka = P.in[I_KA][layer * 512 + 0];  (void)ka;
    for (int unit2 = bid * 8 + w; unit2 < 2 * 32 * RWC_NCK; unit2 += nb * 8) {
        const int dir = unit2 >= 32 * RWC_NCK ? 1 : 0; const int unit = unit2 - dir * 32 * RWC_NCK;
        const int sh = unit / RWC_NCK, ck = unit - sh * RWC_NCK, sl = sh >> 3, head = sh & 7;
        const float kac = P.in[I_KA][layer * 512 + head * 64 + lane];
        float ak[16], bt[16], dt[16], rt[16];
        typedef const __attribute__((address_space(1))) unsigned short* gu16p;
        const gu16p pR = (gu16p)slotp(P, 17), pK = (gu16p)slotp(P, 18), pKK = (gu16p)slotp(P, 20), pE = (gu16p)slotp(P, 22 + dir), pA = (gu16p)slotp(P, dir == 0 ? 24 : 13);
        unsigned short r16[16], k16[16], q16[16], e16[16], a16[16];
#pragma unroll
        for (int t = 0; t < 16; ++t) {
            const int sidx = ck * 16 + t;
            const int p = dir ? LSEQ - 1 - sidx : sidx; const size_t ro = (size_t)row_of(sl, p) * 512 + head * 64 + lane;
            r16[t] = pR[ro]; k16[t] = pK[ro]; q16[t] = pKK[ro]; e16[t] = pE[ro]; a16[t] = pA[ro]; }
        float g = 1.f;
#pragma unroll
        for (int t = 0; t < 16; ++t) {
            const float r = bf2f(r16[t]), k = bf2f(k16[t]), kk = bf2f(q16[t]), e = bf2f(e16[t]), a = bf2f(a16[t]);
            const float wdec = __expf(-e), kd = k * (1.f + (a - 1.f) * kac), b = kk * a;
            ak[t] = g * kk; g *= wdec; const float gi = __builtin_amdgcn_rcpf(g); bt[t] = b * gi; dt[t] = kd * gi; rt[t] = g * r;
        }
        const float gC = g;
#pragma unroll
        for (int t = 0; t < 16; ++t) { Bt[t * 72 + lane] = (bf16_t)(pk2(bt[t], 0.f) & 0xffffu); Dt[t * 72 + lane] = (bf16_t)(pk2(dt[t], 0.f) & 0xffffu);
            Ak[t * 72 + lane] = (bf16_t)(pk2(ak[t], 0.f) & 0xffffu); Rt[t * 72 + lane] = (bf16_t)(pk2(rt[t], 0.f) & 0xffffu); }
        asm volatile("s_waitcnt lgkmcnt(0)" ::: "memory");
        {
            f32x4 mb = (f32x4){0.f, 0.f, 0.f, 0.f}, md = mb, gb = mb, gd = mb;
#pragma unroll
            for (int ks = 0; ks < 2; ++ks) {
                const bf16x8 fb = *(const bf16x8*)(Bt + l15 * 72 + ks * 32 + quad * 8), fd = *(const bf16x8*)(Dt + l15 * 72 + ks * 32 + quad * 8);
                const bf16x8 fa = *(const bf16x8*)(Ak + l15 * 72 + ks * 32 + quad * 8), fr = *(const bf16x8*)(Rt + l15 * 72 + ks * 32 + quad * 8);
                mb = mfma16(fb, fa, mb); md = mfma16(fd, fa, md); gb = mfma16(fb, fr, gb); gd = mfma16(fd, fr, gd); }
#pragma unroll
            for (int jj = 0; jj < 4; ++jj) { const int j = quad * 4 + jj, t = l15;
                Mb[j * 16 + t] = j < t ? mb[jj] : 0.f; Md[j * 16 + t] = j < t ? md[jj] : 0.f; Gb[j * 16 + t] = j <= t ? gb[jj] : 0.f; Gd[j * 16 + t] = j <= t ? gd[jj] : 0.f; }
        }
        asm volatile("s_waitcnt lgkmcnt(0)" ::: "memory");
        {
            float tc[16];
#pragma unroll
            for (int i = 15; i >= 0; --i) { float acc = (i == l15) ? 1.f : 0.f;
                float mr[16];
#pragma unroll
                for (int q4 = (i + 1) >> 2; q4 < 4; ++q4) { const f32x4 m4 = *(const f32x4*)(Mb + i * 16 + q4 * 4); mr[q4 * 4] = m4[0]; mr[q4 * 4 + 1] = m4[1]; mr[q4 * 4 + 2] = m4[2]; mr[q4 * 4 + 3] = m4[3]; }
#pragma unroll
                for (int l = i + 1; l < 16; ++l) acc -= mr[l] * tc[l];
                tc[i] = acc; }
            if (quad == 0) {
#pragma unroll
                for (int i = 0; i < 16; ++i) Tm[i * 16 + l15] = tc[i]; }
        }
        asm volatile("s_waitcnt lgkmcnt(0)" ::: "memory");
        {
            float n4[4] = {0.f, 0.f, 0.f, 0.f};
#pragma unroll
            for (int l = 0; l < 16; ++l) { const float tv = Tm[l * 16 + l15];
#pragma unroll
                for (int jj = 0; jj < 4; ++jj) n4[jj] += Md[(quad * 4 + jj) * 16 + l] * tv; }
#pragma unroll
            for (int jj = 0; jj < 4; ++jj) Nm[(quad * 4 + jj) * 16 + l15] = n4[jj];
        }
        asm volatile("s_waitcnt lgkmcnt(0)" ::: "memory");
        unsigned char* rec = rwc_rec(P, dir, unit);
        {
            float q4[4];
#pragma unroll
            for (int jj = 0; jj < 4; ++jj) q4[jj] = Gd[(quad * 4 + jj) * 16 + l15];
#pragma unroll
            for (int l = 0; l < 16; ++l) { const float gv = Gb[l * 16 + l15];
#pragma unroll
                for (int jj = 0; jj < 4; ++jj) q4[jj] -= Nm[(quad * 4 + jj) * 16 + l] * gv; }
            *(uint2*)((bf16_t*)(rec + 8192) + l15 * 16 + quad * 4) = make_uint2(pk2(q4[0], q4[1]), pk2(q4[2], q4[3]));
        }
        {
            float ap[16], rp[16], ps[16];
#pragma unroll
            for (int t = 0; t < 16; ++t) { ap[t] = 0.f; rp[t] = rt[t]; }
#pragma unroll
            for (int j = 0; j < 16; ++j) {
#pragma unroll
                for (int q4 = j >> 2; q4 < 4; ++q4) { const f32x4 r4 = *(const f32x4*)(Tm + j * 16 + q4 * 4);
#pragma unroll
                    for (int e = 0; e < 4; ++e) ap[q4 * 4 + e] += ak[j] * r4[e]; } }
#pragma unroll
            for (int j = 0; j < 16; ++j) {
#pragma unroll
                for (int q4 = j >> 2; q4 < 4; ++q4) { const f32x4 r4 = *(const f32x4*)(Gb + j * 16 + q4 * 4);
#pragma unroll
                    for (int e = 0; e < 4; ++e) rp[q4 * 4 + e] -= ap[j] * r4[e]; } }
#pragma unroll
            for (int j = 0; j < 16; ++j) { float acc = dt[j];
#pragma unroll
                for (int q4 = j >> 2; q4 < 4; ++q4) { const f32x4 r4 = *(const f32x4*)(Nm + j * 16 + q4 * 4);
#pragma unroll
                    for (int e = 0; e < 4; ++e) acc -= r4[e] * bt[q4 * 4 + e]; }
                ps[j] = acc * gC; }
            bf16_t* AP = (bf16_t*)rec; bf16_t* RP = AP + 1024; const int so = rwc_slot(lane);
#pragma unroll
            for (int t = 0; t < 16; ++t) { AP[t * 64 + so] = (bf16_t)(pk2(ap[t], 0.f) & 0xffffu); RP[t * 64 + so] = (bf16_t)(pk2(rp[t], 0.f) & 0xffffu); }
            float nb_[16];
#pragma unroll
            for (int t = 0; t < 16; ++t) nb_[t] = -bt[t] * gC;
            uint4* BP = (uint4*)(rec + 4096) + lane * 2; BP[0] = pack8(nb_); BP[1] = pack8(nb_ + 8);
            uint4* PP = (uint4*)(rec + 6144) + lane * 2; PP[0] = pack8(ps); PP[1] = pack8(ps + 8);
            ((float*)(rec + 8704))[lane] = gC;
        }
        asm volatile("s_waitcnt lgkmcnt(0)" ::: "memory");
    }
}
struct RwcRegs { u32x4_t a, b, c, v; };
DEV void rwc_load(const Params& P, RwcRegs& g, int sh, int dir, int ck, int t) {
    const unsigned char* rec = rwc_rec(P, dir, sh * RWC_NCK + ck);
    g.a = GLD16(rec + (size_t)t * 16); g.b = GLD16(rec + (size_t)(t + 256) * 16);
    if (t < 48) g.c = GLD16(rec + (size_t)(t + 512) * 16);
    if (t < 128) { const int j = t >> 3, r8 = (t & 7) * 8, sidx = ck * 16 + j; const int sc = sidx < LSEQ ? sidx : LSEQ - 1; const int p = dir ? LSEQ - 1 - sc : sc;
        g.v = GLD16(slotp(P, 19) + (size_t)row_of(sh >> 3, p) * 512 + (sh & 7) * 64 + r8); if (sidx >= LSEQ) g.v = (u32x4_t){0u, 0u, 0u, 0u}; }
}
DEV void rwc_store(unsigned char* buf, const RwcRegs& g, int t) {
    *(u32x4_t*)(buf + t * 16) = g.a; *(u32x4_t*)(buf + (t + 256) * 16) = g.b;
    if (t < 48) *(u32x4_t*)(buf + (t + 512) * 16) = g.c;
    if (t < 128) { bf16_t* VsT = (bf16_t*)(buf + RWC_REC); const int j = t >> 3, r8 = (t & 7) * 8;
        VsT[(r8 + 0) * 16 + j] = (bf16_t)(g.v.x & 0xffffu); VsT[(r8 + 1) * 16 + j] = (bf16_t)(g.v.x >> 16); VsT[(r8 + 2) * 16 + j] = (bf16_t)(g.v.y & 0xffffu); VsT[(r8 + 3) * 16 + j] = (bf16_t)(g.v.y >> 16);
        VsT[(r8 + 4) * 16 + j] = (bf16_t)(g.v.z & 0xffffu); VsT[(r8 + 5) * 16 + j] = (bf16_t)(g.v.z >> 16); VsT[(r8 + 6) * 16 + j] = (bf16_t)(g.v.w & 0xffffu); VsT[(r8 + 7) * 16 + j] = (bf16_t)(g.v.w >> 16); }
}
DEV void phase_rwc_scan(const Params& P0, unsigned char* lds, int bid, int nb, int wv) {
    Params P = load_params(); asm volatile("" : "+s"(P.ws));
    const int tid = launder_tid(wv), lane = tid & 63, w = __builtin_amdgcn_readfirstlane(tid >> 6), l15 = lane & 15, quad = lane >> 4;
    constexpr int BUFB = RWC_REC + 2048;
    for (int u2 = bid; u2 < 64; u2 += nb) {
        const int sh = u2 & 31, dir = u2 >> 5; const int sl = sh >> 3, head = sh & 7;
        f32x4 ST[4];
#pragma unroll
        for (int ct = 0; ct < 4; ++ct) ST[ct] = (f32x4){0.f, 0.f, 0.f, 0.f};
        RwcRegs g; g.a = g.b = g.c = g.v = (u32x4_t){0u, 0u, 0u, 0u};
        if (w >= 4) { rwc_load(P, g, sh, dir, 0, tid - 256); rwc_store(lds, g, tid - 256); rwc_load(P, g, sh, dir, 1, tid - 256); }
        __syncthreads();
#pragma unroll 1
        for (int ck = 0; ck < RWC_NCK; ++ck) {
            const unsigned char* buf = lds + (ck & 1) * BUFB;
            if (w >= 4) {
                if (ck + 1 < RWC_NCK) rwc_store(lds + ((ck + 1) & 1) * BUFB, g, tid - 256);
                if (ck + 2 < RWC_NCK) rwc_load(P, g, sh, dir, ck + 2, tid - 256);
            } else {
                const bf16_t* AP = (const bf16_t*)buf; const bf16_t* RP = AP + 1024; const bf16_t* BP = (const bf16_t*)(buf + 4096); const bf16_t* PP = (const bf16_t*)(buf + 6144);
                const bf16_t* QP = (const bf16_t*)(buf + 8192); const float* GC = (const float*)(buf + 8704); const bf16_t* VsT = (const bf16_t*)(buf + RWC_REC);
                const u32x4_t z4 = (u32x4_t){0u, 0u, 0u, 0u};
                u32x4_t sb0, sb1;
                sb0.x = pk2(ST[0][0], ST[0][1]); sb0.y = pk2(ST[0][2], ST[0][3]); sb0.z = pk2(ST[1][0], ST[1][1]); sb0.w = pk2(ST[1][2], ST[1][3]);
                sb1.x = pk2(ST[2][0], ST[2][1]); sb1.y = pk2(ST[2][2], ST[2][3]); sb1.z = pk2(ST[3][0], ST[3][1]); sb1.w = pk2(ST[3][2], ST[3][3]);
                const bf16x8 SB0 = __builtin_bit_cast(bf16x8, sb0), SB1 = __builtin_bit_cast(bf16x8, sb1);
                const bf16x8 a0 = *(const bf16x8*)(AP + l15 * 64 + (0 * 4 + quad) * 8), a1 = *(const bf16x8*)(AP + l15 * 64 + (1 * 4 + quad) * 8);
                const bf16x8 r0 = *(const bf16x8*)(RP + l15 * 64 + (0 * 4 + quad) * 8), r1 = *(const bf16x8*)(RP + l15 * 64 + (1 * 4 + quad) * 8);
                const u32x4_t vq = quad < 2 ? *(const u32x4_t*)(VsT + (w * 16 + l15) * 16 + quad * 8) : z4;
                const u32x4_t qq = quad < 2 ? *(const u32x4_t*)(QP + l15 * 16 + quad * 8) : z4;
                f32x4 gcv[4]; uint2 bqv[4]; u32x4_t pqv[4];
#pragma unroll
                for (int ct = 0; ct < 4; ++ct) { gcv[ct] = *(const f32x4*)(GC + ct * 16 + quad * 4); bqv[ct] = *(const uint2*)(BP + (ct * 16 + l15) * 16 + quad * 4);
                    pqv[ct] = quad < 2 ? *(const u32x4_t*)(PP + (ct * 16 + l15) * 16 + quad * 8) : z4; }
                const bf16x8 VB = __builtin_bit_cast(bf16x8, vq), QA = __builtin_bit_cast(bf16x8, qq);
                f32x4 Wt = (f32x4){0.f, 0.f, 0.f, 0.f}, Ot = Wt;
                Wt = mfma16(a0, SB0, Wt); Wt = mfma16(a1, SB1, Wt);
                Ot = mfma16(r0, SB0, Ot); Ot = mfma16(r1, SB1, Ot); Ot = mfma16(QA, VB, Ot);
                u32x4_t wb; wb.x = pk2(Wt[0], Wt[1]); wb.y = pk2(Wt[2], Wt[3]); wb.z = 0u; wb.w = 0u;
                const bf16x8 WB = __builtin_bit_cast(bf16x8, wb);
#pragma unroll
                for (int ct = 0; ct < 4; ++ct) {
                    u32x4_t ba; ba.x = bqv[ct].x; ba.y = bqv[ct].y; ba.z = 0u; ba.w = 0u;
                    f32x4 acc = ST[ct] * gcv[ct];
                    acc = mfma16(__builtin_bit_cast(bf16x8, ba), WB, acc);
                    acc = mfma16(__builtin_bit_cast(bf16x8, pqv[ct]), VB, acc);
                    ST[ct] = acc;
                }
                bf16_t* Oo = slotp(P, 15 + dir);
#pragma unroll
                for (int jj = 0; jj < 4; ++jj) { const int sidx = ck * 16 + quad * 4 + jj;
                    if (sidx < LSEQ) { const int p = dir ? LSEQ - 1 - sidx : sidx; ((__attribute__((address_space(1))) bf16_t*)Oo)[(size_t)row_of(sl, p) * 512 + head * 64 + w * 16 + l15] = (bf16_t)(pk2(Ot[jj], 0.f) & 0xffffu); } }
            }
            __syncthreads();
        }
    }
}


DEV void phase_attn_combine(const Params& P0, int layer, int bid, int nb, int wv) {
    Params P = load_params(); asm volatile("" : "+s"(P.ws));
    ROWPRO
    const float lam_init = layer == 0 ? 0.2f : 0.35550906759096934f;
    float lam;
    { const float* lp = P.in[I_LAM] + (size_t)layer * 256; const float s1 = wave_sum(lp[lane] * lp[64 + lane]), s2 = wave_sum(lp[128 + lane] * lp[192 + lane]); lam = __expf(s1) - __expf(s2) + lam_init; }
    const float* PT = (const float*)slotp(P, 22);
    for (int task = gw; task < 64 * 128; task += ngw) {
        const int ul = task >> 7, row = task & 127, unit = 448 + ul, sh = unit >> 5, qb = unit & 31, sl = sh >> 2, head = sh & 3;
        float om[2][2];
#pragma unroll
        for (int map = 0; map < 2; ++map) {
            const float* pa = PT + ((size_t)((ul * 2 + 0) * 2 + map) * 128 + row) * 130; const float* pb = PT + ((size_t)((ul * 2 + 1) * 2 + map) * 128 + row) * 130;
            const float ma = pa[128], la = pa[129], mb = pb[128], lb = pb[129];
            const float M = fmaxf(ma, mb), fa = __builtin_amdgcn_exp2f(ma - M), fb = __builtin_amdgcn_exp2f(mb - M);
            const float inv = 1.0f / (la * fa + lb * fb);
            om[map][0] = (pa[lane * 2] * fa + pb[lane * 2] * fb) * inv; om[map][1] = (pa[lane * 2 + 1] * fa + pb[lane * 2 + 1] * fb) * inv; }
        const float o0 = om[0][0] - lam * om[1][0], o1 = om[0][1] - lam * om[1][1];
        const float ss = wave_sum(o0 * o0 + o1 * o1);
        const float rs = rsqrtf(ss * (1.f / 128.f) + 1e-5f) * (1.f - lam_init);
        const float g0 = P.in[I_SUBLN][layer * 128 + lane * 2], g1 = P.in[I_SUBLN][layer * 128 + lane * 2 + 1];
        *(unsigned*)(slotp(P, 4) + (size_t)(sl * 4096 + qb * 128 + row) * 512 + head * 128 + lane * 2) = pk2(o0 * rs * g0, o1 * rs * g1);
    }
}
#define LAS __attribute__((address_space(3)))
#define XB_TMO      128
#define XB_XCNT(j)  (256  + 64 * (j))
#define XB_XSUB(j)  (1280 + 64 * (j))
#define XB_XGEN(j)  (2304 + 64 * (j))
#define XB_TOP      3328
#define XB_TOPGEN   3392
#define XCD_BAR_WORDS 3456
#define XB_SPIN_CAP (1u << 18)

__device__ __forceinline__ unsigned xb_ld(unsigned* p)              { return __hip_atomic_load(p, __ATOMIC_RELAXED, __HIP_MEMORY_SCOPE_AGENT); }
__device__ __forceinline__ unsigned xb_add(unsigned* p, unsigned v) { return __hip_atomic_fetch_add(p, v, __ATOMIC_RELAXED, __HIP_MEMORY_SCOPE_AGENT); }
__device__ __forceinline__ unsigned xb_xcc_id() { return (unsigned)__builtin_amdgcn_s_getreg((3 << 11) | 20) & 0xFu; }
#define XB_SPIN(cond, bar) do { unsigned _sp = 0; while (cond) { __builtin_amdgcn_s_sleep(1); \
    if ((++_sp & 255u) == 0u) { if (xb_ld(&(bar)[XB_TMO])) break; if (_sp > XB_SPIN_CAP) { atomicAdd(&(bar)[XB_TMO], 1u); break; } } } } while (0)

struct XcdBarrier {
    unsigned* bar; unsigned x;
    volatile LAS unsigned* st;
};

__device__ __forceinline__ XcdBarrier xcd_barrier_post(unsigned* bar, volatile LAS unsigned* st, int wv) {
    XcdBarrier b; b.bar = bar; b.x = xb_xcc_id(); b.st = st;
    if (launder_tid(wv) == 0) (void)xb_add(&bar[XB_XCNT(b.x)], 1u);
    return b;
}
__device__ __forceinline__ void xcd_barrier_complete(unsigned* bar, unsigned x, unsigned& nloc, unsigned& nx) {
    const unsigned G = gridDim.x * gridDim.y * gridDim.z;
    unsigned sum, cnt, mine, sp = 0u;
    for (;;) {
        sum = 0u; cnt = 0u; mine = 0u;
#pragma unroll
        for (unsigned j = 0; j < 16; ++j) { const unsigned c = xb_ld(&bar[XB_XCNT(j)]); sum += c; cnt += (c > 0u) ? 1u : 0u; mine = (j == x) ? c : mine; }
        if (sum == G) break;
        __builtin_amdgcn_s_sleep(1);
        if ((++sp & 255u) == 0u) { if (xb_ld(&bar[XB_TMO])) break; if (sp > XB_SPIN_CAP) { atomicAdd(&bar[XB_TMO], 1u); break; } }
    }
    nloc = mine > 0u ? mine : 1u; nx = cnt > 0u ? cnt : 1u;
}

__device__ __forceinline__ void xcd_barrier(const XcdBarrier& b, int wv) {
    asm volatile("s_waitcnt vmcnt(0)" ::: "memory");
    __syncthreads();
    if (launder_tid(wv) == 0) {
        unsigned* bar = b.bar;
        __builtin_amdgcn_s_waitcnt(0);
        unsigned nloc = b.st[0], nx = b.st[1];
        if (nloc == 0u) { xcd_barrier_complete(bar, b.x, nloc, nx); b.st[0] = nloc; b.st[1] = nx; }
        const unsigned old = xb_add(&bar[XB_XSUB(b.x)], 1u);
        const unsigned gen = old / nloc;
        if (old + 1u == (gen + 1u) * nloc) {
            __builtin_amdgcn_fence(__ATOMIC_RELEASE, "agent");
            asm volatile("s_waitcnt vmcnt(0)" ::: "memory");
            const unsigned og = xb_add(&bar[XB_TOP], 1u);
            const unsigned tg = og / nx;
            if (og + 1u == (tg + 1u) * nx) xb_add(&bar[XB_TOPGEN], 1u);
            else XB_SPIN(xb_ld(&bar[XB_TOPGEN]) == tg, bar);
            __builtin_amdgcn_fence(__ATOMIC_ACQUIRE, "agent");
            xb_add(&bar[XB_XGEN(b.x)], 1u);
            asm volatile("s_waitcnt vmcnt(0)" ::: "memory");
        } else {
            XB_SPIN(xb_ld(&bar[XB_XGEN(b.x)]) == gen, bar);
            __builtin_amdgcn_fence(__ATOMIC_ACQUIRE, "agent");
            asm volatile("s_waitcnt vmcnt(0)" ::: "memory");
        }
    }
    __syncthreads();
}

__global__ void __launch_bounds__(512) mega_fwd(Params P) {
    extern __shared__ __attribute__((aligned(16))) unsigned char lds[];
    cg::grid_group grid = cg::this_grid();
    const int bid = blockIdx.x, nb = gridDim.x; const int wv = __builtin_amdgcn_readfirstlane(threadIdx.x >> 6);
    volatile LAS unsigned* MISC = (volatile LAS unsigned*)((LAS unsigned char*)lds + 131072 + 256);
    if (threadIdx.x < 4) MISC[threadIdx.x] = 0u;
    __syncthreads();
    XcdBarrier xbar;
    { Params Pb = load_params(); xbar = xcd_barrier_post((unsigned*)Pb.ws, MISC, wv); }
#define GSYNC() xcd_barrier(xbar, wv)
    PG8_LAS unsigned char* ldsl = (PG8_LAS unsigned char*)lds;
#pragma unroll 1
    for (int layer_ = 0; layer_ < 2; ++layer_) {
        phase_weights(P, lsd(layer_), lds, bid, nb, wv);
        grid.sync();
#pragma unroll 1
        for (int g_ = 0; g_ < NGRP; ++g_) {
            #define Mpost ((lsd(layer_) == 0 && lsd(g_) == 2) ? TGP : TREAL)
#define NVALID ((lsd(layer_) == 0 && lsd(g_) == 2) ? TG + 128 : TG)
            phase_rmsnorm(P, lsd(g_), lsd(layer_) == 0, I_NMIX, lsd(layer_), TGP, NVALID, bid, nb, wv);
            if (PROBE == 5) { phase_rmsnorm(P, lsd(g_), lsd(layer_) == 0, I_NMIX, lsd(layer_), TGP, NVALID, bid, nb, wv); }
            GSYNC();
            if (PROBE == 6) { for (int q_ = 0; q_ < 15; ++q_) GSYNC(); }
            for (int rep_ = 0; rep_ < (PROBE == 3 ? 2 : 1); ++rep_)
            { Params Pl = load_params(); asm volatile("" : "+s"(Pl.ws)); pg8::bf16_t* W = (pg8::bf16_t*)(Pl.ws + WS_W); pg8::Gemm gm{slotp(Pl, 0), W + WO_IN, TGP, 7680, 1024, 0, 0}; pg8::StaticOrder S; S.init(TGP, 7680, nb, bid);
              pg8::EpiBf<0> E{slotp(Pl, 2), 512, SLOT_E};
              pg8::gemm_phase<pg8::EpiBf<0>, pg8::StaticOrder, true, true>(ldsl, gm, S, E, wv); }
            GSYNC();
            phase_da_prep(P, lsd(layer_), bid, nb, wv);
            phase_hg1(P, lsd(layer_), lds, bid, nb, wv);
            if (PROBE == 4) { phase_hg1(P, lsd(layer_), lds, bid, nb, wv); }
            GSYNC();
            phase_hg2(P, bid, nb, wv);
            GSYNC();
            phase_hg3(P, lsd(layer_), lds, bid, nb, wv);
            GSYNC();
            phase_conv(P, lsd(layer_), bid, nb, wv);
            if (PROBE == 5) { phase_conv(P, lsd(layer_), bid, nb, wv); }
            phase_vtrans(P, lds, bid, nb, wv);
            if (PROBE == 5) { phase_vtrans(P, lds, bid, nb, wv); }
            phase_rw_prep(P, lsd(layer_), bid, nb, wv);
            if (PROBE == 5) { phase_rw_prep(P, lsd(layer_), bid, nb, wv); }
            GSYNC();
            { Params Pl = load_params(); asm volatile("" : "+s"(Pl.ws)); pg8::bf16_t* W = (pg8::bf16_t*)(Pl.ws + WS_W); pg8::Gemm gm{slotp(Pl, 21), W + WO_LR, TGP, 2560, 384, 0, 0}; pg8::StaticOrder S; S.init(TGP, 2560, nb, bid);
              pg8::EpiLR E{slotp(Pl, 22), slotp(Pl, 23), slotp(Pl, 24), slotp(Pl, 13), slotp(Pl, 14), Pl.in[I_W0] + lsd(layer_) * 1024, Pl.in[I_A0] + lsd(layer_) * 1024};
              pg8::gemm_phase<pg8::EpiLR, pg8::StaticOrder, true, true>(ldsl, gm, S, E, wv); }
            GSYNC();
            phase_rwc_pre(P, lsd(layer_), lds, bid, nb, wv);
            GSYNC();
            if (nb == 256) {
                const int nun = lsd(layer_) == 0 ? 528 : 512;
                if (bid < 64) { phase_rwc_scan(P, lds, bid, nb, wv); __syncthreads(); phase_attn(P, lsd(layer_), lds, bid, -1, -1, wv); }
                else { const int bq = bid - 64;
                    const int third = bq < 128 ? ((448 + (bq >> 1)) | ((3 + (bq & 1)) << 12)) : ((384 + bq < nun) ? 384 + bq : -1);
                    phase_attn(P, lsd(layer_), lds, 64 + bq, 256 + bq, third, wv); }
            } else {
                phase_rwc_scan(P, lds, bid, nb, wv); __syncthreads();
                for (int u = bid; u < (lsd(layer_) == 0 ? 528 : 512); u += nb) phase_attn(P, lsd(layer_), lds, u, -1, -1, wv);
            }
            GSYNC();
            if (nb == 256) phase_attn_combine(P, lsd(layer_), bid, nb, wv);
            phase_rw_post(P, lsd(layer_), lsd(g_), lsd(layer_) == 0 ? TG : TREAL, bid, nb, wv);
            if (PROBE == 5) { phase_rw_post(P, lsd(layer_), lsd(g_), lsd(layer_) == 0 ? TG : TREAL, bid, nb, wv); }
            GSYNC();
            { Params Pl = load_params(); asm volatile("" : "+s"(Pl.ws)); pg8::bf16_t* W = (pg8::bf16_t*)(Pl.ws + WS_W); pg8::Gemm gm{slotp(Pl, 2), W + WO_BP, Mpost, 4096, 512, 4, SLOT_B}; pg8::StaticOrder S; S.init(Mpost, 4096, nb, bid);
              pg8::EpiBf<0> E{slotp(Pl, 6), 4096, 0};
              pg8::gemm_phase<pg8::EpiBf<0>, pg8::StaticOrder, true, true>(ldsl, gm, S, E, wv); }
            GSYNC();
            { Params Pl = load_params(); asm volatile("" : "+s"(Pl.ws)); pg8::bf16_t* W = (pg8::bf16_t*)(Pl.ws + WS_W); pg8::Gemm gm{slotp(Pl, 0), W + WO_G, Mpost, 4096, 1024, 0, 0}; pg8::StaticOrder S; S.init(Mpost, 4096, nb, bid);
              pg8::EpiGate E{slotp(Pl, 6), slotp(Pl, 14)};
              pg8::gemm_phase<pg8::EpiGate, pg8::StaticOrder, true, true>(ldsl, gm, S, E, wv); }
            GSYNC();
            { Params Pl = load_params(); asm volatile("" : "+s"(Pl.ws)); pg8::bf16_t* W = (pg8::bf16_t*)(Pl.ws + WS_W); pg8::Gemm gm{slotp(Pl, 14), W + WO_OUT, Mpost, 1024, 1024, 0, 0}; pg8::StaticOrder S; S.init(Mpost, 1024, nb, bid);
              pg8::EpiResid E{lsd(layer_) == 0 ? x_in_row(Pl, lsd(g_), 0) : (const float*)x_cur_row(Pl, lsd(g_), 0), lsd(layer_) == 0 ? Pl.in[I_META] : (const float*)nullptr, x_cur_row(Pl, lsd(g_), 0), GPTR(float, Pl.ws + WS_XMETA), lsd(g_), NVALID};
              pg8::gemm_phase<pg8::EpiResid, pg8::StaticOrder, true, true>(ldsl, gm, S, E, wv); }
            GSYNC();
            phase_rmsnorm(P, lsd(g_), false, I_NMLP, lsd(layer_), Mpost, NVALID, bid, nb, wv);
            if (PROBE == 5) { phase_rmsnorm(P, lsd(g_), false, I_NMLP, lsd(layer_), Mpost, NVALID, bid, nb, wv); }
            GSYNC();
            for (int rep_ = 0; rep_ < (PROBE == 7 ? 2 : 1); ++rep_)
            { Params Pl = load_params(); asm volatile("" : "+s"(Pl.ws)); pg8::bf16_t* W = (pg8::bf16_t*)(Pl.ws + WS_W); pg8::Gemm gm{slotp(Pl, 0), W + WO_1, Mpost, 4096, 1024, 0, 0}; pg8::StaticOrder S; S.init(Mpost, 4096, nb, bid);
              pg8::EpiBf<1> E{slotp(Pl, 6), 4096, 0};
              pg8::gemm_phase<pg8::EpiBf<1>, pg8::StaticOrder, true, true>(ldsl, gm, S, E, wv); }
            GSYNC();
            { Params Pl = load_params(); asm volatile("" : "+s"(Pl.ws)); pg8::bf16_t* W = (pg8::bf16_t*)(Pl.ws + WS_W); pg8::Gemm gm{slotp(Pl, 6), W + WO_2, Mpost, 1024, 4096, 0, 0}; pg8::StaticOrder S; S.init(Mpost, 1024, nb, bid);
              pg8::EpiResid E{(const float*)x_cur_row(Pl, lsd(g_), 0), (const float*)nullptr, x_cur_row(Pl, lsd(g_), 0), GPTR(float, Pl.ws + WS_XMETA), lsd(g_), NVALID};
              pg8::gemm_phase<pg8::EpiResid, pg8::StaticOrder, true, true>(ldsl, gm, S, E, wv); }
            GSYNC();
        }
    }
}

extern "C" void kernel_launch(void* const* d_in, const int* in_sizes, int n_in, void* d_out, int out_size, void* d_ws, size_t ws_size, hipStream_t stream) {
    static int grid = 0;
    if (grid == 0) {
        if (n_in != 29 || ws_size < WS_NEED) { fprintf(stderr, "kernel_launch: need 29 inputs and %zu bytes of workspace; got %d, %zu\n", (size_t)WS_NEED, n_in, ws_size); grid = -1; return; }
        int dev = 0, cus = 0, per_cu = 0;
        if (hipGetDevice(&dev) != hipSuccess || hipDeviceGetAttribute(&cus, hipDeviceAttributeMultiprocessorCount, dev) != hipSuccess) { grid = -1; return; }
        if (hipFuncSetAttribute((const void*)mega_fwd, hipFuncAttributeMaxDynamicSharedMemorySize, LDS_BYTES) != hipSuccess) { fprintf(stderr, "kernel_launch: hipFuncSetAttribute failed\n"); grid = -1; return; }
        if (hipOccupancyMaxActiveBlocksPerMultiprocessor(&per_cu, (const void*)mega_fwd, 512, LDS_BYTES) != hipSuccess || per_cu < 1) { fprintf(stderr, "kernel_launch: occupancy query says %d\n", per_cu); per_cu = 1; }
        (void)hipGetLastError();
        grid = cus;
    }
    if (grid < 0) return;
    if (hipMemsetAsync(d_ws, 0, 16384, stream) != hipSuccess) { fprintf(stderr, "kernel_launch: memset failed\n"); return; }
    Params p{};
    for (int i = 0; i < 29; ++i) p.in[i] = (const float*)d_in[i];
    p.out = (float*)d_out; p.ws = (unsigned char*)d_ws;
    void* args[] = {&p};
    hipError_t e = hipLaunchCooperativeKernel((const void*)mega_fwd, dim3(grid), dim3(512), args, LDS_BYTES, stream);
    if (e != hipSuccess) fprintf(stderr, "kernel_launch: cooperative launch failed: %s (grid %d)\n", hipGetErrorString(e), grid);
}
```

```cpp
#include <hip/hip_runtime.h>
#include <hip/hip_cooperative_groups.h>
#include <cstdio>
#include <cstdint>
namespace cg = cooperative_groups;
#define PROBE 0
#define DEV __device__ __forceinline__
__device__ __forceinline__ int lsd(int x) { asm volatile("" : "+s"(x)); return x; }
__device__ __forceinline__ int launder_tid(int wv) { int l; asm volatile("v_mbcnt_lo_u32_b32 %0, -1, 0\n\tv_mbcnt_hi_u32_b32 %0, -1, %0" : "=v"(l)); return wv * 64 + l; }
namespace pg8 {
#define PG8_LAS __attribute__((address_space(3)))
typedef unsigned short bf16_t;
typedef short bf16x8 __attribute__((ext_vector_type(8)));
typedef float f32x4 __attribute__((ext_vector_type(4)));
typedef unsigned u32x4 __attribute__((ext_vector_type(4)));
constexpr int BM = 256, BK = 64, HALF = 128, HTB = HALF * BK * 2  , STAGE_BYTES = 8 * HTB, NXCD = 8, WGM = 8;

__host__ __device__ __forceinline__ int lds_byte(int r, int c) { const int st = (r >> 4) * 2 + (c >> 5), rr = r & 15, cc = c & 31, ob = rr * 64 + cc * 2; return st * 1024 + (ob ^ (((ob >> 9) & 1) << 5)); }
__host__ __device__ __forceinline__ void stage_rc(int b, int& R, int& C) { const int st = b / 1024, sb = b % 1024, swz = sb ^ (((sb >> 9) & 1) << 5); R = (st >> 1) * 16 + swz / 64; C = (st & 1) * 32 + (swz % 64) / 2; }
__host__ __device__ __forceinline__ int perm32(int rho) { const int n = rho >> 4, i = rho & 15; return 8 * (i >> 2) + 4 * n + (i & 3); }

struct Unit { int pm, pn; };
struct Gemm { const bf16_t* A; const bf16_t* Bt; int M, N, K; int pn_per_ab; size_t ab_stride; };

struct StaticOrder {
    int nM, nN, nwg, G, c;
    __host__ __device__ void init(int M, int N, int G_, int c_) { nM = M / BM; nN = N / BM; nwg = nM * nN; G = G_; c = c_; }
    __host__ __device__ bool next(int i, Unit& u) const {
        const long L = (long)i * G + c; if (L >= nwg) return false;
        int wgid = (int)L; { const int q = nwg / NXCD, r = nwg % NXCD, xcd = wgid % NXCD, off = wgid / NXCD; wgid = (xcd < r ? xcd * (q + 1) : r * (q + 1) + (xcd - r) * q) + off; }
        const int nig = WGM * nN, gid = wgid / nig, fm = gid * WGM, gsz = (nM - fm) < WGM ? (nM - fm) : WGM;
        u.pm = fm + ((wgid % nig) % gsz); u.pn = (wgid % nig) / gsz; return true;
    }
    __device__ __forceinline__ void a_ready(const Unit&) const {}
    __device__ __forceinline__ void done(const Unit&) const {}
};

typedef float f32x2cv_t __attribute__((ext_vector_type(2))); typedef __bf16 bf16x2cv_t __attribute__((ext_vector_type(2)));
__device__ __forceinline__ unsigned cvt_pk_bf16(float lo, float hi) { const f32x2cv_t v = {lo, hi}; const bf16x2cv_t b = __builtin_convertvector(v, bf16x2cv_t); return __builtin_bit_cast(unsigned, b); }
typedef float f32x2 __attribute__((ext_vector_type(2)));
__device__ __forceinline__ float sigm(float x) { return __builtin_amdgcn_rcpf(1.0f + __expf(-x)); }
template <int ACT  > struct EpiBf {
    static constexpr bool PERM = true, AFTER_DRAIN = false;
    bf16_t* O; int ldc; size_t gstride;
    __device__ __forceinline__ void operator()(const f32x4 (&acc)[2][2][4][2], const Unit& u, int wr, int wc, int fr, int fq) const {
        const int row0 = u.pm * BM + wr * 64 + fr; int colt = u.pn * BM; bf16_t* base = O; int ld = ldc;
        if (gstride) { const int t = colt >> 9; colt &= 511; base += (size_t)t * gstride; ld = 512; }
        const int col0 = colt + wc * 32 + 8 * fq;
#pragma unroll
        for (int ai = 0; ai < 2; ++ai)
#pragma unroll
            for (int m = 0; m < 4; ++m) { bf16_t* rowp = base + (size_t)(row0 + ai * HALF + m * 16) * ld + col0;
#pragma unroll
                for (int bj = 0; bj < 2; ++bj) { f32x4 v0 = acc[ai][bj][m][0], v1 = acc[ai][bj][m][1];
                    if (ACT == 1) {
#pragma unroll
                        for (int i = 0; i < 4; ++i) { float a = fmaxf(v0[i], 0.f), b = fmaxf(v1[i], 0.f); v0[i] = a * a; v1[i] = b * b; } }
                    u32x4 w; w.x = cvt_pk_bf16(v0[0], v0[1]); w.y = cvt_pk_bf16(v0[2], v0[3]); w.z = cvt_pk_bf16(v1[0], v1[1]); w.w = cvt_pk_bf16(v1[2], v1[3]);
                    *(u32x4*)(rowp + bj * HALF) = w; } }
    }
};
struct EpiLR {
    static constexpr bool PERM = true, AFTER_DRAIN = false;
    bf16_t *s0, *s1, *s2, *s3, *s4; const float* w0; const float* a0;
    __device__ __forceinline__ void operator()(const f32x4 (&acc)[2][2][4][2], const Unit& u, int wr, int wc, int fr, int fq) const {
        const int row0 = u.pm * BM + wr * 64 + fr; const int colg = u.pn * BM; const int seg = colg >> 9; const int cb = colg & 511;
        bf16_t* base = seg == 0 ? s0 : seg == 1 ? s1 : seg == 2 ? s2 : seg == 3 ? s3 : s4;
        const int col0 = cb + wc * 32 + 8 * fq;
        const float* bsrc = seg < 2 ? w0 + seg * 512 : a0 + (seg & 1) * 512;
        const float sc = seg < 2 ? 0.6065306597f : 1.0f; const float bm = seg < 4 ? 1.f : 0.f; const bool act = seg < 4;
#pragma unroll
        for (int bj = 0; bj < 2; ++bj) {
            const f32x4 b0 = *(const f32x4*)(bsrc + col0 + bj * HALF) * bm, b1 = *(const f32x4*)(bsrc + col0 + bj * HALF + 4) * bm;
#pragma unroll
            for (int ai = 0; ai < 2; ++ai)
#pragma unroll
                for (int m = 0; m < 4; ++m) { bf16_t* rowp = base + (size_t)(row0 + ai * HALF + m * 16) * 512 + col0;
                    f32x4 v0 = acc[ai][bj][m][0] + b0, v1 = acc[ai][bj][m][1] + b1;
#pragma unroll
                    for (int i = 0; i < 4; ++i) { const float g0 = sc * sigm(v0[i]), g1 = sc * sigm(v1[i]); v0[i] = act ? g0 : v0[i]; v1[i] = act ? g1 : v1[i]; }
                    u32x4 w; w.x = cvt_pk_bf16(v0[0], v0[1]); w.y = cvt_pk_bf16(v0[2], v0[3]); w.z = cvt_pk_bf16(v1[0], v1[1]); w.w = cvt_pk_bf16(v1[2], v1[3]);
                    *(u32x4*)(rowp + bj * HALF) = w; __builtin_amdgcn_sched_barrier(0); }
        }
    }
};
struct EpiGate {
    static constexpr bool PERM = true, AFTER_DRAIN = false;
    const bf16_t* Pm; bf16_t* Mg;
    __device__ __forceinline__ void operator()(const f32x4 (&acc)[2][2][4][2], const Unit& u, int wr, int wc, int fr, int fq) const {
        const int row0 = u.pm * BM + wr * 64 + fr; const int ocol = u.pn * 64 + wc * 16 + fq * 4;
#pragma unroll
        for (int ai = 0; ai < 2; ++ai)
#pragma unroll
            for (int m = 0; m < 4; ++m) { const size_t row = (size_t)(row0 + ai * HALF + m * 16);
                float s0 = 0.f, s1 = 0.f, s2 = 0.f, s3 = 0.f;
#pragma unroll
                for (int bj = 0; bj < 2; ++bj)
#pragma unroll
                    for (int n = 0; n < 2; ++n) { const int br = bj * 2 + n;
                        const uint2 pw = *(const uint2*)(Pm + row * 4096 + br * 1024 + ocol);
                        const f32x4 a = acc[ai][bj][m][n];
                        s0 += sigm(a[0]) * __uint_as_float(pw.x << 16); s1 += sigm(a[1]) * __uint_as_float(pw.x & 0xffff0000u);
                        s2 += sigm(a[2]) * __uint_as_float(pw.y << 16); s3 += sigm(a[3]) * __uint_as_float(pw.y & 0xffff0000u); }
                uint2 o; o.x = cvt_pk_bf16(s0, s1); o.y = cvt_pk_bf16(s2, s3);
                *(uint2*)(Mg + row * 1024 + ocol) = o; }
    }
};
struct EpiResid {
    static constexpr bool PERM = true, AFTER_DRAIN = false;
    const float* om; const float* mt; float* nm; float* xmb; int g; int rlim;
    __device__ __forceinline__ void operator()(const f32x4 (&acc)[2][2][4][2], const Unit& u, int wr, int wc, int fr, int fq) const {
        const int row0 = u.pm * BM + wr * 64 + fr; const int col0 = u.pn * BM + wc * 32 + 8 * fq;
#pragma unroll
        for (int ai = 0; ai < 2; ++ai)
#pragma unroll
            for (int m = 0; m < 4; ++m) { const int r = row0 + ai * HALF + m * 16;
                if (r < rlim) {
                    const int mi = r - 16384;
                    float* dmeta = xmb + (size_t)(mi < 64 ? g * 64 + mi : ((mi >> 6) - 1) * 64 + (mi & 63)) * 1024;
                    const float* src = r < 16384 ? om + (size_t)r * 1024 : (mt ? mt + (size_t)(mi & 15) * 1024 : (const float*)dmeta);
                    float* dst = r < 16384 ? nm + (size_t)r * 1024 : dmeta;
#pragma unroll
                    for (int bj = 0; bj < 2; ++bj)
#pragma unroll
                        for (int n = 0; n < 2; ++n) { const int c = col0 + bj * HALF + 4 * n;
                            const f32x4 xo = *(const f32x4*)(src + c); *(f32x4*)(dst + c) = xo + acc[ai][bj][m][n]; } } }
    }
};
template <class Epi, class Sched, bool ALIGN_EPI = false, bool SP2 = false>
__device__ __forceinline__ void gemm_phase(PG8_LAS unsigned char* lds, const Gemm g, const Sched& S, const Epi& E, int wv) {
    const int tid = launder_tid(wv), wid = __builtin_amdgcn_readfirstlane(tid >> 6), lane = tid & 63, wr = wid >> 2, wc = wid & 3, fr = lane & 15, fq = lane >> 4;
    const int K = g.K, nt = K / BK;
    unsigned voffA[2], voffB[2];
#pragma unroll
    for (int i = 0; i < 2; ++i) { int R, C; stage_rc(tid * 16 + i * 8192, R, C); const int Rb = Epi::PERM ? ((R & ~31) + perm32(R & 31)) : R;
        voffA[i] = (unsigned)(R * K + C) * 2u; voffB[i] = (unsigned)(Rb * K + C) * 2u; }
    const size_t kstep = (size_t)(BK * 2);
    const size_t hstep = (size_t)HALF * K * 2;
    const size_t tstep = 2 * hstep;
    const unsigned ldsw = (unsigned)wid * 1024u;
    const int aoff = lds_byte(wr * 64 + fr, fq * 8), boff = lds_byte(wc * 32 + fr, fq * 8);
#define PG8_SA(b, h) (((b) * 2 + (h)) * HTB)
#define PG8_SB(b, h) ((4 + (b) * 2 + (h)) * HTB)
#define PG8_STAGE(bufoff, gbase, voff) do { _Pragma("unroll") for (int _i = 0; _i < 2; ++_i) \
        __builtin_amdgcn_global_load_lds((const unsigned*)((const char*)(gbase) + (voff)[_i]), (PG8_LAS unsigned*)(lds + (bufoff) + ldsw + _i * 8192), 16, 0, 0); } while (0)
#define PG8_LDA(dst, b, h) do { _Pragma("unroll") for (int m = 0; m < 4; ++m) _Pragma("unroll") for (int k = 0; k < 2; ++k) dst[m][k] = *(const PG8_LAS bf16x8*)(lds + PG8_SA(b, h) + aoff + m * 2048 + k * 1024); } while (0)
#define PG8_LDB(dst, b, h) do { _Pragma("unroll") for (int n = 0; n < 2; ++n) _Pragma("unroll") for (int k = 0; k < 2; ++k) dst[n][k] = *(const PG8_LAS bf16x8*)(lds + PG8_SB(b, h) + boff + n * 2048 + k * 1024); } while (0)
#define PG8_MMA(ai, bj, At, Bt) do { __builtin_amdgcn_s_setprio(1); _Pragma("unroll") for (int m = 0; m < 4; ++m) _Pragma("unroll") for (int n = 0; n < 2; ++n) _Pragma("unroll") for (int k = 0; k < 2; ++k) \
        acc[ai][bj][m][n] = __builtin_amdgcn_mfma_f32_16x16x32_bf16(Bt[n][k], At[m][k], acc[ai][bj][m][n], 0, 0, 0); __builtin_amdgcn_s_setprio(0); } while (0)
#define PG8_WAIT_V(n) asm volatile("s_waitcnt vmcnt(" #n ")" ::: "memory")
#define PG8_WAIT_L(n) asm volatile("s_waitcnt lgkmcnt(" #n ")" ::: "memory")
#define PG8_BAR __builtin_amdgcn_s_barrier()
#define PG8_SCHED __builtin_amdgcn_sched_barrier(0)
    Unit cur, nxt; int ui = 0;
    if (!S.next(0, cur)) return;
    f32x4 acc[2][2][4][2];
#pragma unroll
    for (int a = 0; a < 2; ++a)
#pragma unroll
        for (int b = 0; b < 2; ++b)
#pragma unroll
            for (int m = 0; m < 4; ++m)
#pragma unroll
                for (int n = 0; n < 2; ++n) { float z_ = 0.f; asm volatile("" : "+v"(z_)); acc[a][b][m][n] = (f32x4){z_, z_, z_, z_}; }
    bf16x8 At[4][2], B0[2][2], B1[2][2];
    const char* cA = (const char*)g.A + (g.pn_per_ab ? (size_t)(cur.pn / g.pn_per_ab) * g.ab_stride : (size_t)0) + (size_t)cur.pm * tstep; const char* cB = (const char*)g.Bt + (size_t)cur.pn * tstep;
    S.a_ready(cur);
    if constexpr (SP2) {
        PG8_STAGE(PG8_SB(0, 0), cB, voffB); PG8_STAGE(PG8_SB(0, 1), cB + hstep, voffB); PG8_STAGE(PG8_SA(0, 0), cA, voffA); PG8_STAGE(PG8_SA(0, 1), cA + hstep, voffA);
        if (wr == 1) PG8_BAR;
        PG8_WAIT_V(2); PG8_BAR;
        PG8_STAGE(PG8_SB(1, 0), cB + kstep, voffB); PG8_STAGE(PG8_SA(1, 0), cA + kstep, voffA); PG8_STAGE(PG8_SB(1, 1), cB + hstep + kstep, voffB);
        PG8_WAIT_V(6); PG8_BAR;
    } else {
        PG8_STAGE(PG8_SB(0, 0), cB, voffB); PG8_STAGE(PG8_SA(0, 0), cA, voffA); PG8_STAGE(PG8_SB(0, 1), cB + hstep, voffB); PG8_STAGE(PG8_SA(0, 1), cA + hstep, voffA);
        if (wr == 1) PG8_BAR;
        PG8_WAIT_V(4); PG8_BAR;
        PG8_STAGE(PG8_SB(1, 0), cB + kstep, voffB); PG8_STAGE(PG8_SA(1, 0), cA + kstep, voffA); PG8_STAGE(PG8_SB(1, 1), cB + hstep + kstep, voffB);
        PG8_WAIT_V(6); PG8_BAR;
    }
    for (;;) {
        const bool has_next = S.next(ui + 1, nxt);
        const char* nA = has_next ? (const char*)g.A + (g.pn_per_ab ? (size_t)(nxt.pn / g.pn_per_ab) * g.ab_stride : (size_t)0) + (size_t)nxt.pm * tstep : cA; const char* nB = has_next ? (const char*)g.Bt + (size_t)nxt.pn * tstep : cB;
#pragma unroll 1
        for (int t = 0; t < nt; t += 2) {
            const bool last = (t == nt - 2);
            const char* a1 = cA + (size_t)(t + 1) * kstep;
            const char* a2 = last ? nA : cA + (size_t)(t + 2) * kstep; const char* b2 = last ? nB : cB + (size_t)(t + 2) * kstep;
            const char* a3 = a2 + kstep; const char* b3 = b2 + kstep;
            if (last && has_next) S.a_ready(nxt);
            if constexpr (SP2) {
            PG8_LDB(B0, 0, 0); PG8_LDB(B1, 0, 1); PG8_SCHED; PG8_LDA(At, 0, 0); PG8_STAGE(PG8_SA(1, 1), a1 + hstep, voffA);
            PG8_WAIT_V(8); PG8_WAIT_L(0); PG8_BAR; PG8_MMA(0, 0, At, B0); PG8_MMA(0, 1, At, B1); PG8_BAR; PG8_SCHED;
            PG8_LDA(At, 0, 1); PG8_STAGE(PG8_SB(0, 0), b2, voffB); PG8_STAGE(PG8_SB(0, 1), b2 + hstep, voffB); PG8_STAGE(PG8_SA(0, 0), a2, voffA);
            PG8_WAIT_V(8); PG8_WAIT_L(0); PG8_BAR; PG8_MMA(1, 0, At, B0); PG8_MMA(1, 1, At, B1); PG8_BAR; PG8_SCHED;
            PG8_LDB(B0, 1, 0); PG8_LDB(B1, 1, 1); PG8_SCHED; PG8_LDA(At, 1, 0); PG8_STAGE(PG8_SA(0, 1), a2 + hstep, voffA);
            PG8_WAIT_V(8); PG8_WAIT_L(0); PG8_BAR; PG8_MMA(0, 0, At, B0); PG8_MMA(0, 1, At, B1); PG8_BAR; PG8_SCHED;
            PG8_LDA(At, 1, 1); PG8_STAGE(PG8_SB(1, 0), b3, voffB); PG8_STAGE(PG8_SB(1, 1), b3 + hstep, voffB); PG8_STAGE(PG8_SA(1, 0), a3, voffA);
            PG8_WAIT_V(8); PG8_WAIT_L(0); PG8_BAR; PG8_MMA(1, 0, At, B0); PG8_MMA(1, 1, At, B1); PG8_BAR; PG8_SCHED;
            } else {
            PG8_LDB(B0, 0, 0); PG8_SCHED; PG8_LDA(At, 0, 0); PG8_STAGE(PG8_SA(1, 1), a1 + hstep, voffA);
            PG8_WAIT_L(8); PG8_BAR; PG8_WAIT_L(0); PG8_MMA(0, 0, At, B0); PG8_BAR; PG8_SCHED;
            PG8_LDB(B1, 0, 1); PG8_STAGE(PG8_SB(0, 0), b2, voffB);
            PG8_BAR; PG8_WAIT_L(0); PG8_MMA(0, 1, At, B1); PG8_BAR;
            PG8_LDA(At, 0, 1); PG8_STAGE(PG8_SA(0, 0), a2, voffA);
            PG8_BAR; PG8_WAIT_L(0); PG8_MMA(1, 0, At, B0); PG8_BAR; PG8_SCHED;
            PG8_STAGE(PG8_SB(0, 1), b2 + hstep, voffB);
            PG8_WAIT_V(6); PG8_BAR; PG8_MMA(1, 1, At, B1); PG8_BAR;
            PG8_LDB(B0, 1, 0); PG8_SCHED; PG8_LDA(At, 1, 0); PG8_STAGE(PG8_SA(0, 1), a2 + hstep, voffA);
            PG8_WAIT_L(8); PG8_BAR; PG8_WAIT_L(0); PG8_MMA(0, 0, At, B0); PG8_BAR; PG8_SCHED;
            PG8_LDB(B1, 1, 1); PG8_STAGE(PG8_SB(1, 0), b3, voffB);
            PG8_BAR; PG8_WAIT_L(0); PG8_MMA(0, 1, At, B1); PG8_BAR;
            PG8_LDA(At, 1, 1); PG8_STAGE(PG8_SA(1, 0), a3, voffA);
            PG8_BAR; PG8_WAIT_L(0); PG8_MMA(1, 0, At, B0); PG8_BAR; PG8_SCHED;
            PG8_STAGE(PG8_SB(1, 1), b3 + hstep, voffB);
            PG8_WAIT_V(6); PG8_BAR; PG8_MMA(1, 1, At, B1); PG8_BAR;
            }
        }
        if constexpr (ALIGN_EPI) { if (wr == 0) PG8_BAR; }
        if constexpr (!Epi::AFTER_DRAIN) { E(acc, cur, wr, wc, fr, fq); S.done(cur); }
        if (!has_next) break;
#pragma unroll
        for (int a = 0; a < 2; ++a)
#pragma unroll
            for (int b = 0; b < 2; ++b)
#pragma unroll
                for (int m = 0; m < 4; ++m)
#pragma unroll
                    for (int n = 0; n < 2; ++n) { float z_ = 0.f; asm volatile("" : "+v"(z_)); acc[a][b][m][n] = (f32x4){z_, z_, z_, z_}; }
        cur = nxt; cA = nA; cB = nB; ++ui;
        if constexpr (ALIGN_EPI) { if (wr == 1) PG8_BAR; }
    }
    PG8_WAIT_V(0);
    if constexpr (!ALIGN_EPI) { if (wr == 0) PG8_BAR; }
    PG8_BAR;
    if constexpr (Epi::AFTER_DRAIN) { E.fused(acc, cur, wr, wc, fr, fq, lds, wid, lane); S.done(cur); }
#undef PG8_SA
#undef PG8_SB
#undef PG8_STAGE
#undef PG8_LDA
#undef PG8_LDB
#undef PG8_MMA
#undef PG8_WAIT_V
#undef PG8_WAIT_L
#undef PG8_BAR
#undef PG8_SCHED
}
}
typedef unsigned short bf16_t;
typedef short bf16x8 __attribute__((ext_vector_type(8)));
typedef float f32x4 __attribute__((ext_vector_type(4)));
typedef float f32x16 __attribute__((ext_vector_type(16)));
constexpr int LSEQ = 4112, TREAL = 16384, TG = 16448, TGP = 16640, NGRP = 3;
constexpr size_t SLOT_E = (size_t)TGP * 512;
constexpr size_t SLOT_B = SLOT_E * 2;
constexpr size_t MiB = 1u << 20;
constexpr size_t WS_XMETA = 1 * MiB, WS_DECAY = 2 * MiB, WS_SIDE = 3 * MiB + 512 * 1024, WS_W = 5 * MiB, WS_SLOTS = 53 * MiB;
constexpr size_t WS_NEED = 512 * MiB;
static_assert(WS_SLOTS + 25 * SLOT_B + (size_t)(16448 - 11408) * 8960 <= 512 * MiB, "record tail fits the workspace");
constexpr size_t WO_IN = 0, WO_G = 7864320, WO_BP = 12058624, WO_OUT = 14155776, WO_1 = 15204352, WO_2 = 19398656, WO_LR = 23592960;
constexpr int LDS_BYTES = 140 * 1024;
enum { I_XP = 0, I_XS, I_META, I_NMIX, I_WIN, I_LBL, I_ONORM, I_CONV, I_QN, I_KN, I_LAM, I_SUBLN, I_MU, I_W0, I_W2, I_A0, I_A2, I_G2, I_KK, I_KA, I_RK, I_LNG, I_LNB, I_WG, I_BP, I_WOUT, I_NMLP, I_W1, I_W2M };
struct Params { const float* in[29]; float* out; unsigned char* ws; };
#define GPTR(T, p) ((T*)(__attribute__((address_space(1))) T*)(p))
typedef const __attribute__((address_space(4))) Params* KParamsPtr;
typedef unsigned u32x4g_t __attribute__((ext_vector_type(4)));
#define GLD16(p) (*(const __attribute__((address_space(1))) u32x4g_t*)(p))
DEV KParamsPtr kparams() { KParamsPtr p = (KParamsPtr)__builtin_amdgcn_kernarg_segment_ptr(); asm volatile("" : "+s"(p)); return p; }
DEV Params load_params() { KParamsPtr p = kparams(); Params r;
#pragma unroll
    for (int i = 0; i < 29; ++i) r.in[i] = (const float*)(const __attribute__((address_space(1))) float*)(unsigned long long)p->in[i];
    r.out = (float*)(__attribute__((address_space(1))) float*)(unsigned long long)p->out; r.ws = p->ws; return r; }
DEV unsigned char* launder_ws(unsigned char* p) { __attribute__((address_space(1))) unsigned char* g = (__attribute__((address_space(1))) unsigned char*)(unsigned long long)p; asm volatile("" : "+s"(g)); return (unsigned char*)g; }
DEV unsigned zero_u() { unsigned z = 0u; asm volatile("" : "+v"(z)); return z; }

#define ROWPRO const int tid_ = launder_tid(wv); const int lane = tid_ & 63; const int gw = bid * 8 + __builtin_amdgcn_readfirstlane(tid_ >> 6); const int ngw = nb * 8;
DEV float bf2f(unsigned short u) { return __uint_as_float((unsigned)u << 16); }
DEV unsigned pk2(float lo, float hi) { return pg8::cvt_pk_bf16(lo, hi); }
DEV void unpack8(const uint4 w, float* f) {
    f[0] = __uint_as_float(w.x << 16); f[1] = __uint_as_float(w.x & 0xffff0000u); f[2] = __uint_as_float(w.y << 16); f[3] = __uint_as_float(w.y & 0xffff0000u);
    f[4] = __uint_as_float(w.z << 16); f[5] = __uint_as_float(w.z & 0xffff0000u); f[6] = __uint_as_float(w.w << 16); f[7] = __uint_as_float(w.w & 0xffff0000u); }
DEV uint4 pack8(const float* f) { uint4 o; o.x = pk2(f[0], f[1]); o.y = pk2(f[2], f[3]); o.z = pk2(f[4], f[5]); o.w = pk2(f[6], f[7]); return o; }
DEV bf16_t* slotp(const Params& P, int s) { return GPTR(bf16_t, P.ws + WS_SLOTS + (size_t)s * SLOT_B); }
DEV int row_of(int sl, int p) { return p >= 16 ? sl * 4096 + p - 16 : TREAL + sl * 16 + p; }
DEV void pos_of(int r, int& sl, int& p) { if (r < TREAL) { sl = r >> 12; p = (r & 4095) + 16; } else { const int m = r - TREAL; sl = m >> 4; p = m & 15; } }
DEV float wave_sum(float v) {
#pragma unroll
    for (int o = 1; o < 64; o <<= 1) v += __shfl_xor(v, o);
    return v; }
DEV float red8(float v) { v += __shfl_xor(v, 1); v += __shfl_xor(v, 2); v += __shfl_xor(v, 4); return v; }
DEV f32x4 mfma16(bf16x8 a, bf16x8 b, f32x4 c) { return __builtin_amdgcn_mfma_f32_16x16x32_bf16(a, b, c, 0, 0, 0); }
DEV f32x16 mfma32(bf16x8 a, bf16x8 b, f32x16 c) { return __builtin_amdgcn_mfma_f32_32x32x16_bf16(a, b, c, 0, 0, 0); }
DEV const float* x_in_row(const Params& P, int g, int r) {
    if (r < TREAL) return (g < 2 ? P.in[I_XP] + (size_t)g * TREAL * 1024 : P.in[I_XS]) + (size_t)r * 1024;
    return P.in[I_META] + (size_t)((r - TREAL) & 15) * 1024; }
DEV float* x_cur_row(const Params& P, int g, int r) {
    if (r < TREAL) return P.out + ((size_t)g * TREAL + r) * 1024;
    const int m = r - TREAL;
    return GPTR(float, P.ws + WS_XMETA) + (size_t)(m < 64 ? g * 64 + m : ((m >> 6) - 1) * 64 + (m & 63)) * 1024; }

DEV int gate_row(int n) { const int br = n >> 10, c = n & 1023, pn = c >> 6, oc = c & 63, wc = oc >> 4, fq = (oc >> 2) & 3, i = oc & 3; return pn * 256 + (br >> 1) * 128 + wc * 32 + fq * 8 + (br & 1) * 4 + i; }
template <int MODE> DEV void wt_items(const float* __restrict__ W, int K, int N, bf16_t* WT, int row_off, float* scr, int gw, int ngw, int lane) {
    const int nblk = N >> 5, items = (K >> 6) * nblk;
    for (int it = gw; it < items; it += ngw) {
        const int kb = it / nblk, nbk = it - kb * nblk, k0 = 64 * kb, n0 = 32 * nbk;
#pragma unroll 8
        for (int i = 0; i < 32; ++i) { const int kk = 2 * i + (lane >> 5); scr[kk * 33 + (lane & 31)] = W[(size_t)(k0 + kk) * N + n0 + (lane & 31)]; }
        asm volatile("s_waitcnt lgkmcnt(0)" ::: "memory");
        const int c = lane & 7;
#pragma unroll
        for (int j = 0; j < 4; ++j) { const int n = (lane >> 3) + 8 * j; const float* sp = scr + (8 * c) * 33 + n;
            uint4 o; o.x = pk2(sp[0 * 33], sp[1 * 33]); o.y = pk2(sp[2 * 33], sp[3 * 33]); o.z = pk2(sp[4 * 33], sp[5 * 33]); o.w = pk2(sp[6 * 33], sp[7 * 33]);
            const int dr = MODE == 1 ? gate_row(n0 + n) : n0 + n + row_off;
            *(uint4*)(WT + (size_t)dr * K + k0 + 8 * c) = o; }
        asm volatile("s_waitcnt lgkmcnt(0)" ::: "memory");
    }
}
DEV void phase_weights(const Params& P0, int layer, unsigned char* lds, int bid, int nb, int wv) {
    Params P = load_params(); P.ws = launder_ws(P.ws);
    const int tid = launder_tid(wv), lane = tid & 63, w = __builtin_amdgcn_readfirstlane(tid >> 6);
    const int gtid = bid * 512 + tid, gth = nb * 512, gw = bid * 8 + w, ngw = nb * 8;
    float* scr = (float*)(lds + w * 8448);
    bf16_t* W = GPTR(bf16_t, P.ws + WS_W);
    wt_items<0>(P.in[I_WIN] + (size_t)layer * 1024 * 7552, 1024, 7552, W + WO_IN, 0, scr, gw, ngw, lane);
    for (int it = gtid; it < 128 * 128; it += gth) { const unsigned z = zero_u(); *(uint4*)(W + WO_IN + (size_t)7552 * 1024 + (size_t)it * 8) = make_uint4(z, z, z, z); }
    wt_items<1>(P.in[I_WG] + (size_t)layer * 1024 * 4096, 1024, 4096, W + WO_G, 0, scr, gw, ngw, lane);
    for (int n = 0; n < 4; ++n) wt_items<0>(P.in[I_BP] + (size_t)(layer * 4 + n) * 512 * 1024, 512, 1024, W + WO_BP, n * 1024, scr, gw, ngw, lane);
    wt_items<0>(P.in[I_WOUT] + (size_t)layer * 1024 * 1024, 1024, 1024, W + WO_OUT, 0, scr, gw, ngw, lane);
    wt_items<0>(P.in[I_W1] + (size_t)layer * 1024 * 4096, 1024, 4096, W + WO_1, 0, scr, gw, ngw, lane);
    wt_items<0>(P.in[I_W2M] + (size_t)layer * 4096 * 1024, 4096, 1024, W + WO_2, 0, scr, gw, ngw, lane);
    for (int it = gtid; it < 2560 * 48; it += gth) {
        const int row = it / 48, k8 = it - row * 48, seg = row >> 9, c = row & 511, k0 = k8 * 8;
        float v[8];
#pragma unroll
        for (int j = 0; j < 8; ++j) { const int k = k0 + j; float x = 0.f;
            if (seg == 0) { if (k < 64) x = P.in[I_W2][((size_t)(layer * 2 + 0) * 64 + k) * 512 + c]; }
            else if (seg == 1) { if (k >= 64 && k < 128) x = P.in[I_W2][((size_t)(layer * 2 + 1) * 64 + (k - 64)) * 512 + c]; }
            else if (seg == 2) { if (k >= 128 && k < 192) x = P.in[I_A2][((size_t)(layer * 2 + 0) * 64 + (k - 128)) * 512 + c]; }
            else if (seg == 3) { if (k >= 192 && k < 256) x = P.in[I_A2][((size_t)(layer * 2 + 1) * 64 + (k - 192)) * 512 + c]; }
            else { if (k >= 256) x = P.in[I_G2][((size_t)layer * 128 + (k - 256)) * 512 + c]; }
            v[j] = x; }
        *(uint4*)(W + WO_LR + (size_t)row * 384 + k0) = pack8(v);
    }
}

DEV void phase_rmsnorm(const Params& P0, int g, bool src_in, int gain_idx, int layer, int nrows, int nvalid, int bid, int nb, int wv) {
    Params P = load_params(); P.ws = launder_ws(P.ws);
    ROWPRO
    const float* gain = P.in[gain_idx] + layer * 1024;
    bf16_t* H = slotp(P, 0);
    for (int r = gw; r < nrows; r += ngw) {
        uint2* o8 = (uint2*)(H + (size_t)r * 1024) + lane;
        if (r >= nvalid) {
#pragma unroll
            for (int j = 0; j < 4; ++j) { const unsigned z = zero_u(); o8[64 * j] = make_uint2(z, z); }
            continue; }
        const f32x4* xr = (const f32x4*)(src_in ? x_in_row(P, g, r) : (const float*)x_cur_row(P, g, r)) + lane;
        f32x4 v[4]; float s = 0.f;
#pragma unroll
        for (int j = 0; j < 4; ++j) { v[j] = xr[64 * j]; s += (v[j].x * v[j].x + v[j].y * v[j].y) + (v[j].z * v[j].z + v[j].w * v[j].w); }
        const float rs = rsqrtf(wave_sum(s) * (1.f / 1024.f) + 1e-6f);
#pragma unroll
        for (int j = 0; j < 4; ++j) { const f32x4 gg = *((const f32x4*)gain + lane + 64 * j);
            o8[64 * j] = make_uint2(pk2(v[j].x * rs * gg.x, v[j].y * rs * gg.y), pk2(v[j].z * rs * gg.z, v[j].w * rs * gg.w)); }
    }
}
DEV void phase_da_prep(const Params& P0, int layer, int bid, int nb, int wv) {
    Params P = load_params(); P.ws = launder_ws(P.ws);
    ROWPRO
    const float inv8[8] = {1.0f, 0.19392274474868576f, 0.03760603093086393f, 0.007292664737217109f, 0.001414213562373095f, 0.0002742481756762073f, 5.318295896944988e-05f, 1.031338537721246e-05f};
    const int d0 = (lane & 7) * 8;
    float gq[8], gk[8];
#pragma unroll
    for (int j = 0; j < 8; ++j) { gq[j] = P.in[I_QN][layer * 64 + d0 + j]; gk[j] = P.in[I_KN][layer * 64 + d0 + j]; }
    for (int r = gw; r < TG; r += ngw) {
        int sl, p; pos_of(r, sl, p);
        float cs[8], sn[8];
#pragma unroll
        for (int j = 0; j < 8; ++j) { const float ang = (float)p * inv8[j]; double a = (double)ang; a -= 6.283185307179586 * __builtin_rint(a * 0.15915494309189535); const float rr = (float)a; cs[j] = __cosf(rr); sn[j] = __sinf(rr); }
#pragma unroll
        for (int which = 0; which < 2; ++which) {
            uint4* ptr = (uint4*)(slotp(P, 10 + which) + (size_t)r * 512) + lane;
            float f[8]; unpack8(*ptr, f);
            float ss = 0.f;
#pragma unroll
            for (int j = 0; j < 8; ++j) ss += f[j] * f[j];
            ss = red8(ss);
            const float rs = rsqrtf(ss * (1.f / 64.f) + 1e-6f);
#pragma unroll
            for (int j = 0; j < 8; ++j) f[j] = f[j] * rs * (which == 0 ? gq[j] : gk[j]);
#pragma unroll
            for (int j = 0; j < 8; ++j) { const float pr = __shfl_xor(f[j], 1);
                if ((lane & 7) == 0) f[j] = f[j] * cs[j] - pr * sn[j];
                else if ((lane & 7) == 1) f[j] = f[j] * cs[j] + pr * sn[j]; }
            if (which == 0) {
#pragma unroll
                for (int j = 0; j < 8; ++j) f[j] *= 0.18033688011112042f; }
            *ptr = pack8(f);
        }
    }
}
DEV void phase_conv(const Params& P0, int layer, int bid, int nb, int wv) {
    Params P = load_params(); P.ws = launder_ws(P.ws);
    ROWPRO
    const int c0 = lane * 8;
    float w0[8], w1[8], w2[8];
#pragma unroll
    for (int j = 0; j < 8; ++j) { w0[j] = P.in[I_CONV][(layer * 3 + 0) * 512 + c0 + j]; w1[j] = P.in[I_CONV][(layer * 3 + 1) * 512 + c0 + j]; w2[j] = P.in[I_CONV][(layer * 3 + 2) * 512 + c0 + j]; }
    const bf16_t* SB = slotp(P, 7); const bf16_t* SC = slotp(P, 8); const bf16_t* SH = slotp(P, 9); bf16_t* Y = slotp(P, 3);
    for (int r = gw; r < TG; r += ngw) {
        int sl, p; pos_of(r, sl, p);
        float acc[8], a[8], b[8];
        unpack8(*((const uint4*)(SC + (size_t)r * 512) + lane), a); unpack8(*((const uint4*)(SH + (size_t)r * 512) + lane), b);
#pragma unroll
        for (int j = 0; j < 8; ++j) acc[j] = a[j] * b[j] * w1[j];
        if (p > 0) { const int rp = row_of(sl, p - 1);
            unpack8(*((const uint4*)(SC + (size_t)rp * 512) + lane), a); unpack8(*((const uint4*)(SH + (size_t)rp * 512) + lane), b);
#pragma unroll
            for (int j = 0; j < 8; ++j) acc[j] += a[j] * b[j] * w0[j]; }
        if (p < LSEQ - 1) { const int rn = row_of(sl, p + 1);
            unpack8(*((const uint4*)(SC + (size_t)rn * 512) + lane), a); unpack8(*((const uint4*)(SH + (size_t)rn * 512) + lane), b);
#pragma unroll
            for (int j = 0; j < 8; ++j) acc[j] += a[j] * b[j] * w2[j]; }
        unpack8(*((const uint4*)(SB + (size_t)r * 512) + lane), a);
#pragma unroll
        for (int j = 0; j < 8; ++j) acc[j] *= a[j];
        *((uint4*)(Y + (size_t)r * 512) + lane) = pack8(acc);
    }
}
DEV void phase_rw_prep(const Params& P0, int layer, int bid, int nb, int wv) {
    Params P = load_params(); P.ws = launder_ws(P.ws);
    ROWPRO
    const float* mu = P.in[I_MU] + (size_t)layer * 1920;
    for (int r = gw; r < TG; r += ngw) {
        int sl, p; pos_of(r, sl, p);
        const int rp = p > 0 ? row_of(sl, p - 1) : -1, rn = p < LSEQ - 1 ? row_of(sl, p + 1) : -1;
#pragma unroll
        for (int grp = 0; grp < 4; ++grp) {
            if (grp == 3 && lane >= 48) break;
            const int c0 = (grp < 3 ? grp * 512 : 1536) + lane * 8;
            const bf16_t* src = slotp(P, 13 + (c0 >> 9)) + (c0 & 511);
            float u[8], up[8], un[8], xm[8];
            unpack8(*(const uint4*)(src + (size_t)r * 512), u);
            if (rp >= 0) unpack8(*(const uint4*)(src + (size_t)rp * 512), up); else {
#pragma unroll
                for (int j = 0; j < 8; ++j) up[j] = 0.f; }
            if (rn >= 0) unpack8(*(const uint4*)(src + (size_t)rn * 512), un); else {
#pragma unroll
                for (int j = 0; j < 8; ++j) un[j] = 0.f; }
#pragma unroll
            for (int j = 0; j < 8; ++j) xm[j] = u[j] + mu[c0 + j] * (0.5f * (up[j] + un[j]) - u[j]);
            if (grp < 3) {
                *((uint4*)(slotp(P, 17 + grp) + (size_t)r * 512) + lane) = pack8(xm);
                if (grp == 1) {
                    float kk[8], ss = 0.f;
#pragma unroll
                    for (int j = 0; j < 8; ++j) { kk[j] = xm[j] * P.in[I_KK][layer * 512 + c0 - 512 + j]; ss += kk[j] * kk[j]; }
                    ss = red8(ss);
                    const float inv = 1.0f / fmaxf(sqrtf(ss), 1e-12f);
#pragma unroll
                    for (int j = 0; j < 8; ++j) kk[j] *= inv;
                    *((uint4*)(slotp(P, 20) + (size_t)r * 512) + lane) = pack8(kk); }
            } else {
                const int a0 = lane * 8;
                float o[8];
#pragma unroll
                for (int j = 0; j < 8; ++j) { const float x = xm[j];
                    if (a0 < 128) { const float e = __expf(2.f * x); o[j] = 1.f - 2.f / (e + 1.f); }
                    else if (a0 < 256) o[j] = x;
                    else o[j] = 1.f / (1.f + __expf(-x)); }
                *((uint4*)(slotp(P, 21) + (size_t)r * 384) + lane) = pack8(o);
            }
        }
    }
    for (int r = TG + gw; r < TGP; r += ngw) if (lane < 48) { const unsigned z = zero_u(); *((uint4*)(slotp(P, 21) + (size_t)r * 384) + lane) = make_uint4(z, z, z, z); }
}
DEV void phase_rw_post(const Params& P0, int layer, int g, int nrows, int bid, int nb, int wv) {
    Params P = load_params(); P.ws = launder_ws(P.ws);
    ROWPRO
    const int c0 = lane * 8;
    float ka[8], rk[8], lg[8], lb[8];
#pragma unroll
    for (int j = 0; j < 8; ++j) { ka[j] = P.in[I_KA][layer * 512 + c0 + j]; rk[j] = P.in[I_RK][layer * 512 + c0 + j]; lg[j] = P.in[I_LNG][layer * 512 + c0 + j]; lb[j] = P.in[I_LNB][layer * 512 + c0 + j]; }
    for (int r = gw; r < nrows; r += ngw) {
        float of[8], ob[8], o[8];
        unpack8(*((const uint4*)(slotp(P, 15) + (size_t)r * 512) + lane), of); unpack8(*((const uint4*)(slotp(P, 16) + (size_t)r * 512) + lane), ob);
        float s = 0.f;
#pragma unroll
        for (int j = 0; j < 8; ++j) { o[j] = of[j] + ob[j]; s += o[j]; }
        const float mean = red8(s) * (1.f / 64.f);
        float q = 0.f;
#pragma unroll
        for (int j = 0; j < 8; ++j) { o[j] -= mean; q += o[j] * o[j]; }
        const float rs = rsqrtf(red8(q) * (1.f / 64.f) + 64e-5f);
        float rr[8], kk[8], vv[8], af[8], ab[8], gg[8];
        unpack8(*((const uint4*)(slotp(P, 17) + (size_t)r * 512) + lane), rr); unpack8(*((const uint4*)(slotp(P, 18) + (size_t)r * 512) + lane), kk);
        unpack8(*((const uint4*)(slotp(P, 19) + (size_t)r * 512) + lane), vv); unpack8(*((const uint4*)(slotp(P, 24) + (size_t)r * 512) + lane), af);
        unpack8(*((const uint4*)(slotp(P, 13) + (size_t)r * 512) + lane), ab); unpack8(*((const uint4*)(slotp(P, 14) + (size_t)r * 512) + lane), gg);
        float bs = 0.f;
#pragma unroll
        for (int j = 0; j < 8; ++j) { const float kd = kk[j] * (2.f + (af[j] + ab[j] - 2.f) * ka[j]); bs += rr[j] * kd * rk[j]; }
        bs = red8(bs);
        float y[8];
#pragma unroll
        for (int j = 0; j < 8; ++j) y[j] = (o[j] * rs * lg[j] + lb[j] + bs * vv[j]) * gg[j];
        const uint4 yv = pack8(y);
        *((uint4*)(slotp(P, 5) + (size_t)r * 512) + lane) = yv;
        if (layer == 0 && g < 2 && r >= TREAL) {
            bf16_t* sd = GPTR(bf16_t, P.ws + WS_SIDE) + (size_t)g * 4 * 64 * 512 + (size_t)(r - TREAL) * 512;
#pragma unroll
            for (int k = 0; k < 3; ++k) *((uint4*)(sd + (size_t)k * 64 * 512) + lane) = *((const uint4*)(slotp(P, 2 + k) + (size_t)r * 512) + lane);
            *((uint4*)(sd + (size_t)3 * 64 * 512) + lane) = yv; }
    }
    if (layer == 0 && g == 2) {
        for (int m2 = gw; m2 < 128; m2 += ngw) { const bf16_t* sd = GPTR(const bf16_t, P.ws + WS_SIDE) + (size_t)(m2 >> 6) * 4 * 64 * 512 + (size_t)(m2 & 63) * 512;
#pragma unroll
            for (int k = 0; k < 4; ++k) *((uint4*)(slotp(P, 2 + k) + (size_t)(TG + m2) * 512) + lane) = *((const uint4*)(sd + (size_t)k * 64 * 512) + lane); }
    }
}
DEV void hg_gate(float x, float lbv, float& lg, float& kk) {
    const float e = __expf(-fabsf(x)); const float sp = 1.f / (1.f + e);
    const float s = x >= 0.f ? sp : e * sp, s1 = x >= 0.f ? e * sp : sp;
    const float f = fmaxf(lbv, 1e-20f) + (1.f - lbv) * s;
    lg = __logf(f); kk = (1.f - lbv) * s1; }
DEV float hg_lb(const Params& P, int layer, int dir, int col) {
    if (layer == 0) return 0.f;
    const float a = P.in[I_LBL][(dir * 2 + 0) * 512 + col], b = P.in[I_LBL][(dir * 2 + 1) * 512 + col];
    return 1.f / (1.f + __expf(a - b)); }
DEV int hg_row(int sl, int c, int j, bool& valid) { if (c == 0) { valid = j < 16; return TREAL + sl * 16 + j; } valid = true; return sl * 4096 + (c - 1) * 64 + j; }
DEV void hg_cumsum(float* Lb, float* Bt, float* Seg, int dir, int tid) {
    const int ch = tid & 127, seg = tid >> 7;
    float v[16];
#pragma unroll
    for (int i = 0; i < 16; ++i) v[i] = Lb[(seg * 16 + i) * 128 + ch];
    if (dir == 0) {
#pragma unroll
        for (int i = 1; i < 16; ++i) v[i] += v[i - 1];
        Seg[seg * 128 + ch] = v[15];
    } else {
#pragma unroll
        for (int i = 14; i >= 0; --i) v[i] += v[i + 1];
        Seg[seg * 128 + ch] = v[0];
    }
    __syncthreads();
    const float s0 = Seg[ch], s1 = Seg[128 + ch], s2 = Seg[256 + ch], s3 = Seg[384 + ch];
    float off;
    if (dir == 0) off = seg == 0 ? 0.f : seg == 1 ? s0 : seg == 2 ? s0 + s1 : s0 + s1 + s2;
    else off = seg == 3 ? 0.f : seg == 2 ? s3 : seg == 1 ? s3 + s2 : s3 + s2 + s1;
#pragma unroll
    for (int i = 0; i < 16; ++i) Lb[(seg * 16 + i) * 128 + ch] = v[i] + off;
    if (seg == 0) Bt[ch] = (s0 + s1) + (s2 + s3);
}
DEV void phase_hg1(const Params& P0, int layer, unsigned char* lds, int bid, int nb, int wv) {
    Params P = load_params(); P.ws = launder_ws(P.ws);
    float* Lb = (float*)lds; bf16_t* KlT = (bf16_t*)(lds + 32768); bf16_t* VT = (bf16_t*)(lds + 32768 + 18432); float* Bt = (float*)(lds + 69632); float* Seg = (float*)(lds + 70656);
    bf16_t* X = slotp(P, 17); float* DC = GPTR(float, P.ws + WS_DECAY);
    const int tid = launder_tid(wv), lane = tid & 63, w = __builtin_amdgcn_readfirstlane(tid >> 6), j = tid >> 3, c0 = (tid & 7) * 16, l15 = lane & 15, quad = lane >> 4;
    for (int unit = bid; unit < 32 * 65; unit += nb) {
        const int chain = unit / 65, c = unit - chain * 65, sl = chain >> 3, head = (chain >> 1) & 3, dir = chain & 1;
        bool valid; const int r = hg_row(sl, c, j, valid);
        float lg[16], kk[16]; uint4 vv[2] = {make_uint4(0, 0, 0, 0), make_uint4(0, 0, 0, 0)};
        if (valid) {
            float fr[16];
            const uint4* fp = (const uint4*)(slotp(P, 3 + dir) + (size_t)r * 512 + head * 128 + c0);
            unpack8(fp[0], fr); unpack8(fp[1], fr + 8);
            const uint4* vp = (const uint4*)(slotp(P, 5) + (size_t)r * 512 + head * 128 + c0); vv[0] = vp[0]; vv[1] = vp[1];
#pragma unroll
            for (int e = 0; e < 16; ++e) hg_gate(fr[e], hg_lb(P, layer, dir, head * 128 + c0 + e), lg[e], kk[e]);
        } else {
#pragma unroll
            for (int e = 0; e < 16; ++e) { lg[e] = 0.f; kk[e] = 0.f; } }
#pragma unroll
        for (int e = 0; e < 16; e += 4) *(f32x4*)(Lb + j * 128 + c0 + e) = (f32x4){lg[e], lg[e + 1], lg[e + 2], lg[e + 3]};
        __syncthreads();
        hg_cumsum(Lb, Bt, Seg, dir, tid);
        __syncthreads();
        float vf[16]; unpack8(vv[0], vf); unpack8(vv[1], vf + 8);
#pragma unroll
        for (int e = 0; e < 16; ++e) { const float kl = kk[e] * __expf(Bt[c0 + e] - Lb[j * 128 + c0 + e]);
            KlT[(c0 + e) * 72 + j] = (bf16_t)(pk2(kl, 0.f) & 0xffffu); VT[(c0 + e) * 72 + j] = (bf16_t)(__float_as_uint(vf[e]) >> 16); }
        if (tid < 128) DC[(size_t)(chain * 65 + c) * 128 + tid] = __expf(Bt[tid]);
        __syncthreads();
        f32x4 acc[8];
#pragma unroll
        for (int ct = 0; ct < 8; ++ct) acc[ct] = (f32x4){0.f, 0.f, 0.f, 0.f};
#pragma unroll
        for (int ks = 0; ks < 2; ++ks) { const bf16x8 a = *(const bf16x8*)(VT + (w * 16 + l15) * 72 + ks * 32 + quad * 8);
#pragma unroll
            for (int ct = 0; ct < 8; ++ct) { const bf16x8 b = *(const bf16x8*)(KlT + (ct * 16 + l15) * 72 + ks * 32 + quad * 8); acc[ct] = mfma16(b, a, acc[ct]); } }
        bf16_t* xo = X + (size_t)(chain * 65 + c) * 16384;
#pragma unroll
        for (int ct = 0; ct < 8; ++ct) *(uint2*)(xo + (w * 16 + l15) * 128 + ct * 16 + quad * 4) = make_uint2(pk2(acc[ct][0], acc[ct][1]), pk2(acc[ct][2], acc[ct][3]));
        __syncthreads();
    }
}
DEV void phase_hg2(const Params& P0, int bid, int nb, int wv) {
    Params P = load_params(); P.ws = launder_ws(P.ws);
    const int gtid = bid * 512 + launder_tid(wv), gth = nb * 512;
    uint2* X = (uint2*)slotp(P, 17); const f32x4* DC = GPTR(const f32x4, P.ws + WS_DECAY);
    for (int e = gtid; e < 32 * 4096; e += gth) {
        const int chain = e >> 12, e4 = e & 4095, dir = chain & 1;
        f32x4 S = (f32x4){0.f, 0.f, 0.f, 0.f};
#pragma unroll 5
        for (int step = 0; step < 65; ++step) { const int c = dir ? 64 - step : step;
            const size_t idx = (size_t)(chain * 65 + c) * 4096 + e4;
            const uint2 kvw = X[idx]; const f32x4 dc = DC[(size_t)(chain * 65 + c) * 32 + (e4 & 31)];
            const f32x4 kv = (f32x4){__uint_as_float(kvw.x << 16), __uint_as_float(kvw.x & 0xffff0000u), __uint_as_float(kvw.y << 16), __uint_as_float(kvw.y & 0xffff0000u)};
            X[idx] = make_uint2(pk2(S[0], S[1]), pk2(S[2], S[3])); S = dc * S + kv; }
    }
}
DEV void phase_hg3(const Params& P0, int layer, unsigned char* lds, int bid, int nb, int wv) {
    Params P = load_params(); P.ws = launder_ws(P.ws);
    float* Lb = (float*)lds; bf16_t* Qs = (bf16_t*)(lds + 32768); bf16_t* Ks = (bf16_t*)(lds + 50176); bf16_t* Am = (bf16_t*)(lds + 67584);
    bf16_t* VT = (bf16_t*)(lds + 76800); bf16_t* Sb = (bf16_t*)(lds + 95232); float* Bt = (float*)(lds + 130048); float* Seg = (float*)(lds + 132096); float* Ost = (float*)lds;
    const bf16_t* X = slotp(P, 17);
    const int tid = launder_tid(wv), lane = tid & 63, w = __builtin_amdgcn_readfirstlane(tid >> 6), j = tid >> 3, c0 = (tid & 7) * 16, l15 = lane & 15, quad = lane >> 4;
    const int tt = w >> 1, st0 = (w & 1) * 2, vt0 = (w & 1) * 4;
    const int cfirst = layer == 0 ? 0 : 1;
    const int ncb = 65 - cfirst;
    for (int unit = bid; unit < 16 * ncb; unit += nb) {
        const int sh = unit / ncb, c = unit - sh * ncb + cfirst, sl = sh >> 2, head = sh & 3;
        bool valid; const int r = hg_row(sl, c, j, valid);
        float q[16]; uint4 gv[2] = {make_uint4(0, 0, 0, 0), make_uint4(0, 0, 0, 0)};
        if (valid) {
            const uint4* qp = (const uint4*)(slotp(P, 2) + (size_t)r * 512 + head * 128 + c0); unpack8(qp[0], q); unpack8(qp[1], q + 8);
            const uint4* vp = (const uint4*)(slotp(P, 5) + (size_t)r * 512 + head * 128 + c0); float vf[16]; unpack8(vp[0], vf); unpack8(vp[1], vf + 8);
#pragma unroll
            for (int e = 0; e < 16; ++e) VT[(c0 + e) * 72 + j] = (bf16_t)(__float_as_uint(vf[e]) >> 16);
            const uint4* gp = (const uint4*)(slotp(P, 6) + (size_t)r * 512 + head * 128 + c0); gv[0] = gp[0]; gv[1] = gp[1];
        } else {
#pragma unroll
            for (int e = 0; e < 16; ++e) { q[e] = 0.f; VT[(c0 + e) * 72 + j] = 0; } }
        f32x4 accA[2], accO[4];
#pragma unroll
        for (int i = 0; i < 2; ++i) accA[i] = (f32x4){0.f, 0.f, 0.f, 0.f};
#pragma unroll
        for (int i = 0; i < 4; ++i) accO[i] = (f32x4){0.f, 0.f, 0.f, 0.f};
#pragma unroll 1
        for (int dir = 0; dir < 2; ++dir) {
            float lg[16], kk[16];
            if (valid) { float fr[16];
                const uint4* fp = (const uint4*)(slotp(P, 3 + dir) + (size_t)r * 512 + head * 128 + c0); unpack8(fp[0], fr); unpack8(fp[1], fr + 8);
#pragma unroll
                for (int e = 0; e < 16; ++e) hg_gate(fr[e], hg_lb(P, layer, dir, head * 128 + c0 + e), lg[e], kk[e]);
            } else {
#pragma unroll
                for (int e = 0; e < 16; ++e) { lg[e] = 0.f; kk[e] = 0.f; } }
#pragma unroll
            for (int e = 0; e < 16; e += 4) *(f32x4*)(Lb + j * 128 + c0 + e) = (f32x4){lg[e], lg[e + 1], lg[e + 2], lg[e + 3]};
            __syncthreads();
            hg_cumsum(Lb, Bt, Seg, dir, tid);
            __syncthreads();
            {
                float qs[16], ks[16];
#pragma unroll
                for (int e = 0; e < 16; ++e) { const float b = Lb[j * 128 + c0 + e], rf = Lb[32 * 128 + c0 + e]; qs[e] = q[e] * __expf(b - rf); ks[e] = kk[e] * __expf(rf - b); }
                *(uint4*)(Qs + j * 136 + c0) = pack8(qs); *(uint4*)(Qs + j * 136 + c0 + 8) = pack8(qs + 8);
                *(uint4*)(Ks + j * 136 + c0) = pack8(ks); *(uint4*)(Ks + j * 136 + c0 + 8) = pack8(ks + 8);
            }
            {
                const int chain = sl * 8 + head * 2 + dir; const uint4* xs = (const uint4*)(X + (size_t)(chain * 65 + c) * 16384 + (size_t)(tid >> 2) * 128 + (tid & 3) * 32);
#pragma unroll
                for (int i = 0; i < 4; ++i) *(uint4*)(Sb + (tid >> 2) * 136 + (tid & 3) * 32 + i * 8) = xs[i];
            }
            __syncthreads();
            {
                f32x4 t0 = (f32x4){0.f, 0.f, 0.f, 0.f}, t1 = t0;
#pragma unroll
                for (int k4 = 0; k4 < 4; ++k4) { const bf16x8 a = *(const bf16x8*)(Qs + (tt * 16 + l15) * 136 + k4 * 32 + quad * 8);
                    const bf16x8 b0 = *(const bf16x8*)(Ks + ((st0 + 0) * 16 + l15) * 136 + k4 * 32 + quad * 8); const bf16x8 b1 = *(const bf16x8*)(Ks + ((st0 + 1) * 16 + l15) * 136 + k4 * 32 + quad * 8);
                    t0 = mfma16(a, b0, t0); t1 = mfma16(a, b1, t1); }
#pragma unroll
                for (int jj = 0; jj < 4; ++jj) { const int t = tt * 16 + quad * 4 + jj, s0 = (st0 + 0) * 16 + l15, s1 = (st0 + 1) * 16 + l15;
                    const bool k0 = dir == 0 ? s0 <= t : s0 >= t, k1 = dir == 0 ? s1 <= t : s1 >= t;
                    accA[0][jj] += k0 ? t0[jj] : 0.f; accA[1][jj] += k1 ? t1[jj] : 0.f; }
            }
            __syncthreads();
            {   float qg[16];
#pragma unroll
                for (int e = 0; e < 16; ++e) qg[e] = q[e] * __expf(Lb[j * 128 + c0 + e]);
                *(uint4*)(Qs + j * 136 + c0) = pack8(qg); *(uint4*)(Qs + j * 136 + c0 + 8) = pack8(qg + 8); }
            __syncthreads();
#pragma unroll
            for (int k4 = 0; k4 < 4; ++k4) { const bf16x8 a = *(const bf16x8*)(Qs + (tt * 16 + l15) * 136 + k4 * 32 + quad * 8);
#pragma unroll
                for (int v4 = 0; v4 < 4; ++v4) { const bf16x8 b = *(const bf16x8*)(Sb + ((vt0 + v4) * 16 + l15) * 136 + k4 * 32 + quad * 8); accO[v4] = mfma16(a, b, accO[v4]); } }
            __syncthreads();
        }
#pragma unroll
        for (int s2 = 0; s2 < 2; ++s2)
#pragma unroll
            for (int jj = 0; jj < 4; ++jj) Am[(tt * 16 + quad * 4 + jj) * 72 + (st0 + s2) * 16 + l15] = (bf16_t)(pk2(accA[s2][jj], 0.f) & 0xffffu);
        __syncthreads();
#pragma unroll
        for (int ks = 0; ks < 2; ++ks) { const bf16x8 a = *(const bf16x8*)(Am + (tt * 16 + l15) * 72 + ks * 32 + quad * 8);
#pragma unroll
            for (int v4 = 0; v4 < 4; ++v4) { const bf16x8 b = *(const bf16x8*)(VT + ((vt0 + v4) * 16 + l15) * 72 + ks * 32 + quad * 8); accO[v4] = mfma16(a, b, accO[v4]); } }
#pragma unroll
        for (int v4 = 0; v4 < 4; ++v4)
#pragma unroll
            for (int jj = 0; jj < 4; ++jj) Ost[(tt * 16 + quad * 4 + jj) * 132 + (vt0 + v4) * 16 + l15] = accO[v4][jj];
        __syncthreads();
        {   float o[16], ss = 0.f;
#pragma unroll
            for (int e = 0; e < 16; ++e) { o[e] = Ost[j * 132 + c0 + e]; ss += o[e] * o[e]; }
            ss = red8(ss);
            const float rs = rsqrtf(ss * (1.f / 128.f) + 1e-6f);
            float gf[16]; unpack8(gv[0], gf); unpack8(gv[1], gf + 8);
#pragma unroll
            for (int e = 0; e < 16; ++e) { const float gg = gf[e]; o[e] = o[e] * rs * P.in[I_ONORM][layer * 512 + head * 128 + c0 + e] * (gg / (1.f + __expf(-gg))); }
            if (valid) { uint4* yp = (uint4*)(slotp(P, 2) + (size_t)r * 512 + head * 128 + c0); yp[0] = pack8(o); yp[1] = pack8(o + 8); }
        }
        __syncthreads();
    }
}
DEV void phase_vtrans(const Params& P0, unsigned char* lds, int bid, int nb, int wv) {
    Params P = load_params(); P.ws = launder_ws(P.ws);
    bf16_t* T = (bf16_t*)lds;
    const bf16_t* V = slotp(P, 12); bf16_t* VTg = slotp(P, 6);
    const int tid = launder_tid(wv);
    for (int unit = bid; unit < 4 * 65 * 8; unit += nb) {
        const int sl = unit / 520, rem = unit - sl * 520, pt = rem >> 3, vdt = rem & 7;
        { const int tok = tid >> 3, c8 = (tid & 7) * 8, p = pt * 64 + tok;
          uint4 v = make_uint4(0, 0, 0, 0);
          if (p < LSEQ) v = *(const uint4*)(V + (size_t)row_of(sl, p) * 512 + vdt * 64 + c8);
          *(uint4*)(T + tok * 72 + c8) = v; }
        __syncthreads();
        { const int vd = tid >> 3, t8 = (tid & 7) * 8;
          unsigned short e[8];
#pragma unroll
          for (int i = 0; i < 8; ++i) { const int pp = t8 + i; const int sp = (pp & ~12) | (((pp >> 2) & 1) << 3) | (((pp >> 3) & 1) << 2); e[i] = T[sp * 72 + vd]; }
          uint4 o; o.x = e[0] | ((unsigned)e[1] << 16); o.y = e[2] | ((unsigned)e[3] << 16); o.z = e[4] | ((unsigned)e[5] << 16); o.w = e[6] | ((unsigned)e[7] << 16);
          *(uint4*)(VTg + (size_t)(sl * 512 + vdt * 64 + vd) * 4160 + pt * 64 + t8) = o; }
        __syncthreads();
    }
}
DEV int crow(int r, int hi) { return (r & 3) + 8 * (r >> 2) + 4 * hi; }
typedef unsigned u32x4_t __attribute__((ext_vector_type(4)));
struct AttnStage { u32x4_t k0, k1, v0, v1; };
DEV void attn_stage_load(const Params& P, int sl, int head, int kt, int tid, AttnStage& st) {
    const bf16_t* Kg = slotp(P, 11); const bf16_t* VTg = slotp(P, 6);
    { const int ci = tid, krow = ci >> 4, kc = ci & 15; const int p = kt * 64 + krow; const int r = p < LSEQ ? row_of(sl, p) : 0; st.k0 = GLD16(Kg + (size_t)r * 512 + head * 128 + kc * 8); }
    { const int ci = tid + 512, krow = ci >> 4, kc = ci & 15; const int p = kt * 64 + krow; const int r = p < LSEQ ? row_of(sl, p) : 0; st.k1 = GLD16(Kg + (size_t)r * 512 + head * 128 + kc * 8); }
    { const int vi = tid, vrow = vi >> 3, vc = vi & 7; st.v0 = GLD16(VTg + (size_t)(sl * 512 + head * 128 + vrow) * 4160 + kt * 64 + vc * 8); }
    { const int vi = tid + 512, vrow = vi >> 3, vc = vi & 7; st.v1 = GLD16(VTg + (size_t)(sl * 512 + head * 128 + vrow) * 4160 + kt * 64 + vc * 8); }
}
DEV void attn_stage_store(unsigned char* buf, int tid, const AttnStage& st) {
    bf16_t* Kt = (bf16_t*)buf; bf16_t* Vt = (bf16_t*)(buf + 17408);
    { const int ci = tid, krow = ci >> 4, kc = ci & 15; *(u32x4_t*)(Kt + krow * 136 + kc * 8) = st.k0; }
    { const int ci = tid + 512, krow = ci >> 4, kc = ci & 15; *(u32x4_t*)(Kt + krow * 136 + kc * 8) = st.k1; }
    { const int vi = tid, vrow = vi >> 3, vc = vi & 7; *(u32x4_t*)(Vt + vrow * 72 + vc * 8) = st.v0; }
    { const int vi = tid + 512, vrow = vi >> 3, vc = vi & 7; *(u32x4_t*)(Vt + vrow * 72 + vc * 8) = st.v1; }
}
DEV void phase_attn(const Params& P0, int layer, unsigned char* lds, int ua, int ub, int uc, int wv) {
    Params P = load_params(); P.ws = launder_ws(P.ws);
    const int tid = launder_tid(wv), lane = tid & 63, w = __builtin_amdgcn_readfirstlane(tid >> 6), map = w >> 2, qsub = w & 3, qi = lane & 31, hi = lane >> 5;
    const float lam_init = layer == 0 ? 0.2f : 0.35550906759096934f;
    float lam;
    { const float* lp = P.in[I_LAM] + (size_t)layer * 256; float s1 = 0.f, s2 = 0.f;
      for (int i = 0; i < 64; ++i) { s1 += lp[i] * lp[64 + i]; s2 += lp[128 + i] * lp[192 + i]; }
      lam = __expf(s1) - __expf(s2) + lam_init; }
    float* Ex = (float*)lds;
#pragma unroll 1
    for (int ui = 0; ui < 3; ++ui) {
        int unit = ui == 0 ? ua : (ui == 1 ? ub : uc);
        if (unit < 0) continue;
        const int ucode = unit; unit = ucode & 4095; const int hmode = ucode >> 12;
        const int sh = unit < 512 ? (unit >> 5) : unit - 512, qb = unit < 512 ? (unit & 31) : 32, sl = sh >> 2, head = sh & 3;
        const int qrow0 = qb < 32 ? sl * 4096 + qb * 128 : TREAL + sl * 16; const int nvalid = qb < 32 ? 128 : 16;
        const bool active = (qsub * 32 < nvalid) && (hmode == 0 || hmode >= 3 || (qsub >> 1) == hmode - 1);
        bf16x8 Qf[4];
        { const bf16_t* qp = slotp(P, 10) + (size_t)(qrow0 + qsub * 32 + qi) * 512 + head * 128 + map * 64 + hi * 8;
#pragma unroll
          for (int ds = 0; ds < 4; ++ds) Qf[ds] = __builtin_bit_cast(bf16x8, GLD16(qp + ds * 16)); }
        AttnStage st;
        const int kt0 = hmode == 4 ? 33 : 0, kt1 = hmode == 3 ? 33 : 65;
        attn_stage_load(P, sl, head, kt0, tid, st); attn_stage_store(lds + (kt0 & 1) * 35840, tid, st); attn_stage_load(P, sl, head, kt0 + 1, tid, st);
        __syncthreads();
        f32x16 O[4];
#pragma unroll
        for (int v = 0; v < 4; ++v)
#pragma unroll
            for (int r = 0; r < 16; ++r) O[v][r] = 0.f;
        float m_run = -INFINITY, l_run = 0.f;
#pragma unroll 1
        for (int kt = kt0; kt < kt1; ++kt) {
            if (kt + 1 < kt1) attn_stage_store(lds + ((kt + 1) & 1) * 35840, tid, st);
            if (kt + 2 < kt1) attn_stage_load(P, sl, head, kt + 2, tid, st);
            const unsigned char* buf = lds + (kt & 1) * 35840;
            const bf16_t* Kb = (const bf16_t*)buf; const bf16_t* Vb = (const bf16_t*)(buf + 17408);
            if (active) {
            f32x16 S0, S1;
#pragma unroll
            for (int r = 0; r < 16; ++r) { S0[r] = 0.f; S1[r] = 0.f; }
#pragma unroll
            for (int ds = 0; ds < 4; ++ds) {
                const bf16x8 a0 = *(const bf16x8*)(Kb + qi * 136 + map * 64 + ds * 16 + hi * 8);
                const bf16x8 a1 = *(const bf16x8*)(Kb + (32 + qi) * 136 + map * 64 + ds * 16 + hi * 8);
                S0 = mfma32(a0, Qf[ds], S0); S1 = mfma32(a1, Qf[ds], S1); }
            if (kt == 64) {
#pragma unroll
                for (int r = 0; r < 16; ++r) { if (crow(r, hi) >= 16) S0[r] = -INFINITY; S1[r] = -INFINITY; } }
            float mx = -INFINITY;
#pragma unroll
            for (int r = 0; r < 16; ++r) mx = fmaxf(mx, fmaxf(S0[r], S1[r]));
            { const auto sw = __builtin_amdgcn_permlane32_swap(__float_as_uint(mx), __float_as_uint(mx), false, false); mx = fmaxf(__uint_as_float(sw[0]), __uint_as_float(sw[1])); }
            const float m_new = fmaxf(m_run, mx); const float alpha = __builtin_amdgcn_exp2f(m_run - m_new); m_run = m_new;
            float ps = 0.f;
#pragma unroll
            for (int r = 0; r < 16; ++r) { S0[r] = __builtin_amdgcn_exp2f(S0[r] - m_new); S1[r] = __builtin_amdgcn_exp2f(S1[r] - m_new); ps += S0[r] + S1[r]; }
            l_run = l_run * alpha + ps;
            if (__builtin_amdgcn_ballot_w64(alpha != 1.0f) != 0ull) {
#pragma unroll
                for (int v = 0; v < 4; ++v)
#pragma unroll
                    for (int r = 0; r < 16; ++r) O[v][r] *= alpha; }
            bf16x8 pf[2][2];
#pragma unroll
            for (int half = 0; half < 2; ++half) {
                uint4 a, b;
                a.x = pk2(S0[half * 8 + 0], S0[half * 8 + 1]); a.y = pk2(S0[half * 8 + 2], S0[half * 8 + 3]); a.z = pk2(S0[half * 8 + 4], S0[half * 8 + 5]); a.w = pk2(S0[half * 8 + 6], S0[half * 8 + 7]);
                b.x = pk2(S1[half * 8 + 0], S1[half * 8 + 1]); b.y = pk2(S1[half * 8 + 2], S1[half * 8 + 3]); b.z = pk2(S1[half * 8 + 4], S1[half * 8 + 5]); b.w = pk2(S1[half * 8 + 6], S1[half * 8 + 7]);
                pf[0][half] = __builtin_bit_cast(bf16x8, a); pf[1][half] = __builtin_bit_cast(bf16x8, b); }
#pragma unroll
            for (int v = 0; v < 4; ++v)
#pragma unroll
                for (int sub = 0; sub < 2; ++sub)
#pragma unroll
                    for (int half = 0; half < 2; ++half) {
                        const bf16x8 av = *(const bf16x8*)(Vb + (v * 32 + qi) * 72 + sub * 32 + half * 16 + hi * 8);
                        O[v] = mfma32(av, pf[sub][half], O[v]); }
            }
            __syncthreads();
        }
        const float l_tot = l_run + __shfl_xor(l_run, 32); const float inv = 1.0f / l_tot;
        if (hmode >= 3) {
            float* pt = (float*)slotp(P, 22) + ((size_t)(((unit - 448) * 2 + (hmode - 3)) * 2 + map) * 128 + qsub * 32 + qi) * 130;
#pragma unroll
            for (int v = 0; v < 4; ++v)
#pragma unroll
                for (int rg = 0; rg < 4; ++rg) { float* d = pt + v * 32 + 8 * rg + 4 * hi; d[0] = O[v][rg * 4 + 0]; d[1] = O[v][rg * 4 + 1]; d[2] = O[v][rg * 4 + 2]; d[3] = O[v][rg * 4 + 3]; }
            if (hi == 0) { pt[128] = m_run; pt[129] = l_tot; }
            __syncthreads();
            continue; }
        if (map == 1) {
#pragma unroll
            for (int v = 0; v < 4; ++v)
#pragma unroll
                for (int r = 0; r < 16; ++r) Ex[(qsub * 32 + qi) * 132 + v * 32 + crow(r, hi)] = O[v][r] * inv; }
        __syncthreads();
        if (map == 0) {
            float ss = 0.f;
#pragma unroll
            for (int v = 0; v < 4; ++v)
#pragma unroll
                for (int r = 0; r < 16; ++r) { const float o = O[v][r] * inv - lam * Ex[(qsub * 32 + qi) * 132 + v * 32 + crow(r, hi)]; O[v][r] = o; ss += o * o; }
            ss += __shfl_xor(ss, 32);
            const float rs = rsqrtf(ss * (1.f / 128.f) + 1e-5f) * (1.f - lam_init);
            if (active && qsub * 32 + qi < nvalid) {
                bf16_t* yp = slotp(P, 4) + (size_t)(qrow0 + qsub * 32 + qi) * 512 + head * 128;
#pragma unroll
                for (int v = 0; v < 4; ++v)
#pragma unroll
                    for (int rg = 0; rg < 4; ++rg) { const int vd0 = v * 32 + 8 * rg + 4 * hi; const f32x4 gg = *(const f32x4*)(P.in[I_SUBLN] + layer * 128 + vd0);
                        uint2 o; o.x = pk2(O[v][rg * 4 + 0] * rs * gg[0], O[v][rg * 4 + 1] * rs * gg[1]); o.y = pk2(O[v][rg * 4 + 2] * rs * gg[2], O[v][rg * 4 + 3] * rs * gg[3]);
                        *(uint2*)(yp + vd0) = o; } }
        }
        __syncthreads();
    }
}
DEV float dpp_f(float x, const int ctrl) { return x; }
template <int CTRL> DEV float dppmov(float x) { return __builtin_bit_cast(float, __builtin_amdgcn_update_dpp(0, __builtin_bit_cast(int, x), CTRL, 0xf, 0xf, true)); }
DEV float sum16(float x) { x += dppmov<0xB1>(x); x += dppmov<0x4E>(x); x += dppmov<0x141>(x); x += dppmov<0x140>(x); return x; }
constexpr int RW_CH = 16, RW_BUF_F = 5120 + 256 + 4096, RW_BUFB = RW_BUF_F * 4;
struct RwRegs { u32x4_t r, k, kk, e, a, v; };
DEV void unpack8v(const u32x4_t w, float* f) { unpack8(make_uint4(w.x, w.y, w.z, w.w), f); }
DEV void rw_stage_load(const Params& P, RwRegs& g, int sl, int head, int dir, int qr, int ck, int t) {
    if (t < 128) { const int step = t >> 3, ch8 = (t & 7) * 8, sidx = ck * RW_CH + step;
        if (sidx < LSEQ) { const int p = dir ? LSEQ - 1 - sidx : sidx; const size_t ro = (size_t)row_of(sl, p) * 512 + head * 64 + ch8;
            g.r = *(const u32x4_t*)(slotp(P, 17) + ro); g.k = *(const u32x4_t*)(slotp(P, 18) + ro); g.kk = *(const u32x4_t*)(slotp(P, 20) + ro);
            g.e = *(const u32x4_t*)(slotp(P, 22 + dir) + ro); g.a = *(const u32x4_t*)(slotp(P, dir == 0 ? 24 : 13) + ro); } }
    if (t < 32) { const int tt = t, s2 = tt >> 1, r8 = (tt & 1) * 8, si2 = ck * RW_CH + s2;
        if (si2 < LSEQ) { const int p2 = dir ? LSEQ - 1 - si2 : si2; g.v = *(const u32x4_t*)(slotp(P, 19) + (size_t)row_of(sl, p2) * 512 + head * 64 + qr * 16 + r8); } }
}
DEV void rw_stage_write(const Params& P, int layer, unsigned char* buf, const RwRegs& g, int head, int ck, int t) {
    float* Rr = (float*)buf; float* Ww = Rr + 1024; float* Kd = Ww + 1024; float* Kk = Kd + 1024; float* Bb = Kk + 1024; float* Vs = Bb + 1024;
    if (t < 128) { const int step = t >> 3, ch8 = (t & 7) * 8, sidx = ck * RW_CH + step;
        if (sidx < LSEQ) {
            float r[8], k[8], kk[8], e[8], a[8];
            unpack8v(g.r, r); unpack8v(g.k, k); unpack8v(g.kk, kk); unpack8v(g.e, e); unpack8v(g.a, a);
            float ww[8], kd[8], bb[8];
#pragma unroll
            for (int j = 0; j < 8; ++j) { ww[j] = __expf(-e[j]); kd[j] = k[j] * (1.f + (a[j] - 1.f) * P.in[I_KA][layer * 512 + head * 64 + ch8 + j]); bb[j] = kk[j] * a[j]; }
            const int o = step * 64 + ch8;
            *(f32x4*)(Rr + o) = (f32x4){r[0], r[1], r[2], r[3]}; *(f32x4*)(Rr + o + 4) = (f32x4){r[4], r[5], r[6], r[7]};
            *(f32x4*)(Ww + o) = (f32x4){ww[0], ww[1], ww[2], ww[3]}; *(f32x4*)(Ww + o + 4) = (f32x4){ww[4], ww[5], ww[6], ww[7]};
            *(f32x4*)(Kd + o) = (f32x4){kd[0], kd[1], kd[2], kd[3]}; *(f32x4*)(Kd + o + 4) = (f32x4){kd[4], kd[5], kd[6], kd[7]};
            *(f32x4*)(Kk + o) = (f32x4){kk[0], kk[1], kk[2], kk[3]}; *(f32x4*)(Kk + o + 4) = (f32x4){kk[4], kk[5], kk[6], kk[7]};
            *(f32x4*)(Bb + o) = (f32x4){bb[0], bb[1], bb[2], bb[3]}; *(f32x4*)(Bb + o + 4) = (f32x4){bb[4], bb[5], bb[6], bb[7]};
        } }
    if (t < 32) { const int tt = t, s2 = tt >> 1, r8 = (tt & 1) * 8, si2 = ck * RW_CH + s2;
        if (si2 < LSEQ) { float v[8]; unpack8v(g.v, v);
            *(f32x4*)(Vs + s2 * 16 + r8) = (f32x4){v[0], v[1], v[2], v[3]}; *(f32x4*)(Vs + s2 * 16 + r8 + 4) = (f32x4){v[4], v[5], v[6], v[7]}; } }
}
DEV void rw_flush(const Params& P, const unsigned char* buf, int sl, int head, int dir, int qr, int ck, int t) {
    if (t >= 160 && t < 192) { const float* Op = (const float*)buf + 5376; const int tt = t - 160, s2 = tt >> 1, r8 = (tt & 1) * 8, sidx = ck * RW_CH + s2;
        if (sidx < LSEQ) { const int p = dir ? LSEQ - 1 - sidx : sidx; float o[8];
#pragma unroll
            for (int j = 0; j < 8; ++j) { const int row = r8 + j; const f32x4* q = (const f32x4*)(Op + s2 * 256 + (row >> 2) * 64 + (row & 3) * 16);
                const f32x4 a = q[0], b = q[1], c = q[2], d = q[3];
                o[j] = ((a[0] + a[1]) + (a[2] + a[3])) + ((b[0] + b[1]) + (b[2] + b[3])) + (((c[0] + c[1]) + (c[2] + c[3])) + ((d[0] + d[1]) + (d[2] + d[3]))); }
            *(uint4*)(slotp(P, 15 + dir) + (size_t)row_of(sl, p) * 512 + head * 64 + qr * 16 + r8) = pack8(o); } }
}
DEV void phase_rw_scan(const Params& P0, int layer, unsigned char* lds, int bid, int nb, int wv) {
    Params P = load_params(); P.ws = launder_ws(P.ws);
    const int tid = launder_tid(wv), lane = tid & 63, w = __builtin_amdgcn_readfirstlane(tid >> 6), li = lane & 15, rl = (w & 3) * 4 + (lane >> 4);
    constexpr int NCK = (LSEQ + RW_CH - 1) / RW_CH;
    typedef float f32x2 __attribute__((ext_vector_type(2)));
    for (int unit = bid; unit < 256; unit += nb) {
        const int sl = unit >> 6, head = (unit >> 3) & 7, dir = (unit >> 2) & 1, qr = unit & 3;
        f32x2 SA = (f32x2){0.f, 0.f}, SB = (f32x2){0.f, 0.f};
        RwRegs g; g.r = g.k = g.kk = g.e = g.a = g.v = (u32x4_t){0u, 0u, 0u, 0u};
        if (w >= 4) { rw_stage_load(P, g, sl, head, dir, qr, 0, tid - 256); rw_stage_write(P, layer, lds, g, head, 0, tid - 256); rw_stage_load(P, g, sl, head, dir, qr, 1, tid - 256); }
        __syncthreads();
#pragma unroll 1
        for (int ck = 0; ck < NCK; ++ck) {
            unsigned char* buf = lds + (ck & 1) * RW_BUFB;
            if (w >= 4) {
                if (ck + 1 < NCK) rw_stage_write(P, layer, lds + ((ck + 1) & 1) * RW_BUFB, g, head, ck + 1, tid - 256);
                if (ck + 2 < NCK) rw_stage_load(P, g, sl, head, dir, qr, ck + 2, tid - 256);
                if (ck > 0) rw_flush(P, lds + ((ck - 1) & 1) * RW_BUFB, sl, head, dir, qr, ck - 1, tid - 256);
            } else {
                const float* Rr = (const float*)buf + li * 4; const float* Vs = (const float*)buf + 5120 + rl; float* Op = (float*)buf + 5376 + w * 64 + lane;
                const int ns = (LSEQ - ck * RW_CH) < RW_CH ? (LSEQ - ck * RW_CH) : RW_CH;
                f32x4 rr = *(const f32x4*)(Rr), ww = *(const f32x4*)(Rr + 1024), kd = *(const f32x4*)(Rr + 2048), kk = *(const f32x4*)(Rr + 3072), bb = *(const f32x4*)(Rr + 4096); float vv = Vs[0];
#pragma unroll 2
                for (int i = 0; i < ns; ++i) {
                    const int in = i < RW_CH - 1 ? i + 1 : RW_CH - 1;
                    const f32x4 rr_n = *(const f32x4*)(Rr + in * 64), ww_n = *(const f32x4*)(Rr + 1024 + in * 64), kd_n = *(const f32x4*)(Rr + 2048 + in * 64);
                    const f32x4 kk_n = *(const f32x4*)(Rr + 3072 + in * 64), bb_n = *(const f32x4*)(Rr + 4096 + in * 64); const float vv_n = Vs[in * 16];
                    f32x2 p = SA * (f32x2){kk[0], kk[1]}; p = __builtin_elementwise_fma(SB, (f32x2){kk[2], kk[3]}, p);
                    const f32x2 vv2 = (f32x2){vv, vv};
                    const f32x2 ta = vv2 * (f32x2){kd[0], kd[1]}, tb = vv2 * (f32x2){kd[2], kd[3]};
                    const float sa = -sum16(p[0] + p[1]);
                    const f32x2 sa2 = (f32x2){sa, sa};
                    SA = __builtin_elementwise_fma(SA, (f32x2){ww[0], ww[1]}, __builtin_elementwise_fma(sa2, (f32x2){bb[0], bb[1]}, ta));
                    SB = __builtin_elementwise_fma(SB, (f32x2){ww[2], ww[3]}, __builtin_elementwise_fma(sa2, (f32x2){bb[2], bb[3]}, tb));
                    f32x2 q = SA * (f32x2){rr[0], rr[1]}; q = __builtin_elementwise_fma(SB, (f32x2){rr[2], rr[3]}, q);
                    Op[i * 256] = q[0] + q[1];
                    rr = rr_n; ww = ww_n; kd = kd_n; kk = kk_n; bb = bb_n; vv = vv_n;
                }
            }
            __syncthreads();
        }
        if (w >= 4) rw_flush(P, lds + ((NCK - 1) & 1) * RW_BUFB, sl, head, dir, qr, NCK - 1, tid - 256);
        __syncthreads();
    }
}
static_assert(LSEQ == 257 * 16, "chunked RWKV assumes whole 16-step chunks");
constexpr int RWC_REC = 8960, RWC_NCK = 257;
DEV unsigned char* rwc_rec(const Params& P, int dir, int idx) {
    const int gi = dir * 8224 + idx;
    if (gi < 1901) return (unsigned char*)slotp(P, 5) + (size_t)gi * RWC_REC;
    if (gi < 7606) return (unsigned char*)slotp(P, 7) + (size_t)(gi - 1901) * RWC_REC;
    if (gi < 9507) return (unsigned char*)slotp(P, 12) + (size_t)(gi - 7606) * RWC_REC;
    if (gi < 11408) return (unsigned char*)slotp(P, 21) + (size_t)(gi - 9507) * RWC_REC;
    return GPTR(unsigned char, P.ws + WS_SLOTS + 25 * SLOT_B + (size_t)(gi - 11408) * RWC_REC); }
DEV int rwc_slot(int c) { return (((c >> 5) * 4 + ((c >> 2) & 3)) * 8) + ((c >> 4) & 1) * 4 + (c & 3); }
DEV void phase_rwc_pre(const Params& P0, int layer, unsigned char* lds, int bid, int nb, int wv) {
    Params P = load_params(); P.ws = launder_ws(P.ws);
    const int tid = launder_tid(wv), lane = tid & 63, w = __builtin_amdgcn_readfirstlane(tid >> 6), l15 = lane & 15, quad = lane >> 4;
    unsigned char* wl = lds + w * 15616;
    bf16_t* Bt = (bf16_t*)wl; bf16_t* Dt = Bt + 16 * 72; bf16_t* Ak = Dt + 16 * 72; bf16_t* Rt = Ak + 16 * 72;
    float* Mb = (float*)(wl + 9216); float* Md = Mb + 256; float* Gb = Md + 256; float* Gd = Gb + 256; float* Tm = Gd + 256; float* Nm = Tm + 256;
    const float ka = P.in[I_KA][layer * 512 + 0];  (void)ka;
    for (int unit2 = bid * 8 + w; unit2 < 2 * 32 * RWC_NCK; unit2 += nb * 8) {
        const int dir = unit2 >= 32 * RWC_NCK ? 1 : 0; const int unit = unit2 - dir * 32 * RWC_NCK;
        const int sh = unit / RWC_NCK, ck = unit - sh * RWC_NCK, sl = sh >> 3, head = sh & 7;
        const float kac = P.in[I_KA][layer * 512 + head * 64 + lane];
        float ak[16], bt[16], dt[16], rt[16];
        typedef const __attribute__((address_space(1))) unsigned short* gu16p;
        const gu16p pR = (gu16p)slotp(P, 17), pK = (gu16p)slotp(P, 18), pKK = (gu16p)slotp(P, 20), pE = (gu16p)slotp(P, 22 + dir), pA = (gu16p)slotp(P, dir == 0 ? 24 : 13);
        unsigned short r16[16], k16[16], q16[16], e16[16], a16[16];
#pragma unroll
        for (int t = 0; t < 16; ++t) {
            const int sidx = ck * 16 + t;
            const int p = dir ? LSEQ - 1 - sidx : sidx; const size_t ro = (size_t)row_of(sl, p) * 512 + head * 64 + lane;
            r16[t] = pR[ro]; k16[t] = pK[ro]; q16[t] = pKK[ro]; e16[t] = pE[ro]; a16[t] = pA[ro]; }
        float g = 1.f;
#pragma unroll
        for (int t = 0; t < 16; ++t) {
            const float r = bf2f(r16[t]), k = bf2f(k16[t]), kk = bf2f(q16[t]), e = bf2f(e16[t]), a = bf2f(a16[t]);
            const float wdec = __expf(-e), kd = k * (1.f + (a - 1.f) * kac), b = kk * a;
            ak[t] = g * kk; g *= wdec; const float gi = __builtin_amdgcn_rcpf(g); bt[t] = b * gi; dt[t] = kd * gi; rt[t] = g * r;
        }
        const float gC = g;
#pragma unroll
        for (int t = 0; t < 16; ++t) { Bt[t * 72 + lane] = (bf16_t)(pk2(bt[t], 0.f) & 0xffffu); Dt[t * 72 + lane] = (bf16_t)(pk2(dt[t], 0.f) & 0xffffu);
            Ak[t * 72 + lane] = (bf16_t)(pk2(ak[t], 0.f) & 0xffffu); Rt[t * 72 + lane] = (bf16_t)(pk2(rt[t], 0.f) & 0xffffu); }
        asm volatile("s_waitcnt lgkmcnt(0)" ::: "memory");
        {
            f32x4 mb = (f32x4){0.f, 0.f, 0.f, 0.f}, md = mb, gb = mb, gd = mb;
#pragma unroll
            for (int ks = 0; ks < 2; ++ks) {
                const bf16x8 fb = *(const bf16x8*)(Bt + l15 * 72 + ks * 32 + quad * 8), fd = *(const bf16x8*)(Dt + l15 * 72 + ks * 32 + quad * 8);
                const bf16x8 fa = *(const bf16x8*)(Ak + l15 * 72 + ks * 32 + quad * 8), fr = *(const bf16x8*)(Rt + l15 * 72 + ks * 32 + quad * 8);
                mb = mfma16(fb, fa, mb); md = mfma16(fd, fa, md); gb = mfma16(fb, fr, gb); gd = mfma16(fd, fr, gd); }
#pragma unroll
            for (int jj = 0; jj < 4; ++jj) { const int j = quad * 4 + jj, t = l15;
                Mb[j * 16 + t] = j < t ? mb[jj] : 0.f; Md[j * 16 + t] = j < t ? md[jj] : 0.f; Gb[j * 16 + t] = j <= t ? gb[jj] : 0.f; Gd[j * 16 + t] = j <= t ? gd[jj] : 0.f; }
        }
        asm volatile("s_waitcnt lgkmcnt(0)" ::: "memory");
        {
            float tc[16];
#pragma unroll
            for (int i = 15; i >= 0; --i) { float acc = (i == l15) ? 1.f : 0.f;
                float mr[16];
#pragma unroll
                for (int q4 = (i + 1) >> 2; q4 < 4; ++q4) { const f32x4 m4 = *(const f32x4*)(Mb + i * 16 + q4 * 4); mr[q4 * 4] = m4[0]; mr[q4 * 4 + 1] = m4[1]; mr[q4 * 4 + 2] = m4[2]; mr[q4 * 4 + 3] = m4[3]; }
#pragma unroll
                for (int l = i + 1; l < 16; ++l) acc -= mr[l] * tc[l];
                tc[i] = acc; }
            if (quad == 0) {
#pragma unroll
                for (int i = 0; i < 16; ++i) Tm[i * 16 + l15] = tc[i]; }
        }
        asm volatile("s_waitcnt lgkmcnt(0)" ::: "memory");
        {
            float n4[4] = {0.f, 0.f, 0.f, 0.f};
#pragma unroll
            for (int l = 0; l < 16; ++l) { const float tv = Tm[l * 16 + l15];
#pragma unroll
                for (int jj = 0; jj < 4; ++jj) n4[jj] += Md[(quad * 4 + jj) * 16 + l] * tv; }
#pragma unroll
            for (int jj = 0; jj < 4; ++jj) Nm[(quad * 4 + jj) * 16 + l15] = n4[jj];
        }
        asm volatile("s_waitcnt lgkmcnt(0)" ::: "memory");
        unsigned char* rec = rwc_rec(P, dir, unit);
        {
            float q4[4];
#pragma unroll
            for (int jj = 0; jj < 4; ++jj) q4[jj] = Gd[(quad * 4 + jj) * 16 + l15];
#pragma unroll
            for (int l = 0; l < 16; ++l) { const float gv = Gb[l * 16 + l15];
#pragma unroll
                for (int jj = 0; jj < 4; ++jj) q4[jj] -= Nm[(quad * 4 + jj) * 16 + l] * gv; }
            *(uint2*)((bf16_t*)(rec + 8192) + l15 * 16 + quad * 4) = make_uint2(pk2(q4[0], q4[1]), pk2(q4[2], q4[3]));
        }
        {
            float ap[16], rp[16], ps[16];
#pragma unroll
            for (int t = 0; t < 16; ++t) { ap[t] = 0.f; rp[t] = rt[t]; }
#pragma unroll
            for (int j = 0; j < 16; ++j) {
#pragma unroll
                for (int q4 = j >> 2; q4 < 4; ++q4) { const f32x4 r4 = *(const f32x4*)(Tm + j * 16 + q4 * 4);
#pragma unroll
                    for (int e = 0; e < 4; ++e) ap[q4 * 4 + e] += ak[j] * r4[e]; } }
#pragma unroll
            for (int j = 0; j < 16; ++j) {
#pragma unroll
                for (int q4 = j >> 2; q4 < 4; ++q4) { const f32x4 r4 = *(const f32x4*)(Gb + j * 16 + q4 * 4);
#pragma unroll
                    for (int e = 0; e < 4; ++e) rp[q4 * 4 + e] -= ap[j] * r4[e]; } }
#pragma unroll
            for (int j = 0; j < 16; ++j) { float acc = dt[j];
#pragma unroll
                for (int q4 = j >> 2; q4 < 4; ++q4) { const f32x4 r4 = *(const f32x4*)(Nm + j * 16 + q4 * 4);
#pragma unroll
                    for (int e = 0; e < 4; ++e) acc -= r4[e] * bt[q4 * 4 + e]; }
                ps[j] = acc * gC; }
            bf16_t* AP = (bf16_t*)rec; bf16_t* RP = AP + 1024; const int so = rwc_slot(lane);
#pragma unroll
            for (int t = 0; t < 16; ++t) { AP[t * 64 + so] = (bf16_t)(pk2(ap[t], 0.f) & 0xffffu); RP[t * 64 + so] = (bf16_t)(pk2(rp[t], 0.f) & 0xffffu); }
            float nb_[16];
#pragma unroll
            for (int t = 0; t < 16; ++t) nb_[t] = -bt[t] * gC;
            uint4* BP = (uint4*)(rec + 4096) + lane * 2; BP[0] = pack8(nb_); BP[1] = pack8(nb_ + 8);
            uint4* PP = (uint4*)(rec + 6144) + lane * 2; PP[0] = pack8(ps); PP[1] = pack8(ps + 8);
            ((float*)(rec + 8704))[lane] = gC;
        }
        asm volatile("s_waitcnt lgkmcnt(0)" ::: "memory");
    }
}
struct RwcRegs { u32x4_t a, b, c, v; };
DEV void rwc_load(const Params& P, RwcRegs& g, int sh, int dir, int ck, int t) {
    const unsigned char* rec = rwc_rec(P, dir, sh * RWC_NCK + ck);
    g.a = GLD16(rec + (size_t)t * 16); g.b = GLD16(rec + (size_t)(t + 256) * 16);
    if (t < 48) g.c = GLD16(rec + (size_t)(t + 512) * 16);
    if (t < 128) { const int j = t >> 3, r8 = (t & 7) * 8, sidx = ck * 16 + j; const int sc = sidx < LSEQ ? sidx : LSEQ - 1; const int p = dir ? LSEQ - 1 - sc : sc;
        g.v = GLD16(slotp(P, 19) + (size_t)row_of(sh >> 3, p) * 512 + (sh & 7) * 64 + r8); if (sidx >= LSEQ) g.v = (u32x4_t){0u, 0u, 0u, 0u}; }
}
DEV void rwc_store(unsigned char* buf, const RwcRegs& g, int t) {
    *(u32x4_t*)(buf + t * 16) = g.a; *(u32x4_t*)(buf + (t + 256) * 16) = g.b;
    if (t < 48) *(u32x4_t*)(buf + (t + 512) * 16) = g.c;
    if (t < 128) { bf16_t* VsT = (bf16_t*)(buf + RWC_REC); const int j = t >> 3, r8 = (t & 7) * 8;
        VsT[(r8 + 0) * 16 + j] = (bf16_t)(g.v.x & 0xffffu); VsT[(r8 + 1) * 16 + j] = (bf16_t)(g.v.x >> 16); VsT[(r8 + 2) * 16 + j] = (bf16_t)(g.v.y & 0xffffu); VsT[(r8 + 3) * 16 + j] = (bf16_t)(g.v.y >> 16);
        VsT[(r8 + 4) * 16 + j] = (bf16_t)(g.v.z & 0xffffu); VsT[(r8 + 5) * 16 + j] = (bf16_t)(g.v.z >> 16); VsT[(r8 + 6) * 16 + j] = (bf16_t)(g.v.w & 0xffffu); VsT[(r8 + 7) * 16 + j] = (bf16_t)(g.v.w >> 16); }
}
DEV void phase_rwc_scan(const Params& P0, unsigned char* lds, int bid, int nb, int wv) {
    Params P = load_params(); P.ws = launder_ws(P.ws);
    const int tid = launder_tid(wv), lane = tid & 63, w = __builtin_amdgcn_readfirstlane(tid >> 6), l15 = lane & 15, quad = lane >> 4;
    constexpr int BUFB = RWC_REC + 2048;
    for (int u2 = bid; u2 < 64; u2 += nb) {
        const int sh = u2 & 31, dir = u2 >> 5; const int sl = sh >> 3, head = sh & 7;
        f32x4 ST[4];
#pragma unroll
        for (int ct = 0; ct < 4; ++ct) ST[ct] = (f32x4){0.f, 0.f, 0.f, 0.f};
        RwcRegs g; g.a = g.b = g.c = g.v = (u32x4_t){0u, 0u, 0u, 0u};
        if (w >= 4) { rwc_load(P, g, sh, dir, 0, tid - 256); rwc_store(lds, g, tid - 256); rwc_load(P, g, sh, dir, 1, tid - 256); }
        __syncthreads();
#pragma unroll 1
        for (int ck = 0; ck < RWC_NCK; ++ck) {
            const unsigned char* buf = lds + (ck & 1) * BUFB;
            if (w >= 4) {
                if (ck + 1 < RWC_NCK) rwc_store(lds + ((ck + 1) & 1) * BUFB, g, tid - 256);
                if (ck + 2 < RWC_NCK) rwc_load(P, g, sh, dir, ck + 2, tid - 256);
            } else {
                const bf16_t* AP = (const bf16_t*)buf; const bf16_t* RP = AP + 1024; const bf16_t* BP = (const bf16_t*)(buf + 4096); const bf16_t* PP = (const bf16_t*)(buf + 6144);
                const bf16_t* QP = (const bf16_t*)(buf + 8192); const float* GC = (const float*)(buf + 8704); const bf16_t* VsT = (const bf16_t*)(buf + RWC_REC);
                const u32x4_t z4 = (u32x4_t){0u, 0u, 0u, 0u};
                u32x4_t sb0, sb1;
                sb0.x = pk2(ST[0][0], ST[0][1]); sb0.y = pk2(ST[0][2], ST[0][3]); sb0.z = pk2(ST[1][0], ST[1][1]); sb0.w = pk2(ST[1][2], ST[1][3]);
                sb1.x = pk2(ST[2][0], ST[2][1]); sb1.y = pk2(ST[2][2], ST[2][3]); sb1.z = pk2(ST[3][0], ST[3][1]); sb1.w = pk2(ST[3][2], ST[3][3]);
                const bf16x8 SB0 = __builtin_bit_cast(bf16x8, sb0), SB1 = __builtin_bit_cast(bf16x8, sb1);
                const bf16x8 a0 = *(const bf16x8*)(AP + l15 * 64 + (0 * 4 + quad) * 8), a1 = *(const bf16x8*)(AP + l15 * 64 + (1 * 4 + quad) * 8);
                const bf16x8 r0 = *(const bf16x8*)(RP + l15 * 64 + (0 * 4 + quad) * 8), r1 = *(const bf16x8*)(RP + l15 * 64 + (1 * 4 + quad) * 8);
                const u32x4_t vq = quad < 2 ? *(const u32x4_t*)(VsT + (w * 16 + l15) * 16 + quad * 8) : z4;
                const u32x4_t qq = quad < 2 ? *(const u32x4_t*)(QP + l15 * 16 + quad * 8) : z4;
                f32x4 gcv[4]; uint2 bqv[4]; u32x4_t pqv[4];
#pragma unroll
                for (int ct = 0; ct < 4; ++ct) { gcv[ct] = *(const f32x4*)(GC + ct * 16 + quad * 4); bqv[ct] = *(const uint2*)(BP + (ct * 16 + l15) * 16 + quad * 4);
                    pqv[ct] = quad < 2 ? *(const u32x4_t*)(PP + (ct * 16 + l15) * 16 + quad * 8) : z4; }
                const bf16x8 VB = __builtin_bit_cast(bf16x8, vq), QA = __builtin_bit_cast(bf16x8, qq);
                f32x4 Wt = (f32x4){0.f, 0.f, 0.f, 0.f}, Ot = Wt;
                Wt = mfma16(a0, SB0, Wt); Wt = mfma16(a1, SB1, Wt);
                Ot = mfma16(r0, SB0, Ot); Ot = mfma16(r1, SB1, Ot); Ot = mfma16(QA, VB, Ot);
                u32x4_t wb; wb.x = pk2(Wt[0], Wt[1]); wb.y = pk2(Wt[2], Wt[3]); wb.z = 0u; wb.w = 0u;
                const bf16x8 WB = __builtin_bit_cast(bf16x8, wb);
#pragma unroll
                for (int ct = 0; ct < 4; ++ct) {
                    u32x4_t ba; ba.x = bqv[ct].x; ba.y = bqv[ct].y; ba.z = 0u; ba.w = 0u;
                    f32x4 acc = ST[ct] * gcv[ct];
                    acc = mfma16(__builtin_bit_cast(bf16x8, ba), WB, acc);
                    acc = mfma16(__builtin_bit_cast(bf16x8, pqv[ct]), VB, acc);
                    ST[ct] = acc;
                }
                bf16_t* Oo = slotp(P, 15 + dir);
#pragma unroll
                for (int jj = 0; jj < 4; ++jj) { const int sidx = ck * 16 + quad * 4 + jj;
                    if (sidx < LSEQ) { const int p = dir ? LSEQ - 1 - sidx : sidx; ((__attribute__((address_space(1))) bf16_t*)Oo)[(size_t)row_of(sl, p) * 512 + head * 64 + w * 16 + l15] = (bf16_t)(pk2(Ot[jj], 0.f) & 0xffffu); } }
            }
            __syncthreads();
        }
    }
}


DEV void phase_attn_combine(const Params& P0, int layer, int bid, int nb, int wv) {
    Params P = load_params(); P.ws = launder_ws(P.ws);
    ROWPRO
    const float lam_init = layer == 0 ? 0.2f : 0.35550906759096934f;
    float lam;
    { const float* lp = P.in[I_LAM] + (size_t)layer * 256; const float s1 = wave_sum(lp[lane] * lp[64 + lane]), s2 = wave_sum(lp[128 + lane] * lp[192 + lane]); lam = __expf(s1) - __expf(s2) + lam_init; }
    const float* PT = (const float*)slotp(P, 22);
    for (int task = gw; task < 64 * 128; task += ngw) {
        const int ul = task >> 7, row = task & 127, unit = 448 + ul, sh = unit >> 5, qb = unit & 31, sl = sh >> 2, head = sh & 3;
        float om[2][2];
#pragma unroll
        for (int map = 0; map < 2; ++map) {
            const float* pa = PT + ((size_t)((ul * 2 + 0) * 2 + map) * 128 + row) * 130; const float* pb = PT + ((size_t)((ul * 2 + 1) * 2 + map) * 128 + row) * 130;
            const float ma = pa[128], la = pa[129], mb = pb[128], lb = pb[129];
            const float M = fmaxf(ma, mb), fa = __builtin_amdgcn_exp2f(ma - M), fb = __builtin_amdgcn_exp2f(mb - M);
            const float inv = 1.0f / (la * fa + lb * fb);
            om[map][0] = (pa[lane * 2] * fa + pb[lane * 2] * fb) * inv; om[map][1] = (pa[lane * 2 + 1] * fa + pb[lane * 2 + 1] * fb) * inv; }
        const float o0 = om[0][0] - lam * om[1][0], o1 = om[0][1] - lam * om[1][1];
        const float ss = wave_sum(o0 * o0 + o1 * o1);
        const float rs = rsqrtf(ss * (1.f / 128.f) + 1e-5f) * (1.f - lam_init);
        const float g0 = P.in[I_SUBLN][layer * 128 + lane * 2], g1 = P.in[I_SUBLN][layer * 128 + lane * 2 + 1];
        *(unsigned*)(slotp(P, 4) + (size_t)(sl * 4096 + qb * 128 + row) * 512 + head * 128 + lane * 2) = pk2(o0 * rs * g0, o1 * rs * g1);
    }
}
#define LAS __attribute__((address_space(3)))
#define XB_TMO      128
#define XB_XCNT(j)  (256  + 64 * (j))
#define XB_XSUB(j)  (1280 + 64 * (j))
#define XB_XGEN(j)  (2304 + 64 * (j))
#define XB_TOP      3328
#define XB_TOPGEN   3392
#define XCD_BAR_WORDS 3456
#define XB_SPIN_CAP (1u << 18)

__device__ __forceinline__ unsigned xb_ld(unsigned* p)              { return __hip_atomic_load(p, __ATOMIC_RELAXED, __HIP_MEMORY_SCOPE_AGENT); }
__device__ __forceinline__ unsigned xb_add(unsigned* p, unsigned v) { return __hip_atomic_fetch_add(p, v, __ATOMIC_RELAXED, __HIP_MEMORY_SCOPE_AGENT); }
__device__ __forceinline__ unsigned xb_xcc_id() { return (unsigned)__builtin_amdgcn_s_getreg((3 << 11) | 20) & 0xFu; }
#define XB_SPIN(cond, bar) do { unsigned _sp = 0; while (cond) { __builtin_amdgcn_s_sleep(1); \
    if ((++_sp & 255u) == 0u) { if (xb_ld(&(bar)[XB_TMO])) break; if (_sp > XB_SPIN_CAP) { atomicAdd(&(bar)[XB_TMO], 1u); break; } } } } while (0)

struct XcdBarrier {
    unsigned* bar; unsigned x;
    volatile LAS unsigned* st;
};

__device__ __forceinline__ XcdBarrier xcd_barrier_post(unsigned* bar, volatile LAS unsigned* st, int wv) {
    XcdBarrier b; b.bar = bar; b.x = xb_xcc_id(); b.st = st;
    if (launder_tid(wv) == 0) (void)xb_add(&bar[XB_XCNT(b.x)], 1u);
    return b;
}
__device__ __forceinline__ void xcd_barrier_complete(unsigned* bar, unsigned x, unsigned& nloc, unsigned& nx) {
    const unsigned G = gridDim.x * gridDim.y * gridDim.z;
    unsigned sum, cnt, mine, sp = 0u;
    for (;;) {
        sum = 0u; cnt = 0u; mine = 0u;
#pragma unroll
        for (unsigned j = 0; j < 16; ++j) { const unsigned c = xb_ld(&bar[XB_XCNT(j)]); sum += c; cnt += (c > 0u) ? 1u : 0u; mine = (j == x) ? c : mine; }
        if (sum == G) break;
        __builtin_amdgcn_s_sleep(1);
        if ((++sp & 255u) == 0u) { if (xb_ld(&bar[XB_TMO])) break; if (sp > XB_SPIN_CAP) { atomicAdd(&bar[XB_TMO], 1u); break; } }
    }
    nloc = mine > 0u ? mine : 1u; nx = cnt > 0u ? cnt : 1u;
}

__device__ __forceinline__ void xcd_barrier(const XcdBarrier& b, int wv) {
    asm volatile("s_waitcnt vmcnt(0)" ::: "memory");
    __syncthreads();
    if (launder_tid(wv) == 0) {
        unsigned* bar = b.bar;
        __builtin_amdgcn_s_waitcnt(0);
        unsigned nloc = b.st[0], nx = b.st[1];
        if (nloc == 0u) { xcd_barrier_complete(bar, b.x, nloc, nx); b.st[0] = nloc; b.st[1] = nx; }
        const unsigned old = xb_add(&bar[XB_XSUB(b.x)], 1u);
        const unsigned gen = old / nloc;
        if (old + 1u == (gen + 1u) * nloc) {
            __builtin_amdgcn_fence(__ATOMIC_RELEASE, "agent");
            asm volatile("s_waitcnt vmcnt(0)" ::: "memory");
            const unsigned og = xb_add(&bar[XB_TOP], 1u);
            const unsigned tg = og / nx;
            if (og + 1u == (tg + 1u) * nx) xb_add(&bar[XB_TOPGEN], 1u);
            else XB_SPIN(xb_ld(&bar[XB_TOPGEN]) == tg, bar);
            __builtin_amdgcn_fence(__ATOMIC_ACQUIRE, "agent");
            xb_add(&bar[XB_XGEN(b.x)], 1u);
            asm volatile("s_waitcnt vmcnt(0)" ::: "memory");
        } else {
            XB_SPIN(xb_ld(&bar[XB_XGEN(b.x)]) == gen, bar);
            __builtin_amdgcn_fence(__ATOMIC_ACQUIRE, "agent");
            asm volatile("s_waitcnt vmcnt(0)" ::: "memory");
        }
    }
    __syncthreads();
}

__global__ void __launch_bounds__(512) mega_fwd(Params P) {
    extern __shared__ __attribute__((aligned(16))) unsigned char lds[];
    cg::grid_group grid = cg::this_grid();
    const int bid = blockIdx.x, nb = gridDim.x; const int wv = __builtin_amdgcn_readfirstlane(threadIdx.x >> 6);
    volatile LAS unsigned* MISC = (volatile LAS unsigned*)((LAS unsigned char*)lds + 131072 + 256);
    if (threadIdx.x < 4) MISC[threadIdx.x] = 0u;
    __syncthreads();
    XcdBarrier xbar;
    { Params Pb = load_params(); xbar = xcd_barrier_post((unsigned*)Pb.ws, MISC, wv); }
#define GSYNC() xcd_barrier(xbar, wv)
    PG8_LAS unsigned char* ldsl = (PG8_LAS unsigned char*)lds;
#pragma unroll 1
    for (int layer_ = 0; layer_ < 2; ++layer_) {
        phase_weights(P, lsd(layer_), lds, bid, nb, wv);
        grid.sync();
#pragma unroll 1
        for (int g_ = 0; g_ < NGRP; ++g_) {
            #define Mpost ((lsd(layer_) == 0 && lsd(g_) == 2) ? TGP : TREAL)
#define NVALID ((lsd(layer_) == 0 && lsd(g_) == 2) ? TG + 128 : TG)
            phase_rmsnorm(P, lsd(g_), lsd(layer_) == 0, I_NMIX, lsd(layer_), TGP, NVALID, bid, nb, wv);
            if (PROBE == 5) { phase_rmsnorm(P, lsd(g_), lsd(layer_) == 0, I_NMIX, lsd(layer_), TGP, NVALID, bid, nb, wv); }
            GSYNC();
            if (PROBE == 6) { for (int q_ = 0; q_ < 15; ++q_) GSYNC(); }
            for (int rep_ = 0; rep_ < (PROBE == 3 ? 2 : 1); ++rep_)
            { Params Pl = load_params(); Pl.ws = launder_ws(Pl.ws); pg8::bf16_t* W = (pg8::bf16_t*)(Pl.ws + WS_W); pg8::Gemm gm{slotp(Pl, 0), W + WO_IN, TGP, 7680, 1024, 0, 0}; pg8::StaticOrder S; S.init(TGP, 7680, nb, bid);
              pg8::EpiBf<0> E{slotp(Pl, 2), 512, SLOT_E};
              pg8::gemm_phase<pg8::EpiBf<0>, pg8::StaticOrder, true, true>(ldsl, gm, S, E, wv); }
            GSYNC();
            phase_da_prep(P, lsd(layer_), bid, nb, wv);
            phase_hg1(P, lsd(layer_), lds, bid, nb, wv);
            if (PROBE == 4) { phase_hg1(P, lsd(layer_), lds, bid, nb, wv); }
            GSYNC();
            phase_hg2(P, bid, nb, wv);
            GSYNC();
            phase_hg3(P, lsd(layer_), lds, bid, nb, wv);
            GSYNC();
            phase_conv(P, lsd(layer_), bid, nb, wv);
            if (PROBE == 5) { phase_conv(P, lsd(layer_), bid, nb, wv); }
            phase_vtrans(P, lds, bid, nb, wv);
            if (PROBE == 5) { phase_vtrans(P, lds, bid, nb, wv); }
            phase_rw_prep(P, lsd(layer_), bid, nb, wv);
            if (PROBE == 5) { phase_rw_prep(P, lsd(layer_), bid, nb, wv); }
            GSYNC();
            { Params Pl = load_params(); Pl.ws = launder_ws(Pl.ws); pg8::bf16_t* W = (pg8::bf16_t*)(Pl.ws + WS_W); pg8::Gemm gm{slotp(Pl, 21), W + WO_LR, TGP, 2560, 384, 0, 0}; pg8::StaticOrder S; S.init(TGP, 2560, nb, bid);
              pg8::EpiLR E{slotp(Pl, 22), slotp(Pl, 23), slotp(Pl, 24), slotp(Pl, 13), slotp(Pl, 14), Pl.in[I_W0] + lsd(layer_) * 1024, Pl.in[I_A0] + lsd(layer_) * 1024};
              pg8::gemm_phase<pg8::EpiLR, pg8::StaticOrder, true, true>(ldsl, gm, S, E, wv); }
            GSYNC();
            phase_rwc_pre(P, lsd(layer_), lds, bid, nb, wv);
            GSYNC();
            if (nb == 256) {
                const int nun = lsd(layer_) == 0 ? 528 : 512;
                if (bid < 64) { phase_rwc_scan(P, lds, bid, nb, wv); __syncthreads(); phase_attn(P, lsd(layer_), lds, bid, -1, -1, wv); }
                else { const int bq = bid - 64;
                    const int third = bq < 128 ? ((448 + (bq >> 1)) | ((3 + (bq & 1)) << 12)) : ((384 + bq < nun) ? 384 + bq : -1);
                    phase_attn(P, lsd(layer_), lds, 64 + bq, 256 + bq, third, wv); }
            } else {
                phase_rwc_scan(P, lds, bid, nb, wv); __syncthreads();
                for (int u = bid; u < (lsd(layer_) == 0 ? 528 : 512); u += nb) phase_attn(P, lsd(layer_), lds, u, -1, -1, wv);
            }
            GSYNC();
            if (nb == 256) phase_attn_combine(P, lsd(layer_), bid, nb, wv);
            phase_rw_post(P, lsd(layer_), lsd(g_), lsd(layer_) == 0 ? TG : TREAL, bid, nb, wv);
            if (PROBE == 5) { phase_rw_post(P, lsd(layer_), lsd(g_), lsd(layer_) == 0 ? TG : TREAL, bid, nb, wv); }
            GSYNC();
            { Params Pl = load_params(); Pl.ws = launder_ws(Pl.ws); pg8::bf16_t* W = (pg8::bf16_t*)(Pl.ws + WS_W); pg8::Gemm gm{slotp(Pl, 2), W + WO_BP, Mpost, 4096, 512, 4, SLOT_B}; pg8::StaticOrder S; S.init(Mpost, 4096, nb, bid);
              pg8::EpiBf<0> E{slotp(Pl, 6), 4096, 0};
              pg8::gemm_phase<pg8::EpiBf<0>, pg8::StaticOrder, true, true>(ldsl, gm, S, E, wv); }
            GSYNC();
            { Params Pl = load_params(); Pl.ws = launder_ws(Pl.ws); pg8::bf16_t* W = (pg8::bf16_t*)(Pl.ws + WS_W); pg8::Gemm gm{slotp(Pl, 0), W + WO_G, Mpost, 4096, 1024, 0, 0}; pg8::StaticOrder S; S.init(Mpost, 4096, nb, bid);
              pg8::EpiGate E{slotp(Pl, 6), slotp(Pl, 14)};
              pg8::gemm_phase<pg8::EpiGate, pg8::StaticOrder, true, true>(ldsl, gm, S, E, wv); }
            GSYNC();
            { Params Pl = load_params(); Pl.ws = launder_ws(Pl.ws); pg8::bf16_t* W = (pg8::bf16_t*)(Pl.ws + WS_W); pg8::Gemm gm{slotp(Pl, 14), W + WO_OUT, Mpost, 1024, 1024, 0, 0}; pg8::StaticOrder S; S.init(Mpost, 1024, nb, bid);
              pg8::EpiResid E{lsd(layer_) == 0 ? x_in_row(Pl, lsd(g_), 0) : (const float*)x_cur_row(Pl, lsd(g_), 0), lsd(layer_) == 0 ? Pl.in[I_META] : (const float*)nullptr, x_cur_row(Pl, lsd(g_), 0), GPTR(float, Pl.ws + WS_XMETA), lsd(g_), NVALID};
              pg8::gemm_phase<pg8::EpiResid, pg8::StaticOrder, true, true>(ldsl, gm, S, E, wv); }
            GSYNC();
            phase_rmsnorm(P, lsd(g_), false, I_NMLP, lsd(layer_), Mpost, NVALID, bid, nb, wv);
            if (PROBE == 5) { phase_rmsnorm(P, lsd(g_), false, I_NMLP, lsd(layer_), Mpost, NVALID, bid, nb, wv); }
            GSYNC();
            for (int rep_ = 0; rep_ < (PROBE == 7 ? 2 : 1); ++rep_)
            { Params Pl = load_params(); Pl.ws = launder_ws(Pl.ws); pg8::bf16_t* W = (pg8::bf16_t*)(Pl.ws + WS_W); pg8::Gemm gm{slotp(Pl, 0), W + WO_1, Mpost, 4096, 1024, 0, 0}; pg8::StaticOrder S; S.init(Mpost, 4096, nb, bid);
              pg8::EpiBf<1> E{slotp(Pl, 6), 4096, 0};
              pg8::gemm_phase<pg8::EpiBf<1>, pg8::StaticOrder, true, true>(ldsl, gm, S, E, wv); }
            GSYNC();
            { Params Pl = load_params(); Pl.ws = launder_ws(Pl.ws); pg8::bf16_t* W = (pg8::bf16_t*)(Pl.ws + WS_W); pg8::Gemm gm{slotp(Pl, 6), W + WO_2, Mpost, 1024, 4096, 0, 0}; pg8::StaticOrder S; S.init(Mpost, 1024, nb, bid);
              pg8::EpiResid E{(const float*)x_cur_row(Pl, lsd(g_), 0), (const float*)nullptr, x_cur_row(Pl, lsd(g_), 0), GPTR(float, Pl.ws + WS_XMETA), lsd(g_), NVALID};
              pg8::gemm_phase<pg8::EpiResid, pg8::StaticOrder, true, true>(ldsl, gm, S, E, wv); }
            GSYNC();
        }
    }
}

extern "C" void kernel_launch(void* const* d_in, const int* in_sizes, int n_in, void* d_out, int out_size, void* d_ws, size_t ws_size, hipStream_t stream) {
    static int grid = 0;
    if (grid == 0) {
        if (n_in != 29 || ws_size < WS_NEED) { fprintf(stderr, "kernel_launch: need 29 inputs and %zu bytes of workspace; got %d, %zu\n", (size_t)WS_NEED, n_in, ws_size); grid = -1; return; }
        int dev = 0, cus = 0, per_cu = 0;
        if (hipGetDevice(&dev) != hipSuccess || hipDeviceGetAttribute(&cus, hipDeviceAttributeMultiprocessorCount, dev) != hipSuccess) { grid = -1; return; }
        if (hipFuncSetAttribute((const void*)mega_fwd, hipFuncAttributeMaxDynamicSharedMemorySize, LDS_BYTES) != hipSuccess) { fprintf(stderr, "kernel_launch: hipFuncSetAttribute failed\n"); grid = -1; return; }
        if (hipOccupancyMaxActiveBlocksPerMultiprocessor(&per_cu, (const void*)mega_fwd, 512, LDS_BYTES) != hipSuccess || per_cu < 1) { fprintf(stderr, "kernel_launch: occupancy query says %d\n", per_cu); per_cu = 1; }
        (void)hipGetLastError();
        grid = cus;
    }
    if (grid < 0) return;
    if (hipMemsetAsync(d_ws, 0, 16384, stream) != hipSuccess) { fprintf(stderr, "kernel_launch: memset failed\n"); return; }
    Params p{};
    for (int i = 0; i < 29; ++i) p.in[i] = (const float*)d_in[i];
    p.out = (float*)d_out; p.ws = (unsigned char*)d_ws;
    void* args[] = {&p};
    hipError_t e = hipLaunchCooperativeKernel((const void*)mega_fwd, dim3(grid), dim3(512), args, LDS_BYTES, stream);
    if (e != hipSuccess) fprintf(stderr, "kernel_launch: cooperative launch failed: %s (grid %d)\n", hipGetErrorString(e), grid);
}
```

```cpp
#include <hip/hip_runtime.h>
#include <hip/hip_cooperative_groups.h>
#include <cstdio>
#include <cstdint>
namespace cg = cooperative_groups;
#define PROBE 0
#define DEV __device__ __forceinline__
__device__ __forceinline__ int lsd(int x) { asm volatile("" : "+s"(x)); return x; }
__device__ __forceinline__ int launder_tid(int wv) { int l; asm volatile("v_mbcnt_lo_u32_b32 %0, -1, 0\n\tv_mbcnt_hi_u32_b32 %0, -1, %0" : "=v"(l)); return wv * 64 + l; }
namespace pg8 {
#define PG8_LAS __attribute__((address_space(3)))
typedef unsigned short bf16_t;
typedef short bf16x8 __attribute__((ext_vector_type(8)));
typedef float f32x4 __attribute__((ext_vector_type(4)));
typedef unsigned u32x4 __attribute__((ext_vector_type(4)));
constexpr int BM = 256, BK = 64, HALF = 128, HTB = HALF * BK * 2  , STAGE_BYTES = 8 * HTB, NXCD = 8, WGM = 8;

__host__ __device__ __forceinline__ int lds_byte(int r, int c) { const int st = (r >> 4) * 2 + (c >> 5), rr = r & 15, cc = c & 31, ob = rr * 64 + cc * 2; return st * 1024 + (ob ^ (((ob >> 9) & 1) << 5)); }
__host__ __device__ __forceinline__ void stage_rc(int b, int& R, int& C) { const int st = b / 1024, sb = b % 1024, swz = sb ^ (((sb >> 9) & 1) << 5); R = (st >> 1) * 16 + swz / 64; C = (st & 1) * 32 + (swz % 64) / 2; }
__host__ __device__ __forceinline__ int perm32(int rho) { const int n = rho >> 4, i = rho & 15; return 8 * (i >> 2) + 4 * n + (i & 3); }

struct Unit { int pm, pn; };
struct Gemm { const bf16_t* A; const bf16_t* Bt; int M, N, K; int pn_per_ab; size_t ab_stride; };

struct StaticOrder {
    int nM, nN, nwg, G, c;
    __host__ __device__ void init(int M, int N, int G_, int c_) { nM = M / BM; nN = N / BM; nwg = nM * nN; G = G_; c = c_; }
    __host__ __device__ bool next(int i, Unit& u) const {
        const long L = (long)i * G + c; if (L >= nwg) return false;
        int wgid = (int)L; { const int q = nwg / NXCD, r = nwg % NXCD, xcd = wgid % NXCD, off = wgid / NXCD; wgid = (xcd < r ? xcd * (q + 1) : r * (q + 1) + (xcd - r) * q) + off; }
        const int nig = WGM * nN, gid = wgid / nig, fm = gid * WGM, gsz = (nM - fm) < WGM ? (nM - fm) : WGM;
        u.pm = fm + ((wgid % nig) % gsz); u.pn = (wgid % nig) / gsz; return true;
    }
    __device__ __forceinline__ void a_ready(const Unit&) const {}
    __device__ __forceinline__ void done(const Unit&) const {}
};

typedef float f32x2cv_t __attribute__((ext_vector_type(2))); typedef __bf16 bf16x2cv_t __attribute__((ext_vector_type(2)));
__device__ __forceinline__ unsigned cvt_pk_bf16(float lo, float hi) { const f32x2cv_t v = {lo, hi}; const bf16x2cv_t b = __builtin_convertvector(v, bf16x2cv_t); return __builtin_bit_cast(unsigned, b); }
typedef float f32x2 __attribute__((ext_vector_type(2)));
__device__ __forceinline__ float sigm(float x) { return __builtin_amdgcn_rcpf(1.0f + __expf(-x)); }
template <int ACT  > struct EpiBf {
    static constexpr bool PERM = true, AFTER_DRAIN = false;
    bf16_t* O; int ldc; size_t gstride;
    __device__ __forceinline__ void operator()(const f32x4 (&acc)[2][2][4][2], const Unit& u, int wr, int wc, int fr, int fq) const {
        const int row0 = u.pm * BM + wr * 64 + fr; int colt = u.pn * BM; bf16_t* base = O; int ld = ldc;
        if (gstride) { const int t = colt >> 9; colt &= 511; base += (size_t)t * gstride; ld = 512; }
        const int col0 = colt + wc * 32 + 8 * fq;
#pragma unroll
        for (int ai = 0; ai < 2; ++ai)
#pragma unroll
            for (int m = 0; m < 4; ++m) { bf16_t* rowp = base + (size_t)(row0 + ai * HALF + m * 16) * ld + col0;
#pragma unroll
                for (int bj = 0; bj < 2; ++bj) { f32x4 v0 = acc[ai][bj][m][0], v1 = acc[ai][bj][m][1];
                    if (ACT == 1) {
#pragma unroll
                        for (int i = 0; i < 4; ++i) { float a = fmaxf(v0[i], 0.f), b = fmaxf(v1[i], 0.f); v0[i] = a * a; v1[i] = b * b; } }
                    u32x4 w; w.x = cvt_pk_bf16(v0[0], v0[1]); w.y = cvt_pk_bf16(v0[2], v0[3]); w.z = cvt_pk_bf16(v1[0], v1[1]); w.w = cvt_pk_bf16(v1[2], v1[3]);
                    *(u32x4*)(rowp + bj * HALF) = w; } }
    }
};
struct EpiLR {
    static constexpr bool PERM = true, AFTER_DRAIN = false;
    bf16_t *s0, *s1, *s2, *s3, *s4; const float* w0; const float* a0;
    __device__ __forceinline__ void operator()(const f32x4 (&acc)[2][2][4][2], const Unit& u, int wr, int wc, int fr, int fq) const {
        const int row0 = u.pm * BM + wr * 64 + fr; const int colg = u.pn * BM; const int seg = colg >> 9; const int cb = colg & 511;
        bf16_t* base = seg == 0 ? s0 : seg == 1 ? s1 : seg == 2 ? s2 : seg == 3 ? s3 : s4;
        const int col0 = cb + wc * 32 + 8 * fq;
        const float* bsrc = seg < 2 ? w0 + seg * 512 : a0 + (seg & 1) * 512;
        const float sc = seg < 2 ? 0.6065306597f : 1.0f; const float bm = seg < 4 ? 1.f : 0.f; const bool act = seg < 4;
#pragma unroll
        for (int bj = 0; bj < 2; ++bj) {
            const f32x4 b0 = *(const f32x4*)(bsrc + col0 + bj * HALF) * bm, b1 = *(const f32x4*)(bsrc + col0 + bj * HALF + 4) * bm;
#pragma unroll
            for (int ai = 0; ai < 2; ++ai)
#pragma unroll
                for (int m = 0; m < 4; ++m) { bf16_t* rowp = base + (size_t)(row0 + ai * HALF + m * 16) * 512 + col0;
                    f32x4 v0 = acc[ai][bj][m][0] + b0, v1 = acc[ai][bj][m][1] + b1;
#pragma unroll
                    for (int i = 0; i < 4; ++i) { const float g0 = sc * sigm(v0[i]), g1 = sc * sigm(v1[i]); v0[i] = act ? g0 : v0[i]; v1[i] = act ? g1 : v1[i]; }
                    u32x4 w; w.x = cvt_pk_bf16(v0[0], v0[1]); w.y = cvt_pk_bf16(v0[2], v0[3]); w.z = cvt_pk_bf16(v1[0], v1[1]); w.w = cvt_pk_bf16(v1[2], v1[3]);
                    *(u32x4*)(rowp + bj * HALF) = w; __builtin_amdgcn_sched_barrier(0); }
        }
    }
};
struct EpiGate {
    static constexpr bool PERM = true, AFTER_DRAIN = false;
    const bf16_t* Pm; bf16_t* Mg;
    __device__ __forceinline__ void operator()(const f32x4 (&acc)[2][2][4][2], const Unit& u, int wr, int wc, int fr, int fq) const {
        const int row0 = u.pm * BM + wr * 64 + fr; const int ocol = u.pn * 64 + wc * 16 + fq * 4;
#pragma unroll
        for (int ai = 0; ai < 2; ++ai)
#pragma unroll
            for (int m = 0; m < 4; ++m) { const size_t row = (size_t)(row0 + ai * HALF + m * 16);
                float s0 = 0.f, s1 = 0.f, s2 = 0.f, s3 = 0.f;
#pragma unroll
                for (int bj = 0; bj < 2; ++bj)
#pragma unroll
                    for (int n = 0; n < 2; ++n) { const int br = bj * 2 + n;
                        const uint2 pw = *(const uint2*)(Pm + row * 4096 + br * 1024 + ocol);
                        const f32x4 a = acc[ai][bj][m][n];
                        s0 += sigm(a[0]) * __uint_as_float(pw.x << 16); s1 += sigm(a[1]) * __uint_as_float(pw.x & 0xffff0000u);
                        s2 += sigm(a[2]) * __uint_as_float(pw.y << 16); s3 += sigm(a[3]) * __uint_as_float(pw.y & 0xffff0000u); }
                uint2 o; o.x = cvt_pk_bf16(s0, s1); o.y = cvt_pk_bf16(s2, s3);
                *(uint2*)(Mg + row * 1024 + ocol) = o; }
    }
};
struct EpiResid {
    static constexpr bool PERM = true, AFTER_DRAIN = false;
    const float* om; const float* mt; float* nm; float* xmb; int g; int rlim;
    __device__ __forceinline__ void operator()(const f32x4 (&acc)[2][2][4][2], const Unit& u, int wr, int wc, int fr, int fq) const {
        const int row0 = u.pm * BM + wr * 64 + fr; const int col0 = u.pn * BM + wc * 32 + 8 * fq;
#pragma unroll
        for (int ai = 0; ai < 2; ++ai)
#pragma unroll
            for (int m = 0; m < 4; ++m) { const int r = row0 + ai * HALF + m * 16;
                if (r < rlim) {
                    const int mi = r - 16384;
                    float* dmeta = xmb + (size_t)(mi < 64 ? g * 64 + mi : ((mi >> 6) - 1) * 64 + (mi & 63)) * 1024;
                    const float* src = r < 16384 ? om + (size_t)r * 1024 : (mt ? mt + (size_t)(mi & 15) * 1024 : (const float*)dmeta);
                    float* dst = r < 16384 ? nm + (size_t)r * 1024 : dmeta;
#pragma unroll
                    for (int bj = 0; bj < 2; ++bj)
#pragma unroll
                        for (int n = 0; n < 2; ++n) { const int c = col0 + bj * HALF + 4 * n;
                            const f32x4 xo = *(const f32x4*)(src + c); *(f32x4*)(dst + c) = xo + acc[ai][bj][m][n]; } } }
    }
};
template <class Epi, class Sched, bool ALIGN_EPI = false, bool SP2 = false>
__device__ __forceinline__ void gemm_phase(PG8_LAS unsigned char* lds, const Gemm g, const Sched& S, const Epi& E, int wv) {
    const int tid = launder_tid(wv), wid = __builtin_amdgcn_readfirstlane(tid >> 6), lane = tid & 63, wr = wid >> 2, wc = wid & 3, fr = lane & 15, fq = lane >> 4;
    const int K = g.K, nt = K / BK;
    unsigned voffA[2], voffB[2];
#pragma unroll
    for (int i = 0; i < 2; ++i) { int R, C; stage_rc(tid * 16 + i * 8192, R, C); const int Rb = Epi::PERM ? ((R & ~31) + perm32(R & 31)) : R;
        voffA[i] = (unsigned)(R * K + C) * 2u; voffB[i] = (unsigned)(Rb * K + C) * 2u; }
    const size_t kstep = (size_t)(BK * 2);
    const size_t hstep = (size_t)HALF * K * 2;
    const size_t tstep = 2 * hstep;
    const unsigned ldsw = (unsigned)wid * 1024u;
    const int aoff = lds_byte(wr * 64 + fr, fq * 8), boff = lds_byte(wc * 32 + fr, fq * 8);
#define PG8_SA(b, h) (((b) * 2 + (h)) * HTB)
#define PG8_SB(b, h) ((4 + (b) * 2 + (h)) * HTB)
#define PG8_STAGE(bufoff, gbase, voff) do { _Pragma("unroll") for (int _i = 0; _i < 2; ++_i) \
        __builtin_amdgcn_global_load_lds((const unsigned*)((const char*)(gbase) + (voff)[_i]), (PG8_LAS unsigned*)(lds + (bufoff) + ldsw + _i * 8192), 16, 0, 0); } while (0)
#define PG8_LDA(dst, b, h) do { _Pragma("unroll") for (int m = 0; m < 4; ++m) _Pragma("unroll") for (int k = 0; k < 2; ++k) dst[m][k] = *(const PG8_LAS bf16x8*)(lds + PG8_SA(b, h) + aoff + m * 2048 + k * 1024); } while (0)
#define PG8_LDB(dst, b, h) do { _Pragma("unroll") for (int n = 0; n < 2; ++n) _Pragma("unroll") for (int k = 0; k < 2; ++k) dst[n][k] = *(const PG8_LAS bf16x8*)(lds + PG8_SB(b, h) + boff + n * 2048 + k * 1024); } while (0)
#define PG8_MMA(ai, bj, At, Bt) do { __builtin_amdgcn_s_setprio(1); _Pragma("unroll") for (int m = 0; m < 4; ++m) _Pragma("unroll") for (int n = 0; n < 2; ++n) _Pragma("unroll") for (int k = 0; k < 2; ++k) \
        acc[ai][bj][m][n] = __builtin_amdgcn_mfma_f32_16x16x32_bf16(Bt[n][k], At[m][k], acc[ai][bj][m][n], 0, 0, 0); __builtin_amdgcn_s_setprio(0); } while (0)
#define PG8_WAIT_V(n) asm volatile("s_waitcnt vmcnt(" #n ")" ::: "memory")
#define PG8_WAIT_L(n) asm volatile("s_waitcnt lgkmcnt(" #n ")" ::: "memory")
#define PG8_BAR __builtin_amdgcn_s_barrier()
#define PG8_SCHED __builtin_amdgcn_sched_barrier(0)
    Unit cur, nxt; int ui = 0;
    if (!S.next(0, cur)) return;
    f32x4 acc[2][2][4][2];
#pragma unroll
    for (int a = 0; a < 2; ++a)
#pragma unroll
        for (int b = 0; b < 2; ++b)
#pragma unroll
            for (int m = 0; m < 4; ++m)
#pragma unroll
                for (int n = 0; n < 2; ++n) { float z_ = 0.f; asm volatile("" : "+v"(z_)); acc[a][b][m][n] = (f32x4){z_, z_, z_, z_}; }
    bf16x8 At[4][2], B0[2][2], B1[2][2];
    const char* cA = (const char*)g.A + (g.pn_per_ab ? (size_t)(cur.pn / g.pn_per_ab) * g.ab_stride : (size_t)0) + (size_t)cur.pm * tstep; const char* cB = (const char*)g.Bt + (size_t)cur.pn * tstep;
    S.a_ready(cur);
    if constexpr (SP2) {
        PG8_STAGE(PG8_SB(0, 0), cB, voffB); PG8_STAGE(PG8_SB(0, 1), cB + hstep, voffB); PG8_STAGE(PG8_SA(0, 0), cA, voffA); PG8_STAGE(PG8_SA(0, 1), cA + hstep, voffA);
        if (wr == 1) PG8_BAR;
        PG8_WAIT_V(2); PG8_BAR;
        PG8_STAGE(PG8_SB(1, 0), cB + kstep, voffB); PG8_STAGE(PG8_SA(1, 0), cA + kstep, voffA); PG8_STAGE(PG8_SB(1, 1), cB + hstep + kstep, voffB);
        PG8_WAIT_V(6); PG8_BAR;
    } else {
        PG8_STAGE(PG8_SB(0, 0), cB, voffB); PG8_STAGE(PG8_SA(0, 0), cA, voffA); PG8_STAGE(PG8_SB(0, 1), cB + hstep, voffB); PG8_STAGE(PG8_SA(0, 1), cA + hstep, voffA);
        if (wr == 1) PG8_BAR;
        PG8_WAIT_V(4); PG8_BAR;
        PG8_STAGE(PG8_SB(1, 0), cB + kstep, voffB); PG8_STAGE(PG8_SA(1, 0), cA + kstep, voffA); PG8_STAGE(PG8_SB(1, 1), cB + hstep + kstep, voffB);
        PG8_WAIT_V(6); PG8_BAR;
    }
    for (;;) {
        const bool has_next = S.next(ui + 1, nxt);
        const char* nA = has_next ? (const char*)g.A + (g.pn_per_ab ? (size_t)(nxt.pn / g.pn_per_ab) * g.ab_stride : (size_t)0) + (size_t)nxt.pm * tstep : cA; const char* nB = has_next ? (const char*)g.Bt + (size_t)nxt.pn * tstep : cB;
#pragma unroll 1
        for (int t = 0; t < nt; t += 2) {
            const bool last = (t == nt - 2);
            const char* a1 = cA + (size_t)(t + 1) * kstep;
            const char* a2 = last ? nA : cA + (size_t)(t + 2) * kstep; const char* b2 = last ? nB : cB + (size_t)(t + 2) * kstep;
            const char* a3 = a2 + kstep; const char* b3 = b2 + kstep;
            if (last && has_next) S.a_ready(nxt);
            if constexpr (SP2) {
            PG8_LDB(B0, 0, 0); PG8_LDB(B1, 0, 1); PG8_SCHED; PG8_LDA(At, 0, 0); PG8_STAGE(PG8_SA(1, 1), a1 + hstep, voffA);
            PG8_WAIT_V(8); PG8_WAIT_L(0); PG8_BAR; PG8_MMA(0, 0, At, B0); PG8_MMA(0, 1, At, B1); PG8_BAR; PG8_SCHED;
            PG8_LDA(At, 0, 1); PG8_STAGE(PG8_SB(0, 0), b2, voffB); PG8_STAGE(PG8_SB(0, 1), b2 + hstep, voffB); PG8_STAGE(PG8_SA(0, 0), a2, voffA);
            PG8_WAIT_V(8); PG8_WAIT_L(0); PG8_BAR; PG8_MMA(1, 0, At, B0); PG8_MMA(1, 1, At, B1); PG8_BAR; PG8_SCHED;
            PG8_LDB(B0, 1, 0); PG8_LDB(B1, 1, 1); PG8_SCHED; PG8_LDA(At, 1, 0); PG8_STAGE(PG8_SA(0, 1), a2 + hstep, voffA);
            PG8_WAIT_V(8); PG8_WAIT_L(0); PG8_BAR; PG8_MMA(0, 0, At, B0); PG8_MMA(0, 1, At, B1); PG8_BAR; PG8_SCHED;
            PG8_LDA(At, 1, 1); PG8_STAGE(PG8_SB(1, 0), b3, voffB); PG8_STAGE(PG8_SB(1, 1), b3 + hstep, voffB); PG8_STAGE(PG8_SA(1, 0), a3, voffA);
            PG8_WAIT_V(8); PG8_WAIT_L(0); PG8_BAR; PG8_MMA(1, 0, At, B0); PG8_MMA(1, 1, At, B1); PG8_BAR; PG8_SCHED;
            } else {
            PG8_LDB(B0, 0, 0); PG8_SCHED; PG8_LDA(At, 0, 0); PG8_STAGE(PG8_SA(1, 1), a1 + hstep, voffA);
            PG8_WAIT_L(8); PG8_BAR; PG8_WAIT_L(0); PG8_MMA(0, 0, At, B0); PG8_BAR; PG8_SCHED;
            PG8_LDB(B1, 0, 1); PG8_STAGE(PG8_SB(0, 0), b2, voffB);
            PG8_BAR; PG8_WAIT_L(0); PG8_MMA(0, 1, At, B1); PG8_BAR;
            PG8_LDA(At, 0, 1); PG8_STAGE(PG8_SA(0, 0), a2, voffA);
            PG8_BAR; PG8_WAIT_L(0); PG8_MMA(1, 0, At, B0); PG8_BAR; PG8_SCHED;
            PG8_STAGE(PG8_SB(0, 1), b2 + hstep, voffB);
            PG8_WAIT_V(6); PG8_BAR; PG8_MMA(1, 1, At, B1); PG8_BAR;
            PG8_LDB(B0, 1, 0); PG8_SCHED; PG8_LDA(At, 1, 0); PG8_STAGE(PG8_SA(0, 1), a2 + hstep, voffA);
            PG8_WAIT_L(8); PG8_BAR; PG8_WAIT_L(0); PG8_MMA(0, 0, At, B0); PG8_BAR; PG8_SCHED;
            PG8_LDB(B1, 1, 1); PG8_STAGE(PG8_SB(1, 0), b3, voffB);
            PG8_BAR; PG8_WAIT_L(0); PG8_MMA(0, 1, At, B1); PG8_BAR;
            PG8_LDA(At, 1, 1); PG8_STAGE(PG8_SA(1, 0), a3, voffA);
            PG8_BAR; PG8_WAIT_L(0); PG8_MMA(1, 0, At, B0); PG8_BAR; PG8_SCHED;
            PG8_STAGE(PG8_SB(1, 1), b3 + hstep, voffB);
            PG8_WAIT_V(6); PG8_BAR; PG8_MMA(1, 1, At, B1); PG8_BAR;
            }
        }
        if constexpr (ALIGN_EPI) { if (wr == 0) PG8_BAR; }
        if constexpr (!Epi::AFTER_DRAIN) { E(acc, cur, wr, wc, fr, fq); S.done(cur); }
        if (!has_next) break;
#pragma unroll
        for (int a = 0; a < 2; ++a)
#pragma unroll
            for (int b = 0; b < 2; ++b)
#pragma unroll
                for (int m = 0; m < 4; ++m)
#pragma unroll
                    for (int n = 0; n < 2; ++n) { float z_ = 0.f; asm volatile("" : "+v"(z_)); acc[a][b][m][n] = (f32x4){z_, z_, z_, z_}; }
        cur = nxt; cA = nA; cB = nB; ++ui;
        if constexpr (ALIGN_EPI) { if (wr == 1) PG8_BAR; }
    }
    PG8_WAIT_V(0);
    if constexpr (!ALIGN_EPI) { if (wr == 0) PG8_BAR; }
    PG8_BAR;
    if constexpr (Epi::AFTER_DRAIN) { E.fused(acc, cur, wr, wc, fr, fq, lds, wid, lane); S.done(cur); }
#undef PG8_SA
#undef PG8_SB
#undef PG8_STAGE
#undef PG8_LDA
#undef PG8_LDB
#undef PG8_MMA
#undef PG8_WAIT_V
#undef PG8_WAIT_L
#undef PG8_BAR
#undef PG8_SCHED
}
}
typedef unsigned short bf16_t;
typedef short bf16x8 __attribute__((ext_vector_type(8)));
typedef float f32x4 __attribute__((ext_vector_type(4)));
typedef float f32x16 __attribute__((ext_vector_type(16)));
constexpr int LSEQ = 4112, TREAL = 16384, TG = 16448, TGP = 16640, NGRP = 3;
constexpr size_t SLOT_E = (size_t)TGP * 512;
constexpr size_t SLOT_B = SLOT_E * 2;
constexpr size_t MiB = 1u << 20;
constexpr size_t WS_XMETA = 1 * MiB, WS_DECAY = 2 * MiB, WS_SIDE = 3 * MiB + 512 * 1024, WS_W = 5 * MiB, WS_SLOTS = 53 * MiB;
constexpr size_t WS_NEED = 512 * MiB;
static_assert(WS_SLOTS + 25 * SLOT_B + (size_t)(16448 - 11408) * 8960 <= 512 * MiB, "record tail fits the workspace");
constexpr size_t WO_IN = 0, WO_G = 7864320, WO_BP = 12058624, WO_OUT = 14155776, WO_1 = 15204352, WO_2 = 19398656, WO_LR = 23592960;
constexpr int LDS_BYTES = 140 * 1024;
enum { I_XP = 0, I_XS, I_META, I_NMIX, I_WIN, I_LBL, I_ONORM, I_CONV, I_QN, I_KN, I_LAM, I_SUBLN, I_MU, I_W0, I_W2, I_A0, I_A2, I_G2, I_KK, I_KA, I_RK, I_LNG, I_LNB, I_WG, I_BP, I_WOUT, I_NMLP, I_W1, I_W2M };
struct Params { const float* in[29]; float* out; unsigned char* ws; };
#define GPTR(T, p) ((T*)(__attribute__((address_space(1))) T*)(p))
typedef const __attribute__((address_space(4))) Params* KParamsPtr;
typedef unsigned u32x4g_t __attribute__((ext_vector_type(4)));
#define GLD16(p) (*(const __attribute__((address_space(1))) u32x4g_t*)(p))
DEV KParamsPtr kparams() { KParamsPtr p = (KParamsPtr)__builtin_amdgcn_kernarg_segment_ptr(); asm volatile("" : "+s"(p)); return p; }
DEV Params load_params() { KParamsPtr p = kparams(); Params r;
#pragma unroll
    for (int i = 0; i < 29; ++i) r.in[i] = (const float*)(const __attribute__((address_space(1))) float*)(unsigned long long)p->in[i];
    r.out = (float*)(__attribute__((address_space(1))) float*)(unsigned long long)p->out; r.ws = p->ws; return r; }
DEV unsigned char* launder_ws(unsigned char* p) { __attribute__((address_space(1))) unsigned char* g = (__attribute__((address_space(1))) unsigned char*)(unsigned long long)p; asm volatile("" : "+s"(g)); return (unsigned char*)g; }
DEV unsigned zero_u() { unsigned z = 0u; asm volatile("" : "+v"(z)); return z; }

#define ROWPRO const int tid_ = launder_tid(wv); const int lane = tid_ & 63; const int gw = bid * 8 + __builtin_amdgcn_readfirstlane(tid_ >> 6); const int ngw = nb * 8;
DEV float bf2f(unsigned short u) { return __uint_as_float((unsigned)u << 16); }
DEV unsigned pk2(float lo, float hi) { return pg8::cvt_pk_bf16(lo, hi); }
DEV void unpack8(const uint4 w, float* f) {
    f[0] = __uint_as_float(w.x << 16); f[1] = __uint_as_float(w.x & 0xffff0000u); f[2] = __uint_as_float(w.y << 16); f[3] = __uint_as_float(w.y & 0xffff0000u);
    f[4] = __uint_as_float(w.z << 16); f[5] = __uint_as_float(w.z & 0xffff0000u); f[6] = __uint_as_float(w.w << 16); f[7] = __uint_as_float(w.w & 0xffff0000u); }
DEV uint4 pack8(const float* f) { uint4 o; o.x = pk2(f[0], f[1]); o.y = pk2(f[2], f[3]); o.z = pk2(f[4], f[5]); o.w = pk2(f[6], f[7]); return o; }
DEV bf16_t* slotp(const Params& P, int s) { return GPTR(bf16_t, P.ws + WS_SLOTS + (size_t)s * SLOT_B); }
DEV int row_of(int sl, int p) { return p >= 16 ? sl * 4096 + p - 16 : TREAL + sl * 16 + p; }
DEV void pos_of(int r, int& sl, int& p) { if (r < TREAL) { sl = r >> 12; p = (r & 4095) + 16; } else { const int m = r - TREAL; sl = m >> 4; p = m & 15; } }
DEV float wave_sum(float v) {
#pragma unroll
    for (int o = 1; o < 64; o <<= 1) v += __shfl_xor(v, o);
    return v; }
DEV float red8(float v) { v += __shfl_xor(v, 1); v += __shfl_xor(v, 2); v += __shfl_xor(v, 4); return v; }
DEV f32x4 mfma16(bf16x8 a, bf16x8 b, f32x4 c) { return __builtin_amdgcn_mfma_f32_16x16x32_bf16(a, b, c, 0, 0, 0); }
DEV f32x16 mfma32(bf16x8 a, bf16x8 b, f32x16 c) { return __builtin_amdgcn_mfma_f32_32x32x16_bf16(a, b, c, 0, 0, 0); }
DEV const float* x_in_row(const Params& P, int g, int r) {
    if (r < TREAL) return (g < 2 ? P.in[I_XP] + (size_t)g * TREAL * 1024 : P.in[I_XS]) + (size_t)r * 1024;
    return P.in[I_META] + (size_t)((r - TREAL) & 15) * 1024; }
DEV float* x_cur_row(const Params& P, int g, int r) {
    if (r < TREAL) return P.out + ((size_t)g * TREAL + r) * 1024;
    const int m = r - TREAL;
    return GPTR(float, P.ws + WS_XMETA) + (size_t)(m < 64 ? g * 64 + m : ((m >> 6) - 1) * 64 + (m & 63)) * 1024; }

DEV int gate_row(int n) { const int br = n >> 10, c = n & 1023, pn = c >> 6, oc = c & 63, wc = oc >> 4, fq = (oc >> 2) & 3, i = oc & 3; return pn * 256 + (br >> 1) * 128 + wc * 32 + fq * 8 + (br & 1) * 4 + i; }
template <int MODE> DEV void wt_items(const float* __restrict__ W, int K, int N, bf16_t* WT, int row_off, float* scr, int gw, int ngw, int lane) {
    const int nblk = N >> 5, items = (K >> 6) * nblk;
    for (int it = gw; it < items; it += ngw) {
        const int kb = it / nblk, nbk = it - kb * nblk, k0 = 64 * kb, n0 = 32 * nbk;
#pragma unroll 8
        for (int i = 0; i < 32; ++i) { const int kk = 2 * i + (lane >> 5); scr[kk * 33 + (lane & 31)] = W[(size_t)(k0 + kk) * N + n0 + (lane & 31)]; }
        asm volatile("s_waitcnt lgkmcnt(0)" ::: "memory");
        const int c = lane & 7;
#pragma unroll
        for (int j = 0; j < 4; ++j) { const int n = (lane >> 3) + 8 * j; const float* sp = scr + (8 * c) * 33 + n;
            uint4 o; o.x = pk2(sp[0 * 33], sp[1 * 33]); o.y = pk2(sp[2 * 33], sp[3 * 33]); o.z = pk2(sp[4 * 33], sp[5 * 33]); o.w = pk2(sp[6 * 33], sp[7 * 33]);
            const int dr = MODE == 1 ? gate_row(n0 + n) : n0 + n + row_off;
            *(uint4*)(WT + (size_t)dr * K + k0 + 8 * c) = o; }
        asm volatile("s_waitcnt lgkmcnt(0)" ::: "memory");
    }
}
DEV void phase_weights(const Params& P0, int layer, unsigned char* lds, int bid, int nb, int wv) {
    Params P = load_params(); P.ws = launder_ws(P.ws);
    const int tid = launder_tid(wv), lane = tid & 63, w = __builtin_amdgcn_readfirstlane(tid >> 6);
    const int gtid = bid * 512 + tid, gth = nb * 512, gw = bid * 8 + w, ngw = nb * 8;
    float* scr = (float*)(lds + w * 8448);
    bf16_t* W = GPTR(bf16_t, P.ws + WS_W);
    wt_items<0>(P.in[I_WIN] + (size_t)layer * 1024 * 7552, 1024, 7552, W + WO_IN, 0, scr, gw, ngw, lane);
    for (int it = gtid; it < 128 * 128; it += gth) { const unsigned z = zero_u(); *(uint4*)(W + WO_IN + (size_t)7552 * 1024 + (size_t)it * 8) = make_uint4(z, z, z, z); }
    wt_items<1>(P.in[I_WG] + (size_t)layer * 1024 * 4096, 1024, 4096, W + WO_G, 0, scr, gw, ngw, lane);
    for (int n = 0; n < 4; ++n) wt_items<0>(P.in[I_BP] + (size_t)(layer * 4 + n) * 512 * 1024, 512, 1024, W + WO_BP, n * 1024, scr, gw, ngw, lane);
    wt_items<0>(P.in[I_WOUT] + (size_t)layer * 1024 * 1024, 1024, 1024, W + WO_OUT, 0, scr, gw, ngw, lane);
    wt_items<0>(P.in[I_W1] + (size_t)layer * 1024 * 4096, 1024, 4096, W + WO_1, 0, scr, gw, ngw, lane);
    wt_items<0>(P.in[I_W2M] + (size_t)layer * 4096 * 1024, 4096, 1024, W + WO_2, 0, scr, gw, ngw, lane);
    for (int it = gtid; it < 2560 * 48; it += gth) {
        const int row = it / 48, k8 = it - row * 48, seg = row >> 9, c = row & 511, k0 = k8 * 8;
        float v[8];
#pragma unroll
        for (int j = 0; j < 8; ++j) { const int k = k0 + j; float x = 0.f;
            if (seg == 0) { if (k < 64) x = P.in[I_W2][((size_t)(layer * 2 + 0) * 64 + k) * 512 + c]; }
            else if (seg == 1) { if (k >= 64 && k < 128) x = P.in[I_W2][((size_t)(layer * 2 + 1) * 64 + (k - 64)) * 512 + c]; }
            else if (seg == 2) { if (k >= 128 && k < 192) x = P.in[I_A2][((size_t)(layer * 2 + 0) * 64 + (k - 128)) * 512 + c]; }
            else if (seg == 3) { if (k >= 192 && k < 256) x = P.in[I_A2][((size_t)(layer * 2 + 1) * 64 + (k - 192)) * 512 + c]; }
            else { if (k >= 256) x = P.in[I_G2][((size_t)layer * 128 + (k - 256)) * 512 + c]; }
            v[j] = x; }
        *(uint4*)(W + WO_LR + (size_t)row * 384 + k0) = pack8(v);
    }
}

DEV void phase_rmsnorm(const Params& P0, int g, bool src_in, int gain_idx, int layer, int nrows, int nvalid, int bid, int nb, int wv) {
    Params P = load_params(); P.ws = launder_ws(P.ws);
    ROWPRO
    const float* gain = P.in[gain_idx] + layer * 1024;
    bf16_t* H = slotp(P, 0);
    for (int r = gw; r < nrows; r += ngw) {
        uint2* o8 = (uint2*)(H + (size_t)r * 1024) + lane;
        if (r >= nvalid) {
#pragma unroll
            for (int j = 0; j < 4; ++j) { const unsigned z = zero_u(); o8[64 * j] = make_uint2(z, z); }
            continue; }
        const f32x4* xr = (const f32x4*)(src_in ? x_in_row(P, g, r) : (const float*)x_cur_row(P, g, r)) + lane;
        f32x4 v[4]; float s = 0.f;
#pragma unroll
        for (int j = 0; j < 4; ++j) { v[j] = xr[64 * j]; s += (v[j].x * v[j].x + v[j].y * v[j].y) + (v[j].z * v[j].z + v[j].w * v[j].w); }
        const float rs = rsqrtf(wave_sum(s) * (1.f / 1024.f) + 1e-6f);
#pragma unroll
        for (int j = 0; j < 4; ++j) { const f32x4 gg = *((const f32x4*)gain + lane + 64 * j);
            o8[64 * j] = make_uint2(pk2(v[j].x * rs * gg.x, v[j].y * rs * gg.y), pk2(v[j].z * rs * gg.z, v[j].w * rs * gg.w)); }
    }
}
DEV void phase_da_prep(const Params& P0, int layer, int bid, int nb, int wv) {
    Params P = load_params(); P.ws = launder_ws(P.ws);
    ROWPRO
    const float inv8[8] = {1.0f, 0.19392274474868576f, 0.03760603093086393f, 0.007292664737217109f, 0.001414213562373095f, 0.0002742481756762073f, 5.318295896944988e-05f, 1.031338537721246e-05f};
    const int d0 = (lane & 7) * 8;
    float gq[8], gk[8];
#pragma unroll
    for (int j = 0; j < 8; ++j) { gq[j] = P.in[I_QN][layer * 64 + d0 + j]; gk[j] = P.in[I_KN][layer * 64 + d0 + j]; }
    for (int r = gw; r < TG; r += ngw) {
        int sl, p; pos_of(r, sl, p);
        float cs[8], sn[8];
#pragma unroll
        for (int j = 0; j < 8; ++j) { const float ang = (float)p * inv8[j]; double a = (double)ang; a -= 6.283185307179586 * __builtin_rint(a * 0.15915494309189535); const float rr = (float)a; cs[j] = __cosf(rr); sn[j] = __sinf(rr); }
#pragma unroll
        for (int which = 0; which < 2; ++which) {
            uint4* ptr = (uint4*)(slotp(P, 10 + which) + (size_t)r * 512) + lane;
            float f[8]; unpack8(*ptr, f);
            float ss = 0.f;
#pragma unroll
            for (int j = 0; j < 8; ++j) ss += f[j] * f[j];
            ss = red8(ss);
            const float rs = rsqrtf(ss * (1.f / 64.f) + 1e-6f);
#pragma unroll
            for (int j = 0; j < 8; ++j) f[j] = f[j] * rs * (which == 0 ? gq[j] : gk[j]);
#pragma unroll
            for (int j = 0; j < 8; ++j) { const float pr = __shfl_xor(f[j], 1);
                if ((lane & 7) == 0) f[j] = f[j] * cs[j] - pr * sn[j];
                else if ((lane & 7) == 1) f[j] = f[j] * cs[j] + pr * sn[j]; }
            if (which == 0) {
#pragma unroll
                for (int j = 0; j < 8; ++j) f[j] *= 0.18033688011112042f; }
            *ptr = pack8(f);
        }
    }
}
DEV void phase_conv(const Params& P0, int layer, int bid, int nb, int wv) {
    Params P = load_params(); P.ws = launder_ws(P.ws);
    ROWPRO
    const int c0 = lane * 8;
    float w0[8], w1[8], w2[8];
#pragma unroll
    for (int j = 0; j < 8; ++j) { w0[j] = P.in[I_CONV][(layer * 3 + 0) * 512 + c0 + j]; w1[j] = P.in[I_CONV][(layer * 3 + 1) * 512 + c0 + j]; w2[j] = P.in[I_CONV][(layer * 3 + 2) * 512 + c0 + j]; }
    const bf16_t* SB = slotp(P, 7); const bf16_t* SC = slotp(P, 8); const bf16_t* SH = slotp(P, 9); bf16_t* Y = slotp(P, 3);
    for (int r = gw; r < TG; r += ngw) {
        int sl, p; pos_of(r, sl, p);
        float acc[8], a[8], b[8];
        unpack8(*((const uint4*)(SC + (size_t)r * 512) + lane), a); unpack8(*((const uint4*)(SH + (size_t)r * 512) + lane), b);
#pragma unroll
        for (int j = 0; j < 8; ++j) acc[j] = a[j] * b[j] * w1[j];
        if (p > 0) { const int rp = row_of(sl, p - 1);
            unpack8(*((const uint4*)(SC + (size_t)rp * 512) + lane), a); unpack8(*((const uint4*)(SH + (size_t)rp * 512) + lane), b);
#pragma unroll
            for (int j = 0; j < 8; ++j) acc[j] += a[j] * b[j] * w0[j]; }
        if (p < LSEQ - 1) { const int rn = row_of(sl, p + 1);
            unpack8(*((const uint4*)(SC + (size_t)rn * 512) + lane), a); unpack8(*((const uint4*)(SH + (size_t)rn * 512) + lane), b);
#pragma unroll
            for (int j = 0; j < 8; ++j) acc[j] += a[j] * b[j] * w2[j]; }
        unpack8(*((const uint4*)(SB + (size_t)r * 512) + lane), a);
#pragma unroll
        for (int j = 0; j < 8; ++j) acc[j] *= a[j];
        *((uint4*)(Y + (size_t)r * 512) + lane) = pack8(acc);
    }
}
DEV void phase_rw_prep(const Params& P0, int layer, int bid, int nb, int wv) {
    Params P = load_params(); P.ws = launder_ws(P.ws);
    ROWPRO
    const float* mu = P.in[I_MU] + (size_t)layer * 1920;
    for (int r = gw; r < TG; r += ngw) {
        int sl, p; pos_of(r, sl, p);
        const int rp = p > 0 ? row_of(sl, p - 1) : -1, rn = p < LSEQ - 1 ? row_of(sl, p + 1) : -1;
#pragma unroll
        for (int grp = 0; grp < 4; ++grp) {
            if (grp == 3 && lane >= 48) break;
            const int c0 = (grp < 3 ? grp * 512 : 1536) + lane * 8;
            const bf16_t* src = slotp(P, 13 + (c0 >> 9)) + (c0 & 511);
            float u[8], up[8], un[8], xm[8];
            unpack8(*(const uint4*)(src + (size_t)r * 512), u);
            if (rp >= 0) unpack8(*(const uint4*)(src + (size_t)rp * 512), up); else {
#pragma unroll
                for (int j = 0; j < 8; ++j) up[j] = 0.f; }
            if (rn >= 0) unpack8(*(const uint4*)(src + (size_t)rn * 512), un); else {
#pragma unroll
                for (int j = 0; j < 8; ++j) un[j] = 0.f; }
#pragma unroll
            for (int j = 0; j < 8; ++j) xm[j] = u[j] + mu[c0 + j] * (0.5f * (up[j] + un[j]) - u[j]);
            if (grp < 3) {
                *((uint4*)(slotp(P, 17 + grp) + (size_t)r * 512) + lane) = pack8(xm);
                if (grp == 1) {
                    float kk[8], ss = 0.f;
#pragma unroll
                    for (int j = 0; j < 8; ++j) { kk[j] = xm[j] * P.in[I_KK][layer * 512 + c0 - 512 + j]; ss += kk[j] * kk[j]; }
                    ss = red8(ss);
                    const float inv = 1.0f / fmaxf(sqrtf(ss), 1e-12f);
#pragma unroll
                    for (int j = 0; j < 8; ++j) kk[j] *= inv;
                    *((uint4*)(slotp(P, 20) + (size_t)r * 512) + lane) = pack8(kk); }
            } else {
                const int a0 = lane * 8;
                float o[8];
#pragma unroll
                for (int j = 0; j < 8; ++j) { const float x = xm[j];
                    if (a0 < 128) { const float e = __expf(2.f * x); o[j] = 1.f - 2.f / (e + 1.f); }
                    else if (a0 < 256) o[j] = x;
                    else o[j] = 1.f / (1.f + __expf(-x)); }
                *((uint4*)(slotp(P, 21) + (size_t)r * 384) + lane) = pack8(o);
            }
        }
    }
    for (int r = TG + gw; r < TGP; r += ngw) if (lane < 48) { const unsigned z = zero_u(); *((uint4*)(slotp(P, 21) + (size_t)r * 384) + lane) = make_uint4(z, z, z, z); }
}
DEV void phase_rw_post(const Params& P0, int layer, int g, int nrows, int bid, int nb, int wv) {
    Params P = load_params(); P.ws = launder_ws(P.ws);
    ROWPRO
    const int c0 = lane * 8;
    float ka[8], rk[8], lg[8], lb[8];
#pragma unroll
    for (int j = 0; j < 8; ++j) { ka[j] = P.in[I_KA][layer * 512 + c0 + j]; rk[j] = P.in[I_RK][layer * 512 + c0 + j]; lg[j] = P.in[I_LNG][layer * 512 + c0 + j]; lb[j] = P.in[I_LNB][layer * 512 + c0 + j]; }
    for (int r = gw; r < nrows; r += ngw) {
        float of[8], ob[8], o[8];
        unpack8(*((const uint4*)(slotp(P, 15) + (size_t)r * 512) + lane), of); unpack8(*((const uint4*)(slotp(P, 16) + (size_t)r * 512) + lane), ob);
        float s = 0.f;
#pragma unroll
        for (int j = 0; j < 8; ++j) { o[j] = of[j] + ob[j]; s += o[j]; }
        const float mean = red8(s) * (1.f / 64.f);
        float q = 0.f;
#pragma unroll
        for (int j = 0; j < 8; ++j) { o[j] -= mean; q += o[j] * o[j]; }
        const float rs = rsqrtf(red8(q) * (1.f / 64.f) + 64e-5f);
        float rr[8], kk[8], vv[8], af[8], ab[8], gg[8];
        unpack8(*((const uint4*)(slotp(P, 17) + (size_t)r * 512) + lane), rr); unpack8(*((const uint4*)(slotp(P, 18) + (size_t)r * 512) + lane), kk);
        unpack8(*((const uint4*)(slotp(P, 19) + (size_t)r * 512) + lane), vv); unpack8(*((const uint4*)(slotp(P, 24) + (size_t)r * 512) + lane), af);
        unpack8(*((const uint4*)(slotp(P, 13) + (size_t)r * 512) + lane), ab); unpack8(*((const uint4*)(slotp(P, 14) + (size_t)r * 512) + lane), gg);
        float bs = 0.f;
#pragma unroll
        for (int j = 0; j < 8; ++j) { const float kd = kk[j] * (2.f + (af[j] + ab[j] - 2.f) * ka[j]); bs += rr[j] * kd * rk[j]; }
        bs = red8(bs);
        float y[8];
#pragma unroll
        for (int j = 0; j < 8; ++j) y[j] = (o[j] * rs * lg[j] + lb[j] + bs * vv[j]) * gg[j];
        const uint4 yv = pack8(y);
        *((uint4*)(slotp(P, 5) + (size_t)r * 512) + lane) = yv;
        if (layer == 0 && g < 2 && r >= TREAL) {
            bf16_t* sd = GPTR(bf16_t, P.ws + WS_SIDE) + (size_t)g * 4 * 64 * 512 + (size_t)(r - TREAL) * 512;
#pragma unroll
            for (int k = 0; k < 3; ++k) *((uint4*)(sd + (size_t)k * 64 * 512) + lane) = *((const uint4*)(slotp(P, 2 + k) + (size_t)r * 512) + lane);
            *((uint4*)(sd + (size_t)3 * 64 * 512) + lane) = yv; }
    }
    if (layer == 0 && g == 2) {
        for (int m2 = gw; m2 < 128; m2 += ngw) { const bf16_t* sd = GPTR(const bf16_t, P.ws + WS_SIDE) + (size_t)(m2 >> 6) * 4 * 64 * 512 + (size_t)(m2 & 63) * 512;
#pragma unroll
            for (int k = 0; k < 4; ++k) *((uint4*)(slotp(P, 2 + k) + (size_t)(TG + m2) * 512) + lane) = *((const uint4*)(sd + (size_t)k * 64 * 512) + lane); }
    }
}
DEV void hg_gate(float x, float lbv, float& lg, float& kk) {
    const float e = __expf(-fabsf(x)); const float sp = 1.f / (1.f + e);
    const float s = x >= 0.f ? sp : e * sp, s1 = x >= 0.f ? e * sp : sp;
    const float f = fmaxf(lbv, 1e-20f) + (1.f - lbv) * s;
    lg = __logf(f); kk = (1.f - lbv) * s1; }
DEV float hg_lb(const Params& P, int layer, int dir, int col) {
    if (layer == 0) return 0.f;
    const float a = P.in[I_LBL][(dir * 2 + 0) * 512 + col], b = P.in[I_LBL][(dir * 2 + 1) * 512 + col];
    return 1.f / (1.f + __expf(a - b)); }
DEV int hg_row(int sl, int c, int j, bool& valid) { if (c == 0) { valid = j < 16; return TREAL + sl * 16 + j; } valid = true; return sl * 4096 + (c - 1) * 64 + j; }
DEV void hg_cumsum(float* Lb, float* Bt, float* Seg, int dir, int tid) {
    const int ch = tid & 127, seg = tid >> 7;
    float v[16];
#pragma unroll
    for (int i = 0; i < 16; ++i) v[i] = Lb[(seg * 16 + i) * 128 + ch];
    if (dir == 0) {
#pragma unroll
        for (int i = 1; i < 16; ++i) v[i] += v[i - 1];
        Seg[seg * 128 + ch] = v[15];
    } else {
#pragma unroll
        for (int i = 14; i >= 0; --i) v[i] += v[i + 1];
        Seg[seg * 128 + ch] = v[0];
    }
    __syncthreads();
    const float s0 = Seg[ch], s1 = Seg[128 + ch], s2 = Seg[256 + ch], s3 = Seg[384 + ch];
    float off;
    if (dir == 0) off = seg == 0 ? 0.f : seg == 1 ? s0 : seg == 2 ? s0 + s1 : s0 + s1 + s2;
    else off = seg == 3 ? 0.f : seg == 2 ? s3 : seg == 1 ? s3 + s2 : s3 + s2 + s1;
#pragma unroll
    for (int i = 0; i < 16; ++i) Lb[(seg * 16 + i) * 128 + ch] = v[i] + off;
    if (seg == 0) Bt[ch] = (s0 + s1) + (s2 + s3);
}
DEV void phase_hg1(const Params& P0, int layer, unsigned char* lds, int bid, int nb, int wv) {
    Params P = load_params(); P.ws = launder_ws(P.ws);
    float* Lb = (float*)lds; bf16_t* KlT = (bf16_t*)(lds + 32768); bf16_t* VT = (bf16_t*)(lds + 32768 + 18432); float* Bt = (float*)(lds + 69632); float* Seg = (float*)(lds + 70656);
    bf16_t* X = slotp(P, 17); float* DC = GPTR(float, P.ws + WS_DECAY);
    const int tid = launder_tid(wv), lane = tid & 63, w = __builtin_amdgcn_readfirstlane(tid >> 6), j = tid >> 3, c0 = (tid & 7) * 16, l15 = lane & 15, quad = lane >> 4;
    for (int unit = bid; unit < 32 * 65; unit += nb) {
        const int chain = unit / 65, c = unit - chain * 65, sl = chain >> 3, head = (chain >> 1) & 3, dir = chain & 1;
        bool valid; const int r = hg_row(sl, c, j, valid);
        float lg[16], kk[16]; uint4 vv[2] = {make_uint4(0, 0, 0, 0), make_uint4(0, 0, 0, 0)};
        if (valid) {
            float fr[16];
            const uint4* fp = (const uint4*)(slotp(P, 3 + dir) + (size_t)r * 512 + head * 128 + c0);
            unpack8(fp[0], fr); unpack8(fp[1], fr + 8);
            const uint4* vp = (const uint4*)(slotp(P, 5) + (size_t)r * 512 + head * 128 + c0); vv[0] = vp[0]; vv[1] = vp[1];
#pragma unroll
            for (int e = 0; e < 16; ++e) hg_gate(fr[e], hg_lb(P, layer, dir, head * 128 + c0 + e), lg[e], kk[e]);
        } else {
#pragma unroll
            for (int e = 0; e < 16; ++e) { lg[e] = 0.f; kk[e] = 0.f; } }
#pragma unroll
        for (int e = 0; e < 16; e += 4) *(f32x4*)(Lb + j * 128 + c0 + e) = (f32x4){lg[e], lg[e + 1], lg[e + 2], lg[e + 3]};
        __syncthreads();
        hg_cumsum(Lb, Bt, Seg, dir, tid);
        __syncthreads();
        float vf[16]; unpack8(vv[0], vf); unpack8(vv[1], vf + 8);
#pragma unroll
        for (int e = 0; e < 16; ++e) { const float kl = kk[e] * __expf(Bt[c0 + e] - Lb[j * 128 + c0 + e]);
            KlT[(c0 + e) * 72 + j] = (bf16_t)(pk2(kl, 0.f) & 0xffffu); VT[(c0 + e) * 72 + j] = (bf16_t)(__float_as_uint(vf[e]) >> 16); }
        if (tid < 128) DC[(size_t)(chain * 65 + c) * 128 + tid] = __expf(Bt[tid]);
        __syncthreads();
        f32x4 acc[8];
#pragma unroll
        for (int ct = 0; ct < 8; ++ct) acc[ct] = (f32x4){0.f, 0.f, 0.f, 0.f};
#pragma unroll
        for (int ks = 0; ks < 2; ++ks) { const bf16x8 a = *(const bf16x8*)(VT + (w * 16 + l15) * 72 + ks * 32 + quad * 8);
#pragma unroll
            for (int ct = 0; ct < 8; ++ct) { const bf16x8 b = *(const bf16x8*)(KlT + (ct * 16 + l15) * 72 + ks * 32 + quad * 8); acc[ct] = mfma16(b, a, acc[ct]); } }
        bf16_t* xo = X + (size_t)(chain * 65 + c) * 16384;
#pragma unroll
        for (int ct = 0; ct < 8; ++ct) *(uint2*)(xo + (w * 16 + l15) * 128 + ct * 16 + quad * 4) = make_uint2(pk2(acc[ct][0], acc[ct][1]), pk2(acc[ct][2], acc[ct][3]));
        __syncthreads();
    }
}
DEV void phase_hg2(const Params& P0, int bid, int nb, int wv) {
    Params P = load_params(); P.ws = launder_ws(P.ws);
    const int gtid = bid * 512 + launder_tid(wv), gth = nb * 512;
    uint2* X = (uint2*)slotp(P, 17); const f32x4* DC = GPTR(const f32x4, P.ws + WS_DECAY);
    for (int e = gtid; e < 32 * 4096; e += gth) {
        const int chain = e >> 12, e4 = e & 4095, dir = chain & 1;
        f32x4 S = (f32x4){0.f, 0.f, 0.f, 0.f};
#pragma unroll 5
        for (int step = 0; step < 65; ++step) { const int c = dir ? 64 - step : step;
            const size_t idx = (size_t)(chain * 65 + c) * 4096 + e4;
            const uint2 kvw = X[idx]; const f32x4 dc = DC[(size_t)(chain * 65 + c) * 32 + (e4 & 31)];
            const f32x4 kv = (f32x4){__uint_as_float(kvw.x << 16), __uint_as_float(kvw.x & 0xffff0000u), __uint_as_float(kvw.y << 16), __uint_as_float(kvw.y & 0xffff0000u)};
            X[idx] = make_uint2(pk2(S[0], S[1]), pk2(S[2], S[3])); S = dc * S + kv; }
    }
}
DEV void phase_hg3(const Params& P0, int layer, unsigned char* lds, int bid, int nb, int wv) {
    Params P = load_params(); P.ws = launder_ws(P.ws);
    float* Lb = (float*)lds; bf16_t* Qs = (bf16_t*)(lds + 32768); bf16_t* Ks = (bf16_t*)(lds + 50176); bf16_t* Am = (bf16_t*)(lds + 67584);
    bf16_t* VT = (bf16_t*)(lds + 76800); bf16_t* Sb = (bf16_t*)(lds + 95232); float* Bt = (float*)(lds + 130048); float* Seg = (float*)(lds + 132096); float* Ost = (float*)lds;
    const bf16_t* X = slotp(P, 17);
    const int tid = launder_tid(wv), lane = tid & 63, w = __builtin_amdgcn_readfirstlane(tid >> 6), j = tid >> 3, c0 = (tid & 7) * 16, l15 = lane & 15, quad = lane >> 4;
    const int tt = w >> 1, st0 = (w & 1) * 2, vt0 = (w & 1) * 4;
    const int cfirst = layer == 0 ? 0 : 1;
    const int ncb = 65 - cfirst;
    for (int unit = bid; unit < 16 * ncb; unit += nb) {
        const int sh = unit / ncb, c = unit - sh * ncb + cfirst, sl = sh >> 2, head = sh & 3;
        bool valid; const int r = hg_row(sl, c, j, valid);
        float q[16]; uint4 gv[2] = {make_uint4(0, 0, 0, 0), make_uint4(0, 0, 0, 0)};
        if (valid) {
            const uint4* qp = (const uint4*)(slotp(P, 2) + (size_t)r * 512 + head * 128 + c0); unpack8(qp[0], q); unpack8(qp[1], q + 8);
            const uint4* vp = (const uint4*)(slotp(P, 5) + (size_t)r * 512 + head * 128 + c0); float vf[16]; unpack8(vp[0], vf); unpack8(vp[1], vf + 8);
#pragma unroll
            for (int e = 0; e < 16; ++e) VT[(c0 + e) * 72 + j] = (bf16_t)(__float_as_uint(vf[e]) >> 16);
            const uint4* gp = (const uint4*)(slotp(P, 6) + (size_t)r * 512 + head * 128 + c0); gv[0] = gp[0]; gv[1] = gp[1];
        } else {
#pragma unroll
            for (int e = 0; e < 16; ++e) { q[e] = 0.f; VT[(c0 + e) * 72 + j] = 0; } }
        f32x4 accA[2], accO[4];
#pragma unroll
        for (int i = 0; i < 2; ++i) accA[i] = (f32x4){0.f, 0.f, 0.f, 0.f};
#pragma unroll
        for (int i = 0; i < 4; ++i) accO[i] = (f32x4){0.f, 0.f, 0.f, 0.f};
#pragma unroll 1
        for (int dir = 0; dir < 2; ++dir) {
            float lg[16], kk[16];
            if (valid) { float fr[16];
                const uint4* fp = (const uint4*)(slotp(P, 3 + dir) + (size_t)r * 512 + head * 128 + c0); unpack8(fp[0], fr); unpack8(fp[1], fr + 8);
#pragma unroll
                for (int e = 0; e < 16; ++e) hg_gate(fr[e], hg_lb(P, layer, dir, head * 128 + c0 + e), lg[e], kk[e]);
            } else {
#pragma unroll
                for (int e = 0; e < 16; ++e) { lg[e] = 0.f; kk[e] = 0.f; } }
#pragma unroll
            for (int e = 0; e < 16; e += 4) *(f32x4*)(Lb + j * 128 + c0 + e) = (f32x4){lg[e], lg[e + 1], lg[e + 2], lg[e + 3]};
            __syncthreads();
            hg_cumsum(Lb, Bt, Seg, dir, tid);
            __syncthreads();
            {
                float qs[16], ks[16];
#pragma unroll
                for (int e = 0; e < 16; ++e) { const float b = Lb[j * 128 + c0 + e], rf = Lb[32 * 128 + c0 + e]; qs[e] = q[e] * __expf(b - rf); ks[e] = kk[e] * __expf(rf - b); }
                *(uint4*)(Qs + j * 136 + c0) = pack8(qs); *(uint4*)(Qs + j * 136 + c0 + 8) = pack8(qs + 8);
                *(uint4*)(Ks + j * 136 + c0) = pack8(ks); *(uint4*)(Ks + j * 136 + c0 + 8) = pack8(ks + 8);
            }
            {
                const int chain = sl * 8 + head * 2 + dir; const uint4* xs = (const uint4*)(X + (size_t)(chain * 65 + c) * 16384 + (size_t)(tid >> 2) * 128 + (tid & 3) * 32);
#pragma unroll
                for (int i = 0; i < 4; ++i) *(uint4*)(Sb + (tid >> 2) * 136 + (tid & 3) * 32 + i * 8) = xs[i];
            }
            __syncthreads();
            {
                f32x4 t0 = (f32x4){0.f, 0.f, 0.f, 0.f}, t1 = t0;
#pragma unroll
                for (int k4 = 0; k4 < 4; ++k4) { const bf16x8 a = *(const bf16x8*)(Qs + (tt * 16 + l15) * 136 + k4 * 32 + quad * 8);
                    const bf16x8 b0 = *(const bf16x8*)(Ks + ((st0 + 0) * 16 + l15) * 136 + k4 * 32 + quad * 8); const bf16x8 b1 = *(const bf16x8*)(Ks + ((st0 + 1) * 16 + l15) * 136 + k4 * 32 + quad * 8);
                    t0 = mfma16(a, b0, t0); t1 = mfma16(a, b1, t1); }
#pragma unroll
                for (int jj = 0; jj < 4; ++jj) { const int t = tt * 16 + quad * 4 + jj, s0 = (st0 + 0) * 16 + l15, s1 = (st0 + 1) * 16 + l15;
                    const bool k0 = dir == 0 ? s0 <= t : s0 >= t, k1 = dir == 0 ? s1 <= t : s1 >= t;
                    accA[0][jj] += k0 ? t0[jj] : 0.f; accA[1][jj] += k1 ? t1[jj] : 0.f; }
            }
            __syncthreads();
            {   float qg[16];
#pragma unroll
                for (int e = 0; e < 16; ++e) qg[e] = q[e] * __expf(Lb[j * 128 + c0 + e]);
                *(uint4*)(Qs + j * 136 + c0) = pack8(qg); *(uint4*)(Qs + j * 136 + c0 + 8) = pack8(qg + 8); }
            __syncthreads();
#pragma unroll
            for (int k4 = 0; k4 < 4; ++k4) { const bf16x8 a = *(const bf16x8*)(Qs + (tt * 16 + l15) * 136 + k4 * 32 + quad * 8);
#pragma unroll
                for (int v4 = 0; v4 < 4; ++v4) { const bf16x8 b = *(const bf16x8*)(Sb + ((vt0 + v4) * 16 + l15) * 136 + k4 * 32 + quad * 8); accO[v4] = mfma16(a, b, accO[v4]); } }
            __syncthreads();
        }
#pragma unroll
        for (int s2 = 0; s2 < 2; ++s2)
#pragma unroll
            for (int jj = 0; jj < 4; ++jj) Am[(tt * 16 + quad * 4 + jj) * 72 + (st0 + s2) * 16 + l15] = (bf16_t)(pk2(accA[s2][jj], 0.f) & 0xffffu);
        __syncthreads();
#pragma unroll
        for (int ks = 0; ks < 2; ++ks) { const bf16x8 a = *(const bf16x8*)(Am + (tt * 16 + l15) * 72 + ks * 32 + quad * 8);
#pragma unroll
            for (int v4 = 0; v4 < 4; ++v4) { const bf16x8 b = *(const bf16x8*)(VT + ((vt0 + v4) * 16 + l15) * 72 + ks * 32 + quad * 8); accO[v4] = mfma16(a, b, accO[v4]); } }
#pragma unroll
        for (int v4 = 0; v4 < 4; ++v4)
#pragma unroll
            for (int jj = 0; jj < 4; ++jj) Ost[(tt * 16 + quad * 4 + jj) * 132 + (vt0 + v4) * 16 + l15] = accO[v4][jj];
        __syncthreads();
        {   float o[16], ss = 0.f;
#pragma unroll
            for (int e = 0; e < 16; ++e) { o[e] = Ost[j * 132 + c0 + e]; ss += o[e] * o[e]; }
            ss = red8(ss);
            const float rs = rsqrtf(ss * (1.f / 128.f) + 1e-6f);
            float gf[16]; unpack8(gv[0], gf); unpack8(gv[1], gf + 8);
#pragma unroll
            for (int e = 0; e < 16; ++e) { const float gg = gf[e]; o[e] = o[e] * rs * P.in[I_ONORM][layer * 512 + head * 128 + c0 + e] * (gg / (1.f + __expf(-gg))); }
            if (valid) { uint4* yp = (uint4*)(slotp(P, 2) + (size_t)r * 512 + head * 128 + c0); yp[0] = pack8(o); yp[1] = pack8(o + 8); }
        }
        __syncthreads();
    }
}
DEV void phase_vtrans(const Params& P0, unsigned char* lds, int bid, int nb, int wv) {
    Params P = load_params(); P.ws = launder_ws(P.ws);
    bf16_t* T = (bf16_t*)lds;
    const bf16_t* V = slotp(P, 12); bf16_t* VTg = slotp(P, 6);
    const int tid = launder_tid(wv);
    for (int unit = bid; unit < 4 * 65 * 8; unit += nb) {
        const int sl = unit / 520, rem = unit - sl * 520, pt = rem >> 3, vdt = rem & 7;
        { const int tok = tid >> 3, c8 = (tid & 7) * 8, p = pt * 64 + tok;
          uint4 v = make_uint4(0, 0, 0, 0);
          if (p < LSEQ) v = *(const uint4*)(V + (size_t)row_of(sl, p) * 512 + vdt * 64 + c8);
          *(uint4*)(T + tok * 72 + c8) = v; }
        __syncthreads();
        { const int vd = tid >> 3, t8 = (tid & 7) * 8;
          unsigned short e[8];
#pragma unroll
          for (int i = 0; i < 8; ++i) { const int pp = t8 + i; const int sp = (pp & ~12) | (((pp >> 2) & 1) << 3) | (((pp >> 3) & 1) << 2); e[i] = T[sp * 72 + vd]; }
          uint4 o; o.x = e[0] | ((unsigned)e[1] << 16); o.y = e[2] | ((unsigned)e[3] << 16); o.z = e[4] | ((unsigned)e[5] << 16); o.w = e[6] | ((unsigned)e[7] << 16);
          *(uint4*)(VTg + (size_t)(sl * 512 + vdt * 64 + vd) * 4160 + pt * 64 + t8) = o; }
        __syncthreads();
    }
}
DEV int crow(int r, int hi) { return (r & 3) + 8 * (r >> 2) + 4 * hi; }
typedef unsigned u32x4_t __attribute__((ext_vector_type(4)));
struct AttnStage { u32x4_t k0, k1, v0, v1; };
DEV void attn_stage_load(const Params& P, int sl, int head, int kt, int tid, AttnStage& st) {
    const bf16_t* Kg = slotp(P, 11); const bf16_t* VTg = slotp(P, 6);
    { const int ci = tid, krow = ci >> 4, kc = ci & 15; const int p = kt * 64 + krow; const int r = p < LSEQ ? row_of(sl, p) : 0; st.k0 = GLD16(Kg + (size_t)r * 512 + head * 128 + kc * 8); }
    { const int ci = tid + 512, krow = ci >> 4, kc = ci & 15; const int p = kt * 64 + krow; const int r = p < LSEQ ? row_of(sl, p) : 0; st.k1 = GLD16(Kg + (size_t)r * 512 + head * 128 + kc * 8); }
    { const int vi = tid, vrow = vi >> 3, vc = vi & 7; st.v0 = GLD16(VTg + (size_t)(sl * 512 + head * 128 + vrow) * 4160 + kt * 64 + vc * 8); }
    { const int vi = tid + 512, vrow = vi >> 3, vc = vi & 7; st.v1 = GLD16(VTg + (size_t)(sl * 512 + head * 128 + vrow) * 4160 + kt * 64 + vc * 8); }
}
DEV void attn_stage_store(unsigned char* buf, int tid, const AttnStage& st) {
    bf16_t* Kt = (bf16_t*)buf; bf16_t* Vt = (bf16_t*)(buf + 17408);
    { const int ci = tid, krow = ci >> 4, kc = ci & 15; *(u32x4_t*)(Kt + krow * 136 + kc * 8) = st.k0; }
    { const int ci = tid + 512, krow = ci >> 4, kc = ci & 15; *(u32x4_t*)(Kt + krow * 136 + kc * 8) = st.k1; }
    { const int vi = tid, vrow = vi >> 3, vc = vi & 7; *(u32x4_t*)(Vt + vrow * 72 + vc * 8) = st.v0; }
    { const int vi = tid + 512, vrow = vi >> 3, vc = vi & 7; *(u32x4_t*)(Vt + vrow * 72 + vc * 8) = st.v1; }
}
DEV void phase_attn(const Params& P0, int layer, unsigned char* lds, int ua, int ub, int uc, int wv) {
    Params P = load_params(); P.ws = launder_ws(P.ws);
    const int tid = launder_tid(wv), lane = tid & 63, w = __builtin_amdgcn_readfirstlane(tid >> 6), map = w >> 2, qsub = w & 3, qi = lane & 31, hi = lane >> 5;
    const float lam_init = layer == 0 ? 0.2f : 0.35550906759096934f;
    float lam;
    { const float* lp = P.in[I_LAM] + (size_t)layer * 256; float s1 = 0.f, s2 = 0.f;
      for (int i = 0; i < 64; ++i) { s1 += lp[i] * lp[64 + i]; s2 += lp[128 + i] * lp[192 + i]; }
      lam = __expf(s1) - __expf(s2) + lam_init; }
    float* Ex = (float*)lds;
#pragma unroll 1
    for (int ui = 0; ui < 3; ++ui) {
        int unit = ui == 0 ? ua : (ui == 1 ? ub : uc);
        if (unit < 0) continue;
        const int ucode = unit; unit = ucode & 4095; const int hmode = ucode >> 12;
        const int sh = unit < 512 ? (unit >> 5) : unit - 512, qb = unit < 512 ? (unit & 31) : 32, sl = sh >> 2, head = sh & 3;
        const int qrow0 = qb < 32 ? sl * 4096 + qb * 128 : TREAL + sl * 16; const int nvalid = qb < 32 ? 128 : 16;
        const bool active = (qsub * 32 < nvalid) && (hmode == 0 || hmode >= 3 || (qsub >> 1) == hmode - 1);
        bf16x8 Qf[4];
        { const bf16_t* qp = slotp(P, 10) + (size_t)(qrow0 + qsub * 32 + qi) * 512 + head * 128 + map * 64 + hi * 8;
#pragma unroll
          for (int ds = 0; ds < 4; ++ds) Qf[ds] = __builtin_bit_cast(bf16x8, GLD16(qp + ds * 16)); }
        AttnStage st;
        const int kt0 = hmode == 4 ? 33 : 0, kt1 = hmode == 3 ? 33 : 65;
        attn_stage_load(P, sl, head, kt0, tid, st); attn_stage_store(lds + (kt0 & 1) * 35840, tid, st); attn_stage_load(P, sl, head, kt0 + 1, tid, st);
        __syncthreads();
        f32x16 O[4];
#pragma unroll
        for (int v = 0; v < 4; ++v)
#pragma unroll
            for (int r = 0; r < 16; ++r) O[v][r] = 0.f;
        float m_run = -INFINITY, l_run = 0.f;
#pragma unroll 1
        for (int kt = kt0; kt < kt1; ++kt) {
            if (kt + 1 < kt1) attn_stage_store(lds + ((kt + 1) & 1) * 35840, tid, st);
            if (kt + 2 < kt1) attn_stage_load(P, sl, head, kt + 2, tid, st);
            const unsigned char* buf = lds + (kt & 1) * 35840;
            const bf16_t* Kb = (const bf16_t*)buf; const bf16_t* Vb = (const bf16_t*)(buf + 17408);
            if (active) {
            f32x16 S0, S1;
            {   const f32x16 zero16 = {0.f, 0.f, 0.f, 0.f, 0.f, 0.f, 0.f, 0.f, 0.f, 0.f, 0.f, 0.f, 0.f, 0.f, 0.f, 0.f};
                bf16x8 ka[4], kb[4];
#pragma unroll
                for (int ds = 0; ds < 4; ++ds) { ka[ds] = *(const bf16x8*)(Kb + qi * 136 + map * 64 + ds * 16 + hi * 8); kb[ds] = *(const bf16x8*)(Kb + (32 + qi) * 136 + map * 64 + ds * 16 + hi * 8); }
                __builtin_amdgcn_sched_barrier(0);
                S0 = mfma32(ka[0], Qf[0], zero16); S1 = mfma32(kb[0], Qf[0], zero16);
#pragma unroll
                for (int ds = 1; ds < 4; ++ds) { S0 = mfma32(ka[ds], Qf[ds], S0); S1 = mfma32(kb[ds], Qf[ds], S1); } }
            if (__builtin_expect(__builtin_amdgcn_readfirstlane(kt) == 64, 0)) {
#pragma unroll
                for (int r = 0; r < 16; ++r) { if (crow(r, hi) >= 16) S0[r] = -INFINITY; S1[r] = -INFINITY; }
                asm volatile("" : "+v"(S0), "+v"(S1)); }
            float mx = -INFINITY;
#pragma unroll
            for (int r = 0; r < 16; ++r) mx = fmaxf(mx, fmaxf(S0[r], S1[r]));
            { const auto sw = __builtin_amdgcn_permlane32_swap(__float_as_uint(mx), __float_as_uint(mx), false, false); mx = fmaxf(__uint_as_float(sw[0]), __uint_as_float(sw[1])); }
            const float m_new = fmaxf(m_run, mx); const float alpha = __builtin_amdgcn_exp2f(m_run - m_new); m_run = m_new;
            float ps = 0.f;
#pragma unroll
            for (int r = 0; r < 16; ++r) { S0[r] = __builtin_amdgcn_exp2f(S0[r] - m_new); S1[r] = __builtin_amdgcn_exp2f(S1[r] - m_new); ps += S0[r] + S1[r]; }
            l_run = l_run * alpha + ps;
            if (__builtin_amdgcn_ballot_w64(alpha != 1.0f) != 0ull) {
#pragma unroll
                for (int v = 0; v < 4; ++v)
#pragma unroll
                    for (int r = 0; r < 16; ++r) O[v][r] *= alpha; }
            bf16x8 pf[2][2];
#pragma unroll
            for (int half = 0; half < 2; ++half) {
                uint4 a, b;
                a.x = pk2(S0[half * 8 + 0], S0[half * 8 + 1]); a.y = pk2(S0[half * 8 + 2], S0[half * 8 + 3]); a.z = pk2(S0[half * 8 + 4], S0[half * 8 + 5]); a.w = pk2(S0[half * 8 + 6], S0[half * 8 + 7]);
                b.x = pk2(S1[half * 8 + 0], S1[half * 8 + 1]); b.y = pk2(S1[half * 8 + 2], S1[half * 8 + 3]); b.z = pk2(S1[half * 8 + 4], S1[half * 8 + 5]); b.w = pk2(S1[half * 8 + 6], S1[half * 8 + 7]);
                pf[0][half] = __builtin_bit_cast(bf16x8, a); pf[1][half] = __builtin_bit_cast(bf16x8, b); }
            {   bf16x8 av[4], nx[4];
#pragma unroll
                for (int f = 0; f < 4; ++f) av[f] = *(const bf16x8*)(Vb + qi * 72 + (f >> 1) * 32 + (f & 1) * 16 + hi * 8);
                __builtin_amdgcn_sched_barrier(0);
#pragma unroll
                for (int v = 0; v < 4; ++v) {
                    if (v < 3) {
#pragma unroll
                        for (int f = 0; f < 4; ++f) nx[f] = *(const bf16x8*)(Vb + ((v + 1) * 32 + qi) * 72 + (f >> 1) * 32 + (f & 1) * 16 + hi * 8); }
                    __builtin_amdgcn_sched_barrier(0);
#pragma unroll
                    for (int f = 0; f < 4; ++f) O[v] = mfma32(av[f], pf[f >> 1][f & 1], O[v]);
                    if (v < 3) {
#pragma unroll
                        for (int f = 0; f < 4; ++f) av[f] = nx[f]; }
                }
            }
            }
            __syncthreads();
        }
        const float l_tot = l_run + __shfl_xor(l_run, 32); const float inv = 1.0f / l_tot;
        if (hmode >= 3) {
            float* pt = (float*)slotp(P, 22) + ((size_t)(((unit - 448) * 2 + (hmode - 3)) * 2 + map) * 128 + qsub * 32 + qi) * 130;
#pragma unroll
            for (int v = 0; v < 4; ++v)
#pragma unroll
                for (int rg = 0; rg < 4; ++rg) { float* d = pt + v * 32 + 8 * rg + 4 * hi; d[0] = O[v][rg * 4 + 0]; d[1] = O[v][rg * 4 + 1]; d[2] = O[v][rg * 4 + 2]; d[3] = O[v][rg * 4 + 3]; }
            if (hi == 0) { pt[128] = m_run; pt[129] = l_tot; }
            __syncthreads();
            continue; }
        if (map == 1) {
#pragma unroll
            for (int v = 0; v < 4; ++v)
#pragma unroll
                for (int r = 0; r < 16; ++r) Ex[(qsub * 32 + qi) * 132 + v * 32 + crow(r, hi)] = O[v][r] * inv; }
        __syncthreads();
        if (map == 0) {
            float ss = 0.f;
#pragma unroll
            for (int v = 0; v < 4; ++v)
#pragma unroll
                for (int r = 0; r < 16; ++r) { const float o = O[v][r] * inv - lam * Ex[(qsub * 32 + qi) * 132 + v * 32 + crow(r, hi)]; O[v][r] = o; ss += o * o; }
            ss += __shfl_xor(ss, 32);
            const float rs = rsqrtf(ss * (1.f / 128.f) + 1e-5f) * (1.f - lam_init);
            if (active && qsub * 32 + qi < nvalid) {
                bf16_t* yp = slotp(P, 4) + (size_t)(qrow0 + qsub * 32 + qi) * 512 + head * 128;
#pragma unroll
                for (int v = 0; v < 4; ++v)
#pragma unroll
                    for (int rg = 0; rg < 4; ++rg) { const int vd0 = v * 32 + 8 * rg + 4 * hi; const f32x4 gg = *(const f32x4*)(P.in[I_SUBLN] + layer * 128 + vd0);
                        uint2 o; o.x = pk2(O[v][rg * 4 + 0] * rs * gg[0], O[v][rg * 4 + 1] * rs * gg[1]); o.y = pk2(O[v][rg * 4 + 2] * rs * gg[2], O[v][rg * 4 + 3] * rs * gg[3]);
                        *(uint2*)(yp + vd0) = o; } }
        }
        __syncthreads();
    }
}
DEV float dpp_f(float x, const int ctrl) { return x; }
template <int CTRL> DEV float dppmov(float x) { return __builtin_bit_cast(float, __builtin_amdgcn_update_dpp(0, __builtin_bit_cast(int, x), CTRL, 0xf, 0xf, true)); }
DEV float sum16(float x) { x += dppmov<0xB1>(x); x += dppmov<0x4E>(x); x += dppmov<0x141>(x); x += dppmov<0x140>(x); return x; }
constexpr int RW_CH = 16, RW_BUF_F = 5120 + 256 + 4096, RW_BUFB = RW_BUF_F * 4;
struct RwRegs { u32x4_t r, k, kk, e, a, v; };
DEV void unpack8v(const u32x4_t w, float* f) { unpack8(make_uint4(w.x, w.y, w.z, w.w), f); }
DEV void rw_stage_load(const Params& P, RwRegs& g, int sl, int head, int dir, int qr, int ck, int t) {
    if (t < 128) { const int step = t >> 3, ch8 = (t & 7) * 8, sidx = ck * RW_CH + step;
        if (sidx < LSEQ) { const int p = dir ? LSEQ - 1 - sidx : sidx; const size_t ro = (size_t)row_of(sl, p) * 512 + head * 64 + ch8;
            g.r = *(const u32x4_t*)(slotp(P, 17) + ro); g.k = *(const u32x4_t*)(slotp(P, 18) + ro); g.kk = *(const u32x4_t*)(slotp(P, 20) + ro);
            g.e = *(const u32x4_t*)(slotp(P, 22 + dir) + ro); g.a = *(const u32x4_t*)(slotp(P, dir == 0 ? 24 : 13) + ro); } }
    if (t < 32) { const int tt = t, s2 = tt >> 1, r8 = (tt & 1) * 8, si2 = ck * RW_CH + s2;
        if (si2 < LSEQ) { const int p2 = dir ? LSEQ - 1 - si2 : si2; g.v = *(const u32x4_t*)(slotp(P, 19) + (size_t)row_of(sl, p2) * 512 + head * 64 + qr * 16 + r8); } }
}
DEV void rw_stage_write(const Params& P, int layer, unsigned char* buf, const RwRegs& g, int head, int ck, int t) {
    float* Rr = (float*)buf; float* Ww = Rr + 1024; float* Kd = Ww + 1024; float* Kk = Kd + 1024; float* Bb = Kk + 1024; float* Vs = Bb + 1024;
    if (t < 128) { const int step = t >> 3, ch8 = (t & 7) * 8, sidx = ck * RW_CH + step;
        if (sidx < LSEQ) {
            float r[8], k[8], kk[8], e[8], a[8];
            unpack8v(g.r, r); unpack8v(g.k, k); unpack8v(g.kk, kk); unpack8v(g.e, e); unpack8v(g.a, a);
            float ww[8], kd[8], bb[8];
#pragma unroll
            for (int j = 0; j < 8; ++j) { ww[j] = __expf(-e[j]); kd[j] = k[j] * (1.f + (a[j] - 1.f) * P.in[I_KA][layer * 512 + head * 64 + ch8 + j]); bb[j] = kk[j] * a[j]; }
            const int o = step * 64 + ch8;
            *(f32x4*)(Rr + o) = (f32x4){r[0], r[1], r[2], r[3]}; *(f32x4*)(Rr + o + 4) = (f32x4){r[4], r[5], r[6], r[7]};
            *(f32x4*)(Ww + o) = (f32x4){ww[0], ww[1], ww[2], ww[3]}; *(f32x4*)(Ww + o + 4) = (f32x4){ww[4], ww[5], ww[6], ww[7]};
            *(f32x4*)(Kd + o) = (f32x4){kd[0], kd[1], kd[2], kd[3]}; *(f32x4*)(Kd + o + 4) = (f32x4){kd[4], kd[5], kd[6], kd[7]};
            *(f32x4*)(Kk + o) = (f32x4){kk[0], kk[1], kk[2], kk[3]}; *(f32x4*)(Kk + o + 4) = (f32x4){kk[4], kk[5], kk[6], kk[7]};
            *(f32x4*)(Bb + o) = (f32x4){bb[0], bb[1], bb[2], bb[3]}; *(f32x4*)(Bb + o + 4) = (f32x4){bb[4], bb[5], bb[6], bb[7]};
        } }
    if (t < 32) { const int tt = t, s2 = tt >> 1, r8 = (tt & 1) * 8, si2 = ck * RW_CH + s2;
        if (si2 < LSEQ) { float v[8]; unpack8v(g.v, v);
            *(f32x4*)(Vs + s2 * 16 + r8) = (f32x4){v[0], v[1], v[2], v[3]}; *(f32x4*)(Vs + s2 * 16 + r8 + 4) = (f32x4){v[4], v[5], v[6], v[7]}; } }
}
DEV void rw_flush(const Params& P, const unsigned char* buf, int sl, int head, int dir, int qr, int ck, int t) {
    if (t >= 160 && t < 192) { const float* Op = (const float*)buf + 5376; const int tt = t - 160, s2 = tt >> 1, r8 = (tt & 1) * 8, sidx = ck * RW_CH + s2;
        if (sidx < LSEQ) { const int p = dir ? LSEQ - 1 - sidx : sidx; float o[8];
#pragma unroll
            for (int j = 0; j < 8; ++j) { const int row = r8 + j; const f32x4* q = (const f32x4*)(Op + s2 * 256 + (row >> 2) * 64 + (row & 3) * 16);
                const f32x4 a = q[0], b = q[1], c = q[2], d = q[3];
                o[j] = ((a[0] + a[1]) + (a[2] + a[3])) + ((b[0] + b[1]) + (b[2] + b[3])) + (((c[0] + c[1]) + (c[2] + c[3])) + ((d[0] + d[1]) + (d[2] + d[3]))); }
            *(uint4*)(slotp(P, 15 + dir) + (size_t)row_of(sl, p) * 512 + head * 64 + qr * 16 + r8) = pack8(o); } }
}
DEV void phase_rw_scan(const Params& P0, int layer, unsigned char* lds, int bid, int nb, int wv) {
    Params P = load_params(); P.ws = launder_ws(P.ws);
    const int tid = launder_tid(wv), lane = tid & 63, w = __builtin_amdgcn_readfirstlane(tid >> 6), li = lane & 15, rl = (w & 3) * 4 + (lane >> 4);
    constexpr int NCK = (LSEQ + RW_CH - 1) / RW_CH;
    typedef float f32x2 __attribute__((ext_vector_type(2)));
    for (int unit = bid; unit < 256; unit += nb) {
        const int sl = unit >> 6, head = (unit >> 3) & 7, dir = (unit >> 2) & 1, qr = unit & 3;
        f32x2 SA = (f32x2){0.f, 0.f}, SB = (f32x2){0.f, 0.f};
        RwRegs g; g.r = g.k = g.kk = g.e = g.a = g.v = (u32x4_t){0u, 0u, 0u, 0u};
        if (w >= 4) { rw_stage_load(P, g, sl, head, dir, qr, 0, tid - 256); rw_stage_write(P, layer, lds, g, head, 0, tid - 256); rw_stage_load(P, g, sl, head, dir, qr, 1, tid - 256); }
        __syncthreads();
#pragma unroll 1
        for (int ck = 0; ck < NCK; ++ck) {
            unsigned char* buf = lds + (ck & 1) * RW_BUFB;
            if (w >= 4) {
                if (ck + 1 < NCK) rw_stage_write(P, layer, lds + ((ck + 1) & 1) * RW_BUFB, g, head, ck + 1, tid - 256);
                if (ck + 2 < NCK) rw_stage_load(P, g, sl, head, dir, qr, ck + 2, tid - 256);
                if (ck > 0) rw_flush(P, lds + ((ck - 1) & 1) * RW_BUFB, sl, head, dir, qr, ck - 1, tid - 256);
            } else {
                const float* Rr = (const float*)buf + li * 4; const float* Vs = (const float*)buf + 5120 + rl; float* Op = (float*)buf + 5376 + w * 64 + lane;
                const int ns = (LSEQ - ck * RW_CH) < RW_CH ? (LSEQ - ck * RW_CH) : RW_CH;
                f32x4 rr = *(const f32x4*)(Rr), ww = *(const f32x4*)(Rr + 1024), kd = *(const f32x4*)(Rr + 2048), kk = *(const f32x4*)(Rr + 3072), bb = *(const f32x4*)(Rr + 4096); float vv = Vs[0];
#pragma unroll 2
                for (int i = 0; i < ns; ++i) {
                    const int in = i < RW_CH - 1 ? i + 1 : RW_CH - 1;
                    const f32x4 rr_n = *(const f32x4*)(Rr + in * 64), ww_n = *(const f32x4*)(Rr + 1024 + in * 64), kd_n = *(const f32x4*)(Rr + 2048 + in * 64);
                    const f32x4 kk_n = *(const f32x4*)(Rr + 3072 + in * 64), bb_n = *(const f32x4*)(Rr + 4096 + in * 64); const float vv_n = Vs[in * 16];
                    f32x2 p = SA * (f32x2){kk[0], kk[1]}; p = __builtin_elementwise_fma(SB, (f32x2){kk[2], kk[3]}, p);
                    const f32x2 vv2 = (f32x2){vv, vv};
                    const f32x2 ta = vv2 * (f32x2){kd[0], kd[1]}, tb = vv2 * (f32x2){kd[2], kd[3]};
                    const float sa = -sum16(p[0] + p[1]);
                    const f32x2 sa2 = (f32x2){sa, sa};
                    SA = __builtin_elementwise_fma(SA, (f32x2){ww[0], ww[1]}, __builtin_elementwise_fma(sa2, (f32x2){bb[0], bb[1]}, ta));
                    SB = __builtin_elementwise_fma(SB, (f32x2){ww[2], ww[3]}, __builtin_elementwise_fma(sa2, (f32x2){bb[2], bb[3]}, tb));
                    f32x2 q = SA * (f32x2){rr[0], rr[1]}; q = __builtin_elementwise_fma(SB, (f32x2){rr[2], rr[3]}, q);
                    Op[i * 256] = q[0] + q[1];
                    rr = rr_n; ww = ww_n; kd = kd_n; kk = kk_n; bb = bb_n; vv = vv_n;
                }
            }
            __syncthreads();
        }
        if (w >= 4) rw_flush(P, lds + ((NCK - 1) & 1) * RW_BUFB, sl, head, dir, qr, NCK - 1, tid - 256);
        __syncthreads();
    }
}
static_assert(LSEQ == 257 * 16, "chunked RWKV assumes whole 16-step chunks");
constexpr int RWC_REC = 8960, RWC_NCK = 257;
DEV unsigned char* rwc_rec(const Params& P, int dir, int idx) {
    const int gi = dir * 8224 + idx;
    if (gi < 1901) return (unsigned char*)slotp(P, 5) + (size_t)gi * RWC_REC;
    if (gi < 7606) return (unsigned char*)slotp(P, 7) + (size_t)(gi - 1901) * RWC_REC;
    if (gi < 9507) return (unsigned char*)slotp(P, 12) + (size_t)(gi - 7606) * RWC_REC;
    if (gi < 11408) return (unsigned char*)slotp(P, 21) + (size_t)(gi - 9507) * RWC_REC;
    return GPTR(unsigned char, P.ws + WS_SLOTS + 25 * SLOT_B + (size_t)(gi - 11408) * RWC_REC); }
DEV int rwc_slot(int c) { return (((c >> 5) * 4 + ((c >> 2) & 3)) * 8) + ((c >> 4) & 1) * 4 + (c & 3); }
DEV void phase_rwc_pre(const Params& P0, int layer, unsigned char* lds, int bid, int nb, int wv) {
    Params P = load_params(); P.ws = launder_ws(P.ws);
    const int tid = launder_tid(wv), lane = tid & 63, w = __builtin_amdgcn_readfirstlane(tid >> 6), l15 = lane & 15, quad = lane >> 4;
    unsigned char* wl = lds + w * 15616;
    bf16_t* Bt = (bf16_t*)wl; bf16_t* Dt = Bt + 16 * 72; bf16_t* Ak = Dt + 16 * 72; bf16_t* Rt = Ak + 16 * 72;
    float* Mb = (float*)(wl + 9216); float* Md = Mb + 256; float* Gb = Md + 256; float* Gd = Gb + 256; float* Tm = Gd + 256; float* Nm = Tm + 256;
    const float ka = P.in[I_KA][layer * 512 + 0];  (void)ka;
    for (int unit2 = bid * 8 + w; unit2 < 2 * 32 * RWC_NCK; unit2 += nb * 8) {
        const int dir = unit2 >= 32 * RWC_NCK ? 1 : 0; const int unit = unit2 - dir * 32 * RWC_NCK;
        const int sh = unit / RWC_NCK, ck = unit - sh * RWC_NCK, sl = sh >> 3, head = sh & 7;
        const float kac = P.in[I_KA][layer * 512 + head * 64 + lane];
        float ak[16], bt[16], dt[16], rt[16];
        typedef const __attribute__((address_space(1))) unsigned short* gu16p;
        const gu16p pR = (gu16p)slotp(P, 17), pK = (gu16p)slotp(P, 18), pKK = (gu16p)slotp(P, 20), pE = (gu16p)slotp(P, 22 + dir), pA = (gu16p)slotp(P, dir == 0 ? 24 : 13);
        unsigned short r16[16], k16[16], q16[16], e16[16], a16[16];
#pragma unroll
        for (int t = 0; t < 16; ++t) {
            const int sidx = ck * 16 + t;
            const int p = dir ? LSEQ - 1 - sidx : sidx; const size_t ro = (size_t)row_of(sl, p) * 512 + head * 64 + lane;
            r16[t] = pR[ro]; k16[t] = pK[ro]; q16[t] = pKK[ro]; e16[t] = pE[ro]; a16[t] = pA[ro]; }
        float g = 1.f;
#pragma unroll
        for (int t = 0; t < 16; ++t) {
            const float r = bf2f(r16[t]), k = bf2f(k16[t]), kk = bf2f(q16[t]), e = bf2f(e16[t]), a = bf2f(a16[t]);
            const float wdec = __expf(-e), kd = k * (1.f + (a - 1.f) * kac), b = kk * a;
            ak[t] = g * kk; g *= wdec; const float gi = __builtin_amdgcn_rcpf(g); bt[t] = b * gi; dt[t] = kd * gi; rt[t] = g * r;
        }
        const float gC = g;
#pragma unroll
        for (int t = 0; t < 16; ++t) { Bt[t * 72 + lane] = (bf16_t)(pk2(bt[t], 0.f) & 0xffffu); Dt[t * 72 + lane] = (bf16_t)(pk2(dt[t], 0.f) & 0xffffu);
            Ak[t * 72 + lane] = (bf16_t)(pk2(ak[t], 0.f) & 0xffffu); Rt[t * 72 + lane] = (bf16_t)(pk2(rt[t], 0.f) & 0xffffu); }
        asm volatile("s_waitcnt lgkmcnt(0)" ::: "memory");
        {
            f32x4 mb = (f32x4){0.f, 0.f, 0.f, 0.f}, md = mb, gb = mb, gd = mb;
#pragma unroll
            for (int ks = 0; ks < 2; ++ks) {
                const bf16x8 fb = *(const bf16x8*)(Bt + l15 * 72 + ks * 32 + quad * 8), fd = *(const bf16x8*)(Dt + l15 * 72 + ks * 32 + quad * 8);
                const bf16x8 fa = *(const bf16x8*)(Ak + l15 * 72 + ks * 32 + quad * 8), fr = *(const bf16x8*)(Rt + l15 * 72 + ks * 32 + quad * 8);
                mb = mfma16(fb, fa, mb); md = mfma16(fd, fa, md); gb = mfma16(fb, fr, gb); gd = mfma16(fd, fr, gd); }
#pragma unroll
            for (int jj = 0; jj < 4; ++jj) { const int j = quad * 4 + jj, t = l15;
                Mb[j * 16 + t] = j < t ? mb[jj] : 0.f; Md[j * 16 + t] = j < t ? md[jj] : 0.f; Gb[j * 16 + t] = j <= t ? gb[jj] : 0.f; Gd[j * 16 + t] = j <= t ? gd[jj] : 0.f; }
        }
        asm volatile("s_waitcnt lgkmcnt(0)" ::: "memory");
        {
            float tc[16];
#pragma unroll
            for (int i = 15; i >= 0; --i) { float acc = (i == l15) ? 1.f : 0.f;
                float mr[16];
#pragma unroll
                for (int q4 = (i + 1) >> 2; q4 < 4; ++q4) { const f32x4 m4 = *(const f32x4*)(Mb + i * 16 + q4 * 4); mr[q4 * 4] = m4[0]; mr[q4 * 4 + 1] = m4[1]; mr[q4 * 4 + 2] = m4[2]; mr[q4 * 4 + 3] = m4[3]; }
#pragma unroll
                for (int l = i + 1; l < 16; ++l) acc -= mr[l] * tc[l];
                tc[i] = acc; }
            if (quad == 0) {
#pragma unroll
                for (int i = 0; i < 16; ++i) Tm[i * 16 + l15] = tc[i]; }
        }
        asm volatile("s_waitcnt lgkmcnt(0)" ::: "memory");
        {
            float n4[4] = {0.f, 0.f, 0.f, 0.f};
#pragma unroll
            for (int l = 0; l < 16; ++l) { const float tv = Tm[l * 16 + l15];
#pragma unroll
                for (int jj = 0; jj < 4; ++jj) n4[jj] += Md[(quad * 4 + jj) * 16 + l] * tv; }
#pragma unroll
            for (int jj = 0; jj < 4; ++jj) Nm[(quad * 4 + jj) * 16 + l15] = n4[jj];
        }
        asm volatile("s_waitcnt lgkmcnt(0)" ::: "memory");
        unsigned char* rec = rwc_rec(P, dir, unit);
        {
            float q4[4];
#pragma unroll
            for (int jj = 0; jj < 4; ++jj) q4[jj] = Gd[(quad * 4 + jj) * 16 + l15];
#pragma unroll
            for (int l = 0; l < 16; ++l) { const float gv = Gb[l * 16 + l15];
#pragma unroll
                for (int jj = 0; jj < 4; ++jj) q4[jj] -= Nm[(quad * 4 + jj) * 16 + l] * gv; }
            *(uint2*)((bf16_t*)(rec + 8192) + l15 * 16 + quad * 4) = make_uint2(pk2(q4[0], q4[1]), pk2(q4[2], q4[3]));
        }
        {
            float ap[16], rp[16], ps[16];
#pragma unroll
            for (int t = 0; t < 16; ++t) { ap[t] = 0.f; rp[t] = rt[t]; }
#pragma unroll
            for (int j = 0; j < 16; ++j) {
#pragma unroll
                for (int q4 = j >> 2; q4 < 4; ++q4) { const f32x4 r4 = *(const f32x4*)(Tm + j * 16 + q4 * 4);
#pragma unroll
                    for (int e = 0; e < 4; ++e) ap[q4 * 4 + e] += ak[j] * r4[e]; } }
#pragma unroll
            for (int j = 0; j < 16; ++j) {
#pragma unroll
                for (int q4 = j >> 2; q4 < 4; ++q4) { const f32x4 r4 = *(const f32x4*)(Gb + j * 16 + q4 * 4);
#pragma unroll
                    for (int e = 0; e < 4; ++e) rp[q4 * 4 + e] -= ap[j] * r4[e]; } }
#pragma unroll
            for (int j = 0; j < 16; ++j) { float acc = dt[j];
#pragma unroll
                for (int q4 = j >> 2; q4 < 4; ++q4) { const f32x4 r4 = *(const f32x4*)(Nm + j * 16 + q4 * 4);
#pragma unroll
                    for (int e = 0; e < 4; ++e) acc -= r4[e] * bt[q4 * 4 + e]; }
                ps[j] = acc * gC; }
            bf16_t* AP = (bf16_t*)rec; bf16_t* RP = AP + 1024; const int so = rwc_slot(lane);
#pragma unroll
            for (int t = 0; t < 16; ++t) { AP[t * 64 + so] = (bf16_t)(pk2(ap[t], 0.f) & 0xffffu); RP[t * 64 + so] = (bf16_t)(pk2(rp[t], 0.f) & 0xffffu); }
            float nb_[16];
#pragma unroll
            for (int t = 0; t < 16; ++t) nb_[t] = -bt[t] * gC;
            uint4* BP = (uint4*)(rec + 4096) + lane * 2; BP[0] = pack8(nb_); BP[1] = pack8(nb_ + 8);
            uint4* PP = (uint4*)(rec + 6144) + lane * 2; PP[0] = pack8(ps); PP[1] = pack8(ps + 8);
            ((float*)(rec + 8704))[lane] = gC;
        }
        asm volatile("s_waitcnt lgkmcnt(0)" ::: "memory");
    }
}
struct RwcRegs { u32x4_t a, b, c, v; };
DEV void rwc_load(const Params& P, RwcRegs& g, int sh, int dir, int ck, int t) {
    const unsigned char* rec = rwc_rec(P, dir, sh * RWC_NCK + ck);
    g.a = GLD16(rec + (size_t)t * 16); g.b = GLD16(rec + (size_t)(t + 256) * 16);
    if (t < 48) g.c = GLD16(rec + (size_t)(t + 512) * 16);
    if (t < 128) { const int j = t >> 3, r8 = (t & 7) * 8, sidx = ck * 16 + j; const int sc = sidx < LSEQ ? sidx : LSEQ - 1; const int p = dir ? LSEQ - 1 - sc : sc;
        g.v = GLD16(slotp(P, 19) + (size_t)row_of(sh >> 3, p) * 512 + (sh & 7) * 64 + r8); if (sidx >= LSEQ) g.v = (u32x4_t){0u, 0u, 0u, 0u}; }
}
DEV void rwc_store(unsigned char* buf, const RwcRegs& g, int t) {
    *(u32x4_t*)(buf + t * 16) = g.a; *(u32x4_t*)(buf + (t + 256) * 16) = g.b;
    if (t < 48) *(u32x4_t*)(buf + (t + 512) * 16) = g.c;
    if (t < 128) { bf16_t* VsT = (bf16_t*)(buf + RWC_REC); const int j = t >> 3, r8 = (t & 7) * 8;
        VsT[(r8 + 0) * 16 + j] = (bf16_t)(g.v.x & 0xffffu); VsT[(r8 + 1) * 16 + j] = (bf16_t)(g.v.x >> 16); VsT[(r8 + 2) * 16 + j] = (bf16_t)(g.v.y & 0xffffu); VsT[(r8 + 3) * 16 + j] = (bf16_t)(g.v.y >> 16);
        VsT[(r8 + 4) * 16 + j] = (bf16_t)(g.v.z & 0xffffu); VsT[(r8 + 5) * 16 + j] = (bf16_t)(g.v.z >> 16); VsT[(r8 + 6) * 16 + j] = (bf16_t)(g.v.w & 0xffffu); VsT[(r8 + 7) * 16 + j] = (bf16_t)(g.v.w >> 16); }
}
DEV void phase_rwc_scan(const Params& P0, unsigned char* lds, int bid, int nb, int wv) {
    Params P = load_params(); P.ws = launder_ws(P.ws);
    const int tid = launder_tid(wv), lane = tid & 63, w = __builtin_amdgcn_readfirstlane(tid >> 6), l15 = lane & 15, quad = lane >> 4;
    constexpr int BUFB = RWC_REC + 2048;
    for (int u2 = bid; u2 < 64; u2 += nb) {
        const int sh = u2 & 31, dir = u2 >> 5; const int sl = sh >> 3, head = sh & 7;
        f32x4 ST[4];
#pragma unroll
        for (int ct = 0; ct < 4; ++ct) ST[ct] = (f32x4){0.f, 0.f, 0.f, 0.f};
        RwcRegs g; g.a = g.b = g.c = g.v = (u32x4_t){0u, 0u, 0u, 0u};
        if (w >= 4) { rwc_load(P, g, sh, dir, 0, tid - 256); rwc_store(lds, g, tid - 256); rwc_load(P, g, sh, dir, 1, tid - 256); }
        __syncthreads();
#pragma unroll 1
        for (int ck = 0; ck < RWC_NCK; ++ck) {
            const unsigned char* buf = lds + (ck & 1) * BUFB;
            if (w >= 4) {
                if (ck + 1 < RWC_NCK) rwc_store(lds + ((ck + 1) & 1) * BUFB, g, tid - 256);
                if (ck + 2 < RWC_NCK) rwc_load(P, g, sh, dir, ck + 2, tid - 256);
            } else {
                const bf16_t* AP = (const bf16_t*)buf; const bf16_t* RP = AP + 1024; const bf16_t* BP = (const bf16_t*)(buf + 4096); const bf16_t* PP = (const bf16_t*)(buf + 6144);
                const bf16_t* QP = (const bf16_t*)(buf + 8192); const float* GC = (const float*)(buf + 8704); const bf16_t* VsT = (const bf16_t*)(buf + RWC_REC);
                const u32x4_t z4 = (u32x4_t){0u, 0u, 0u, 0u};
                u32x4_t sb0, sb1;
                sb0.x = pk2(ST[0][0], ST[0][1]); sb0.y = pk2(ST[0][2], ST[0][3]); sb0.z = pk2(ST[1][0], ST[1][1]); sb0.w = pk2(ST[1][2], ST[1][3]);
                sb1.x = pk2(ST[2][0], ST[2][1]); sb1.y = pk2(ST[2][2], ST[2][3]); sb1.z = pk2(ST[3][0], ST[3][1]); sb1.w = pk2(ST[3][2], ST[3][3]);
                const bf16x8 SB0 = __builtin_bit_cast(bf16x8, sb0), SB1 = __builtin_bit_cast(bf16x8, sb1);
                const bf16x8 a0 = *(const bf16x8*)(AP + l15 * 64 + (0 * 4 + quad) * 8), a1 = *(const bf16x8*)(AP + l15 * 64 + (1 * 4 + quad) * 8);
                const bf16x8 r0 = *(const bf16x8*)(RP + l15 * 64 + (0 * 4 + quad) * 8), r1 = *(const bf16x8*)(RP + l15 * 64 + (1 * 4 + quad) * 8);
                const u32x4_t vq = quad < 2 ? *(const u32x4_t*)(VsT + (w * 16 + l15) * 16 + quad * 8) : z4;
                const u32x4_t qq = quad < 2 ? *(const u32x4_t*)(QP + l15 * 16 + quad * 8) : z4;
                f32x4 gcv[4]; uint2 bqv[4]; u32x4_t pqv[4];
#pragma unroll
                for (int ct = 0; ct < 4; ++ct) { gcv[ct] = *(const f32x4*)(GC + ct * 16 + quad * 4); bqv[ct] = *(const uint2*)(BP + (ct * 16 + l15) * 16 + quad * 4);
                    pqv[ct] = quad < 2 ? *(const u32x4_t*)(PP + (ct * 16 + l15) * 16 + quad * 8) : z4; }
                const bf16x8 VB = __builtin_bit_cast(bf16x8, vq), QA = __builtin_bit_cast(bf16x8, qq);
                f32x4 Wt = (f32x4){0.f, 0.f, 0.f, 0.f}, Ot = Wt;
                Wt = mfma16(a0, SB0, Wt); Wt = mfma16(a1, SB1, Wt);
                Ot = mfma16(r0, SB0, Ot); Ot = mfma16(r1, SB1, Ot); Ot = mfma16(QA, VB, Ot);
                u32x4_t wb; wb.x = pk2(Wt[0], Wt[1]); wb.y = pk2(Wt[2], Wt[3]); wb.z = 0u; wb.w = 0u;
                const bf16x8 WB = __builtin_bit_cast(bf16x8, wb);
#pragma unroll
                for (int ct = 0; ct < 4; ++ct) {
                    u32x4_t ba; ba.x = bqv[ct].x; ba.y = bqv[ct].y; ba.z = 0u; ba.w = 0u;
                    f32x4 acc = ST[ct] * gcv[ct];
                    acc = mfma16(__builtin_bit_cast(bf16x8, ba), WB, acc);
                    acc = mfma16(__builtin_bit_cast(bf16x8, pqv[ct]), VB, acc);
                    ST[ct] = acc;
                }
                bf16_t* Oo = slotp(P, 15 + dir);
#pragma unroll
                for (int jj = 0; jj < 4; ++jj) { const int sidx = ck * 16 + quad * 4 + jj;
                    if (sidx < LSEQ) { const int p = dir ? LSEQ - 1 - sidx : sidx; ((__attribute__((address_space(1))) bf16_t*)Oo)[(size_t)row_of(sl, p) * 512 + head * 64 + w * 16 + l15] = (bf16_t)(pk2(Ot[jj], 0.f) & 0xffffu); } }
            }
            __syncthreads();
        }
    }
}


DEV void phase_attn_combine(const Params& P0, int layer, int bid, int nb, int wv) {
    Params P = load_params(); P.ws = launder_ws(P.ws);
    ROWPRO
    const float lam_init = layer == 0 ? 0.2f : 0.35550906759096934f;
    float lam;
    { const float* lp = P.in[I_LAM] + (size_t)layer * 256; const float s1 = wave_sum(lp[lane] * lp[64 + lane]), s2 = wave_sum(lp[128 + lane] * lp[192 + lane]); lam = __expf(s1) - __expf(s2) + lam_init; }
    const float* PT = (const float*)slotp(P, 22);
    for (int task = gw; task < 64 * 128; task += ngw) {
        const int ul = task >> 7, row = task & 127, unit = 448 + ul, sh = unit >> 5, qb = unit & 31, sl = sh >> 2, head = sh & 3;
        float om[2][2];
#pragma unroll
        for (int map = 0; map < 2; ++map) {
            const float* pa = PT + ((size_t)((ul * 2 + 0) * 2 + map) * 128 + row) * 130; const float* pb = PT + ((size_t)((ul * 2 + 1) * 2 + map) * 128 + row) * 130;
            const float ma = pa[128], la = pa[129], mb = pb[128], lb = pb[129];
            const float M = fmaxf(ma, mb), fa = __builtin_amdgcn_exp2f(ma - M), fb = __builtin_amdgcn_exp2f(mb - M);
            const float inv = 1.0f / (la * fa + lb * fb);
            om[map][0] = (pa[lane * 2] * fa + pb[lane * 2] * fb) * inv; om[map][1] = (pa[lane * 2 + 1] * fa + pb[lane * 2 + 1] * fb) * inv; }
        const float o0 = om[0][0] - lam * om[1][0], o1 = om[0][1] - lam * om[1][1];
        const float ss = wave_sum(o0 * o0 + o1 * o1);
        const float rs = rsqrtf(ss * (1.f / 128.f) + 1e-5f) * (1.f - lam_init);
        const float g0 = P.in[I_SUBLN][layer * 128 + lane * 2], g1 = P.in[I_SUBLN][layer * 128 + lane * 2 + 1];
        *(unsigned*)(slotp(P, 4) + (size_t)(sl * 4096 + qb * 128 + row) * 512 + head * 128 + lane * 2) = pk2(o0 * rs * g0, o1 * rs * g1);
    }
}
#define LAS __attribute__((address_space(3)))
#define XB_TMO      128
#define XB_XCNT(j)  (256  + 64 * (j))
#define XB_XSUB(j)  (1280 + 64 * (j))
#define XB_XGEN(j)  (2304 + 64 * (j))
#define XB_TOP      3328
#define XB_TOPGEN   3392
#define XCD_BAR_WORDS 3456
#define XB_SPIN_CAP (1u << 18)

__device__ __forceinline__ unsigned xb_ld(unsigned* p)              { return __hip_atomic_load(p, __ATOMIC_RELAXED, __HIP_MEMORY_SCOPE_AGENT); }
__device__ __forceinline__ unsigned xb_add(unsigned* p, unsigned v) { return __hip_atomic_fetch_add(p, v, __ATOMIC_RELAXED, __HIP_MEMORY_SCOPE_AGENT); }
__device__ __forceinline__ unsigned xb_xcc_id() { return (unsigned)__builtin_amdgcn_s_getreg((3 << 11) | 20) & 0xFu; }
#define XB_SPIN(cond, bar) do { unsigned _sp = 0; while (cond) { __builtin_amdgcn_s_sleep(1); \
    if ((++_sp & 255u) == 0u) { if (xb_ld(&(bar)[XB_TMO])) break; if (_sp > XB_SPIN_CAP) { atomicAdd(&(bar)[XB_TMO], 1u); break; } } } } while (0)

struct XcdBarrier {
    unsigned* bar; unsigned x;
    volatile LAS unsigned* st;
};

__device__ __forceinline__ XcdBarrier xcd_barrier_post(unsigned* bar, volatile LAS unsigned* st, int wv) {
    XcdBarrier b; b.bar = bar; b.x = xb_xcc_id(); b.st = st;
    if (launder_tid(wv) == 0) (void)xb_add(&bar[XB_XCNT(b.x)], 1u);
    return b;
}
__device__ __forceinline__ void xcd_barrier_complete(unsigned* bar, unsigned x, unsigned& nloc, unsigned& nx) {
    const unsigned G = gridDim.x * gridDim.y * gridDim.z;
    unsigned sum, cnt, mine, sp = 0u;
    for (;;) {
        sum = 0u; cnt = 0u; mine = 0u;
#pragma unroll
        for (unsigned j = 0; j < 16; ++j) { const unsigned c = xb_ld(&bar[XB_XCNT(j)]); sum += c; cnt += (c > 0u) ? 1u : 0u; mine = (j == x) ? c : mine; }
        if (sum == G) break;
        __builtin_amdgcn_s_sleep(1);
        if ((++sp & 255u) == 0u) { if (xb_ld(&bar[XB_TMO])) break; if (sp > XB_SPIN_CAP) { atomicAdd(&bar[XB_TMO], 1u); break; } }
    }
    nloc = mine > 0u ? mine : 1u; nx = cnt > 0u ? cnt : 1u;
}

__device__ __forceinline__ void xcd_barrier(const XcdBarrier& b, int wv) {
    asm volatile("s_waitcnt vmcnt(0)" ::: "memory");
    __syncthreads();
    if (launder_tid(wv) == 0) {
        unsigned* bar = b.bar;
        __builtin_amdgcn_s_waitcnt(0);
        unsigned nloc = b.st[0], nx = b.st[1];
        if (nloc == 0u) { xcd_barrier_complete(bar, b.x, nloc, nx); b.st[0] = nloc; b.st[1] = nx; }
        const unsigned old = xb_add(&bar[XB_XSUB(b.x)], 1u);
        const unsigned gen = old / nloc;
        if (old + 1u == (gen + 1u) * nloc) {
            __builtin_amdgcn_fence(__ATOMIC_RELEASE, "agent");
            asm volatile("s_waitcnt vmcnt(0)" ::: "memory");
            const unsigned og = xb_add(&bar[XB_TOP], 1u);
            const unsigned tg = og / nx;
            if (og + 1u == (tg + 1u) * nx) xb_add(&bar[XB_TOPGEN], 1u);
            else XB_SPIN(xb_ld(&bar[XB_TOPGEN]) == tg, bar);
            __builtin_amdgcn_fence(__ATOMIC_ACQUIRE, "agent");
            xb_add(&bar[XB_XGEN(b.x)], 1u);
            asm volatile("s_waitcnt vmcnt(0)" ::: "memory");
        } else {
            XB_SPIN(xb_ld(&bar[XB_XGEN(b.x)]) == gen, bar);
            __builtin_amdgcn_fence(__ATOMIC_ACQUIRE, "agent");
            asm volatile("s_waitcnt vmcnt(0)" ::: "memory");
        }
    }
    __syncthreads();
}

__global__ void __launch_bounds__(512) mega_fwd(Params P) {
    extern __shared__ __attribute__((aligned(16))) unsigned char lds[];
    cg::grid_group grid = cg::this_grid();
    const int bid = blockIdx.x, nb = gridDim.x; const int wv = __builtin_amdgcn_readfirstlane(threadIdx.x >> 6);
    volatile LAS unsigned* MISC = (volatile LAS unsigned*)((LAS unsigned char*)lds + 131072 + 256);
    if (threadIdx.x < 4) MISC[threadIdx.x] = 0u;
    __syncthreads();
    XcdBarrier xbar;
    { Params Pb = load_params(); xbar = xcd_barrier_post((unsigned*)Pb.ws, MISC, wv); }
#define GSYNC() xcd_barrier(xbar, wv)
    PG8_LAS unsigned char* ldsl = (PG8_LAS unsigned char*)lds;
#pragma unroll 1
    for (int layer_ = 0; layer_ < 2; ++layer_) {
        phase_weights(P, lsd(layer_), lds, bid, nb, wv);
        grid.sync();
#pragma unroll 1
        for (int g_ = 0; g_ < NGRP; ++g_) {
            #define Mpost ((lsd(layer_) == 0 && lsd(g_) == 2) ? TGP : TREAL)
#define NVALID ((lsd(layer_) == 0 && lsd(g_) == 2) ? TG + 128 : TG)
            phase_rmsnorm(P, lsd(g_), lsd(layer_) == 0, I_NMIX, lsd(layer_), TGP, NVALID, bid, nb, wv);
            if (PROBE == 5) { phase_rmsnorm(P, lsd(g_), lsd(layer_) == 0, I_NMIX, lsd(layer_), TGP, NVALID, bid, nb, wv); }
            GSYNC();
            if (PROBE == 6) { for (int q_ = 0; q_ < 15; ++q_) GSYNC(); }
            for (int rep_ = 0; rep_ < (PROBE == 3 ? 2 : 1); ++rep_)
            { Params Pl = load_params(); Pl.ws = launder_ws(Pl.ws); pg8::bf16_t* W = (pg8::bf16_t*)(Pl.ws + WS_W); pg8::Gemm gm{slotp(Pl, 0), W + WO_IN, TGP, 7680, 1024, 0, 0}; pg8::StaticOrder S; S.init(TGP, 7680, nb, bid);
              pg8::EpiBf<0> E{slotp(Pl, 2), 512, SLOT_E};
              pg8::gemm_phase<pg8::EpiBf<0>, pg8::StaticOrder, true, true>(ldsl, gm, S, E, wv); }
            GSYNC();
            phase_da_prep(P, lsd(layer_), bid, nb, wv);
            phase_hg1(P, lsd(layer_), lds, bid, nb, wv);
            if (PROBE == 4) { phase_hg1(P, lsd(layer_), lds, bid, nb, wv); }
            GSYNC();
            phase_hg2(P, bid, nb, wv);
            GSYNC();
            phase_hg3(P, lsd(layer_), lds, bid, nb, wv);
            GSYNC();
            phase_conv(P, lsd(layer_), bid, nb, wv);
            if (PROBE == 5) { phase_conv(P, lsd(layer_), bid, nb, wv); }
            phase_vtrans(P, lds, bid, nb, wv);
            if (PROBE == 5) { phase_vtrans(P, lds, bid, nb, wv); }
            phase_rw_prep(P, lsd(layer_), bid, nb, wv);
            if (PROBE == 5) { phase_rw_prep(P, lsd(layer_), bid, nb, wv); }
            GSYNC();
            { Params Pl = load_params(); Pl.ws = launder_ws(Pl.ws); pg8::bf16_t* W = (pg8::bf16_t*)(Pl.ws + WS_W); pg8::Gemm gm{slotp(Pl, 21), W + WO_LR, TGP, 2560, 384, 0, 0}; pg8::StaticOrder S; S.init(TGP, 2560, nb, bid);
              pg8::EpiLR E{slotp(Pl, 22), slotp(Pl, 23), slotp(Pl, 24), slotp(Pl, 13), slotp(Pl, 14), Pl.in[I_W0] + lsd(layer_) * 1024, Pl.in[I_A0] + lsd(layer_) * 1024};
              pg8::gemm_phase<pg8::EpiLR, pg8::StaticOrder, true, true>(ldsl, gm, S, E, wv); }
            GSYNC();
            phase_rwc_pre(P, lsd(layer_), lds, bid, nb, wv);
            GSYNC();
            if (nb == 256) {
                const int nun = lsd(layer_) == 0 ? 528 : 512;
                if (bid < 64) { phase_rwc_scan(P, lds, bid, nb, wv); __syncthreads(); phase_attn(P, lsd(layer_), lds, bid, -1, -1, wv); }
                else { const int bq = bid - 64;
                    const int third = bq < 128 ? ((448 + (bq >> 1)) | ((3 + (bq & 1)) << 12)) : ((384 + bq < nun) ? 384 + bq : -1);
                    phase_attn(P, lsd(layer_), lds, 64 + bq, 256 + bq, third, wv); }
            } else {
                phase_rwc_scan(P, lds, bid, nb, wv); __syncthreads();
                for (int u = bid; u < (lsd(layer_) == 0 ? 528 : 512); u += nb) phase_attn(P, lsd(layer_), lds, u, -1, -1, wv);
            }
            GSYNC();
            if (nb == 256) phase_attn_combine(P, lsd(layer_), bid, nb, wv);
            phase_rw_post(P, lsd(layer_), lsd(g_), lsd(layer_) == 0 ? TG : TREAL, bid, nb, wv);
            if (PROBE == 5) { phase_rw_post(P, lsd(layer_), lsd(g_), lsd(layer_) == 0 ? TG : TREAL, bid, nb, wv); }
            GSYNC();
            { Params Pl = load_params(); Pl.ws = launder_ws(Pl.ws); pg8::bf16_t* W = (pg8::bf16_t*)(Pl.ws + WS_W); pg8::Gemm gm{slotp(Pl, 2), W + WO_BP, Mpost, 4096, 512, 4, SLOT_B}; pg8::StaticOrder S; S.init(Mpost, 4096, nb, bid);
              pg8::EpiBf<0> E{slotp(Pl, 6), 4096, 0};
              pg8::gemm_phase<pg8::EpiBf<0>, pg8::StaticOrder, true, true>(ldsl, gm, S, E, wv); }
            GSYNC();
            { Params Pl = load_params(); Pl.ws = launder_ws(Pl.ws); pg8::bf16_t* W = (pg8::bf16_t*)(Pl.ws + WS_W); pg8::Gemm gm{slotp(Pl, 0), W + WO_G, Mpost, 4096, 1024, 0, 0}; pg8::StaticOrder S; S.init(Mpost, 4096, nb, bid);
              pg8::EpiGate E{slotp(Pl, 6), slotp(Pl, 14)};
              pg8::gemm_phase<pg8::EpiGate, pg8::StaticOrder, true, true>(ldsl, gm, S, E, wv); }
            GSYNC();
            { Params Pl = load_params(); Pl.ws = launder_ws(Pl.ws); pg8::bf16_t* W = (pg8::bf16_t*)(Pl.ws + WS_W); pg8::Gemm gm{slotp(Pl, 14), W + WO_OUT, Mpost, 1024, 1024, 0, 0}; pg8::StaticOrder S; S.init(Mpost, 1024, nb, bid);
              pg8::EpiResid E{lsd(layer_) == 0 ? x_in_row(Pl, lsd(g_), 0) : (const float*)x_cur_row(Pl, lsd(g_), 0), lsd(layer_) == 0 ? Pl.in[I_META] : (const float*)nullptr, x_cur_row(Pl, lsd(g_), 0), GPTR(float, Pl.ws + WS_XMETA), lsd(g_), NVALID};
              pg8::gemm_phase<pg8::EpiResid, pg8::StaticOrder, true, true>(ldsl, gm, S, E, wv); }
            GSYNC();
            phase_rmsnorm(P, lsd(g_), false, I_NMLP, lsd(layer_), Mpost, NVALID, bid, nb, wv);
            if (PROBE == 5) { phase_rmsnorm(P, lsd(g_), false, I_NMLP, lsd(layer_), Mpost, NVALID, bid, nb, wv); }
            GSYNC();
            for (int rep_ = 0; rep_ < (PROBE == 7 ? 2 : 1); ++rep_)
            { Params Pl = load_params(); Pl.ws = launder_ws(Pl.ws); pg8::bf16_t* W = (pg8::bf16_t*)(Pl.ws + WS_W); pg8::Gemm gm{slotp(Pl, 0), W + WO_1, Mpost, 4096, 1024, 0, 0}; pg8::StaticOrder S; S.init(Mpost, 4096, nb, bid);
              pg8::EpiBf<1> E{slotp(Pl, 6), 4096, 0};
              pg8::gemm_phase<pg8::EpiBf<1>, pg8::StaticOrder, true, true>(ldsl, gm, S, E, wv); }
            GSYNC();
            { Params Pl = load_params(); Pl.ws = launder_ws(Pl.ws); pg8::bf16_t* W = (pg8::bf16_t*)(Pl.ws + WS_W); pg8::Gemm gm{slotp(Pl, 6), W + WO_2, Mpost, 1024, 4096, 0, 0}; pg8::StaticOrder S; S.init(Mpost, 1024, nb, bid);
              pg8::EpiResid E{(const float*)x_cur_row(Pl, lsd(g_), 0), (const float*)nullptr, x_cur_row(Pl, lsd(g_), 0), GPTR(float, Pl.ws + WS_XMETA), lsd(g_), NVALID};
              pg8::gemm_phase<pg8::EpiResid, pg8::StaticOrder, true, true>(ldsl, gm, S, E, wv); }
            GSYNC();
        }
    }
}

extern "C" void kernel_launch(void* const* d_in, const int* in_sizes, int n_in, void* d_out, int out_size, void* d_ws, size_t ws_size, hipStream_t stream) {
    static int grid = 0;
    if (grid == 0) {
        if (n_in != 29 || ws_size < WS_NEED) { fprintf(stderr, "kernel_launch: need 29 inputs and %zu bytes of workspace; got %d, %zu\n", (size_t)WS_NEED, n_in, ws_size); grid = -1; return; }
        int dev = 0, cus = 0, per_cu = 0;
        if (hipGetDevice(&dev) != hipSuccess || hipDeviceGetAttribute(&cus, hipDeviceAttributeMultiprocessorCount, dev) != hipSuccess) { grid = -1; return; }
        if (hipFuncSetAttribute((const void*)mega_fwd, hipFuncAttributeMaxDynamicSharedMemorySize, LDS_BYTES) != hipSuccess) { fprintf(stderr, "kernel_launch: hipFuncSetAttribute failed\n"); grid = -1; return; }
        if (hipOccupancyMaxActiveBlocksPerMultiprocessor(&per_cu, (const void*)mega_fwd, 512, LDS_BYTES) != hipSuccess || per_cu < 1) { fprintf(stderr, "kernel_launch: occupancy query says %d\n", per_cu); per_cu = 1; }
        (void)hipGetLastError();
        grid = cus;
    }
    if (grid < 0) return;
    if (hipMemsetAsync(d_ws, 0, 16384, stream) != hipSuccess) { fprintf(stderr, "kernel_launch: memset failed\n"); return; }
    Params p{};
    for (int i = 0; i < 29; ++i) p.in[i] = (const float*)d_in[i];
    p.out = (float*)d_out; p.ws = (unsigned char*)d_ws;
    void* args[] = {&p};
    hipError_t e = hipLaunchCooperativeKernel((const void*)mega_fwd, dim3(grid), dim3(512), args, LDS_BYTES, stream);
    if (e != hipSuccess) fprintf(stderr, "kernel_launch: cooperative launch failed: %s (grid %d)\n", hipGetErrorString(e), grid);
}
```

```cpp
#include <hip/hip_runtime.h>
#include <hip/hip_cooperative_groups.h>
#include <cstdio>
#include <cstdint>
namespace cg = cooperative_groups;
#define PROBE 0
#define DEV __device__ __forceinline__
__device__ __forceinline__ int lsd(int x) { asm volatile("" : "+s"(x)); return x; }
__device__ __forceinline__ int launder_tid(int wv) { int l; asm volatile("v_mbcnt_lo_u32_b32 %0, -1, 0\n\tv_mbcnt_hi_u32_b32 %0, -1, %0" : "=v"(l)); return wv * 64 + l; }
namespace pg8 {
#define PG8_LAS __attribute__((address_space(3)))
typedef unsigned short bf16_t;
typedef short bf16x8 __attribute__((ext_vector_type(8)));
typedef float f32x4 __attribute__((ext_vector_type(4)));
typedef unsigned u32x4 __attribute__((ext_vector_type(4)));
constexpr int BM = 256, BK = 64, HALF = 128, HTB = HALF * BK * 2  , STAGE_BYTES = 8 * HTB, NXCD = 8, WGM = 8;

__host__ __device__ __forceinline__ int lds_byte(int r, int c) { const int st = (r >> 4) * 2 + (c >> 5), rr = r & 15, cc = c & 31, ob = rr * 64 + cc * 2; return st * 1024 + (ob ^ (((ob >> 9) & 1) << 5)); }
__host__ __device__ __forceinline__ void stage_rc(int b, int& R, int& C) { const int st = b / 1024, sb = b % 1024, swz = sb ^ (((sb >> 9) & 1) << 5); R = (st >> 1) * 16 + swz / 64; C = (st & 1) * 32 + (swz % 64) / 2; }
__host__ __device__ __forceinline__ int perm32(int rho) { const int n = rho >> 4, i = rho & 15; return 8 * (i >> 2) + 4 * n + (i & 3); }

struct Unit { int pm, pn; };
struct Gemm { const bf16_t* A; const bf16_t* Bt; int M, N, K; int pn_per_ab; size_t ab_stride; };

struct StaticOrder {
    int nM, nN, nwg, G, c;
    __host__ __device__ void init(int M, int N, int G_, int c_) { nM = M / BM; nN = N / BM; nwg = nM * nN; G = G_; c = c_; }
    __host__ __device__ bool next(int i, Unit& u) const {
        const long L = (long)i * G + c; if (L >= nwg) return false;
        int wgid = (int)L; { const int q = nwg / NXCD, r = nwg % NXCD, xcd = wgid % NXCD, off = wgid / NXCD; wgid = (xcd < r ? xcd * (q + 1) : r * (q + 1) + (xcd - r) * q) + off; }
        const int nig = WGM * nN, gid = wgid / nig, fm = gid * WGM, gsz = (nM - fm) < WGM ? (nM - fm) : WGM;
        u.pm = fm + ((wgid % nig) % gsz); u.pn = (wgid % nig) / gsz; return true;
    }
    __device__ __forceinline__ void a_ready(const Unit&) const {}
    __device__ __forceinline__ void done(const Unit&) const {}
};

typedef float f32x2cv_t __attribute__((ext_vector_type(2))); typedef __bf16 bf16x2cv_t __attribute__((ext_vector_type(2)));
__device__ __forceinline__ unsigned cvt_pk_bf16(float lo, float hi) { const f32x2cv_t v = {lo, hi}; const bf16x2cv_t b = __builtin_convertvector(v, bf16x2cv_t); return __builtin_bit_cast(unsigned, b); }
typedef float f32x2 __attribute__((ext_vector_type(2)));
__device__ __forceinline__ float sigm(float x) { return __builtin_amdgcn_rcpf(1.0f + __expf(-x)); }
template <int ACT  > struct EpiBf {
    static constexpr bool PERM = true, AFTER_DRAIN = false;
    bf16_t* O; int ldc; size_t gstride;
    __device__ __forceinline__ void operator()(const f32x4 (&acc)[2][2][4][2], const Unit& u, int wr, int wc, int fr, int fq) const {
        const int row0 = u.pm * BM + wr * 64 + fr; int colt = u.pn * BM; bf16_t* base = O; int ld = ldc;
        if (gstride) { const int t = colt >> 9; colt &= 511; base += (size_t)t * gstride; ld = 512; }
        const int col0 = colt + wc * 32 + 8 * fq;
#pragma unroll
        for (int ai = 0; ai < 2; ++ai)
#pragma unroll
            for (int m = 0; m < 4; ++m) { bf16_t* rowp = base + (size_t)(row0 + ai * HALF + m * 16) * ld + col0;
#pragma unroll
                for (int bj = 0; bj < 2; ++bj) { f32x4 v0 = acc[ai][bj][m][0], v1 = acc[ai][bj][m][1];
                    if (ACT == 1) {
#pragma unroll
                        for (int i = 0; i < 4; ++i) { float a = fmaxf(v0[i], 0.f), b = fmaxf(v1[i], 0.f); v0[i] = a * a; v1[i] = b * b; } }
                    u32x4 w; w.x = cvt_pk_bf16(v0[0], v0[1]); w.y = cvt_pk_bf16(v0[2], v0[3]); w.z = cvt_pk_bf16(v1[0], v1[1]); w.w = cvt_pk_bf16(v1[2], v1[3]);
                    *(u32x4*)(rowp + bj * HALF) = w; } }
    }
};
struct EpiLR {
    static constexpr bool PERM = true, AFTER_DRAIN = false;
    bf16_t *s0, *s1, *s2, *s3, *s4; const float* w0; const float* a0;
    __device__ __forceinline__ void operator()(const f32x4 (&acc)[2][2][4][2], const Unit& u, int wr, int wc, int fr, int fq) const {
        const int row0 = u.pm * BM + wr * 64 + fr; const int colg = u.pn * BM; const int seg = colg >> 9; const int cb = colg & 511;
        bf16_t* base = seg == 0 ? s0 : seg == 1 ? s1 : seg == 2 ? s2 : seg == 3 ? s3 : s4;
        const int col0 = cb + wc * 32 + 8 * fq;
        const float* bsrc = seg < 2 ? w0 + seg * 512 : a0 + (seg & 1) * 512;
        const float sc = seg < 2 ? 0.6065306597f : 1.0f; const float bm = seg < 4 ? 1.f : 0.f; const bool act = seg < 4;
#pragma unroll
        for (int bj = 0; bj < 2; ++bj) {
            const f32x4 b0 = *(const f32x4*)(bsrc + col0 + bj * HALF) * bm, b1 = *(const f32x4*)(bsrc + col0 + bj * HALF + 4) * bm;
#pragma unroll
            for (int ai = 0; ai < 2; ++ai)
#pragma unroll
                for (int m = 0; m < 4; ++m) { bf16_t* rowp = base + (size_t)(row0 + ai * HALF + m * 16) * 512 + col0;
                    f32x4 v0 = acc[ai][bj][m][0] + b0, v1 = acc[ai][bj][m][1] + b1;
#pragma unroll
                    for (int i = 0; i < 4; ++i) { const float g0 = sc * sigm(v0[i]), g1 = sc * sigm(v1[i]); v0[i] = act ? g0 : v0[i]; v1[i] = act ? g1 : v1[i]; }
                    u32x4 w; w.x = cvt_pk_bf16(v0[0], v0[1]); w.y = cvt_pk_bf16(v0[2], v0[3]); w.z = cvt_pk_bf16(v1[0], v1[1]); w.w = cvt_pk_bf16(v1[2], v1[3]);
                    *(u32x4*)(rowp + bj * HALF) = w; __builtin_amdgcn_sched_barrier(0); }
        }
    }
};
struct EpiGate {
    static constexpr bool PERM = true, AFTER_DRAIN = false;
    const bf16_t* Pm; bf16_t* Mg;
    __device__ __forceinline__ void operator()(const f32x4 (&acc)[2][2][4][2], const Unit& u, int wr, int wc, int fr, int fq) const {
        const int row0 = u.pm * BM + wr * 64 + fr; const int ocol = u.pn * 64 + wc * 16 + fq * 4;
#pragma unroll
        for (int ai = 0; ai < 2; ++ai)
#pragma unroll
            for (int m = 0; m < 4; ++m) { const size_t row = (size_t)(row0 + ai * HALF + m * 16);
                float s0 = 0.f, s1 = 0.f, s2 = 0.f, s3 = 0.f;
#pragma unroll
                for (int bj = 0; bj < 2; ++bj)
#pragma unroll
                    for (int n = 0; n < 2; ++n) { const int br = bj * 2 + n;
                        const uint2 pw = *(const uint2*)(Pm + row * 4096 + br * 1024 + ocol);
                        const f32x4 a = acc[ai][bj][m][n];
                        s0 += sigm(a[0]) * __uint_as_float(pw.x << 16); s1 += sigm(a[1]) * __uint_as_float(pw.x & 0xffff0000u);
                        s2 += sigm(a[2]) * __uint_as_float(pw.y << 16); s3 += sigm(a[3]) * __uint_as_float(pw.y & 0xffff0000u); }
                uint2 o; o.x = cvt_pk_bf16(s0, s1); o.y = cvt_pk_bf16(s2, s3);
                *(uint2*)(Mg + row * 1024 + ocol) = o; }
    }
};
struct EpiResid {
    static constexpr bool PERM = true, AFTER_DRAIN = false;
    const float* om; const float* mt; float* nm; float* xmb; int g; int rlim;
    __device__ __forceinline__ void operator()(const f32x4 (&acc)[2][2][4][2], const Unit& u, int wr, int wc, int fr, int fq) const {
        const int row0 = u.pm * BM + wr * 64 + fr; const int col0 = u.pn * BM + wc * 32 + 8 * fq;
#pragma unroll
        for (int ai = 0; ai < 2; ++ai)
#pragma unroll
            for (int m = 0; m < 4; ++m) { const int r = row0 + ai * HALF + m * 16;
                if (r < rlim) {
                    const int mi = r - 16384;
                    float* dmeta = xmb + (size_t)(mi < 64 ? g * 64 + mi : ((mi >> 6) - 1) * 64 + (mi & 63)) * 1024;
                    const float* src = r < 16384 ? om + (size_t)r * 1024 : (mt ? mt + (size_t)(mi & 15) * 1024 : (const float*)dmeta);
                    float* dst = r < 16384 ? nm + (size_t)r * 1024 : dmeta;
#pragma unroll
                    for (int bj = 0; bj < 2; ++bj)
#pragma unroll
                        for (int n = 0; n < 2; ++n) { const int c = col0 + bj * HALF + 4 * n;
                            const f32x4 xo = *(const f32x4*)(src + c); *(f32x4*)(dst + c) = xo + acc[ai][bj][m][n]; } } }
    }
};
template <class Epi, class Sched, bool ALIGN_EPI = false, bool SP2 = false>
__device__ __forceinline__ void gemm_phase(PG8_LAS unsigned char* lds, const Gemm g, const Sched& S, const Epi& E, int wv) {
    const int tid = launder_tid(wv), wid = __builtin_amdgcn_readfirstlane(tid >> 6), lane = tid & 63, wr = wid >> 2, wc = wid & 3, fr = lane & 15, fq = lane >> 4;
    const int K = g.K, nt = K / BK;
    unsigned voffA[2], voffB[2];
#pragma unroll
    for (int i = 0; i < 2; ++i) { int R, C; stage_rc(tid * 16 + i * 8192, R, C); const int Rb = Epi::PERM ? ((R & ~31) + perm32(R & 31)) : R;
        voffA[i] = (unsigned)(R * K + C) * 2u; voffB[i] = (unsigned)(Rb * K + C) * 2u; }
    const size_t kstep = (size_t)(BK * 2);
    const size_t hstep = (size_t)HALF * K * 2;
    const size_t tstep = 2 * hstep;
    const unsigned ldsw = (unsigned)wid * 1024u;
    const int aoff = lds_byte(wr * 64 + fr, fq * 8), boff = lds_byte(wc * 32 + fr, fq * 8);
#define PG8_SA(b, h) (((b) * 2 + (h)) * HTB)
#define PG8_SB(b, h) ((4 + (b) * 2 + (h)) * HTB)
#define PG8_STAGE(bufoff, gbase, voff) do { _Pragma("unroll") for (int _i = 0; _i < 2; ++_i) \
        __builtin_amdgcn_global_load_lds((const unsigned*)((const char*)(gbase) + (voff)[_i]), (PG8_LAS unsigned*)(lds + (bufoff) + ldsw + _i * 8192), 16, 0, 0); } while (0)
#define PG8_LDA(dst, b, h) do { _Pragma("unroll") for (int m = 0; m < 4; ++m) _Pragma("unroll") for (int k = 0; k < 2; ++k) dst[m][k] = *(const PG8_LAS bf16x8*)(lds + PG8_SA(b, h) + aoff + m * 2048 + k * 1024); } while (0)
#define PG8_LDB(dst, b, h) do { _Pragma("unroll") for (int n = 0; n < 2; ++n) _Pragma("unroll") for (int k = 0; k < 2; ++k) dst[n][k] = *(const PG8_LAS bf16x8*)(lds + PG8_SB(b, h) + boff + n * 2048 + k * 1024); } while (0)
#define PG8_MMA(ai, bj, At, Bt) do { __builtin_amdgcn_s_setprio(1); _Pragma("unroll") for (int m = 0; m < 4; ++m) _Pragma("unroll") for (int n = 0; n < 2; ++n) _Pragma("unroll") for (int k = 0; k < 2; ++k) \
        acc[ai][bj][m][n] = __builtin_amdgcn_mfma_f32_16x16x32_bf16(Bt[n][k], At[m][k], acc[ai][bj][m][n], 0, 0, 0); __builtin_amdgcn_s_setprio(0); } while (0)
#define PG8_WAIT_V(n) asm volatile("s_waitcnt vmcnt(" #n ")" ::: "memory")
#define PG8_WAIT_L(n) asm volatile("s_waitcnt lgkmcnt(" #n ")" ::: "memory")
#define PG8_BAR __builtin_amdgcn_s_barrier()
#define PG8_SCHED __builtin_amdgcn_sched_barrier(0)
    Unit cur, nxt; int ui = 0;
    if (!S.next(0, cur)) return;
    f32x4 acc[2][2][4][2];
#pragma unroll
    for (int a = 0; a < 2; ++a)
#pragma unroll
        for (int b = 0; b < 2; ++b)
#pragma unroll
            for (int m = 0; m < 4; ++m)
#pragma unroll
                for (int n = 0; n < 2; ++n) { float z_ = 0.f; asm volatile("" : "+v"(z_)); acc[a][b][m][n] = (f32x4){z_, z_, z_, z_}; }
    bf16x8 At[4][2], B0[2][2], B1[2][2];
    const char* cA = (const char*)g.A + (g.pn_per_ab ? (size_t)(cur.pn / g.pn_per_ab) * g.ab_stride : (size_t)0) + (size_t)cur.pm * tstep; const char* cB = (const char*)g.Bt + (size_t)cur.pn * tstep;
    S.a_ready(cur);
    if constexpr (SP2) {
        PG8_STAGE(PG8_SB(0, 0), cB, voffB); PG8_STAGE(PG8_SB(0, 1), cB + hstep, voffB); PG8_STAGE(PG8_SA(0, 0), cA, voffA); PG8_STAGE(PG8_SA(0, 1), cA + hstep, voffA);
        if (wr == 1) PG8_BAR;
        PG8_WAIT_V(2); PG8_BAR;
        PG8_STAGE(PG8_SB(1, 0), cB + kstep, voffB); PG8_STAGE(PG8_SA(1, 0), cA + kstep, voffA); PG8_STAGE(PG8_SB(1, 1), cB + hstep + kstep, voffB);
        PG8_WAIT_V(6); PG8_BAR;
    } else {
        PG8_STAGE(PG8_SB(0, 0), cB, voffB); PG8_STAGE(PG8_SA(0, 0), cA, voffA); PG8_STAGE(PG8_SB(0, 1), cB + hstep, voffB); PG8_STAGE(PG8_SA(0, 1), cA + hstep, voffA);
        if (wr == 1) PG8_BAR;
        PG8_WAIT_V(4); PG8_BAR;
        PG8_STAGE(PG8_SB(1, 0), cB + kstep, voffB); PG8_STAGE(PG8_SA(1, 0), cA + kstep, voffA); PG8_STAGE(PG8_SB(1, 1), cB + hstep + kstep, voffB);
        PG8_WAIT_V(6); PG8_BAR;
    }
    for (;;) {
        const bool has_next = S.next(ui + 1, nxt);
        const char* nA = has_next ? (const char*)g.A + (g.pn_per_ab ? (size_t)(nxt.pn / g.pn_per_ab) * g.ab_stride : (size_t)0) + (size_t)nxt.pm * tstep : cA; const char* nB = has_next ? (const char*)g.Bt + (size_t)nxt.pn * tstep : cB;
#pragma unroll 1
        for (int t = 0; t < nt; t += 2) {
            const bool last = (t == nt - 2);
            const char* a1 = cA + (size_t)(t + 1) * kstep;
            const char* a2 = last ? nA : cA + (size_t)(t + 2) * kstep; const char* b2 = last ? nB : cB + (size_t)(t + 2) * kstep;
            const char* a3 = a2 + kstep; const char* b3 = b2 + kstep;
            if (last && has_next) S.a_ready(nxt);
            if constexpr (SP2) {
            PG8_LDB(B0, 0, 0); PG8_LDB(B1, 0, 1); PG8_SCHED; PG8_LDA(At, 0, 0); PG8_STAGE(PG8_SA(1, 1), a1 + hstep, voffA);
            PG8_WAIT_V(8); PG8_WAIT_L(0); PG8_BAR; PG8_MMA(0, 0, At, B0); PG8_MMA(0, 1, At, B1); PG8_BAR; PG8_SCHED;
            PG8_LDA(At, 0, 1); PG8_STAGE(PG8_SB(0, 0), b2, voffB); PG8_STAGE(PG8_SB(0, 1), b2 + hstep, voffB); PG8_STAGE(PG8_SA(0, 0), a2, voffA);
            PG8_WAIT_V(8); PG8_WAIT_L(0); PG8_BAR; PG8_MMA(1, 0, At, B0); PG8_MMA(1, 1, At, B1); PG8_BAR; PG8_SCHED;
            PG8_LDB(B0, 1, 0); PG8_LDB(B1, 1, 1); PG8_SCHED; PG8_LDA(At, 1, 0); PG8_STAGE(PG8_SA(0, 1), a2 + hstep, voffA);
            PG8_WAIT_V(8); PG8_WAIT_L(0); PG8_BAR; PG8_MMA(0, 0, At, B0); PG8_MMA(0, 1, At, B1); PG8_BAR; PG8_SCHED;
            PG8_LDA(At, 1, 1); PG8_STAGE(PG8_SB(1, 0), b3, voffB); PG8_STAGE(PG8_SB(1, 1), b3 + hstep, voffB); PG8_STAGE(PG8_SA(1, 0), a3, voffA);
            PG8_WAIT_V(8); PG8_WAIT_L(0); PG8_BAR; PG8_MMA(1, 0, At, B0); PG8_MMA(1, 1, At, B1); PG8_BAR; PG8_SCHED;
            } else {
            PG8_LDB(B0, 0, 0); PG8_SCHED; PG8_LDA(At, 0, 0); PG8_STAGE(PG8_SA(1, 1), a1 + hstep, voffA);
            PG8_WAIT_L(8); PG8_BAR; PG8_WAIT_L(0); PG8_MMA(0, 0, At, B0); PG8_BAR; PG8_SCHED;
            PG8_LDB(B1, 0, 1); PG8_STAGE(PG8_SB(0, 0), b2, voffB);
            PG8_BAR; PG8_WAIT_L(0); PG8_MMA(0, 1, At, B1); PG8_BAR;
            PG8_LDA(At, 0, 1); PG8_STAGE(PG8_SA(0, 0), a2, voffA);
            PG8_BAR; PG8_WAIT_L(0); PG8_MMA(1, 0, At, B0); PG8_BAR; PG8_SCHED;
            PG8_STAGE(PG8_SB(0, 1), b2 + hstep, voffB);
            PG8_WAIT_V(6); PG8_BAR; PG8_MMA(1, 1, At, B1); PG8_BAR;
            PG8_LDB(B0, 1, 0); PG8_SCHED; PG8_LDA(At, 1, 0); PG8_STAGE(PG8_SA(0, 1), a2 + hstep, voffA);
            PG8_WAIT_L(8); PG8_BAR; PG8_WAIT_L(0); PG8_MMA(0, 0, At, B0); PG8_BAR; PG8_SCHED;
            PG8_LDB(B1, 1, 1); PG8_STAGE(PG8_SB(1, 0), b3, voffB);
            PG8_BAR; PG8_WAIT_L(0); PG8_MMA(0, 1, At, B1); PG8_BAR;
            PG8_LDA(At, 1, 1); PG8_STAGE(PG8_SA(1, 0), a3, voffA);
            PG8_BAR; PG8_WAIT_L(0); PG8_MMA(1, 0, At, B0); PG8_BAR; PG8_SCHED;
            PG8_STAGE(PG8_SB(1, 1), b3 + hstep, voffB);
            PG8_WAIT_V(6); PG8_BAR; PG8_MMA(1, 1, At, B1); PG8_BAR;
            }
        }
        if constexpr (ALIGN_EPI) { if (wr == 0) PG8_BAR; }
        if constexpr (!Epi::AFTER_DRAIN) { E(acc, cur, wr, wc, fr, fq); S.done(cur); }
        if (!has_next) break;
#pragma unroll
        for (int a = 0; a < 2; ++a)
#pragma unroll
            for (int b = 0; b < 2; ++b)
#pragma unroll
                for (int m = 0; m < 4; ++m)
#pragma unroll
                    for (int n = 0; n < 2; ++n) { float z_ = 0.f; asm volatile("" : "+v"(z_)); acc[a][b][m][n] = (f32x4){z_, z_, z_, z_}; }
        cur = nxt; cA = nA; cB = nB; ++ui;
        if constexpr (ALIGN_EPI) { if (wr == 1) PG8_BAR; }
    }
    PG8_WAIT_V(0);
    if constexpr (!ALIGN_EPI) { if (wr == 0) PG8_BAR; }
    PG8_BAR;
    if constexpr (Epi::AFTER_DRAIN) { E.fused(acc, cur, wr, wc, fr, fq, lds, wid, lane); S.done(cur); }
#undef PG8_SA
#undef PG8_SB
#undef PG8_STAGE
#undef PG8_LDA
#undef PG8_LDB
#undef PG8_MMA
#undef PG8_WAIT_V
#undef PG8_WAIT_L
#undef PG8_BAR
#undef PG8_SCHED
}
}
typedef unsigned short bf16_t;
typedef short bf16x8 __attribute__((ext_vector_type(8)));
typedef float f32x4 __attribute__((ext_vector_type(4)));
typedef float f32x16 __attribute__((ext_vector_type(16)));
constexpr int LSEQ = 4112, TREAL = 16384, TG = 16448, TGP = 16640, NGRP = 3;
constexpr size_t SLOT_E = (size_t)TGP * 512;
constexpr size_t SLOT_B = SLOT_E * 2;
constexpr size_t MiB = 1u << 20;
constexpr size_t WS_XMETA = 1 * MiB, WS_DECAY = 2 * MiB, WS_SIDE = 3 * MiB + 512 * 1024, WS_W = 5 * MiB, WS_SLOTS = 53 * MiB;
constexpr size_t WS_NEED = 512 * MiB;
static_assert(WS_SLOTS + 25 * SLOT_B + (size_t)(16448 - 11408) * 8960 <= 512 * MiB, "record tail fits the workspace");
constexpr size_t WO_IN = 0, WO_G = 7864320, WO_BP = 12058624, WO_OUT = 14155776, WO_1 = 15204352, WO_2 = 19398656, WO_LR = 23592960;
constexpr int LDS_BYTES = 140 * 1024;
enum { I_XP = 0, I_XS, I_META, I_NMIX, I_WIN, I_LBL, I_ONORM, I_CONV, I_QN, I_KN, I_LAM, I_SUBLN, I_MU, I_W0, I_W2, I_A0, I_A2, I_G2, I_KK, I_KA, I_RK, I_LNG, I_LNB, I_WG, I_BP, I_WOUT, I_NMLP, I_W1, I_W2M };
struct Params { const float* in[29]; float* out; unsigned char* ws; };
#define GPTR(T, p) ((T*)(__attribute__((address_space(1))) T*)(p))
typedef const __attribute__((address_space(4))) Params* KParamsPtr;
typedef unsigned u32x4g_t __attribute__((ext_vector_type(4)));
#define GLD16(p) (*(const __attribute__((address_space(1))) u32x4g_t*)(p))
DEV KParamsPtr kparams() { KParamsPtr p = (KParamsPtr)__builtin_amdgcn_kernarg_segment_ptr(); asm volatile("" : "+s"(p)); return p; }
DEV Params load_params() { KParamsPtr p = kparams(); Params r;
#pragma unroll
    for (int i = 0; i < 29; ++i) r.in[i] = (const float*)(const __attribute__((address_space(1))) float*)(unsigned long long)p->in[i];
    r.out = (float*)(__attribute__((address_space(1))) float*)(unsigned long long)p->out; r.ws = p->ws; return r; }
DEV unsigned char* launder_ws(unsigned char* p) { __attribute__((address_space(1))) unsigned char* g = (__attribute__((address_space(1))) unsigned char*)(unsigned long long)p; asm volatile("" : "+s"(g)); return (unsigned char*)g; }
DEV unsigned zero_u() { unsigned z = 0u; asm volatile("" : "+v"(z)); return z; }

#define ROWPRO const int tid_ = launder_tid(wv); const int lane = tid_ & 63; const int gw = bid * 8 + __builtin_amdgcn_readfirstlane(tid_ >> 6); const int ngw = nb * 8;
DEV float bf2f(unsigned short u) { return __uint_as_float((unsigned)u << 16); }
DEV unsigned pk2(float lo, float hi) { return pg8::cvt_pk_bf16(lo, hi); }
DEV void unpack8(const uint4 w, float* f) {
    f[0] = __uint_as_float(w.x << 16); f[1] = __uint_as_float(w.x & 0xffff0000u); f[2] = __uint_as_float(w.y << 16); f[3] = __uint_as_float(w.y & 0xffff0000u);
    f[4] = __uint_as_float(w.z << 16); f[5] = __uint_as_float(w.z & 0xffff0000u); f[6] = __uint_as_float(w.w << 16); f[7] = __uint_as_float(w.w & 0xffff0000u); }
DEV uint4 pack8(const float* f) { uint4 o; o.x = pk2(f[0], f[1]); o.y = pk2(f[2], f[3]); o.z = pk2(f[4], f[5]); o.w = pk2(f[6], f[7]); return o; }
DEV bf16_t* slotp(const Params& P, int s) { return GPTR(bf16_t, P.ws + WS_SLOTS + (size_t)s * SLOT_B); }
DEV int row_of(int sl, int p) { return p >= 16 ? sl * 4096 + p - 16 : TREAL + sl * 16 + p; }
DEV void pos_of(int r, int& sl, int& p) { if (r < TREAL) { sl = r >> 12; p = (r & 4095) + 16; } else { const int m = r - TREAL; sl = m >> 4; p = m & 15; } }
DEV float wave_sum(float v) {
#pragma unroll
    for (int o = 1; o < 64; o <<= 1) v += __shfl_xor(v, o);
    return v; }
DEV float red8(float v) { v += __shfl_xor(v, 1); v += __shfl_xor(v, 2); v += __shfl_xor(v, 4); return v; }
DEV f32x4 mfma16(bf16x8 a, bf16x8 b, f32x4 c) { return __builtin_amdgcn_mfma_f32_16x16x32_bf16(a, b, c, 0, 0, 0); }
DEV f32x16 mfma32(bf16x8 a, bf16x8 b, f32x16 c) { return __builtin_amdgcn_mfma_f32_32x32x16_bf16(a, b, c, 0, 0, 0); }
DEV const float* x_in_row(const Params& P, int g, int r) {
    if (r < TREAL) return (g < 2 ? P.in[I_XP] + (size_t)g * TREAL * 1024 : P.in[I_XS]) + (size_t)r * 1024;
    return P.in[I_META] + (size_t)((r - TREAL) & 15) * 1024; }
DEV float* x_cur_row(const Params& P, int g, int r) {
    if (r < TREAL) return P.out + ((size_t)g * TREAL + r) * 1024;
    const int m = r - TREAL;
    return GPTR(float, P.ws + WS_XMETA) + (size_t)(m < 64 ? g * 64 + m : ((m >> 6) - 1) * 64 + (m & 63)) * 1024; }

DEV int gate_row(int n) { const int br = n >> 10, c = n & 1023, pn = c >> 6, oc = c & 63, wc = oc >> 4, fq = (oc >> 2) & 3, i = oc & 3; return pn * 256 + (br >> 1) * 128 + wc * 32 + fq * 8 + (br & 1) * 4 + i; }
template <int MODE> DEV void wt_items(const float* __restrict__ W, int K, int N, bf16_t* WT, int row_off, float* scr, int gw, int ngw, int lane) {
    const int nblk = N >> 5, items = (K >> 6) * nblk;
    for (int it = gw; it < items; it += ngw) {
        const int kb = it / nblk, nbk = it - kb * nblk, k0 = 64 * kb, n0 = 32 * nbk;
#pragma unroll 8
        for (int i = 0; i < 32; ++i) { const int kk = 2 * i + (lane >> 5); scr[kk * 33 + (lane & 31)] = W[(size_t)(k0 + kk) * N + n0 + (lane & 31)]; }
        asm volatile("s_waitcnt lgkmcnt(0)" ::: "memory");
        const int c = lane & 7;
#pragma unroll
        for (int j = 0; j < 4; ++j) { const int n = (lane >> 3) + 8 * j; const float* sp = scr + (8 * c) * 33 + n;
            uint4 o; o.x = pk2(sp[0 * 33], sp[1 * 33]); o.y = pk2(sp[2 * 33], sp[3 * 33]); o.z = pk2(sp[4 * 33], sp[5 * 33]); o.w = pk2(sp[6 * 33], sp[7 * 33]);
            const int dr = MODE == 1 ? gate_row(n0 + n) : n0 + n + row_off;
            *(uint4*)(WT + (size_t)dr * K + k0 + 8 * c) = o; }
        asm volatile("s_waitcnt lgkmcnt(0)" ::: "memory");
    }
}
DEV void phase_weights(const Params& P0, int layer, unsigned char* lds, int bid, int nb, int wv) {
    Params P = load_params(); P.ws = launder_ws(P.ws);
    const int tid = launder_tid(wv), lane = tid & 63, w = __builtin_amdgcn_readfirstlane(tid >> 6);
    const int gtid = bid * 512 + tid, gth = nb * 512, gw = bid * 8 + w, ngw = nb * 8;
    float* scr = (float*)(lds + w * 8448);
    bf16_t* W = GPTR(bf16_t, P.ws + WS_W);
    wt_items<0>(P.in[I_WIN] + (size_t)layer * 1024 * 7552, 1024, 7552, W + WO_IN, 0, scr, gw, ngw, lane);
    for (int it = gtid; it < 128 * 128; it += gth) { const unsigned z = zero_u(); *(uint4*)(W + WO_IN + (size_t)7552 * 1024 + (size_t)it * 8) = make_uint4(z, z, z, z); }
    wt_items<1>(P.in[I_WG] + (size_t)layer * 1024 * 4096, 1024, 4096, W + WO_G, 0, scr, gw, ngw, lane);
    for (int n = 0; n < 4; ++n) wt_items<0>(P.in[I_BP] + (size_t)(layer * 4 + n) * 512 * 1024, 512, 1024, W + WO_BP, n * 1024, scr, gw, ngw, lane);
    wt_items<0>(P.in[I_WOUT] + (size_t)layer * 1024 * 1024, 1024, 1024, W + WO_OUT, 0, scr, gw, ngw, lane);
    wt_items<0>(P.in[I_W1] + (size_t)layer * 1024 * 4096, 1024, 4096, W + WO_1, 0, scr, gw, ngw, lane);
    wt_items<0>(P.in[I_W2M] + (size_t)layer * 4096 * 1024, 4096, 1024, W + WO_2, 0, scr, gw, ngw, lane);
    for (int it = gtid; it < 2560 * 48; it += gth) {
        const int row = it / 48, k8 = it - row * 48, seg = row >> 9, c = row & 511, k0 = k8 * 8;
        float v[8];
#pragma unroll
        for (int j = 0; j < 8; ++j) { const int k = k0 + j; float x = 0.f;
            if (seg == 0) { if (k < 64) x = P.in[I_W2][((size_t)(layer * 2 + 0) * 64 + k) * 512 + c]; }
            else if (seg == 1) { if (k >= 64 && k < 128) x = P.in[I_W2][((size_t)(layer * 2 + 1) * 64 + (k - 64)) * 512 + c]; }
            else if (seg == 2) { if (k >= 128 && k < 192) x = P.in[I_A2][((size_t)(layer * 2 + 0) * 64 + (k - 128)) * 512 + c]; }
            else if (seg == 3) { if (k >= 192 && k < 256) x = P.in[I_A2][((size_t)(layer * 2 + 1) * 64 + (k - 192)) * 512 + c]; }
            else { if (k >= 256) x = P.in[I_G2][((size_t)layer * 128 + (k - 256)) * 512 + c]; }
            v[j] = x; }
        *(uint4*)(W + WO_LR + (size_t)row * 384 + k0) = pack8(v);
    }
}

DEV void phase_rmsnorm(const Params& P0, int g, bool src_in, int gain_idx, int layer, int nrows, int nvalid, int bid, int nb, int wv) {
    Params P = load_params(); P.ws = launder_ws(P.ws);
    ROWPRO
    const float* gain = P.in[gain_idx] + layer * 1024;
    bf16_t* H = slotp(P, 0);
    for (int r = gw; r < nrows; r += ngw) {
        uint2* o8 = (uint2*)(H + (size_t)r * 1024) + lane;
        if (r >= nvalid) {
#pragma unroll
            for (int j = 0; j < 4; ++j) { const unsigned z = zero_u(); o8[64 * j] = make_uint2(z, z); }
            continue; }
        const f32x4* xr = (const f32x4*)(src_in ? x_in_row(P, g, r) : (const float*)x_cur_row(P, g, r)) + lane;
        f32x4 v[4]; float s = 0.f;
#pragma unroll
        for (int j = 0; j < 4; ++j) { v[j] = xr[64 * j]; s += (v[j].x * v[j].x + v[j].y * v[j].y) + (v[j].z * v[j].z + v[j].w * v[j].w); }
        const float rs = rsqrtf(wave_sum(s) * (1.f / 1024.f) + 1e-6f);
#pragma unroll
        for (int j = 0; j < 4; ++j) { const f32x4 gg = *((const f32x4*)gain + lane + 64 * j);
            o8[64 * j] = make_uint2(pk2(v[j].x * rs * gg.x, v[j].y * rs * gg.y), pk2(v[j].z * rs * gg.z, v[j].w * rs * gg.w)); }
    }
}
DEV void phase_da_prep(const Params& P0, int layer, int bid, int nb, int wv) {
    Params P = load_params(); P.ws = launder_ws(P.ws);
    ROWPRO
    const float inv8[8] = {1.0f, 0.19392274474868576f, 0.03760603093086393f, 0.007292664737217109f, 0.001414213562373095f, 0.0002742481756762073f, 5.318295896944988e-05f, 1.031338537721246e-05f};
    const int d0 = (lane & 7) * 8;
    float gq[8], gk[8];
#pragma unroll
    for (int j = 0; j < 8; ++j) { gq[j] = P.in[I_QN][layer * 64 + d0 + j]; gk[j] = P.in[I_KN][layer * 64 + d0 + j]; }
    for (int r = gw; r < TG; r += ngw) {
        int sl, p; pos_of(r, sl, p);
        float cs[8], sn[8];
#pragma unroll
        for (int j = 0; j < 8; ++j) { const float ang = (float)p * inv8[j]; double a = (double)ang; a -= 6.283185307179586 * __builtin_rint(a * 0.15915494309189535); const float rr = (float)a; cs[j] = __cosf(rr); sn[j] = __sinf(rr); }
#pragma unroll
        for (int which = 0; which < 2; ++which) {
            uint4* ptr = (uint4*)(slotp(P, 10 + which) + (size_t)r * 512) + lane;
            float f[8]; unpack8(*ptr, f);
            float ss = 0.f;
#pragma unroll
            for (int j = 0; j < 8; ++j) ss += f[j] * f[j];
            ss = red8(ss);
            const float rs = rsqrtf(ss * (1.f / 64.f) + 1e-6f);
#pragma unroll
            for (int j = 0; j < 8; ++j) f[j] = f[j] * rs * (which == 0 ? gq[j] : gk[j]);
#pragma unroll
            for (int j = 0; j < 8; ++j) { const float pr = __shfl_xor(f[j], 1);
                if ((lane & 7) == 0) f[j] = f[j] * cs[j] - pr * sn[j];
                else if ((lane & 7) == 1) f[j] = f[j] * cs[j] + pr * sn[j]; }
            if (which == 0) {
#pragma unroll
                for (int j = 0; j < 8; ++j) f[j] *= 0.18033688011112042f; }
            *ptr = pack8(f);
        }
    }
}
DEV void phase_conv(const Params& P0, int layer, int bid, int nb, int wv) {
    Params P = load_params(); P.ws = launder_ws(P.ws);
    ROWPRO
    const int c0 = lane * 8;
    float w0[8], w1[8], w2[8];
#pragma unroll
    for (int j = 0; j < 8; ++j) { w0[j] = P.in[I_CONV][(layer * 3 + 0) * 512 + c0 + j]; w1[j] = P.in[I_CONV][(layer * 3 + 1) * 512 + c0 + j]; w2[j] = P.in[I_CONV][(layer * 3 + 2) * 512 + c0 + j]; }
    const bf16_t* SB = slotp(P, 7); const bf16_t* SC = slotp(P, 8); const bf16_t* SH = slotp(P, 9); bf16_t* Y = slotp(P, 3);
    for (int r = gw; r < TG; r += ngw) {
        int sl, p; pos_of(r, sl, p);
        float acc[8], a[8], b[8];
        unpack8(*((const uint4*)(SC + (size_t)r * 512) + lane), a); unpack8(*((const uint4*)(SH + (size_t)r * 512) + lane), b);
#pragma unroll
        for (int j = 0; j < 8; ++j) acc[j] = a[j] * b[j] * w1[j];
        if (p > 0) { const int rp = row_of(sl, p - 1);
            unpack8(*((const uint4*)(SC + (size_t)rp * 512) + lane), a); unpack8(*((const uint4*)(SH + (size_t)rp * 512) + lane), b);
#pragma unroll
            for (int j = 0; j < 8; ++j) acc[j] += a[j] * b[j] * w0[j]; }
        if (p < LSEQ - 1) { const int rn = row_of(sl, p + 1);
            unpack8(*((const uint4*)(SC + (size_t)rn * 512) + lane), a); unpack8(*((const uint4*)(SH + (size_t)rn * 512) + lane), b);
#pragma unroll
            for (int j = 0; j < 8; ++j) acc[j] += a[j] * b[j] * w2[j]; }
        unpack8(*((const uint4*)(SB + (size_t)r * 512) + lane), a);
#pragma unroll
        for (int j = 0; j < 8; ++j) acc[j] *= a[j];
        *((uint4*)(Y + (size_t)r * 512) + lane) = pack8(acc);
    }
}
DEV void phase_rw_prep(const Params& P0, int layer, int bid, int nb, int wv) {
    Params P = load_params(); P.ws = launder_ws(P.ws);
    ROWPRO
    const float* mu = P.in[I_MU] + (size_t)layer * 1920;
    for (int r = gw; r < TG; r += ngw) {
        int sl, p; pos_of(r, sl, p);
        const int rp = p > 0 ? row_of(sl, p - 1) : -1, rn = p < LSEQ - 1 ? row_of(sl, p + 1) : -1;
#pragma unroll
        for (int grp = 0; grp < 4; ++grp) {
            if (grp == 3 && lane >= 48) break;
            const int c0 = (grp < 3 ? grp * 512 : 1536) + lane * 8;
            const bf16_t* src = slotp(P, 13 + (c0 >> 9)) + (c0 & 511);
            float u[8], up[8], un[8], xm[8];
            unpack8(*(const uint4*)(src + (size_t)r * 512), u);
            if (rp >= 0) unpack8(*(const uint4*)(src + (size_t)rp * 512), up); else {
#pragma unroll
                for (int j = 0; j < 8; ++j) up[j] = 0.f; }
            if (rn >= 0) unpack8(*(const uint4*)(src + (size_t)rn * 512), un); else {
#pragma unroll
                for (int j = 0; j < 8; ++j) un[j] = 0.f; }
#pragma unroll
            for (int j = 0; j < 8; ++j) xm[j] = u[j] + mu[c0 + j] * (0.5f * (up[j] + un[j]) - u[j]);
            if (grp < 3) {
                *((uint4*)(slotp(P, 17 + grp) + (size_t)r * 512) + lane) = pack8(xm);
                if (grp == 1) {
                    float kk[8], ss = 0.f;
#pragma unroll
                    for (int j = 0; j < 8; ++j) { kk[j] = xm[j] * P.in[I_KK][layer * 512 + c0 - 512 + j]; ss += kk[j] * kk[j]; }
                    ss = red8(ss);
                    const float inv = 1.0f / fmaxf(sqrtf(ss), 1e-12f);
#pragma unroll
                    for (int j = 0; j < 8; ++j) kk[j] *= inv;
                    *((uint4*)(slotp(P, 20) + (size_t)r * 512) + lane) = pack8(kk); }
            } else {
                const int a0 = lane * 8;
                float o[8];
#pragma unroll
                for (int j = 0; j < 8; ++j) { const float x = xm[j];
                    if (a0 < 128) { const float e = __expf(2.f * x); o[j] = 1.f - 2.f / (e + 1.f); }
                    else if (a0 < 256) o[j] = x;
                    else o[j] = 1.f / (1.f + __expf(-x)); }
                *((uint4*)(slotp(P, 21) + (size_t)r * 384) + lane) = pack8(o);
            }
        }
    }
    for (int r = TG + gw; r < TGP; r += ngw) if (lane < 48) { const unsigned z = zero_u(); *((uint4*)(slotp(P, 21) + (size_t)r * 384) + lane) = make_uint4(z, z, z, z); }
}
DEV void phase_rw_post(const Params& P0, int layer, int g, int nrows, int bid, int nb, int wv) {
    Params P = load_params(); P.ws = launder_ws(P.ws);
    ROWPRO
    const int c0 = lane * 8;
    float ka[8], rk[8], lg[8], lb[8];
#pragma unroll
    for (int j = 0; j < 8; ++j) { ka[j] = P.in[I_KA][layer * 512 + c0 + j]; rk[j] = P.in[I_RK][layer * 512 + c0 + j]; lg[j] = P.in[I_LNG][layer * 512 + c0 + j]; lb[j] = P.in[I_LNB][layer * 512 + c0 + j]; }
    for (int r = gw; r < nrows; r += ngw) {
        float of[8], ob[8], o[8];
        unpack8(*((const uint4*)(slotp(P, 15) + (size_t)r * 512) + lane), of); unpack8(*((const uint4*)(slotp(P, 16) + (size_t)r * 512) + lane), ob);
        float s = 0.f;
#pragma unroll
        for (int j = 0; j < 8; ++j) { o[j] = of[j] + ob[j]; s += o[j]; }
        const float mean = red8(s) * (1.f / 64.f);
        float q = 0.f;
#pragma unroll
        for (int j = 0; j < 8; ++j) { o[j] -= mean; q += o[j] * o[j]; }
        const float rs = rsqrtf(red8(q) * (1.f / 64.f) + 64e-5f);
        float rr[8], kk[8], vv[8], af[8], ab[8], gg[8];
        unpack8(*((const uint4*)(slotp(P, 17) + (size_t)r * 512) + lane), rr); unpack8(*((const uint4*)(slotp(P, 18) + (size_t)r * 512) + lane), kk);
        unpack8(*((const uint4*)(slotp(P, 19) + (size_t)r * 512) + lane), vv); unpack8(*((const uint4*)(slotp(P, 24) + (size_t)r * 512) + lane), af);
        unpack8(*((const uint4*)(slotp(P, 13) + (size_t)r * 512) + lane), ab); unpack8(*((const uint4*)(slotp(P, 14) + (size_t)r * 512) + lane), gg);
        float bs = 0.f;
#pragma unroll
        for (int j = 0; j < 8; ++j) { const float kd = kk[j] * (2.f + (af[j] + ab[j] - 2.f) * ka[j]); bs += rr[j] * kd * rk[j]; }
        bs = red8(bs);
        float y[8];
#pragma unroll
        for (int j = 0; j < 8; ++j) y[j] = (o[j] * rs * lg[j] + lb[j] + bs * vv[j]) * gg[j];
        const uint4 yv = pack8(y);
        *((uint4*)(slotp(P, 5) + (size_t)r * 512) + lane) = yv;
        if (layer == 0 && g < 2 && r >= TREAL) {
            bf16_t* sd = GPTR(bf16_t, P.ws + WS_SIDE) + (size_t)g * 4 * 64 * 512 + (size_t)(r - TREAL) * 512;
#pragma unroll
            for (int k = 0; k < 3; ++k) *((uint4*)(sd + (size_t)k * 64 * 512) + lane) = *((const uint4*)(slotp(P, 2 + k) + (size_t)r * 512) + lane);
            *((uint4*)(sd + (size_t)3 * 64 * 512) + lane) = yv; }
    }
    if (layer == 0 && g == 2) {
        for (int m2 = gw; m2 < 128; m2 += ngw) { const bf16_t* sd = GPTR(const bf16_t, P.ws + WS_SIDE) + (size_t)(m2 >> 6) * 4 * 64 * 512 + (size_t)(m2 & 63) * 512;
#pragma unroll
            for (int k = 0; k < 4; ++k) *((uint4*)(slotp(P, 2 + k) + (size_t)(TG + m2) * 512) + lane) = *((const uint4*)(sd + (size_t)k * 64 * 512) + lane); }
    }
}
DEV void hg_gate(float x, float lbv, float& lg, float& kk) {
    const float e = __expf(-fabsf(x)); const float sp = 1.f / (1.f + e);
    const float s = x >= 0.f ? sp : e * sp, s1 = x >= 0.f ? e * sp : sp;
    const float f = fmaxf(lbv, 1e-20f) + (1.f - lbv) * s;
    lg = __logf(f); kk = (1.f - lbv) * s1; }
DEV float hg_lb(const Params& P, int layer, int dir, int col) {
    if (layer == 0) return 0.f;
    const float a = P.in[I_LBL][(dir * 2 + 0) * 512 + col], b = P.in[I_LBL][(dir * 2 + 1) * 512 + col];
    return 1.f / (1.f + __expf(a - b)); }
DEV int hg_row(int sl, int c, int j, bool& valid) { if (c == 0) { valid = j < 16; return TREAL + sl * 16 + j; } valid = true; return sl * 4096 + (c - 1) * 64 + j; }
DEV void hg_cumsum(float* Lb, float* Bt, float* Seg, int dir, int tid) {
    const int ch = tid & 127, seg = tid >> 7;
    float v[16];
#pragma unroll
    for (int i = 0; i < 16; ++i) v[i] = Lb[(seg * 16 + i) * 128 + ch];
    if (dir == 0) {
#pragma unroll
        for (int i = 1; i < 16; ++i) v[i] += v[i - 1];
        Seg[seg * 128 + ch] = v[15];
    } else {
#pragma unroll
        for (int i = 14; i >= 0; --i) v[i] += v[i + 1];
        Seg[seg * 128 + ch] = v[0];
    }
    __syncthreads();
    const float s0 = Seg[ch], s1 = Seg[128 + ch], s2 = Seg[256 + ch], s3 = Seg[384 + ch];
    float off;
    if (dir == 0) off = seg == 0 ? 0.f : seg == 1 ? s0 : seg == 2 ? s0 + s1 : s0 + s1 + s2;
    else off = seg == 3 ? 0.f : seg == 2 ? s3 : seg == 1 ? s3 + s2 : s3 + s2 + s1;
#pragma unroll
    for (int i = 0; i < 16; ++i) Lb[(seg * 16 + i) * 128 + ch] = v[i] + off;
    if (seg == 0) Bt[ch] = (s0 + s1) + (s2 + s3);
}
DEV void phase_hg1(const Params& P0, int layer, unsigned char* lds, int bid, int nb, int wv) {
    Params P = load_params(); P.ws = launder_ws(P.ws);
    float* Lb = (float*)lds; bf16_t* KlT = (bf16_t*)(lds + 32768); bf16_t* VT = (bf16_t*)(lds + 32768 + 18432); float* Bt = (float*)(lds + 69632); float* Seg = (float*)(lds + 70656);
    bf16_t* X = slotp(P, 17); float* DC = GPTR(float, P.ws + WS_DECAY);
    const int tid = launder_tid(wv), lane = tid & 63, w = __builtin_amdgcn_readfirstlane(tid >> 6), j = tid >> 3, c0 = (tid & 7) * 16, l15 = lane & 15, quad = lane >> 4;
    for (int unit = bid; unit < 32 * 65; unit += nb) {
        const int chain = unit / 65, c = unit - chain * 65, sl = chain >> 3, head = (chain >> 1) & 3, dir = chain & 1;
        bool valid; const int r = hg_row(sl, c, j, valid);
        float lg[16], kk[16]; uint4 vv[2] = {make_uint4(0, 0, 0, 0), make_uint4(0, 0, 0, 0)};
        if (valid) {
            float fr[16];
            const uint4* fp = (const uint4*)(slotp(P, 3 + dir) + (size_t)r * 512 + head * 128 + c0);
            unpack8(fp[0], fr); unpack8(fp[1], fr + 8);
            const uint4* vp = (const uint4*)(slotp(P, 5) + (size_t)r * 512 + head * 128 + c0); vv[0] = vp[0]; vv[1] = vp[1];
#pragma unroll
            for (int e = 0; e < 16; ++e) hg_gate(fr[e], hg_lb(P, layer, dir, head * 128 + c0 + e), lg[e], kk[e]);
        } else {
#pragma unroll
            for (int e = 0; e < 16; ++e) { lg[e] = 0.f; kk[e] = 0.f; } }
#pragma unroll
        for (int e = 0; e < 16; e += 4) *(f32x4*)(Lb + j * 128 + c0 + e) = (f32x4){lg[e], lg[e + 1], lg[e + 2], lg[e + 3]};
        __syncthreads();
        hg_cumsum(Lb, Bt, Seg, dir, tid);
        __syncthreads();
        float vf[16]; unpack8(vv[0], vf); unpack8(vv[1], vf + 8);
#pragma unroll
        for (int e = 0; e < 16; ++e) { const float kl = kk[e] * __expf(Bt[c0 + e] - Lb[j * 128 + c0 + e]);
            KlT[(c0 + e) * 72 + j] = (bf16_t)(pk2(kl, 0.f) & 0xffffu); VT[(c0 + e) * 72 + j] = (bf16_t)(__float_as_uint(vf[e]) >> 16); }
        if (tid < 128) DC[(size_t)(chain * 65 + c) * 128 + tid] = __expf(Bt[tid]);
        __syncthreads();
        f32x4 acc[8];
#pragma unroll
        for (int ct = 0; ct < 8; ++ct) acc[ct] = (f32x4){0.f, 0.f, 0.f, 0.f};
#pragma unroll
        for (int ks = 0; ks < 2; ++ks) { const bf16x8 a = *(const bf16x8*)(VT + (w * 16 + l15) * 72 + ks * 32 + quad * 8);
#pragma unroll
            for (int ct = 0; ct < 8; ++ct) { const bf16x8 b = *(const bf16x8*)(KlT + (ct * 16 + l15) * 72 + ks * 32 + quad * 8); acc[ct] = mfma16(b, a, acc[ct]); } }
        bf16_t* xo = X + (size_t)(chain * 65 + c) * 16384;
#pragma unroll
        for (int ct = 0; ct < 8; ++ct) *(uint2*)(xo + (w * 16 + l15) * 128 + ct * 16 + quad * 4) = make_uint2(pk2(acc[ct][0], acc[ct][1]), pk2(acc[ct][2], acc[ct][3]));
        __syncthreads();
    }
}
DEV void phase_hg2(const Params& P0, int bid, int nb, int wv) {
    Params P = load_params(); P.ws = launder_ws(P.ws);
    const int gtid = bid * 512 + launder_tid(wv), gth = nb * 512;
    uint2* X = (uint2*)slotp(P, 17); const f32x4* DC = GPTR(const f32x4, P.ws + WS_DECAY);
    for (int e = gtid; e < 32 * 4096; e += gth) {
        const int chain = e >> 12, e4 = e & 4095, dir = chain & 1;
        f32x4 S = (f32x4){0.f, 0.f, 0.f, 0.f};
#pragma unroll 5
        for (int step = 0; step < 65; ++step) { const int c = dir ? 64 - step : step;
            const size_t idx = (size_t)(chain * 65 + c) * 4096 + e4;
            const uint2 kvw = X[idx]; const f32x4 dc = DC[(size_t)(chain * 65 + c) * 32 + (e4 & 31)];
            const f32x4 kv = (f32x4){__uint_as_float(kvw.x << 16), __uint_as_float(kvw.x & 0xffff0000u), __uint_as_float(kvw.y << 16), __uint_as_float(kvw.y & 0xffff0000u)};
            X[idx] = make_uint2(pk2(S[0], S[1]), pk2(S[2], S[3])); S = dc * S + kv; }
    }
}
DEV void phase_hg3(const Params& P0, int layer, unsigned char* lds, int bid, int nb, int wv) {
    Params P = load_params(); P.ws = launder_ws(P.ws);
    float* Lb = (float*)lds; bf16_t* Qs = (bf16_t*)(lds + 32768); bf16_t* Ks = (bf16_t*)(lds + 50176); bf16_t* Am = (bf16_t*)(lds + 67584);
    bf16_t* VT = (bf16_t*)(lds + 76800); bf16_t* Sb = (bf16_t*)(lds + 95232); float* Bt = (float*)(lds + 130048); float* Seg = (float*)(lds + 132096); float* Ost = (float*)lds;
    const bf16_t* X = slotp(P, 17);
    const int tid = launder_tid(wv), lane = tid & 63, w = __builtin_amdgcn_readfirstlane(tid >> 6), j = tid >> 3, c0 = (tid & 7) * 16, l15 = lane & 15, quad = lane >> 4;
    const int tt = w >> 1, st0 = (w & 1) * 2, vt0 = (w & 1) * 4;
    const int cfirst = layer == 0 ? 0 : 1;
    const int ncb = 65 - cfirst;
    for (int unit = bid; unit < 16 * ncb; unit += nb) {
        const int sh = unit / ncb, c = unit - sh * ncb + cfirst, sl = sh >> 2, head = sh & 3;
        bool valid; const int r = hg_row(sl, c, j, valid);
        float q[16]; uint4 gv[2] = {make_uint4(0, 0, 0, 0), make_uint4(0, 0, 0, 0)};
        if (valid) {
            const uint4* qp = (const uint4*)(slotp(P, 2) + (size_t)r * 512 + head * 128 + c0); unpack8(qp[0], q); unpack8(qp[1], q + 8);
            const uint4* vp = (const uint4*)(slotp(P, 5) + (size_t)r * 512 + head * 128 + c0); float vf[16]; unpack8(vp[0], vf); unpack8(vp[1], vf + 8);
#pragma unroll
            for (int e = 0; e < 16; ++e) VT[(c0 + e) * 72 + j] = (bf16_t)(__float_as_uint(vf[e]) >> 16);
            const uint4* gp = (const uint4*)(slotp(P, 6) + (size_t)r * 512 + head * 128 + c0); gv[0] = gp[0]; gv[1] = gp[1];
        } else {
#pragma unroll
            for (int e = 0; e < 16; ++e) { q[e] = 0.f; VT[(c0 + e) * 72 + j] = 0; } }
        f32x4 accA[2], accO[4];
#pragma unroll
        for (int i = 0; i < 2; ++i) accA[i] = (f32x4){0.f, 0.f, 0.f, 0.f};
#pragma unroll
        for (int i = 0; i < 4; ++i) accO[i] = (f32x4){0.f, 0.f, 0.f, 0.f};
#pragma unroll 1
        for (int dir = 0; dir < 2; ++dir) {
            float lg[16], kk[16];
            if (valid) { float fr[16];
                const uint4* fp = (const uint4*)(slotp(P, 3 + dir) + (size_t)r * 512 + head * 128 + c0); unpack8(fp[0], fr); unpack8(fp[1], fr + 8);
#pragma unroll
                for (int e = 0; e < 16; ++e) hg_gate(fr[e], hg_lb(P, layer, dir, head * 128 + c0 + e), lg[e], kk[e]);
            } else {
#pragma unroll
                for (int e = 0; e < 16; ++e) { lg[e] = 0.f; kk[e] = 0.f; } }
#pragma unroll
            for (int e = 0; e < 16; e += 4) *(f32x4*)(Lb + j * 128 + c0 + e) = (f32x4){lg[e], lg[e + 1], lg[e + 2], lg[e + 3]};
            __syncthreads();
            hg_cumsum(Lb, Bt, Seg, dir, tid);
            __syncthreads();
            {
                float qs[16], ks[16];
#pragma unroll
                for (int e = 0; e < 16; ++e) { const float b = Lb[j * 128 + c0 + e], rf = Lb[32 * 128 + c0 + e]; qs[e] = q[e] * __expf(b - rf); ks[e] = kk[e] * __expf(rf - b); }
                *(uint4*)(Qs + j * 136 + c0) = pack8(qs); *(uint4*)(Qs + j * 136 + c0 + 8) = pack8(qs + 8);
                *(uint4*)(Ks + j * 136 + c0) = pack8(ks); *(uint4*)(Ks + j * 136 + c0 + 8) = pack8(ks + 8);
            }
            {
                const int chain = sl * 8 + head * 2 + dir; const uint4* xs = (const uint4*)(X + (size_t)(chain * 65 + c) * 16384 + (size_t)(tid >> 2) * 128 + (tid & 3) * 32);
#pragma unroll
                for (int i = 0; i < 4; ++i) *(uint4*)(Sb + (tid >> 2) * 136 + (tid & 3) * 32 + i * 8) = xs[i];
            }
            __syncthreads();
            {
                f32x4 t0 = (f32x4){0.f, 0.f, 0.f, 0.f}, t1 = t0;
#pragma unroll
                for (int k4 = 0; k4 < 4; ++k4) { const bf16x8 a = *(const bf16x8*)(Qs + (tt * 16 + l15) * 136 + k4 * 32 + quad * 8);
                    const bf16x8 b0 = *(const bf16x8*)(Ks + ((st0 + 0) * 16 + l15) * 136 + k4 * 32 + quad * 8); const bf16x8 b1 = *(const bf16x8*)(Ks + ((st0 + 1) * 16 + l15) * 136 + k4 * 32 + quad * 8);
                    t0 = mfma16(a, b0, t0); t1 = mfma16(a, b1, t1); }
#pragma unroll
                for (int jj = 0; jj < 4; ++jj) { const int t = tt * 16 + quad * 4 + jj, s0 = (st0 + 0) * 16 + l15, s1 = (st0 + 1) * 16 + l15;
                    const bool k0 = dir == 0 ? s0 <= t : s0 >= t, k1 = dir == 0 ? s1 <= t : s1 >= t;
                    accA[0][jj] += k0 ? t0[jj] : 0.f; accA[1][jj] += k1 ? t1[jj] : 0.f; }
            }
            __syncthreads();
            {   float qg[16];
#pragma unroll
                for (int e = 0; e < 16; ++e) qg[e] = q[e] * __expf(Lb[j * 128 + c0 + e]);
                *(uint4*)(Qs + j * 136 + c0) = pack8(qg); *(uint4*)(Qs + j * 136 + c0 + 8) = pack8(qg + 8); }
            __syncthreads();
#pragma unroll
            for (int k4 = 0; k4 < 4; ++k4) { const bf16x8 a = *(const bf16x8*)(Qs + (tt * 16 + l15) * 136 + k4 * 32 + quad * 8);
#pragma unroll
                for (int v4 = 0; v4 < 4; ++v4) { const bf16x8 b = *(const bf16x8*)(Sb + ((vt0 + v4) * 16 + l15) * 136 + k4 * 32 + quad * 8); accO[v4] = mfma16(a, b, accO[v4]); } }
            __syncthreads();
        }
#pragma unroll
        for (int s2 = 0; s2 < 2; ++s2)
#pragma unroll
            for (int jj = 0; jj < 4; ++jj) Am[(tt * 16 + quad * 4 + jj) * 72 + (st0 + s2) * 16 + l15] = (bf16_t)(pk2(accA[s2][jj], 0.f) & 0xffffu);
        __syncthreads();
#pragma unroll
        for (int ks = 0; ks < 2; ++ks) { const bf16x8 a = *(const bf16x8*)(Am + (tt * 16 + l15) * 72 + ks * 32 + quad * 8);
#pragma unroll
            for (int v4 = 0; v4 < 4; ++v4) { const bf16x8 b = *(const bf16x8*)(VT + ((vt0 + v4) * 16 + l15) * 72 + ks * 32 + quad * 8); accO[v4] = mfma16(a, b, accO[v4]); } }
#pragma unroll
        for (int v4 = 0; v4 < 4; ++v4)
#pragma unroll
            for (int jj = 0; jj < 4; ++jj) Ost[(tt * 16 + quad * 4 + jj) * 132 + (vt0 + v4) * 16 + l15] = accO[v4][jj];
        __syncthreads();
        {   float o[16], ss = 0.f;
#pragma unroll
            for (int e = 0; e < 16; ++e) { o[e] = Ost[j * 132 + c0 + e]; ss += o[e] * o[e]; }
            ss = red8(ss);
            const float rs = rsqrtf(ss * (1.f / 128.f) + 1e-6f);
            float gf[16]; unpack8(gv[0], gf); unpack8(gv[1], gf + 8);
#pragma unroll
            for (int e = 0; e < 16; ++e) { const float gg = gf[e]; o[e] = o[e] * rs * P.in[I_ONORM][layer * 512 + head * 128 + c0 + e] * (gg / (1.f + __expf(-gg))); }
            if (valid) { uint4* yp = (uint4*)(slotp(P, 2) + (size_t)r * 512 + head * 128 + c0); yp[0] = pack8(o); yp[1] = pack8(o + 8); }
        }
        __syncthreads();
    }
}
DEV void phase_vtrans(const Params& P0, unsigned char* lds, int bid, int nb, int wv) {
    Params P = load_params(); P.ws = launder_ws(P.ws);
    bf16_t* T = (bf16_t*)lds;
    const bf16_t* V = slotp(P, 12); bf16_t* VTg = slotp(P, 6);
    const int tid = launder_tid(wv);
    for (int unit = bid; unit < 4 * 65 * 8; unit += nb) {
        const int sl = unit / 520, rem = unit - sl * 520, pt = rem >> 3, vdt = rem & 7;
        { const int tok = tid >> 3, c8 = (tid & 7) * 8, p = pt * 64 + tok;
          uint4 v = make_uint4(0, 0, 0, 0);
          if (p < LSEQ) v = *(const uint4*)(V + (size_t)row_of(sl, p) * 512 + vdt * 64 + c8);
          *(uint4*)(T + tok * 72 + c8) = v; }
        __syncthreads();
        { const int vd = tid >> 3, t8 = (tid & 7) * 8;
          unsigned short e[8];
#pragma unroll
          for (int i = 0; i < 8; ++i) { const int pp = t8 + i; const int sp = (pp & ~12) | (((pp >> 2) & 1) << 3) | (((pp >> 3) & 1) << 2); e[i] = T[sp * 72 + vd]; }
          uint4 o; o.x = e[0] | ((unsigned)e[1] << 16); o.y = e[2] | ((unsigned)e[3] << 16); o.z = e[4] | ((unsigned)e[5] << 16); o.w = e[6] | ((unsigned)e[7] << 16);
          *(uint4*)(VTg + (size_t)(sl * 512 + vdt * 64 + vd) * 4160 + pt * 64 + t8) = o; }
        __syncthreads();
    }
}
DEV int crow(int r, int hi) { return (r & 3) + 8 * (r >> 2) + 4 * hi; }
typedef unsigned u32x4_t __attribute__((ext_vector_type(4)));
struct AttnStage { u32x4_t k0, k1, v0, v1; };
DEV void attn_stage_load(const Params& P, int sl, int head, int kt, int tid, AttnStage& st) {
    const bf16_t* Kg = slotp(P, 11); const bf16_t* VTg = slotp(P, 6);
    { const int ci = tid, krow = ci >> 4, kc = ci & 15; const int p = kt * 64 + krow; const int r = p < LSEQ ? row_of(sl, p) : 0; st.k0 = GLD16(Kg + (size_t)r * 512 + head * 128 + kc * 8); }
    { const int ci = tid + 512, krow = ci >> 4, kc = ci & 15; const int p = kt * 64 + krow; const int r = p < LSEQ ? row_of(sl, p) : 0; st.k1 = GLD16(Kg + (size_t)r * 512 + head * 128 + kc * 8); }
    { const int vi = tid, vrow = vi >> 3, vc = vi & 7; st.v0 = GLD16(VTg + (size_t)(sl * 512 + head * 128 + vrow) * 4160 + kt * 64 + vc * 8); }
    { const int vi = tid + 512, vrow = vi >> 3, vc = vi & 7; st.v1 = GLD16(VTg + (size_t)(sl * 512 + head * 128 + vrow) * 4160 + kt * 64 + vc * 8); }
}
DEV void attn_stage_store(unsigned char* buf, int tid, const AttnStage& st) {
    bf16_t* Kt = (bf16_t*)buf; bf16_t* Vt = (bf16_t*)(buf + 17408);
    { const int ci = tid, krow = ci >> 4, kc = ci & 15; *(u32x4_t*)(Kt + krow * 136 + kc * 8) = st.k0; }
    { const int ci = tid + 512, krow = ci >> 4, kc = ci & 15; *(u32x4_t*)(Kt + krow * 136 + kc * 8) = st.k1; }
    { const int vi = tid, vrow = vi >> 3, vc = vi & 7; *(u32x4_t*)(Vt + vrow * 72 + vc * 8) = st.v0; }
    { const int vi = tid + 512, vrow = vi >> 3, vc = vi & 7; *(u32x4_t*)(Vt + vrow * 72 + vc * 8) = st.v1; }
}
DEV void phase_attn(const Params& P0, int layer, unsigned char* lds, int ua, int ub, int uc, int wv) {
    Params P = load_params(); P.ws = launder_ws(P.ws);
    const int tid = launder_tid(wv), lane = tid & 63, w = __builtin_amdgcn_readfirstlane(tid >> 6), map = w >> 2, qsub = w & 3, qi = lane & 31, hi = lane >> 5;
    const float lam_init = layer == 0 ? 0.2f : 0.35550906759096934f;
    float lam;
    { const float* lp = P.in[I_LAM] + (size_t)layer * 256; float s1 = 0.f, s2 = 0.f;
      for (int i = 0; i < 64; ++i) { s1 += lp[i] * lp[64 + i]; s2 += lp[128 + i] * lp[192 + i]; }
      lam = __expf(s1) - __expf(s2) + lam_init; }
    float* Ex = (float*)lds;
#pragma unroll 1
    for (int ui = 0; ui < 3; ++ui) {
        int unit = ui == 0 ? ua : (ui == 1 ? ub : uc);
        if (unit < 0) continue;
        const int ucode = unit; unit = ucode & 4095; const int hmode = ucode >> 12;
        const int sh = unit < 512 ? (unit >> 5) : unit - 512, qb = unit < 512 ? (unit & 31) : 32, sl = sh >> 2, head = sh & 3;
        const int qrow0 = qb < 32 ? sl * 4096 + qb * 128 : TREAL + sl * 16; const int nvalid = qb < 32 ? 128 : 16;
        const bool active = (qsub * 32 < nvalid) && (hmode == 0 || hmode >= 3 || (qsub >> 1) == hmode - 1);
        bf16x8 Qf[4];
        { const bf16_t* qp = slotp(P, 10) + (size_t)(qrow0 + qsub * 32 + qi) * 512 + head * 128 + map * 64 + hi * 8;
#pragma unroll
          for (int ds = 0; ds < 4; ++ds) Qf[ds] = __builtin_bit_cast(bf16x8, GLD16(qp + ds * 16)); }
        AttnStage st;
        const int kt0 = hmode == 4 ? 33 : 0, kt1 = hmode == 3 ? 33 : 65;
        attn_stage_load(P, sl, head, kt0, tid, st); attn_stage_store(lds + (kt0 & 1) * 35840, tid, st); attn_stage_load(P, sl, head, kt0 + 1, tid, st);
        __syncthreads();
        f32x16 O[4];
#pragma unroll
        for (int v = 0; v < 4; ++v)
#pragma unroll
            for (int r = 0; r < 16; ++r) O[v][r] = 0.f;
        float m_run = -INFINITY, l_run = 0.f;
#pragma unroll 1
        for (int kt = kt0; kt < kt1; ++kt) {
            if (kt + 1 < kt1) attn_stage_store(lds + ((kt + 1) & 1) * 35840, tid, st);
            if (kt + 2 < kt1) attn_stage_load(P, sl, head, kt + 2, tid, st);
            const unsigned char* buf = lds + (kt & 1) * 35840;
            const bf16_t* Kb = (const bf16_t*)buf; const bf16_t* Vb = (const bf16_t*)(buf + 17408);
            if (active) {
            f32x16 S0, S1;
            {   const f32x16 zero16 = {0.f, 0.f, 0.f, 0.f, 0.f, 0.f, 0.f, 0.f, 0.f, 0.f, 0.f, 0.f, 0.f, 0.f, 0.f, 0.f};
                bf16x8 ka[4], kb[4];
#pragma unroll
                for (int ds = 0; ds < 4; ++ds) { ka[ds] = *(const bf16x8*)(Kb + qi * 136 + map * 64 + ds * 16 + hi * 8); kb[ds] = *(const bf16x8*)(Kb + (32 + qi) * 136 + map * 64 + ds * 16 + hi * 8); }
                __builtin_amdgcn_sched_barrier(0);
                S0 = mfma32(ka[0], Qf[0], zero16); S1 = mfma32(kb[0], Qf[0], zero16);
#pragma unroll
                for (int ds = 1; ds < 4; ++ds) { S0 = mfma32(ka[ds], Qf[ds], S0); S1 = mfma32(kb[ds], Qf[ds], S1); } }
            if (__builtin_expect(__builtin_amdgcn_readfirstlane(kt) == 64, 0)) {
#pragma unroll
                for (int r = 0; r < 16; ++r) { if (crow(r, hi) >= 16) S0[r] = -INFINITY; S1[r] = -INFINITY; }
                asm volatile("" : "+v"(S0), "+v"(S1)); }
            float mx = -INFINITY;
#pragma unroll
            for (int r = 0; r < 16; ++r) mx = fmaxf(mx, fmaxf(S0[r], S1[r]));
            { const auto sw = __builtin_amdgcn_permlane32_swap(__float_as_uint(mx), __float_as_uint(mx), false, false); mx = fmaxf(__uint_as_float(sw[0]), __uint_as_float(sw[1])); }
            if (__builtin_amdgcn_ballot_w64(mx > m_run + 8.0f) != 0ull) {
                const float m_new = (mx > m_run + 8.0f) ? mx : m_run; const float alpha = __builtin_amdgcn_exp2f(m_run - m_new); m_run = m_new;
                l_run *= alpha;
#pragma unroll
                for (int v = 0; v < 4; ++v)
#pragma unroll
                    for (int r = 0; r < 16; ++r) O[v][r] *= alpha; }
            const float m_new = m_run;
            float ps = 0.f;
#pragma unroll
            for (int r = 0; r < 16; ++r) { S0[r] = __builtin_amdgcn_exp2f(S0[r] - m_new); S1[r] = __builtin_amdgcn_exp2f(S1[r] - m_new); ps += S0[r] + S1[r]; }
            l_run += ps;
            bf16x8 pf[2][2];
#pragma unroll
            for (int half = 0; half < 2; ++half) {
                uint4 a, b;
                a.x = pk2(S0[half * 8 + 0], S0[half * 8 + 1]); a.y = pk2(S0[half * 8 + 2], S0[half * 8 + 3]); a.z = pk2(S0[half * 8 + 4], S0[half * 8 + 5]); a.w = pk2(S0[half * 8 + 6], S0[half * 8 + 7]);
                b.x = pk2(S1[half * 8 + 0], S1[half * 8 + 1]); b.y = pk2(S1[half * 8 + 2], S1[half * 8 + 3]); b.z = pk2(S1[half * 8 + 4], S1[half * 8 + 5]); b.w = pk2(S1[half * 8 + 6], S1[half * 8 + 7]);
                pf[0][half] = __builtin_bit_cast(bf16x8, a); pf[1][half] = __builtin_bit_cast(bf16x8, b); }
            {   bf16x8 av[4], nx[4];
#pragma unroll
                for (int f = 0; f < 4; ++f) av[f] = *(const bf16x8*)(Vb + qi * 72 + (f >> 1) * 32 + (f & 1) * 16 + hi * 8);
                __builtin_amdgcn_sched_barrier(0);
#pragma unroll
                for (int v = 0; v < 4; ++v) {
                    if (v < 3) {
#pragma unroll
                        for (int f = 0; f < 4; ++f) nx[f] = *(const bf16x8*)(Vb + ((v + 1) * 32 + qi) * 72 + (f >> 1) * 32 + (f & 1) * 16 + hi * 8); }
                    __builtin_amdgcn_sched_barrier(0);
#pragma unroll
                    for (int f = 0; f < 4; ++f) O[v] = mfma32(av[f], pf[f >> 1][f & 1], O[v]);
                    if (v < 3) {
#pragma unroll
                        for (int f = 0; f < 4; ++f) av[f] = nx[f]; }
                }
            }
            }
            __syncthreads();
        }
        const float l_tot = l_run + __shfl_xor(l_run, 32); const float inv = 1.0f / l_tot;
        if (hmode >= 3) {
            float* pt = (float*)slotp(P, 22) + ((size_t)(((unit - 448) * 2 + (hmode - 3)) * 2 + map) * 128 + qsub * 32 + qi) * 130;
#pragma unroll
            for (int v = 0; v < 4; ++v)
#pragma unroll
                for (int rg = 0; rg < 4; ++rg) { float* d = pt + v * 32 + 8 * rg + 4 * hi; d[0] = O[v][rg * 4 + 0]; d[1] = O[v][rg * 4 + 1]; d[2] = O[v][rg * 4 + 2]; d[3] = O[v][rg * 4 + 3]; }
            if (hi == 0) { pt[128] = m_run; pt[129] = l_tot; }
            __syncthreads();
            continue; }
        if (map == 1) {
#pragma unroll
            for (int v = 0; v < 4; ++v)
#pragma unroll
                for (int r = 0; r < 16; ++r) Ex[(qsub * 32 + qi) * 132 + v * 32 + crow(r, hi)] = O[v][r] * inv; }
        __syncthreads();
        if (map == 0) {
            float ss = 0.f;
#pragma unroll
            for (int v = 0; v < 4; ++v)
#pragma unroll
                for (int r = 0; r < 16; ++r) { const float o = O[v][r] * inv - lam * Ex[(qsub * 32 + qi) * 132 + v * 32 + crow(r, hi)]; O[v][r] = o; ss += o * o; }
            ss += __shfl_xor(ss, 32);
            const float rs = rsqrtf(ss * (1.f / 128.f) + 1e-5f) * (1.f - lam_init);
            if (active && qsub * 32 + qi < nvalid) {
                bf16_t* yp = slotp(P, 4) + (size_t)(qrow0 + qsub * 32 + qi) * 512 + head * 128;
#pragma unroll
                for (int v = 0; v < 4; ++v)
#pragma unroll
                    for (int rg = 0; rg < 4; ++rg) { const int vd0 = v * 32 + 8 * rg + 4 * hi; const f32x4 gg = *(const f32x4*)(P.in[I_SUBLN] + layer * 128 + vd0);
                        uint2 o; o.x = pk2(O[v][rg * 4 + 0] * rs * gg[0], O[v][rg * 4 + 1] * rs * gg[1]); o.y = pk2(O[v][rg * 4 + 2] * rs * gg[2], O[v][rg * 4 + 3] * rs * gg[3]);
                        *(uint2*)(yp + vd0) = o; } }
        }
        __syncthreads();
    }
}
DEV float dpp_f(float x, const int ctrl) { return x; }
template <int CTRL> DEV float dppmov(float x) { return __builtin_bit_cast(float, __builtin_amdgcn_update_dpp(0, __builtin_bit_cast(int, x), CTRL, 0xf, 0xf, true)); }
DEV float sum16(float x) { x += dppmov<0xB1>(x); x += dppmov<0x4E>(x); x += dppmov<0x141>(x); x += dppmov<0x140>(x); return x; }
constexpr int RW_CH = 16, RW_BUF_F = 5120 + 256 + 4096, RW_BUFB = RW_BUF_F * 4;
struct RwRegs { u32x4_t r, k, kk, e, a, v; };
DEV void unpack8v(const u32x4_t w, float* f) { unpack8(make_uint4(w.x, w.y, w.z, w.w), f); }
DEV void rw_stage_load(const Params& P, RwRegs& g, int sl, int head, int dir, int qr, int ck, int t) {
    if (t < 128) { const int step = t >> 3, ch8 = (t & 7) * 8, sidx = ck * RW_CH + step;
        if (sidx < LSEQ) { const int p = dir ? LSEQ - 1 - sidx : sidx; const size_t ro = (size_t)row_of(sl, p) * 512 + head * 64 + ch8;
            g.r = *(const u32x4_t*)(slotp(P, 17) + ro); g.k = *(const u32x4_t*)(slotp(P, 18) + ro); g.kk = *(const u32x4_t*)(slotp(P, 20) + ro);
            g.e = *(const u32x4_t*)(slotp(P, 22 + dir) + ro); g.a = *(const u32x4_t*)(slotp(P, dir == 0 ? 24 : 13) + ro); } }
    if (t < 32) { const int tt = t, s2 = tt >> 1, r8 = (tt & 1) * 8, si2 = ck * RW_CH + s2;
        if (si2 < LSEQ) { const int p2 = dir ? LSEQ - 1 - si2 : si2; g.v = *(const u32x4_t*)(slotp(P, 19) + (size_t)row_of(sl, p2) * 512 + head * 64 + qr * 16 + r8); } }
}
DEV void rw_stage_write(const Params& P, int layer, unsigned char* buf, const RwRegs& g, int head, int ck, int t) {
    float* Rr = (float*)buf; float* Ww = Rr + 1024; float* Kd = Ww + 1024; float* Kk = Kd + 1024; float* Bb = Kk + 1024; float* Vs = Bb + 1024;
    if (t < 128) { const int step = t >> 3, ch8 = (t & 7) * 8, sidx = ck * RW_CH + step;
        if (sidx < LSEQ) {
            float r[8], k[8], kk[8], e[8], a[8];
            unpack8v(g.r, r); unpack8v(g.k, k); unpack8v(g.kk, kk); unpack8v(g.e, e); unpack8v(g.a, a);
            float ww[8], kd[8], bb[8];
#pragma unroll
            for (int j = 0; j < 8; ++j) { ww[j] = __expf(-e[j]); kd[j] = k[j] * (1.f + (a[j] - 1.f) * P.in[I_KA][layer * 512 + head * 64 + ch8 + j]); bb[j] = kk[j] * a[j]; }
            const int o = step * 64 + ch8;
            *(f32x4*)(Rr + o) = (f32x4){r[0], r[1], r[2], r[3]}; *(f32x4*)(Rr + o + 4) = (f32x4){r[4], r[5], r[6], r[7]};
            *(f32x4*)(Ww + o) = (f32x4){ww[0], ww[1], ww[2], ww[3]}; *(f32x4*)(Ww + o + 4) = (f32x4){ww[4], ww[5], ww[6], ww[7]};
            *(f32x4*)(Kd + o) = (f32x4){kd[0], kd[1], kd[2], kd[3]}; *(f32x4*)(Kd + o + 4) = (f32x4){kd[4], kd[5], kd[6], kd[7]};
            *(f32x4*)(Kk + o) = (f32x4){kk[0], kk[1], kk[2], kk[3]}; *(f32x4*)(Kk + o + 4) = (f32x4){kk[4], kk[5], kk[6], kk[7]};
            *(f32x4*)(Bb + o) = (f32x4){bb[0], bb[1], bb[2], bb[3]}; *(f32x4*)(Bb + o + 4) = (f32x4){bb[4], bb[5], bb[6], bb[7]};
        } }
    if (t < 32) { const int tt = t, s2 = tt >> 1, r8 = (tt & 1) * 8, si2 = ck * RW_CH + s2;
        if (si2 < LSEQ) { float v[8]; unpack8v(g.v, v);
            *(f32x4*)(Vs + s2 * 16 + r8) = (f32x4){v[0], v[1], v[2], v[3]}; *(f32x4*)(Vs + s2 * 16 + r8 + 4) = (f32x4){v[4], v[5], v[6], v[7]}; } }
}
DEV void rw_flush(const Params& P, const unsigned char* buf, int sl, int head, int dir, int qr, int ck, int t) {
    if (t >= 160 && t < 192) { const float* Op = (const float*)buf + 5376; const int tt = t - 160, s2 = tt >> 1, r8 = (tt & 1) * 8, sidx = ck * RW_CH + s2;
        if (sidx < LSEQ) { const int p = dir ? LSEQ - 1 - sidx : sidx; float o[8];
#pragma unroll
            for (int j = 0; j < 8; ++j) { const int row = r8 + j; const f32x4* q = (const f32x4*)(Op + s2 * 256 + (row >> 2) * 64 + (row & 3) * 16);
                const f32x4 a = q[0], b = q[1], c = q[2], d = q[3];
                o[j] = ((a[0] + a[1]) + (a[2] + a[3])) + ((b[0] + b[1]) + (b[2] + b[3])) + (((c[0] + c[1]) + (c[2] + c[3])) + ((d[0] + d[1]) + (d[2] + d[3]))); }
            *(uint4*)(slotp(P, 15 + dir) + (size_t)row_of(sl, p) * 512 + head * 64 + qr * 16 + r8) = pack8(o); } }
}
DEV void phase_rw_scan(const Params& P0, int layer, unsigned char* lds, int bid, int nb, int wv) {
    Params P = load_params(); P.ws = launder_ws(P.ws);
    const int tid = launder_tid(wv), lane = tid & 63, w = __builtin_amdgcn_readfirstlane(tid >> 6), li = lane & 15, rl = (w & 3) * 4 + (lane >> 4);
    constexpr int NCK = (LSEQ + RW_CH - 1) / RW_CH;
    typedef float f32x2 __attribute__((ext_vector_type(2)));
    for (int unit = bid; unit < 256; unit += nb) {
        const int sl = unit >> 6, head = (unit >> 3) & 7, dir = (unit >> 2) & 1, qr = unit & 3;
        f32x2 SA = (f32x2){0.f, 0.f}, SB = (f32x2){0.f, 0.f};
        RwRegs g; g.r = g.k = g.kk = g.e = g.a = g.v = (u32x4_t){0u, 0u, 0u, 0u};
        if (w >= 4) { rw_stage_load(P, g, sl, head, dir, qr, 0, tid - 256); rw_stage_write(P, layer, lds, g, head, 0, tid - 256); rw_stage_load(P, g, sl, head, dir, qr, 1, tid - 256); }
        __syncthreads();
#pragma unroll 1
        for (int ck = 0; ck < NCK; ++ck) {
            unsigned char* buf = lds + (ck & 1) * RW_BUFB;
            if (w >= 4) {
                if (ck + 1 < NCK) rw_stage_write(P, layer, lds + ((ck + 1) & 1) * RW_BUFB, g, head, ck + 1, tid - 256);
                if (ck + 2 < NCK) rw_stage_load(P, g, sl, head, dir, qr, ck + 2, tid - 256);
                if (ck > 0) rw_flush(P, lds + ((ck - 1) & 1) * RW_BUFB, sl, head, dir, qr, ck - 1, tid - 256);
            } else {
                const float* Rr = (const float*)buf + li * 4; const float* Vs = (const float*)buf + 5120 + rl; float* Op = (float*)buf + 5376 + w * 64 + lane;
                const int ns = (LSEQ - ck * RW_CH) < RW_CH ? (LSEQ - ck * RW_CH) : RW_CH;
                f32x4 rr = *(const f32x4*)(Rr), ww = *(const f32x4*)(Rr + 1024), kd = *(const f32x4*)(Rr + 2048), kk = *(const f32x4*)(Rr + 3072), bb = *(const f32x4*)(Rr + 4096); float vv = Vs[0];
#pragma unroll 2
                for (int i = 0; i < ns; ++i) {
                    const int in = i < RW_CH - 1 ? i + 1 : RW_CH - 1;
                    const f32x4 rr_n = *(const f32x4*)(Rr + in * 64), ww_n = *(const f32x4*)(Rr + 1024 + in * 64), kd_n = *(const f32x4*)(Rr + 2048 + in * 64);
                    const f32x4 kk_n = *(const f32x4*)(Rr + 3072 + in * 64), bb_n = *(const f32x4*)(Rr + 4096 + in * 64); const float vv_n = Vs[in * 16];
                    f32x2 p = SA * (f32x2){kk[0], kk[1]}; p = __builtin_elementwise_fma(SB, (f32x2){kk[2], kk[3]}, p);
                    const f32x2 vv2 = (f32x2){vv, vv};
                    const f32x2 ta = vv2 * (f32x2){kd[0], kd[1]}, tb = vv2 * (f32x2){kd[2], kd[3]};
                    const float sa = -sum16(p[0] + p[1]);
                    const f32x2 sa2 = (f32x2){sa, sa};
                    SA = __builtin_elementwise_fma(SA, (f32x2){ww[0], ww[1]}, __builtin_elementwise_fma(sa2, (f32x2){bb[0], bb[1]}, ta));
                    SB = __builtin_elementwise_fma(SB, (f32x2){ww[2], ww[3]}, __builtin_elementwise_fma(sa2, (f32x2){bb[2], bb[3]}, tb));
                    f32x2 q = SA * (f32x2){rr[0], rr[1]}; q = __builtin_elementwise_fma(SB, (f32x2){rr[2], rr[3]}, q);
                    Op[i * 256] = q[0] + q[1];
                    rr = rr_n; ww = ww_n; kd = kd_n; kk = kk_n; bb = bb_n; vv = vv_n;
                }
            }
            __syncthreads();
        }
        if (w >= 4) rw_flush(P, lds + ((NCK - 1) & 1) * RW_BUFB, sl, head, dir, qr, NCK - 1, tid - 256);
        __syncthreads();
    }
}
static_assert(LSEQ == 257 * 16, "chunked RWKV assumes whole 16-step chunks");
constexpr int RWC_REC = 8960, RWC_NCK = 257;
DEV unsigned char* rwc_rec(const Params& P, int dir, int idx) {
    const int gi = dir * 8224 + idx;
    if (gi < 1901) return (unsigned char*)slotp(P, 5) + (size_t)gi * RWC_REC;
    if (gi < 7606) return (unsigned char*)slotp(P, 7) + (size_t)(gi - 1901) * RWC_REC;
    if (gi < 9507) return (unsigned char*)slotp(P, 12) + (size_t)(gi - 7606) * RWC_REC;
    if (gi < 11408) return (unsigned char*)slotp(P, 21) + (size_t)(gi - 9507) * RWC_REC;
    return GPTR(unsigned char, P.ws + WS_SLOTS + 25 * SLOT_B + (size_t)(gi - 11408) * RWC_REC); }
DEV int rwc_slot(int c) { return (((c >> 5) * 4 + ((c >> 2) & 3)) * 8) + ((c >> 4) & 1) * 4 + (c & 3); }
DEV void phase_rwc_pre(const Params& P0, int layer, unsigned char* lds, int bid, int nb, int wv) {
    Params P = load_params(); P.ws = launder_ws(P.ws);
    const int tid = launder_tid(wv), lane = tid & 63, w = __builtin_amdgcn_readfirstlane(tid >> 6), l15 = lane & 15, quad = lane >> 4;
    unsigned char* wl = lds + w * 15616;
    bf16_t* Bt = (bf16_t*)wl; bf16_t* Dt = Bt + 16 * 72; bf16_t* Ak = Dt + 16 * 72; bf16_t* Rt = Ak + 16 * 72;
    float* Mb = (float*)(wl + 9216); float* Md = Mb + 256; float* Gb = Md + 256; float* Gd = Gb + 256; float* Tm = Gd + 256; float* Nm = Tm + 256;
    const float ka = P.in[I_KA][layer * 512 + 0];  (void)ka;
    for (int unit2 = bid * 8 + w; unit2 < 2 * 32 * RWC_NCK; unit2 += nb * 8) {
        const int dir = unit2 >= 32 * RWC_NCK ? 1 : 0; const int unit = unit2 - dir * 32 * RWC_NCK;
        const int sh = unit / RWC_NCK, ck = unit - sh * RWC_NCK, sl = sh >> 3, head = sh & 7;
        const float kac = P.in[I_KA][layer * 512 + head * 64 + lane];
        float ak[16], bt[16], dt[16], rt[16];
        typedef const __attribute__((address_space(1))) unsigned short* gu16p;
        const gu16p pR = (gu16p)slotp(P, 17), pK = (gu16p)slotp(P, 18), pKK = (gu16p)slotp(P, 20), pE = (gu16p)slotp(P, 22 + dir), pA = (gu16p)slotp(P, dir == 0 ? 24 : 13);
        unsigned short r16[16], k16[16], q16[16], e16[16], a16[16];
#pragma unroll
        for (int t = 0; t < 16; ++t) {
            const int sidx = ck * 16 + t;
            const int p = dir ? LSEQ - 1 - sidx : sidx; const size_t ro = (size_t)row_of(sl, p) * 512 + head * 64 + lane;
            r16[t] = pR[ro]; k16[t] = pK[ro]; q16[t] = pKK[ro]; e16[t] = pE[ro]; a16[t] = pA[ro]; }
        float g = 1.f;
#pragma unroll
        for (int t = 0; t < 16; ++t) {
            const float r = bf2f(r16[t]), k = bf2f(k16[t]), kk = bf2f(q16[t]), e = bf2f(e16[t]), a = bf2f(a16[t]);
            const float wdec = __expf(-e), kd = k * (1.f + (a - 1.f) * kac), b = kk * a;
            ak[t] = g * kk; g *= wdec; const float gi = __builtin_amdgcn_rcpf(g); bt[t] = b * gi; dt[t] = kd * gi; rt[t] = g * r;
        }
        const float gC = g;
#pragma unroll
        for (int t = 0; t < 16; ++t) { Bt[t * 72 + lane] = (bf16_t)(pk2(bt[t], 0.f) & 0xffffu); Dt[t * 72 + lane] = (bf16_t)(pk2(dt[t], 0.f) & 0xffffu);
            Ak[t * 72 + lane] = (bf16_t)(pk2(ak[t], 0.f) & 0xffffu); Rt[t * 72 + lane] = (bf16_t)(pk2(rt[t], 0.f) & 0xffffu); }
        asm volatile("s_waitcnt lgkmcnt(0)" ::: "memory");
        {
            f32x4 mb = (f32x4){0.f, 0.f, 0.f, 0.f}, md = mb, gb = mb, gd = mb;
#pragma unroll
            for (int ks = 0; ks < 2; ++ks) {
                const bf16x8 fb = *(const bf16x8*)(Bt + l15 * 72 + ks * 32 + quad * 8), fd = *(const bf16x8*)(Dt + l15 * 72 + ks * 32 + quad * 8);
                const bf16x8 fa = *(const bf16x8*)(Ak + l15 * 72 + ks * 32 + quad * 8), fr = *(const bf16x8*)(Rt + l15 * 72 + ks * 32 + quad * 8);
                mb = mfma16(fb, fa, mb); md = mfma16(fd, fa, md); gb = mfma16(fb, fr, gb); gd = mfma16(fd, fr, gd); }
#pragma unroll
            for (int jj = 0; jj < 4; ++jj) { const int j = quad * 4 + jj, t = l15;
                Mb[j * 16 + t] = j < t ? mb[jj] : 0.f; Md[j * 16 + t] = j < t ? md[jj] : 0.f; Gb[j * 16 + t] = j <= t ? gb[jj] : 0.f; Gd[j * 16 + t] = j <= t ? gd[jj] : 0.f; }
        }
        asm volatile("s_waitcnt lgkmcnt(0)" ::: "memory");
        {
            float tc[16];
#pragma unroll
            for (int i = 15; i >= 0; --i) { float acc = (i == l15) ? 1.f : 0.f;
                float mr[16];
#pragma unroll
                for (int q4 = (i + 1) >> 2; q4 < 4; ++q4) { const f32x4 m4 = *(const f32x4*)(Mb + i * 16 + q4 * 4); mr[q4 * 4] = m4[0]; mr[q4 * 4 + 1] = m4[1]; mr[q4 * 4 + 2] = m4[2]; mr[q4 * 4 + 3] = m4[3]; }
#pragma unroll
                for (int l = i + 1; l < 16; ++l) acc -= mr[l] * tc[l];
                tc[i] = acc; }
            if (quad == 0) {
#pragma unroll
                for (int i = 0; i < 16; ++i) Tm[i * 16 + l15] = tc[i]; }
        }
        asm volatile("s_waitcnt lgkmcnt(0)" ::: "memory");
        {
            float n4[4] = {0.f, 0.f, 0.f, 0.f};
#pragma unroll
            for (int l = 0; l < 16; ++l) { const float tv = Tm[l * 16 + l15];
#pragma unroll
                for (int jj = 0; jj < 4; ++jj) n4[jj] += Md[(quad * 4 + jj) * 16 + l] * tv; }
#pragma unroll
            for (int jj = 0; jj < 4; ++jj) Nm[(quad * 4 + jj) * 16 + l15] = n4[jj];
        }
        asm volatile("s_waitcnt lgkmcnt(0)" ::: "memory");
        unsigned char* rec = rwc_rec(P, dir, unit);
        {
            float q4[4];
#pragma unroll
            for (int jj = 0; jj < 4; ++jj) q4[jj] = Gd[(quad * 4 + jj) * 16 + l15];
#pragma unroll
            for (int l = 0; l < 16; ++l) { const float gv = Gb[l * 16 + l15];
#pragma unroll
                for (int jj = 0; jj < 4; ++jj) q4[jj] -= Nm[(quad * 4 + jj) * 16 + l] * gv; }
            *(uint2*)((bf16_t*)(rec + 8192) + l15 * 16 + quad * 4) = make_uint2(pk2(q4[0], q4[1]), pk2(q4[2], q4[3]));
        }
        {
            float ap[16], rp[16], ps[16];
#pragma unroll
            for (int t = 0; t < 16; ++t) { ap[t] = 0.f; rp[t] = rt[t]; }
#pragma unroll
            for (int j = 0; j < 16; ++j) {
#pragma unroll
                for (int q4 = j >> 2; q4 < 4; ++q4) { const f32x4 r4 = *(const f32x4*)(Tm + j * 16 + q4 * 4);
#pragma unroll
                    for (int e = 0; e < 4; ++e) ap[q4 * 4 + e] += ak[j] * r4[e]; } }
#pragma unroll
            for (int j = 0; j < 16; ++j) {
#pragma unroll
                for (int q4 = j >> 2; q4 < 4; ++q4) { const f32x4 r4 = *(const f32x4*)(Gb + j * 16 + q4 * 4);
#pragma unroll
                    for (int e = 0; e < 4; ++e) rp[q4 * 4 + e] -= ap[j] * r4[e]; } }
#pragma unroll
            for (int j = 0; j < 16; ++j) { float acc = dt[j];
#pragma unroll
                for (int q4 = j >> 2; q4 < 4; ++q4) { const f32x4 r4 = *(const f32x4*)(Nm + j * 16 + q4 * 4);
#pragma unroll
                    for (int e = 0; e < 4; ++e) acc -= r4[e] * bt[q4 * 4 + e]; }
                ps[j] = acc * gC; }
            bf16_t* AP = (bf16_t*)rec; bf16_t* RP = AP + 1024; const int so = rwc_slot(lane);
#pragma unroll
            for (int t = 0; t < 16; ++t) { AP[t * 64 + so] = (bf16_t)(pk2(ap[t], 0.f) & 0xffffu); RP[t * 64 + so] = (bf16_t)(pk2(rp[t], 0.f) & 0xffffu); }
            float nb_[16];
#pragma unroll
            for (int t = 0; t < 16; ++t) nb_[t] = -bt[t] * gC;
            uint4* BP = (uint4*)(rec + 4096) + lane * 2; BP[0] = pack8(nb_); BP[1] = pack8(nb_ + 8);
            uint4* PP = (uint4*)(rec + 6144) + lane * 2; PP[0] = pack8(ps); PP[1] = pack8(ps + 8);
            ((float*)(rec + 8704))[lane] = gC;
        }
        asm volatile("s_waitcnt lgkmcnt(0)" ::: "memory");
    }
}
struct RwcRegs { u32x4_t a, b, c, v; };
DEV void rwc_load(const Params& P, RwcRegs& g, int sh, int dir, int ck, int t) {
    const unsigned char* rec = rwc_rec(P, dir, sh * RWC_NCK + ck);
    g.a = GLD16(rec + (size_t)t * 16); g.b = GLD16(rec + (size_t)(t + 256) * 16);
    if (t < 48) g.c = GLD16(rec + (size_t)(t + 512) * 16);
    if (t < 128) { const int j = t >> 3, r8 = (t & 7) * 8, sidx = ck * 16 + j; const int sc = sidx < LSEQ ? sidx : LSEQ - 1; const int p = dir ? LSEQ - 1 - sc : sc;
        g.v = GLD16(slotp(P, 19) + (size_t)row_of(sh >> 3, p) * 512 + (sh & 7) * 64 + r8); if (sidx >= LSEQ) g.v = (u32x4_t){0u, 0u, 0u, 0u}; }
}
DEV void rwc_store(unsigned char* buf, const RwcRegs& g, int t) {
    *(u32x4_t*)(buf + t * 16) = g.a; *(u32x4_t*)(buf + (t + 256) * 16) = g.b;
    if (t < 48) *(u32x4_t*)(buf + (t + 512) * 16) = g.c;
    if (t < 128) { bf16_t* VsT = (bf16_t*)(buf + RWC_REC); const int j = t >> 3, r8 = (t & 7) * 8;
        VsT[(r8 + 0) * 16 + j] = (bf16_t)(g.v.x & 0xffffu); VsT[(r8 + 1) * 16 + j] = (bf16_t)(g.v.x >> 16); VsT[(r8 + 2) * 16 + j] = (bf16_t)(g.v.y & 0xffffu); VsT[(r8 + 3) * 16 + j] = (bf16_t)(g.v.y >> 16);
        VsT[(r8 + 4) * 16 + j] = (bf16_t)(g.v.z & 0xffffu); VsT[(r8 + 5) * 16 + j] = (bf16_t)(g.v.z >> 16); VsT[(r8 + 6) * 16 + j] = (bf16_t)(g.v.w & 0xffffu); VsT[(r8 + 7) * 16 + j] = (bf16_t)(g.v.w >> 16); }
}
DEV void phase_rwc_scan(const Params& P0, unsigned char* lds, int bid, int nb, int wv) {
    Params P = load_params(); P.ws = launder_ws(P.ws);
    const int tid = launder_tid(wv), lane = tid & 63, w = __builtin_amdgcn_readfirstlane(tid >> 6), l15 = lane & 15, quad = lane >> 4;
    constexpr int BUFB = RWC_REC + 2048;
    for (int u2 = bid; u2 < 64; u2 += nb) {
        const int sh = u2 & 31, dir = u2 >> 5; const int sl = sh >> 3, head = sh & 7;
        f32x4 ST[4];
#pragma unroll
        for (int ct = 0; ct < 4; ++ct) ST[ct] = (f32x4){0.f, 0.f, 0.f, 0.f};
        RwcRegs g; g.a = g.b = g.c = g.v = (u32x4_t){0u, 0u, 0u, 0u};
        if (w >= 4) { rwc_load(P, g, sh, dir, 0, tid - 256); rwc_store(lds, g, tid - 256); rwc_load(P, g, sh, dir, 1, tid - 256); }
        __syncthreads();
#pragma unroll 1
        for (int ck = 0; ck < RWC_NCK; ++ck) {
            const unsigned char* buf = lds + (ck & 1) * BUFB;
            if (w >= 4) {
                if (ck + 1 < RWC_NCK) rwc_store(lds + ((ck + 1) & 1) * BUFB, g, tid - 256);
                if (ck + 2 < RWC_NCK) rwc_load(P, g, sh, dir, ck + 2, tid - 256);
            } else {
                const bf16_t* AP = (const bf16_t*)buf; const bf16_t* RP = AP + 1024; const bf16_t* BP = (const bf16_t*)(buf + 4096); const bf16_t* PP = (const bf16_t*)(buf + 6144);
                const bf16_t* QP = (const bf16_t*)(buf + 8192); const float* GC = (const float*)(buf + 8704); const bf16_t* VsT = (const bf16_t*)(buf + RWC_REC);
                const u32x4_t z4 = (u32x4_t){0u, 0u, 0u, 0u};
                u32x4_t sb0, sb1;
                sb0.x = pk2(ST[0][0], ST[0][1]); sb0.y = pk2(ST[0][2], ST[0][3]); sb0.z = pk2(ST[1][0], ST[1][1]); sb0.w = pk2(ST[1][2], ST[1][3]);
                sb1.x = pk2(ST[2][0], ST[2][1]); sb1.y = pk2(ST[2][2], ST[2][3]); sb1.z = pk2(ST[3][0], ST[3][1]); sb1.w = pk2(ST[3][2], ST[3][3]);
                const bf16x8 SB0 = __builtin_bit_cast(bf16x8, sb0), SB1 = __builtin_bit_cast(bf16x8, sb1);
                const bf16x8 a0 = *(const bf16x8*)(AP + l15 * 64 + (0 * 4 + quad) * 8), a1 = *(const bf16x8*)(AP + l15 * 64 + (1 * 4 + quad) * 8);
                const bf16x8 r0 = *(const bf16x8*)(RP + l15 * 64 + (0 * 4 + quad) * 8), r1 = *(const bf16x8*)(RP + l15 * 64 + (1 * 4 + quad) * 8);
                const u32x4_t vq = quad < 2 ? *(const u32x4_t*)(VsT + (w * 16 + l15) * 16 + quad * 8) : z4;
                const u32x4_t qq = quad < 2 ? *(const u32x4_t*)(QP + l15 * 16 + quad * 8) : z4;
                f32x4 gcv[4]; uint2 bqv[4]; u32x4_t pqv[4];
#pragma unroll
                for (int ct = 0; ct < 4; ++ct) { gcv[ct] = *(const f32x4*)(GC + ct * 16 + quad * 4); bqv[ct] = *(const uint2*)(BP + (ct * 16 + l15) * 16 + quad * 4);
                    pqv[ct] = quad < 2 ? *(const u32x4_t*)(PP + (ct * 16 + l15) * 16 + quad * 8) : z4; }
                const bf16x8 VB = __builtin_bit_cast(bf16x8, vq), QA = __builtin_bit_cast(bf16x8, qq);
                f32x4 Wt = (f32x4){0.f, 0.f, 0.f, 0.f}, Ot = Wt;
                Wt = mfma16(a0, SB0, Wt); Wt = mfma16(a1, SB1, Wt);
                Ot = mfma16(r0, SB0, Ot); Ot = mfma16(r1, SB1, Ot); Ot = mfma16(QA, VB, Ot);
                u32x4_t wb; wb.x = pk2(Wt[0], Wt[1]); wb.y = pk2(Wt[2], Wt[3]); wb.z = 0u; wb.w = 0u;
                const bf16x8 WB = __builtin_bit_cast(bf16x8, wb);
#pragma unroll
                for (int ct = 0; ct < 4; ++ct) {
                    u32x4_t ba; ba.x = bqv[ct].x; ba.y = bqv[ct].y; ba.z = 0u; ba.w = 0u;
                    f32x4 acc = ST[ct] * gcv[ct];
                    acc = mfma16(__builtin_bit_cast(bf16x8, ba), WB, acc);
                    acc = mfma16(__builtin_bit_cast(bf16x8, pqv[ct]), VB, acc);
                    ST[ct] = acc;
                }
                bf16_t* Oo = slotp(P, 15 + dir);
#pragma unroll
                for (int jj = 0; jj < 4; ++jj) { const int sidx = ck * 16 + quad * 4 + jj;
                    if (sidx < LSEQ) { const int p = dir ? LSEQ - 1 - sidx : sidx; ((__attribute__((address_space(1))) bf16_t*)Oo)[(size_t)row_of(sl, p) * 512 + head * 64 + w * 16 + l15] = (bf16_t)(pk2(Ot[jj], 0.f) & 0xffffu); } }
            }
            __syncthreads();
        }
    }
}


DEV void phase_attn_combine(const Params& P0, int layer, int bid, int nb, int wv) {
    Params P = load_params(); P.ws = launder_ws(P.ws);
    ROWPRO
    const float lam_init = layer == 0 ? 0.2f : 0.35550906759096934f;
    float lam;
    { const float* lp = P.in[I_LAM] + (size_t)layer * 256; const float s1 = wave_sum(lp[lane] * lp[64 + lane]), s2 = wave_sum(lp[128 + lane] * lp[192 + lane]); lam = __expf(s1) - __expf(s2) + lam_init; }
    const float* PT = (const float*)slotp(P, 22);
    for (int task = gw; task < 64 * 128; task += ngw) {
        const int ul = task >> 7, row = task & 127, unit = 448 + ul, sh = unit >> 5, qb = unit & 31, sl = sh >> 2, head = sh & 3;
        float om[2][2];
#pragma unroll
        for (int map = 0; map < 2; ++map) {
            const float* pa = PT + ((size_t)((ul * 2 + 0) * 2 + map) * 128 + row) * 130; const float* pb = PT + ((size_t)((ul * 2 + 1) * 2 + map) * 128 + row) * 130;
            const float ma = pa[128], la = pa[129], mb = pb[128], lb = pb[129];
            const float M = fmaxf(ma, mb), fa = __builtin_amdgcn_exp2f(ma - M), fb = __builtin_amdgcn_exp2f(mb - M);
            const float inv = 1.0f / (la * fa + lb * fb);
            om[map][0] = (pa[lane * 2] * fa + pb[lane * 2] * fb) * inv; om[map][1] = (pa[lane * 2 + 1] * fa + pb[lane * 2 + 1] * fb) * inv; }
        const float o0 = om[0][0] - lam * om[1][0], o1 = om[0][1] - lam * om[1][1];
        const float ss = wave_sum(o0 * o0 + o1 * o1);
        const float rs = rsqrtf(ss * (1.f / 128.f) + 1e-5f) * (1.f - lam_init);
        const float g0 = P.in[I_SUBLN][layer * 128 + lane * 2], g1 = P.in[I_SUBLN][layer * 128 + lane * 2 + 1];
        *(unsigned*)(slotp(P, 4) + (size_t)(sl * 4096 + qb * 128 + row) * 512 + head * 128 + lane * 2) = pk2(o0 * rs * g0, o1 * rs * g1);
    }
}
#define LAS __attribute__((address_space(3)))
#define XB_TMO      128
#define XB_XCNT(j)  (256  + 64 * (j))
#define XB_XSUB(j)  (1280 + 64 * (j))
#define XB_XGEN(j)  (2304 + 64 * (j))
#define XB_TOP      3328
#define XB_TOPGEN   3392
#define XCD_BAR_WORDS 3456
#define XB_SPIN_CAP (1u << 18)

__device__ __forceinline__ unsigned xb_ld(unsigned* p)              { return __hip_atomic_load(p, __ATOMIC_RELAXED, __HIP_MEMORY_SCOPE_AGENT); }
__device__ __forceinline__ unsigned xb_add(unsigned* p, unsigned v) { return __hip_atomic_fetch_add(p, v, __ATOMIC_RELAXED, __HIP_MEMORY_SCOPE_AGENT); }
__device__ __forceinline__ unsigned xb_xcc_id() { return (unsigned)__builtin_amdgcn_s_getreg((3 << 11) | 20) & 0xFu; }
#define XB_SPIN(cond, bar) do { unsigned _sp = 0; while (cond) { __builtin_amdgcn_s_sleep(1); \
    if ((++_sp & 255u) == 0u) { if (xb_ld(&(bar)[XB_TMO])) break; if (_sp > XB_SPIN_CAP) { atomicAdd(&(bar)[XB_TMO], 1u); break; } } } } while (0)

struct XcdBarrier {
    unsigned* bar; unsigned x;
    volatile LAS unsigned* st;
};

__device__ __forceinline__ XcdBarrier xcd_barrier_post(unsigned* bar, volatile LAS unsigned* st, int wv) {
    XcdBarrier b; b.bar = bar; b.x = xb_xcc_id(); b.st = st;
    if (launder_tid(wv) == 0) (void)xb_add(&bar[XB_XCNT(b.x)], 1u);
    return b;
}
__device__ __forceinline__ void xcd_barrier_complete(unsigned* bar, unsigned x, unsigned& nloc, unsigned& nx) {
    const unsigned G = gridDim.x * gridDim.y * gridDim.z;
    unsigned sum, cnt, mine, sp = 0u;
    for (;;) {
        sum = 0u; cnt = 0u; mine = 0u;
#pragma unroll
        for (unsigned j = 0; j < 16; ++j) { const unsigned c = xb_ld(&bar[XB_XCNT(j)]); sum += c; cnt += (c > 0u) ? 1u : 0u; mine = (j == x) ? c : mine; }
        if (sum == G) break;
        __builtin_amdgcn_s_sleep(1);
        if ((++sp & 255u) == 0u) { if (xb_ld(&bar[XB_TMO])) break; if (sp > XB_SPIN_CAP) { atomicAdd(&bar[XB_TMO], 1u); break; } }
    }
    nloc = mine > 0u ? mine : 1u; nx = cnt > 0u ? cnt : 1u;
}

__device__ __forceinline__ void xcd_barrier(const XcdBarrier& b, int wv) {
    asm volatile("s_waitcnt vmcnt(0)" ::: "memory");
    __syncthreads();
    if (launder_tid(wv) == 0) {
        unsigned* bar = b.bar;
        __builtin_amdgcn_s_waitcnt(0);
        unsigned nloc = b.st[0], nx = b.st[1];
        if (nloc == 0u) { xcd_barrier_complete(bar, b.x, nloc, nx); b.st[0] = nloc; b.st[1] = nx; }
        const unsigned old = xb_add(&bar[XB_XSUB(b.x)], 1u);
        const unsigned gen = old / nloc;
        if (old + 1u == (gen + 1u) * nloc) {
            __builtin_amdgcn_fence(__ATOMIC_RELEASE, "agent");
            asm volatile("s_waitcnt vmcnt(0)" ::: "memory");
            const unsigned og = xb_add(&bar[XB_TOP], 1u);
            const unsigned tg = og / nx;
            if (og + 1u == (tg + 1u) * nx) xb_add(&bar[XB_TOPGEN], 1u);
            else XB_SPIN(xb_ld(&bar[XB_TOPGEN]) == tg, bar);
            __builtin_amdgcn_fence(__ATOMIC_ACQUIRE, "agent");
            xb_add(&bar[XB_XGEN(b.x)], 1u);
            asm volatile("s_waitcnt vmcnt(0)" ::: "memory");
        } else {
            XB_SPIN(xb_ld(&bar[XB_XGEN(b.x)]) == gen, bar);
            __builtin_amdgcn_fence(__ATOMIC_ACQUIRE, "agent");
            asm volatile("s_waitcnt vmcnt(0)" ::: "memory");
        }
    }
    __syncthreads();
}

__global__ void __launch_bounds__(512) mega_fwd(Params P) {
    extern __shared__ __attribute__((aligned(16))) unsigned char lds[];
    cg::grid_group grid = cg::this_grid();
    const int bid = blockIdx.x, nb = gridDim.x; const int wv = __builtin_amdgcn_readfirstlane(threadIdx.x >> 6);
    volatile LAS unsigned* MISC = (volatile LAS unsigned*)((LAS unsigned char*)lds + 131072 + 256);
    if (threadIdx.x < 4) MISC[threadIdx.x] = 0u;
    __syncthreads();
    XcdBarrier xbar;
    { Params Pb = load_params(); xbar = xcd_barrier_post((unsigned*)Pb.ws, MISC, wv); }
#define GSYNC() xcd_barrier(xbar, wv)
    PG8_LAS unsigned char* ldsl = (PG8_LAS unsigned char*)lds;
#pragma unroll 1
    for (int layer_ = 0; layer_ < 2; ++layer_) {
        phase_weights(P, lsd(layer_), lds, bid, nb, wv);
        grid.sync();
#pragma unroll 1
        for (int g_ = 0; g_ < NGRP; ++g_) {
            #define Mpost ((lsd(layer_) == 0 && lsd(g_) == 2) ? TGP : TREAL)
#define NVALID ((lsd(layer_) == 0 && lsd(g_) == 2) ? TG + 128 : TG)
            phase_rmsnorm(P, lsd(g_), lsd(layer_) == 0, I_NMIX, lsd(layer_), TGP, NVALID, bid, nb, wv);
            if (PROBE == 5) { phase_rmsnorm(P, lsd(g_), lsd(layer_) == 0, I_NMIX, lsd(layer_), TGP, NVALID, bid, nb, wv); }
            GSYNC();
            if (PROBE == 6) { for (int q_ = 0; q_ < 15; ++q_) GSYNC(); }
            for (int rep_ = 0; rep_ < (PROBE == 3 ? 2 : 1); ++rep_)
            { Params Pl = load_params(); Pl.ws = launder_ws(Pl.ws); pg8::bf16_t* W = (pg8::bf16_t*)(Pl.ws + WS_W); pg8::Gemm gm{slotp(Pl, 0), W + WO_IN, TGP, 7680, 1024, 0, 0}; pg8::StaticOrder S; S.init(TGP, 7680, nb, bid);
              pg8::EpiBf<0> E{slotp(Pl, 2), 512, SLOT_E};
              pg8::gemm_phase<pg8::EpiBf<0>, pg8::StaticOrder, true, true>(ldsl, gm, S, E, wv); }
            GSYNC();
            phase_da_prep(P, lsd(layer_), bid, nb, wv);
            phase_hg1(P, lsd(layer_), lds, bid, nb, wv);
            if (PROBE == 4) { phase_hg1(P, lsd(layer_), lds, bid, nb, wv); }
            GSYNC();
            phase_hg2(P, bid, nb, wv);
            GSYNC();
            phase_hg3(P, lsd(layer_), lds, bid, nb, wv);
            GSYNC();
            phase_conv(P, lsd(layer_), bid, nb, wv);
            if (PROBE == 5) { phase_conv(P, lsd(layer_), bid, nb, wv); }
            phase_vtrans(P, lds, bid, nb, wv);
            if (PROBE == 5) { phase_vtrans(P, lds, bid, nb, wv); }
            phase_rw_prep(P, lsd(layer_), bid, nb, wv);
            if (PROBE == 5) { phase_rw_prep(P, lsd(layer_), bid, nb, wv); }
            GSYNC();
            { Params Pl = load_params(); Pl.ws = launder_ws(Pl.ws); pg8::bf16_t* W = (pg8::bf16_t*)(Pl.ws + WS_W); pg8::Gemm gm{slotp(Pl, 21), W + WO_LR, TGP, 2560, 384, 0, 0}; pg8::StaticOrder S; S.init(TGP, 2560, nb, bid);
              pg8::EpiLR E{slotp(Pl, 22), slotp(Pl, 23), slotp(Pl, 24), slotp(Pl, 13), slotp(Pl, 14), Pl.in[I_W0] + lsd(layer_) * 1024, Pl.in[I_A0] + lsd(layer_) * 1024};
              pg8::gemm_phase<pg8::EpiLR, pg8::StaticOrder, true, true>(ldsl, gm, S, E, wv); }
            GSYNC();
            phase_rwc_pre(P, lsd(layer_), lds, bid, nb, wv);
            GSYNC();
            if (nb == 256) {
                const int nun = lsd(layer_) == 0 ? 528 : 512;
                if (bid < 64) { phase_rwc_scan(P, lds, bid, nb, wv); __syncthreads(); phase_attn(P, lsd(layer_), lds, bid, -1, -1, wv); }
                else { const int bq = bid - 64;
                    const int third = bq < 128 ? ((448 + (bq >> 1)) | ((3 + (bq & 1)) << 12)) : ((384 + bq < nun) ? 384 + bq : -1);
                    phase_attn(P, lsd(layer_), lds, 64 + bq, 256 + bq, third, wv); }
            } else {
                phase_rwc_scan(P, lds, bid, nb, wv); __syncthreads();
                for (int u = bid; u < (lsd(layer_) == 0 ? 528 : 512); u += nb) phase_attn(P, lsd(layer_), lds, u, -1, -1, wv);
            }
            GSYNC();
            if (nb == 256) phase_attn_combine(P, lsd(layer_), bid, nb, wv);
            phase_rw_post(P, lsd(layer_), lsd(g_), lsd(layer_) == 0 ? TG : TREAL, bid, nb, wv);
            if (PROBE == 5) { phase_rw_post(P, lsd(layer_), lsd(g_), lsd(layer_) == 0 ? TG : TREAL, bid, nb, wv); }
            GSYNC();
            { Params Pl = load_params(); Pl.ws = launder_ws(Pl.ws); pg8::bf16_t* W = (pg8::bf16_t*)(Pl.ws + WS_W); pg8::Gemm gm{slotp(Pl, 2), W + WO_BP, Mpost, 4096, 512, 4, SLOT_B}; pg8::StaticOrder S; S.init(Mpost, 4096, nb, bid);
              pg8::EpiBf<0> E{slotp(Pl, 6), 4096, 0};
              pg8::gemm_phase<pg8::EpiBf<0>, pg8::StaticOrder, true, true>(ldsl, gm, S, E, wv); }
            GSYNC();
            { Params Pl = load_params(); Pl.ws = launder_ws(Pl.ws); pg8::bf16_t* W = (pg8::bf16_t*)(Pl.ws + WS_W); pg8::Gemm gm{slotp(Pl, 0), W + WO_G, Mpost, 4096, 1024, 0, 0}; pg8::StaticOrder S; S.init(Mpost, 4096, nb, bid);
              pg8::EpiGate E{slotp(Pl, 6), slotp(Pl, 14)};
              pg8::gemm_phase<pg8::EpiGate, pg8::StaticOrder, true, true>(ldsl, gm, S, E, wv); }
            GSYNC();
            { Params Pl = load_params(); Pl.ws = launder_ws(Pl.ws); pg8::bf16_t* W = (pg8::bf16_t*)(Pl.ws + WS_W); pg8::Gemm gm{slotp(Pl, 14), W + WO_OUT, Mpost, 1024, 1024, 0, 0}; pg8::StaticOrder S; S.init(Mpost, 1024, nb, bid);
              pg8::EpiResid E{lsd(layer_) == 0 ? x_in_row(Pl, lsd(g_), 0) : (const float*)x_cur_row(Pl, lsd(g_), 0), lsd(layer_) == 0 ? Pl.in[I_META] : (const float*)nullptr, x_cur_row(Pl, lsd(g_), 0), GPTR(float, Pl.ws + WS_XMETA), lsd(g_), NVALID};
              pg8::gemm_phase<pg8::EpiResid, pg8::StaticOrder, true, true>(ldsl, gm, S, E, wv); }
            GSYNC();
            phase_rmsnorm(P, lsd(g_), false, I_NMLP, lsd(layer_), Mpost, NVALID, bid, nb, wv);
            if (PROBE == 5) { phase_rmsnorm(P, lsd(g_), false, I_NMLP, lsd(layer_), Mpost, NVALID, bid, nb, wv); }
            GSYNC();
            for (int rep_ = 0; rep_ < (PROBE == 7 ? 2 : 1); ++rep_)
            { Params Pl = load_params(); Pl.ws = launder_ws(Pl.ws); pg8::bf16_t* W = (pg8::bf16_t*)(Pl.ws + WS_W); pg8::Gemm gm{slotp(Pl, 0), W + WO_1, Mpost, 4096, 1024, 0, 0}; pg8::StaticOrder S; S.init(Mpost, 4096, nb, bid);
              pg8::EpiBf<1> E{slotp(Pl, 6), 4096, 0};
              pg8::gemm_phase<pg8::EpiBf<1>, pg8::StaticOrder, true, true>(ldsl, gm, S, E, wv); }
            GSYNC();
            { Params Pl = load_params(); Pl.ws = launder_ws(Pl.ws); pg8::bf16_t* W = (pg8::bf16_t*)(Pl.ws + WS_W); pg8::Gemm gm{slotp(Pl, 6), W + WO_2, Mpost, 1024, 4096, 0, 0}; pg8::StaticOrder S; S.init(Mpost, 1024, nb, bid);
              pg8::EpiResid E{(const float*)x_cur_row(Pl, lsd(g_), 0), (const float*)nullptr, x_cur_row(Pl, lsd(g_), 0), GPTR(float, Pl.ws + WS_XMETA), lsd(g_), NVALID};
              pg8::gemm_phase<pg8::EpiResid, pg8::StaticOrder, true, true>(ldsl, gm, S, E, wv); }
            GSYNC();
        }
    }
}

extern "C" void kernel_launch(void* const* d_in, const int* in_sizes, int n_in, void* d_out, int out_size, void* d_ws, size_t ws_size, hipStream_t stream) {
    static int grid = 0;
    if (grid == 0) {
        if (n_in != 29 || ws_size < WS_NEED) { fprintf(stderr, "kernel_launch: need 29 inputs and %zu bytes of workspace; got %d, %zu\n", (size_t)WS_NEED, n_in, ws_size); grid = -1; return; }
        int dev = 0, cus = 0, per_cu = 0;
        if (hipGetDevice(&dev) != hipSuccess || hipDeviceGetAttribute(&cus, hipDeviceAttributeMultiprocessorCount, dev) != hipSuccess) { grid = -1; return; }
        if (hipFuncSetAttribute((const void*)mega_fwd, hipFuncAttributeMaxDynamicSharedMemorySize, LDS_BYTES) != hipSuccess) { fprintf(stderr, "kernel_launch: hipFuncSetAttribute failed\n"); grid = -1; return; }
        if (hipOccupancyMaxActiveBlocksPerMultiprocessor(&per_cu, (const void*)mega_fwd, 512, LDS_BYTES) != hipSuccess || per_cu < 1) { fprintf(stderr, "kernel_launch: occupancy query says %d\n", per_cu); per_cu = 1; }
        (void)hipGetLastError();
        grid = cus;
    }
    if (grid < 0) return;
    if (hipMemsetAsync(d_ws, 0, 16384, stream) != hipSuccess) { fprintf(stderr, "kernel_launch: memset failed\n"); return; }
    Params p{};
    for (int i = 0; i < 29; ++i) p.in[i] = (const float*)d_in[i];
    p.out = (float*)d_out; p.ws = (unsigned char*)d_ws;
    void* args[] = {&p};
    hipError_t e = hipLaunchCooperativeKernel((const void*)mega_fwd, dim3(grid), dim3(512), args, LDS_BYTES, stream);
    if (e != hipSuccess) fprintf(stderr, "kernel_launch: cooperative launch failed: %s (grid %d)\n", hipGetErrorString(e), grid);
}
```

```cpp
#include <hip/hip_runtime.h>
#include <hip/hip_cooperative_groups.h>
#include <cstdio>
#include <cstdint>
namespace cg = cooperative_groups;
#define PROBE 0
#define DEV __device__ __forceinline__
__device__ __forceinline__ int lsd(int x) { asm volatile("" : "+s"(x)); return x; }
__device__ __forceinline__ int launder_tid(int wv) { int l; asm volatile("v_mbcnt_lo_u32_b32 %0, -1, 0\n\tv_mbcnt_hi_u32_b32 %0, -1, %0" : "=v"(l)); return wv * 64 + l; }
namespace pg8 {
#define PG8_LAS __attribute__((address_space(3)))
typedef unsigned short bf16_t;
typedef short bf16x8 __attribute__((ext_vector_type(8)));
typedef float f32x4 __attribute__((ext_vector_type(4)));
typedef unsigned u32x4 __attribute__((ext_vector_type(4)));
constexpr int BM = 256, BK = 64, HALF = 128, HTB = HALF * BK * 2  , STAGE_BYTES = 8 * HTB, NXCD = 8, WGM = 8;

__host__ __device__ __forceinline__ int lds_byte(int r, int c) { const int st = (r >> 4) * 2 + (c >> 5), rr = r & 15, cc = c & 31, ob = rr * 64 + cc * 2; return st * 1024 + (ob ^ (((ob >> 9) & 1) << 5)); }
__host__ __device__ __forceinline__ void stage_rc(int b, int& R, int& C) { const int st = b / 1024, sb = b % 1024, swz = sb ^ (((sb >> 9) & 1) << 5); R = (st >> 1) * 16 + swz / 64; C = (st & 1) * 32 + (swz % 64) / 2; }
__host__ __device__ __forceinline__ int perm32(int rho) { const int n = rho >> 4, i = rho & 15; return 8 * (i >> 2) + 4 * n + (i & 3); }

struct Unit { int pm, pn; };
struct Gemm { const bf16_t* A; const bf16_t* Bt; int M, N, K; int pn_per_ab; size_t ab_stride; };

struct StaticOrder {
    int nM, nN, nwg, G, c;
    __host__ __device__ void init(int M, int N, int G_, int c_) { nM = M / BM; nN = N / BM; nwg = nM * nN; G = G_; c = c_; }
    __host__ __device__ bool next(int i, Unit& u) const {
        const long L = (long)i * G + c; if (L >= nwg) return false;
        int wgid = (int)L; { const int q = nwg / NXCD, r = nwg % NXCD, xcd = wgid % NXCD, off = wgid / NXCD; wgid = (xcd < r ? xcd * (q + 1) : r * (q + 1) + (xcd - r) * q) + off; }
        const int nig = WGM * nN, gid = wgid / nig, fm = gid * WGM, gsz = (nM - fm) < WGM ? (nM - fm) : WGM;
        u.pm = fm + ((wgid % nig) % gsz); u.pn = (wgid % nig) / gsz; return true;
    }
    __device__ __forceinline__ void a_ready(const Unit&) const {}
    __device__ __forceinline__ void done(const Unit&) const {}
};

typedef float f32x2cv_t __attribute__((ext_vector_type(2))); typedef __bf16 bf16x2cv_t __attribute__((ext_vector_type(2)));
__device__ __forceinline__ unsigned cvt_pk_bf16(float lo, float hi) { const f32x2cv_t v = {lo, hi}; const bf16x2cv_t b = __builtin_convertvector(v, bf16x2cv_t); return __builtin_bit_cast(unsigned, b); }
typedef float f32x2 __attribute__((ext_vector_type(2)));
__device__ __forceinline__ float sigm(float x) { return __builtin_amdgcn_rcpf(1.0f + __expf(-x)); }
template <int ACT  > struct EpiBf {
    static constexpr bool PERM = true, AFTER_DRAIN = false;
    bf16_t* O; int ldc; size_t gstride;
    __device__ __forceinline__ void operator()(const f32x4 (&acc)[2][2][4][2], const Unit& u, int wr, int wc, int fr, int fq) const {
        const int row0 = u.pm * BM + wr * 64 + fr; int colt = u.pn * BM; bf16_t* base = O; int ld = ldc;
        if (gstride) { const int t = colt >> 9; colt &= 511; base += (size_t)t * gstride; ld = 512; }
        const int col0 = colt + wc * 32 + 8 * fq;
#pragma unroll
        for (int ai = 0; ai < 2; ++ai)
#pragma unroll
            for (int m = 0; m < 4; ++m) { bf16_t* rowp = base + (size_t)(row0 + ai * HALF + m * 16) * ld + col0;
#pragma unroll
                for (int bj = 0; bj < 2; ++bj) { f32x4 v0 = acc[ai][bj][m][0], v1 = acc[ai][bj][m][1];
                    if (ACT == 1) {
#pragma unroll
                        for (int i = 0; i < 4; ++i) { float a = fmaxf(v0[i], 0.f), b = fmaxf(v1[i], 0.f); v0[i] = a * a; v1[i] = b * b; } }
                    u32x4 w; w.x = cvt_pk_bf16(v0[0], v0[1]); w.y = cvt_pk_bf16(v0[2], v0[3]); w.z = cvt_pk_bf16(v1[0], v1[1]); w.w = cvt_pk_bf16(v1[2], v1[3]);
                    *(u32x4*)(rowp + bj * HALF) = w; } }
    }
};
struct EpiLR {
    static constexpr bool PERM = true, AFTER_DRAIN = false;
    bf16_t *s0, *s1, *s2, *s3, *s4; const float* w0; const float* a0;
    __device__ __forceinline__ void operator()(const f32x4 (&acc)[2][2][4][2], const Unit& u, int wr, int wc, int fr, int fq) const {
        const int row0 = u.pm * BM + wr * 64 + fr; const int colg = u.pn * BM; const int seg = colg >> 9; const int cb = colg & 511;
        bf16_t* base = seg == 0 ? s0 : seg == 1 ? s1 : seg == 2 ? s2 : seg == 3 ? s3 : s4;
        const int col0 = cb + wc * 32 + 8 * fq;
        const float* bsrc = seg < 2 ? w0 + seg * 512 : a0 + (seg & 1) * 512;
        const float sc = seg < 2 ? 0.6065306597f : 1.0f; const float bm = seg < 4 ? 1.f : 0.f; const bool act = seg < 4;
#pragma unroll
        for (int bj = 0; bj < 2; ++bj) {
            const f32x4 b0 = *(const f32x4*)(bsrc + col0 + bj * HALF) * bm, b1 = *(const f32x4*)(bsrc + col0 + bj * HALF + 4) * bm;
#pragma unroll
            for (int ai = 0; ai < 2; ++ai)
#pragma unroll
                for (int m = 0; m < 4; ++m) { bf16_t* rowp = base + (size_t)(row0 + ai * HALF + m * 16) * 512 + col0;
                    f32x4 v0 = acc[ai][bj][m][0] + b0, v1 = acc[ai][bj][m][1] + b1;
#pragma unroll
                    for (int i = 0; i < 4; ++i) { const float g0 = sc * sigm(v0[i]), g1 = sc * sigm(v1[i]); v0[i] = act ? g0 : v0[i]; v1[i] = act ? g1 : v1[i]; }
                    u32x4 w; w.x = cvt_pk_bf16(v0[0], v0[1]); w.y = cvt_pk_bf16(v0[2], v0[3]); w.z = cvt_pk_bf16(v1[0], v1[1]); w.w = cvt_pk_bf16(v1[2], v1[3]);
                    *(u32x4*)(rowp + bj * HALF) = w; __builtin_amdgcn_sched_barrier(0); }
        }
    }
};
struct EpiGate {
    static constexpr bool PERM = true, AFTER_DRAIN = false;
    const bf16_t* Pm; bf16_t* Mg;
    __device__ __forceinline__ void operator()(const f32x4 (&acc)[2][2][4][2], const Unit& u, int wr, int wc, int fr, int fq) const {
        const int row0 = u.pm * BM + wr * 64 + fr; const int ocol = u.pn * 64 + wc * 16 + fq * 4;
#pragma unroll
        for (int ai = 0; ai < 2; ++ai)
#pragma unroll
            for (int m = 0; m < 4; ++m) { const size_t row = (size_t)(row0 + ai * HALF + m * 16);
                float s0 = 0.f, s1 = 0.f, s2 = 0.f, s3 = 0.f;
#pragma unroll
                for (int bj = 0; bj < 2; ++bj)
#pragma unroll
                    for (int n = 0; n < 2; ++n) { const int br = bj * 2 + n;
                        const uint2 pw = *(const uint2*)(Pm + row * 4096 + br * 1024 + ocol);
                        const f32x4 a = acc[ai][bj][m][n];
                        s0 += sigm(a[0]) * __uint_as_float(pw.x << 16); s1 += sigm(a[1]) * __uint_as_float(pw.x & 0xffff0000u);
                        s2 += sigm(a[2]) * __uint_as_float(pw.y << 16); s3 += sigm(a[3]) * __uint_as_float(pw.y & 0xffff0000u); }
                uint2 o; o.x = cvt_pk_bf16(s0, s1); o.y = cvt_pk_bf16(s2, s3);
                *(uint2*)(Mg + row * 1024 + ocol) = o; }
    }
};
struct EpiResid {
    static constexpr bool PERM = true, AFTER_DRAIN = false;
    const float* om; const float* mt; float* nm; float* xmb; int g; int rlim;
    __device__ __forceinline__ void operator()(const f32x4 (&acc)[2][2][4][2], const Unit& u, int wr, int wc, int fr, int fq) const {
        const int row0 = u.pm * BM + wr * 64 + fr; const int col0 = u.pn * BM + wc * 32 + 8 * fq;
#pragma unroll
        for (int ai = 0; ai < 2; ++ai)
#pragma unroll
            for (int m = 0; m < 4; ++m) { const int r = row0 + ai * HALF + m * 16;
                if (r < rlim) {
                    const int mi = r - 16384;
                    float* dmeta = xmb + (size_t)(mi < 64 ? g * 64 + mi : ((mi >> 6) - 1) * 64 + (mi & 63)) * 1024;
                    const float* src = r < 16384 ? om + (size_t)r * 1024 : (mt ? mt + (size_t)(mi & 15) * 1024 : (const float*)dmeta);
                    float* dst = r < 16384 ? nm + (size_t)r * 1024 : dmeta;
#pragma unroll
                    for (int bj = 0; bj < 2; ++bj)
#pragma unroll
                        for (int n = 0; n < 2; ++n) { const int c = col0 + bj * HALF + 4 * n;
                            const f32x4 xo = *(const f32x4*)(src + c); *(f32x4*)(dst + c) = xo + acc[ai][bj][m][n]; } } }
    }
};
template <class Epi, class Sched, bool ALIGN_EPI = false, bool SP2 = false>
__device__ __forceinline__ void gemm_phase(PG8_LAS unsigned char* lds, const Gemm g, const Sched& S, const Epi& E, int wv) {
    const int tid = launder_tid(wv), wid = __builtin_amdgcn_readfirstlane(tid >> 6), lane = tid & 63, wr = wid >> 2, wc = wid & 3, fr = lane & 15, fq = lane >> 4;
    const int K = g.K, nt = K / BK;
    unsigned voffA[2], voffB[2];
#pragma unroll
    for (int i = 0; i < 2; ++i) { int R, C; stage_rc(tid * 16 + i * 8192, R, C); const int Rb = Epi::PERM ? ((R & ~31) + perm32(R & 31)) : R;
        voffA[i] = (unsigned)(R * K + C) * 2u; voffB[i] = (unsigned)(Rb * K + C) * 2u; }
    const size_t kstep = (size_t)(BK * 2);
    const size_t hstep = (size_t)HALF * K * 2;
    const size_t tstep = 2 * hstep;
    const unsigned ldsw = (unsigned)wid * 1024u;
    const int aoff = lds_byte(wr * 64 + fr, fq * 8), boff = lds_byte(wc * 32 + fr, fq * 8);
#define PG8_SA(b, h) (((b) * 2 + (h)) * HTB)
#define PG8_SB(b, h) ((4 + (b) * 2 + (h)) * HTB)
#define PG8_STAGE(bufoff, gbase, voff) do { _Pragma("unroll") for (int _i = 0; _i < 2; ++_i) \
        __builtin_amdgcn_global_load_lds((const unsigned*)((const char*)(gbase) + (voff)[_i]), (PG8_LAS unsigned*)(lds + (bufoff) + ldsw + _i * 8192), 16, 0, 0); } while (0)
#define PG8_LDA(dst, b, h) do { _Pragma("unroll") for (int m = 0; m < 4; ++m) _Pragma("unroll") for (int k = 0; k < 2; ++k) dst[m][k] = *(const PG8_LAS bf16x8*)(lds + PG8_SA(b, h) + aoff + m * 2048 + k * 1024); } while (0)
#define PG8_LDB(dst, b, h) do { _Pragma("unroll") for (int n = 0; n < 2; ++n) _Pragma("unroll") for (int k = 0; k < 2; ++k) dst[n][k] = *(const PG8_LAS bf16x8*)(lds + PG8_SB(b, h) + boff + n * 2048 + k * 1024); } while (0)
#define PG8_MMA(ai, bj, At, Bt) do { __builtin_amdgcn_s_setprio(1); _Pragma("unroll") for (int m = 0; m < 4; ++m) _Pragma("unroll") for (int n = 0; n < 2; ++n) _Pragma("unroll") for (int k = 0; k < 2; ++k) \
        acc[ai][bj][m][n] = __builtin_amdgcn_mfma_f32_16x16x32_bf16(Bt[n][k], At[m][k], acc[ai][bj][m][n], 0, 0, 0); __builtin_amdgcn_s_setprio(0); } while (0)
#define PG8_WAIT_V(n) asm volatile("s_waitcnt vmcnt(" #n ")" ::: "memory")
#define PG8_WAIT_L(n) asm volatile("s_waitcnt lgkmcnt(" #n ")" ::: "memory")
#define PG8_BAR __builtin_amdgcn_s_barrier()
#define PG8_SCHED __builtin_amdgcn_sched_barrier(0)
    Unit cur, nxt; int ui = 0;
    if (!S.next(0, cur)) return;
    f32x4 acc[2][2][4][2];
#pragma unroll
    for (int a = 0; a < 2; ++a)
#pragma unroll
        for (int b = 0; b < 2; ++b)
#pragma unroll
            for (int m = 0; m < 4; ++m)
#pragma unroll
                for (int n = 0; n < 2; ++n) { float z_ = 0.f; asm volatile("" : "+v"(z_)); acc[a][b][m][n] = (f32x4){z_, z_, z_, z_}; }
    bf16x8 At[4][2], B0[2][2], B1[2][2];
    const char* cA = (const char*)g.A + (g.pn_per_ab ? (size_t)(cur.pn / g.pn_per_ab) * g.ab_stride : (size_t)0) + (size_t)cur.pm * tstep; const char* cB = (const char*)g.Bt + (size_t)cur.pn * tstep;
    S.a_ready(cur);
    if constexpr (SP2) {
        PG8_STAGE(PG8_SB(0, 0), cB, voffB); PG8_STAGE(PG8_SB(0, 1), cB + hstep, voffB); PG8_STAGE(PG8_SA(0, 0), cA, voffA); PG8_STAGE(PG8_SA(0, 1), cA + hstep, voffA);
        if (wr == 1) PG8_BAR;
        PG8_WAIT_V(2); PG8_BAR;
        PG8_STAGE(PG8_SB(1, 0), cB + kstep, voffB); PG8_STAGE(PG8_SA(1, 0), cA + kstep, voffA); PG8_STAGE(PG8_SB(1, 1), cB + hstep + kstep, voffB);
        PG8_WAIT_V(6); PG8_BAR;
    } else {
        PG8_STAGE(PG8_SB(0, 0), cB, voffB); PG8_STAGE(PG8_SA(0, 0), cA, voffA); PG8_STAGE(PG8_SB(0, 1), cB + hstep, voffB); PG8_STAGE(PG8_SA(0, 1), cA + hstep, voffA);
        if (wr == 1) PG8_BAR;
        PG8_WAIT_V(4); PG8_BAR;
        PG8_STAGE(PG8_SB(1, 0), cB + kstep, voffB); PG8_STAGE(PG8_SA(1, 0), cA + kstep, voffA); PG8_STAGE(PG8_SB(1, 1), cB + hstep + kstep, voffB);
        PG8_WAIT_V(6); PG8_BAR;
    }
    for (;;) {
        const bool has_next = S.next(ui + 1, nxt);
        const char* nA = has_next ? (const char*)g.A + (g.pn_per_ab ? (size_t)(nxt.pn / g.pn_per_ab) * g.ab_stride : (size_t)0) + (size_t)nxt.pm * tstep : cA; const char* nB = has_next ? (const char*)g.Bt + (size_t)nxt.pn * tstep : cB;
#pragma unroll 1
        for (int t = 0; t < nt; t += 2) {
            const bool last = (t == nt - 2);
            const char* a1 = cA + (size_t)(t + 1) * kstep;
            const char* a2 = last ? nA : cA + (size_t)(t + 2) * kstep; const char* b2 = last ? nB : cB + (size_t)(t + 2) * kstep;
            const char* a3 = a2 + kstep; const char* b3 = b2 + kstep;
            if (last && has_next) S.a_ready(nxt);
            if constexpr (SP2) {
            PG8_LDB(B0, 0, 0); PG8_LDB(B1, 0, 1); PG8_SCHED; PG8_LDA(At, 0, 0); PG8_STAGE(PG8_SA(1, 1), a1 + hstep, voffA);
            PG8_WAIT_V(8); PG8_WAIT_L(0); PG8_BAR; PG8_MMA(0, 0, At, B0); PG8_MMA(0, 1, At, B1); PG8_BAR; PG8_SCHED;
            PG8_LDA(At, 0, 1); PG8_STAGE(PG8_SB(0, 0), b2, voffB); PG8_STAGE(PG8_SB(0, 1), b2 + hstep, voffB); PG8_STAGE(PG8_SA(0, 0), a2, voffA);
            PG8_WAIT_V(8); PG8_WAIT_L(0); PG8_BAR; PG8_MMA(1, 0, At, B0); PG8_MMA(1, 1, At, B1); PG8_BAR; PG8_SCHED;
            PG8_LDB(B0, 1, 0); PG8_LDB(B1, 1, 1); PG8_SCHED; PG8_LDA(At, 1, 0); PG8_STAGE(PG8_SA(0, 1), a2 + hstep, voffA);
            PG8_WAIT_V(8); PG8_WAIT_L(0); PG8_BAR; PG8_MMA(0, 0, At, B0); PG8_MMA(0, 1, At, B1); PG8_BAR; PG8_SCHED;
            PG8_LDA(At, 1, 1); PG8_STAGE(PG8_SB(1, 0), b3, voffB); PG8_STAGE(PG8_SB(1, 1), b3 + hstep, voffB); PG8_STAGE(PG8_SA(1, 0), a3, voffA);
            PG8_WAIT_V(8); PG8_WAIT_L(0); PG8_BAR; PG8_MMA(1, 0, At, B0); PG8_MMA(1, 1, At, B1); PG8_BAR; PG8_SCHED;
            } else {
            PG8_LDB(B0, 0, 0); PG8_SCHED; PG8_LDA(At, 0, 0); PG8_STAGE(PG8_SA(1, 1), a1 + hstep, voffA);
            PG8_WAIT_L(8); PG8_BAR; PG8_WAIT_L(0); PG8_MMA(0, 0, At, B0); PG8_BAR; PG8_SCHED;
            PG8_LDB(B1, 0, 1); PG8_STAGE(PG8_SB(0, 0), b2, voffB);
            PG8_BAR; PG8_WAIT_L(0); PG8_MMA(0, 1, At, B1); PG8_BAR;
            PG8_LDA(At, 0, 1); PG8_STAGE(PG8_SA(0, 0), a2, voffA);
            PG8_BAR; PG8_WAIT_L(0); PG8_MMA(1, 0, At, B0); PG8_BAR; PG8_SCHED;
            PG8_STAGE(PG8_SB(0, 1), b2 + hstep, voffB);
            PG8_WAIT_V(6); PG8_BAR; PG8_MMA(1, 1, At, B1); PG8_BAR;
            PG8_LDB(B0, 1, 0); PG8_SCHED; PG8_LDA(At, 1, 0); PG8_STAGE(PG8_SA(0, 1), a2 + hstep, voffA);
            PG8_WAIT_L(8); PG8_BAR; PG8_WAIT_L(0); PG8_MMA(0, 0, At, B0); PG8_BAR; PG8_SCHED;
            PG8_LDB(B1, 1, 1); PG8_STAGE(PG8_SB(1, 0), b3, voffB);
            PG8_BAR; PG8_WAIT_L(0); PG8_MMA(0, 1, At, B1); PG8_BAR;
            PG8_LDA(At, 1, 1); PG8_STAGE(PG8_SA(1, 0), a3, voffA);
            PG8_BAR; PG8_WAIT_L(0); PG8_MMA(1, 0, At, B0); PG8_BAR; PG8_SCHED;
            PG8_STAGE(PG8_SB(1, 1), b3 + hstep, voffB);
            PG8_WAIT_V(6); PG8_BAR; PG8_MMA(1, 1, At, B1); PG8_BAR;
            }
        }
        if constexpr (ALIGN_EPI) { if (wr == 0) PG8_BAR; }
        if constexpr (!Epi::AFTER_DRAIN) { E(acc, cur, wr, wc, fr, fq); S.done(cur); }
        if (!has_next) break;
#pragma unroll
        for (int a = 0; a < 2; ++a)
#pragma unroll
            for (int b = 0; b < 2; ++b)
#pragma unroll
                for (int m = 0; m < 4; ++m)
#pragma unroll
                    for (int n = 0; n < 2; ++n) { float z_ = 0.f; asm volatile("" : "+v"(z_)); acc[a][b][m][n] = (f32x4){z_, z_, z_, z_}; }
        cur = nxt; cA = nA; cB = nB; ++ui;
        if constexpr (ALIGN_EPI) { if (wr == 1) PG8_BAR; }
    }
    PG8_WAIT_V(0);
    if constexpr (!ALIGN_EPI) { if (wr == 0) PG8_BAR; }
    PG8_BAR;
    if constexpr (Epi::AFTER_DRAIN) { E.fused(acc, cur, wr, wc, fr, fq, lds, wid, lane); S.done(cur); }
#undef PG8_SA
#undef PG8_SB
#undef PG8_STAGE
#undef PG8_LDA
#undef PG8_LDB
#undef PG8_MMA
#undef PG8_WAIT_V
#undef PG8_WAIT_L
#undef PG8_BAR
#undef PG8_SCHED
}
}
typedef unsigned short bf16_t;
typedef short bf16x8 __attribute__((ext_vector_type(8)));
typedef float f32x4 __attribute__((ext_vector_type(4)));
typedef float f32x16 __attribute__((ext_vector_type(16)));
constexpr int LSEQ = 4112, TREAL = 16384, TG = 16448, TGP = 16640, NGRP = 3;
constexpr size_t SLOT_E = (size_t)TGP * 512;
constexpr size_t SLOT_B = SLOT_E * 2;
constexpr size_t MiB = 1u << 20;
constexpr size_t WS_XMETA = 1 * MiB, WS_DECAY = 2 * MiB, WS_SIDE = 3 * MiB + 512 * 1024, WS_W = 5 * MiB, WS_SLOTS = 53 * MiB;
constexpr size_t WS_NEED = 512 * MiB;
static_assert(WS_SLOTS + 25 * SLOT_B + (size_t)(16448 - 11408) * 8960 <= 512 * MiB, "record tail fits the workspace");
constexpr size_t WO_IN = 0, WO_G = 7864320, WO_BP = 12058624, WO_OUT = 14155776, WO_1 = 15204352, WO_2 = 19398656, WO_LR = 23592960;
constexpr int LDS_BYTES = 140 * 1024;
enum { I_XP = 0, I_XS, I_META, I_NMIX, I_WIN, I_LBL, I_ONORM, I_CONV, I_QN, I_KN, I_LAM, I_SUBLN, I_MU, I_W0, I_W2, I_A0, I_A2, I_G2, I_KK, I_KA, I_RK, I_LNG, I_LNB, I_WG, I_BP, I_WOUT, I_NMLP, I_W1, I_W2M };
struct Params { const float* in[29]; float* out; unsigned char* ws; };
#define GPTR(T, p) ((T*)(__attribute__((address_space(1))) T*)(p))
typedef const __attribute__((address_space(4))) Params* KParamsPtr;
typedef unsigned u32x4g_t __attribute__((ext_vector_type(4)));
#define GLD16(p) (*(const __attribute__((address_space(1))) u32x4g_t*)(p))
DEV KParamsPtr kparams() { KParamsPtr p = (KParamsPtr)__builtin_amdgcn_kernarg_segment_ptr(); asm volatile("" : "+s"(p)); return p; }
DEV Params load_params() { KParamsPtr p = kparams(); Params r;
#pragma unroll
    for (int i = 0; i < 29; ++i) r.in[i] = (const float*)(const __attribute__((address_space(1))) float*)(unsigned long long)p->in[i];
    r.out = (float*)(__attribute__((address_space(1))) float*)(unsigned long long)p->out; r.ws = p->ws; return r; }
DEV unsigned char* launder_ws(unsigned char* p) { __attribute__((address_space(1))) unsigned char* g = (__attribute__((address_space(1))) unsigned char*)(unsigned long long)p; asm volatile("" : "+s"(g)); return (unsigned char*)g; }
DEV unsigned zero_u() { unsigned z = 0u; asm volatile("" : "+v"(z)); return z; }

#define ROWPRO const int tid_ = launder_tid(wv); const int lane = tid_ & 63; const int gw = bid * 8 + __builtin_amdgcn_readfirstlane(tid_ >> 6); const int ngw = nb * 8;
DEV float bf2f(unsigned short u) { return __uint_as_float((unsigned)u << 16); }
DEV unsigned pk2(float lo, float hi) { return pg8::cvt_pk_bf16(lo, hi); }
DEV void unpack8(const uint4 w, float* f) {
    f[0] = __uint_as_float(w.x << 16); f[1] = __uint_as_float(w.x & 0xffff0000u); f[2] = __uint_as_float(w.y << 16); f[3] = __uint_as_float(w.y & 0xffff0000u);
    f[4] = __uint_as_float(w.z << 16); f[5] = __uint_as_float(w.z & 0xffff0000u); f[6] = __uint_as_float(w.w << 16); f[7] = __uint_as_float(w.w & 0xffff0000u); }
DEV uint4 pack8(const float* f) { uint4 o; o.x = pk2(f[0], f[1]); o.y = pk2(f[2], f[3]); o.z = pk2(f[4], f[5]); o.w = pk2(f[6], f[7]); return o; }
DEV bf16_t* slotp(const Params& P, int s) { return GPTR(bf16_t, P.ws + WS_SLOTS + (size_t)s * SLOT_B); }
DEV int row_of(int sl, int p) { return p >= 16 ? sl * 4096 + p - 16 : TREAL + sl * 16 + p; }
DEV void pos_of(int r, int& sl, int& p) { if (r < TREAL) { sl = r >> 12; p = (r & 4095) + 16; } else { const int m = r - TREAL; sl = m >> 4; p = m & 15; } }
DEV float wave_sum(float v) {
#pragma unroll
    for (int o = 1; o < 64; o <<= 1) v += __shfl_xor(v, o);
    return v; }
DEV float red8(float v) { v += __shfl_xor(v, 1); v += __shfl_xor(v, 2); v += __shfl_xor(v, 4); return v; }
DEV f32x4 mfma16(bf16x8 a, bf16x8 b, f32x4 c) { return __builtin_amdgcn_mfma_f32_16x16x32_bf16(a, b, c, 0, 0, 0); }
DEV f32x16 mfma32(bf16x8 a, bf16x8 b, f32x16 c) { return __builtin_amdgcn_mfma_f32_32x32x16_bf16(a, b, c, 0, 0, 0); }
DEV const float* x_in_row(const Params& P, int g, int r) {
    if (r < TREAL) return (g < 2 ? P.in[I_XP] + (size_t)g * TREAL * 1024 : P.in[I_XS]) + (size_t)r * 1024;
    return P.in[I_META] + (size_t)((r - TREAL) & 15) * 1024; }
DEV float* x_cur_row(const Params& P, int g, int r) {
    if (r < TREAL) return P.out + ((size_t)g * TREAL + r) * 1024;
    const int m = r - TREAL;
    return GPTR(float, P.ws + WS_XMETA) + (size_t)(m < 64 ? g * 64 + m : ((m >> 6) - 1) * 64 + (m & 63)) * 1024; }

DEV int gate_row(int n) { const int br = n >> 10, c = n & 1023, pn = c >> 6, oc = c & 63, wc = oc >> 4, fq = (oc >> 2) & 3, i = oc & 3; return pn * 256 + (br >> 1) * 128 + wc * 32 + fq * 8 + (br & 1) * 4 + i; }
template <int MODE> DEV void wt_items(const float* __restrict__ W, int K, int N, bf16_t* WT, int row_off, float* scr, int gw, int ngw, int lane) {
    const int nblk = N >> 5, items = (K >> 6) * nblk;
    for (int it = gw; it < items; it += ngw) {
        const int kb = it / nblk, nbk = it - kb * nblk, k0 = 64 * kb, n0 = 32 * nbk;
#pragma unroll 8
        for (int i = 0; i < 32; ++i) { const int kk = 2 * i + (lane >> 5); scr[kk * 33 + (lane & 31)] = W[(size_t)(k0 + kk) * N + n0 + (lane & 31)]; }
        asm volatile("s_waitcnt lgkmcnt(0)" ::: "memory");
        const int c = lane & 7;
#pragma unroll
        for (int j = 0; j < 4; ++j) { const int n = (lane >> 3) + 8 * j; const float* sp = scr + (8 * c) * 33 + n;
            uint4 o; o.x = pk2(sp[0 * 33], sp[1 * 33]); o.y = pk2(sp[2 * 33], sp[3 * 33]); o.z = pk2(sp[4 * 33], sp[5 * 33]); o.w = pk2(sp[6 * 33], sp[7 * 33]);
            const int dr = MODE == 1 ? gate_row(n0 + n) : n0 + n + row_off;
            *(uint4*)(WT + (size_t)dr * K + k0 + 8 * c) = o; }
        asm volatile("s_waitcnt lgkmcnt(0)" ::: "memory");
    }
}
DEV void phase_weights(const Params& P0, int layer, unsigned char* lds, int bid, int nb, int wv) {
    Params P = load_params(); P.ws = launder_ws(P.ws);
    const int tid = launder_tid(wv), lane = tid & 63, w = __builtin_amdgcn_readfirstlane(tid >> 6);
    const int gtid = bid * 512 + tid, gth = nb * 512, gw = bid * 8 + w, ngw = nb * 8;
    float* scr = (float*)(lds + w * 8448);
    bf16_t* W = GPTR(bf16_t, P.ws + WS_W);
    wt_items<0>(P.in[I_WIN] + (size_t)layer * 1024 * 7552, 1024, 7552, W + WO_IN, 0, scr, gw, ngw, lane);
    for (int it = gtid; it < 128 * 128; it += gth) { const unsigned z = zero_u(); *(uint4*)(W + WO_IN + (size_t)7552 * 1024 + (size_t)it * 8) = make_uint4(z, z, z, z); }
    wt_items<1>(P.in[I_WG] + (size_t)layer * 1024 * 4096, 1024, 4096, W + WO_G, 0, scr, gw, ngw, lane);
    for (int n = 0; n < 4; ++n) wt_items<0>(P.in[I_BP] + (size_t)(layer * 4 + n) * 512 * 1024, 512, 1024, W + WO_BP, n * 1024, scr, gw, ngw, lane);
    wt_items<0>(P.in[I_WOUT] + (size_t)layer * 1024 * 1024, 1024, 1024, W + WO_OUT, 0, scr, gw, ngw, lane);
    wt_items<0>(P.in[I_W1] + (size_t)layer * 1024 * 4096, 1024, 4096, W + WO_1, 0, scr, gw, ngw, lane);
    wt_items<0>(P.in[I_W2M] + (size_t)layer * 4096 * 1024, 4096, 1024, W + WO_2, 0, scr, gw, ngw, lane);
    for (int it = gtid; it < 2560 * 48; it += gth) {
        const int row = it / 48, k8 = it - row * 48, seg = row >> 9, c = row & 511, k0 = k8 * 8;
        float v[8];
#pragma unroll
        for (int j = 0; j < 8; ++j) { const int k = k0 + j; float x = 0.f;
            if (seg == 0) { if (k < 64) x = P.in[I_W2][((size_t)(layer * 2 + 0) * 64 + k) * 512 + c]; }
            else if (seg == 1) { if (k >= 64 && k < 128) x = P.in[I_W2][((size_t)(layer * 2 + 1) * 64 + (k - 64)) * 512 + c]; }
            else if (seg == 2) { if (k >= 128 && k < 192) x = P.in[I_A2][((size_t)(layer * 2 + 0) * 64 + (k - 128)) * 512 + c]; }
            else if (seg == 3) { if (k >= 192 && k < 256) x = P.in[I_A2][((size_t)(layer * 2 + 1) * 64 + (k - 192)) * 512 + c]; }
            else { if (k >= 256) x = P.in[I_G2][((size_t)layer * 128 + (k - 256)) * 512 + c]; }
            v[j] = x; }
        *(uint4*)(W + WO_LR + (size_t)row * 384 + k0) = pack8(v);
    }
}

DEV void phase_rmsnorm(const Params& P0, int g, bool src_in, int gain_idx, int layer, int nrows, int nvalid, int bid, int nb, int wv) {
    Params P = load_params(); P.ws = launder_ws(P.ws);
    ROWPRO
    const float* gain = P.in[gain_idx] + layer * 1024;
    bf16_t* H = slotp(P, 0);
    for (int r = gw; r < nrows; r += ngw) {
        uint2* o8 = (uint2*)(H + (size_t)r * 1024) + lane;
        if (r >= nvalid) {
#pragma unroll
            for (int j = 0; j < 4; ++j) { const unsigned z = zero_u(); o8[64 * j] = make_uint2(z, z); }
            continue; }
        const f32x4* xr = (const f32x4*)(src_in ? x_in_row(P, g, r) : (const float*)x_cur_row(P, g, r)) + lane;
        f32x4 v[4]; float s = 0.f;
#pragma unroll
        for (int j = 0; j < 4; ++j) { v[j] = xr[64 * j]; s += (v[j].x * v[j].x + v[j].y * v[j].y) + (v[j].z * v[j].z + v[j].w * v[j].w); }
        const float rs = rsqrtf(wave_sum(s) * (1.f / 1024.f) + 1e-6f);
#pragma unroll
        for (int j = 0; j < 4; ++j) { const f32x4 gg = *((const f32x4*)gain + lane + 64 * j);
            o8[64 * j] = make_uint2(pk2(v[j].x * rs * gg.x, v[j].y * rs * gg.y), pk2(v[j].z * rs * gg.z, v[j].w * rs * gg.w)); }
    }
}
DEV void phase_da_prep(const Params& P0, int layer, int bid, int nb, int wv) {
    Params P = load_params(); P.ws = launder_ws(P.ws);
    ROWPRO
    const float inv8[8] = {1.0f, 0.19392274474868576f, 0.03760603093086393f, 0.007292664737217109f, 0.001414213562373095f, 0.0002742481756762073f, 5.318295896944988e-05f, 1.031338537721246e-05f};
    const int d0 = (lane & 7) * 8;
    float gq[8], gk[8];
#pragma unroll
    for (int j = 0; j < 8; ++j) { gq[j] = P.in[I_QN][layer * 64 + d0 + j]; gk[j] = P.in[I_KN][layer * 64 + d0 + j]; }
    for (int r = gw; r < TG; r += ngw) {
        int sl, p; pos_of(r, sl, p);
        float cs[8], sn[8];
#pragma unroll
        for (int j = 0; j < 8; ++j) { const float ang = (float)p * inv8[j]; double a = (double)ang; a -= 6.283185307179586 * __builtin_rint(a * 0.15915494309189535); const float rr = (float)a; cs[j] = __cosf(rr); sn[j] = __sinf(rr); }
#pragma unroll
        for (int which = 0; which < 2; ++which) {
            uint4* ptr = (uint4*)(slotp(P, 10 + which) + (size_t)r * 512) + lane;
            float f[8]; unpack8(*ptr, f);
            float ss = 0.f;
#pragma unroll
            for (int j = 0; j < 8; ++j) ss += f[j] * f[j];
            ss = red8(ss);
            const float rs = rsqrtf(ss * (1.f / 64.f) + 1e-6f);
#pragma unroll
            for (int j = 0; j < 8; ++j) f[j] = f[j] * rs * (which == 0 ? gq[j] : gk[j]);
#pragma unroll
            for (int j = 0; j < 8; ++j) { const float pr = __shfl_xor(f[j], 1);
                if ((lane & 7) == 0) f[j] = f[j] * cs[j] - pr * sn[j];
                else if ((lane & 7) == 1) f[j] = f[j] * cs[j] + pr * sn[j]; }
            if (which == 0) {
#pragma unroll
                for (int j = 0; j < 8; ++j) f[j] *= 0.18033688011112042f; }
            *ptr = pack8(f);
        }
    }
}
DEV void phase_conv(const Params& P0, int layer, int bid, int nb, int wv) {
    Params P = load_params(); P.ws = launder_ws(P.ws);
    ROWPRO
    const int c0 = lane * 8;
    float w0[8], w1[8], w2[8];
#pragma unroll
    for (int j = 0; j < 8; ++j) { w0[j] = P.in[I_CONV][(layer * 3 + 0) * 512 + c0 + j]; w1[j] = P.in[I_CONV][(layer * 3 + 1) * 512 + c0 + j]; w2[j] = P.in[I_CONV][(layer * 3 + 2) * 512 + c0 + j]; }
    const bf16_t* SB = slotp(P, 7); const bf16_t* SC = slotp(P, 8); const bf16_t* SH = slotp(P, 9); bf16_t* Y = slotp(P, 3);
    for (int r = gw; r < TG; r += ngw) {
        int sl, p; pos_of(r, sl, p);
        float acc[8], a[8], b[8];
        unpack8(*((const uint4*)(SC + (size_t)r * 512) + lane), a); unpack8(*((const uint4*)(SH + (size_t)r * 512) + lane), b);
#pragma unroll
        for (int j = 0; j < 8; ++j) acc[j] = a[j] * b[j] * w1[j];
        if (p > 0) { const int rp = row_of(sl, p - 1);
            unpack8(*((const uint4*)(SC + (size_t)rp * 512) + lane), a); unpack8(*((const uint4*)(SH + (size_t)rp * 512) + lane), b);
#pragma unroll
            for (int j = 0; j < 8; ++j) acc[j] += a[j] * b[j] * w0[j]; }
        if (p < LSEQ - 1) { const int rn = row_of(sl, p + 1);
            unpack8(*((const uint4*)(SC + (size_t)rn * 512) + lane), a); unpack8(*((const uint4*)(SH + (size_t)rn * 512) + lane), b);
#pragma unroll
            for (int j = 0; j < 8; ++j) acc[j] += a[j] * b[j] * w2[j]; }
        unpack8(*((const uint4*)(SB + (size_t)r * 512) + lane), a);
#pragma unroll
        for (int j = 0; j < 8; ++j) acc[j] *= a[j];
        *((uint4*)(Y + (size_t)r * 512) + lane) = pack8(acc);
    }
}
DEV void phase_rw_prep(const Params& P0, int layer, int bid, int nb, int wv) {
    Params P = load_params(); P.ws = launder_ws(P.ws);
    ROWPRO
    const float* mu = P.in[I_MU] + (size_t)layer * 1920;
    for (int r = gw; r < TG; r += ngw) {
        int sl, p; pos_of(r, sl, p);
        const int rp = p > 0 ? row_of(sl, p - 1) : -1, rn = p < LSEQ - 1 ? row_of(sl, p + 1) : -1;
#pragma unroll
        for (int grp = 0; grp < 4; ++grp) {
            if (grp == 3 && lane >= 48) break;
            const int c0 = (grp < 3 ? grp * 512 : 1536) + lane * 8;
            const bf16_t* src = slotp(P, 13 + (c0 >> 9)) + (c0 & 511);
            float u[8], up[8], un[8], xm[8];
            unpack8(*(const uint4*)(src + (size_t)r * 512), u);
            if (rp >= 0) unpack8(*(const uint4*)(src + (size_t)rp * 512), up); else {
#pragma unroll
                for (int j = 0; j < 8; ++j) up[j] = 0.f; }
            if (rn >= 0) unpack8(*(const uint4*)(src + (size_t)rn * 512), un); else {
#pragma unroll
                for (int j = 0; j < 8; ++j) un[j] = 0.f; }
#pragma unroll
            for (int j = 0; j < 8; ++j) xm[j] = u[j] + mu[c0 + j] * (0.5f * (up[j] + un[j]) - u[j]);
            if (grp < 3) {
                *((uint4*)(slotp(P, 17 + grp) + (size_t)r * 512) + lane) = pack8(xm);
                if (grp == 1) {
                    float kk[8], ss = 0.f;
#pragma unroll
                    for (int j = 0; j < 8; ++j) { kk[j] = xm[j] * P.in[I_KK][layer * 512 + c0 - 512 + j]; ss += kk[j] * kk[j]; }
                    ss = red8(ss);
                    const float inv = 1.0f / fmaxf(sqrtf(ss), 1e-12f);
#pragma unroll
                    for (int j = 0; j < 8; ++j) kk[j] *= inv;
                    *((uint4*)(slotp(P, 20) + (size_t)r * 512) + lane) = pack8(kk); }
            } else {
                const int a0 = lane * 8;
                float o[8];
#pragma unroll
                for (int j = 0; j < 8; ++j) { const float x = xm[j];
                    if (a0 < 128) { const float e = __expf(2.f * x); o[j] = 1.f - 2.f / (e + 1.f); }
                    else if (a0 < 256) o[j] = x;
                    else o[j] = 1.f / (1.f + __expf(-x)); }
                *((uint4*)(slotp(P, 21) + (size_t)r * 384) + lane) = pack8(o);
            }
        }
    }
    for (int r = TG + gw; r < TGP; r += ngw) if (lane < 48) { const unsigned z = zero_u(); *((uint4*)(slotp(P, 21) + (size_t)r * 384) + lane) = make_uint4(z, z, z, z); }
}
DEV void phase_rw_post(const Params& P0, int layer, int g, int nrows, int bid, int nb, int wv) {
    Params P = load_params(); P.ws = launder_ws(P.ws);
    ROWPRO
    const int c0 = lane * 8;
    float ka[8], rk[8], lg[8], lb[8];
#pragma unroll
    for (int j = 0; j < 8; ++j) { ka[j] = P.in[I_KA][layer * 512 + c0 + j]; rk[j] = P.in[I_RK][layer * 512 + c0 + j]; lg[j] = P.in[I_LNG][layer * 512 + c0 + j]; lb[j] = P.in[I_LNB][layer * 512 + c0 + j]; }
    for (int r = gw; r < nrows; r += ngw) {
        float of[8], ob[8], o[8];
        unpack8(*((const uint4*)(slotp(P, 15) + (size_t)r * 512) + lane), of); unpack8(*((const uint4*)(slotp(P, 16) + (size_t)r * 512) + lane), ob);
        float s = 0.f;
#pragma unroll
        for (int j = 0; j < 8; ++j) { o[j] = of[j] + ob[j]; s += o[j]; }
        const float mean = red8(s) * (1.f / 64.f);
        float q = 0.f;
#pragma unroll
        for (int j = 0; j < 8; ++j) { o[j] -= mean; q += o[j] * o[j]; }
        const float rs = rsqrtf(red8(q) * (1.f / 64.f) + 64e-5f);
        float rr[8], kk[8], vv[8], af[8], ab[8], gg[8];
        unpack8(*((const uint4*)(slotp(P, 17) + (size_t)r * 512) + lane), rr); unpack8(*((const uint4*)(slotp(P, 18) + (size_t)r * 512) + lane), kk);
        unpack8(*((const uint4*)(slotp(P, 19) + (size_t)r * 512) + lane), vv); unpack8(*((const uint4*)(slotp(P, 24) + (size_t)r * 512) + lane), af);
        unpack8(*((const uint4*)(slotp(P, 13) + (size_t)r * 512) + lane), ab); unpack8(*((const uint4*)(slotp(P, 14) + (size_t)r * 512) + lane), gg);
        float bs = 0.f;
#pragma unroll
        for (int j = 0; j < 8; ++j) { const float kd = kk[j] * (2.f + (af[j] + ab[j] - 2.f) * ka[j]); bs += rr[j] * kd * rk[j]; }
        bs = red8(bs);
        float y[8];
#pragma unroll
        for (int j = 0; j < 8; ++j) y[j] = (o[j] * rs * lg[j] + lb[j] + bs * vv[j]) * gg[j];
        const uint4 yv = pack8(y);
        *((uint4*)(slotp(P, 5) + (size_t)r * 512) + lane) = yv;
        if (layer == 0 && g < 2 && r >= TREAL) {
            bf16_t* sd = GPTR(bf16_t, P.ws + WS_SIDE) + (size_t)g * 4 * 64 * 512 + (size_t)(r - TREAL) * 512;
#pragma unroll
            for (int k = 0; k < 3; ++k) *((uint4*)(sd + (size_t)k * 64 * 512) + lane) = *((const uint4*)(slotp(P, 2 + k) + (size_t)r * 512) + lane);
            *((uint4*)(sd + (size_t)3 * 64 * 512) + lane) = yv; }
    }
    if (layer == 0 && g == 2) {
        for (int m2 = gw; m2 < 128; m2 += ngw) { const bf16_t* sd = GPTR(const bf16_t, P.ws + WS_SIDE) + (size_t)(m2 >> 6) * 4 * 64 * 512 + (size_t)(m2 & 63) * 512;
#pragma unroll
            for (int k = 0; k < 4; ++k) *((uint4*)(slotp(P, 2 + k) + (size_t)(TG + m2) * 512) + lane) = *((const uint4*)(sd + (size_t)k * 64 * 512) + lane); }
    }
}
DEV void hg_gate(float x, float lbv, float& lg, float& kk) {
    const float e = __expf(-fabsf(x)); const float sp = 1.f / (1.f + e);
    const float s = x >= 0.f ? sp : e * sp, s1 = x >= 0.f ? e * sp : sp;
    const float f = fmaxf(lbv, 1e-20f) + (1.f - lbv) * s;
    lg = __logf(f); kk = (1.f - lbv) * s1; }
DEV float hg_lb(const Params& P, int layer, int dir, int col) {
    if (layer == 0) return 0.f;
    const float a = P.in[I_LBL][(dir * 2 + 0) * 512 + col], b = P.in[I_LBL][(dir * 2 + 1) * 512 + col];
    return 1.f / (1.f + __expf(a - b)); }
DEV int hg_row(int sl, int c, int j, bool& valid) { if (c == 0) { valid = j < 16; return TREAL + sl * 16 + j; } valid = true; return sl * 4096 + (c - 1) * 64 + j; }
DEV void hg_cumsum(float* Lb, float* Bt, float* Seg, int dir, int tid) {
    const int ch = tid & 127, seg = tid >> 7;
    float v[16];
#pragma unroll
    for (int i = 0; i < 16; ++i) v[i] = Lb[(seg * 16 + i) * 128 + ch];
    if (dir == 0) {
#pragma unroll
        for (int i = 1; i < 16; ++i) v[i] += v[i - 1];
        Seg[seg * 128 + ch] = v[15];
    } else {
#pragma unroll
        for (int i = 14; i >= 0; --i) v[i] += v[i + 1];
        Seg[seg * 128 + ch] = v[0];
    }
    __syncthreads();
    const float s0 = Seg[ch], s1 = Seg[128 + ch], s2 = Seg[256 + ch], s3 = Seg[384 + ch];
    float off;
    if (dir == 0) off = seg == 0 ? 0.f : seg == 1 ? s0 : seg == 2 ? s0 + s1 : s0 + s1 + s2;
    else off = seg == 3 ? 0.f : seg == 2 ? s3 : seg == 1 ? s3 + s2 : s3 + s2 + s1;
#pragma unroll
    for (int i = 0; i < 16; ++i) Lb[(seg * 16 + i) * 128 + ch] = v[i] + off;
    if (seg == 0) Bt[ch] = (s0 + s1) + (s2 + s3);
}
DEV void phase_hg1(const Params& P0, int layer, unsigned char* lds, int bid, int nb, int wv) {
    Params P = load_params(); P.ws = launder_ws(P.ws);
    float* Lb = (float*)lds; bf16_t* KlT = (bf16_t*)(lds + 32768); bf16_t* VT = (bf16_t*)(lds + 32768 + 18432); float* Bt = (float*)(lds + 69632); float* Seg = (float*)(lds + 70656);
    bf16_t* X = slotp(P, 17); float* DC = GPTR(float, P.ws + WS_DECAY);
    const int tid = launder_tid(wv), lane = tid & 63, w = __builtin_amdgcn_readfirstlane(tid >> 6), j = tid >> 3, c0 = (tid & 7) * 16, l15 = lane & 15, quad = lane >> 4;
    for (int unit = bid; unit < 32 * 65; unit += nb) {
        const int chain = unit / 65, c = unit - chain * 65, sl = chain >> 3, head = (chain >> 1) & 3, dir = chain & 1;
        bool valid; const int r = hg_row(sl, c, j, valid);
        float lg[16], kk[16]; uint4 vv[2] = {make_uint4(0, 0, 0, 0), make_uint4(0, 0, 0, 0)};
        if (valid) {
            float fr[16];
            const uint4* fp = (const uint4*)(slotp(P, 3 + dir) + (size_t)r * 512 + head * 128 + c0);
            unpack8(fp[0], fr); unpack8(fp[1], fr + 8);
            const uint4* vp = (const uint4*)(slotp(P, 5) + (size_t)r * 512 + head * 128 + c0); vv[0] = vp[0]; vv[1] = vp[1];
#pragma unroll
            for (int e = 0; e < 16; ++e) hg_gate(fr[e], hg_lb(P, layer, dir, head * 128 + c0 + e), lg[e], kk[e]);
        } else {
#pragma unroll
            for (int e = 0; e < 16; ++e) { lg[e] = 0.f; kk[e] = 0.f; } }
#pragma unroll
        for (int e = 0; e < 16; e += 4) *(f32x4*)(Lb + j * 128 + c0 + e) = (f32x4){lg[e], lg[e + 1], lg[e + 2], lg[e + 3]};
        __syncthreads();
        hg_cumsum(Lb, Bt, Seg, dir, tid);
        __syncthreads();
        float vf[16]; unpack8(vv[0], vf); unpack8(vv[1], vf + 8);
#pragma unroll
        for (int e = 0; e < 16; ++e) { const float kl = kk[e] * __expf(Bt[c0 + e] - Lb[j * 128 + c0 + e]);
            KlT[(c0 + e) * 72 + j] = (bf16_t)(pk2(kl, 0.f) & 0xffffu); VT[(c0 + e) * 72 + j] = (bf16_t)(__float_as_uint(vf[e]) >> 16); }
        if (tid < 128) DC[(size_t)(chain * 65 + c) * 128 + tid] = __expf(Bt[tid]);
        __syncthreads();
        f32x4 acc[8];
#pragma unroll
        for (int ct = 0; ct < 8; ++ct) acc[ct] = (f32x4){0.f, 0.f, 0.f, 0.f};
#pragma unroll
        for (int ks = 0; ks < 2; ++ks) { const bf16x8 a = *(const bf16x8*)(VT + (w * 16 + l15) * 72 + ks * 32 + quad * 8);
#pragma unroll
            for (int ct = 0; ct < 8; ++ct) { const bf16x8 b = *(const bf16x8*)(KlT + (ct * 16 + l15) * 72 + ks * 32 + quad * 8); acc[ct] = mfma16(b, a, acc[ct]); } }
        bf16_t* xo = X + (size_t)(chain * 65 + c) * 16384;
#pragma unroll
        for (int ct = 0; ct < 8; ++ct) *(uint2*)(xo + (w * 16 + l15) * 128 + ct * 16 + quad * 4) = make_uint2(pk2(acc[ct][0], acc[ct][1]), pk2(acc[ct][2], acc[ct][3]));
        __syncthreads();
    }
}
DEV void phase_hg2(const Params& P0, int bid, int nb, int wv) {
    Params P = load_params(); P.ws = launder_ws(P.ws);
    const int gtid = bid * 512 + launder_tid(wv), gth = nb * 512;
    uint2* X = (uint2*)slotp(P, 17); const f32x4* DC = GPTR(const f32x4, P.ws + WS_DECAY);
    for (int e = gtid; e < 32 * 4096; e += gth) {
        const int chain = e >> 12, e4 = e & 4095, dir = chain & 1;
        f32x4 S = (f32x4){0.f, 0.f, 0.f, 0.f};
#pragma unroll 5
        for (int step = 0; step < 65; ++step) { const int c = dir ? 64 - step : step;
            const size_t idx = (size_t)(chain * 65 + c) * 4096 + e4;
            const uint2 kvw = X[idx]; const f32x4 dc = DC[(size_t)(chain * 65 + c) * 32 + (e4 & 31)];
            const f32x4 kv = (f32x4){__uint_as_float(kvw.x << 16), __uint_as_float(kvw.x & 0xffff0000u), __uint_as_float(kvw.y << 16), __uint_as_float(kvw.y & 0xffff0000u)};
            X[idx] = make_uint2(pk2(S[0], S[1]), pk2(S[2], S[3])); S = dc * S + kv; }
    }
}
DEV void phase_hg3(const Params& P0, int layer, unsigned char* lds, int bid, int nb, int wv) {
    Params P = load_params(); P.ws = launder_ws(P.ws);
    float* Lb = (float*)lds; bf16_t* Qs = (bf16_t*)(lds + 32768); bf16_t* Ks = (bf16_t*)(lds + 50176); bf16_t* Am = (bf16_t*)(lds + 67584);
    bf16_t* VT = (bf16_t*)(lds + 76800); bf16_t* Sb = (bf16_t*)(lds + 95232); float* Bt = (float*)(lds + 130048); float* Seg = (float*)(lds + 132096); float* Ost = (float*)lds;
    const bf16_t* X = slotp(P, 17);
    const int tid = launder_tid(wv), lane = tid & 63, w = __builtin_amdgcn_readfirstlane(tid >> 6), j = tid >> 3, c0 = (tid & 7) * 16, l15 = lane & 15, quad = lane >> 4;
    const int tt = w >> 1, st0 = (w & 1) * 2, vt0 = (w & 1) * 4;
    const int cfirst = layer == 0 ? 0 : 1;
    const int ncb = 65 - cfirst;
    for (int unit = bid; unit < 16 * ncb; unit += nb) {
        const int sh = unit / ncb, c = unit - sh * ncb + cfirst, sl = sh >> 2, head = sh & 3;
        bool valid; const int r = hg_row(sl, c, j, valid);
        float q[16]; uint4 gv[2] = {make_uint4(0, 0, 0, 0), make_uint4(0, 0, 0, 0)};
        if (valid) {
            const uint4* qp = (const uint4*)(slotp(P, 2) + (size_t)r * 512 + head * 128 + c0); unpack8(qp[0], q); unpack8(qp[1], q + 8);
            const uint4* vp = (const uint4*)(slotp(P, 5) + (size_t)r * 512 + head * 128 + c0); float vf[16]; unpack8(vp[0], vf); unpack8(vp[1], vf + 8);
#pragma unroll
            for (int e = 0; e < 16; ++e) VT[(c0 + e) * 72 + j] = (bf16_t)(__float_as_uint(vf[e]) >> 16);
            const uint4* gp = (const uint4*)(slotp(P, 6) + (size_t)r * 512 + head * 128 + c0); gv[0] = gp[0]; gv[1] = gp[1];
        } else {
#pragma unroll
            for (int e = 0; e < 16; ++e) { q[e] = 0.f; VT[(c0 + e) * 72 + j] = 0; } }
        f32x4 accA[2], accO[4];
#pragma unroll
        for (int i = 0; i < 2; ++i) accA[i] = (f32x4){0.f, 0.f, 0.f, 0.f};
#pragma unroll
        for (int i = 0; i < 4; ++i) accO[i] = (f32x4){0.f, 0.f, 0.f, 0.f};
#pragma unroll 1
        for (int dir = 0; dir < 2; ++dir) {
            float lg[16], kk[16];
            if (valid) { float fr[16];
                const uint4* fp = (const uint4*)(slotp(P, 3 + dir) + (size_t)r * 512 + head * 128 + c0); unpack8(fp[0], fr); unpack8(fp[1], fr + 8);
#pragma unroll
                for (int e = 0; e < 16; ++e) hg_gate(fr[e], hg_lb(P, layer, dir, head * 128 + c0 + e), lg[e], kk[e]);
            } else {
#pragma unroll
                for (int e = 0; e < 16; ++e) { lg[e] = 0.f; kk[e] = 0.f; } }
#pragma unroll
            for (int e = 0; e < 16; e += 4) *(f32x4*)(Lb + j * 128 + c0 + e) = (f32x4){lg[e], lg[e + 1], lg[e + 2], lg[e + 3]};
            __syncthreads();
            hg_cumsum(Lb, Bt, Seg, dir, tid);
            __syncthreads();
            {
                float qs[16], ks[16];
#pragma unroll
                for (int e = 0; e < 16; ++e) { const float b = Lb[j * 128 + c0 + e], rf = Lb[32 * 128 + c0 + e]; qs[e] = q[e] * __expf(b - rf); ks[e] = kk[e] * __expf(rf - b); }
                *(uint4*)(Qs + j * 136 + c0) = pack8(qs); *(uint4*)(Qs + j * 136 + c0 + 8) = pack8(qs + 8);
                *(uint4*)(Ks + j * 136 + c0) = pack8(ks); *(uint4*)(Ks + j * 136 + c0 + 8) = pack8(ks + 8);
            }
            {
                const int chain = sl * 8 + head * 2 + dir; const uint4* xs = (const uint4*)(X + (size_t)(chain * 65 + c) * 16384 + (size_t)(tid >> 2) * 128 + (tid & 3) * 32);
#pragma unroll
                for (int i = 0; i < 4; ++i) *(uint4*)(Sb + (tid >> 2) * 136 + (tid & 3) * 32 + i * 8) = xs[i];
            }
            __syncthreads();
            {
                f32x4 t0 = (f32x4){0.f, 0.f, 0.f, 0.f}, t1 = t0;
#pragma unroll
                for (int k4 = 0; k4 < 4; ++k4) { const bf16x8 a = *(const bf16x8*)(Qs + (tt * 16 + l15) * 136 + k4 * 32 + quad * 8);
                    const bf16x8 b0 = *(const bf16x8*)(Ks + ((st0 + 0) * 16 + l15) * 136 + k4 * 32 + quad * 8); const bf16x8 b1 = *(const bf16x8*)(Ks + ((st0 + 1) * 16 + l15) * 136 + k4 * 32 + quad * 8);
                    t0 = mfma16(a, b0, t0); t1 = mfma16(a, b1, t1); }
#pragma unroll
                for (int jj = 0; jj < 4; ++jj) { const int t = tt * 16 + quad * 4 + jj, s0 = (st0 + 0) * 16 + l15, s1 = (st0 + 1) * 16 + l15;
                    const bool k0 = dir == 0 ? s0 <= t : s0 >= t, k1 = dir == 0 ? s1 <= t : s1 >= t;
                    accA[0][jj] += k0 ? t0[jj] : 0.f; accA[1][jj] += k1 ? t1[jj] : 0.f; }
            }
            __syncthreads();
            {   float qg[16];
#pragma unroll
                for (int e = 0; e < 16; ++e) qg[e] = q[e] * __expf(Lb[j * 128 + c0 + e]);
                *(uint4*)(Qs + j * 136 + c0) = pack8(qg); *(uint4*)(Qs + j * 136 + c0 + 8) = pack8(qg + 8); }
            __syncthreads();
#pragma unroll
            for (int k4 = 0; k4 < 4; ++k4) { const bf16x8 a = *(const bf16x8*)(Qs + (tt * 16 + l15) * 136 + k4 * 32 + quad * 8);
#pragma unroll
                for (int v4 = 0; v4 < 4; ++v4) { const bf16x8 b = *(const bf16x8*)(Sb + ((vt0 + v4) * 16 + l15) * 136 + k4 * 32 + quad * 8); accO[v4] = mfma16(a, b, accO[v4]); } }
            __syncthreads();
        }
#pragma unroll
        for (int s2 = 0; s2 < 2; ++s2)
#pragma unroll
            for (int jj = 0; jj < 4; ++jj) Am[(tt * 16 + quad * 4 + jj) * 72 + (st0 + s2) * 16 + l15] = (bf16_t)(pk2(accA[s2][jj], 0.f) & 0xffffu);
        __syncthreads();
#pragma unroll
        for (int ks = 0; ks < 2; ++ks) { const bf16x8 a = *(const bf16x8*)(Am + (tt * 16 + l15) * 72 + ks * 32 + quad * 8);
#pragma unroll
            for (int v4 = 0; v4 < 4; ++v4) { const bf16x8 b = *(const bf16x8*)(VT + ((vt0 + v4) * 16 + l15) * 72 + ks * 32 + quad * 8); accO[v4] = mfma16(a, b, accO[v4]); } }
#pragma unroll
        for (int v4 = 0; v4 < 4; ++v4)
#pragma unroll
            for (int jj = 0; jj < 4; ++jj) Ost[(tt * 16 + quad * 4 + jj) * 132 + (vt0 + v4) * 16 + l15] = accO[v4][jj];
        __syncthreads();
        {   float o[16], ss = 0.f;
#pragma unroll
            for (int e = 0; e < 16; ++e) { o[e] = Ost[j * 132 + c0 + e]; ss += o[e] * o[e]; }
            ss = red8(ss);
            const float rs = rsqrtf(ss * (1.f / 128.f) + 1e-6f);
            float gf[16]; unpack8(gv[0], gf); unpack8(gv[1], gf + 8);
#pragma unroll
            for (int e = 0; e < 16; ++e) { const float gg = gf[e]; o[e] = o[e] * rs * P.in[I_ONORM][layer * 512 + head * 128 + c0 + e] * (gg / (1.f + __expf(-gg))); }
            if (valid) { uint4* yp = (uint4*)(slotp(P, 2) + (size_t)r * 512 + head * 128 + c0); yp[0] = pack8(o); yp[1] = pack8(o + 8); }
        }
        __syncthreads();
    }
}
DEV void phase_vtrans(const Params& P0, unsigned char* lds, int bid, int nb, int wv) {
    Params P = load_params(); P.ws = launder_ws(P.ws);
    bf16_t* T = (bf16_t*)lds;
    const bf16_t* V = slotp(P, 12); bf16_t* VTg = slotp(P, 6);
    const int tid = launder_tid(wv);
    for (int unit = bid; unit < 4 * 65 * 8; unit += nb) {
        const int sl = unit / 520, rem = unit - sl * 520, pt = rem >> 3, vdt = rem & 7;
        { const int tok = tid >> 3, c8 = (tid & 7) * 8, p = pt * 64 + tok;
          uint4 v = make_uint4(0, 0, 0, 0);
          if (p < LSEQ) v = *(const uint4*)(V + (size_t)row_of(sl, p) * 512 + vdt * 64 + c8);
          *(uint4*)(T + tok * 72 + c8) = v; }
        __syncthreads();
        { const int vd = tid >> 3, t8 = (tid & 7) * 8;
          unsigned short e[8];
#pragma unroll
          for (int i = 0; i < 8; ++i) { const int pp = t8 + i; const int sp = (pp & ~12) | (((pp >> 2) & 1) << 3) | (((pp >> 3) & 1) << 2); e[i] = T[sp * 72 + vd]; }
          uint4 o; o.x = e[0] | ((unsigned)e[1] << 16); o.y = e[2] | ((unsigned)e[3] << 16); o.z = e[4] | ((unsigned)e[5] << 16); o.w = e[6] | ((unsigned)e[7] << 16);
          *(uint4*)(VTg + (size_t)(sl * 512 + vdt * 64 + vd) * 4160 + pt * 64 + t8) = o; }
        __syncthreads();
    }
}
DEV int crow(int r, int hi) { return (r & 3) + 8 * (r >> 2) + 4 * hi; }
typedef unsigned u32x4_t __attribute__((ext_vector_type(4)));
struct AttnStage { u32x4_t k0, k1, v0, v1; };
DEV void attn_stage_load(const Params& P, int sl, int head, int kt, int tid, AttnStage& st) {
    const bf16_t* Kg = slotp(P, 11); const bf16_t* VTg = slotp(P, 6);
    { const int ci = tid, krow = ci >> 4, kc = ci & 15; const int p = kt * 64 + krow; const int r = p < LSEQ ? row_of(sl, p) : 0; st.k0 = GLD16(Kg + (size_t)r * 512 + head * 128 + kc * 8); }
    { const int ci = tid + 512, krow = ci >> 4, kc = ci & 15; const int p = kt * 64 + krow; const int r = p < LSEQ ? row_of(sl, p) : 0; st.k1 = GLD16(Kg + (size_t)r * 512 + head * 128 + kc * 8); }
    { const int vi = tid, vrow = vi >> 3, vc = vi & 7; st.v0 = GLD16(VTg + (size_t)(sl * 512 + head * 128 + vrow) * 4160 + kt * 64 + vc * 8); }
    { const int vi = tid + 512, vrow = vi >> 3, vc = vi & 7; st.v1 = GLD16(VTg + (size_t)(sl * 512 + head * 128 + vrow) * 4160 + kt * 64 + vc * 8); }
}
DEV void attn_stage_store(unsigned char* buf, int tid, const AttnStage& st) {
    bf16_t* Kt = (bf16_t*)buf; bf16_t* Vt = (bf16_t*)(buf + 17408);
    { const int ci = tid, krow = ci >> 4, kc = ci & 15; *(u32x4_t*)(Kt + krow * 136 + kc * 8) = st.k0; }
    { const int ci = tid + 512, krow = ci >> 4, kc = ci & 15; *(u32x4_t*)(Kt + krow * 136 + kc * 8) = st.k1; }
    { const int vi = tid, vrow = vi >> 3, vc = vi & 7; *(u32x4_t*)(Vt + vrow * 72 + vc * 8) = st.v0; }
    { const int vi = tid + 512, vrow = vi >> 3, vc = vi & 7; *(u32x4_t*)(Vt + vrow * 72 + vc * 8) = st.v1; }
}
DEV void phase_attn(const Params& P0, int layer, unsigned char* lds, int ua, int ub, int uc, int wv) {
    Params P = load_params(); P.ws = launder_ws(P.ws);
    const int tid = launder_tid(wv), lane = tid & 63, w = __builtin_amdgcn_readfirstlane(tid >> 6), map = w >> 2, qsub = w & 3, qi = lane & 31, hi = lane >> 5;
    const float lam_init = layer == 0 ? 0.2f : 0.35550906759096934f;
    float lam;
    { const float* lp = P.in[I_LAM] + (size_t)layer * 256; float s1 = 0.f, s2 = 0.f;
      for (int i = 0; i < 64; ++i) { s1 += lp[i] * lp[64 + i]; s2 += lp[128 + i] * lp[192 + i]; }
      lam = __expf(s1) - __expf(s2) + lam_init; }
    float* Ex = (float*)lds;
#pragma unroll 1
    for (int ui = 0; ui < 3; ++ui) {
        int unit = ui == 0 ? ua : (ui == 1 ? ub : uc);
        if (unit < 0) continue;
        const int ucode = unit; unit = ucode & 4095; const int hmode = ucode >> 12;
        const int sh = unit < 512 ? (unit >> 5) : unit - 512, qb = unit < 512 ? (unit & 31) : 32, sl = sh >> 2, head = sh & 3;
        const int qrow0 = qb < 32 ? sl * 4096 + qb * 128 : TREAL + sl * 16; const int nvalid = qb < 32 ? 128 : 16;
        const bool active = (qsub * 32 < nvalid) && (hmode == 0 || hmode >= 3 || (qsub >> 1) == hmode - 1);
        bf16x8 Qf[4];
        { const bf16_t* qp = slotp(P, 10) + (size_t)(qrow0 + qsub * 32 + qi) * 512 + head * 128 + map * 64 + hi * 8;
#pragma unroll
          for (int ds = 0; ds < 4; ++ds) Qf[ds] = __builtin_bit_cast(bf16x8, GLD16(qp + ds * 16)); }
        AttnStage st;
        const int kt0 = hmode == 4 ? 33 : 0, kt1 = hmode == 3 ? 33 : 65;
        attn_stage_load(P, sl, head, kt0, tid, st); attn_stage_store(lds + (kt0 & 1) * 35840, tid, st); attn_stage_load(P, sl, head, kt0 + 1, tid, st);
        __syncthreads();
        f32x16 O[4];
#pragma unroll
        for (int v = 0; v < 4; ++v)
#pragma unroll
            for (int r = 0; r < 16; ++r) O[v][r] = 0.f;
        float m_run = 0.f, l_run = 0.f;
        f32x16 negm;
#pragma unroll
        for (int r = 0; r < 16; ++r) negm[r] = 0.f;
#pragma unroll 1
        for (int kt = kt0; kt < kt1; ++kt) {
            if (kt + 1 < kt1) attn_stage_store(lds + ((kt + 1) & 1) * 35840, tid, st);
            if (kt + 2 < kt1) attn_stage_load(P, sl, head, kt + 2, tid, st);
            const unsigned char* buf = lds + (kt & 1) * 35840;
            const bf16_t* Kb = (const bf16_t*)buf; const bf16_t* Vb = (const bf16_t*)(buf + 17408);
            if (active) {
            f32x16 S0, S1;
            {
                bf16x8 ka[4], kb[4];
#pragma unroll
                for (int ds = 0; ds < 4; ++ds) { ka[ds] = *(const bf16x8*)(Kb + qi * 136 + map * 64 + ds * 16 + hi * 8); kb[ds] = *(const bf16x8*)(Kb + (32 + qi) * 136 + map * 64 + ds * 16 + hi * 8); }
                __builtin_amdgcn_sched_barrier(0);
                S0 = mfma32(ka[0], Qf[0], negm); S1 = mfma32(kb[0], Qf[0], negm);
#pragma unroll
                for (int ds = 1; ds < 4; ++ds) { S0 = mfma32(ka[ds], Qf[ds], S0); S1 = mfma32(kb[ds], Qf[ds], S1); } }
            if (__builtin_expect(__builtin_amdgcn_readfirstlane(kt) == 64, 0)) {
#pragma unroll
                for (int r = 0; r < 16; ++r) { if (crow(r, hi) >= 16) S0[r] = -INFINITY; S1[r] = -INFINITY; }
                asm volatile("" : "+v"(S0), "+v"(S1)); }
            float mx = -INFINITY;
#pragma unroll
            for (int r = 0; r < 16; ++r) mx = fmaxf(mx, fmaxf(S0[r], S1[r]));
            { const auto sw = __builtin_amdgcn_permlane32_swap(__float_as_uint(mx), __float_as_uint(mx), false, false); mx = fmaxf(__uint_as_float(sw[0]), __uint_as_float(sw[1])); }
            if (__builtin_amdgcn_ballot_w64(mx > 8.0f || kt == kt0) != 0ull) {
                const float d = (mx > 8.0f || kt == kt0) ? mx : 0.f; const float alpha = __builtin_amdgcn_exp2f(-d); m_run += d;
                l_run *= alpha;
#pragma unroll
                for (int v = 0; v < 4; ++v)
#pragma unroll
                    for (int r = 0; r < 16; ++r) O[v][r] *= alpha;
#pragma unroll
                for (int r = 0; r < 16; ++r) { S0[r] -= d; S1[r] -= d; negm[r] = -m_run; } }
            float ps = 0.f;
#pragma unroll
            for (int r = 0; r < 16; ++r) { S0[r] = __builtin_amdgcn_exp2f(S0[r]); S1[r] = __builtin_amdgcn_exp2f(S1[r]); ps += S0[r] + S1[r]; }
            l_run += ps;
            bf16x8 pf[2][2];
#pragma unroll
            for (int half = 0; half < 2; ++half) {
                uint4 a, b;
                a.x = pk2(S0[half * 8 + 0], S0[half * 8 + 1]); a.y = pk2(S0[half * 8 + 2], S0[half * 8 + 3]); a.z = pk2(S0[half * 8 + 4], S0[half * 8 + 5]); a.w = pk2(S0[half * 8 + 6], S0[half * 8 + 7]);
                b.x = pk2(S1[half * 8 + 0], S1[half * 8 + 1]); b.y = pk2(S1[half * 8 + 2], S1[half * 8 + 3]); b.z = pk2(S1[half * 8 + 4], S1[half * 8 + 5]); b.w = pk2(S1[half * 8 + 6], S1[half * 8 + 7]);
                pf[0][half] = __builtin_bit_cast(bf16x8, a); pf[1][half] = __builtin_bit_cast(bf16x8, b); }
            {   bf16x8 av[4], nx[4];
#pragma unroll
                for (int f = 0; f < 4; ++f) av[f] = *(const bf16x8*)(Vb + qi * 72 + (f >> 1) * 32 + (f & 1) * 16 + hi * 8);
                __builtin_amdgcn_sched_barrier(0);
#pragma unroll
                for (int v = 0; v < 4; ++v) {
                    if (v < 3) {
#pragma unroll
                        for (int f = 0; f < 4; ++f) nx[f] = *(const bf16x8*)(Vb + ((v + 1) * 32 + qi) * 72 + (f >> 1) * 32 + (f & 1) * 16 + hi * 8); }
                    __builtin_amdgcn_sched_barrier(0);
#pragma unroll
                    for (int f = 0; f < 4; ++f) O[v] = mfma32(av[f], pf[f >> 1][f & 1], O[v]);
                    if (v < 3) {
#pragma unroll
                        for (int f = 0; f < 4; ++f) av[f] = nx[f]; }
                }
            }
            }
            __syncthreads();
        }
        const float l_tot = l_run + __shfl_xor(l_run, 32); const float inv = 1.0f / l_tot;
        if (hmode >= 3) {
            float* pt = (float*)slotp(P, 22) + ((size_t)(((unit - 448) * 2 + (hmode - 3)) * 2 + map) * 128 + qsub * 32 + qi) * 130;
#pragma unroll
            for (int v = 0; v < 4; ++v)
#pragma unroll
                for (int rg = 0; rg < 4; ++rg) { float* d = pt + v * 32 + 8 * rg + 4 * hi; d[0] = O[v][rg * 4 + 0]; d[1] = O[v][rg * 4 + 1]; d[2] = O[v][rg * 4 + 2]; d[3] = O[v][rg * 4 + 3]; }
            if (hi == 0) { pt[128] = m_run; pt[129] = l_tot; }
            __syncthreads();
            continue; }
        if (map == 1) {
#pragma unroll
            for (int v = 0; v < 4; ++v)
#pragma unroll
                for (int r = 0; r < 16; ++r) Ex[(qsub * 32 + qi) * 132 + v * 32 + crow(r, hi)] = O[v][r] * inv; }
        __syncthreads();
        if (map == 0) {
            float ss = 0.f;
#pragma unroll
            for (int v = 0; v < 4; ++v)
#pragma unroll
                for (int r = 0; r < 16; ++r) { const float o = O[v][r] * inv - lam * Ex[(qsub * 32 + qi) * 132 + v * 32 + crow(r, hi)]; O[v][r] = o; ss += o * o; }
            ss += __shfl_xor(ss, 32);
            const float rs = rsqrtf(ss * (1.f / 128.f) + 1e-5f) * (1.f - lam_init);
            if (active && qsub * 32 + qi < nvalid) {
                bf16_t* yp = slotp(P, 4) + (size_t)(qrow0 + qsub * 32 + qi) * 512 + head * 128;
#pragma unroll
                for (int v = 0; v < 4; ++v)
#pragma unroll
                    for (int rg = 0; rg < 4; ++rg) { const int vd0 = v * 32 + 8 * rg + 4 * hi; const f32x4 gg = *(const f32x4*)(P.in[I_SUBLN] + layer * 128 + vd0);
                        uint2 o; o.x = pk2(O[v][rg * 4 + 0] * rs * gg[0], O[v][rg * 4 + 1] * rs * gg[1]); o.y = pk2(O[v][rg * 4 + 2] * rs * gg[2], O[v][rg * 4 + 3] * rs * gg[3]);
                        *(uint2*)(yp + vd0) = o; } }
        }
        __syncthreads();
    }
}
DEV float dpp_f(float x, const int ctrl) { return x; }
template <int CTRL> DEV float dppmov(float x) { return __builtin_bit_cast(float, __builtin_amdgcn_update_dpp(0, __builtin_bit_cast(int, x), CTRL, 0xf, 0xf, true)); }
DEV float sum16(float x) { x += dppmov<0xB1>(x); x += dppmov<0x4E>(x); x += dppmov<0x141>(x); x += dppmov<0x140>(x); return x; }
constexpr int RW_CH = 16, RW_BUF_F = 5120 + 256 + 4096, RW_BUFB = RW_BUF_F * 4;
struct RwRegs { u32x4_t r, k, kk, e, a, v; };
DEV void unpack8v(const u32x4_t w, float* f) { unpack8(make_uint4(w.x, w.y, w.z, w.w), f); }
DEV void rw_stage_load(const Params& P, RwRegs& g, int sl, int head, int dir, int qr, int ck, int t) {
    if (t < 128) { const int step = t >> 3, ch8 = (t & 7) * 8, sidx = ck * RW_CH + step;
        if (sidx < LSEQ) { const int p = dir ? LSEQ - 1 - sidx : sidx; const size_t ro = (size_t)row_of(sl, p) * 512 + head * 64 + ch8;
            g.r = *(const u32x4_t*)(slotp(P, 17) + ro); g.k = *(const u32x4_t*)(slotp(P, 18) + ro); g.kk = *(const u32x4_t*)(slotp(P, 20) + ro);
            g.e = *(const u32x4_t*)(slotp(P, 22 + dir) + ro); g.a = *(const u32x4_t*)(slotp(P, dir == 0 ? 24 : 13) + ro); } }
    if (t < 32) { const int tt = t, s2 = tt >> 1, r8 = (tt & 1) * 8, si2 = ck * RW_CH + s2;
        if (si2 < LSEQ) { const int p2 = dir ? LSEQ - 1 - si2 : si2; g.v = *(const u32x4_t*)(slotp(P, 19) + (size_t)row_of(sl, p2) * 512 + head * 64 + qr * 16 + r8); } }
}
DEV void rw_stage_write(const Params& P, int layer, unsigned char* buf, const RwRegs& g, int head, int ck, int t) {
    float* Rr = (float*)buf; float* Ww = Rr + 1024; float* Kd = Ww + 1024; float* Kk = Kd + 1024; float* Bb = Kk + 1024; float* Vs = Bb + 1024;
    if (t < 128) { const int step = t >> 3, ch8 = (t & 7) * 8, sidx = ck * RW_CH + step;
        if (sidx < LSEQ) {
            float r[8], k[8], kk[8], e[8], a[8];
            unpack8v(g.r, r); unpack8v(g.k, k); unpack8v(g.kk, kk); unpack8v(g.e, e); unpack8v(g.a, a);
            float ww[8], kd[8], bb[8];
#pragma unroll
            for (int j = 0; j < 8; ++j) { ww[j] = __expf(-e[j]); kd[j] = k[j] * (1.f + (a[j] - 1.f) * P.in[I_KA][layer * 512 + head * 64 + ch8 + j]); bb[j] = kk[j] * a[j]; }
            const int o = step * 64 + ch8;
            *(f32x4*)(Rr + o) = (f32x4){r[0], r[1], r[2], r[3]}; *(f32x4*)(Rr + o + 4) = (f32x4){r[4], r[5], r[6], r[7]};
            *(f32x4*)(Ww + o) = (f32x4){ww[0], ww[1], ww[2], ww[3]}; *(f32x4*)(Ww + o + 4) = (f32x4){ww[4], ww[5], ww[6], ww[7]};
            *(f32x4*)(Kd + o) = (f32x4){kd[0], kd[1], kd[2], kd[3]}; *(f32x4*)(Kd + o + 4) = (f32x4){kd[4], kd[5], kd[6], kd[7]};
            *(f32x4*)(Kk + o) = (f32x4){kk[0], kk[1], kk[2], kk[3]}; *(f32x4*)(Kk + o + 4) = (f32x4){kk[4], kk[5], kk[6], kk[7]};
            *(f32x4*)(Bb + o) = (f32x4){bb[0], bb[1], bb[2], bb[3]}; *(f32x4*)(Bb + o + 4) = (f32x4){bb[4], bb[5], bb[6], bb[7]};
        } }
    if (t < 32) { const int tt = t, s2 = tt >> 1, r8 = (tt & 1) * 8, si2 = ck * RW_CH + s2;
        if (si2 < LSEQ) { float v[8]; unpack8v(g.v, v);
            *(f32x4*)(Vs + s2 * 16 + r8) = (f32x4){v[0], v[1], v[2], v[3]}; *(f32x4*)(Vs + s2 * 16 + r8 + 4) = (f32x4){v[4], v[5], v[6], v[7]}; } }
}
DEV void rw_flush(const Params& P, const unsigned char* buf, int sl, int head, int dir, int qr, int ck, int t) {
    if (t >= 160 && t < 192) { const float* Op = (const float*)buf + 5376; const int tt = t - 160, s2 = tt >> 1, r8 = (tt & 1) * 8, sidx = ck * RW_CH + s2;
        if (sidx < LSEQ) { const int p = dir ? LSEQ - 1 - sidx : sidx; float o[8];
#pragma unroll
            for (int j = 0; j < 8; ++j) { const int row = r8 + j; const f32x4* q = (const f32x4*)(Op + s2 * 256 + (row >> 2) * 64 + (row & 3) * 16);
                const f32x4 a = q[0], b = q[1], c = q[2], d = q[3];
                o[j] = ((a[0] + a[1]) + (a[2] + a[3])) + ((b[0] + b[1]) + (b[2] + b[3])) + (((c[0] + c[1]) + (c[2] + c[3])) + ((d[0] + d[1]) + (d[2] + d[3]))); }
            *(uint4*)(slotp(P, 15 + dir) + (size_t)row_of(sl, p) * 512 + head * 64 + qr * 16 + r8) = pack8(o); } }
}
DEV void phase_rw_scan(const Params& P0, int layer, unsigned char* lds, int bid, int nb, int wv) {
    Params P = load_params(); P.ws = launder_ws(P.ws);
    const int tid = launder_tid(wv), lane = tid & 63, w = __builtin_amdgcn_readfirstlane(tid >> 6), li = lane & 15, rl = (w & 3) * 4 + (lane >> 4);
    constexpr int NCK = (LSEQ + RW_CH - 1) / RW_CH;
    typedef float f32x2 __attribute__((ext_vector_type(2)));
    for (int unit = bid; unit < 256; unit += nb) {
        const int sl = unit >> 6, head = (unit >> 3) & 7, dir = (unit >> 2) & 1, qr = unit & 3;
        f32x2 SA = (f32x2){0.f, 0.f}, SB = (f32x2){0.f, 0.f};
        RwRegs g; g.r = g.k = g.kk = g.e = g.a = g.v = (u32x4_t){0u, 0u, 0u, 0u};
        if (w >= 4) { rw_stage_load(P, g, sl, head, dir, qr, 0, tid - 256); rw_stage_write(P, layer, lds, g, head, 0, tid - 256); rw_stage_load(P, g, sl, head, dir, qr, 1, tid - 256); }
        __syncthreads();
#pragma unroll 1
        for (int ck = 0; ck < NCK; ++ck) {
            unsigned char* buf = lds + (ck & 1) * RW_BUFB;
            if (w >= 4) {
                if (ck + 1 < NCK) rw_stage_write(P, layer, lds + ((ck + 1) & 1) * RW_BUFB, g, head, ck + 1, tid - 256);
                if (ck + 2 < NCK) rw_stage_load(P, g, sl, head, dir, qr, ck + 2, tid - 256);
                if (ck > 0) rw_flush(P, lds + ((ck - 1) & 1) * RW_BUFB, sl, head, dir, qr, ck - 1, tid - 256);
            } else {
                const float* Rr = (const float*)buf + li * 4; const float* Vs = (const float*)buf + 5120 + rl; float* Op = (float*)buf + 5376 + w * 64 + lane;
                const int ns = (LSEQ - ck * RW_CH) < RW_CH ? (LSEQ - ck * RW_CH) : RW_CH;
                f32x4 rr = *(const f32x4*)(Rr), ww = *(const f32x4*)(Rr + 1024), kd = *(const f32x4*)(Rr + 2048), kk = *(const f32x4*)(Rr + 3072), bb = *(const f32x4*)(Rr + 4096); float vv = Vs[0];
#pragma unroll 2
                for (int i = 0; i < ns; ++i) {
                    const int in = i < RW_CH - 1 ? i + 1 : RW_CH - 1;
                    const f32x4 rr_n = *(const f32x4*)(Rr + in * 64), ww_n = *(const f32x4*)(Rr + 1024 + in * 64), kd_n = *(const f32x4*)(Rr + 2048 + in * 64);
                    const f32x4 kk_n = *(const f32x4*)(Rr + 3072 + in * 64), bb_n = *(const f32x4*)(Rr + 4096 + in * 64); const float vv_n = Vs[in * 16];
                    f32x2 p = SA * (f32x2){kk[0], kk[1]}; p = __builtin_elementwise_fma(SB, (f32x2){kk[2], kk[3]}, p);
                    const f32x2 vv2 = (f32x2){vv, vv};
                    const f32x2 ta = vv2 * (f32x2){kd[0], kd[1]}, tb = vv2 * (f32x2){kd[2], kd[3]};
                    const float sa = -sum16(p[0] + p[1]);
                    const f32x2 sa2 = (f32x2){sa, sa};
                    SA = __builtin_elementwise_fma(SA, (f32x2){ww[0], ww[1]}, __builtin_elementwise_fma(sa2, (f32x2){bb[0], bb[1]}, ta));
                    SB = __builtin_elementwise_fma(SB, (f32x2){ww[2], ww[3]}, __builtin_elementwise_fma(sa2, (f32x2){bb[2], bb[3]}, tb));
                    f32x2 q = SA * (f32x2){rr[0], rr[1]}; q = __builtin_elementwise_fma(SB, (f32x2){rr[2], rr[3]}, q);
                    Op[i * 256] = q[0] + q[1];
                    rr = rr_n; ww = ww_n; kd = kd_n; kk = kk_n; bb = bb_n; vv = vv_n;
                }
            }
            __syncthreads();
        }
        if (w >= 4) rw_flush(P, lds + ((NCK - 1) & 1) * RW_BUFB, sl, head, dir, qr, NCK - 1, tid - 256);
        __syncthreads();
    }
}
static_assert(LSEQ == 257 * 16, "chunked RWKV assumes whole 16-step chunks");
constexpr int RWC_REC = 8960, RWC_NCK = 257;
DEV unsigned char* rwc_rec(const Params& P, int dir, int idx) {
    const int gi = dir * 8224 + idx;
    if (gi < 1901) return (unsigned char*)slotp(P, 5) + (size_t)gi * RWC_REC;
    if (gi < 7606) return (unsigned char*)slotp(P, 7) + (size_t)(gi - 1901) * RWC_REC;
    if (gi < 9507) return (unsigned char*)slotp(P, 12) + (size_t)(gi - 7606) * RWC_REC;
    if (gi < 11408) return (unsigned char*)slotp(P, 21) + (size_t)(gi - 9507) * RWC_REC;
    return GPTR(unsigned char, P.ws + WS_SLOTS + 25 * SLOT_B + (size_t)(gi - 11408) * RWC_REC); }
DEV int rwc_slot(int c) { return (((c >> 5) * 4 + ((c >> 2) & 3)) * 8) + ((c >> 4) & 1) * 4 + (c & 3); }
DEV void phase_rwc_pre(const Params& P0, int layer, unsigned char* lds, int bid, int nb, int wv) {
    Params P = load_params(); P.ws = launder_ws(P.ws);
    const int tid = launder_tid(wv), lane = tid & 63, w = __builtin_amdgcn_readfirstlane(tid >> 6), l15 = lane & 15, quad = lane >> 4;
    unsigned char* wl = lds + w * 15616;
    bf16_t* Bt = (bf16_t*)wl; bf16_t* Dt = Bt + 16 * 72; bf16_t* Ak = Dt + 16 * 72; bf16_t* Rt = Ak + 16 * 72;
    float* Mb = (float*)(wl + 9216); float* Md = Mb + 256; float* Gb = Md + 256; float* Gd = Gb + 256; float* Tm = Gd + 256; float* Nm = Tm + 256;
    const float ka = P.in[I_KA][layer * 512 + 0];  (void)ka;
    for (int unit2 = bid * 8 + w; unit2 < 2 * 32 * RWC_NCK; unit2 += nb * 8) {
        const int dir = unit2 >= 32 * RWC_NCK ? 1 : 0; const int unit = unit2 - dir * 32 * RWC_NCK;
        const int sh = unit / RWC_NCK, ck = unit - sh * RWC_NCK, sl = sh >> 3, head = sh & 7;
        const float kac = P.in[I_KA][layer * 512 + head * 64 + lane];
        float ak[16], bt[16], dt[16], rt[16];
        typedef const __attribute__((address_space(1))) unsigned short* gu16p;
        const gu16p pR = (gu16p)slotp(P, 17), pK = (gu16p)slotp(P, 18), pKK = (gu16p)slotp(P, 20), pE = (gu16p)slotp(P, 22 + dir), pA = (gu16p)slotp(P, dir == 0 ? 24 : 13);
        unsigned short r16[16], k16[16], q16[16], e16[16], a16[16];
#pragma unroll
        for (int t = 0; t < 16; ++t) {
            const int sidx = ck * 16 + t;
            const int p = dir ? LSEQ - 1 - sidx : sidx; const size_t ro = (size_t)row_of(sl, p) * 512 + head * 64 + lane;
            r16[t] = pR[ro]; k16[t] = pK[ro]; q16[t] = pKK[ro]; e16[t] = pE[ro]; a16[t] = pA[ro]; }
        float g = 1.f;
#pragma unroll
        for (int t = 0; t < 16; ++t) {
            const float r = bf2f(r16[t]), k = bf2f(k16[t]), kk = bf2f(q16[t]), e = bf2f(e16[t]), a = bf2f(a16[t]);
            const float wdec = __expf(-e), kd = k * (1.f + (a - 1.f) * kac), b = kk * a;
            ak[t] = g * kk; g *= wdec; const float gi = __builtin_amdgcn_rcpf(g); bt[t] = b * gi; dt[t] = kd * gi; rt[t] = g * r;
        }
        const float gC = g;
#pragma unroll
        for (int t = 0; t < 16; ++t) { Bt[t * 72 + lane] = (bf16_t)(pk2(bt[t], 0.f) & 0xffffu); Dt[t * 72 + lane] = (bf16_t)(pk2(dt[t], 0.f) & 0xffffu);
            Ak[t * 72 + lane] = (bf16_t)(pk2(ak[t], 0.f) & 0xffffu); Rt[t * 72 + lane] = (bf16_t)(pk2(rt[t], 0.f) & 0xffffu); }
        asm volatile("s_waitcnt lgkmcnt(0)" ::: "memory");
        {
            f32x4 mb = (f32x4){0.f, 0.f, 0.f, 0.f}, md = mb, gb = mb, gd = mb;
#pragma unroll
            for (int ks = 0; ks < 2; ++ks) {
                const bf16x8 fb = *(const bf16x8*)(Bt + l15 * 72 + ks * 32 + quad * 8), fd = *(const bf16x8*)(Dt + l15 * 72 + ks * 32 + quad * 8);
                const bf16x8 fa = *(const bf16x8*)(Ak + l15 * 72 + ks * 32 + quad * 8), fr = *(const bf16x8*)(Rt + l15 * 72 + ks * 32 + quad * 8);
                mb = mfma16(fb, fa, mb); md = mfma16(fd, fa, md); gb = mfma16(fb, fr, gb); gd = mfma16(fd, fr, gd); }
#pragma unroll
            for (int jj = 0; jj < 4; ++jj) { const int j = quad * 4 + jj, t = l15;
                Mb[j * 16 + t] = j < t ? mb[jj] : 0.f; Md[j * 16 + t] = j < t ? md[jj] : 0.f; Gb[j * 16 + t] = j <= t ? gb[jj] : 0.f; Gd[j * 16 + t] = j <= t ? gd[jj] : 0.f; }
        }
        asm volatile("s_waitcnt lgkmcnt(0)" ::: "memory");
        {
            float tc[16];
#pragma unroll
            for (int i = 15; i >= 0; --i) { float acc = (i == l15) ? 1.f : 0.f;
                float mr[16];
#pragma unroll
                for (int q4 = (i + 1) >> 2; q4 < 4; ++q4) { const f32x4 m4 = *(const f32x4*)(Mb + i * 16 + q4 * 4); mr[q4 * 4] = m4[0]; mr[q4 * 4 + 1] = m4[1]; mr[q4 * 4 + 2] = m4[2]; mr[q4 * 4 + 3] = m4[3]; }
#pragma unroll
                for (int l = i + 1; l < 16; ++l) acc -= mr[l] * tc[l];
                tc[i] = acc; }
            if (quad == 0) {
#pragma unroll
                for (int i = 0; i < 16; ++i) Tm[i * 16 + l15] = tc[i]; }
        }
        asm volatile("s_waitcnt lgkmcnt(0)" ::: "memory");
        {
            float n4[4] = {0.f, 0.f, 0.f, 0.f};
#pragma unroll
            for (int l = 0; l < 16; ++l) { const float tv = Tm[l * 16 + l15];
#pragma unroll
                for (int jj = 0; jj < 4; ++jj) n4[jj] += Md[(quad * 4 + jj) * 16 + l] * tv; }
#pragma unroll
            for (int jj = 0; jj < 4; ++jj) Nm[(quad * 4 + jj) * 16 + l15] = n4[jj];
        }
        asm volatile("s_waitcnt lgkmcnt(0)" ::: "memory");
        unsigned char* rec = rwc_rec(P, dir, unit);
        {
            float q4[4];
#pragma unroll
            for (int jj = 0; jj < 4; ++jj) q4[jj] = Gd[(quad * 4 + jj) * 16 + l15];
#pragma unroll
            for (int l = 0; l < 16; ++l) { const float gv = Gb[l * 16 + l15];
#pragma unroll
                for (int jj = 0; jj < 4; ++jj) q4[jj] -= Nm[(quad * 4 + jj) * 16 + l] * gv; }
            *(uint2*)((bf16_t*)(rec + 8192) + l15 * 16 + quad * 4) = make_uint2(pk2(q4[0], q4[1]), pk2(q4[2], q4[3]));
        }
        {
            float ap[16], rp[16], ps[16];
#pragma unroll
            for (int t = 0; t < 16; ++t) { ap[t] = 0.f; rp[t] = rt[t]; }
#pragma unroll
            for (int j = 0; j < 16; ++j) {
#pragma unroll
                for (int q4 = j >> 2; q4 < 4; ++q4) { const f32x4 r4 = *(const f32x4*)(Tm + j * 16 + q4 * 4);
#pragma unroll
                    for (int e = 0; e < 4; ++e) ap[q4 * 4 + e] += ak[j] * r4[e]; } }
#pragma unroll
            for (int j = 0; j < 16; ++j) {
#pragma unroll
                for (int q4 = j >> 2; q4 < 4; ++q4) { const f32x4 r4 = *(const f32x4*)(Gb + j * 16 + q4 * 4);
#pragma unroll
                    for (int e = 0; e < 4; ++e) rp[q4 * 4 + e] -= ap[j] * r4[e]; } }
#pragma unroll
            for (int j = 0; j < 16; ++j) { float acc = dt[j];
#pragma unroll
                for (int q4 = j >> 2; q4 < 4; ++q4) { const f32x4 r4 = *(const f32x4*)(Nm + j * 16 + q4 * 4);
#pragma unroll
                    for (int e = 0; e < 4; ++e) acc -= r4[e] * bt[q4 * 4 + e]; }
                ps[j] = acc * gC; }
            bf16_t* AP = (bf16_t*)rec; bf16_t* RP = AP + 1024; const int so = rwc_slot(lane);
#pragma unroll
            for (int t = 0; t < 16; ++t) { AP[t * 64 + so] = (bf16_t)(pk2(ap[t], 0.f) & 0xffffu); RP[t * 64 + so] = (bf16_t)(pk2(rp[t], 0.f) & 0xffffu); }
            float nb_[16];
#pragma unroll
            for (int t = 0; t < 16; ++t) nb_[t] = -bt[t] * gC;
            uint4* BP = (uint4*)(rec + 4096) + lane * 2; BP[0] = pack8(nb_); BP[1] = pack8(nb_ + 8);
            uint4* PP = (uint4*)(rec + 6144) + lane * 2; PP[0] = pack8(ps); PP[1] = pack8(ps + 8);
            ((float*)(rec + 8704))[lane] = gC;
        }
        asm volatile("s_waitcnt lgkmcnt(0)" ::: "memory");
    }
}
struct RwcRegs { u32x4_t a, b, c, v; };
DEV void rwc_load(const Params& P, RwcRegs& g, int sh, int dir, int ck, int t) {
    const unsigned char* rec = rwc_rec(P, dir, sh * RWC_NCK + ck);
    g.a = GLD16(rec + (size_t)t * 16); g.b = GLD16(rec + (size_t)(t + 256) * 16);
    if (t < 48) g.c = GLD16(rec + (size_t)(t + 512) * 16);
    if (t < 128) { const int j = t >> 3, r8 = (t & 7) * 8, sidx = ck * 16 + j; const int sc = sidx < LSEQ ? sidx : LSEQ - 1; const int p = dir ? LSEQ - 1 - sc : sc;
        g.v = GLD16(slotp(P, 19) + (size_t)row_of(sh >> 3, p) * 512 + (sh & 7) * 64 + r8); if (sidx >= LSEQ) g.v = (u32x4_t){0u, 0u, 0u, 0u}; }
}
DEV void rwc_store(unsigned char* buf, const RwcRegs& g, int t) {
    *(u32x4_t*)(buf + t * 16) = g.a; *(u32x4_t*)(buf + (t + 256) * 16) = g.b;
    if (t < 48) *(u32x4_t*)(buf + (t + 512) * 16) = g.c;
    if (t < 128) { bf16_t* VsT = (bf16_t*)(buf + RWC_REC); const int j = t >> 3, r8 = (t & 7) * 8;
        VsT[(r8 + 0) * 16 + j] = (bf16_t)(g.v.x & 0xffffu); VsT[(r8 + 1) * 16 + j] = (bf16_t)(g.v.x >> 16); VsT[(r8 + 2) * 16 + j] = (bf16_t)(g.v.y & 0xffffu); VsT[(r8 + 3) * 16 + j] = (bf16_t)(g.v.y >> 16);
        VsT[(r8 + 4) * 16 + j] = (bf16_t)(g.v.z & 0xffffu); VsT[(r8 + 5) * 16 + j] = (bf16_t)(g.v.z >> 16); VsT[(r8 + 6) * 16 + j] = (bf16_t)(g.v.w & 0xffffu); VsT[(r8 + 7) * 16 + j] = (bf16_t)(g.v.w >> 16); }
}
DEV void phase_rwc_scan(const Params& P0, unsigned char* lds, int bid, int nb, int wv) {
    Params P = load_params(); P.ws = launder_ws(P.ws);
    const int tid = launder_tid(wv), lane = tid & 63, w = __builtin_amdgcn_readfirstlane(tid >> 6), l15 = lane & 15, quad = lane >> 4;
    constexpr int BUFB = RWC_REC + 2048;
    for (int u2 = bid; u2 < 64; u2 += nb) {
        const int sh = u2 & 31, dir = u2 >> 5; const int sl = sh >> 3, head = sh & 7;
        f32x4 ST[4];
#pragma unroll
        for (int ct = 0; ct < 4; ++ct) ST[ct] = (f32x4){0.f, 0.f, 0.f, 0.f};
        RwcRegs g; g.a = g.b = g.c = g.v = (u32x4_t){0u, 0u, 0u, 0u};
        if (w >= 4) { rwc_load(P, g, sh, dir, 0, tid - 256); rwc_store(lds, g, tid - 256); rwc_load(P, g, sh, dir, 1, tid - 256); }
        __syncthreads();
#pragma unroll 1
        for (int ck = 0; ck < RWC_NCK; ++ck) {
            const unsigned char* buf = lds + (ck & 1) * BUFB;
            if (w >= 4) {
                if (ck + 1 < RWC_NCK) rwc_store(lds + ((ck + 1) & 1) * BUFB, g, tid - 256);
                if (ck + 2 < RWC_NCK) rwc_load(P, g, sh, dir, ck + 2, tid - 256);
            } else {
                const bf16_t* AP = (const bf16_t*)buf; const bf16_t* RP = AP + 1024; const bf16_t* BP = (const bf16_t*)(buf + 4096); const bf16_t* PP = (const bf16_t*)(buf + 6144);
                const bf16_t* QP = (const bf16_t*)(buf + 8192); const float* GC = (const float*)(buf + 8704); const bf16_t* VsT = (const bf16_t*)(buf + RWC_REC);
                const u32x4_t z4 = (u32x4_t){0u, 0u, 0u, 0u};
                u32x4_t sb0, sb1;
                sb0.x = pk2(ST[0][0], ST[0][1]); sb0.y = pk2(ST[0][2], ST[0][3]); sb0.z = pk2(ST[1][0], ST[1][1]); sb0.w = pk2(ST[1][2], ST[1][3]);
                sb1.x = pk2(ST[2][0], ST[2][1]); sb1.y = pk2(ST[2][2], ST[2][3]); sb1.z = pk2(ST[3][0], ST[3][1]); sb1.w = pk2(ST[3][2], ST[3][3]);
                const bf16x8 SB0 = __builtin_bit_cast(bf16x8, sb0), SB1 = __builtin_bit_cast(bf16x8, sb1);
                const bf16x8 a0 = *(const bf16x8*)(AP + l15 * 64 + (0 * 4 + quad) * 8), a1 = *(const bf16x8*)(AP + l15 * 64 + (1 * 4 + quad) * 8);
                const bf16x8 r0 = *(const bf16x8*)(RP + l15 * 64 + (0 * 4 + quad) * 8), r1 = *(const bf16x8*)(RP + l15 * 64 + (1 * 4 + quad) * 8);
                const u32x4_t vq = quad < 2 ? *(const u32x4_t*)(VsT + (w * 16 + l15) * 16 + quad * 8) : z4;
                const u32x4_t qq = quad < 2 ? *(const u32x4_t*)(QP + l15 * 16 + quad * 8) : z4;
                f32x4 gcv[4]; uint2 bqv[4]; u32x4_t pqv[4];
#pragma unroll
                for (int ct = 0; ct < 4; ++ct) { gcv[ct] = *(const f32x4*)(GC + ct * 16 + quad * 4); bqv[ct] = *(const uint2*)(BP + (ct * 16 + l15) * 16 + quad * 4);
                    pqv[ct] = quad < 2 ? *(const u32x4_t*)(PP + (ct * 16 + l15) * 16 + quad * 8) : z4; }
                const bf16x8 VB = __builtin_bit_cast(bf16x8, vq), QA = __builtin_bit_cast(bf16x8, qq);
                f32x4 Wt = (f32x4){0.f, 0.f, 0.f, 0.f}, Ot = Wt;
                Wt = mfma16(a0, SB0, Wt); Wt = mfma16(a1, SB1, Wt);
                Ot = mfma16(r0, SB0, Ot); Ot = mfma16(r1, SB1, Ot); Ot = mfma16(QA, VB, Ot);
                u32x4_t wb; wb.x = pk2(Wt[0], Wt[1]); wb.y = pk2(Wt[2], Wt[3]); wb.z = 0u; wb.w = 0u;
                const bf16x8 WB = __builtin_bit_cast(bf16x8, wb);
#pragma unroll
                for (int ct = 0; ct < 4; ++ct) {
                    u32x4_t ba; ba.x = bqv[ct].x; ba.y = bqv[ct].y; ba.z = 0u; ba.w = 0u;
                    f32x4 acc = ST[ct] * gcv[ct];
                    acc = mfma16(__builtin_bit_cast(bf16x8, ba), WB, acc);
                    acc = mfma16(__builtin_bit_cast(bf16x8, pqv[ct]), VB, acc);
                    ST[ct] = acc;
                }
                bf16_t* Oo = slotp(P, 15 + dir);
#pragma unroll
                for (int jj = 0; jj < 4; ++jj) { const int sidx = ck * 16 + quad * 4 + jj;
                    if (sidx < LSEQ) { const int p = dir ? LSEQ - 1 - sidx : sidx; ((__attribute__((address_space(1))) bf16_t*)Oo)[(size_t)row_of(sl, p) * 512 + head * 64 + w * 16 + l15] = (bf16_t)(pk2(Ot[jj], 0.f) & 0xffffu); } }
            }
            __syncthreads();
        }
    }
}


DEV void phase_attn_combine(const Params& P0, int layer, int bid, int nb, int wv) {
    Params P = load_params(); P.ws = launder_ws(P.ws);
    ROWPRO
    const float lam_init = layer == 0 ? 0.2f : 0.35550906759096934f;
    float lam;
    { const float* lp = P.in[I_LAM] + (size_t)layer * 256; const float s1 = wave_sum(lp[lane] * lp[64 + lane]), s2 = wave_sum(lp[128 + lane] * lp[192 + lane]); lam = __expf(s1) - __expf(s2) + lam_init; }
    const float* PT = (const float*)slotp(P, 22);
    for (int task = gw; task < 64 * 128; task += ngw) {
        const int ul = task >> 7, row = task & 127, unit = 448 + ul, sh = unit >> 5, qb = unit & 31, sl = sh >> 2, head = sh & 3;
        float om[2][2];
#pragma unroll
        for (int map = 0; map < 2; ++map) {
            const float* pa = PT + ((size_t)((ul * 2 + 0) * 2 + map) * 128 + row) * 130; const float* pb = PT + ((size_t)((ul * 2 + 1) * 2 + map) * 128 + row) * 130;
            const float ma = pa[128], la = pa[129], mb = pb[128], lb = pb[129];
            const float M = fmaxf(ma, mb), fa = __builtin_amdgcn_exp2f(ma - M), fb = __builtin_amdgcn_exp2f(mb - M);
            const float inv = 1.0f / (la * fa + lb * fb);
            om[map][0] = (pa[lane * 2] * fa + pb[lane * 2] * fb) * inv; om[map][1] = (pa[lane * 2 + 1] * fa + pb[lane * 2 + 1] * fb) * inv; }
        const float o0 = om[0][0] - lam * om[1][0], o1 = om[0][1] - lam * om[1][1];
        const float ss = wave_sum(o0 * o0 + o1 * o1);
        const float rs = rsqrtf(ss * (1.f / 128.f) + 1e-5f) * (1.f - lam_init);
        const float g0 = P.in[I_SUBLN][layer * 128 + lane * 2], g1 = P.in[I_SUBLN][layer * 128 + lane * 2 + 1];
        *(unsigned*)(slotp(P, 4) + (size_t)(sl * 4096 + qb * 128 + row) * 512 + head * 128 + lane * 2) = pk2(o0 * rs * g0, o1 * rs * g1);
    }
}
#define LAS __attribute__((address_space(3)))
#define XB_TMO      128
#define XB_XCNT(j)  (256  + 64 * (j))
#define XB_XSUB(j)  (1280 + 64 * (j))
#define XB_XGEN(j)  (2304 + 64 * (j))
#define XB_TOP      3328
#define XB_TOPGEN   3392
#define XCD_BAR_WORDS 3456
#define XB_SPIN_CAP (1u << 18)

__device__ __forceinline__ unsigned xb_ld(unsigned* p)              { return __hip_atomic_load(p, __ATOMIC_RELAXED, __HIP_MEMORY_SCOPE_AGENT); }
__device__ __forceinline__ unsigned xb_add(unsigned* p, unsigned v) { return __hip_atomic_fetch_add(p, v, __ATOMIC_RELAXED, __HIP_MEMORY_SCOPE_AGENT); }
__device__ __forceinline__ unsigned xb_xcc_id() { return (unsigned)__builtin_amdgcn_s_getreg((3 << 11) | 20) & 0xFu; }
#define XB_SPIN(cond, bar) do { unsigned _sp = 0; while (cond) { __builtin_amdgcn_s_sleep(1); \
    if ((++_sp & 255u) == 0u) { if (xb_ld(&(bar)[XB_TMO])) break; if (_sp > XB_SPIN_CAP) { atomicAdd(&(bar)[XB_TMO], 1u); break; } } } } while (0)

struct XcdBarrier {
    unsigned* bar; unsigned x;
    volatile LAS unsigned* st;
};

__device__ __forceinline__ XcdBarrier xcd_barrier_post(unsigned* bar, volatile LAS unsigned* st, int wv) {
    XcdBarrier b; b.bar = bar; b.x = xb_xcc_id(); b.st = st;
    if (launder_tid(wv) == 0) (void)xb_add(&bar[XB_XCNT(b.x)], 1u);
    return b;
}
__device__ __forceinline__ void xcd_barrier_complete(unsigned* bar, unsigned x, unsigned& nloc, unsigned& nx) {
    const unsigned G = gridDim.x * gridDim.y * gridDim.z;
    unsigned sum, cnt, mine, sp = 0u;
    for (;;) {
        sum = 0u; cnt = 0u; mine = 0u;
#pragma unroll
        for (unsigned j = 0; j < 16; ++j) { const unsigned c = xb_ld(&bar[XB_XCNT(j)]); sum += c; cnt += (c > 0u) ? 1u : 0u; mine = (j == x) ? c : mine; }
        if (sum == G) break;
        __builtin_amdgcn_s_sleep(1);
        if ((++sp & 255u) == 0u) { if (xb_ld(&bar[XB_TMO])) break; if (sp > XB_SPIN_CAP) { atomicAdd(&bar[XB_TMO], 1u); break; } }
    }
    nloc = mine > 0u ? mine : 1u; nx = cnt > 0u ? cnt : 1u;
}

__device__ __forceinline__ void xcd_barrier(const XcdBarrier& b, int wv) {
    asm volatile("s_waitcnt vmcnt(0)" ::: "memory");
    __syncthreads();
    if (launder_tid(wv) == 0) {
        unsigned* bar = b.bar;
        __builtin_amdgcn_s_waitcnt(0);
        unsigned nloc = b.st[0], nx = b.st[1];
        if (nloc == 0u) { xcd_barrier_complete(bar, b.x, nloc, nx); b.st[0] = nloc; b.st[1] = nx; }
        const unsigned old = xb_add(&bar[XB_XSUB(b.x)], 1u);
        const unsigned gen = old / nloc;
        if (old + 1u == (gen + 1u) * nloc) {
            __builtin_amdgcn_fence(__ATOMIC_RELEASE, "agent");
            asm volatile("s_waitcnt vmcnt(0)" ::: "memory");
            const unsigned og = xb_add(&bar[XB_TOP], 1u);
            const unsigned tg = og / nx;
            if (og + 1u == (tg + 1u) * nx) xb_add(&bar[XB_TOPGEN], 1u);
            else XB_SPIN(xb_ld(&bar[XB_TOPGEN]) == tg, bar);
            __builtin_amdgcn_fence(__ATOMIC_ACQUIRE, "agent");
            xb_add(&bar[XB_XGEN(b.x)], 1u);
            asm volatile("s_waitcnt vmcnt(0)" ::: "memory");
        } else {
            XB_SPIN(xb_ld(&bar[XB_XGEN(b.x)]) == gen, bar);
            __builtin_amdgcn_fence(__ATOMIC_ACQUIRE, "agent");
            asm volatile("s_waitcnt vmcnt(0)" ::: "memory");
        }
    }
    __syncthreads();
}

__global__ void __launch_bounds__(512) mega_fwd(Params P) {
    extern __shared__ __attribute__((aligned(16))) unsigned char lds[];
    cg::grid_group grid = cg::this_grid();
    const int bid = blockIdx.x, nb = gridDim.x; const int wv = __builtin_amdgcn_readfirstlane(threadIdx.x >> 6);
    volatile LAS unsigned* MISC = (volatile LAS unsigned*)((LAS unsigned char*)lds + 131072 + 256);
    if (threadIdx.x < 4) MISC[threadIdx.x] = 0u;
    __syncthreads();
    XcdBarrier xbar;
    { Params Pb = load_params(); xbar = xcd_barrier_post((unsigned*)Pb.ws, MISC, wv); }
#define GSYNC() xcd_barrier(xbar, wv)
    PG8_LAS unsigned char* ldsl = (PG8_LAS unsigned char*)lds;
#pragma unroll 1
    for (int layer_ = 0; layer_ < 2; ++layer_) {
        phase_weights(P, lsd(layer_), lds, bid, nb, wv);
        grid.sync();
#pragma unroll 1
        for (int g_ = 0; g_ < NGRP; ++g_) {
            #define Mpost ((lsd(layer_) == 0 && lsd(g_) == 2) ? TGP : TREAL)
#define NVALID ((lsd(layer_) == 0 && lsd(g_) == 2) ? TG + 128 : TG)
            phase_rmsnorm(P, lsd(g_), lsd(layer_) == 0, I_NMIX, lsd(layer_), TGP, NVALID, bid, nb, wv);
            if (PROBE == 5) { phase_rmsnorm(P, lsd(g_), lsd(layer_) == 0, I_NMIX, lsd(layer_), TGP, NVALID, bid, nb, wv); }
            GSYNC();
            if (PROBE == 6) { for (int q_ = 0; q_ < 15; ++q_) GSYNC(); }
            for (int rep_ = 0; rep_ < (PROBE == 3 ? 2 : 1); ++rep_)
            { Params Pl = load_params(); Pl.ws = launder_ws(Pl.ws); pg8::bf16_t* W = (pg8::bf16_t*)(Pl.ws + WS_W); pg8::Gemm gm{slotp(Pl, 0), W + WO_IN, TGP, 7680, 1024, 0, 0}; pg8::StaticOrder S; S.init(TGP, 7680, nb, bid);
              pg8::EpiBf<0> E{slotp(Pl, 2), 512, SLOT_E};
              pg8::gemm_phase<pg8::EpiBf<0>, pg8::StaticOrder, true, true>(ldsl, gm, S, E, wv); }
            GSYNC();
            phase_da_prep(P, lsd(layer_), bid, nb, wv);
            phase_hg1(P, lsd(layer_), lds, bid, nb, wv);
            if (PROBE == 4) { phase_hg1(P, lsd(layer_), lds, bid, nb, wv); }
            GSYNC();
            phase_hg2(P, bid, nb, wv);
            GSYNC();
            phase_hg3(P, lsd(layer_), lds, bid, nb, wv);
            GSYNC();
            phase_conv(P, lsd(layer_), bid, nb, wv);
            if (PROBE == 5) { phase_conv(P, lsd(layer_), bid, nb, wv); }
            phase_vtrans(P, lds, bid, nb, wv);
            if (PROBE == 5) { phase_vtrans(P, lds, bid, nb, wv); }
            phase_rw_prep(P, lsd(layer_), bid, nb, wv);
            if (PROBE == 5) { phase_rw_prep(P, lsd(layer_), bid, nb, wv); }
            GSYNC();
            { Params Pl = load_params(); Pl.ws = launder_ws(Pl.ws); pg8::bf16_t* W = (pg8::bf16_t*)(Pl.ws + WS_W); pg8::Gemm gm{slotp(Pl, 21), W + WO_LR, TGP, 2560, 384, 0, 0}; pg8::StaticOrder S; S.init(TGP, 2560, nb, bid);
              pg8::EpiLR E{slotp(Pl, 22), slotp(Pl, 23), slotp(Pl, 24), slotp(Pl, 13), slotp(Pl, 14), Pl.in[I_W0] + lsd(layer_) * 1024, Pl.in[I_A0] + lsd(layer_) * 1024};
              pg8::gemm_phase<pg8::EpiLR, pg8::StaticOrder, true, true>(ldsl, gm, S, E, wv); }
            GSYNC();
            phase_rwc_pre(P, lsd(layer_), lds, bid, nb, wv);
            GSYNC();
            if (nb == 256) {
                const int nun = lsd(layer_) == 0 ? 528 : 512;
                if (bid < 64) { phase_rwc_scan(P, lds, bid, nb, wv); __syncthreads(); phase_attn(P, lsd(layer_), lds, bid, -1, -1, wv); }
                else { const int bq = bid - 64;
                    const int third = bq < 128 ? ((448 + (bq >> 1)) | ((3 + (bq & 1)) << 12)) : ((384 + bq < nun) ? 384 + bq : -1);
                    phase_attn(P, lsd(layer_), lds, 64 + bq, 256 + bq, third, wv); }
            } else {
                phase_rwc_scan(P, lds, bid, nb, wv); __syncthreads();
                for (int u = bid; u < (lsd(layer_) == 0 ? 528 : 512); u += nb) phase_attn(P, lsd(layer_), lds, u, -1, -1, wv);
            }
            GSYNC();
            if (nb == 256) phase_attn_combine(P, lsd(layer_), bid, nb, wv);
            phase_rw_post(P, lsd(layer_), lsd(g_), lsd(layer_) == 0 ? TG : TREAL, bid, nb, wv);
            if (PROBE == 5) { phase_rw_post(P, lsd(layer_), lsd(g_), lsd(layer_) == 0 ? TG : TREAL, bid, nb, wv); }
            GSYNC();
            { Params Pl = load_params(); Pl.ws = launder_ws(Pl.ws); pg8::bf16_t* W = (pg8::bf16_t*)(Pl.ws + WS_W); pg8::Gemm gm{slotp(Pl, 2), W + WO_BP, Mpost, 4096, 512, 4, SLOT_B}; pg8::StaticOrder S; S.init(Mpost, 4096, nb, bid);
              pg8::EpiBf<0> E{slotp(Pl, 6), 4096, 0};
              pg8::gemm_phase<pg8::EpiBf<0>, pg8::StaticOrder, true, true>(ldsl, gm, S, E, wv); }
            GSYNC();
            { Params Pl = load_params(); Pl.ws = launder_ws(Pl.ws); pg8::bf16_t* W = (pg8::bf16_t*)(Pl.ws + WS_W); pg8::Gemm gm{slotp(Pl, 0), W + WO_G, Mpost, 4096, 1024, 0, 0}; pg8::StaticOrder S; S.init(Mpost, 4096, nb, bid);
              pg8::EpiGate E{slotp(Pl, 6), slotp(Pl, 14)};
              pg8::gemm_phase<pg8::EpiGate, pg8::StaticOrder, true, true>(ldsl, gm, S, E, wv); }
            GSYNC();
            { Params Pl = load_params(); Pl.ws = launder_ws(Pl.ws); pg8::bf16_t* W = (pg8::bf16_t*)(Pl.ws + WS_W); pg8::Gemm gm{slotp(Pl, 14), W + WO_OUT, Mpost, 1024, 1024, 0, 0}; pg8::StaticOrder S; S.init(Mpost, 1024, nb, bid);
              pg8::EpiResid E{lsd(layer_) == 0 ? x_in_row(Pl, lsd(g_), 0) : (const float*)x_cur_row(Pl, lsd(g_), 0), lsd(layer_) == 0 ? Pl.in[I_META] : (const float*)nullptr, x_cur_row(Pl, lsd(g_), 0), GPTR(float, Pl.ws + WS_XMETA), lsd(g_), NVALID};
              pg8::gemm_phase<pg8::EpiResid, pg8::StaticOrder, true, true>(ldsl, gm, S, E, wv); }
            GSYNC();
            phase_rmsnorm(P, lsd(g_), false, I_NMLP, lsd(layer_), Mpost, NVALID, bid, nb, wv);
            if (PROBE == 5) { phase_rmsnorm(P, lsd(g_), false, I_NMLP, lsd(layer_), Mpost, NVALID, bid, nb, wv); }
            GSYNC();
            for (int rep_ = 0; rep_ < (PROBE == 7 ? 2 : 1); ++rep_)
            { Params Pl = load_params(); Pl.ws = launder_ws(Pl.ws); pg8::bf16_t* W = (pg8::bf16_t*)(Pl.ws + WS_W); pg8::Gemm gm{slotp(Pl, 0), W + WO_1, Mpost, 4096, 1024, 0, 0}; pg8::StaticOrder S; S.init(Mpost, 4096, nb, bid);
              pg8::EpiBf<1> E{slotp(Pl, 6), 4096, 0};
              pg8::gemm_phase<pg8::EpiBf<1>, pg8::StaticOrder, true, true>(ldsl, gm, S, E, wv); }
            GSYNC();
            { Params Pl = load_params(); Pl.ws = launder_ws(Pl.ws); pg8::bf16_t* W = (pg8::bf16_t*)(Pl.ws + WS_W); pg8::Gemm gm{slotp(Pl, 6), W + WO_2, Mpost, 1024, 4096, 0, 0}; pg8::StaticOrder S; S.init(Mpost, 1024, nb, bid);
              pg8::EpiResid E{(const float*)x_cur_row(Pl, lsd(g_), 0), (const float*)nullptr, x_cur_row(Pl, lsd(g_), 0), GPTR(float, Pl.ws + WS_XMETA), lsd(g_), NVALID};
              pg8::gemm_phase<pg8::EpiResid, pg8::StaticOrder, true, true>(ldsl, gm, S, E, wv); }
            GSYNC();
        }
    }
}

extern "C" void kernel_launch(void* const* d_in, const int* in_sizes, int n_in, void* d_out, int out_size, void* d_ws, size_t ws_size, hipStream_t stream) {
    static int grid = 0;
    if (grid == 0) {
        if (n_in != 29 || ws_size < WS_NEED) { fprintf(stderr, "kernel_launch: need 29 inputs and %zu bytes of workspace; got %d, %zu\n", (size_t)WS_NEED, n_in, ws_size); grid = -1; return; }
        int dev = 0, cus = 0, per_cu = 0;
        if (hipGetDevice(&dev) != hipSuccess || hipDeviceGetAttribute(&cus, hipDeviceAttributeMultiprocessorCount, dev) != hipSuccess) { grid = -1; return; }
        if (hipFuncSetAttribute((const void*)mega_fwd, hipFuncAttributeMaxDynamicSharedMemorySize, LDS_BYTES) != hipSuccess) { fprintf(stderr, "kernel_launch: hipFuncSetAttribute failed\n"); grid = -1; return; }
        if (hipOccupancyMaxActiveBlocksPerMultiprocessor(&per_cu, (const void*)mega_fwd, 512, LDS_BYTES) != hipSuccess || per_cu < 1) { fprintf(stderr, "kernel_launch: occupancy query says %d\n", per_cu); per_cu = 1; }
        (void)hipGetLastError();
        grid = cus;
    }
    if (grid < 0) return;
    if (hipMemsetAsync(d_ws, 0, 16384, stream) != hipSuccess) { fprintf(stderr, "kernel_launch: memset failed\n"); return; }
    Params p{};
    for (int i = 0; i < 29; ++i) p.in[i] = (const float*)d_in[i];
    p.out = (float*)d_out; p.ws = (unsigned char*)d_ws;
    void* args[] = {&p};
    hipError_t e = hipLaunchCooperativeKernel((const void*)mega_fwd, dim3(grid), dim3(512), args, LDS_BYTES, stream);
    if (e != hipSuccess) fprintf(stderr, "kernel_launch: cooperative launch failed: %s (grid %d)\n", hipGetErrorString(e), grid);
}
```

```cpp
#include <hip/hip_runtime.h>
#include <hip/hip_cooperative_groups.h>
#include <cstdio>
#include <cstdint>
namespace cg = cooperative_groups;
#define PROBE 0
#define DEV __device__ __forceinline__
__device__ __forceinline__ int lsd(int x) { asm volatile("" : "+s"(x)); return x; }
__device__ __forceinline__ int launder_tid(int wv) { int l; asm volatile("v_mbcnt_lo_u32_b32 %0, -1, 0\n\tv_mbcnt_hi_u32_b32 %0, -1, %0" : "=v"(l)); return wv * 64 + l; }
namespace pg8 {
#define PG8_LAS __attribute__((address_space(3)))
typedef unsigned short bf16_t;
typedef short bf16x8 __attribute__((ext_vector_type(8)));
typedef float f32x4 __attribute__((ext_vector_type(4)));
typedef unsigned u32x4 __attribute__((ext_vector_type(4)));
constexpr int BM = 256, BK = 64, HALF = 128, HTB = HALF * BK * 2  , STAGE_BYTES = 8 * HTB, NXCD = 8, WGM = 8;

__host__ __device__ __forceinline__ int lds_byte(int r, int c) { const int st = (r >> 4) * 2 + (c >> 5), rr = r & 15, cc = c & 31, ob = rr * 64 + cc * 2; return st * 1024 + (ob ^ (((ob >> 9) & 1) << 5)); }
__host__ __device__ __forceinline__ void stage_rc(int b, int& R, int& C) { const int st = b / 1024, sb = b % 1024, swz = sb ^ (((sb >> 9) & 1) << 5); R = (st >> 1) * 16 + swz / 64; C = (st & 1) * 32 + (swz % 64) / 2; }
__host__ __device__ __forceinline__ int perm32(int rho) { const int n = rho >> 4, i = rho & 15; return 8 * (i >> 2) + 4 * n + (i & 3); }

struct Unit { int pm, pn; };
struct Gemm { const bf16_t* A; const bf16_t* Bt; int M, N, K; int pn_per_ab; size_t ab_stride; };

struct StaticOrder {
    int nM, nN, nwg, G, c;
    __host__ __device__ void init(int M, int N, int G_, int c_) { nM = M / BM; nN = N / BM; nwg = nM * nN; G = G_; c = c_; }
    __host__ __device__ bool next(int i, Unit& u) const {
        const long L = (long)i * G + c; if (L >= nwg) return false;
        int wgid = (int)L; { const int q = nwg / NXCD, r = nwg % NXCD, xcd = wgid % NXCD, off = wgid / NXCD; wgid = (xcd < r ? xcd * (q + 1) : r * (q + 1) + (xcd - r) * q) + off; }
        const int nig = WGM * nN, gid = wgid / nig, fm = gid * WGM, gsz = (nM - fm) < WGM ? (nM - fm) : WGM;
        u.pm = fm + ((wgid % nig) % gsz); u.pn = (wgid % nig) / gsz; return true;
    }
    __device__ __forceinline__ void a_ready(const Unit&) const {}
    __device__ __forceinline__ void done(const Unit&) const {}
};

typedef float f32x2cv_t __attribute__((ext_vector_type(2))); typedef __bf16 bf16x2cv_t __attribute__((ext_vector_type(2)));
__device__ __forceinline__ unsigned cvt_pk_bf16(float lo, float hi) { const f32x2cv_t v = {lo, hi}; const bf16x2cv_t b = __builtin_convertvector(v, bf16x2cv_t); return __builtin_bit_cast(unsigned, b); }
typedef float f32x2 __attribute__((ext_vector_type(2)));
__device__ __forceinline__ float sigm(float x) { return __builtin_amdgcn_rcpf(1.0f + __expf(-x)); }
template <int ACT  > struct EpiBf {
    static constexpr bool PERM = true, AFTER_DRAIN = false;
    bf16_t* O; int ldc; size_t gstride;
    __device__ __forceinline__ void operator()(const f32x4 (&acc)[2][2][4][2], const Unit& u, int wr, int wc, int fr, int fq) const {
        const int row0 = u.pm * BM + wr * 64 + fr; int colt = u.pn * BM; bf16_t* base = O; int ld = ldc;
        if (gstride) { const int t = colt >> 9; colt &= 511; base += (size_t)t * gstride; ld = 512; }
        const int col0 = colt + wc * 32 + 8 * fq;
#pragma unroll
        for (int ai = 0; ai < 2; ++ai)
#pragma unroll
            for (int m = 0; m < 4; ++m) { bf16_t* rowp = base + (size_t)(row0 + ai * HALF + m * 16) * ld + col0;
#pragma unroll
                for (int bj = 0; bj < 2; ++bj) { f32x4 v0 = acc[ai][bj][m][0], v1 = acc[ai][bj][m][1];
                    if (ACT == 1) {
#pragma unroll
                        for (int i = 0; i < 4; ++i) { float a = fmaxf(v0[i], 0.f), b = fmaxf(v1[i], 0.f); v0[i] = a * a; v1[i] = b * b; } }
                    u32x4 w; w.x = cvt_pk_bf16(v0[0], v0[1]); w.y = cvt_pk_bf16(v0[2], v0[3]); w.z = cvt_pk_bf16(v1[0], v1[1]); w.w = cvt_pk_bf16(v1[2], v1[3]);
                    *(u32x4*)(rowp + bj * HALF) = w; } }
    }
};
struct EpiLR {
    static constexpr bool PERM = true, AFTER_DRAIN = false;
    bf16_t *s0, *s1, *s2, *s3, *s4; const float* w0; const float* a0;
    __device__ __forceinline__ void operator()(const f32x4 (&acc)[2][2][4][2], const Unit& u, int wr, int wc, int fr, int fq) const {
        const int row0 = u.pm * BM + wr * 64 + fr; const int colg = u.pn * BM; const int seg = colg >> 9; const int cb = colg & 511;
        bf16_t* base = seg == 0 ? s0 : seg == 1 ? s1 : seg == 2 ? s2 : seg == 3 ? s3 : s4;
        const int col0 = cb + wc * 32 + 8 * fq;
        const float* bsrc = seg < 2 ? w0 + seg * 512 : a0 + (seg & 1) * 512;
        const float sc = seg < 2 ? 0.6065306597f : 1.0f; const float bm = seg < 4 ? 1.f : 0.f; const bool act = seg < 4;
#pragma unroll
        for (int bj = 0; bj < 2; ++bj) {
            const f32x4 b0 = *(const f32x4*)(bsrc + col0 + bj * HALF) * bm, b1 = *(const f32x4*)(bsrc + col0 + bj * HALF + 4) * bm;
#pragma unroll
            for (int ai = 0; ai < 2; ++ai)
#pragma unroll
                for (int m = 0; m < 4; ++m) { bf16_t* rowp = base + (size_t)(row0 + ai * HALF + m * 16) * 512 + col0;
                    f32x4 v0 = acc[ai][bj][m][0] + b0, v1 = acc[ai][bj][m][1] + b1;
#pragma unroll
                    for (int i = 0; i < 4; ++i) { const float g0 = sc * sigm(v0[i]), g1 = sc * sigm(v1[i]); v0[i] = act ? g0 : v0[i]; v1[i] = act ? g1 : v1[i]; }
                    u32x4 w; w.x = cvt_pk_bf16(v0[0], v0[1]); w.y = cvt_pk_bf16(v0[2], v0[3]); w.z = cvt_pk_bf16(v1[0], v1[1]); w.w = cvt_pk_bf16(v1[2], v1[3]);
                    *(u32x4*)(rowp + bj * HALF) = w; __builtin_amdgcn_sched_barrier(0); }
        }
    }
};
struct EpiGate {
    static constexpr bool PERM = true, AFTER_DRAIN = false;
    const bf16_t* Pm; bf16_t* Mg;
    __device__ __forceinline__ void operator()(const f32x4 (&acc)[2][2][4][2], const Unit& u, int wr, int wc, int fr, int fq) const {
        const int row0 = u.pm * BM + wr * 64 + fr; const int ocol = u.pn * 64 + wc * 16 + fq * 4;
#pragma unroll
        for (int ai = 0; ai < 2; ++ai)
#pragma unroll
            for (int m = 0; m < 4; ++m) { const size_t row = (size_t)(row0 + ai * HALF + m * 16);
                float s0 = 0.f, s1 = 0.f, s2 = 0.f, s3 = 0.f;
#pragma unroll
                for (int bj = 0; bj < 2; ++bj)
#pragma unroll
                    for (int n = 0; n < 2; ++n) { const int br = bj * 2 + n;
                        const uint2 pw = *(const uint2*)(Pm + row * 4096 + br * 1024 + ocol);
                        const f32x4 a = acc[ai][bj][m][n];
                        s0 += sigm(a[0]) * __uint_as_float(pw.x << 16); s1 += sigm(a[1]) * __uint_as_float(pw.x & 0xffff0000u);
                        s2 += sigm(a[2]) * __uint_as_float(pw.y << 16); s3 += sigm(a[3]) * __uint_as_float(pw.y & 0xffff0000u); }
                uint2 o; o.x = cvt_pk_bf16(s0, s1); o.y = cvt_pk_bf16(s2, s3);
                *(uint2*)(Mg + row * 1024 + ocol) = o; }
    }
};
struct EpiResid {
    static constexpr bool PERM = true, AFTER_DRAIN = false;
    const float* om; const float* mt; float* nm; float* xmb; int g; int rlim;
    __device__ __forceinline__ void operator()(const f32x4 (&acc)[2][2][4][2], const Unit& u, int wr, int wc, int fr, int fq) const {
        const int row0 = u.pm * BM + wr * 64 + fr; const int col0 = u.pn * BM + wc * 32 + 8 * fq;
#pragma unroll
        for (int ai = 0; ai < 2; ++ai)
#pragma unroll
            for (int m = 0; m < 4; ++m) { const int r = row0 + ai * HALF + m * 16;
                if (r < rlim) {
                    const int mi = r - 16384;
                    float* dmeta = xmb + (size_t)(mi < 64 ? g * 64 + mi : ((mi >> 6) - 1) * 64 + (mi & 63)) * 1024;
                    const float* src = r < 16384 ? om + (size_t)r * 1024 : (mt ? mt + (size_t)(mi & 15) * 1024 : (const float*)dmeta);
                    float* dst = r < 16384 ? nm + (size_t)r * 1024 : dmeta;
#pragma unroll
                    for (int bj = 0; bj < 2; ++bj)
#pragma unroll
                        for (int n = 0; n < 2; ++n) { const int c = col0 + bj * HALF + 4 * n;
                            const f32x4 xo = *(const f32x4*)(src + c); *(f32x4*)(dst + c) = xo + acc[ai][bj][m][n]; } } }
    }
};
template <class Epi, class Sched, bool ALIGN_EPI = false, bool SP2 = false>
__device__ __forceinline__ void gemm_phase(PG8_LAS unsigned char* lds, const Gemm g, const Sched& S, const Epi& E, int wv) {
    const int tid = launder_tid(wv), wid = __builtin_amdgcn_readfirstlane(tid >> 6), lane = tid & 63, wr = wid >> 2, wc = wid & 3, fr = lane & 15, fq = lane >> 4;
    const int K = g.K, nt = K / BK;
    unsigned voffA[2], voffB[2];
#pragma unroll
    for (int i = 0; i < 2; ++i) { int R, C; stage_rc(tid * 16 + i * 8192, R, C); const int Rb = Epi::PERM ? ((R & ~31) + perm32(R & 31)) : R;
        voffA[i] = (unsigned)(R * K + C) * 2u; voffB[i] = (unsigned)(Rb * K + C) * 2u; }
    const size_t kstep = (size_t)(BK * 2);
    const size_t hstep = (size_t)HALF * K * 2;
    const size_t tstep = 2 * hstep;
    const unsigned ldsw = (unsigned)wid * 1024u;
    const int aoff = lds_byte(wr * 64 + fr, fq * 8), boff = lds_byte(wc * 32 + fr, fq * 8);
#define PG8_SA(b, h) (((b) * 2 + (h)) * HTB)
#define PG8_SB(b, h) ((4 + (b) * 2 + (h)) * HTB)
#define PG8_STAGE(bufoff, gbase, voff) do { _Pragma("unroll") for (int _i = 0; _i < 2; ++_i) \
        __builtin_amdgcn_global_load_lds((const unsigned*)((const char*)(gbase) + (voff)[_i]), (PG8_LAS unsigned*)(lds + (bufoff) + ldsw + _i * 8192), 16, 0, 0); } while (0)
#define PG8_LDA(dst, b, h) do { _Pragma("unroll") for (int m = 0; m < 4; ++m) _Pragma("unroll") for (int k = 0; k < 2; ++k) dst[m][k] = *(const PG8_LAS bf16x8*)(lds + PG8_SA(b, h) + aoff + m * 2048 + k * 1024); } while (0)
#define PG8_LDB(dst, b, h) do { _Pragma("unroll") for (int n = 0; n < 2; ++n) _Pragma("unroll") for (int k = 0; k < 2; ++k) dst[n][k] = *(const PG8_LAS bf16x8*)(lds + PG8_SB(b, h) + boff + n * 2048 + k * 1024); } while (0)
#define PG8_MMA(ai, bj, At, Bt) do { __builtin_amdgcn_s_setprio(1); _Pragma("unroll") for (int m = 0; m < 4; ++m) _Pragma("unroll") for (int n = 0; n < 2; ++n) _Pragma("unroll") for (int k = 0; k < 2; ++k) \
        acc[ai][bj][m][n] = __builtin_amdgcn_mfma_f32_16x16x32_bf16(Bt[n][k], At[m][k], acc[ai][bj][m][n], 0, 0, 0); __builtin_amdgcn_s_setprio(0); } while (0)
#define PG8_WAIT_V(n) asm volatile("s_waitcnt vmcnt(" #n ")" ::: "memory")
#define PG8_WAIT_L(n) asm volatile("s_waitcnt lgkmcnt(" #n ")" ::: "memory")
#define PG8_BAR __builtin_amdgcn_s_barrier()
#define PG8_SCHED __builtin_amdgcn_sched_barrier(0)
    Unit cur, nxt; int ui = 0;
    if (!S.next(0, cur)) return;
    f32x4 acc[2][2][4][2];
#pragma unroll
    for (int a = 0; a < 2; ++a)
#pragma unroll
        for (int b = 0; b < 2; ++b)
#pragma unroll
            for (int m = 0; m < 4; ++m)
#pragma unroll
                for (int n = 0; n < 2; ++n) { float z_ = 0.f; asm volatile("" : "+v"(z_)); acc[a][b][m][n] = (f32x4){z_, z_, z_, z_}; }
    bf16x8 At[4][2], B0[2][2], B1[2][2];
    const char* cA = (const char*)g.A + (g.pn_per_ab ? (size_t)(cur.pn / g.pn_per_ab) * g.ab_stride : (size_t)0) + (size_t)cur.pm * tstep; const char* cB = (const char*)g.Bt + (size_t)cur.pn * tstep;
    S.a_ready(cur);
    if constexpr (SP2) {
        PG8_STAGE(PG8_SB(0, 0), cB, voffB); PG8_STAGE(PG8_SB(0, 1), cB + hstep, voffB); PG8_STAGE(PG8_SA(0, 0), cA, voffA); PG8_STAGE(PG8_SA(0, 1), cA + hstep, voffA);
        if (wr == 1) PG8_BAR;
        PG8_WAIT_V(2); PG8_BAR;
        PG8_STAGE(PG8_SB(1, 0), cB + kstep, voffB); PG8_STAGE(PG8_SA(1, 0), cA + kstep, voffA); PG8_STAGE(PG8_SB(1, 1), cB + hstep + kstep, voffB);
        PG8_WAIT_V(6); PG8_BAR;
    } else {
        PG8_STAGE(PG8_SB(0, 0), cB, voffB); PG8_STAGE(PG8_SA(0, 0), cA, voffA); PG8_STAGE(PG8_SB(0, 1), cB + hstep, voffB); PG8_STAGE(PG8_SA(0, 1), cA + hstep, voffA);
        if (wr == 1) PG8_BAR;
        PG8_WAIT_V(4); PG8_BAR;
        PG8_STAGE(PG8_SB(1, 0), cB + kstep, voffB); PG8_STAGE(PG8_SA(1, 0), cA + kstep, voffA); PG8_STAGE(PG8_SB(1, 1), cB + hstep + kstep, voffB);
        PG8_WAIT_V(6); PG8_BAR;
    }
    for (;;) {
        const bool has_next = S.next(ui + 1, nxt);
        const char* nA = has_next ? (const char*)g.A + (g.pn_per_ab ? (size_t)(nxt.pn / g.pn_per_ab) * g.ab_stride : (size_t)0) + (size_t)nxt.pm * tstep : cA; const char* nB = has_next ? (const char*)g.Bt + (size_t)nxt.pn * tstep : cB;
#pragma unroll 1
        for (int t = 0; t < nt; t += 2) {
            const bool last = (t == nt - 2);
            const char* a1 = cA + (size_t)(t + 1) * kstep;
            const char* a2 = last ? nA : cA + (size_t)(t + 2) * kstep; const char* b2 = last ? nB : cB + (size_t)(t + 2) * kstep;
            const char* a3 = a2 + kstep; const char* b3 = b2 + kstep;
            if (last && has_next) S.a_ready(nxt);
            if constexpr (SP2) {
            PG8_LDB(B0, 0, 0); PG8_LDB(B1, 0, 1); PG8_SCHED; PG8_LDA(At, 0, 0); PG8_STAGE(PG8_SA(1, 1), a1 + hstep, voffA);
            PG8_WAIT_V(8); PG8_WAIT_L(0); PG8_BAR; PG8_MMA(0, 0, At, B0); PG8_MMA(0, 1, At, B1); PG8_BAR; PG8_SCHED;
            PG8_LDA(At, 0, 1); PG8_STAGE(PG8_SB(0, 0), b2, voffB); PG8_STAGE(PG8_SB(0, 1), b2 + hstep, voffB); PG8_STAGE(PG8_SA(0, 0), a2, voffA);
            PG8_WAIT_V(8); PG8_WAIT_L(0); PG8_BAR; PG8_MMA(1, 0, At, B0); PG8_MMA(1, 1, At, B1); PG8_BAR; PG8_SCHED;
            PG8_LDB(B0, 1, 0); PG8_LDB(B1, 1, 1); PG8_SCHED; PG8_LDA(At, 1, 0); PG8_STAGE(PG8_SA(0, 1), a2 + hstep, voffA);
            PG8_WAIT_V(8); PG8_WAIT_L(0); PG8_BAR; PG8_MMA(0, 0, At, B0); PG8_MMA(0, 1, At, B1); PG8_BAR; PG8_SCHED;
            PG8_LDA(At, 1, 1); PG8_STAGE(PG8_SB(1, 0), b3, voffB); PG8_STAGE(PG8_SB(1, 1), b3 + hstep, voffB); PG8_STAGE(PG8_SA(1, 0), a3, voffA);
            PG8_WAIT_V(8); PG8_WAIT_L(0); PG8_BAR; PG8_MMA(1, 0, At, B0); PG8_MMA(1, 1, At, B1); PG8_BAR; PG8_SCHED;
            } else {
            PG8_LDB(B0, 0, 0); PG8_SCHED; PG8_LDA(At, 0, 0); PG8_STAGE(PG8_SA(1, 1), a1 + hstep, voffA);
            PG8_WAIT_L(8); PG8_BAR; PG8_WAIT_L(0); PG8_MMA(0, 0, At, B0); PG8_BAR; PG8_SCHED;
            PG8_LDB(B1, 0, 1); PG8_STAGE(PG8_SB(0, 0), b2, voffB);
            PG8_BAR; PG8_WAIT_L(0); PG8_MMA(0, 1, At, B1); PG8_BAR;
            PG8_LDA(At, 0, 1); PG8_STAGE(PG8_SA(0, 0), a2, voffA);
            PG8_BAR; PG8_WAIT_L(0); PG8_MMA(1, 0, At, B0); PG8_BAR; PG8_SCHED;
            PG8_STAGE(PG8_SB(0, 1), b2 + hstep, voffB);
            PG8_WAIT_V(6); PG8_BAR; PG8_MMA(1, 1, At, B1); PG8_BAR;
            PG8_LDB(B0, 1, 0); PG8_SCHED; PG8_LDA(At, 1, 0); PG8_STAGE(PG8_SA(0, 1), a2 + hstep, voffA);
            PG8_WAIT_L(8); PG8_BAR; PG8_WAIT_L(0); PG8_MMA(0, 0, At, B0); PG8_BAR; PG8_SCHED;
            PG8_LDB(B1, 1, 1); PG8_STAGE(PG8_SB(1, 0), b3, voffB);
            PG8_BAR; PG8_WAIT_L(0); PG8_MMA(0, 1, At, B1); PG8_BAR;
            PG8_LDA(At, 1, 1); PG8_STAGE(PG8_SA(1, 0), a3, voffA);
            PG8_BAR; PG8_WAIT_L(0); PG8_MMA(1, 0, At, B0); PG8_BAR; PG8_SCHED;
            PG8_STAGE(PG8_SB(1, 1), b3 + hstep, voffB);
            PG8_WAIT_V(6); PG8_BAR; PG8_MMA(1, 1, At, B1); PG8_BAR;
            }
        }
        if constexpr (ALIGN_EPI) { if (wr == 0) PG8_BAR; }
        if constexpr (!Epi::AFTER_DRAIN) { E(acc, cur, wr, wc, fr, fq); S.done(cur); }
        if (!has_next) break;
#pragma unroll
        for (int a = 0; a < 2; ++a)
#pragma unroll
            for (int b = 0; b < 2; ++b)
#pragma unroll
                for (int m = 0; m < 4; ++m)
#pragma unroll
                    for (int n = 0; n < 2; ++n) { float z_ = 0.f; asm volatile("" : "+v"(z_)); acc[a][b][m][n] = (f32x4){z_, z_, z_, z_}; }
        cur = nxt; cA = nA; cB = nB; ++ui;
        if constexpr (ALIGN_EPI) { if (wr == 1) PG8_BAR; }
    }
    PG8_WAIT_V(0);
    if constexpr (!ALIGN_EPI) { if (wr == 0) PG8_BAR; }
    PG8_BAR;
    if constexpr (Epi::AFTER_DRAIN) { E.fused(acc, cur, wr, wc, fr, fq, lds, wid, lane); S.done(cur); }
#undef PG8_SA
#undef PG8_SB
#undef PG8_STAGE
#undef PG8_LDA
#undef PG8_LDB
#undef PG8_MMA
#undef PG8_WAIT_V
#undef PG8_WAIT_L
#undef PG8_BAR
#undef PG8_SCHED
}
}
typedef unsigned short bf16_t;
typedef short bf16x8 __attribute__((ext_vector_type(8)));
typedef float f32x4 __attribute__((ext_vector_type(4)));
typedef float f32x16 __attribute__((ext_vector_type(16)));
constexpr int LSEQ = 4112, TREAL = 16384, TG = 16448, TGP = 16640, NGRP = 3;
constexpr size_t SLOT_E = (size_t)TGP * 512;
constexpr size_t SLOT_B = SLOT_E * 2;
constexpr size_t MiB = 1u << 20;
constexpr size_t WS_XMETA = 1 * MiB, WS_DECAY = 2 * MiB, WS_SIDE = 3 * MiB + 512 * 1024, WS_W = 5 * MiB, WS_SLOTS = 53 * MiB;
constexpr size_t WS_NEED = 512 * MiB;
static_assert(WS_SLOTS + 25 * SLOT_B + (size_t)(16448 - 11408) * 8960 <= 512 * MiB, "record tail fits the workspace");
constexpr size_t WO_IN = 0, WO_G = 7864320, WO_BP = 12058624, WO_OUT = 14155776, WO_1 = 15204352, WO_2 = 19398656, WO_LR = 23592960;
constexpr int LDS_BYTES = 140 * 1024;
enum { I_XP = 0, I_XS, I_META, I_NMIX, I_WIN, I_LBL, I_ONORM, I_CONV, I_QN, I_KN, I_LAM, I_SUBLN, I_MU, I_W0, I_W2, I_A0, I_A2, I_G2, I_KK, I_KA, I_RK, I_LNG, I_LNB, I_WG, I_BP, I_WOUT, I_NMLP, I_W1, I_W2M };
struct Params { const float* in[29]; float* out; unsigned char* ws; };
#define GPTR(T, p) ((T*)(__attribute__((address_space(1))) T*)(p))
typedef const __attribute__((address_space(4))) Params* KParamsPtr;
typedef unsigned u32x4g_t __attribute__((ext_vector_type(4)));
#define GLD16(p) (*(const __attribute__((address_space(1))) u32x4g_t*)(p))
DEV KParamsPtr kparams() { KParamsPtr p = (KParamsPtr)__builtin_amdgcn_kernarg_segment_ptr(); asm volatile("" : "+s"(p)); return p; }
DEV Params load_params() { KParamsPtr p = kparams(); Params r;
#pragma unroll
    for (int i = 0; i < 29; ++i) r.in[i] = (const float*)(const __attribute__((address_space(1))) float*)(unsigned long long)p->in[i];
    r.out = (float*)(__attribute__((address_space(1))) float*)(unsigned long long)p->out; r.ws = p->ws; return r; }
DEV unsigned char* launder_ws(unsigned char* p) { __attribute__((address_space(1))) unsigned char* g = (__attribute__((address_space(1))) unsigned char*)(unsigned long long)p; asm volatile("" : "+s"(g)); return (unsigned char*)g; }
DEV unsigned zero_u() { unsigned z = 0u; asm volatile("" : "+v"(z)); return z; }

#define ROWPRO const int tid_ = launder_tid(wv); const int lane = tid_ & 63; const int gw = bid * 8 + __builtin_amdgcn_readfirstlane(tid_ >> 6); const int ngw = nb * 8;
DEV float bf2f(unsigned short u) { return __uint_as_float((unsigned)u << 16); }
DEV unsigned pk2(float lo, float hi) { return pg8::cvt_pk_bf16(lo, hi); }
DEV void unpack8(const uint4 w, float* f) {
    f[0] = __uint_as_float(w.x << 16); f[1] = __uint_as_float(w.x & 0xffff0000u); f[2] = __uint_as_float(w.y << 16); f[3] = __uint_as_float(w.y & 0xffff0000u);
    f[4] = __uint_as_float(w.z << 16); f[5] = __uint_as_float(w.z & 0xffff0000u); f[6] = __uint_as_float(w.w << 16); f[7] = __uint_as_float(w.w & 0xffff0000u); }
DEV uint4 pack8(const float* f) { uint4 o; o.x = pk2(f[0], f[1]); o.y = pk2(f[2], f[3]); o.z = pk2(f[4], f[5]); o.w = pk2(f[6], f[7]); return o; }
DEV bf16_t* slotp(const Params& P, int s) { return GPTR(bf16_t, P.ws + WS_SLOTS + (size_t)s * SLOT_B); }
DEV int row_of(int sl, int p) { return p >= 16 ? sl * 4096 + p - 16 : TREAL + sl * 16 + p; }
DEV void pos_of(int r, int& sl, int& p) { if (r < TREAL) { sl = r >> 12; p = (r & 4095) + 16; } else { const int m = r - TREAL; sl = m >> 4; p = m & 15; } }
DEV float wave_sum(float v) {
#pragma unroll
    for (int o = 1; o < 64; o <<= 1) v += __shfl_xor(v, o);
    return v; }
DEV float red8(float v) { v += __shfl_xor(v, 1); v += __shfl_xor(v, 2); v += __shfl_xor(v, 4); return v; }
DEV f32x4 mfma16(bf16x8 a, bf16x8 b, f32x4 c) { return __builtin_amdgcn_mfma_f32_16x16x32_bf16(a, b, c, 0, 0, 0); }
DEV f32x16 mfma32(bf16x8 a, bf16x8 b, f32x16 c) { return __builtin_amdgcn_mfma_f32_32x32x16_bf16(a, b, c, 0, 0, 0); }
DEV const float* x_in_row(const Params& P, int g, int r) {
    if (r < TREAL) return (g < 2 ? P.in[I_XP] + (size_t)g * TREAL * 1024 : P.in[I_XS]) + (size_t)r * 1024;
    return P.in[I_META] + (size_t)((r - TREAL) & 15) * 1024; }
DEV float* x_cur_row(const Params& P, int g, int r) {
    if (r < TREAL) return P.out + ((size_t)g * TREAL + r) * 1024;
    const int m = r - TREAL;
    return GPTR(float, P.ws + WS_XMETA) + (size_t)(m < 64 ? g * 64 + m : ((m >> 6) - 1) * 64 + (m & 63)) * 1024; }

DEV int gate_row(int n) { const int br = n >> 10, c = n & 1023, pn = c >> 6, oc = c & 63, wc = oc >> 4, fq = (oc >> 2) & 3, i = oc & 3; return pn * 256 + (br >> 1) * 128 + wc * 32 + fq * 8 + (br & 1) * 4 + i; }
template <int MODE> DEV void wt_items(const float* __restrict__ W, int K, int N, bf16_t* WT, int row_off, float* scr, int gw, int ngw, int lane) {
    const int nblk = N >> 5, items = (K >> 6) * nblk;
    for (int it = gw; it < items; it += ngw) {
        const int kb = it / nblk, nbk = it - kb * nblk, k0 = 64 * kb, n0 = 32 * nbk;
#pragma unroll 8
        for (int i = 0; i < 32; ++i) { const int kk = 2 * i + (lane >> 5); scr[kk * 33 + (lane & 31)] = W[(size_t)(k0 + kk) * N + n0 + (lane & 31)]; }
        asm volatile("s_waitcnt lgkmcnt(0)" ::: "memory");
        const int c = lane & 7;
#pragma unroll
        for (int j = 0; j < 4; ++j) { const int n = (lane >> 3) + 8 * j; const float* sp = scr + (8 * c) * 33 + n;
            uint4 o; o.x = pk2(sp[0 * 33], sp[1 * 33]); o.y = pk2(sp[2 * 33], sp[3 * 33]); o.z = pk2(sp[4 * 33], sp[5 * 33]); o.w = pk2(sp[6 * 33], sp[7 * 33]);
            const int dr = MODE == 1 ? gate_row(n0 + n) : n0 + n + row_off;
            *(uint4*)(WT + (size_t)dr * K + k0 + 8 * c) = o; }
        asm volatile("s_waitcnt lgkmcnt(0)" ::: "memory");
    }
}
DEV void phase_weights(const Params& P0, int layer, unsigned char* lds, int bid, int nb, int wv) {
    Params P = load_params(); P.ws = launder_ws(P.ws);
    const int tid = launder_tid(wv), lane = tid & 63, w = __builtin_amdgcn_readfirstlane(tid >> 6);
    const int gtid = bid * 512 + tid, gth = nb * 512, gw = bid * 8 + w, ngw = nb * 8;
    float* scr = (float*)(lds + w * 8448);
    bf16_t* W = GPTR(bf16_t, P.ws + WS_W);
    wt_items<0>(P.in[I_WIN] + (size_t)layer * 1024 * 7552, 1024, 7552, W + WO_IN, 0, scr, gw, ngw, lane);
    for (int it = gtid; it < 128 * 128; it += gth) { const unsigned z = zero_u(); *(uint4*)(W + WO_IN + (size_t)7552 * 1024 + (size_t)it * 8) = make_uint4(z, z, z, z); }
    wt_items<1>(P.in[I_WG] + (size_t)layer * 1024 * 4096, 1024, 4096, W + WO_G, 0, scr, gw, ngw, lane);
    for (int n = 0; n < 4; ++n) wt_items<0>(P.in[I_BP] + (size_t)(layer * 4 + n) * 512 * 1024, 512, 1024, W + WO_BP, n * 1024, scr, gw, ngw, lane);
    wt_items<0>(P.in[I_WOUT] + (size_t)layer * 1024 * 1024, 1024, 1024, W + WO_OUT, 0, scr, gw, ngw, lane);
    wt_items<0>(P.in[I_W1] + (size_t)layer * 1024 * 4096, 1024, 4096, W + WO_1, 0, scr, gw, ngw, lane);
    wt_items<0>(P.in[I_W2M] + (size_t)layer * 4096 * 1024, 4096, 1024, W + WO_2, 0, scr, gw, ngw, lane);
    for (int it = gtid; it < 2560 * 48; it += gth) {
        const int row = it / 48, k8 = it - row * 48, seg = row >> 9, c = row & 511, k0 = k8 * 8;
        float v[8];
#pragma unroll
        for (int j = 0; j < 8; ++j) { const int k = k0 + j; float x = 0.f;
            if (seg == 0) { if (k < 64) x = P.in[I_W2][((size_t)(layer * 2 + 0) * 64 + k) * 512 + c]; }
            else if (seg == 1) { if (k >= 64 && k < 128) x = P.in[I_W2][((size_t)(layer * 2 + 1) * 64 + (k - 64)) * 512 + c]; }
            else if (seg == 2) { if (k >= 128 && k < 192) x = P.in[I_A2][((size_t)(layer * 2 + 0) * 64 + (k - 128)) * 512 + c]; }
            else if (seg == 3) { if (k >= 192 && k < 256) x = P.in[I_A2][((size_t)(layer * 2 + 1) * 64 + (k - 192)) * 512 + c]; }
            else { if (k >= 256) x = P.in[I_G2][((size_t)layer * 128 + (k - 256)) * 512 + c]; }
            v[j] = x; }
        *(uint4*)(W + WO_LR + (size_t)row * 384 + k0) = pack8(v);
    }
}

DEV void phase_rmsnorm(const Params& P0, int g, bool src_in, int gain_idx, int layer, int nrows, int nvalid, int bid, int nb, int wv) {
    Params P = load_params(); P.ws = launder_ws(P.ws);
    ROWPRO
    const float* gain = P.in[gain_idx] + layer * 1024;
    bf16_t* H = slotp(P, 0);
    for (int r = gw; r < nrows; r += ngw) {
        uint2* o8 = (uint2*)(H + (size_t)r * 1024) + lane;
        if (r >= nvalid) {
#pragma unroll
            for (int j = 0; j < 4; ++j) { const unsigned z = zero_u(); o8[64 * j] = make_uint2(z, z); }
            continue; }
        const f32x4* xr = (const f32x4*)(src_in ? x_in_row(P, g, r) : (const float*)x_cur_row(P, g, r)) + lane;
        f32x4 v[4]; float s = 0.f;
#pragma unroll
        for (int j = 0; j < 4; ++j) { v[j] = xr[64 * j]; s += (v[j].x * v[j].x + v[j].y * v[j].y) + (v[j].z * v[j].z + v[j].w * v[j].w); }
        const float rs = rsqrtf(wave_sum(s) * (1.f / 1024.f) + 1e-6f);
#pragma unroll
        for (int j = 0; j < 4; ++j) { const f32x4 gg = *((const f32x4*)gain + lane + 64 * j);
            o8[64 * j] = make_uint2(pk2(v[j].x * rs * gg.x, v[j].y * rs * gg.y), pk2(v[j].z * rs * gg.z, v[j].w * rs * gg.w)); }
    }
}
DEV void phase_da_prep(const Params& P0, int layer, int bid, int nb, int wv) {
    Params P = load_params(); P.ws = launder_ws(P.ws);
    ROWPRO
    const float inv8[8] = {1.0f, 0.19392274474868576f, 0.03760603093086393f, 0.007292664737217109f, 0.001414213562373095f, 0.0002742481756762073f, 5.318295896944988e-05f, 1.031338537721246e-05f};
    const int d0 = (lane & 7) * 8;
    float gq[8], gk[8];
#pragma unroll
    for (int j = 0; j < 8; ++j) { gq[j] = P.in[I_QN][layer * 64 + d0 + j]; gk[j] = P.in[I_KN][layer * 64 + d0 + j]; }
    for (int r = gw; r < TG; r += ngw) {
        int sl, p; pos_of(r, sl, p);
        float cs[8], sn[8];
#pragma unroll
        for (int j = 0; j < 8; ++j) { const float ang = (float)p * inv8[j]; double a = (double)ang; a -= 6.283185307179586 * __builtin_rint(a * 0.15915494309189535); const float rr = (float)a; cs[j] = __cosf(rr); sn[j] = __sinf(rr); }
#pragma unroll
        for (int which = 0; which < 2; ++which) {
            uint4* ptr = (uint4*)(slotp(P, 10 + which) + (size_t)r * 512) + lane;
            float f[8]; unpack8(*ptr, f);
            float ss = 0.f;
#pragma unroll
            for (int j = 0; j < 8; ++j) ss += f[j] * f[j];
            ss = red8(ss);
            const float rs = rsqrtf(ss * (1.f / 64.f) + 1e-6f);
#pragma unroll
            for (int j = 0; j < 8; ++j) f[j] = f[j] * rs * (which == 0 ? gq[j] : gk[j]);
#pragma unroll
            for (int j = 0; j < 8; ++j) { const float pr = __shfl_xor(f[j], 1);
                if ((lane & 7) == 0) f[j] = f[j] * cs[j] - pr * sn[j];
                else if ((lane & 7) == 1) f[j] = f[j] * cs[j] + pr * sn[j]; }
            if (which == 0) {
#pragma unroll
                for (int j = 0; j < 8; ++j) f[j] *= 0.18033688011112042f; }
            *ptr = pack8(f);
        }
    }
}
DEV void phase_conv(const Params& P0, int layer, int bid, int nb, int wv) {
    Params P = load_params(); P.ws = launder_ws(P.ws);
    ROWPRO
    const int c0 = lane * 8;
    float w0[8], w1[8], w2[8];
#pragma unroll
    for (int j = 0; j < 8; ++j) { w0[j] = P.in[I_CONV][(layer * 3 + 0) * 512 + c0 + j]; w1[j] = P.in[I_CONV][(layer * 3 + 1) * 512 + c0 + j]; w2[j] = P.in[I_CONV][(layer * 3 + 2) * 512 + c0 + j]; }
    const bf16_t* SB = slotp(P, 7); const bf16_t* SC = slotp(P, 8); const bf16_t* SH = slotp(P, 9); bf16_t* Y = slotp(P, 3);
    for (int r = gw; r < TG; r += ngw) {
        int sl, p; pos_of(r, sl, p);
        float acc[8], a[8], b[8];
        unpack8(*((const uint4*)(SC + (size_t)r * 512) + lane), a); unpack8(*((const uint4*)(SH + (size_t)r * 512) + lane), b);
#pragma unroll
        for (int j = 0; j < 8; ++j) acc[j] = a[j] * b[j] * w1[j];
        if (p > 0) { const int rp = row_of(sl, p - 1);
            unpack8(*((const uint4*)(SC + (size_t)rp * 512) + lane), a); unpack8(*((const uint4*)(SH + (size_t)rp * 512) + lane), b);
#pragma unroll
            for (int j = 0; j < 8; ++j) acc[j] += a[j] * b[j] * w0[j]; }
        if (p < LSEQ - 1) { const int rn = row_of(sl, p + 1);
            unpack8(*((const uint4*)(SC + (size_t)rn * 512) + lane), a); unpack8(*((const uint4*)(SH + (size_t)rn * 512) + lane), b);
#pragma unroll
            for (int j = 0; j < 8; ++j) acc[j] += a[j] * b[j] * w2[j]; }
        unpack8(*((const uint4*)(SB + (size_t)r * 512) + lane), a);
#pragma unroll
        for (int j = 0; j < 8; ++j) acc[j] *= a[j];
        *((uint4*)(Y + (size_t)r * 512) + lane) = pack8(acc);
    }
}
DEV void phase_rw_prep(const Params& P0, int layer, int bid, int nb, int wv) {
    Params P = load_params(); P.ws = launder_ws(P.ws);
    ROWPRO
    const float* mu = P.in[I_MU] + (size_t)layer * 1920;
    for (int r = gw; r < TG; r += ngw) {
        int sl, p; pos_of(r, sl, p);
        const int rp = p > 0 ? row_of(sl, p - 1) : -1, rn = p < LSEQ - 1 ? row_of(sl, p + 1) : -1;
#pragma unroll
        for (int grp = 0; grp < 4; ++grp) {
            if (grp == 3 && lane >= 48) break;
            const int c0 = (grp < 3 ? grp * 512 : 1536) + lane * 8;
            const bf16_t* src = slotp(P, 13 + (c0 >> 9)) + (c0 & 511);
            float u[8], up[8], un[8], xm[8];
            unpack8(*(const uint4*)(src + (size_t)r * 512), u);
            if (rp >= 0) unpack8(*(const uint4*)(src + (size_t)rp * 512), up); else {
#pragma unroll
                for (int j = 0; j < 8; ++j) up[j] = 0.f; }
            if (rn >= 0) unpack8(*(const uint4*)(src + (size_t)rn * 512), un); else {
#pragma unroll
                for (int j = 0; j < 8; ++j) un[j] = 0.f; }
#pragma unroll
            for (int j = 0; j < 8; ++j) xm[j] = u[j] + mu[c0 + j] * (0.5f * (up[j] + un[j]) - u[j]);
            if (grp < 3) {
                *((uint4*)(slotp(P, 17 + grp) + (size_t)r * 512) + lane) = pack8(xm);
                if (grp == 1) {
                    float kk[8], ss = 0.f;
#pragma unroll
                    for (int j = 0; j < 8; ++j) { kk[j] = xm[j] * P.in[I_KK][layer * 512 + c0 - 512 + j]; ss += kk[j] * kk[j]; }
                    ss = red8(ss);
                    const float inv = 1.0f / fmaxf(sqrtf(ss), 1e-12f);
#pragma unroll
                    for (int j = 0; j < 8; ++j) kk[j] *= inv;
                    *((uint4*)(slotp(P, 20) + (size_t)r * 512) + lane) = pack8(kk); }
            } else {
                const int a0 = lane * 8;
                float o[8];
#pragma unroll
                for (int j = 0; j < 8; ++j) { const float x = xm[j];
                    if (a0 < 128) { const float e = __expf(2.f * x); o[j] = 1.f - 2.f / (e + 1.f); }
                    else if (a0 < 256) o[j] = x;
                    else o[j] = 1.f / (1.f + __expf(-x)); }
                *((uint4*)(slotp(P, 21) + (size_t)r * 384) + lane) = pack8(o);
            }
        }
    }
    for (int r = TG + gw; r < TGP; r += ngw) if (lane < 48) { const unsigned z = zero_u(); *((uint4*)(slotp(P, 21) + (size_t)r * 384) + lane) = make_uint4(z, z, z, z); }
}
DEV void phase_rw_post(const Params& P0, int layer, int g, int nrows, int bid, int nb, int wv) {
    Params P = load_params(); P.ws = launder_ws(P.ws);
    ROWPRO
    const int c0 = lane * 8;
    float ka[8], rk[8], lg[8], lb[8];
#pragma unroll
    for (int j = 0; j < 8; ++j) { ka[j] = P.in[I_KA][layer * 512 + c0 + j]; rk[j] = P.in[I_RK][layer * 512 + c0 + j]; lg[j] = P.in[I_LNG][layer * 512 + c0 + j]; lb[j] = P.in[I_LNB][layer * 512 + c0 + j]; }
    for (int r = gw; r < nrows; r += ngw) {
        float of[8], ob[8], o[8];
        unpack8(*((const uint4*)(slotp(P, 15) + (size_t)r * 512) + lane), of); unpack8(*((const uint4*)(slotp(P, 16) + (size_t)r * 512) + lane), ob);
        float s = 0.f;
#pragma unroll
        for (int j = 0; j < 8; ++j) { o[j] = of[j] + ob[j]; s += o[j]; }
        const float mean = red8(s) * (1.f / 64.f);
        float q = 0.f;
#pragma unroll
        for (int j = 0; j < 8; ++j) { o[j] -= mean; q += o[j] * o[j]; }
        const float rs = rsqrtf(red8(q) * (1.f / 64.f) + 64e-5f);
        float rr[8], kk[8], vv[8], af[8], ab[8], gg[8];
        unpack8(*((const uint4*)(slotp(P, 17) + (size_t)r * 512) + lane), rr); unpack8(*((const uint4*)(slotp(P, 18) + (size_t)r * 512) + lane), kk);
        unpack8(*((const uint4*)(slotp(P, 19) + (size_t)r * 512) + lane), vv); unpack8(*((const uint4*)(slotp(P, 24) + (size_t)r * 512) + lane), af);
        unpack8(*((const uint4*)(slotp(P, 13) + (size_t)r * 512) + lane), ab); unpack8(*((const uint4*)(slotp(P, 14) + (size_t)r * 512) + lane), gg);
        float bs = 0.f;
#pragma unroll
        for (int j = 0; j < 8; ++j) { const float kd = kk[j] * (2.f + (af[j] + ab[j] - 2.f) * ka[j]); bs += rr[j] * kd * rk[j]; }
        bs = red8(bs);
        float y[8];
#pragma unroll
        for (int j = 0; j < 8; ++j) y[j] = (o[j] * rs * lg[j] + lb[j] + bs * vv[j]) * gg[j];
        const uint4 yv = pack8(y);
        *((uint4*)(slotp(P, 5) + (size_t)r * 512) + lane) = yv;
        if (layer == 0 && g < 2 && r >= TREAL) {
            bf16_t* sd = GPTR(bf16_t, P.ws + WS_SIDE) + (size_t)g * 4 * 64 * 512 + (size_t)(r - TREAL) * 512;
#pragma unroll
            for (int k = 0; k < 3; ++k) *((uint4*)(sd + (size_t)k * 64 * 512) + lane) = *((const uint4*)(slotp(P, 2 + k) + (size_t)r * 512) + lane);
            *((uint4*)(sd + (size_t)3 * 64 * 512) + lane) = yv; }
    }
    if (layer == 0 && g == 2) {
        for (int m2 = gw; m2 < 128; m2 += ngw) { const bf16_t* sd = GPTR(const bf16_t, P.ws + WS_SIDE) + (size_t)(m2 >> 6) * 4 * 64 * 512 + (size_t)(m2 & 63) * 512;
#pragma unroll
            for (int k = 0; k < 4; ++k) *((uint4*)(slotp(P, 2 + k) + (size_t)(TG + m2) * 512) + lane) = *((const uint4*)(sd + (size_t)k * 64 * 512) + lane); }
    }
}
DEV void hg_gate(float x, float lbv, float& lg, float& kk) {
    const float e = __expf(-fabsf(x)); const float sp = 1.f / (1.f + e);
    const float s = x >= 0.f ? sp : e * sp, s1 = x >= 0.f ? e * sp : sp;
    const float f = fmaxf(lbv, 1e-20f) + (1.f - lbv) * s;
    lg = __logf(f); kk = (1.f - lbv) * s1; }
DEV float hg_lb(const Params& P, int layer, int dir, int col) {
    if (layer == 0) return 0.f;
    const float a = P.in[I_LBL][(dir * 2 + 0) * 512 + col], b = P.in[I_LBL][(dir * 2 + 1) * 512 + col];
    return 1.f / (1.f + __expf(a - b)); }
DEV int hg_row(int sl, int c, int j, bool& valid) { if (c == 0) { valid = j < 16; return TREAL + sl * 16 + j; } valid = true; return sl * 4096 + (c - 1) * 64 + j; }
DEV void hg_cumsum(float* Lb, float* Bt, float* Seg, int dir, int tid) {
    const int ch = tid & 127, seg = tid >> 7;
    float v[16];
#pragma unroll
    for (int i = 0; i < 16; ++i) v[i] = Lb[(seg * 16 + i) * 128 + ch];
    if (dir == 0) {
#pragma unroll
        for (int i = 1; i < 16; ++i) v[i] += v[i - 1];
        Seg[seg * 128 + ch] = v[15];
    } else {
#pragma unroll
        for (int i = 14; i >= 0; --i) v[i] += v[i + 1];
        Seg[seg * 128 + ch] = v[0];
    }
    __syncthreads();
    const float s0 = Seg[ch], s1 = Seg[128 + ch], s2 = Seg[256 + ch], s3 = Seg[384 + ch];
    float off;
    if (dir == 0) off = seg == 0 ? 0.f : seg == 1 ? s0 : seg == 2 ? s0 + s1 : s0 + s1 + s2;
    else off = seg == 3 ? 0.f : seg == 2 ? s3 : seg == 1 ? s3 + s2 : s3 + s2 + s1;
#pragma unroll
    for (int i = 0; i < 16; ++i) Lb[(seg * 16 + i) * 128 + ch] = v[i] + off;
    if (seg == 0) Bt[ch] = (s0 + s1) + (s2 + s3);
}
DEV void phase_hg1(const Params& P0, int layer, unsigned char* lds, int bid, int nb, int wv) {
    Params P = load_params(); P.ws = launder_ws(P.ws);
    float* Lb = (float*)lds; bf16_t* KlT = (bf16_t*)(lds + 32768); bf16_t* VT = (bf16_t*)(lds + 32768 + 18432); float* Bt = (float*)(lds + 69632); float* Seg = (float*)(lds + 70656);
    bf16_t* X = slotp(P, 17); float* DC = GPTR(float, P.ws + WS_DECAY);
    const int tid = launder_tid(wv), lane = tid & 63, w = __builtin_amdgcn_readfirstlane(tid >> 6), j = tid >> 3, c0 = (tid & 7) * 16, l15 = lane & 15, quad = lane >> 4;
    for (int unit = bid; unit < 32 * 65; unit += nb) {
        const int chain = unit / 65, c = unit - chain * 65, sl = chain >> 3, head = (chain >> 1) & 3, dir = chain & 1;
        bool valid; const int r = hg_row(sl, c, j, valid);
        float lg[16], kk[16]; uint4 vv[2] = {make_uint4(0, 0, 0, 0), make_uint4(0, 0, 0, 0)};
        if (valid) {
            float fr[16];
            const uint4* fp = (const uint4*)(slotp(P, 3 + dir) + (size_t)r * 512 + head * 128 + c0);
            unpack8(fp[0], fr); unpack8(fp[1], fr + 8);
            const uint4* vp = (const uint4*)(slotp(P, 5) + (size_t)r * 512 + head * 128 + c0); vv[0] = vp[0]; vv[1] = vp[1];
#pragma unroll
            for (int e = 0; e < 16; ++e) hg_gate(fr[e], hg_lb(P, layer, dir, head * 128 + c0 + e), lg[e], kk[e]);
        } else {
#pragma unroll
            for (int e = 0; e < 16; ++e) { lg[e] = 0.f; kk[e] = 0.f; } }
#pragma unroll
        for (int e = 0; e < 16; e += 4) *(f32x4*)(Lb + j * 128 + c0 + e) = (f32x4){lg[e], lg[e + 1], lg[e + 2], lg[e + 3]};
        __syncthreads();
        hg_cumsum(Lb, Bt, Seg, dir, tid);
        __syncthreads();
        float vf[16]; unpack8(vv[0], vf); unpack8(vv[1], vf + 8);
#pragma unroll
        for (int e = 0; e < 16; ++e) { const float kl = kk[e] * __expf(Bt[c0 + e] - Lb[j * 128 + c0 + e]);
            KlT[(c0 + e) * 72 + j] = (bf16_t)(pk2(kl, 0.f) & 0xffffu); VT[(c0 + e) * 72 + j] = (bf16_t)(__float_as_uint(vf[e]) >> 16); }
        if (tid < 128) DC[(size_t)(chain * 65 + c) * 128 + tid] = __expf(Bt[tid]);
        __syncthreads();
        f32x4 acc[8];
#pragma unroll
        for (int ct = 0; ct < 8; ++ct) acc[ct] = (f32x4){0.f, 0.f, 0.f, 0.f};
#pragma unroll
        for (int ks = 0; ks < 2; ++ks) { const bf16x8 a = *(const bf16x8*)(VT + (w * 16 + l15) * 72 + ks * 32 + quad * 8);
#pragma unroll
            for (int ct = 0; ct < 8; ++ct) { const bf16x8 b = *(const bf16x8*)(KlT + (ct * 16 + l15) * 72 + ks * 32 + quad * 8); acc[ct] = mfma16(b, a, acc[ct]); } }
        bf16_t* xo = X + (size_t)(chain * 65 + c) * 16384;
#pragma unroll
        for (int ct = 0; ct < 8; ++ct) *(uint2*)(xo + (w * 16 + l15) * 128 + ct * 16 + quad * 4) = make_uint2(pk2(acc[ct][0], acc[ct][1]), pk2(acc[ct][2], acc[ct][3]));
        __syncthreads();
    }
}
DEV void phase_hg2(const Params& P0, int bid, int nb, int wv) {
    Params P = load_params(); P.ws = launder_ws(P.ws);
    const int gtid = bid * 512 + launder_tid(wv), gth = nb * 512;
    uint2* X = (uint2*)slotp(P, 17); const f32x4* DC = GPTR(const f32x4, P.ws + WS_DECAY);
    for (int e = gtid; e < 32 * 4096; e += gth) {
        const int chain = e >> 12, e4 = e & 4095, dir = chain & 1;
        f32x4 S = (f32x4){0.f, 0.f, 0.f, 0.f};
#pragma unroll 5
        for (int step = 0; step < 65; ++step) { const int c = dir ? 64 - step : step;
            const size_t idx = (size_t)(chain * 65 + c) * 4096 + e4;
            const uint2 kvw = X[idx]; const f32x4 dc = DC[(size_t)(chain * 65 + c) * 32 + (e4 & 31)];
            const f32x4 kv = (f32x4){__uint_as_float(kvw.x << 16), __uint_as_float(kvw.x & 0xffff0000u), __uint_as_float(kvw.y << 16), __uint_as_float(kvw.y & 0xffff0000u)};
            X[idx] = make_uint2(pk2(S[0], S[1]), pk2(S[2], S[3])); S = dc * S + kv; }
    }
}
DEV void phase_hg3(const Params& P0, int layer, unsigned char* lds, int bid, int nb, int wv) {
    Params P = load_params(); P.ws = launder_ws(P.ws);
    float* Lb = (float*)lds; bf16_t* Qs = (bf16_t*)(lds + 32768); bf16_t* Ks = (bf16_t*)(lds + 50176); bf16_t* Am = (bf16_t*)(lds + 67584);
    bf16_t* VT = (bf16_t*)(lds + 76800); bf16_t* Sb = (bf16_t*)(lds + 95232); float* Bt = (float*)(lds + 130048); float* Seg = (float*)(lds + 132096); float* Ost = (float*)lds;
    const bf16_t* X = slotp(P, 17);
    const int tid = launder_tid(wv), lane = tid & 63, w = __builtin_amdgcn_readfirstlane(tid >> 6), j = tid >> 3, c0 = (tid & 7) * 16, l15 = lane & 15, quad = lane >> 4;
    const int tt = w >> 1, st0 = (w & 1) * 2, vt0 = (w & 1) * 4;
    const int cfirst = layer == 0 ? 0 : 1;
    const int ncb = 65 - cfirst;
    for (int unit = bid; unit < 16 * ncb; unit += nb) {
        const int sh = unit / ncb, c = unit - sh * ncb + cfirst, sl = sh >> 2, head = sh & 3;
        bool valid; const int r = hg_row(sl, c, j, valid);
        float q[16]; uint4 gv[2] = {make_uint4(0, 0, 0, 0), make_uint4(0, 0, 0, 0)};
        if (valid) {
            const uint4* qp = (const uint4*)(slotp(P, 2) + (size_t)r * 512 + head * 128 + c0); unpack8(qp[0], q); unpack8(qp[1], q + 8);
            const uint4* vp = (const uint4*)(slotp(P, 5) + (size_t)r * 512 + head * 128 + c0); float vf[16]; unpack8(vp[0], vf); unpack8(vp[1], vf + 8);
#pragma unroll
            for (int e = 0; e < 16; ++e) VT[(c0 + e) * 72 + j] = (bf16_t)(__float_as_uint(vf[e]) >> 16);
            const uint4* gp = (const uint4*)(slotp(P, 6) + (size_t)r * 512 + head * 128 + c0); gv[0] = gp[0]; gv[1] = gp[1];
        } else {
#pragma unroll
            for (int e = 0; e < 16; ++e) { q[e] = 0.f; VT[(c0 + e) * 72 + j] = 0; } }
        f32x4 accA[2], accO[4];
#pragma unroll
        for (int i = 0; i < 2; ++i) accA[i] = (f32x4){0.f, 0.f, 0.f, 0.f};
#pragma unroll
        for (int i = 0; i < 4; ++i) accO[i] = (f32x4){0.f, 0.f, 0.f, 0.f};
#pragma unroll 1
        for (int dir = 0; dir < 2; ++dir) {
            float lg[16], kk[16];
            if (valid) { float fr[16];
                const uint4* fp = (const uint4*)(slotp(P, 3 + dir) + (size_t)r * 512 + head * 128 + c0); unpack8(fp[0], fr); unpack8(fp[1], fr + 8);
#pragma unroll
                for (int e = 0; e < 16; ++e) hg_gate(fr[e], hg_lb(P, layer, dir, head * 128 + c0 + e), lg[e], kk[e]);
            } else {
#pragma unroll
                for (int e = 0; e < 16; ++e) { lg[e] = 0.f; kk[e] = 0.f; } }
#pragma unroll
            for (int e = 0; e < 16; e += 4) *(f32x4*)(Lb + j * 128 + c0 + e) = (f32x4){lg[e], lg[e + 1], lg[e + 2], lg[e + 3]};
            __syncthreads();
            hg_cumsum(Lb, Bt, Seg, dir, tid);
            __syncthreads();
            {
                float qs[16], ks[16];
#pragma unroll
                for (int e = 0; e < 16; ++e) { const float b = Lb[j * 128 + c0 + e], rf = Lb[32 * 128 + c0 + e]; qs[e] = q[e] * __expf(b - rf); ks[e] = kk[e] * __expf(rf - b); }
                *(uint4*)(Qs + j * 136 + c0) = pack8(qs); *(uint4*)(Qs + j * 136 + c0 + 8) = pack8(qs + 8);
                *(uint4*)(Ks + j * 136 + c0) = pack8(ks); *(uint4*)(Ks + j * 136 + c0 + 8) = pack8(ks + 8);
            }
            {
                const int chain = sl * 8 + head * 2 + dir; const uint4* xs = (const uint4*)(X + (size_t)(chain * 65 + c) * 16384 + (size_t)(tid >> 2) * 128 + (tid & 3) * 32);
#pragma unroll
                for (int i = 0; i < 4; ++i) *(uint4*)(Sb + (tid >> 2) * 136 + (tid & 3) * 32 + i * 8) = xs[i];
            }
            __syncthreads();
            {
                f32x4 t0 = (f32x4){0.f, 0.f, 0.f, 0.f}, t1 = t0;
#pragma unroll
                for (int k4 = 0; k4 < 4; ++k4) { const bf16x8 a = *(const bf16x8*)(Qs + (tt * 16 + l15) * 136 + k4 * 32 + quad * 8);
                    const bf16x8 b0 = *(const bf16x8*)(Ks + ((st0 + 0) * 16 + l15) * 136 + k4 * 32 + quad * 8); const bf16x8 b1 = *(const bf16x8*)(Ks + ((st0 + 1) * 16 + l15) * 136 + k4 * 32 + quad * 8);
                    t0 = mfma16(a, b0, t0); t1 = mfma16(a, b1, t1); }
#pragma unroll
                for (int jj = 0; jj < 4; ++jj) { const int t = tt * 16 + quad * 4 + jj, s0 = (st0 + 0) * 16 + l15, s1 = (st0 + 1) * 16 + l15;
                    const bool k0 = dir == 0 ? s0 <= t : s0 >= t, k1 = dir == 0 ? s1 <= t : s1 >= t;
                    accA[0][jj] += k0 ? t0[jj] : 0.f; accA[1][jj] += k1 ? t1[jj] : 0.f; }
            }
            __syncthreads();
            {   float qg[16];
#pragma unroll
                for (int e = 0; e < 16; ++e) qg[e] = q[e] * __expf(Lb[j * 128 + c0 + e]);
                *(uint4*)(Qs + j * 136 + c0) = pack8(qg); *(uint4*)(Qs + j * 136 + c0 + 8) = pack8(qg + 8); }
            __syncthreads();
#pragma unroll
            for (int k4 = 0; k4 < 4; ++k4) { const bf16x8 a = *(const bf16x8*)(Qs + (tt * 16 + l15) * 136 + k4 * 32 + quad * 8);
#pragma unroll
                for (int v4 = 0; v4 < 4; ++v4) { const bf16x8 b = *(const bf16x8*)(Sb + ((vt0 + v4) * 16 + l15) * 136 + k4 * 32 + quad * 8); accO[v4] = mfma16(a, b, accO[v4]); } }
            __syncthreads();
        }
#pragma unroll
        for (int s2 = 0; s2 < 2; ++s2)
#pragma unroll
            for (int jj = 0; jj < 4; ++jj) Am[(tt * 16 + quad * 4 + jj) * 72 + (st0 + s2) * 16 + l15] = (bf16_t)(pk2(accA[s2][jj], 0.f) & 0xffffu);
        __syncthreads();
#pragma unroll
        for (int ks = 0; ks < 2; ++ks) { const bf16x8 a = *(const bf16x8*)(Am + (tt * 16 + l15) * 72 + ks * 32 + quad * 8);
#pragma unroll
            for (int v4 = 0; v4 < 4; ++v4) { const bf16x8 b = *(const bf16x8*)(VT + ((vt0 + v4) * 16 + l15) * 72 + ks * 32 + quad * 8); accO[v4] = mfma16(a, b, accO[v4]); } }
#pragma unroll
        for (int v4 = 0; v4 < 4; ++v4)
#pragma unroll
            for (int jj = 0; jj < 4; ++jj) Ost[(tt * 16 + quad * 4 + jj) * 132 + (vt0 + v4) * 16 + l15] = accO[v4][jj];
        __syncthreads();
        {   float o[16], ss = 0.f;
#pragma unroll
            for (int e = 0; e < 16; ++e) { o[e] = Ost[j * 132 + c0 + e]; ss += o[e] * o[e]; }
            ss = red8(ss);
            const float rs = rsqrtf(ss * (1.f / 128.f) + 1e-6f);
            float gf[16]; unpack8(gv[0], gf); unpack8(gv[1], gf + 8);
#pragma unroll
            for (int e = 0; e < 16; ++e) { const float gg = gf[e]; o[e] = o[e] * rs * P.in[I_ONORM][layer * 512 + head * 128 + c0 + e] * (gg / (1.f + __expf(-gg))); }
            if (valid) { uint4* yp = (uint4*)(slotp(P, 2) + (size_t)r * 512 + head * 128 + c0); yp[0] = pack8(o); yp[1] = pack8(o + 8); }
        }
        __syncthreads();
    }
}
DEV void phase_vtrans(const Params& P0, unsigned char* lds, int bid, int nb, int wv) {
    Params P = load_params(); P.ws = launder_ws(P.ws);
    bf16_t* T = (bf16_t*)lds;
    const bf16_t* V = slotp(P, 12); bf16_t* VTg = slotp(P, 6);
    const int tid = launder_tid(wv);
    for (int unit = bid; unit < 4 * 65 * 8; unit += nb) {
        const int sl = unit / 520, rem = unit - sl * 520, pt = rem >> 3, vdt = rem & 7;
        { const int tok = tid >> 3, c8 = (tid & 7) * 8, p = pt * 64 + tok;
          uint4 v = make_uint4(0, 0, 0, 0);
          if (p < LSEQ) v = *(const uint4*)(V + (size_t)row_of(sl, p) * 512 + vdt * 64 + c8);
          *(uint4*)(T + tok * 72 + c8) = v; }
        __syncthreads();
        { const int vd = tid >> 3, t8 = (tid & 7) * 8;
          unsigned short e[8];
#pragma unroll
          for (int i = 0; i < 8; ++i) { const int pp = t8 + i; const int sp = (pp & ~12) | (((pp >> 2) & 1) << 3) | (((pp >> 3) & 1) << 2); e[i] = T[sp * 72 + vd]; }
          uint4 o; o.x = e[0] | ((unsigned)e[1] << 16); o.y = e[2] | ((unsigned)e[3] << 16); o.z = e[4] | ((unsigned)e[5] << 16); o.w = e[6] | ((unsigned)e[7] << 16);
          *(uint4*)(VTg + (size_t)(sl * 512 + vdt * 64 + vd) * 4160 + pt * 64 + t8) = o; }
        __syncthreads();
    }
}
DEV int crow(int r, int hi) { return (r & 3) + 8 * (r >> 2) + 4 * hi; }
typedef unsigned u32x4_t __attribute__((ext_vector_type(4)));
struct AttnStage { u32x4_t k0, k1, v0, v1; };
DEV void attn_stage_load(const Params& P, int sl, int head, int kt, int tid, AttnStage& st) {
    const bf16_t* Kg = slotp(P, 11); const bf16_t* VTg = slotp(P, 6);
    { const int ci = tid, krow = ci >> 4, kc = ci & 15; const int p = kt * 64 + krow; const int r = p < LSEQ ? row_of(sl, p) : 0; st.k0 = GLD16(Kg + (size_t)r * 512 + head * 128 + kc * 8); }
    { const int ci = tid + 512, krow = ci >> 4, kc = ci & 15; const int p = kt * 64 + krow; const int r = p < LSEQ ? row_of(sl, p) : 0; st.k1 = GLD16(Kg + (size_t)r * 512 + head * 128 + kc * 8); }
    { const int vi = tid, vrow = vi >> 3, vc = vi & 7; st.v0 = GLD16(VTg + (size_t)(sl * 512 + head * 128 + vrow) * 4160 + kt * 64 + vc * 8); }
    { const int vi = tid + 512, vrow = vi >> 3, vc = vi & 7; st.v1 = GLD16(VTg + (size_t)(sl * 512 + head * 128 + vrow) * 4160 + kt * 64 + vc * 8); }
}
DEV void attn_stage_store(unsigned char* buf, int tid, const AttnStage& st) {
    bf16_t* Kt = (bf16_t*)buf; bf16_t* Vt = (bf16_t*)(buf + 17408);
    { const int ci = tid, krow = ci >> 4, kc = ci & 15; *(u32x4_t*)(Kt + krow * 136 + kc * 8) = st.k0; }
    { const int ci = tid + 512, krow = ci >> 4, kc = ci & 15; *(u32x4_t*)(Kt + krow * 136 + kc * 8) = st.k1; }
    { const int vi = tid, vrow = vi >> 3, vc = vi & 7; *(u32x4_t*)(Vt + vrow * 72 + vc * 8) = st.v0; }
    { const int vi = tid + 512, vrow = vi >> 3, vc = vi & 7; *(u32x4_t*)(Vt + vrow * 72 + vc * 8) = st.v1; }
}
DEV void phase_attn(const Params& P0, int layer, unsigned char* lds, int ua, int ub, int uc, int wv) {
    Params P = load_params(); P.ws = launder_ws(P.ws);
    const int tid = launder_tid(wv), lane = tid & 63, w = __builtin_amdgcn_readfirstlane(tid >> 6), map = w >> 2, qsub = w & 3, qi = lane & 31, hi = lane >> 5;
    const float lam_init = layer == 0 ? 0.2f : 0.35550906759096934f;
    bool fastsm;
    { float mq = 0.f, mk = 0.f;
      for (int i = 0; i < 64; ++i) { mq = fmaxf(mq, fabsf(P.in[I_QN][layer * 64 + i])); mk = fmaxf(mk, fabsf(P.in[I_KN][layer * 64 + i])); }
      fastsm = 11.6f * mq * mk <= 30.0f; }
    float lam;
    { const float* lp = P.in[I_LAM] + (size_t)layer * 256; float s1 = 0.f, s2 = 0.f;
      for (int i = 0; i < 64; ++i) { s1 += lp[i] * lp[64 + i]; s2 += lp[128 + i] * lp[192 + i]; }
      lam = __expf(s1) - __expf(s2) + lam_init; }
    float* Ex = (float*)lds;
#pragma unroll 1
    for (int ui = 0; ui < 3; ++ui) {
        int unit = ui == 0 ? ua : (ui == 1 ? ub : uc);
        if (unit < 0) continue;
        const int ucode = unit; unit = ucode & 4095; const int hmode = ucode >> 12;
        const int sh = unit < 512 ? (unit >> 5) : unit - 512, qb = unit < 512 ? (unit & 31) : 32, sl = sh >> 2, head = sh & 3;
        const int qrow0 = qb < 32 ? sl * 4096 + qb * 128 : TREAL + sl * 16; const int nvalid = qb < 32 ? 128 : 16;
        const bool active = (qsub * 32 < nvalid) && (hmode == 0 || hmode >= 3 || (qsub >> 1) == hmode - 1);
        bf16x8 Qf[4];
        { const bf16_t* qp = slotp(P, 10) + (size_t)(qrow0 + qsub * 32 + qi) * 512 + head * 128 + map * 64 + hi * 8;
#pragma unroll
          for (int ds = 0; ds < 4; ++ds) Qf[ds] = __builtin_bit_cast(bf16x8, GLD16(qp + ds * 16)); }
        AttnStage st;
        const int kt0 = hmode == 4 ? 33 : 0, kt1 = hmode == 3 ? 33 : 65;
        attn_stage_load(P, sl, head, kt0, tid, st); attn_stage_store(lds + (kt0 & 1) * 35840, tid, st); attn_stage_load(P, sl, head, kt0 + 1, tid, st);
        __syncthreads();
        f32x16 O[4];
#pragma unroll
        for (int v = 0; v < 4; ++v)
#pragma unroll
            for (int r = 0; r < 16; ++r) O[v][r] = 0.f;
        float m_run = 0.f, l_run = 0.f;
        f32x16 negm;
#pragma unroll
        for (int r = 0; r < 16; ++r) negm[r] = 0.f;
#pragma unroll 1
        for (int kt = kt0; kt < kt1; ++kt) {
            if (kt + 1 < kt1) attn_stage_store(lds + ((kt + 1) & 1) * 35840, tid, st);
            if (kt + 2 < kt1) attn_stage_load(P, sl, head, kt + 2, tid, st);
            const unsigned char* buf = lds + (kt & 1) * 35840;
            const bf16_t* Kb = (const bf16_t*)buf; const bf16_t* Vb = (const bf16_t*)(buf + 17408);
            if (active) {
            f32x16 S0, S1;
            {
                bf16x8 ka[4], kb[4];
#pragma unroll
                for (int ds = 0; ds < 4; ++ds) { ka[ds] = *(const bf16x8*)(Kb + qi * 136 + map * 64 + ds * 16 + hi * 8); kb[ds] = *(const bf16x8*)(Kb + (32 + qi) * 136 + map * 64 + ds * 16 + hi * 8); }
                __builtin_amdgcn_sched_barrier(0);
                S0 = mfma32(ka[0], Qf[0], negm); S1 = mfma32(kb[0], Qf[0], negm);
#pragma unroll
                for (int ds = 1; ds < 4; ++ds) { S0 = mfma32(ka[ds], Qf[ds], S0); S1 = mfma32(kb[ds], Qf[ds], S1); } }
            if (__builtin_expect(__builtin_amdgcn_readfirstlane(kt) == 64, 0)) {
#pragma unroll
                for (int r = 0; r < 16; ++r) { if (crow(r, hi) >= 16) S0[r] = -INFINITY; S1[r] = -INFINITY; }
                asm volatile("" : "+v"(S0), "+v"(S1)); }
            if (!fastsm) {
            float mx = -INFINITY;
#pragma unroll
            for (int r = 0; r < 16; ++r) mx = fmaxf(mx, fmaxf(S0[r], S1[r]));
            { const auto sw = __builtin_amdgcn_permlane32_swap(__float_as_uint(mx), __float_as_uint(mx), false, false); mx = fmaxf(__uint_as_float(sw[0]), __uint_as_float(sw[1])); }
            if (__builtin_amdgcn_ballot_w64(mx > 8.0f || kt == kt0) != 0ull) {
                const float d = (mx > 8.0f || kt == kt0) ? mx : 0.f; const float alpha = __builtin_amdgcn_exp2f(-d); m_run += d;
                l_run *= alpha;
#pragma unroll
                for (int v = 0; v < 4; ++v)
#pragma unroll
                    for (int r = 0; r < 16; ++r) O[v][r] *= alpha;
#pragma unroll
                for (int r = 0; r < 16; ++r) { S0[r] -= d; S1[r] -= d; negm[r] = -m_run; } }
            }
            float ps = 0.f;
#pragma unroll
            for (int r = 0; r < 16; ++r) { S0[r] = __builtin_amdgcn_exp2f(S0[r]); S1[r] = __builtin_amdgcn_exp2f(S1[r]); ps += S0[r] + S1[r]; }
            l_run += ps;
            bf16x8 pf[2][2];
#pragma unroll
            for (int half = 0; half < 2; ++half) {
                uint4 a, b;
                a.x = pk2(S0[half * 8 + 0], S0[half * 8 + 1]); a.y = pk2(S0[half * 8 + 2], S0[half * 8 + 3]); a.z = pk2(S0[half * 8 + 4], S0[half * 8 + 5]); a.w = pk2(S0[half * 8 + 6], S0[half * 8 + 7]);
                b.x = pk2(S1[half * 8 + 0], S1[half * 8 + 1]); b.y = pk2(S1[half * 8 + 2], S1[half * 8 + 3]); b.z = pk2(S1[half * 8 + 4], S1[half * 8 + 5]); b.w = pk2(S1[half * 8 + 6], S1[half * 8 + 7]);
                pf[0][half] = __builtin_bit_cast(bf16x8, a); pf[1][half] = __builtin_bit_cast(bf16x8, b); }
            {   bf16x8 av[4], nx[4];
#pragma unroll
                for (int f = 0; f < 4; ++f) av[f] = *(const bf16x8*)(Vb + qi * 72 + (f >> 1) * 32 + (f & 1) * 16 + hi * 8);
                __builtin_amdgcn_sched_barrier(0);
#pragma unroll
                for (int v = 0; v < 4; ++v) {
                    if (v < 3) {
#pragma unroll
                        for (int f = 0; f < 4; ++f) nx[f] = *(const bf16x8*)(Vb + ((v + 1) * 32 + qi) * 72 + (f >> 1) * 32 + (f & 1) * 16 + hi * 8); }
                    __builtin_amdgcn_sched_barrier(0);
#pragma unroll
                    for (int f = 0; f < 4; ++f) O[v] = mfma32(av[f], pf[f >> 1][f & 1], O[v]);
                    if (v < 3) {
#pragma unroll
                        for (int f = 0; f < 4; ++f) av[f] = nx[f]; }
                }
            }
            }
            __syncthreads();
        }
        const float l_tot = l_run + __shfl_xor(l_run, 32); const float inv = 1.0f / l_tot;
        if (hmode >= 3) {
            float* pt = (float*)slotp(P, 22) + ((size_t)(((unit - 448) * 2 + (hmode - 3)) * 2 + map) * 128 + qsub * 32 + qi) * 130;
#pragma unroll
            for (int v = 0; v < 4; ++v)
#pragma unroll
                for (int rg = 0; rg < 4; ++rg) { float* d = pt + v * 32 + 8 * rg + 4 * hi; d[0] = O[v][rg * 4 + 0]; d[1] = O[v][rg * 4 + 1]; d[2] = O[v][rg * 4 + 2]; d[3] = O[v][rg * 4 + 3]; }
            if (hi == 0) { pt[128] = m_run; pt[129] = l_tot; }
            __syncthreads();
            continue; }
        if (map == 1) {
#pragma unroll
            for (int v = 0; v < 4; ++v)
#pragma unroll
                for (int r = 0; r < 16; ++r) Ex[(qsub * 32 + qi) * 132 + v * 32 + crow(r, hi)] = O[v][r] * inv; }
        __syncthreads();
        if (map == 0) {
            float ss = 0.f;
#pragma unroll
            for (int v = 0; v < 4; ++v)
#pragma unroll
                for (int r = 0; r < 16; ++r) { const float o = O[v][r] * inv - lam * Ex[(qsub * 32 + qi) * 132 + v * 32 + crow(r, hi)]; O[v][r] = o; ss += o * o; }
            ss += __shfl_xor(ss, 32);
            const float rs = rsqrtf(ss * (1.f / 128.f) + 1e-5f) * (1.f - lam_init);
            if (active && qsub * 32 + qi < nvalid) {
                bf16_t* yp = slotp(P, 4) + (size_t)(qrow0 + qsub * 32 + qi) * 512 + head * 128;
#pragma unroll
                for (int v = 0; v < 4; ++v)
#pragma unroll
                    for (int rg = 0; rg < 4; ++rg) { const int vd0 = v * 32 + 8 * rg + 4 * hi; const f32x4 gg = *(const f32x4*)(P.in[I_SUBLN] + layer * 128 + vd0);
                        uint2 o; o.x = pk2(O[v][rg * 4 + 0] * rs * gg[0], O[v][rg * 4 + 1] * rs * gg[1]); o.y = pk2(O[v][rg * 4 + 2] * rs * gg[2], O[v][rg * 4 + 3] * rs * gg[3]);
                        *(uint2*)(yp + vd0) = o; } }
        }
        __syncthreads();
    }
}
DEV float dpp_f(float x, const int ctrl) { return x; }
template <int CTRL> DEV float dppmov(float x) { return __builtin_bit_cast(float, __builtin_amdgcn_update_dpp(0, __builtin_bit_cast(int, x), CTRL, 0xf, 0xf, true)); }
DEV float sum16(float x) { x += dppmov<0xB1>(x); x += dppmov<0x4E>(x); x += dppmov<0x141>(x); x += dppmov<0x140>(x); return x; }
constexpr int RW_CH = 16, RW_BUF_F = 5120 + 256 + 4096, RW_BUFB = RW_BUF_F * 4;
struct RwRegs { u32x4_t r, k, kk, e, a, v; };
DEV void unpack8v(const u32x4_t w, float* f) { unpack8(make_uint4(w.x, w.y, w.z, w.w), f); }
DEV void rw_stage_load(const Params& P, RwRegs& g, int sl, int head, int dir, int qr, int ck, int t) {
    if (t < 128) { const int step = t >> 3, ch8 = (t & 7) * 8, sidx = ck * RW_CH + step;
        if (sidx < LSEQ) { const int p = dir ? LSEQ - 1 - sidx : sidx; const size_t ro = (size_t)row_of(sl, p) * 512 + head * 64 + ch8;
            g.r = *(const u32x4_t*)(slotp(P, 17) + ro); g.k = *(const u32x4_t*)(slotp(P, 18) + ro); g.kk = *(const u32x4_t*)(slotp(P, 20) + ro);
            g.e = *(const u32x4_t*)(slotp(P, 22 + dir) + ro); g.a = *(const u32x4_t*)(slotp(P, dir == 0 ? 24 : 13) + ro); } }
    if (t < 32) { const int tt = t, s2 = tt >> 1, r8 = (tt & 1) * 8, si2 = ck * RW_CH + s2;
        if (si2 < LSEQ) { const int p2 = dir ? LSEQ - 1 - si2 : si2; g.v = *(const u32x4_t*)(slotp(P, 19) + (size_t)row_of(sl, p2) * 512 + head * 64 + qr * 16 + r8); } }
}
DEV void rw_stage_write(const Params& P, int layer, unsigned char* buf, const RwRegs& g, int head, int ck, int t) {
    float* Rr = (float*)buf; float* Ww = Rr + 1024; float* Kd = Ww + 1024; float* Kk = Kd + 1024; float* Bb = Kk + 1024; float* Vs = Bb + 1024;
    if (t < 128) { const int step = t >> 3, ch8 = (t & 7) * 8, sidx = ck * RW_CH + step;
        if (sidx < LSEQ) {
            float r[8], k[8], kk[8], e[8], a[8];
            unpack8v(g.r, r); unpack8v(g.k, k); unpack8v(g.kk, kk); unpack8v(g.e, e); unpack8v(g.a, a);
            float ww[8], kd[8], bb[8];
#pragma unroll
            for (int j = 0; j < 8; ++j) { ww[j] = __expf(-e[j]); kd[j] = k[j] * (1.f + (a[j] - 1.f) * P.in[I_KA][layer * 512 + head * 64 + ch8 + j]); bb[j] = kk[j] * a[j]; }
            const int o = step * 64 + ch8;
            *(f32x4*)(Rr + o) = (f32x4){r[0], r[1], r[2], r[3]}; *(f32x4*)(Rr + o + 4) = (f32x4){r[4], r[5], r[6], r[7]};
            *(f32x4*)(Ww + o) = (f32x4){ww[0], ww[1], ww[2], ww[3]}; *(f32x4*)(Ww + o + 4) = (f32x4){ww[4], ww[5], ww[6], ww[7]};
            *(f32x4*)(Kd + o) = (f32x4){kd[0], kd[1], kd[2], kd[3]}; *(f32x4*)(Kd + o + 4) = (f32x4){kd[4], kd[5], kd[6], kd[7]};
            *(f32x4*)(Kk + o) = (f32x4){kk[0], kk[1], kk[2], kk[3]}; *(f32x4*)(Kk + o + 4) = (f32x4){kk[4], kk[5], kk[6], kk[7]};
            *(f32x4*)(Bb + o) = (f32x4){bb[0], bb[1], bb[2], bb[3]}; *(f32x4*)(Bb + o + 4) = (f32x4){bb[4], bb[5], bb[6], bb[7]};
        } }
    if (t < 32) { const int tt = t, s2 = tt >> 1, r8 = (tt & 1) * 8, si2 = ck * RW_CH + s2;
        if (si2 < LSEQ) { float v[8]; unpack8v(g.v, v);
            *(f32x4*)(Vs + s2 * 16 + r8) = (f32x4){v[0], v[1], v[2], v[3]}; *(f32x4*)(Vs + s2 * 16 + r8 + 4) = (f32x4){v[4], v[5], v[6], v[7]}; } }
}
DEV void rw_flush(const Params& P, const unsigned char* buf, int sl, int head, int dir, int qr, int ck, int t) {
    if (t >= 160 && t < 192) { const float* Op = (const float*)buf + 5376; const int tt = t - 160, s2 = tt >> 1, r8 = (tt & 1) * 8, sidx = ck * RW_CH + s2;
        if (sidx < LSEQ) { const int p = dir ? LSEQ - 1 - sidx : sidx; float o[8];
#pragma unroll
            for (int j = 0; j < 8; ++j) { const int row = r8 + j; const f32x4* q = (const f32x4*)(Op + s2 * 256 + (row >> 2) * 64 + (row & 3) * 16);
                const f32x4 a = q[0], b = q[1], c = q[2], d = q[3];
                o[j] = ((a[0] + a[1]) + (a[2] + a[3])) + ((b[0] + b[1]) + (b[2] + b[3])) + (((c[0] + c[1]) + (c[2] + c[3])) + ((d[0] + d[1]) + (d[2] + d[3]))); }
            *(uint4*)(slotp(P, 15 + dir) + (size_t)row_of(sl, p) * 512 + head * 64 + qr * 16 + r8) = pack8(o); } }
}
DEV void phase_rw_scan(const Params& P0, int layer, unsigned char* lds, int bid, int nb, int wv) {
    Params P = load_params(); P.ws = launder_ws(P.ws);
    const int tid = launder_tid(wv), lane = tid & 63, w = __builtin_amdgcn_readfirstlane(tid >> 6), li = lane & 15, rl = (w & 3) * 4 + (lane >> 4);
    constexpr int NCK = (LSEQ + RW_CH - 1) / RW_CH;
    typedef float f32x2 __attribute__((ext_vector_type(2)));
    for (int unit = bid; unit < 256; unit += nb) {
        const int sl = unit >> 6, head = (unit >> 3) & 7, dir = (unit >> 2) & 1, qr = unit & 3;
        f32x2 SA = (f32x2){0.f, 0.f}, SB = (f32x2){0.f, 0.f};
        RwRegs g; g.r = g.k = g.kk = g.e = g.a = g.v = (u32x4_t){0u, 0u, 0u, 0u};
        if (w >= 4) { rw_stage_load(P, g, sl, head, dir, qr, 0, tid - 256); rw_stage_write(P, layer, lds, g, head, 0, tid - 256); rw_stage_load(P, g, sl, head, dir, qr, 1, tid - 256); }
        __syncthreads();
#pragma unroll 1
        for (int ck = 0; ck < NCK; ++ck) {
            unsigned char* buf = lds + (ck & 1) * RW_BUFB;
            if (w >= 4) {
                if (ck + 1 < NCK) rw_stage_write(P, layer, lds + ((ck + 1) & 1) * RW_BUFB, g, head, ck + 1, tid - 256);
                if (ck + 2 < NCK) rw_stage_load(P, g, sl, head, dir, qr, ck + 2, tid - 256);
                if (ck > 0) rw_flush(P, lds + ((ck - 1) & 1) * RW_BUFB, sl, head, dir, qr, ck - 1, tid - 256);
            } else {
                const float* Rr = (const float*)buf + li * 4; const float* Vs = (const float*)buf + 5120 + rl; float* Op = (float*)buf + 5376 + w * 64 + lane;
                const int ns = (LSEQ - ck * RW_CH) < RW_CH ? (LSEQ - ck * RW_CH) : RW_CH;
                f32x4 rr = *(const f32x4*)(Rr), ww = *(const f32x4*)(Rr + 1024), kd = *(const f32x4*)(Rr + 2048), kk = *(const f32x4*)(Rr + 3072), bb = *(const f32x4*)(Rr + 4096); float vv = Vs[0];
#pragma unroll 2
                for (int i = 0; i < ns; ++i) {
                    const int in = i < RW_CH - 1 ? i + 1 : RW_CH - 1;
                    const f32x4 rr_n = *(const f32x4*)(Rr + in * 64), ww_n = *(const f32x4*)(Rr + 1024 + in * 64), kd_n = *(const f32x4*)(Rr + 2048 + in * 64);
                    const f32x4 kk_n = *(const f32x4*)(Rr + 3072 + in * 64), bb_n = *(const f32x4*)(Rr + 4096 + in * 64); const float vv_n = Vs[in * 16];
                    f32x2 p = SA * (f32x2){kk[0], kk[1]}; p = __builtin_elementwise_fma(SB, (f32x2){kk[2], kk[3]}, p);
                    const f32x2 vv2 = (f32x2){vv, vv};
                    const f32x2 ta = vv2 * (f32x2){kd[0], kd[1]}, tb = vv2 * (f32x2){kd[2], kd[3]};
                    const float sa = -sum16(p[0] + p[1]);
                    const f32x2 sa2 = (f32x2){sa, sa};
                    SA = __builtin_elementwise_fma(SA, (f32x2){ww[0], ww[1]}, __builtin_elementwise_fma(sa2, (f32x2){bb[0], bb[1]}, ta));
                    SB = __builtin_elementwise_fma(SB, (f32x2){ww[2], ww[3]}, __builtin_elementwise_fma(sa2, (f32x2){bb[2], bb[3]}, tb));
                    f32x2 q = SA * (f32x2){rr[0], rr[1]}; q = __builtin_elementwise_fma(SB, (f32x2){rr[2], rr[3]}, q);
                    Op[i * 256] = q[0] + q[1];
                    rr = rr_n; ww = ww_n; kd = kd_n; kk = kk_n; bb = bb_n; vv = vv_n;
                }
            }
            __syncthreads();
        }
        if (w >= 4) rw_flush(P, lds + ((NCK - 1) & 1) * RW_BUFB, sl, head, dir, qr, NCK - 1, tid - 256);
        __syncthreads();
    }
}
static_assert(LSEQ == 257 * 16, "chunked RWKV assumes whole 16-step chunks");
constexpr int RWC_REC = 8960, RWC_NCK = 257;
DEV unsigned char* rwc_rec(const Params& P, int dir, int idx) {
    const int gi = dir * 8224 + idx;
    if (gi < 1901) return (unsigned char*)slotp(P, 5) + (size_t)gi * RWC_REC;
    if (gi < 7606) return (unsigned char*)slotp(P, 7) + (size_t)(gi - 1901) * RWC_REC;
    if (gi < 9507) return (unsigned char*)slotp(P, 12) + (size_t)(gi - 7606) * RWC_REC;
    if (gi < 11408) return (unsigned char*)slotp(P, 21) + (size_t)(gi - 9507) * RWC_REC;
    return GPTR(unsigned char, P.ws + WS_SLOTS + 25 * SLOT_B + (size_t)(gi - 11408) * RWC_REC); }
DEV int rwc_slot(int c) { return (((c >> 5) * 4 + ((c >> 2) & 3)) * 8) + ((c >> 4) & 1) * 4 + (c & 3); }
DEV void phase_rwc_pre(const Params& P0, int layer, unsigned char* lds, int bid, int nb, int wv) {
    Params P = load_params(); P.ws = launder_ws(P.ws);
    const int tid = launder_tid(wv), lane = tid & 63, w = __builtin_amdgcn_readfirstlane(tid >> 6), l15 = lane & 15, quad = lane >> 4;
    unsigned char* wl = lds + w * 15616;
    bf16_t* Bt = (bf16_t*)wl; bf16_t* Dt = Bt + 16 * 72; bf16_t* Ak = Dt + 16 * 72; bf16_t* Rt = Ak + 16 * 72;
    float* Mb = (float*)(wl + 9216); float* Md = Mb + 256; float* Gb = Md + 256; float* Gd = Gb + 256; float* Tm = Gd + 256; float* Nm = Tm + 256;
    const float ka = P.in[I_KA][layer * 512 + 0];  (void)ka;
    for (int unit2 = bid * 8 + w; unit2 < 2 * 32 * RWC_NCK; unit2 += nb * 8) {
        const int dir = unit2 >= 32 * RWC_NCK ? 1 : 0; const int unit = unit2 - dir * 32 * RWC_NCK;
        const int sh = unit / RWC_NCK, ck = unit - sh * RWC_NCK, sl = sh >> 3, head = sh & 7;
        const float kac = P.in[I_KA][layer * 512 + head * 64 + lane];
        float ak[16], bt[16], dt[16], rt[16];
        typedef const __attribute__((address_space(1))) unsigned short* gu16p;
        const gu16p pR = (gu16p)slotp(P, 17), pK = (gu16p)slotp(P, 18), pKK = (gu16p)slotp(P, 20), pE = (gu16p)slotp(P, 22 + dir), pA = (gu16p)slotp(P, dir == 0 ? 24 : 13);
        unsigned short r16[16], k16[16], q16[16], e16[16], a16[16];
#pragma unroll
        for (int t = 0; t < 16; ++t) {
            const int sidx = ck * 16 + t;
            const int p = dir ? LSEQ - 1 - sidx : sidx; const size_t ro = (size_t)row_of(sl, p) * 512 + head * 64 + lane;
            r16[t] = pR[ro]; k16[t] = pK[ro]; q16[t] = pKK[ro]; e16[t] = pE[ro]; a16[t] = pA[ro]; }
        float g = 1.f;
#pragma unroll
        for (int t = 0; t < 16; ++t) {
            const float r = bf2f(r16[t]), k = bf2f(k16[t]), kk = bf2f(q16[t]), e = bf2f(e16[t]), a = bf2f(a16[t]);
            const float wdec = __expf(-e), kd = k * (1.f + (a - 1.f) * kac), b = kk * a;
            ak[t] = g * kk; g *= wdec; const float gi = __builtin_amdgcn_rcpf(g); bt[t] = b * gi; dt[t] = kd * gi; rt[t] = g * r;
        }
        const float gC = g;
#pragma unroll
        for (int t = 0; t < 16; ++t) { Bt[t * 72 + lane] = (bf16_t)(pk2(bt[t], 0.f) & 0xffffu); Dt[t * 72 + lane] = (bf16_t)(pk2(dt[t], 0.f) & 0xffffu);
            Ak[t * 72 + lane] = (bf16_t)(pk2(ak[t], 0.f) & 0xffffu); Rt[t * 72 + lane] = (bf16_t)(pk2(rt[t], 0.f) & 0xffffu); }
        asm volatile("s_waitcnt lgkmcnt(0)" ::: "memory");
        {
            f32x4 mb = (f32x4){0.f, 0.f, 0.f, 0.f}, md = mb, gb = mb, gd = mb;
#pragma unroll
            for (int ks = 0; ks < 2; ++ks) {
                const bf16x8 fb = *(const bf16x8*)(Bt + l15 * 72 + ks * 32 + quad * 8), fd = *(const bf16x8*)(Dt + l15 * 72 + ks * 32 + quad * 8);
                const bf16x8 fa = *(const bf16x8*)(Ak + l15 * 72 + ks * 32 + quad * 8), fr = *(const bf16x8*)(Rt + l15 * 72 + ks * 32 + quad * 8);
                mb = mfma16(fb, fa, mb); md = mfma16(fd, fa, md); gb = mfma16(fb, fr, gb); gd = mfma16(fd, fr, gd); }
#pragma unroll
            for (int jj = 0; jj < 4; ++jj) { const int j = quad * 4 + jj, t = l15;
                Mb[j * 16 + t] = j < t ? mb[jj] : 0.f; Md[j * 16 + t] = j < t ? md[jj] : 0.f; Gb[j * 16 + t] = j <= t ? gb[jj] : 0.f; Gd[j * 16 + t] = j <= t ? gd[jj] : 0.f; }
        }
        asm volatile("s_waitcnt lgkmcnt(0)" ::: "memory");
        {
            float tc[16];
#pragma unroll
            for (int i = 15; i >= 0; --i) { float acc = (i == l15) ? 1.f : 0.f;
                float mr[16];
#pragma unroll
                for (int q4 = (i + 1) >> 2; q4 < 4; ++q4) { const f32x4 m4 = *(const f32x4*)(Mb + i * 16 + q4 * 4); mr[q4 * 4] = m4[0]; mr[q4 * 4 + 1] = m4[1]; mr[q4 * 4 + 2] = m4[2]; mr[q4 * 4 + 3] = m4[3]; }
#pragma unroll
                for (int l = i + 1; l < 16; ++l) acc -= mr[l] * tc[l];
                tc[i] = acc; }
            if (quad == 0) {
#pragma unroll
                for (int i = 0; i < 16; ++i) Tm[i * 16 + l15] = tc[i]; }
        }
        asm volatile("s_waitcnt lgkmcnt(0)" ::: "memory");
        {
            float n4[4] = {0.f, 0.f, 0.f, 0.f};
#pragma unroll
            for (int l = 0; l < 16; ++l) { const float tv = Tm[l * 16 + l15];
#pragma unroll
                for (int jj = 0; jj < 4; ++jj) n4[jj] += Md[(quad * 4 + jj) * 16 + l] * tv; }
#pragma unroll
            for (int jj = 0; jj < 4; ++jj) Nm[(quad * 4 + jj) * 16 + l15] = n4[jj];
        }
        asm volatile("s_waitcnt lgkmcnt(0)" ::: "memory");
        unsigned char* rec = rwc_rec(P, dir, unit);
        {
            float q4[4];
#pragma unroll
            for (int jj = 0; jj < 4; ++jj) q4[jj] = Gd[(quad * 4 + jj) * 16 + l15];
#pragma unroll
            for (int l = 0; l < 16; ++l) { const float gv = Gb[l * 16 + l15];
#pragma unroll
                for (int jj = 0; jj < 4; ++jj) q4[jj] -= Nm[(quad * 4 + jj) * 16 + l] * gv; }
            *(uint2*)((bf16_t*)(rec + 8192) + l15 * 16 + quad * 4) = make_uint2(pk2(q4[0], q4[1]), pk2(q4[2], q4[3]));
        }
        {
            float ap[16], rp[16], ps[16];
#pragma unroll
            for (int t = 0; t < 16; ++t) { ap[t] = 0.f; rp[t] = rt[t]; }
#pragma unroll
            for (int j = 0; j < 16; ++j) {
#pragma unroll
                for (int q4 = j >> 2; q4 < 4; ++q4) { const f32x4 r4 = *(const f32x4*)(Tm + j * 16 + q4 * 4);
#pragma unroll
                    for (int e = 0; e < 4; ++e) ap[q4 * 4 + e] += ak[j] * r4[e]; } }
#pragma unroll
            for (int j = 0; j < 16; ++j) {
#pragma unroll
                for (int q4 = j >> 2; q4 < 4; ++q4) { const f32x4 r4 = *(const f32x4*)(Gb + j * 16 + q4 * 4);
#pragma unroll
                    for (int e = 0; e < 4; ++e) rp[q4 * 4 + e] -= ap[j] * r4[e]; } }
#pragma unroll
            for (int j = 0; j < 16; ++j) { float acc = dt[j];
#pragma unroll
                for (int q4 = j >> 2; q4 < 4; ++q4) { const f32x4 r4 = *(const f32x4*)(Nm + j * 16 + q4 * 4);
#pragma unroll
                    for (int e = 0; e < 4; ++e) acc -= r4[e] * bt[q4 * 4 + e]; }
                ps[j] = acc * gC; }
            bf16_t* AP = (bf16_t*)rec; bf16_t* RP = AP + 1024; const int so = rwc_slot(lane);
#pragma unroll
            for (int t = 0; t < 16; ++t) { AP[t * 64 + so] = (bf16_t)(pk2(ap[t], 0.f) & 0xffffu); RP[t * 64 + so] = (bf16_t)(pk2(rp[t], 0.f) & 0xffffu); }
            float nb_[16];
#pragma unroll
            for (int t = 0; t < 16; ++t) nb_[t] = -bt[t] * gC;
            uint4* BP = (uint4*)(rec + 4096) + lane * 2; BP[0] = pack8(nb_); BP[1] = pack8(nb_ + 8);
            uint4* PP = (uint4*)(rec + 6144) + lane * 2; PP[0] = pack8(ps); PP[1] = pack8(ps + 8);
            ((float*)(rec + 8704))[lane] = gC;
        }
        asm volatile("s_waitcnt lgkmcnt(0)" ::: "memory");
    }
}
struct RwcRegs { u32x4_t a, b, c, v; };
DEV void rwc_load(const Params& P, RwcRegs& g, int sh, int dir, int ck, int t) {
    const unsigned char* rec = rwc_rec(P, dir, sh * RWC_NCK + ck);
    g.a = GLD16(rec + (size_t)t * 16); g.b = GLD16(rec + (size_t)(t + 256) * 16);
    if (t < 48) g.c = GLD16(rec + (size_t)(t + 512) * 16);
    if (t < 128) { const int j = t >> 3, r8 = (t & 7) * 8, sidx = ck * 16 + j; const int sc = sidx < LSEQ ? sidx : LSEQ - 1; const int p = dir ? LSEQ - 1 - sc : sc;
        g.v = GLD16(slotp(P, 19) + (size_t)row_of(sh >> 3, p) * 512 + (sh & 7) * 64 + r8); if (sidx >= LSEQ) g.v = (u32x4_t){0u, 0u, 0u, 0u}; }
}
DEV void rwc_store(unsigned char* buf, const RwcRegs& g, int t) {
    *(u32x4_t*)(buf + t * 16) = g.a; *(u32x4_t*)(buf + (t + 256) * 16) = g.b;
    if (t < 48) *(u32x4_t*)(buf + (t + 512) * 16) = g.c;
    if (t < 128) { bf16_t* VsT = (bf16_t*)(buf + RWC_REC); const int j = t >> 3, r8 = (t & 7) * 8;
        VsT[(r8 + 0) * 16 + j] = (bf16_t)(g.v.x & 0xffffu); VsT[(r8 + 1) * 16 + j] = (bf16_t)(g.v.x >> 16); VsT[(r8 + 2) * 16 + j] = (bf16_t)(g.v.y & 0xffffu); VsT[(r8 + 3) * 16 + j] = (bf16_t)(g.v.y >> 16);
        VsT[(r8 + 4) * 16 + j] = (bf16_t)(g.v.z & 0xffffu); VsT[(r8 + 5) * 16 + j] = (bf16_t)(g.v.z >> 16); VsT[(r8 + 6) * 16 + j] = (bf16_t)(g.v.w & 0xffffu); VsT[(r8 + 7) * 16 + j] = (bf16_t)(g.v.w >> 16); }
}
DEV void phase_rwc_scan(const Params& P0, unsigned char* lds, int bid, int nb, int wv) {
    Params P = load_params(); P.ws = launder_ws(P.ws);
    const int tid = launder_tid(wv), lane = tid & 63, w = __builtin_amdgcn_readfirstlane(tid >> 6), l15 = lane & 15, quad = lane >> 4;
    constexpr int BUFB = RWC_REC + 2048;
    for (int u2 = bid; u2 < 64; u2 += nb) {
        const int sh = u2 & 31, dir = u2 >> 5; const int sl = sh >> 3, head = sh & 7;
        f32x4 ST[4];
#pragma unroll
        for (int ct = 0; ct < 4; ++ct) ST[ct] = (f32x4){0.f, 0.f, 0.f, 0.f};
        RwcRegs g; g.a = g.b = g.c = g.v = (u32x4_t){0u, 0u, 0u, 0u};
        if (w >= 4) { rwc_load(P, g, sh, dir, 0, tid - 256); rwc_store(lds, g, tid - 256); rwc_load(P, g, sh, dir, 1, tid - 256); }
        __syncthreads();
#pragma unroll 1
        for (int ck = 0; ck < RWC_NCK; ++ck) {
            const unsigned char* buf = lds + (ck & 1) * BUFB;
            if (w >= 4) {
                if (ck + 1 < RWC_NCK) rwc_store(lds + ((ck + 1) & 1) * BUFB, g, tid - 256);
                if (ck + 2 < RWC_NCK) rwc_load(P, g, sh, dir, ck + 2, tid - 256);
            } else {
                const bf16_t* AP = (const bf16_t*)buf; const bf16_t* RP = AP + 1024; const bf16_t* BP = (const bf16_t*)(buf + 4096); const bf16_t* PP = (const bf16_t*)(buf + 6144);
                const bf16_t* QP = (const bf16_t*)(buf + 8192); const float* GC = (const float*)(buf + 8704); const bf16_t* VsT = (const bf16_t*)(buf + RWC_REC);
                const u32x4_t z4 = (u32x4_t){0u, 0u, 0u, 0u};
                u32x4_t sb0, sb1;
                sb0.x = pk2(ST[0][0], ST[0][1]); sb0.y = pk2(ST[0][2], ST[0][3]); sb0.z = pk2(ST[1][0], ST[1][1]); sb0.w = pk2(ST[1][2], ST[1][3]);
                sb1.x = pk2(ST[2][0], ST[2][1]); sb1.y = pk2(ST[2][2], ST[2][3]); sb1.z = pk2(ST[3][0], ST[3][1]); sb1.w = pk2(ST[3][2], ST[3][3]);
                const bf16x8 SB0 = __builtin_bit_cast(bf16x8, sb0), SB1 = __builtin_bit_cast(bf16x8, sb1);
                const bf16x8 a0 = *(const bf16x8*)(AP + l15 * 64 + (0 * 4 + quad) * 8), a1 = *(const bf16x8*)(AP + l15 * 64 + (1 * 4 + quad) * 8);
                const bf16x8 r0 = *(const bf16x8*)(RP + l15 * 64 + (0 * 4 + quad) * 8), r1 = *(const bf16x8*)(RP + l15 * 64 + (1 * 4 + quad) * 8);
                const u32x4_t vq = quad < 2 ? *(const u32x4_t*)(VsT + (w * 16 + l15) * 16 + quad * 8) : z4;
                const u32x4_t qq = quad < 2 ? *(const u32x4_t*)(QP + l15 * 16 + quad * 8) : z4;
                f32x4 gcv[4]; uint2 bqv[4]; u32x4_t pqv[4];
#pragma unroll
                for (int ct = 0; ct < 4; ++ct) { gcv[ct] = *(const f32x4*)(GC + ct * 16 + quad * 4); bqv[ct] = *(const uint2*)(BP + (ct * 16 + l15) * 16 + quad * 4);
                    pqv[ct] = quad < 2 ? *(const u32x4_t*)(PP + (ct * 16 + l15) * 16 + quad * 8) : z4; }
                const bf16x8 VB = __builtin_bit_cast(bf16x8, vq), QA = __builtin_bit_cast(bf16x8, qq);
                f32x4 Wt = (f32x4){0.f, 0.f, 0.f, 0.f}, Ot = Wt;
                Wt = mfma16(a0, SB0, Wt); Wt = mfma16(a1, SB1, Wt);
                Ot = mfma16(r0, SB0, Ot); Ot = mfma16(r1, SB1, Ot); Ot = mfma16(QA, VB, Ot);
                u32x4_t wb; wb.x = pk2(Wt[0], Wt[1]); wb.y = pk2(Wt[2], Wt[3]); wb.z = 0u; wb.w = 0u;
                const bf16x8 WB = __builtin_bit_cast(bf16x8, wb);
#pragma unroll
                for (int ct = 0; ct < 4; ++ct) {
                    u32x4_t ba; ba.x = bqv[ct].x; ba.y = bqv[ct].y; ba.z = 0u; ba.w = 0u;
                    f32x4 acc = ST[ct] * gcv[ct];
                    acc = mfma16(__builtin_bit_cast(bf16x8, ba), WB, acc);
                    acc = mfma16(__builtin_bit_cast(bf16x8, pqv[ct]), VB, acc);
                    ST[ct] = acc;
                }
                bf16_t* Oo = slotp(P, 15 + dir);
#pragma unroll
                for (int jj = 0; jj < 4; ++jj) { const int sidx = ck * 16 + quad * 4 + jj;
                    if (sidx < LSEQ) { const int p = dir ? LSEQ - 1 - sidx : sidx; ((__attribute__((address_space(1))) bf16_t*)Oo)[(size_t)row_of(sl, p) * 512 + head * 64 + w * 16 + l15] = (bf16_t)(pk2(Ot[jj], 0.f) & 0xffffu); } }
            }
            __syncthreads();
        }
    }
}


DEV void phase_attn_combine(const Params& P0, int layer, int bid, int nb, int wv) {
    Params P = load_params(); P.ws = launder_ws(P.ws);
    ROWPRO
    const float lam_init = layer == 0 ? 0.2f : 0.35550906759096934f;
    float lam;
    { const float* lp = P.in[I_LAM] + (size_t)layer * 256; const float s1 = wave_sum(lp[lane] * lp[64 + lane]), s2 = wave_sum(lp[128 + lane] * lp[192 + lane]); lam = __expf(s1) - __expf(s2) + lam_init; }
    const float* PT = (const float*)slotp(P, 22);
    for (int task = gw; task < 64 * 128; task += ngw) {
        const int ul = task >> 7, row = task & 127, unit = 448 + ul, sh = unit >> 5, qb = unit & 31, sl = sh >> 2, head = sh & 3;
        float om[2][2];
#pragma unroll
        for (int map = 0; map < 2; ++map) {
            const float* pa = PT + ((size_t)((ul * 2 + 0) * 2 + map) * 128 + row) * 130; const float* pb = PT + ((size_t)((ul * 2 + 1) * 2 + map) * 128 + row) * 130;
            const float ma = pa[128], la = pa[129], mb = pb[128], lb = pb[129];
            const float M = fmaxf(ma, mb), fa = __builtin_amdgcn_exp2f(ma - M), fb = __builtin_amdgcn_exp2f(mb - M);
            const float inv = 1.0f / (la * fa + lb * fb);
            om[map][0] = (pa[lane * 2] * fa + pb[lane * 2] * fb) * inv; om[map][1] = (pa[lane * 2 + 1] * fa + pb[lane * 2 + 1] * fb) * inv; }
        const float o0 = om[0][0] - lam * om[1][0], o1 = om[0][1] - lam * om[1][1];
        const float ss = wave_sum(o0 * o0 + o1 * o1);
        const float rs = rsqrtf(ss * (1.f / 128.f) + 1e-5f) * (1.f - lam_init);
        const float g0 = P.in[I_SUBLN][layer * 128 + lane * 2], g1 = P.in[I_SUBLN][layer * 128 + lane * 2 + 1];
        *(unsigned*)(slotp(P, 4) + (size_t)(sl * 4096 + qb * 128 + row) * 512 + head * 128 + lane * 2) = pk2(o0 * rs * g0, o1 * rs * g1);
    }
}
#define LAS __attribute__((address_space(3)))
#define XB_TMO      128
#define XB_XCNT(j)  (256  + 64 * (j))
#define XB_XSUB(j)  (1280 + 64 * (j))
#define XB_XGEN(j)  (2304 + 64 * (j))
#define XB_TOP      3328
#define XB_TOPGEN   3392
#define XCD_BAR_WORDS 3456
#define XB_SPIN_CAP (1u << 18)

__device__ __forceinline__ unsigned xb_ld(unsigned* p)              { return __hip_atomic_load(p, __ATOMIC_RELAXED, __HIP_MEMORY_SCOPE_AGENT); }
__device__ __forceinline__ unsigned xb_add(unsigned* p, unsigned v) { return __hip_atomic_fetch_add(p, v, __ATOMIC_RELAXED, __HIP_MEMORY_SCOPE_AGENT); }
__device__ __forceinline__ unsigned xb_xcc_id() { return (unsigned)__builtin_amdgcn_s_getreg((3 << 11) | 20) & 0xFu; }
#define XB_SPIN(cond, bar) do { unsigned _sp = 0; while (cond) { __builtin_amdgcn_s_sleep(1); \
    if ((++_sp & 255u) == 0u) { if (xb_ld(&(bar)[XB_TMO])) break; if (_sp > XB_SPIN_CAP) { atomicAdd(&(bar)[XB_TMO], 1u); break; } } } } while (0)

struct XcdBarrier {
    unsigned* bar; unsigned x;
    volatile LAS unsigned* st;
};

__device__ __forceinline__ XcdBarrier xcd_barrier_post(unsigned* bar, volatile LAS unsigned* st, int wv) {
    XcdBarrier b; b.bar = bar; b.x = xb_xcc_id(); b.st = st;
    if (launder_tid(wv) == 0) (void)xb_add(&bar[XB_XCNT(b.x)], 1u);
    return b;
}
__device__ __forceinline__ void xcd_barrier_complete(unsigned* bar, unsigned x, unsigned& nloc, unsigned& nx) {
    const unsigned G = gridDim.x * gridDim.y * gridDim.z;
    unsigned sum, cnt, mine, sp = 0u;
    for (;;) {
        sum = 0u; cnt = 0u; mine = 0u;
#pragma unroll
        for (unsigned j = 0; j < 16; ++j) { const unsigned c = xb_ld(&bar[XB_XCNT(j)]); sum += c; cnt += (c > 0u) ? 1u : 0u; mine = (j == x) ? c : mine; }
        if (sum == G) break;
        __builtin_amdgcn_s_sleep(1);
        if ((++sp & 255u) == 0u) { if (xb_ld(&bar[XB_TMO])) break; if (sp > XB_SPIN_CAP) { atomicAdd(&bar[XB_TMO], 1u); break; } }
    }
    nloc = mine > 0u ? mine : 1u; nx = cnt > 0u ? cnt : 1u;
}

__device__ __forceinline__ void xcd_barrier(const XcdBarrier& b, int wv) {
    asm volatile("s_waitcnt vmcnt(0)" ::: "memory");
    __syncthreads();
    if (launder_tid(wv) == 0) {
        unsigned* bar = b.bar;
        __builtin_amdgcn_s_waitcnt(0);
        unsigned nloc = b.st[0], nx = b.st[1];
        if (nloc == 0u) { xcd_barrier_complete(bar, b.x, nloc, nx); b.st[0] = nloc; b.st[1] = nx; }
        const unsigned old = xb_add(&bar[XB_XSUB(b.x)], 1u);
        const unsigned gen = old / nloc;
        if (old + 1u == (gen + 1u) * nloc) {
            __builtin_amdgcn_fence(__ATOMIC_RELEASE, "agent");
            asm volatile("s_waitcnt vmcnt(0)" ::: "memory");
            const unsigned og = xb_add(&bar[XB_TOP], 1u);
            const unsigned tg = og / nx;
            if (og + 1u == (tg + 1u) * nx) xb_add(&bar[XB_TOPGEN], 1u);
            else XB_SPIN(xb_ld(&bar[XB_TOPGEN]) == tg, bar);
            __builtin_amdgcn_fence(__ATOMIC_ACQUIRE, "agent");
            xb_add(&bar[XB_XGEN(b.x)], 1u);
            asm volatile("s_waitcnt vmcnt(0)" ::: "memory");
        } else {
            XB_SPIN(xb_ld(&bar[XB_XGEN(b.x)]) == gen, bar);
            __builtin_amdgcn_fence(__ATOMIC_ACQUIRE, "agent");
            asm volatile("s_waitcnt vmcnt(0)" ::: "memory");
        }
    }
    __syncthreads();
}

__global__ void __launch_bounds__(512) mega_fwd(Params P) {
    extern __shared__ __attribute__((aligned(16))) unsigned char lds[];
    cg::grid_group grid = cg::this_grid();
    const int bid = blockIdx.x, nb = gridDim.x; const int wv = __builtin_amdgcn_readfirstlane(threadIdx.x >> 6);
    volatile LAS unsigned* MISC = (volatile LAS unsigned*)((LAS unsigned char*)lds + 131072 + 256);
    if (threadIdx.x < 4) MISC[threadIdx.x] = 0u;
    __syncthreads();
    XcdBarrier xbar;
    { Params Pb = load_params(); xbar = xcd_barrier_post((unsigned*)Pb.ws, MISC, wv); }
#define GSYNC() xcd_barrier(xbar, wv)
    PG8_LAS unsigned char* ldsl = (PG8_LAS unsigned char*)lds;
#pragma unroll 1
    for (int layer_ = 0; layer_ < 2; ++layer_) {
        phase_weights(P, lsd(layer_), lds, bid, nb, wv);
        grid.sync();
#pragma unroll 1
        for (int g_ = 0; g_ < NGRP; ++g_) {
            #define Mpost ((lsd(layer_) == 0 && lsd(g_) == 2) ? TGP : TREAL)
#define NVALID ((lsd(layer_) == 0 && lsd(g_) == 2) ? TG + 128 : TG)
            phase_rmsnorm(P, lsd(g_), lsd(layer_) == 0, I_NMIX, lsd(layer_), TGP, NVALID, bid, nb, wv);
            if (PROBE == 5) { phase_rmsnorm(P, lsd(g_), lsd(layer_) == 0, I_NMIX, lsd(layer_), TGP, NVALID, bid, nb, wv); }
            GSYNC();
            if (PROBE == 6) { for (int q_ = 0; q_ < 15; ++q_) GSYNC(); }
            for (int rep_ = 0; rep_ < (PROBE == 3 ? 2 : 1); ++rep_)
            { Params Pl = load_params(); Pl.ws = launder_ws(Pl.ws); pg8::bf16_t* W = (pg8::bf16_t*)(Pl.ws + WS_W); pg8::Gemm gm{slotp(Pl, 0), W + WO_IN, TGP, 7680, 1024, 0, 0}; pg8::StaticOrder S; S.init(TGP, 7680, nb, bid);
              pg8::EpiBf<0> E{slotp(Pl, 2), 512, SLOT_E};
              pg8::gemm_phase<pg8::EpiBf<0>, pg8::StaticOrder, true, true>(ldsl, gm, S, E, wv); }
            GSYNC();
            phase_da_prep(P, lsd(layer_), bid, nb, wv);
            phase_hg1(P, lsd(layer_), lds, bid, nb, wv);
            if (PROBE == 4) { phase_hg1(P, lsd(layer_), lds, bid, nb, wv); }
            GSYNC();
            phase_hg2(P, bid, nb, wv);
            GSYNC();
            phase_hg3(P, lsd(layer_), lds, bid, nb, wv);
            GSYNC();
            phase_conv(P, lsd(layer_), bid, nb, wv);
            if (PROBE == 5) { phase_conv(P, lsd(layer_), bid, nb, wv); }
            phase_vtrans(P, lds, bid, nb, wv);
            if (PROBE == 5) { phase_vtrans(P, lds, bid, nb, wv); }
            phase_rw_prep(P, lsd(layer_), bid, nb, wv);
            if (PROBE == 5) { phase_rw_prep(P, lsd(layer_), bid, nb, wv); }
            GSYNC();
            { Params Pl = load_params(); Pl.ws = launder_ws(Pl.ws); pg8::bf16_t* W = (pg8::bf16_t*)(Pl.ws + WS_W); pg8::Gemm gm{slotp(Pl, 21), W + WO_LR, TGP, 2560, 384, 0, 0}; pg8::StaticOrder S; S.init(TGP, 2560, nb, bid);
              pg8::EpiLR E{slotp(Pl, 22), slotp(Pl, 23), slotp(Pl, 24), slotp(Pl, 13), slotp(Pl, 14), Pl.in[I_W0] + lsd(layer_) * 1024, Pl.in[I_A0] + lsd(layer_) * 1024};
              pg8::gemm_phase<pg8::EpiLR, pg8::StaticOrder, true, true>(ldsl, gm, S, E, wv); }
            GSYNC();
            phase_rwc_pre(P, lsd(layer_), lds, bid, nb, wv);
            GSYNC();
            if (nb == 256) {
                const int nun = lsd(layer_) == 0 ? 528 : 512;
                if (bid < 64) { phase_rwc_scan(P, lds, bid, nb, wv); __syncthreads(); phase_attn(P, lsd(layer_), lds, bid, -1, -1, wv); }
                else { const int bq = bid - 64;
                    const int third = bq < 128 ? ((448 + (bq >> 1)) | ((3 + (bq & 1)) << 12)) : ((384 + bq < nun) ? 384 + bq : -1);
                    phase_attn(P, lsd(layer_), lds, 64 + bq, 256 + bq, third, wv); }
            } else {
                phase_rwc_scan(P, lds, bid, nb, wv); __syncthreads();
                for (int u = bid; u < (lsd(layer_) == 0 ? 528 : 512); u += nb) phase_attn(P, lsd(layer_), lds, u, -1, -1, wv);
            }
            GSYNC();
            if (nb == 256) phase_attn_combine(P, lsd(layer_), bid, nb, wv);
            phase_rw_post(P, lsd(layer_), lsd(g_), lsd(layer_) == 0 ? TG : TREAL, bid, nb, wv);
            if (PROBE == 5) { phase_rw_post(P, lsd(layer_), lsd(g_), lsd(layer_) == 0 ? TG : TREAL, bid, nb, wv); }
            GSYNC();
            { Params Pl = load_params(); Pl.ws = launder_ws(Pl.ws); pg8::bf16_t* W = (pg8::bf16_t*)(Pl.ws + WS_W); pg8::Gemm gm{slotp(Pl, 2), W + WO_BP, Mpost, 4096, 512, 4, SLOT_B}; pg8::StaticOrder S; S.init(Mpost, 4096, nb, bid);
              pg8::EpiBf<0> E{slotp(Pl, 6), 4096, 0};
              pg8::gemm_phase<pg8::EpiBf<0>, pg8::StaticOrder, true, true>(ldsl, gm, S, E, wv); }
            GSYNC();
            { Params Pl = load_params(); Pl.ws = launder_ws(Pl.ws); pg8::bf16_t* W = (pg8::bf16_t*)(Pl.ws + WS_W); pg8::Gemm gm{slotp(Pl, 0), W + WO_G, Mpost, 4096, 1024, 0, 0}; pg8::StaticOrder S; S.init(Mpost, 4096, nb, bid);
              pg8::EpiGate E{slotp(Pl, 6), slotp(Pl, 14)};
              pg8::gemm_phase<pg8::EpiGate, pg8::StaticOrder, true, true>(ldsl, gm, S, E, wv); }
            GSYNC();
            { Params Pl = load_params(); Pl.ws = launder_ws(Pl.ws); pg8::bf16_t* W = (pg8::bf16_t*)(Pl.ws + WS_W); pg8::Gemm gm{slotp(Pl, 14), W + WO_OUT, Mpost, 1024, 1024, 0, 0}; pg8::StaticOrder S; S.init(Mpost, 1024, nb, bid);
              pg8::EpiResid E{lsd(layer_) == 0 ? x_in_row(Pl, lsd(g_), 0) : (const float*)x_cur_row(Pl, lsd(g_), 0), lsd(layer_) == 0 ? Pl.in[I_META] : (const float*)nullptr, x_cur_row(Pl, lsd(g_), 0), GPTR(float, Pl.ws + WS_XMETA), lsd(g_), NVALID};
              pg8::gemm_phase<pg8::EpiResid, pg8::StaticOrder, true, true>(ldsl, gm, S, E, wv); }
            GSYNC();
            phase_rmsnorm(P, lsd(g_), false, I_NMLP, lsd(layer_), Mpost, NVALID, bid, nb, wv);
            if (PROBE == 5) { phase_rmsnorm(P, lsd(g_), false, I_NMLP, lsd(layer_), Mpost, NVALID, bid, nb, wv); }
            GSYNC();
            for (int rep_ = 0; rep_ < (PROBE == 7 ? 2 : 1); ++rep_)
            { Params Pl = load_params(); Pl.ws = launder_ws(Pl.ws); pg8::bf16_t* W = (pg8::bf16_t*)(Pl.ws + WS_W); pg8::Gemm gm{slotp(Pl, 0), W + WO_1, Mpost, 4096, 1024, 0, 0}; pg8::StaticOrder S; S.init(Mpost, 4096, nb, bid);
              pg8::EpiBf<1> E{slotp(Pl, 6), 4096, 0};
              pg8::gemm_phase<pg8::EpiBf<1>, pg8::StaticOrder, true, true>(ldsl, gm, S, E, wv); }
            GSYNC();
            { Params Pl = load_params(); Pl.ws = launder_ws(Pl.ws); pg8::bf16_t* W = (pg8::bf16_t*)(Pl.ws + WS_W); pg8::Gemm gm{slotp(Pl, 6), W + WO_2, Mpost, 1024, 4096, 0, 0}; pg8::StaticOrder S; S.init(Mpost, 1024, nb, bid);
              pg8::EpiResid E{(const float*)x_cur_row(Pl, lsd(g_), 0), (const float*)nullptr, x_cur_row(Pl, lsd(g_), 0), GPTR(float, Pl.ws + WS_XMETA), lsd(g_), NVALID};
              pg8::gemm_phase<pg8::EpiResid, pg8::StaticOrder, true, true>(ldsl, gm, S, E, wv); }
            GSYNC();
        }
    }
}

extern "C" void kernel_launch(void* const* d_in, const int* in_sizes, int n_in, void* d_out, int out_size, void* d_ws, size_t ws_size, hipStream_t stream) {
    static int grid = 0;
    if (grid == 0) {
        if (n_in != 29 || ws_size < WS_NEED) { fprintf(stderr, "kernel_launch: need 29 inputs and %zu bytes of workspace; got %d, %zu\n", (size_t)WS_NEED, n_in, ws_size); grid = -1; return; }
        int dev = 0, cus = 0, per_cu = 0;
        if (hipGetDevice(&dev) != hipSuccess || hipDeviceGetAttribute(&cus, hipDeviceAttributeMultiprocessorCount, dev) != hipSuccess) { grid = -1; return; }
        if (hipFuncSetAttribute((const void*)mega_fwd, hipFuncAttributeMaxDynamicSharedMemorySize, LDS_BYTES) != hipSuccess) { fprintf(stderr, "kernel_launch: hipFuncSetAttribute failed\n"); grid = -1; return; }
        if (hipOccupancyMaxActiveBlocksPerMultiprocessor(&per_cu, (const void*)mega_fwd, 512, LDS_BYTES) != hipSuccess || per_cu < 1) { fprintf(stderr, "kernel_launch: occupancy query says %d\n", per_cu); per_cu = 1; }
        (void)hipGetLastError();
        grid = cus;
    }
    if (grid < 0) return;
    if (hipMemsetAsync(d_ws, 0, 16384, stream) != hipSuccess) { fprintf(stderr, "kernel_launch: memset failed\n"); return; }
    Params p{};
    for (int i = 0; i < 29; ++i) p.in[i] = (const float*)d_in[i];
    p.out = (float*)d_out; p.ws = (unsigned char*)d_ws;
    void* args[] = {&p};
    hipError_t e = hipLaunchCooperativeKernel((const void*)mega_fwd, dim3(grid), dim3(512), args, LDS_BYTES, stream);
    if (e != hipSuccess) fprintf(stderr, "kernel_launch: cooperative launch failed: %s (grid %d)\n", hipGetErrorString(e), grid);
}
```
